# Optimizing an MI355X kernel written in HIP

```python
import jax, jax.numpy as jnp
from jax import lax
import numpy as np

D_MODEL = 1024
BATCH = 4
SEQ = 4096
DEPTH = 1

CTX_LEN = 256
GRID_W = 64
CONV_WIDTH = D_MODEL
CONV_K = 3
RET_HEADS = 8
RET_DV = D_MODEL // RET_HEADS
RET_DK = RET_DV // 2
RET_QK_WIDTH = RET_HEADS * RET_DK
RET_V_WIDTH = RET_HEADS * RET_DV
CHUNK = 128
ROPE_BASE = 10000.0
EPS = 1e-6
IN_WIDTHS = (CONV_WIDTH, CONV_WIDTH, CONV_WIDTH, CONV_WIDTH,
             RET_QK_WIDTH, RET_QK_WIDTH, RET_V_WIDTH, RET_V_WIDTH, D_MODEL, D_MODEL)
SPLIT_POINTS = tuple(int(s) for s in np.cumsum(IN_WIDTHS)[:-1])
IN_WIDTH = int(sum(IN_WIDTHS))

kernel_name = "hybrid_conv_retention_dit_block"


def rmsnorm(x, w):
    x32 = x.astype(jnp.float32)
    y = x32 * lax.rsqrt(jnp.mean(x32 * x32, axis=-1, keepdims=True) + EPS)
    return (y * w.astype(jnp.float32)).astype(x.dtype)


def dwconv_centred(u, w, b):
    L = u.shape[1]
    pad = CONV_K // 2
    up = jnp.pad(u, ((0, 0), (pad, pad), (0, 0)))
    return sum(up[:, j:j + L] * w[j] for j in range(CONV_K)) + b


def to_heads(t, d):
    B_, L, _ = t.shape
    return t.reshape(B_, L, RET_HEADS, d).transpose(0, 2, 1, 3)


def rope2d(t):
    L = t.shape[2]
    rows = L // GRID_W
    row = jnp.repeat(jnp.arange(rows), GRID_W).astype(jnp.float32)
    col = jnp.tile(jnp.arange(GRID_W), rows).astype(jnp.float32)
    nf = RET_DK // 4
    inv = ROPE_BASE ** (-jnp.arange(nf, dtype=jnp.float32) / nf)
    ang = jnp.concatenate([row[:, None] * inv, col[:, None] * inv], axis=-1)
    cos = jnp.cos(ang).astype(t.dtype)
    sin = jnp.sin(ang).astype(t.dtype)
    half = RET_DK // 2
    t1, t2 = t[..., :half], t[..., half:]
    return jnp.concatenate([t1 * cos - t2 * sin, t1 * sin + t2 * cos], axis=-1)


def retention_scan(q, k, v, log_gamma, s0):
    B_, H, L, dk = q.shape
    dv = v.shape[-1]
    n = L // CHUNK
    qc = q.astype(jnp.float32).reshape(B_, H, n, CHUNK, dk)
    kc = k.astype(jnp.float32).reshape(B_, H, n, CHUNK, dk)
    vc = v.astype(jnp.float32).reshape(B_, H, n, CHUNK, dv)
    idx = jnp.arange(CHUNK, dtype=jnp.float32)
    diff = idx[:, None] - idx[None, :]
    dmask = jnp.where(diff >= 0, jnp.exp(log_gamma[:, None, None] * jnp.maximum(diff, 0.0)), 0.0)
    scores = jnp.einsum('bhnid,bhnjd->bhnij', qc, kc) * dmask[None, :, None]
    inner = jnp.einsum('bhnij,bhnjv->bhniv', scores, vc)
    k_dec = jnp.exp(log_gamma[:, None] * (CHUNK - 1 - idx))
    kv = jnp.einsum('bhnjd,hj,bhnjv->bhndv', kc, k_dec, vc)
    chunk_decay = jnp.exp(log_gamma * CHUNK)[None, :, None, None]

    def step(s, kv_c):
        return chunk_decay * s + kv_c, s

    _, s_prev = lax.scan(step, s0.astype(jnp.float32), jnp.moveaxis(kv, 2, 0))
    s_prev = jnp.moveaxis(s_prev, 0, 2)
    q_dec = jnp.exp(log_gamma[:, None] * (idx + 1.0))
    cross = jnp.einsum('bhnid,hi,bhndv->bhniv', qc, q_dec, s_prev)
    return (inner + cross).reshape(B_, H, L, dv)


def bidir_retention(q, k, v, lg_f, lg_b, s0_f, s0_b):
    o_f = retention_scan(q, k, v, lg_f, s0_f)
    flip = lambda t: t[:, :, ::-1]
    o_b = retention_scan(flip(q), flip(k), flip(v), lg_b, s0_b)
    return o_f + flip(o_b)


def ctx_final_states(k, v, lg_f, lg_b):
    Lc = k.shape[2]
    m = jnp.arange(Lc, dtype=jnp.float32)
    k32 = k.astype(jnp.float32)
    v32 = v.astype(jnp.float32)
    dec_f = jnp.exp(lg_f[:, None] * (Lc - 1 - m))
    dec_b = jnp.exp(lg_b[:, None] * m)
    s_f = jnp.einsum('bhmd,hm,bhmv->bhdv', k32, dec_f, v32)
    s_b = jnp.einsum('bhmd,hm,bhmv->bhdv', k32, dec_b, v32)
    return s_f, s_b


def retention_groupnorm(ret, gn_w, dtype):
    mu = jnp.mean(ret, axis=-1, keepdims=True)
    var = jnp.mean(jnp.square(ret - mu), axis=-1, keepdims=True)
    rn = (ret - mu) * lax.rsqrt(var + EPS)
    B_, H, L, dv = rn.shape
    rn = rn.transpose(0, 2, 1, 3).reshape(B_, L, H * dv)
    return (rn * gn_w.astype(jnp.float32)).astype(dtype)


def split_heads(proj, rotary):
    h, bg, cg, za, q, k, v, zb, ga, gb = jnp.split(proj, SPLIT_POINTS, axis=-1)
    q = to_heads(q, RET_DK)
    k = to_heads(k, RET_DK) * (RET_DK ** -0.5)
    v = to_heads(v, RET_DV)
    if rotary:
        q, k = rope2d(q), rope2d(k)
    return (h, bg, cg, za, zb, ga, gb), (q, k, v)


def merge_branches(parts, ret, conv_w, conv_b, gn_w, w_a, w_b, w_out):
    h, bg, cg, za, zb, ga, gb = parts
    conv_out = dwconv_centred(cg * h, conv_w, conv_b)
    y_a = (jax.nn.silu(za) * bg * conv_out) @ w_a
    ret_n = retention_groupnorm(ret, gn_w, h.dtype)
    y_b = (jax.nn.silu(zb) * ret_n) @ w_b
    return (jax.nn.sigmoid(ga) * y_a + jax.nn.sigmoid(gb) * y_b) @ w_out


def setup_inputs(seed: int = 0) -> dict:
    key = jax.random.key(seed)
    ks = jax.random.split(key, 20)
    f32 = jnp.float32
    nrm = lambda k, shape, s: jax.random.normal(k, shape, f32) * s
    base_gamma = 1.0 - 2.0 ** (-5.0 - np.arange(RET_HEADS, dtype=np.float32))
    base_logit = jnp.asarray(np.log(base_gamma / (1.0 - base_gamma)), f32)
    decay_logit = base_logit[None, None, :] + nrm(ks[10], (DEPTH, 2, RET_HEADS), 0.1)
    return {
        "x": nrm(ks[0], (BATCH, SEQ, D_MODEL), 1.0),
        "c": nrm(ks[1], (BATCH, D_MODEL), 1.0),
        "ctx": nrm(ks[2], (BATCH, CTX_LEN, D_MODEL), 1.0),
        "c_ctx": nrm(ks[3], (D_MODEL,), 1.0),
        "norm_w": 1.0 + nrm(ks[4], (DEPTH, D_MODEL), 0.02),
        "ada_w": nrm(ks[5], (DEPTH, D_MODEL, 3 * D_MODEL), 0.5 * D_MODEL ** -0.5),
        "ada_b": nrm(ks[6], (DEPTH, 3 * D_MODEL), 0.02),
        "w_in": nrm(ks[7], (DEPTH, D_MODEL, IN_WIDTH), D_MODEL ** -0.5),
        "conv_w": nrm(ks[8], (DEPTH, CONV_K, CONV_WIDTH), CONV_K ** -0.5),
        "conv_b": nrm(ks[9], (DEPTH, CONV_WIDTH), 0.02),
        "decay_logit": decay_logit,
        "gn_w": 1.0 + nrm(ks[11], (DEPTH, RET_V_WIDTH), 0.02),
        "w_a": nrm(ks[12], (DEPTH, CONV_WIDTH, D_MODEL), CONV_WIDTH ** -0.5),
        "w_b": nrm(ks[13], (DEPTH, RET_V_WIDTH, D_MODEL), RET_V_WIDTH ** -0.5),
        "w_out": nrm(ks[14], (DEPTH, D_MODEL, D_MODEL), D_MODEL ** -0.5),
        "final_norm_w": 1.0 + nrm(ks[15], (D_MODEL,), 0.02),
    }


def reference(x, c, ctx, c_ctx, norm_w, ada_w, ada_b, w_in, conv_w, conv_b,
              decay_logit, gn_w, w_a, w_b, w_out, final_norm_w):
    for l in range(DEPTH):
        mod_x = jax.nn.silu(c) @ ada_w[l] + ada_b[l]
        sh_x, sc_x, g_x = jnp.split(mod_x[:, None, :], 3, axis=-1)
        mod_c = jax.nn.silu(c_ctx) @ ada_w[l] + ada_b[l]
        sh_c, sc_c, g_c = jnp.split(mod_c, 3, axis=-1)
        xm = rmsnorm(x, norm_w[l]) * (1.0 + sc_x) + sh_x
        cm = rmsnorm(ctx, norm_w[l]) * (1.0 + sc_c) + sh_c
        parts_x, (qx, kx, vx) = split_heads(xm @ w_in[l], rotary=True)
        parts_c, (qc, kc, vc) = split_heads(cm @ w_in[l], rotary=False)
        lg = jax.nn.log_sigmoid(decay_logit[l].astype(jnp.float32))
        s_f, s_b = ctx_final_states(kc, vc, lg[0], lg[1])
        ret_x = bidir_retention(qx, kx, vx, lg[0], lg[1], s_f, s_b)
        y_x = merge_branches(parts_x, ret_x, conv_w[l], conv_b[l], gn_w[l], w_a[l], w_b[l], w_out[l])
        if l < DEPTH - 1:
            zeros = jnp.zeros_like(s_f)
            ret_c = bidir_retention(qc, kc, vc, lg[0], lg[1], zeros, zeros)
            y_c = merge_branches(parts_c, ret_c, conv_w[l], conv_b[l], gn_w[l], w_a[l], w_b[l], w_out[l])
            ctx = ctx + g_c * y_c
        x = x + g_x * y_x
    return rmsnorm(x, final_norm_w)
```

```cpp
#include <hip/hip_runtime.h>
#include <hip/hip_cooperative_groups.h>
#include <cstdio>
#include <cstdint>
namespace cg = cooperative_groups;

#ifndef MK_LAUNCH_PER_PHASE
#define MK_LAUNCH_PER_PHASE 1
#endif
#ifndef MK_NAIVE_MASK
#define MK_NAIVE_MASK 0xFCu
#endif

#ifndef MK_PHASES
#define MK_PHASES 0x1ff
#endif
#ifndef MK_NAIVE_AVAIL
#define MK_NAIVE_AVAIL 0xffu
#endif
#define DI __device__ __forceinline__
#define LAS __attribute__((address_space(3)))
typedef unsigned short bf16_t;
typedef float f32x4 __attribute__((ext_vector_type(4)));
typedef float f32x2 __attribute__((ext_vector_type(2)));
typedef unsigned u32x4 __attribute__((ext_vector_type(4)));
typedef unsigned u32x2 __attribute__((ext_vector_type(2)));
typedef short bf16x8 __attribute__((ext_vector_type(8)));
typedef short s16x4 __attribute__((ext_vector_type(4)));
typedef short v4i16_t __attribute__((ext_vector_type(4)));

constexpr int NB = 4, SEQ = 4096, DM = 1024, MTOK = NB * SEQ, CTXL = 256, MCTX = NB * CTXL, MALL = MTOK + MCTX;
constexpr int NIN = 9216, NH = 8, DK = 64, DV = 128, CHK = 128, NCHK = SEQ / CHK;
constexpr float EPS = 1e-6f;
constexpr size_t MiB = 1u << 20;
constexpr size_t WS_MOD = 0;
constexpr size_t WS_ROPE = 65536;
constexpr size_t WS_WA = 2 * MiB, WS_WB = 4 * MiB, WS_WOUT = 6 * MiB, WS_WIN = 8 * MiB;
constexpr size_t WS_XM = 26 * MiB;
constexpr size_t WS_KV = 8 * MiB;
constexpr size_t WS_KVC = 40 * MiB;
constexpr size_t WS_RET = 8 * MiB;
constexpr size_t WS_HC = 60 * MiB;
constexpr size_t WS_ST = 60 * MiB;
constexpr size_t WS_MM = 60 * MiB;
constexpr size_t WS_P = 92 * MiB;
constexpr size_t WS_Q = 124 * MiB, WS_K = 140 * MiB, WS_V = 156 * MiB, WS_SZB = 188 * MiB;
constexpr size_t WS_KC = 220 * MiB, WS_VC = 221 * MiB;
constexpr size_t WS_UB = 223 * MiB;
constexpr size_t WS_END = 255 * MiB;
constexpr int LDS_BYTES = 147456;

DI float bf2f(bf16_t v) { return __uint_as_float((unsigned)v << 16); }
DI float bflo(unsigned w) { return __uint_as_float(w << 16); }
DI float bfhi(unsigned w) { return __uint_as_float(w & 0xffff0000u); }
DI unsigned cvt_pk_bf16(float lo, float hi) { unsigned r; asm volatile("v_cvt_pk_bf16_f32 %0, %1, %2" : "=v"(r) : "v"(lo), "v"(hi)); return r; }
DI bf16_t f2bf(float f) { return (bf16_t)(cvt_pk_bf16(f, 0.f) & 0xffffu); }
DI float wave_sum(float v) {
#pragma unroll
    for (int o = 1; o < 64; o <<= 1) v += __shfl_xor(v, o);
    return v;
}
DI float siluf(float x) { return x * __builtin_amdgcn_rcpf(1.f + __expf(-x)); }
DI float log2_gamma(const float* decay_logit, int dir, int h) {
    const float x = decay_logit[dir * NH + h];
    const float ls = fminf(x, 0.f) - log1pf(expf(-fabsf(x)));
    return ls * 1.4426950408889634f;
}

namespace pg8 {
constexpr int BM = 256, BK = 64, HALF = 128, HTB = HALF * BK * 2, STAGE_BYTES = 8 * HTB, NXCD = 8, WGM = 8;
DI int lds_byte(int r, int c) { const int st = (r >> 4) * 2 + (c >> 5), rr = r & 15, cc = c & 31, ob = rr * 64 + cc * 2; return st * 1024 + (ob ^ (((ob >> 9) & 1) << 5)); }
DI void stage_rc(int b, int& R, int& C) { const int st = b / 1024, sb = b % 1024, swz = sb ^ (((sb >> 9) & 1) << 5); R = (st >> 1) * 16 + swz / 64; C = (st & 1) * 32 + (swz % 64) / 2; }
DI int perm32(int rho) { const int n = rho >> 4, i = rho & 15; return 8 * (i >> 2) + 4 * n + (i & 3); }
struct Unit { int pm, pn; };
DI void tile_of(int L, int nM, int nN, Unit& u) {
    const int nwg = nM * nN; int wgid = L;
    { const int q = nwg / NXCD, r = nwg % NXCD, xcd = wgid % NXCD, off = wgid / NXCD; wgid = (xcd < r ? xcd * (q + 1) : r * (q + 1) + (xcd - r) * q) + off; }
    const int nig = WGM * nN, gid = wgid / nig, fm = gid * WGM, gsz = (nM - fm) < WGM ? (nM - fm) : WGM;
    u.pm = fm + ((wgid % nig) % gsz); u.pn = (wgid % nig) / gsz;
}
template <int NSEG, class Epi, class Sched>
DI void gemm_phase(LAS unsigned char* lds, const char* const (&Ab)[2], const char* const (&Bb)[2], const Sched& S, const Epi& E) {
    constexpr int K = 1024, NTS = K / BK;
    constexpr int nt = NSEG * NTS;
    const int tid = threadIdx.x, wid = __builtin_amdgcn_readfirstlane(tid >> 6), lane = tid & 63, wr = wid >> 2, wc = wid & 3, fr = lane & 15, fq = lane >> 4;
    unsigned voffA[2], voffB[2];
#pragma unroll
    for (int i = 0; i < 2; ++i) { int R, C; stage_rc(tid * 16 + i * 8192, R, C); const int Rb = (R & ~31) + perm32(R & 31);
        voffA[i] = (unsigned)(R * K + C) * 2u; voffB[i] = (unsigned)(Rb * K + C) * 2u; }
    constexpr size_t kstep = (size_t)(BK * 2);
    constexpr size_t hstep = (size_t)HALF * K * 2;
    constexpr size_t tstep = 2 * hstep;
    const unsigned ldsw = (unsigned)wid * 1024u;
    const int aoff = lds_byte(wr * 64 + fr, fq * 8), boff = lds_byte(wc * 32 + fr, fq * 8);
#define PG8_SA(b, h) (((b) * 2 + (h)) * HTB)
#define PG8_SB(b, h) ((4 + (b) * 2 + (h)) * HTB)
#define PG8_STAGE(bufoff, gbase, voff) do { _Pragma("unroll") for (int _i = 0; _i < 2; ++_i) \
        __builtin_amdgcn_global_load_lds((const unsigned*)((const char*)(gbase) + (voff)[_i]), (LAS unsigned*)(lds + (bufoff) + ldsw + _i * 8192), 16, 0, 0); } while (0)
#define PG8_LDA(dst, b, h) do { _Pragma("unroll") for (int m = 0; m < 4; ++m) _Pragma("unroll") for (int k = 0; k < 2; ++k) dst[m][k] = *(const LAS bf16x8*)(lds + PG8_SA(b, h) + aoff + m * 2048 + k * 1024); } while (0)
#define PG8_LDB(dst, b, h) do { _Pragma("unroll") for (int n = 0; n < 2; ++n) _Pragma("unroll") for (int k = 0; k < 2; ++k) dst[n][k] = *(const LAS bf16x8*)(lds + PG8_SB(b, h) + boff + n * 2048 + k * 1024); } while (0)
#define PG8_MMA(ai, bj, At, Bt) do { __builtin_amdgcn_s_setprio(1); _Pragma("unroll") for (int m = 0; m < 4; ++m) _Pragma("unroll") for (int n = 0; n < 2; ++n) _Pragma("unroll") for (int k = 0; k < 2; ++k) \
        acc[ai][bj][m][n] = __builtin_amdgcn_mfma_f32_16x16x32_bf16(Bt[n][k], At[m][k], acc[ai][bj][m][n], 0, 0, 0); __builtin_amdgcn_s_setprio(0); } while (0)
#define PG8_WAIT_V(n) asm volatile("s_waitcnt vmcnt(" #n ")" ::: "memory")
#define PG8_WAIT_L(n) asm volatile("s_waitcnt lgkmcnt(" #n ")" ::: "memory")
#define PG8_BAR __builtin_amdgcn_s_barrier()
#define PG8_SCHED __builtin_amdgcn_sched_barrier(0)
#define PG8_TA(u, t) (Ab[(t) / NTS] + (size_t)(u).pm * tstep + (size_t)((t) % NTS) * kstep)
#define PG8_TB(u, t) (Bb[(t) / NTS] + (size_t)(u).pn * tstep + (size_t)((t) % NTS) * kstep)
    Unit cur, nxt; int ui = 0;
    if (!S.next(0, cur)) return;
    f32x4 acc[2][2][4][2];
#pragma unroll
    for (int a = 0; a < 2; ++a)
#pragma unroll
        for (int b = 0; b < 2; ++b)
#pragma unroll
            for (int m = 0; m < 4; ++m)
#pragma unroll
                for (int n = 0; n < 2; ++n) acc[a][b][m][n] = (f32x4){0.f, 0.f, 0.f, 0.f};
    bf16x8 At[4][2], B0[2][2], B1[2][2];
    {
        const char* cA = PG8_TA(cur, 0); const char* cB = PG8_TB(cur, 0);
        PG8_STAGE(PG8_SB(0, 0), cB, voffB); PG8_STAGE(PG8_SB(0, 1), cB + hstep, voffB); PG8_STAGE(PG8_SA(0, 0), cA, voffA); PG8_STAGE(PG8_SA(0, 1), cA + hstep, voffA);
        if (wr == 1) PG8_BAR;
        PG8_WAIT_V(2); PG8_BAR;
        PG8_STAGE(PG8_SB(1, 0), cB + kstep, voffB); PG8_STAGE(PG8_SA(1, 0), cA + kstep, voffA); PG8_STAGE(PG8_SB(1, 1), cB + hstep + kstep, voffB);
        PG8_WAIT_V(6); PG8_BAR;
    }
    for (;;) {
        const bool has_next = S.next(ui + 1, nxt);
        const Unit nu = has_next ? nxt : cur;
        for (int t = 0; t < nt; t += 2) {
            if (NSEG == 2 && t == NTS) E.mid(acc, cur, wr, wc, fr, fq);
            const bool last = (t == nt - 2);
            const char* a1 = PG8_TA(cur, t + 1);
            const char* a2 = last ? PG8_TA(nu, 0) : PG8_TA(cur, t + 2); const char* b2 = last ? PG8_TB(nu, 0) : PG8_TB(cur, t + 2);
            const char* a3 = a2 + kstep; const char* b3 = b2 + kstep;
            PG8_LDB(B0, 0, 0); PG8_LDB(B1, 0, 1); PG8_SCHED; PG8_LDA(At, 0, 0); PG8_STAGE(PG8_SA(1, 1), a1 + hstep, voffA);
            PG8_WAIT_V(8); PG8_WAIT_L(0); PG8_BAR; PG8_MMA(0, 0, At, B0); PG8_MMA(0, 1, At, B1); PG8_BAR; PG8_SCHED;
            PG8_LDA(At, 0, 1); PG8_STAGE(PG8_SB(0, 0), b2, voffB); PG8_STAGE(PG8_SB(0, 1), b2 + hstep, voffB); PG8_STAGE(PG8_SA(0, 0), a2, voffA);
            PG8_WAIT_V(8); PG8_WAIT_L(0); PG8_BAR; PG8_MMA(1, 0, At, B0); PG8_MMA(1, 1, At, B1); PG8_BAR; PG8_SCHED;
            PG8_LDB(B0, 1, 0); PG8_LDB(B1, 1, 1); PG8_SCHED; PG8_LDA(At, 1, 0); PG8_STAGE(PG8_SA(0, 1), a2 + hstep, voffA);
            PG8_WAIT_V(8); PG8_WAIT_L(0); PG8_BAR; PG8_MMA(0, 0, At, B0); PG8_MMA(0, 1, At, B1); PG8_BAR; PG8_SCHED;
            PG8_LDA(At, 1, 1); PG8_STAGE(PG8_SB(1, 0), b3, voffB); PG8_STAGE(PG8_SB(1, 1), b3 + hstep, voffB); PG8_STAGE(PG8_SA(1, 0), a3, voffA);
            PG8_WAIT_V(8); PG8_WAIT_L(0); PG8_BAR; PG8_MMA(1, 0, At, B0); PG8_MMA(1, 1, At, B1); PG8_BAR; PG8_SCHED;
        }
        if (wr == 0) PG8_BAR;
        E(acc, cur, wr, wc, fr, fq);
        if (!has_next) break;
#pragma unroll
        for (int a = 0; a < 2; ++a)
#pragma unroll
            for (int b = 0; b < 2; ++b)
#pragma unroll
                for (int m = 0; m < 4; ++m)
#pragma unroll
                    for (int n = 0; n < 2; ++n) acc[a][b][m][n] = (f32x4){0.f, 0.f, 0.f, 0.f};
        cur = nxt; ++ui;
        if (wr == 1) PG8_BAR;
    }
    PG8_WAIT_V(0);
    PG8_BAR;
#undef PG8_SA
#undef PG8_SB
#undef PG8_STAGE
#undef PG8_LDA
#undef PG8_LDB
#undef PG8_MMA
#undef PG8_WAIT_V
#undef PG8_WAIT_L
#undef PG8_BAR
#undef PG8_SCHED
#undef PG8_TA
#undef PG8_TB
}
}

struct Args { const float* in[16]; float* out; unsigned char* ws; int ph_lo, ph_hi; unsigned naive; int pad; };
struct Ctx {
    LAS unsigned char* lds; int tid, lane, wave;
    const float *x, *c, *ctx, *c_ctx, *norm_w, *ada_w, *ada_b, *w_in, *conv_w, *conv_b, *decay_logit, *gn_w, *w_a, *w_b, *w_out, *final_w;
    float* out; unsigned char* ws;
    float* MOD; f32x2* ROPE;
    bf16_t *WA, *WB, *WOUT, *WIN, *XM, *KV, *KVC, *HC, *ST, *MM, *P, *Q, *K, *V, *SZB, *KC, *VC, *UB, *R, *SGB;
    float* RET;
};

DI int win_dest(int o) {
    if (o < 4096) { const int g = o >> 10, ch = o & 1023; return 256 * (ch >> 6) + 64 * g + (ch & 63); }
    if (o < 5120) { const int qk = (o - 4096) >> 9, oo = (o - 4096) & 511, head = oo >> 6, i = oo & 63, t = head >> 2, hh = head & 3;
        return 256 * (16 + 2 * qk + t) + (i < 32 ? 32 * hh + i : 128 + 32 * hh + (i - 32)); }
    if (o < 7168) return o;
    { const int gs = (o - 7168) >> 10, ch = (o - 7168) & 1023; return 256 * (28 + (ch >> 7)) + 128 * gs + (ch & 127); }
}
DI void p0_transpose_item(const float* W, int K, int N, bf16_t* WT, bool permute, LAS float* scr, int item, int lane) {
    const int nblk = N / 32, kb = item / nblk, nb = item % nblk, k0 = 64 * kb, n0 = 32 * nb;
#pragma unroll 8
    for (int i = 0; i < 32; ++i) { const int kk = 2 * i + (lane >> 5); scr[kk * 33 + (lane & 31)] = W[(size_t)(k0 + kk) * N + n0 + (lane & 31)]; }
    asm volatile("s_waitcnt lgkmcnt(0)" ::: "memory");
    const int c = lane & 7; const int d0 = permute ? win_dest(n0) : n0;
#pragma unroll
    for (int j = 0; j < 4; ++j) { const int n = (lane >> 3) + 8 * j; const LAS float* s = scr + (8 * c) * 33 + n;
        u32x4 o; o.x = cvt_pk_bf16(s[0 * 33], s[1 * 33]); o.y = cvt_pk_bf16(s[2 * 33], s[3 * 33]); o.z = cvt_pk_bf16(s[4 * 33], s[5 * 33]); o.w = cvt_pk_bf16(s[6 * 33], s[7 * 33]);
        *(u32x4*)(WT + (size_t)(d0 + n) * K + k0 + 8 * c) = o; }
    asm volatile("s_waitcnt lgkmcnt(0)" ::: "memory");
}
DI void p0_prologue(const Ctx& F) {
    if (blockIdx.x < 48) {
        LAS float* red = (LAS float*)F.lds;
        const int n0 = 64 * blockIdx.x, k0 = 128 * F.wave;
        float a[5] = {0.f, 0.f, 0.f, 0.f, 0.f};
#pragma unroll 8
        for (int k = 0; k < 128; ++k) {
            const float w = F.ada_w[(size_t)(k0 + k) * 3072 + n0 + F.lane];
#pragma unroll
            for (int v = 0; v < 5; ++v) { const float cv = v < 4 ? F.c[v * 1024 + k0 + k] : F.c_ctx[k0 + k]; a[v] += siluf(cv) * w; }
        }
#pragma unroll
        for (int v = 0; v < 5; ++v) red[(F.wave * 5 + v) * 64 + F.lane] = a[v];
        __syncthreads();
        if (F.tid < 320) { const int v = F.tid >> 6, l = F.tid & 63; float s = F.ada_b[n0 + l];
#pragma unroll
            for (int w = 0; w < 8; ++w) s += red[(w * 5 + v) * 64 + l];
            F.MOD[v * 3072 + n0 + l] = s; }
        __syncthreads();
    }
    if (blockIdx.x == 48) {
        for (int e = F.tid; e < 1024; e += 512) { const int p = e >> 4, f = e & 15; const float inv = powf(10000.f, -(float)f / 16.f); const float ang = (float)p * inv;
            F.ROPE[e] = (f32x2){cosf(ang), sinf(ang)}; }
    }
    LAS float* scr = (LAS float*)(F.lds + F.wave * 16384);
    const int gw = blockIdx.x * 8 + F.wave, NGW = gridDim.x * 8;
    constexpr int I_IN = 16 * (NIN / 32), I_SQ = 16 * 32;
    for (int it = gw; it < I_IN + 3 * I_SQ; it += NGW) {
        int r = it;
        if (r < I_IN) { p0_transpose_item(F.w_in, 1024, NIN, F.WIN, true, scr, r, F.lane); continue; } r -= I_IN;
        if (r < I_SQ) { p0_transpose_item(F.w_a, 1024, 1024, F.WA, false, scr, r, F.lane); continue; } r -= I_SQ;
        if (r < I_SQ) { p0_transpose_item(F.w_b, 1024, 1024, F.WB, false, scr, r, F.lane); continue; } r -= I_SQ;
        p0_transpose_item(F.w_out, 1024, 1024, F.WOUT, false, scr, r, F.lane);
    }
}
DI void p1_rows(const Ctx& F) {
    const int gw = blockIdx.x * 8 + F.wave, NGW = gridDim.x * 8;
    for (int m = gw; m < MALL; m += NGW) {
        const float* xr; int mb;
        if (m < MTOK) { xr = F.x + (size_t)m * DM; mb = m >> 12; } else { xr = F.ctx + (size_t)(m - MTOK) * DM; mb = 4; }
        f32x4 v[4]; float ss = 0.f;
#pragma unroll
        for (int j = 0; j < 4; ++j) { v[j] = ((const f32x4*)xr)[F.lane + 64 * j]; ss += (v[j].x * v[j].x + v[j].y * v[j].y) + (v[j].z * v[j].z + v[j].w * v[j].w); }
        const float rstd = 1.0f / sqrtf(wave_sum(ss) * (1.f / DM) + EPS);
        const float* mod = F.MOD + mb * 3072;
#pragma unroll
        for (int j = 0; j < 4; ++j) { const int col = 4 * (F.lane + 64 * j);
            const f32x4 w = *(const f32x4*)(F.norm_w + col), sh = *(const f32x4*)(mod + col), sc = *(const f32x4*)(mod + 1024 + col);
            const f32x4 y = (v[j] * rstd * w) * (sc + 1.0f) + sh;
            u32x2 o; o.x = cvt_pk_bf16(y.x, y.y); o.y = cvt_pk_bf16(y.z, y.w);
            *(u32x2*)(F.XM + (size_t)m * DM + col) = o; }
    }
}
struct Sched1 {
    int G, c;
    DI bool next(int i, pg8::Unit& u) const {
        const int L = i * G + c;
        if (L < 64 * 36) { pg8::tile_of(L, 64, 36, u); return true; }
        const int e = L - 64 * 36; if (e >= 24) return false;
        u.pm = 64 + e / 6; u.pn = 18 + e % 6; return true;
    }
};
struct Epi1 {
    unsigned char* ws; bf16_t *R, *SGB; const f32x2* rope;
    DI void mid(f32x4 (&)[2][2][4][2], const pg8::Unit&, int, int, int, int) const {}
    DI void operator()(const f32x4 (&acc)[2][2][4][2], const pg8::Unit& u, int wr, int wc, int fr, int fq) const {
        const int pn = u.pn, row0 = u.pm * 256 + wr * 64 + fr, x0 = wc * 32 + 8 * fq;
        const bool isctx = u.pm >= 64;
        if (pn < 16) {
            bf16_t* dst = (bf16_t*)(ws + (wc < 2 ? WS_HC : WS_P)) + 64 * pn + (x0 & 63);
#pragma unroll
            for (int ai = 0; ai < 2; ++ai)
#pragma unroll
                for (int m = 0; m < 4; ++m) { const size_t row = row0 + ai * 128 + m * 16;
                    f32x4 o[2];
#pragma unroll
                    for (int n = 0; n < 2; ++n) { const f32x4 a = acc[ai][0][m][n], b = acc[ai][1][m][n];
                        if (wc < 2) o[n] = a * b;
                        else { o[n].x = a.x * siluf(b.x); o[n].y = a.y * siluf(b.y); o[n].z = a.z * siluf(b.z); o[n].w = a.w * siluf(b.w); } }
                    u32x4 w; w.x = cvt_pk_bf16(o[0].x, o[0].y); w.y = cvt_pk_bf16(o[0].z, o[0].w); w.z = cvt_pk_bf16(o[1].x, o[1].y); w.w = cvt_pk_bf16(o[1].z, o[1].w);
                    *(u32x4*)(dst + row * 1024) = w; }
        } else if (pn < 20) {
            const int t = (pn - 16) & 1, isk = (pn - 16) >> 1, head = 4 * t + wc, i0 = 8 * fq;
            const float scale = isk ? 0.125f : 1.0f;
            bf16_t* base = (bf16_t*)(ws + (isk ? (isctx ? WS_KC : WS_K) : WS_Q));
#pragma unroll
            for (int ai = 0; ai < 2; ++ai)
#pragma unroll
                for (int m = 0; m < 4; ++m) { const int row = row0 + ai * 128 + m * 16; const int orow = isctx ? row - MTOK : row;
                    const int pos = row & 4095, pidx = (fq < 2) ? (pos >> 6) : (pos & 63);
                    const f32x2* rp = rope + pidx * 16 + (fq & 1) * 8;
                    float o1[8], o2[8];
#pragma unroll
                    for (int e = 0; e < 8; ++e) { f32x2 cs = rp[e]; if (isctx) cs = (f32x2){1.f, 0.f};
                        const float t1 = acc[ai][0][m][e >> 2][e & 3], t2 = acc[ai][1][m][e >> 2][e & 3];
                        o1[e] = (t1 * cs.x - t2 * cs.y) * scale; o2[e] = (t1 * cs.y + t2 * cs.x) * scale; }
                    u32x4 w1, w2; w1.x = cvt_pk_bf16(o1[0], o1[1]); w1.y = cvt_pk_bf16(o1[2], o1[3]); w1.z = cvt_pk_bf16(o1[4], o1[5]); w1.w = cvt_pk_bf16(o1[6], o1[7]);
                    w2.x = cvt_pk_bf16(o2[0], o2[1]); w2.y = cvt_pk_bf16(o2[2], o2[3]); w2.z = cvt_pk_bf16(o2[4], o2[5]); w2.w = cvt_pk_bf16(o2[6], o2[7]);
                    bf16_t* d = base + (size_t)orow * 512 + head * 64 + i0;
                    *(u32x4*)d = w1; *(u32x4*)(d + 32) = w2; }
        } else if (pn < 28) {
            const bool isz = pn >= 24;
            bf16_t* base = (bf16_t*)(ws + (isz ? WS_SZB : (isctx ? WS_VC : WS_V)));
            const int colt = 256 * (pn - (isz ? 24 : 20)) + x0;
#pragma unroll
            for (int ai = 0; ai < 2; ++ai)
#pragma unroll
                for (int m = 0; m < 4; ++m) { const int row = row0 + ai * 128 + m * 16; const int orow = isctx ? row - MTOK : row;
#pragma unroll
                    for (int bj = 0; bj < 2; ++bj) { f32x4 a = acc[ai][bj][m][0], b = acc[ai][bj][m][1];
                        if (isz) { a.x = siluf(a.x); a.y = siluf(a.y); a.z = siluf(a.z); a.w = siluf(a.w); b.x = siluf(b.x); b.y = siluf(b.y); b.z = siluf(b.z); b.w = siluf(b.w); }
                        u32x4 w; w.x = cvt_pk_bf16(a.x, a.y); w.y = cvt_pk_bf16(a.z, a.w); w.z = cvt_pk_bf16(b.x, b.y); w.w = cvt_pk_bf16(b.z, b.w);
                        *(u32x4*)(base + (size_t)orow * 1024 + colt + bj * 128) = w; } }
        } else {
            const int col = 128 * (pn - 28) + x0;
#pragma unroll
            for (int ai = 0; ai < 2; ++ai)
#pragma unroll
                for (int m = 0; m < 4; ++m) { const size_t row = row0 + ai * 128 + m * 16;
                    float rr[8], sg[8];
#pragma unroll
                    for (int e = 0; e < 8; ++e) { const float ga = acc[ai][0][m][e >> 2][e & 3], gb = acc[ai][1][m][e >> 2][e & 3];
                        const float ea = __expf(-ga), eb = __expf(-gb); sg[e] = 1.f / (1.f + eb); rr[e] = (1.f + eb) / (1.f + ea); }
                    u32x4 w1, w2; w1.x = cvt_pk_bf16(rr[0], rr[1]); w1.y = cvt_pk_bf16(rr[2], rr[3]); w1.z = cvt_pk_bf16(rr[4], rr[5]); w1.w = cvt_pk_bf16(rr[6], rr[7]);
                    w2.x = cvt_pk_bf16(sg[0], sg[1]); w2.y = cvt_pk_bf16(sg[2], sg[3]); w2.z = cvt_pk_bf16(sg[4], sg[5]); w2.w = cvt_pk_bf16(sg[6], sg[7]);
                    *(u32x4*)(R + row * 1024 + col) = w1; *(u32x4*)(SGB + row * 1024 + col) = w2; }
        }
    }
};
DI void n2_inproj(const Ctx& F) {
    const size_t NT = (size_t)gridDim.x * 512, gt = (size_t)blockIdx.x * 512 + F.tid;
    for (size_t idx = gt; idx < (size_t)(MALL / 4) * 1024; idx += NT) {
        const int ch = (int)(idx & 1023), t0 = (int)(idx >> 10) * 4;
        const bool doqk = ch < 512 && (ch & 63) < 32;
        float a[12][4];
#pragma unroll
        for (int o = 0; o < 12; ++o)
#pragma unroll
            for (int j = 0; j < 4; ++j) a[o][j] = 0.f;
        for (int k = 0; k < 1024; ++k) {
            const float* wr = F.w_in + (size_t)k * NIN;
            float xv[4];
#pragma unroll
            for (int j = 0; j < 4; ++j) xv[j] = bf2f(F.XM[(size_t)(t0 + j) * 1024 + k]);
            float w[12];
            w[0] = wr[ch]; w[1] = wr[1024 + ch]; w[2] = wr[2048 + ch]; w[3] = wr[3072 + ch]; w[4] = wr[5120 + ch]; w[5] = wr[6144 + ch]; w[6] = wr[7168 + ch]; w[7] = wr[8192 + ch];
            if (doqk) { w[8] = wr[4096 + ch]; w[9] = wr[4096 + ch + 32]; w[10] = wr[4608 + ch]; w[11] = wr[4608 + ch + 32]; } else { w[8] = w[9] = w[10] = w[11] = 0.f; }
#pragma unroll
            for (int o = 0; o < 12; ++o)
#pragma unroll
                for (int j = 0; j < 4; ++j) a[o][j] += xv[j] * w[o];
        }
#pragma unroll
        for (int j = 0; j < 4; ++j) { const int t = t0 + j;
            if (t < MTOK) {
                const size_t o = (size_t)t * 1024 + ch;
                F.HC[o] = f2bf(a[2][j] * a[0][j]); F.P[o] = f2bf(siluf(a[3][j]) * a[1][j]); F.V[o] = f2bf(a[4][j]); F.SZB[o] = f2bf(siluf(a[5][j]));
                const float sga = 1.f / (1.f + __expf(-a[6][j])), sgb = 1.f / (1.f + __expf(-a[7][j]));
                F.R[o] = f2bf(sga / sgb); F.SGB[o] = f2bf(sgb);
                if (doqk) { const int i = ch & 63, pos = t & 4095; const int pidx = i < 16 ? (pos >> 6) : (pos & 63); const f32x2 cs = F.ROPE[pidx * 16 + (i & 15)];
                    const size_t q = (size_t)t * 512 + ch;
                    F.Q[q] = f2bf(a[8][j] * cs.x - a[9][j] * cs.y); F.Q[q + 32] = f2bf(a[8][j] * cs.y + a[9][j] * cs.x);
                    F.K[q] = f2bf((a[10][j] * cs.x - a[11][j] * cs.y) * 0.125f); F.K[q + 32] = f2bf((a[10][j] * cs.y + a[11][j] * cs.x) * 0.125f); }
            } else {
                const int tc = t - MTOK;
                F.VC[(size_t)tc * 1024 + ch] = f2bf(a[4][j]);
                if (doqk) { F.KC[(size_t)tc * 512 + ch] = f2bf(a[10][j] * 0.125f); F.KC[(size_t)tc * 512 + ch + 32] = f2bf(a[11][j] * 0.125f); }
            }
        }
    }
}
DI bf16x8 tr2(const LAS unsigned char* p, int delta) {
    const s16x4 lo = __builtin_bit_cast(s16x4, __builtin_amdgcn_ds_read_tr16_b64_v4i16((LAS v4i16_t*)p));
    const s16x4 hi = __builtin_bit_cast(s16x4, __builtin_amdgcn_ds_read_tr16_b64_v4i16((LAS v4i16_t*)(p + delta)));
    return __builtin_shufflevector(lo, hi, 0, 1, 2, 3, 4, 5, 6, 7);
}
DI u32x4 scale8(u32x4 w, float s) {
    u32x4 o; o.x = cvt_pk_bf16(bflo(w.x) * s, bfhi(w.x) * s); o.y = cvt_pk_bf16(bflo(w.y) * s, bfhi(w.y) * s); o.z = cvt_pk_bf16(bflo(w.z) * s, bfhi(w.z) * s); o.w = cvt_pk_bf16(bflo(w.w) * s, bfhi(w.w) * s); return o;
}
DI void p3_kv(const Ctx& F) {
    LAS unsigned char* KFI = F.lds; LAS unsigned char* KBI = F.lds + 20480; LAS unsigned char* VI = F.lds + 40960;
    const int tid = F.tid, lane = F.lane, w = F.wave, g = lane >> 4, q = (lane & 15) >> 2, p = lane & 3;
    for (int it = blockIdx.x; it < 1024 + 64; it += gridDim.x) {
        int bh; const bf16_t *kp, *vp; bf16_t *of, *ob;
        if (it < 1024) { bh = it >> 5; const int c = it & 31; const size_t tok0 = (size_t)(bh >> 3) * SEQ + c * CHK;
            kp = (const bf16_t*)(F.ws + WS_K) + tok0 * 512 + (bh & 7) * 64; vp = (const bf16_t*)(F.ws + WS_V) + tok0 * 1024 + (bh & 7) * 128;
            of = (bf16_t*)(F.ws + WS_KV) + ((size_t)(0 * 32 + bh) * 32 + c) * 8192; ob = (bf16_t*)(F.ws + WS_KV) + ((size_t)(1 * 32 + bh) * 32 + c) * 8192; }
        else { const int e = it - 1024; bh = e >> 1; const int cc = e & 1; const size_t tok0 = (size_t)(bh >> 3) * CTXL + cc * CHK;
            kp = (const bf16_t*)(F.ws + WS_KC) + tok0 * 512 + (bh & 7) * 64; vp = (const bf16_t*)(F.ws + WS_VC) + tok0 * 1024 + (bh & 7) * 128;
            of = (bf16_t*)(F.ws + WS_KVC) + ((size_t)(0 * 32 + bh) * 2 + cc) * 8192; ob = (bf16_t*)(F.ws + WS_KVC) + ((size_t)(1 * 32 + bh) * 2 + cc) * 8192; }
        const float l2f = log2_gamma(F.decay_logit, 0, bh & 7), l2b = log2_gamma(F.decay_logit, 1, bh & 7);
        { const int row = tid >> 2, seg = tid & 3;
            const u32x4 k0 = *(const u32x4*)(kp + (size_t)row * 512 + seg * 16), k1 = *(const u32x4*)(kp + (size_t)row * 512 + seg * 16 + 8);
            const float df = exp2f(l2f * (float)(127 - row)), db = exp2f(l2b * (float)row);
            *(LAS u32x4*)(KFI + row * 160 + seg * 32) = scale8(k0, df); *(LAS u32x4*)(KFI + row * 160 + seg * 32 + 16) = scale8(k1, df);
            *(LAS u32x4*)(KBI + row * 160 + seg * 32) = scale8(k0, db); *(LAS u32x4*)(KBI + row * 160 + seg * 32 + 16) = scale8(k1, db);
#pragma unroll
            for (int i = 0; i < 4; ++i) *(LAS u32x4*)(VI + row * 288 + seg * 64 + 16 * i) = *(const u32x4*)(vp + (size_t)row * 1024 + seg * 32 + 8 * i);
        }
        __syncthreads();
        f32x4 acc[2][4];
#pragma unroll
        for (int d = 0; d < 2; ++d)
#pragma unroll
            for (int nb = 0; nb < 4; ++nb) acc[d][nb] = (f32x4){0.f, 0.f, 0.f, 0.f};
#pragma unroll
        for (int s = 0; s < 4; ++s) {
            const bf16x8 a = tr2(VI + (32 * s + 8 * g + q) * 288 + (16 * w + 4 * p) * 2, 4 * 288);
#pragma unroll
            for (int nb = 0; nb < 4; ++nb) {
                const bf16x8 bfw = tr2(KFI + (32 * s + 8 * g + q) * 160 + (16 * nb + 4 * p) * 2, 4 * 160);
                const bf16x8 bbw = tr2(KBI + (32 * s + 8 * g + q) * 160 + (16 * nb + 4 * p) * 2, 4 * 160);
                acc[0][nb] = __builtin_amdgcn_mfma_f32_16x16x32_bf16(a, bfw, acc[0][nb], 0, 0, 0);
                acc[1][nb] = __builtin_amdgcn_mfma_f32_16x16x32_bf16(a, bbw, acc[1][nb], 0, 0, 0);
            }
        }
#pragma unroll
        for (int nb = 0; nb < 4; ++nb)
#pragma unroll
            for (int r = 0; r < 4; ++r) { const int o = (16 * w + 4 * g + r) * 64 + 16 * nb + (lane & 15);
                of[o] = f2bf(acc[0][nb][r]); ob[o] = f2bf(acc[1][nb][r]); }
        __syncthreads();
    }
}
DI void p3_ua(const Ctx& F) {
    const size_t NT = (size_t)gridDim.x * 512, gt = (size_t)blockIdx.x * 512 + F.tid;
    for (size_t idx = gt; idx < (size_t)MTOK * 128; idx += NT) {
        const int t = (int)(idx >> 7), c8 = (int)(idx & 127) * 8, pos = t & 4095;
        const bf16_t* hp = F.HC + (size_t)t * 1024 + c8;
        const u32x4 z = (u32x4){0u, 0u, 0u, 0u};
        const u32x4 h0 = pos > 0 ? *(const u32x4*)(hp - 1024) : z, h1 = *(const u32x4*)hp, h2 = pos < SEQ - 1 ? *(const u32x4*)(hp + 1024) : z;
        const u32x4 pv = *(const u32x4*)(F.P + (size_t)t * 1024 + c8);
        float o[8];
#pragma unroll
        for (int e = 0; e < 8; ++e) { const unsigned a = h0[e >> 1], b = h1[e >> 1], c = h2[e >> 1], pp = pv[e >> 1];
            const float x0 = (e & 1) ? bfhi(a) : bflo(a), x1 = (e & 1) ? bfhi(b) : bflo(b), x2 = (e & 1) ? bfhi(c) : bflo(c), pf = (e & 1) ? bfhi(pp) : bflo(pp);
            const float cv = F.conv_w[c8 + e] * x0 + F.conv_w[1024 + c8 + e] * x1 + F.conv_w[2048 + c8 + e] * x2 + F.conv_b[c8 + e];
            o[e] = pf * cv; }
        u32x4 w; w.x = cvt_pk_bf16(o[0], o[1]); w.y = cvt_pk_bf16(o[2], o[3]); w.z = cvt_pk_bf16(o[4], o[5]); w.w = cvt_pk_bf16(o[6], o[7]);
        *(u32x4*)(F.P + (size_t)t * 1024 + c8) = w;
    }
}
DI void p4_scan(const Ctx& F) {
    const size_t NT = (size_t)gridDim.x * 512, gt = (size_t)blockIdx.x * 512 + F.tid;
    for (size_t idx = gt; idx < (size_t)2 * 32 * 4096; idx += NT) {
        const int e2 = (int)(idx & 4095), bh = (int)(idx >> 12) & 31, dir = (int)(idx >> 17);
        const float g = exp2f(log2_gamma(F.decay_logit, dir, bh & 7) * 128.f);
        const unsigned* kvc = (const unsigned*)(F.KVC + ((size_t)(dir * 32 + bh) * 2) * 8192) + e2;
        const unsigned* kv = (const unsigned*)(F.KV + ((size_t)(dir * 32 + bh) * 32) * 8192) + e2;
        unsigned* st = (unsigned*)(F.ST + ((size_t)(dir * 32 + bh) * 32) * 8192) + e2;
        const unsigned c0 = kvc[0], c1 = kvc[4096];
        float s0, s1;
        if (dir == 0) { s0 = g * bflo(c0) + bflo(c1); s1 = g * bfhi(c0) + bfhi(c1); } else { s0 = bflo(c0) + g * bflo(c1); s1 = bfhi(c0) + g * bfhi(c1); }
#pragma unroll 8
        for (int i = 0; i < 32; ++i) { const int c = dir == 0 ? i : 31 - i;
            const unsigned v = kv[(size_t)c * 4096];
            st[(size_t)c * 4096] = cvt_pk_bf16(s0, s1);
            s0 = g * s0 + bflo(v); s1 = g * s1 + bfhi(v); }
    }
}
DI void n4_recurrence(const Ctx& F) {
    const int gw = blockIdx.x * 8 + F.wave, NGW = gridDim.x * 8, d = F.lane;
    for (int task = gw; task < 32 * 128; task += NGW) {
        const int bh = task >> 7, v = task & 127, b = bh >> 3, h = bh & 7;
        const float gf = exp2f(log2_gamma(F.decay_logit, 0, h)), gb = exp2f(log2_gamma(F.decay_logit, 1, h));
        float s = 0.f;
        for (int m = 0; m < CTXL; ++m) { const size_t t = (size_t)b * CTXL + m; s = gf * s + bf2f(F.KC[t * 512 + h * 64 + d]) * bf2f(F.VC[t * 1024 + h * 128 + v]); }
        const float sF = s; s = 0.f;
        for (int m = CTXL - 1; m >= 0; --m) { const size_t t = (size_t)b * CTXL + m; s = gb * s + bf2f(F.KC[t * 512 + h * 64 + d]) * bf2f(F.VC[t * 1024 + h * 128 + v]); }
        const float sB = s;
        s = sF;
        for (int n = 0; n < SEQ; ++n) { const size_t t = (size_t)b * SEQ + n; s = gf * s + bf2f(F.K[t * 512 + h * 64 + d]) * bf2f(F.V[t * 1024 + h * 128 + v]);
            const float o = wave_sum(bf2f(F.Q[t * 512 + h * 64 + d]) * s); if (d == 0) F.RET[t * 1024 + h * 128 + v] = o; }
        s = sB;
        for (int n = SEQ - 1; n >= 0; --n) { const size_t t = (size_t)b * SEQ + n; s = gb * s + bf2f(F.K[t * 512 + h * 64 + d]) * bf2f(F.V[t * 1024 + h * 128 + v]);
            const float o = wave_sum(bf2f(F.Q[t * 512 + h * 64 + d]) * s); if (d == 0) F.RET[t * 1024 + h * 128 + v] += o; }
    }
}
DI void n5_groupnorm(const Ctx& F) {
    const int gw = blockIdx.x * 8 + F.wave, NGW = gridDim.x * 8;
    for (int task = gw; task < MTOK * NH; task += NGW) {
        const int t = task >> 3, h = task & 7; const size_t o = (size_t)t * 1024 + h * 128 + 2 * F.lane;
        const float a = F.RET[o], b = F.RET[o + 1];
        const float mu = wave_sum(a + b) * (1.f / 128.f); const float da = a - mu, db = b - mu;
        const float var = wave_sum(da * da + db * db) * (1.f / 128.f); const float rstd = 1.0f / sqrtf(var + EPS);
        const float ra = da * rstd * F.gn_w[h * 128 + 2 * F.lane], rb = db * rstd * F.gn_w[h * 128 + 2 * F.lane + 1];
        *(unsigned*)(F.UB + o) = cvt_pk_bf16(bf2f(F.SZB[o]) * ra, bf2f(F.SZB[o + 1]) * rb);
    }
}
DI void p5_ret(const Ctx& F) {
    LAS unsigned char* KI = F.lds; LAS unsigned char* VI = F.lds + 20480; LAS unsigned char* SF = F.lds + 57344; LAS unsigned char* SB = F.lds + 75776;
    const int tid = F.tid, lane = F.lane, w = F.wave, g = lane >> 4, q = (lane & 15) >> 2, p = lane & 3, l15 = lane & 15;
    for (int it = blockIdx.x; it < 1024; it += gridDim.x) {
        const int bh = it >> 5, c = it & 31, h = bh & 7; const size_t tok0 = (size_t)(bh >> 3) * SEQ + c * CHK;
        const bf16_t* kp = F.K + tok0 * 512 + h * 64; const bf16_t* vp = F.V + tok0 * 1024 + h * 128; const bf16_t* qp = F.Q + tok0 * 512 + h * 64;
        const bf16_t* stf = F.ST + ((size_t)(0 * 32 + bh) * 32 + c) * 8192; const bf16_t* stb = F.ST + ((size_t)(1 * 32 + bh) * 32 + c) * 8192;
        const float l2f = log2_gamma(F.decay_logit, 0, h), l2b = log2_gamma(F.decay_logit, 1, h);
        { const int row = tid >> 2, seg = tid & 3;
#pragma unroll
            for (int i = 0; i < 2; ++i) *(LAS u32x4*)(KI + row * 160 + seg * 32 + 16 * i) = *(const u32x4*)(kp + (size_t)row * 512 + seg * 16 + 8 * i);
#pragma unroll
            for (int i = 0; i < 4; ++i) *(LAS u32x4*)(VI + row * 288 + seg * 64 + 16 * i) = *(const u32x4*)(vp + (size_t)row * 1024 + seg * 32 + 8 * i);
#pragma unroll
            for (int i = 0; i < 2; ++i) { *(LAS u32x4*)(SF + row * 144 + seg * 32 + 16 * i) = *(const u32x4*)(stf + row * 64 + seg * 16 + 8 * i);
                *(LAS u32x4*)(SB + row * 144 + seg * 32 + 16 * i) = *(const u32x4*)(stb + row * 64 + seg * 16 + 8 * i); }
        }
        const int il = 16 * w + l15;
        bf16x8 qf[2];
#pragma unroll
        for (int ks = 0; ks < 2; ++ks) qf[ks] = *(const bf16x8*)(qp + (size_t)il * 512 + 32 * ks + 8 * g);
        __syncthreads();
        f32x4 accS[8];
#pragma unroll
        for (int jb = 0; jb < 8; ++jb) { accS[jb] = (f32x4){0.f, 0.f, 0.f, 0.f};
#pragma unroll
            for (int ks = 0; ks < 2; ++ks) { const bf16x8 kf = *(const LAS bf16x8*)(KI + (16 * jb + l15) * 160 + (32 * ks + 8 * g) * 2);
                accS[jb] = __builtin_amdgcn_mfma_f32_16x16x32_bf16(kf, qf[ks], accS[jb], 0, 0, 0); } }
        bf16x8 pf[4];
#pragma unroll
        for (int s = 0; s < 4; ++s) { float pv[8];
#pragma unroll
            for (int e = 0; e < 8; ++e) { const int jb = 2 * s + (e >> 2), r = e & 3, j = 16 * jb + 4 * g + r, df = il - j;
                float mk = 0.f; if (df >= 0) mk += exp2f(l2f * (float)df); if (df <= 0) mk += exp2f(l2b * (float)(-df));
                pv[e] = accS[jb][r] * mk; }
            u32x4 pw; pw.x = cvt_pk_bf16(pv[0], pv[1]); pw.y = cvt_pk_bf16(pv[2], pv[3]); pw.z = cvt_pk_bf16(pv[4], pv[5]); pw.w = cvt_pk_bf16(pv[6], pv[7]);
            pf[s] = __builtin_bit_cast(bf16x8, pw); }
        const float decf = exp2f(l2f * (float)(il + 1)), decb = exp2f(l2b * (float)(128 - il));
        f32x4 accO[8];
#pragma unroll
        for (int vb = 0; vb < 8; ++vb) { f32x4 o = (f32x4){0.f, 0.f, 0.f, 0.f};
#pragma unroll
            for (int s = 0; s < 4; ++s) { const bf16x8 vf = tr2(VI + (32 * s + 4 * g + q) * 288 + (16 * vb + 4 * p) * 2, 16 * 288);
                o = __builtin_amdgcn_mfma_f32_16x16x32_bf16(vf, pf[s], o, 0, 0, 0); }
            f32x4 tf = (f32x4){0.f, 0.f, 0.f, 0.f}, tb = (f32x4){0.f, 0.f, 0.f, 0.f};
#pragma unroll
            for (int ks = 0; ks < 2; ++ks) { const bf16x8 sf = *(const LAS bf16x8*)(SF + (16 * vb + l15) * 144 + (32 * ks + 8 * g) * 2);
                const bf16x8 sb = *(const LAS bf16x8*)(SB + (16 * vb + l15) * 144 + (32 * ks + 8 * g) * 2);
                tf = __builtin_amdgcn_mfma_f32_16x16x32_bf16(sf, qf[ks], tf, 0, 0, 0); tb = __builtin_amdgcn_mfma_f32_16x16x32_bf16(sb, qf[ks], tb, 0, 0, 0); }
            accO[vb] = o + tf * decf + tb * decb; }
        float sm = 0.f;
#pragma unroll
        for (int vb = 0; vb < 8; ++vb) sm += (accO[vb].x + accO[vb].y) + (accO[vb].z + accO[vb].w);
        sm += __shfl_xor(sm, 16); sm += __shfl_xor(sm, 32);
        const float mu = sm * (1.f / 128.f); float sq = 0.f;
#pragma unroll
        for (int vb = 0; vb < 8; ++vb) { accO[vb] = accO[vb] - mu; sq += (accO[vb].x * accO[vb].x + accO[vb].y * accO[vb].y) + (accO[vb].z * accO[vb].z + accO[vb].w * accO[vb].w); }
        sq += __shfl_xor(sq, 16); sq += __shfl_xor(sq, 32);
        const float rstd = 1.0f / sqrtf(sq * (1.f / 128.f) + EPS);
        __syncthreads();
#pragma unroll
        for (int vb = 0; vb < 8; ++vb) { const f32x4 gw = *(const f32x4*)(F.gn_w + h * 128 + 16 * vb + 4 * g); const f32x4 o = accO[vb] * rstd * gw;
            u32x2 ow; ow.x = cvt_pk_bf16(o.x, o.y); ow.y = cvt_pk_bf16(o.z, o.w);
            *(LAS u32x2*)(VI + il * 288 + (16 * vb + 4 * g) * 2) = ow; }
        __syncthreads();
        { const int row = tid >> 2, seg = tid & 3; const size_t go = (tok0 + row) * 1024 + h * 128 + seg * 32;
#pragma unroll
            for (int i = 0; i < 4; ++i) { const u32x4 o = *(const LAS u32x4*)(VI + row * 288 + seg * 64 + 16 * i); const u32x4 z = *(const u32x4*)(F.SZB + go + 8 * i);
                u32x4 r; r.x = cvt_pk_bf16(bflo(o.x) * bflo(z.x), bfhi(o.x) * bfhi(z.x)); r.y = cvt_pk_bf16(bflo(o.y) * bflo(z.y), bfhi(o.y) * bfhi(z.y));
                r.z = cvt_pk_bf16(bflo(o.z) * bflo(z.z), bfhi(o.z) * bfhi(z.z)); r.w = cvt_pk_bf16(bflo(o.w) * bflo(z.w), bfhi(o.w) * bfhi(z.w));
                *(u32x4*)(F.UB + go + 8 * i) = r; } }
        __syncthreads();
    }
}
struct SchedSq { int G, c; DI bool next(int i, pg8::Unit& u) const { const int L = i * G + c; if (L >= 256) return false; pg8::tile_of(L, 64, 4, u); return true; } };
struct EpiAB {
    const bf16_t* R; const bf16_t* SGB; bf16_t* MM;
    DI void mid(f32x4 (&acc)[2][2][4][2], const pg8::Unit& u, int wr, int wc, int fr, int fq) const { apply<false>(acc, u, wr, wc, fr, fq); }
    DI void operator()(const f32x4 (&acc)[2][2][4][2], const pg8::Unit& u, int wr, int wc, int fr, int fq) const { apply<true>(const_cast<f32x4 (&)[2][2][4][2]>(acc), u, wr, wc, fr, fq); }
    template <bool FIN> DI void apply(f32x4 (&acc)[2][2][4][2], const pg8::Unit& u, int wr, int wc, int fr, int fq) const {
        const bf16_t* src = FIN ? SGB : R;
        const size_t base = (size_t)(u.pm * 256 + wr * 64 + fr) * 1024 + u.pn * 256 + wc * 32 + 8 * fq;
#pragma unroll
        for (int ai = 0; ai < 2; ++ai) {
            u32x4 gv[4][2];
#pragma unroll
            for (int m = 0; m < 4; ++m)
#pragma unroll
                for (int bj = 0; bj < 2; ++bj) gv[m][bj] = *(const u32x4*)(src + base + (size_t)(ai * 128 + m * 16) * 1024 + bj * 128);
#pragma unroll
            for (int m = 0; m < 4; ++m)
#pragma unroll
                for (int bj = 0; bj < 2; ++bj) { const u32x4 gq = gv[m][bj];
                    f32x4 a = acc[ai][bj][m][0], b = acc[ai][bj][m][1];
                    a.x *= bflo(gq.x); a.y *= bfhi(gq.x); a.z *= bflo(gq.y); a.w *= bfhi(gq.y); b.x *= bflo(gq.z); b.y *= bfhi(gq.z); b.z *= bflo(gq.w); b.w *= bfhi(gq.w);
                    if (FIN) { u32x4 w; w.x = cvt_pk_bf16(a.x, a.y); w.y = cvt_pk_bf16(a.z, a.w); w.z = cvt_pk_bf16(b.x, b.y); w.w = cvt_pk_bf16(b.z, b.w);
                        *(u32x4*)(MM + base + (size_t)(ai * 128 + m * 16) * 1024 + bj * 128) = w; }
                    else { acc[ai][bj][m][0] = a; acc[ai][bj][m][1] = b; } }
            asm volatile("" ::: "memory");
        }
    }
};
struct EpiOut {
    const float* x; const float* MOD; float* out;
    DI void mid(f32x4 (&)[2][2][4][2], const pg8::Unit&, int, int, int, int) const {}
    DI void operator()(const f32x4 (&acc)[2][2][4][2], const pg8::Unit& u, int wr, int wc, int fr, int fq) const {
        const int col0 = u.pn * 256 + wc * 32 + 8 * fq; const float* gp = MOD + (u.pm >> 4) * 3072 + 2048 + col0;
        f32x4 gx[2][2];
#pragma unroll
        for (int bj = 0; bj < 2; ++bj)
#pragma unroll
            for (int n = 0; n < 2; ++n) gx[bj][n] = *(const f32x4*)(gp + bj * 128 + 4 * n);
#pragma unroll
        for (int ai = 0; ai < 2; ++ai)
#pragma unroll
            for (int m = 0; m < 4; ++m) { const size_t off = (size_t)(u.pm * 256 + ai * 128 + wr * 64 + m * 16 + fr) * 1024 + col0;
#pragma unroll
                for (int bj = 0; bj < 2; ++bj)
#pragma unroll
                    for (int n = 0; n < 2; ++n) { const f32x4 xv = *(const f32x4*)(x + off + bj * 128 + 4 * n); *(f32x4*)(out + off + bj * 128 + 4 * n) = xv + gx[bj][n] * acc[ai][bj][m][n]; }
                if (m & 1) asm volatile("" ::: "memory"); }
    }
};
DI void n6_ab(const Ctx& F) {
    const size_t NT = (size_t)gridDim.x * 512, gt = (size_t)blockIdx.x * 512 + F.tid;
    for (size_t idx = gt; idx < (size_t)(MTOK / 4) * 1024; idx += NT) {
        const int n = (int)(idx & 1023), t0 = (int)(idx >> 10) * 4; float ya[4] = {0.f, 0.f, 0.f, 0.f}, yb[4] = {0.f, 0.f, 0.f, 0.f};
        for (int k = 0; k < 1024; ++k) { const float wa = F.w_a[(size_t)k * 1024 + n], wb = F.w_b[(size_t)k * 1024 + n];
#pragma unroll
            for (int j = 0; j < 4; ++j) { ya[j] += bf2f(F.P[(size_t)(t0 + j) * 1024 + k]) * wa; yb[j] += bf2f(F.UB[(size_t)(t0 + j) * 1024 + k]) * wb; } }
#pragma unroll
        for (int j = 0; j < 4; ++j) { const size_t o = (size_t)(t0 + j) * 1024 + n; const float sgb = bf2f(F.SGB[o]), sga = bf2f(F.R[o]) * sgb; F.MM[o] = f2bf(sga * ya[j] + sgb * yb[j]); }
    }
}
DI void n7_out(const Ctx& F) {
    const size_t NT = (size_t)gridDim.x * 512, gt = (size_t)blockIdx.x * 512 + F.tid;
    for (size_t idx = gt; idx < (size_t)(MTOK / 4) * 1024; idx += NT) {
        const int n = (int)(idx & 1023), t0 = (int)(idx >> 10) * 4; float y[4] = {0.f, 0.f, 0.f, 0.f};
        for (int k = 0; k < 1024; ++k) { const float w = F.w_out[(size_t)k * 1024 + n];
#pragma unroll
            for (int j = 0; j < 4; ++j) y[j] += bf2f(F.MM[(size_t)(t0 + j) * 1024 + k]) * w; }
#pragma unroll
        for (int j = 0; j < 4; ++j) { const size_t o = (size_t)(t0 + j) * 1024 + n; F.out[o] = F.x[o] + F.MOD[((t0 + j) >> 12) * 3072 + 2048 + n] * y[j]; }
    }
}
DI void p8_final(const Ctx& F) {
    const int gw = blockIdx.x * 8 + F.wave, NGW = gridDim.x * 8;
    for (int m = gw; m < MTOK; m += NGW) {
        f32x4* xr = (f32x4*)(F.out + (size_t)m * DM);
        f32x4 v[4]; float ss = 0.f;
#pragma unroll
        for (int j = 0; j < 4; ++j) { v[j] = xr[F.lane + 64 * j]; ss += (v[j].x * v[j].x + v[j].y * v[j].y) + (v[j].z * v[j].z + v[j].w * v[j].w); }
        const float rstd = 1.0f / sqrtf(wave_sum(ss) * (1.f / DM) + EPS);
#pragma unroll
        for (int j = 0; j < 4; ++j) { const f32x4 w = *(const f32x4*)(F.final_w + 4 * (F.lane + 64 * j)); xr[F.lane + 64 * j] = v[j] * rstd * w; }
    }
}

constexpr int NPH = 9;
__global__ void __launch_bounds__(512, 2) fwd_kernel(Args args) {
    extern __shared__ __attribute__((aligned(16))) unsigned char lds_raw[];
    cg::grid_group grid = cg::this_grid();
    Ctx F;
    F.lds = (LAS unsigned char*)lds_raw; F.tid = threadIdx.x; F.lane = F.tid & 63; F.wave = __builtin_amdgcn_readfirstlane(F.tid >> 6);
    F.x = args.in[0]; F.c = args.in[1]; F.ctx = args.in[2]; F.c_ctx = args.in[3]; F.norm_w = args.in[4]; F.ada_w = args.in[5]; F.ada_b = args.in[6]; F.w_in = args.in[7];
    F.conv_w = args.in[8]; F.conv_b = args.in[9]; F.decay_logit = args.in[10]; F.gn_w = args.in[11]; F.w_a = args.in[12]; F.w_b = args.in[13]; F.w_out = args.in[14]; F.final_w = args.in[15];
    F.out = args.out; unsigned char* ws = args.ws; F.ws = ws;
    F.MOD = (float*)(ws + WS_MOD); F.ROPE = (f32x2*)(ws + WS_ROPE);
    F.WA = (bf16_t*)(ws + WS_WA); F.WB = (bf16_t*)(ws + WS_WB); F.WOUT = (bf16_t*)(ws + WS_WOUT); F.WIN = (bf16_t*)(ws + WS_WIN); F.XM = (bf16_t*)(ws + WS_XM);
    F.KV = (bf16_t*)(ws + WS_KV); F.KVC = (bf16_t*)(ws + WS_KVC); F.HC = (bf16_t*)(ws + WS_HC); F.ST = (bf16_t*)(ws + WS_ST); F.MM = (bf16_t*)(ws + WS_MM);
    F.P = (bf16_t*)(ws + WS_P); F.Q = (bf16_t*)(ws + WS_Q); F.K = (bf16_t*)(ws + WS_K); F.V = (bf16_t*)(ws + WS_V); F.SZB = (bf16_t*)(ws + WS_SZB);
    F.KC = (bf16_t*)(ws + WS_KC); F.VC = (bf16_t*)(ws + WS_VC); F.UB = (bf16_t*)(ws + WS_UB);
    F.R = (bf16_t*)args.out; F.SGB = (bf16_t*)args.out + (size_t)MTOK * DM;
    F.RET = (float*)(ws + WS_RET);
    const int lo = args.ph_lo, hi = args.ph_hi; const unsigned naive = args.naive;
#define IN(k) (lo <= (k) && (k) < hi && ((MK_PHASES >> (k)) & 1))
#define NAIVE(k) (((naive & MK_NAIVE_AVAIL) >> (k)) & 1u)
#define SEAM(k) do { if (IN(k) && IN((k) + 1)) grid.sync(); } while (0)
    if (IN(0)) { p0_prologue(F); } SEAM(0);
    if (IN(1)) { p1_rows(F); } SEAM(1);
    if (IN(2)) {
        if (NAIVE(2)) n2_inproj(F);
        else { const char* const Ab[2] = {(const char*)F.XM, (const char*)F.XM}; const char* const Bb[2] = {(const char*)F.WIN, (const char*)F.WIN};
            Sched1 S{(int)gridDim.x, (int)blockIdx.x}; Epi1 E{F.ws, F.R, F.SGB, F.ROPE};
            pg8::gemm_phase<1, Epi1, Sched1>(F.lds, Ab, Bb, S, E); }
    } SEAM(2);
    if (IN(3)) { if (!NAIVE(3)) p3_kv(F); p3_ua(F); } SEAM(3);
    if (IN(4)) { if (NAIVE(4)) n4_recurrence(F); else p4_scan(F); } SEAM(4);
    if (IN(5)) { if (NAIVE(5)) n5_groupnorm(F); else p5_ret(F); } SEAM(5);
    if (IN(6)) {
        if (NAIVE(6)) n6_ab(F);
        else { const char* const Ab[2] = {(const char*)F.P, (const char*)F.UB}; const char* const Bb[2] = {(const char*)F.WA, (const char*)F.WB};
            SchedSq S{(int)gridDim.x, (int)blockIdx.x}; EpiAB E{F.R, F.SGB, F.MM};
            pg8::gemm_phase<2, EpiAB, SchedSq>(F.lds, Ab, Bb, S, E); }
    } SEAM(6);
    if (IN(7)) {
        if (NAIVE(7)) n7_out(F);
        else { const char* const Ab[2] = {(const char*)F.MM, (const char*)F.MM}; const char* const Bb[2] = {(const char*)F.WOUT, (const char*)F.WOUT};
            SchedSq S{(int)gridDim.x, (int)blockIdx.x}; EpiOut E{F.x, F.MOD, F.out};
            pg8::gemm_phase<1, EpiOut, SchedSq>(F.lds, Ab, Bb, S, E); }
    } SEAM(7);
    if (IN(8)) { p8_final(F); }
#undef IN
#undef NAIVE
#undef SEAM
}

extern "C" void kernel_launch(void* const* d_in, const int* in_sizes, int n_in, void* d_out, int out_size, void* d_ws, size_t ws_size, hipStream_t stream) {
    static int grid = 0;
    if (grid == 0) {
        if (n_in != 16 || out_size != MTOK * DM || ws_size < WS_END) { fprintf(stderr, "kernel_launch: unexpected shapes (n_in %d out %d ws %zu)\n", n_in, out_size, ws_size); grid = -1; return; }
        int dev = 0, cus = 0, per_cu = 0;
        hipGetDevice(&dev); hipDeviceGetAttribute(&cus, hipDeviceAttributeMultiprocessorCount, dev);
        hipFuncSetAttribute((const void*)fwd_kernel, hipFuncAttributeMaxDynamicSharedMemorySize, LDS_BYTES);
        hipOccupancyMaxActiveBlocksPerMultiprocessor(&per_cu, (const void*)fwd_kernel, 512, LDS_BYTES);
        if (per_cu < 1) { fprintf(stderr, "kernel_launch: occupancy query says %d blocks/CU\n", per_cu); per_cu = 1; }
        grid = cus;
        (void)hipGetLastError();
    }
    if (grid < 0) return;
    Args a{};
    for (int i = 0; i < 16; ++i) a.in[i] = (const float*)d_in[i];
    a.out = (float*)d_out; a.ws = (unsigned char*)d_ws; a.naive = MK_NAIVE_MASK;
#if MK_LAUNCH_PER_PHASE
    for (int ph = 0; ph < NPH; ++ph) { a.ph_lo = ph; a.ph_hi = ph + 1; hipLaunchKernelGGL(fwd_kernel, dim3(grid), dim3(512), LDS_BYTES, stream, a); }
#else
    a.ph_lo = 0; a.ph_hi = NPH;
    void* kargs[] = {&a};
    hipError_t e = hipLaunchCooperativeKernel((void*)fwd_kernel, dim3(grid), dim3(512), kargs, LDS_BYTES, stream);
    if (e != hipSuccess) fprintf(stderr, "kernel_launch: cooperative launch failed: %s (grid %d)\n", hipGetErrorString(e), grid);
#endif
}
```

```cpp
#include <hip/hip_runtime.h>
#include <hip/hip_cooperative_groups.h>
#include <cstdio>
#include <cstdint>
namespace cg = cooperative_groups;

#ifndef MK_LAUNCH_PER_PHASE
#define MK_LAUNCH_PER_PHASE 0
#endif
#ifndef MK_NAIVE_MASK
#define MK_NAIVE_MASK 0x00u
#endif

#ifndef MK_PHASES
#define MK_PHASES 0x1ff
#endif
#ifndef MK_NAIVE_AVAIL
#define MK_NAIVE_AVAIL 0xffu
#endif
#define DI __device__ __forceinline__
#define LAS __attribute__((address_space(3)))
typedef unsigned short bf16_t;
typedef float f32x4 __attribute__((ext_vector_type(4)));
typedef float f32x2 __attribute__((ext_vector_type(2)));
typedef unsigned u32x4 __attribute__((ext_vector_type(4)));
typedef unsigned u32x2 __attribute__((ext_vector_type(2)));
typedef short bf16x8 __attribute__((ext_vector_type(8)));
typedef short s16x4 __attribute__((ext_vector_type(4)));
typedef short v4i16_t __attribute__((ext_vector_type(4)));

constexpr int NB = 4, SEQ = 4096, DM = 1024, MTOK = NB * SEQ, CTXL = 256, MCTX = NB * CTXL, MALL = MTOK + MCTX;
constexpr int NIN = 9216, NH = 8, DK = 64, DV = 128, CHK = 128, NCHK = SEQ / CHK;
constexpr float EPS = 1e-6f;
constexpr size_t MiB = 1u << 20;
constexpr size_t WS_MOD = 0;
constexpr size_t WS_ROPE = 65536;
constexpr size_t WS_WA = 2 * MiB, WS_WB = 4 * MiB, WS_WOUT = 6 * MiB, WS_WIN = 8 * MiB;
constexpr size_t WS_XM = 26 * MiB;
constexpr size_t WS_KV = 8 * MiB;
constexpr size_t WS_KVC = 40 * MiB;
constexpr size_t WS_RET = 8 * MiB;
constexpr size_t WS_HC = 60 * MiB;
constexpr size_t WS_ST = 60 * MiB;
constexpr size_t WS_MM = 60 * MiB;
constexpr size_t WS_P = 92 * MiB;
constexpr size_t WS_Q = 124 * MiB, WS_K = 140 * MiB, WS_V = 156 * MiB, WS_SZB = 188 * MiB;
constexpr size_t WS_KC = 220 * MiB, WS_VC = 221 * MiB;
constexpr size_t WS_UB = 223 * MiB;
constexpr size_t WS_END = 255 * MiB;
constexpr int LDS_BYTES = 147456;

DI float bf2f(bf16_t v) { return __uint_as_float((unsigned)v << 16); }
DI float bflo(unsigned w) { return __uint_as_float(w << 16); }
DI float bfhi(unsigned w) { return __uint_as_float(w & 0xffff0000u); }
typedef __bf16 bf16x2_t __attribute__((ext_vector_type(2)));
DI unsigned cvt_pk_bf16(float lo, float hi) { const f32x2 f = {lo, hi}; const bf16x2_t v = __builtin_convertvector(f, bf16x2_t); return __builtin_bit_cast(unsigned, v); }
DI bf16_t f2bf(float f) { return (bf16_t)(cvt_pk_bf16(f, 0.f) & 0xffffu); }
DI float wave_sum(float v) {
#pragma unroll
    for (int o = 1; o < 64; o <<= 1) v += __shfl_xor(v, o);
    return v;
}
struct Tid { int tid, lane, wave; };
DI Tid opaque_tid() { int t = threadIdx.x; asm volatile("" : "+v"(t)); Tid r; r.tid = t; r.lane = t & 63; r.wave = __builtin_amdgcn_readfirstlane(t >> 6); return r; }
DI float siluf(float x) { return x * __builtin_amdgcn_rcpf(1.f + __expf(-x)); }
DI float log2_gamma(const float* decay_logit, int dir, int h) {
    const float x = decay_logit[dir * NH + h];
    const float ls = fminf(x, 0.f) - log1pf(expf(-fabsf(x)));
    return ls * 1.4426950408889634f;
}

namespace pg8 {
constexpr int BM = 256, BK = 64, HALF = 128, HTB = HALF * BK * 2, STAGE_BYTES = 8 * HTB, NXCD = 8, WGM = 8;
DI int lds_byte(int r, int c) { const int st = (r >> 4) * 2 + (c >> 5), rr = r & 15, cc = c & 31, ob = rr * 64 + cc * 2; return st * 1024 + (ob ^ (((ob >> 9) & 1) << 5)); }
DI void stage_rc(int b, int& R, int& C) { const int st = b / 1024, sb = b % 1024, swz = sb ^ (((sb >> 9) & 1) << 5); R = (st >> 1) * 16 + swz / 64; C = (st & 1) * 32 + (swz % 64) / 2; }
DI int perm32(int rho) { const int n = rho >> 4, i = rho & 15; return 8 * (i >> 2) + 4 * n + (i & 3); }
struct Unit { int pm, pn; };
DI void tile_of(int L, int nM, int nN, Unit& u) {
    const int nwg = nM * nN; int wgid = L;
    { const int q = nwg / NXCD, r = nwg % NXCD, xcd = wgid % NXCD, off = wgid / NXCD; wgid = (xcd < r ? xcd * (q + 1) : r * (q + 1) + (xcd - r) * q) + off; }
    const int nig = WGM * nN, gid = wgid / nig, fm = gid * WGM, gsz = (nM - fm) < WGM ? (nM - fm) : WGM;
    u.pm = fm + ((wgid % nig) % gsz); u.pn = (wgid % nig) / gsz;
}
template <int NSEG, class Epi, class Sched>
DI void gemm_phase(LAS unsigned char* lds, const char* const (&Ab)[2], const char* const (&Bb)[2], const Sched& S, const Epi& E) {
    constexpr int K = 1024, NTS = K / BK;
    constexpr int nt = NSEG * NTS;
    const Tid T = opaque_tid();
    const int tid = T.tid, wid = T.wave, lane = T.lane, wr = wid >> 2, wc = wid & 3, fr = lane & 15, fq = lane >> 4;
    unsigned voffA[2], voffB[2];
#pragma unroll
    for (int i = 0; i < 2; ++i) { int R, C; stage_rc(tid * 16 + i * 8192, R, C); const int Rb = (R & ~31) + perm32(R & 31);
        voffA[i] = (unsigned)(R * K + C) * 2u; voffB[i] = (unsigned)(Rb * K + C) * 2u; }
    constexpr size_t kstep = (size_t)(BK * 2);
    constexpr size_t hstep = (size_t)HALF * K * 2;
    constexpr size_t tstep = 2 * hstep;
    const unsigned ldsw = (unsigned)wid * 1024u;
    const int aoff = lds_byte(wr * 64 + fr, fq * 8), boff = lds_byte(wc * 32 + fr, fq * 8);
#define PG8_SA(b, h) (((b) * 2 + (h)) * HTB)
#define PG8_SB(b, h) ((4 + (b) * 2 + (h)) * HTB)
#define PG8_STAGE(bufoff, gbase, voff) do { _Pragma("unroll") for (int _i = 0; _i < 2; ++_i) \
        __builtin_amdgcn_global_load_lds((const unsigned*)((const char*)(gbase) + (voff)[_i]), (LAS unsigned*)(lds + (bufoff) + ldsw + _i * 8192), 16, 0, 0); } while (0)
#define PG8_LDA(dst, b, h) do { _Pragma("unroll") for (int m = 0; m < 4; ++m) _Pragma("unroll") for (int k = 0; k < 2; ++k) dst[m][k] = *(const LAS bf16x8*)(lds + PG8_SA(b, h) + aoff + m * 2048 + k * 1024); } while (0)
#define PG8_LDB(dst, b, h) do { _Pragma("unroll") for (int n = 0; n < 2; ++n) _Pragma("unroll") for (int k = 0; k < 2; ++k) dst[n][k] = *(const LAS bf16x8*)(lds + PG8_SB(b, h) + boff + n * 2048 + k * 1024); } while (0)
#define PG8_MMA(ai, bj, At, Bt) do { __builtin_amdgcn_s_setprio(1); _Pragma("unroll") for (int m = 0; m < 4; ++m) _Pragma("unroll") for (int n = 0; n < 2; ++n) _Pragma("unroll") for (int k = 0; k < 2; ++k) \
        acc[ai][bj][m][n] = __builtin_amdgcn_mfma_f32_16x16x32_bf16(Bt[n][k], At[m][k], acc[ai][bj][m][n], 0, 0, 0); __builtin_amdgcn_s_setprio(0); } while (0)
#define PG8_WAIT_V(n) asm volatile("s_waitcnt vmcnt(" #n ")" ::: "memory")
#define PG8_WAIT_L(n) asm volatile("s_waitcnt lgkmcnt(" #n ")" ::: "memory")
#define PG8_BAR __builtin_amdgcn_s_barrier()
#define PG8_SCHED __builtin_amdgcn_sched_barrier(0)
#define PG8_TA(u, t) (Ab[(t) / NTS] + (size_t)(u).pm * tstep + (size_t)((t) % NTS) * kstep)
#define PG8_TB(u, t) (Bb[(t) / NTS] + (size_t)(u).pn * tstep + (size_t)((t) % NTS) * kstep)
    Unit cur, nxt; int ui = 0;
    if (!S.next(0, cur)) return;
    f32x4 acc[2][2][4][2];
#pragma unroll
    for (int a = 0; a < 2; ++a)
#pragma unroll
        for (int b = 0; b < 2; ++b)
#pragma unroll
            for (int m = 0; m < 4; ++m)
#pragma unroll
                for (int n = 0; n < 2; ++n) acc[a][b][m][n] = (f32x4){0.f, 0.f, 0.f, 0.f};
    bf16x8 At[4][2], B0[2][2], B1[2][2];
    {
        const char* cA = PG8_TA(cur, 0); const char* cB = PG8_TB(cur, 0);
        PG8_STAGE(PG8_SB(0, 0), cB, voffB); PG8_STAGE(PG8_SB(0, 1), cB + hstep, voffB); PG8_STAGE(PG8_SA(0, 0), cA, voffA); PG8_STAGE(PG8_SA(0, 1), cA + hstep, voffA);
        if (wr == 1) PG8_BAR;
        PG8_WAIT_V(2); PG8_BAR;
        PG8_STAGE(PG8_SB(1, 0), cB + kstep, voffB); PG8_STAGE(PG8_SA(1, 0), cA + kstep, voffA); PG8_STAGE(PG8_SB(1, 1), cB + hstep + kstep, voffB);
        PG8_WAIT_V(6); PG8_BAR;
    }
    for (;;) {
        const bool has_next = S.next(ui + 1, nxt);
        const Unit nu = has_next ? nxt : cur;
        for (int t = 0; t < nt; t += 2) {
            if (NSEG == 2 && t == NTS) E.mid(acc, cur, wr, wc, fr, fq);
            const bool last = (t == nt - 2);
            const char* a1 = PG8_TA(cur, t + 1);
            const char* a2 = last ? PG8_TA(nu, 0) : PG8_TA(cur, t + 2); const char* b2 = last ? PG8_TB(nu, 0) : PG8_TB(cur, t + 2);
            const char* a3 = a2 + kstep; const char* b3 = b2 + kstep;
            PG8_LDB(B0, 0, 0); PG8_LDB(B1, 0, 1); PG8_SCHED; PG8_LDA(At, 0, 0); PG8_STAGE(PG8_SA(1, 1), a1 + hstep, voffA);
            PG8_WAIT_V(8); PG8_WAIT_L(0); PG8_BAR; PG8_MMA(0, 0, At, B0); PG8_MMA(0, 1, At, B1); PG8_BAR; PG8_SCHED;
            PG8_LDA(At, 0, 1); PG8_STAGE(PG8_SB(0, 0), b2, voffB); PG8_STAGE(PG8_SB(0, 1), b2 + hstep, voffB); PG8_STAGE(PG8_SA(0, 0), a2, voffA);
            PG8_WAIT_V(8); PG8_WAIT_L(0); PG8_BAR; PG8_MMA(1, 0, At, B0); PG8_MMA(1, 1, At, B1); PG8_BAR; PG8_SCHED;
            PG8_LDB(B0, 1, 0); PG8_LDB(B1, 1, 1); PG8_SCHED; PG8_LDA(At, 1, 0); PG8_STAGE(PG8_SA(0, 1), a2 + hstep, voffA);
            PG8_WAIT_V(8); PG8_WAIT_L(0); PG8_BAR; PG8_MMA(0, 0, At, B0); PG8_MMA(0, 1, At, B1); PG8_BAR; PG8_SCHED;
            PG8_LDA(At, 1, 1); PG8_STAGE(PG8_SB(1, 0), b3, voffB); PG8_STAGE(PG8_SB(1, 1), b3 + hstep, voffB); PG8_STAGE(PG8_SA(1, 0), a3, voffA);
            PG8_WAIT_V(8); PG8_WAIT_L(0); PG8_BAR; PG8_MMA(1, 0, At, B0); PG8_MMA(1, 1, At, B1); PG8_BAR; PG8_SCHED;
        }
        if (wr == 0) PG8_BAR;
        E(acc, cur, wr, wc, fr, fq);
        if (!has_next) break;
#pragma unroll
        for (int a = 0; a < 2; ++a)
#pragma unroll
            for (int b = 0; b < 2; ++b)
#pragma unroll
                for (int m = 0; m < 4; ++m)
#pragma unroll
                    for (int n = 0; n < 2; ++n) acc[a][b][m][n] = (f32x4){0.f, 0.f, 0.f, 0.f};
        cur = nxt; ++ui;
        if (wr == 1) PG8_BAR;
    }
    PG8_WAIT_V(0);
    PG8_BAR;
#undef PG8_SA
#undef PG8_SB
#undef PG8_STAGE
#undef PG8_LDA
#undef PG8_LDB
#undef PG8_MMA
#undef PG8_WAIT_V
#undef PG8_WAIT_L
#undef PG8_BAR
#undef PG8_SCHED
#undef PG8_TA
#undef PG8_TB
}
}

struct Args { const float* in[16]; float* out; unsigned char* ws; int ph_lo, ph_hi; unsigned naive; int pad; };
struct Ctx {
    LAS unsigned char* lds;
    const float *x, *c, *ctx, *c_ctx, *norm_w, *ada_w, *ada_b, *w_in, *conv_w, *conv_b, *decay_logit, *gn_w, *w_a, *w_b, *w_out, *final_w;
    float* out; unsigned char* ws;
    float* MOD; f32x2* ROPE;
    bf16_t *WA, *WB, *WOUT, *WIN, *XM, *KV, *KVC, *HC, *ST, *MM, *P, *Q, *K, *V, *SZB, *KC, *VC, *UB, *R, *SGB;
    float* RET;
};

DI int win_dest(int o) {
    if (o < 4096) { const int g = o >> 10, ch = o & 1023; return 256 * (ch >> 6) + 64 * g + (ch & 63); }
    if (o < 5120) { const int qk = (o - 4096) >> 9, oo = (o - 4096) & 511, head = oo >> 6, i = oo & 63, t = head >> 2, hh = head & 3;
        return 256 * (16 + 2 * qk + t) + (i < 32 ? 32 * hh + i : 128 + 32 * hh + (i - 32)); }
    if (o < 7168) return o;
    { const int gs = (o - 7168) >> 10, ch = (o - 7168) & 1023; return 256 * (28 + (ch >> 7)) + 128 * gs + (ch & 127); }
}
DI void p0_transpose_item(const float* W, int K, int N, bf16_t* WT, bool permute, LAS float* scr, int item, int lane) {
    const int nblk = N / 32, kb = item / nblk, nb = item % nblk, k0 = 64 * kb, n0 = 32 * nb;
#pragma unroll 8
    for (int i = 0; i < 32; ++i) { const int kk = 2 * i + (lane >> 5); scr[kk * 33 + (lane & 31)] = W[(size_t)(k0 + kk) * N + n0 + (lane & 31)]; }
    asm volatile("s_waitcnt lgkmcnt(0)" ::: "memory");
    const int c = lane & 7; const int d0 = permute ? win_dest(n0) : n0;
#pragma unroll
    for (int j = 0; j < 4; ++j) { const int n = (lane >> 3) + 8 * j; const LAS float* s = scr + (8 * c) * 33 + n;
        u32x4 o; o.x = cvt_pk_bf16(s[0 * 33], s[1 * 33]); o.y = cvt_pk_bf16(s[2 * 33], s[3 * 33]); o.z = cvt_pk_bf16(s[4 * 33], s[5 * 33]); o.w = cvt_pk_bf16(s[6 * 33], s[7 * 33]);
        *(u32x4*)(WT + (size_t)(d0 + n) * K + k0 + 8 * c) = o; }
    asm volatile("s_waitcnt lgkmcnt(0)" ::: "memory");
}
DI void p0_prologue(const Ctx& F) {
    const Tid T = opaque_tid();
    if (blockIdx.x < 48) {
        LAS float* red = (LAS float*)F.lds;
        const int n0 = 64 * blockIdx.x, k0 = 128 * T.wave;
        float a[5] = {0.f, 0.f, 0.f, 0.f, 0.f};
#pragma unroll 8
        for (int k = 0; k < 128; ++k) {
            const float w = F.ada_w[(size_t)(k0 + k) * 3072 + n0 + T.lane];
#pragma unroll
            for (int v = 0; v < 5; ++v) { const float cv = v < 4 ? F.c[v * 1024 + k0 + k] : F.c_ctx[k0 + k]; a[v] += siluf(cv) * w; }
        }
#pragma unroll
        for (int v = 0; v < 5; ++v) red[(T.wave * 5 + v) * 64 + T.lane] = a[v];
        __syncthreads();
        if (T.tid < 320) { const int v = T.tid >> 6, l = T.tid & 63; float s = F.ada_b[n0 + l];
#pragma unroll
            for (int w = 0; w < 8; ++w) s += red[(w * 5 + v) * 64 + l];
            F.MOD[v * 3072 + n0 + l] = s; }
        __syncthreads();
    }
    if (blockIdx.x == 48) {
        for (int e = T.tid; e < 1024; e += 512) { const int p = e >> 4, f = e & 15; const float inv = powf(10000.f, -(float)f / 16.f); const float ang = (float)p * inv;
            F.ROPE[e] = (f32x2){cosf(ang), sinf(ang)}; }
    }
    LAS float* scr = (LAS float*)(F.lds + T.wave * 16384);
    const int gw = blockIdx.x * 8 + T.wave, NGW = gridDim.x * 8;
    constexpr int I_IN = 16 * (NIN / 32), I_SQ = 16 * 32;
    for (int it = gw; it < I_IN + 3 * I_SQ; it += NGW) {
        int r = it;
        if (r < I_IN) { p0_transpose_item(F.w_in, 1024, NIN, F.WIN, true, scr, r, T.lane); continue; } r -= I_IN;
        if (r < I_SQ) { p0_transpose_item(F.w_a, 1024, 1024, F.WA, false, scr, r, T.lane); continue; } r -= I_SQ;
        if (r < I_SQ) { p0_transpose_item(F.w_b, 1024, 1024, F.WB, false, scr, r, T.lane); continue; } r -= I_SQ;
        p0_transpose_item(F.w_out, 1024, 1024, F.WOUT, false, scr, r, T.lane);
    }
}
DI void p1_rows(const Ctx& F) {
    const Tid T = opaque_tid();
    const int gw = blockIdx.x * 8 + T.wave, NGW = gridDim.x * 8;
    for (int m = gw; m < MALL; m += NGW) {
        const float* xr; int mb;
        if (m < MTOK) { xr = F.x + (size_t)m * DM; mb = m >> 12; } else { xr = F.ctx + (size_t)(m - MTOK) * DM; mb = 4; }
        f32x4 v[4]; float ss = 0.f;
#pragma unroll
        for (int j = 0; j < 4; ++j) { v[j] = ((const f32x4*)xr)[T.lane + 64 * j]; ss += (v[j].x * v[j].x + v[j].y * v[j].y) + (v[j].z * v[j].z + v[j].w * v[j].w); }
        const float rstd = 1.0f / sqrtf(wave_sum(ss) * (1.f / DM) + EPS);
        const float* mod = F.MOD + mb * 3072;
#pragma unroll
        for (int j = 0; j < 4; ++j) { const int col = 4 * (T.lane + 64 * j);
            const f32x4 w = *(const f32x4*)(F.norm_w + col), sh = *(const f32x4*)(mod + col), sc = *(const f32x4*)(mod + 1024 + col);
            const f32x4 y = (v[j] * rstd * w) * (sc + 1.0f) + sh;
            u32x2 o; o.x = cvt_pk_bf16(y.x, y.y); o.y = cvt_pk_bf16(y.z, y.w);
            *(u32x2*)(F.XM + (size_t)m * DM + col) = o; }
    }
}
struct Sched1 {
    int G, c;
    DI bool next(int i, pg8::Unit& u) const {
        const int L = i * G + c;
        if (L < 64 * 36) { pg8::tile_of(L, 64, 36, u); return true; }
        const int e = L - 64 * 36; if (e >= 24) return false;
        u.pm = 64 + e / 6; u.pn = 18 + e % 6; return true;
    }
};
struct Epi1 {
    unsigned char* ws; bf16_t *R, *SGB; const f32x2* rope;
    DI void mid(f32x4 (&)[2][2][4][2], const pg8::Unit&, int, int, int, int) const {}
    DI void operator()(const f32x4 (&acc)[2][2][4][2], const pg8::Unit& u, int wr, int wc, int fr, int fq) const {
        const int pn = u.pn, row0 = u.pm * 256 + wr * 64 + fr, x0 = wc * 32 + 8 * fq;
        const bool isctx = u.pm >= 64;
        if (pn < 16) {
            bf16_t* dst = (bf16_t*)(ws + (wc < 2 ? WS_HC : WS_P)) + 64 * pn + (x0 & 63);
#pragma unroll
            for (int ai = 0; ai < 2; ++ai)
#pragma unroll
                for (int m = 0; m < 4; ++m) { const size_t row = row0 + ai * 128 + m * 16;
                    f32x4 o[2];
#pragma unroll
                    for (int n = 0; n < 2; ++n) { const f32x4 a = acc[ai][0][m][n], b = acc[ai][1][m][n];
                        if (wc < 2) o[n] = a * b;
                        else { o[n].x = a.x * siluf(b.x); o[n].y = a.y * siluf(b.y); o[n].z = a.z * siluf(b.z); o[n].w = a.w * siluf(b.w); } }
                    u32x4 w; w.x = cvt_pk_bf16(o[0].x, o[0].y); w.y = cvt_pk_bf16(o[0].z, o[0].w); w.z = cvt_pk_bf16(o[1].x, o[1].y); w.w = cvt_pk_bf16(o[1].z, o[1].w);
                    *(u32x4*)(dst + row * 1024) = w; }
        } else if (pn < 20) {
            const int t = (pn - 16) & 1, isk = (pn - 16) >> 1, head = 4 * t + wc, i0 = 8 * fq;
            const float scale = isk ? 0.125f : 1.0f;
            bf16_t* base = (bf16_t*)(ws + (isk ? (isctx ? WS_KC : WS_K) : WS_Q));
#pragma unroll
            for (int ai = 0; ai < 2; ++ai)
#pragma unroll
                for (int m = 0; m < 4; ++m) { const int row = row0 + ai * 128 + m * 16; const int orow = isctx ? row - MTOK : row;
                    const int pos = row & 4095, pidx = (fq < 2) ? (pos >> 6) : (pos & 63);
                    const f32x2* rp = rope + pidx * 16 + (fq & 1) * 8;
                    float o1[8], o2[8];
#pragma unroll
                    for (int e = 0; e < 8; ++e) { f32x2 cs = rp[e]; if (isctx) cs = (f32x2){1.f, 0.f};
                        const float t1 = acc[ai][0][m][e >> 2][e & 3], t2 = acc[ai][1][m][e >> 2][e & 3];
                        o1[e] = (t1 * cs.x - t2 * cs.y) * scale; o2[e] = (t1 * cs.y + t2 * cs.x) * scale; }
                    u32x4 w1, w2; w1.x = cvt_pk_bf16(o1[0], o1[1]); w1.y = cvt_pk_bf16(o1[2], o1[3]); w1.z = cvt_pk_bf16(o1[4], o1[5]); w1.w = cvt_pk_bf16(o1[6], o1[7]);
                    w2.x = cvt_pk_bf16(o2[0], o2[1]); w2.y = cvt_pk_bf16(o2[2], o2[3]); w2.z = cvt_pk_bf16(o2[4], o2[5]); w2.w = cvt_pk_bf16(o2[6], o2[7]);
                    bf16_t* d = base + (size_t)orow * 512 + head * 64 + i0;
                    *(u32x4*)d = w1; *(u32x4*)(d + 32) = w2; }
        } else if (pn < 28) {
            const bool isz = pn >= 24;
            bf16_t* base = (bf16_t*)(ws + (isz ? WS_SZB : (isctx ? WS_VC : WS_V)));
            const int colt = 256 * (pn - (isz ? 24 : 20)) + x0;
#pragma unroll
            for (int ai = 0; ai < 2; ++ai)
#pragma unroll
                for (int m = 0; m < 4; ++m) { const int row = row0 + ai * 128 + m * 16; const int orow = isctx ? row - MTOK : row;
#pragma unroll
                    for (int bj = 0; bj < 2; ++bj) { f32x4 a = acc[ai][bj][m][0], b = acc[ai][bj][m][1];
                        if (isz) { a.x = siluf(a.x); a.y = siluf(a.y); a.z = siluf(a.z); a.w = siluf(a.w); b.x = siluf(b.x); b.y = siluf(b.y); b.z = siluf(b.z); b.w = siluf(b.w); }
                        u32x4 w; w.x = cvt_pk_bf16(a.x, a.y); w.y = cvt_pk_bf16(a.z, a.w); w.z = cvt_pk_bf16(b.x, b.y); w.w = cvt_pk_bf16(b.z, b.w);
                        *(u32x4*)(base + (size_t)orow * 1024 + colt + bj * 128) = w; } }
        } else {
            const int col = 128 * (pn - 28) + x0;
#pragma unroll
            for (int ai = 0; ai < 2; ++ai)
#pragma unroll
                for (int m = 0; m < 4; ++m) { const size_t row = row0 + ai * 128 + m * 16;
                    float rr[8], sg[8];
#pragma unroll
                    for (int e = 0; e < 8; ++e) { const float ga = acc[ai][0][m][e >> 2][e & 3], gb = acc[ai][1][m][e >> 2][e & 3];
                        const float ea = __expf(-ga), eb = __expf(-gb); sg[e] = 1.f / (1.f + eb); rr[e] = (1.f + eb) / (1.f + ea); }
                    u32x4 w1, w2; w1.x = cvt_pk_bf16(rr[0], rr[1]); w1.y = cvt_pk_bf16(rr[2], rr[3]); w1.z = cvt_pk_bf16(rr[4], rr[5]); w1.w = cvt_pk_bf16(rr[6], rr[7]);
                    w2.x = cvt_pk_bf16(sg[0], sg[1]); w2.y = cvt_pk_bf16(sg[2], sg[3]); w2.z = cvt_pk_bf16(sg[4], sg[5]); w2.w = cvt_pk_bf16(sg[6], sg[7]);
                    *(u32x4*)(R + row * 1024 + col) = w1; *(u32x4*)(SGB + row * 1024 + col) = w2; }
        }
    }
};
DI void n2_inproj(const Ctx& F) {
    const Tid T = opaque_tid();
    const size_t NT = (size_t)gridDim.x * 512, gt = (size_t)blockIdx.x * 512 + T.tid;
    for (size_t idx = gt; idx < (size_t)(MALL / 4) * 1024; idx += NT) {
        const int ch = (int)(idx & 1023), t0 = (int)(idx >> 10) * 4;
        const bool doqk = ch < 512 && (ch & 63) < 32;
        float a[12][4];
#pragma unroll
        for (int o = 0; o < 12; ++o)
#pragma unroll
            for (int j = 0; j < 4; ++j) a[o][j] = 0.f;
        for (int k = 0; k < 1024; ++k) {
            const float* wr = F.w_in + (size_t)k * NIN;
            float xv[4];
#pragma unroll
            for (int j = 0; j < 4; ++j) xv[j] = bf2f(F.XM[(size_t)(t0 + j) * 1024 + k]);
            float w[12];
            w[0] = wr[ch]; w[1] = wr[1024 + ch]; w[2] = wr[2048 + ch]; w[3] = wr[3072 + ch]; w[4] = wr[5120 + ch]; w[5] = wr[6144 + ch]; w[6] = wr[7168 + ch]; w[7] = wr[8192 + ch];
            if (doqk) { w[8] = wr[4096 + ch]; w[9] = wr[4096 + ch + 32]; w[10] = wr[4608 + ch]; w[11] = wr[4608 + ch + 32]; } else { w[8] = w[9] = w[10] = w[11] = 0.f; }
#pragma unroll
            for (int o = 0; o < 12; ++o)
#pragma unroll
                for (int j = 0; j < 4; ++j) a[o][j] += xv[j] * w[o];
        }
#pragma unroll
        for (int j = 0; j < 4; ++j) { const int t = t0 + j;
            if (t < MTOK) {
                const size_t o = (size_t)t * 1024 + ch;
                F.HC[o] = f2bf(a[2][j] * a[0][j]); F.P[o] = f2bf(siluf(a[3][j]) * a[1][j]); F.V[o] = f2bf(a[4][j]); F.SZB[o] = f2bf(siluf(a[5][j]));
                const float sga = 1.f / (1.f + __expf(-a[6][j])), sgb = 1.f / (1.f + __expf(-a[7][j]));
                F.R[o] = f2bf(sga / sgb); F.SGB[o] = f2bf(sgb);
                if (doqk) { const int i = ch & 63, pos = t & 4095; const int pidx = i < 16 ? (pos >> 6) : (pos & 63); const f32x2 cs = F.ROPE[pidx * 16 + (i & 15)];
                    const size_t q = (size_t)t * 512 + ch;
                    F.Q[q] = f2bf(a[8][j] * cs.x - a[9][j] * cs.y); F.Q[q + 32] = f2bf(a[8][j] * cs.y + a[9][j] * cs.x);
                    F.K[q] = f2bf((a[10][j] * cs.x - a[11][j] * cs.y) * 0.125f); F.K[q + 32] = f2bf((a[10][j] * cs.y + a[11][j] * cs.x) * 0.125f); }
            } else {
                const int tc = t - MTOK;
                F.VC[(size_t)tc * 1024 + ch] = f2bf(a[4][j]);
                if (doqk) { F.KC[(size_t)tc * 512 + ch] = f2bf(a[10][j] * 0.125f); F.KC[(size_t)tc * 512 + ch + 32] = f2bf(a[11][j] * 0.125f); }
            }
        }
    }
}
DI bf16x8 tr2(const LAS unsigned char* p, int delta) {
    const s16x4 lo = __builtin_bit_cast(s16x4, __builtin_amdgcn_ds_read_tr16_b64_v4i16((LAS v4i16_t*)p));
    const s16x4 hi = __builtin_bit_cast(s16x4, __builtin_amdgcn_ds_read_tr16_b64_v4i16((LAS v4i16_t*)(p + delta)));
    return __builtin_shufflevector(lo, hi, 0, 1, 2, 3, 4, 5, 6, 7);
}
DI u32x4 scale8(u32x4 w, float s) {
    u32x4 o; o.x = cvt_pk_bf16(bflo(w.x) * s, bfhi(w.x) * s); o.y = cvt_pk_bf16(bflo(w.y) * s, bfhi(w.y) * s); o.z = cvt_pk_bf16(bflo(w.z) * s, bfhi(w.z) * s); o.w = cvt_pk_bf16(bflo(w.w) * s, bfhi(w.w) * s); return o;
}
DI void p3_kv(const Ctx& F) {
    const Tid T = opaque_tid();
    LAS unsigned char* KFI = F.lds; LAS unsigned char* KBI = F.lds + 20480; LAS unsigned char* VI = F.lds + 40960;
    const int tid = T.tid, lane = T.lane, w = T.wave, g = lane >> 4, q = (lane & 15) >> 2, p = lane & 3;
    for (int it = blockIdx.x; it < 1024 + 64; it += gridDim.x) {
        int bh; const bf16_t *kp, *vp; bf16_t *of, *ob;
        if (it < 1024) { bh = it >> 5; const int c = it & 31; const size_t tok0 = (size_t)(bh >> 3) * SEQ + c * CHK;
            kp = (const bf16_t*)(F.ws + WS_K) + tok0 * 512 + (bh & 7) * 64; vp = (const bf16_t*)(F.ws + WS_V) + tok0 * 1024 + (bh & 7) * 128;
            of = (bf16_t*)(F.ws + WS_KV) + ((size_t)(0 * 32 + bh) * 32 + c) * 8192; ob = (bf16_t*)(F.ws + WS_KV) + ((size_t)(1 * 32 + bh) * 32 + c) * 8192; }
        else { const int e = it - 1024; bh = e >> 1; const int cc = e & 1; const size_t tok0 = (size_t)(bh >> 3) * CTXL + cc * CHK;
            kp = (const bf16_t*)(F.ws + WS_KC) + tok0 * 512 + (bh & 7) * 64; vp = (const bf16_t*)(F.ws + WS_VC) + tok0 * 1024 + (bh & 7) * 128;
            of = (bf16_t*)(F.ws + WS_KVC) + ((size_t)(0 * 32 + bh) * 2 + cc) * 8192; ob = (bf16_t*)(F.ws + WS_KVC) + ((size_t)(1 * 32 + bh) * 2 + cc) * 8192; }
        const float l2f = log2_gamma(F.decay_logit, 0, bh & 7), l2b = log2_gamma(F.decay_logit, 1, bh & 7);
        { const int row = tid >> 2, seg = tid & 3;
            const u32x4 k0 = *(const u32x4*)(kp + (size_t)row * 512 + seg * 16), k1 = *(const u32x4*)(kp + (size_t)row * 512 + seg * 16 + 8);
            const float df = exp2f(l2f * (float)(127 - row)), db = exp2f(l2b * (float)row);
            *(LAS u32x4*)(KFI + row * 160 + seg * 32) = scale8(k0, df); *(LAS u32x4*)(KFI + row * 160 + seg * 32 + 16) = scale8(k1, df);
            *(LAS u32x4*)(KBI + row * 160 + seg * 32) = scale8(k0, db); *(LAS u32x4*)(KBI + row * 160 + seg * 32 + 16) = scale8(k1, db);
#pragma unroll
            for (int i = 0; i < 4; ++i) *(LAS u32x4*)(VI + row * 288 + seg * 64 + 16 * i) = *(const u32x4*)(vp + (size_t)row * 1024 + seg * 32 + 8 * i);
        }
        __syncthreads();
        f32x4 acc[2][4];
#pragma unroll
        for (int d = 0; d < 2; ++d)
#pragma unroll
            for (int nb = 0; nb < 4; ++nb) acc[d][nb] = (f32x4){0.f, 0.f, 0.f, 0.f};
#pragma unroll
        for (int s = 0; s < 4; ++s) {
            const bf16x8 a = tr2(VI + (32 * s + 8 * g + q) * 288 + (16 * w + 4 * p) * 2, 4 * 288);
#pragma unroll
            for (int nb = 0; nb < 4; ++nb) {
                const bf16x8 bfw = tr2(KFI + (32 * s + 8 * g + q) * 160 + (16 * nb + 4 * p) * 2, 4 * 160);
                const bf16x8 bbw = tr2(KBI + (32 * s + 8 * g + q) * 160 + (16 * nb + 4 * p) * 2, 4 * 160);
                acc[0][nb] = __builtin_amdgcn_mfma_f32_16x16x32_bf16(a, bfw, acc[0][nb], 0, 0, 0);
                acc[1][nb] = __builtin_amdgcn_mfma_f32_16x16x32_bf16(a, bbw, acc[1][nb], 0, 0, 0);
            }
        }
#pragma unroll
        for (int nb = 0; nb < 4; ++nb)
#pragma unroll
            for (int r = 0; r < 4; ++r) { const int o = (16 * w + 4 * g + r) * 64 + 16 * nb + (lane & 15);
                of[o] = f2bf(acc[0][nb][r]); ob[o] = f2bf(acc[1][nb][r]); }
        __syncthreads();
    }
}
DI void p3_ua(const Ctx& F) {
    const Tid T = opaque_tid();
    const size_t NT = (size_t)gridDim.x * 512, gt = (size_t)blockIdx.x * 512 + T.tid;
    for (size_t idx = gt; idx < (size_t)MTOK * 128; idx += NT) {
        const int t = (int)(idx >> 7), c8 = (int)(idx & 127) * 8, pos = t & 4095;
        const bf16_t* hp = F.HC + (size_t)t * 1024 + c8;
        const u32x4 z = (u32x4){0u, 0u, 0u, 0u};
        const u32x4 h0 = pos > 0 ? *(const u32x4*)(hp - 1024) : z, h1 = *(const u32x4*)hp, h2 = pos < SEQ - 1 ? *(const u32x4*)(hp + 1024) : z;
        const u32x4 pv = *(const u32x4*)(F.P + (size_t)t * 1024 + c8);
        float o[8];
#pragma unroll
        for (int e = 0; e < 8; ++e) { const unsigned a = h0[e >> 1], b = h1[e >> 1], c = h2[e >> 1], pp = pv[e >> 1];
            const float x0 = (e & 1) ? bfhi(a) : bflo(a), x1 = (e & 1) ? bfhi(b) : bflo(b), x2 = (e & 1) ? bfhi(c) : bflo(c), pf = (e & 1) ? bfhi(pp) : bflo(pp);
            const float cv = F.conv_w[c8 + e] * x0 + F.conv_w[1024 + c8 + e] * x1 + F.conv_w[2048 + c8 + e] * x2 + F.conv_b[c8 + e];
            o[e] = pf * cv; }
        u32x4 w; w.x = cvt_pk_bf16(o[0], o[1]); w.y = cvt_pk_bf16(o[2], o[3]); w.z = cvt_pk_bf16(o[4], o[5]); w.w = cvt_pk_bf16(o[6], o[7]);
        *(u32x4*)(F.P + (size_t)t * 1024 + c8) = w;
    }
}
DI void p4_scan(const Ctx& F) {
    const Tid T = opaque_tid();
    const size_t NT = (size_t)gridDim.x * 512, gt = (size_t)blockIdx.x * 512 + T.tid;
    for (size_t idx = gt; idx < (size_t)2 * 32 * 4096; idx += NT) {
        const int e2 = (int)(idx & 4095), bh = (int)(idx >> 12) & 31, dir = (int)(idx >> 17);
        const float g = exp2f(log2_gamma(F.decay_logit, dir, bh & 7) * 128.f);
        const unsigned* kvc = (const unsigned*)(F.KVC + ((size_t)(dir * 32 + bh) * 2) * 8192) + e2;
        const unsigned* kv = (const unsigned*)(F.KV + ((size_t)(dir * 32 + bh) * 32) * 8192) + e2;
        unsigned* st = (unsigned*)(F.ST + ((size_t)(dir * 32 + bh) * 32) * 8192) + e2;
        const unsigned c0 = kvc[0], c1 = kvc[4096];
        float s0, s1;
        if (dir == 0) { s0 = g * bflo(c0) + bflo(c1); s1 = g * bfhi(c0) + bfhi(c1); } else { s0 = bflo(c0) + g * bflo(c1); s1 = bfhi(c0) + g * bfhi(c1); }
#pragma unroll 8
        for (int i = 0; i < 32; ++i) { const int c = dir == 0 ? i : 31 - i;
            const unsigned v = kv[(size_t)c * 4096];
            st[(size_t)c * 4096] = cvt_pk_bf16(s0, s1);
            s0 = g * s0 + bflo(v); s1 = g * s1 + bfhi(v); }
    }
}
DI void n4_recurrence(const Ctx& F) {
    const Tid T = opaque_tid();
    const int gw = blockIdx.x * 8 + T.wave, NGW = gridDim.x * 8, d = T.lane;
    for (int task = gw; task < 32 * 128; task += NGW) {
        const int bh = task >> 7, v = task & 127, b = bh >> 3, h = bh & 7;
        const float gf = exp2f(log2_gamma(F.decay_logit, 0, h)), gb = exp2f(log2_gamma(F.decay_logit, 1, h));
        float s = 0.f;
        for (int m = 0; m < CTXL; ++m) { const size_t t = (size_t)b * CTXL + m; s = gf * s + bf2f(F.KC[t * 512 + h * 64 + d]) * bf2f(F.VC[t * 1024 + h * 128 + v]); }
        const float sF = s; s = 0.f;
        for (int m = CTXL - 1; m >= 0; --m) { const size_t t = (size_t)b * CTXL + m; s = gb * s + bf2f(F.KC[t * 512 + h * 64 + d]) * bf2f(F.VC[t * 1024 + h * 128 + v]); }
        const float sB = s;
        s = sF;
        for (int n = 0; n < SEQ; ++n) { const size_t t = (size_t)b * SEQ + n; s = gf * s + bf2f(F.K[t * 512 + h * 64 + d]) * bf2f(F.V[t * 1024 + h * 128 + v]);
            const float o = wave_sum(bf2f(F.Q[t * 512 + h * 64 + d]) * s); if (d == 0) F.RET[t * 1024 + h * 128 + v] = o; }
        s = sB;
        for (int n = SEQ - 1; n >= 0; --n) { const size_t t = (size_t)b * SEQ + n; s = gb * s + bf2f(F.K[t * 512 + h * 64 + d]) * bf2f(F.V[t * 1024 + h * 128 + v]);
            const float o = wave_sum(bf2f(F.Q[t * 512 + h * 64 + d]) * s); if (d == 0) F.RET[t * 1024 + h * 128 + v] += o; }
    }
}
DI void n5_groupnorm(const Ctx& F) {
    const Tid T = opaque_tid();
    const int gw = blockIdx.x * 8 + T.wave, NGW = gridDim.x * 8;
    for (int task = gw; task < MTOK * NH; task += NGW) {
        const int t = task >> 3, h = task & 7; const size_t o = (size_t)t * 1024 + h * 128 + 2 * T.lane;
        const float a = F.RET[o], b = F.RET[o + 1];
        const float mu = wave_sum(a + b) * (1.f / 128.f); const float da = a - mu, db = b - mu;
        const float var = wave_sum(da * da + db * db) * (1.f / 128.f); const float rstd = 1.0f / sqrtf(var + EPS);
        const float ra = da * rstd * F.gn_w[h * 128 + 2 * T.lane], rb = db * rstd * F.gn_w[h * 128 + 2 * T.lane + 1];
        *(unsigned*)(F.UB + o) = cvt_pk_bf16(bf2f(F.SZB[o]) * ra, bf2f(F.SZB[o + 1]) * rb);
    }
}
DI void p5_ret(const Ctx& F) {
    const Tid T = opaque_tid();
    LAS unsigned char* KI = F.lds; LAS unsigned char* VI = F.lds + 20480; LAS unsigned char* SF = F.lds + 57344; LAS unsigned char* SB = F.lds + 75776;
    const int tid = T.tid, lane = T.lane, w = T.wave, g = lane >> 4, q = (lane & 15) >> 2, p = lane & 3, l15 = lane & 15;
    for (int it = blockIdx.x; it < 1024; it += gridDim.x) {
        const int bh = it >> 5, c = it & 31, h = bh & 7; const size_t tok0 = (size_t)(bh >> 3) * SEQ + c * CHK;
        const bf16_t* kp = F.K + tok0 * 512 + h * 64; const bf16_t* vp = F.V + tok0 * 1024 + h * 128; const bf16_t* qp = F.Q + tok0 * 512 + h * 64;
        const bf16_t* stf = F.ST + ((size_t)(0 * 32 + bh) * 32 + c) * 8192; const bf16_t* stb = F.ST + ((size_t)(1 * 32 + bh) * 32 + c) * 8192;
        const float l2f = log2_gamma(F.decay_logit, 0, h), l2b = log2_gamma(F.decay_logit, 1, h);
        { const int row = tid >> 2, seg = tid & 3;
#pragma unroll
            for (int i = 0; i < 2; ++i) *(LAS u32x4*)(KI + row * 160 + seg * 32 + 16 * i) = *(const u32x4*)(kp + (size_t)row * 512 + seg * 16 + 8 * i);
#pragma unroll
            for (int i = 0; i < 4; ++i) *(LAS u32x4*)(VI + row * 288 + seg * 64 + 16 * i) = *(const u32x4*)(vp + (size_t)row * 1024 + seg * 32 + 8 * i);
#pragma unroll
            for (int i = 0; i < 2; ++i) { *(LAS u32x4*)(SF + row * 144 + seg * 32 + 16 * i) = *(const u32x4*)(stf + row * 64 + seg * 16 + 8 * i);
                *(LAS u32x4*)(SB + row * 144 + seg * 32 + 16 * i) = *(const u32x4*)(stb + row * 64 + seg * 16 + 8 * i); }
        }
        const int il = 16 * w + l15;
        bf16x8 qf[2];
#pragma unroll
        for (int ks = 0; ks < 2; ++ks) qf[ks] = *(const bf16x8*)(qp + (size_t)il * 512 + 32 * ks + 8 * g);
        __syncthreads();
        f32x4 accS[8];
#pragma unroll
        for (int jb = 0; jb < 8; ++jb) { accS[jb] = (f32x4){0.f, 0.f, 0.f, 0.f};
#pragma unroll
            for (int ks = 0; ks < 2; ++ks) { const bf16x8 kf = *(const LAS bf16x8*)(KI + (16 * jb + l15) * 160 + (32 * ks + 8 * g) * 2);
                accS[jb] = __builtin_amdgcn_mfma_f32_16x16x32_bf16(kf, qf[ks], accS[jb], 0, 0, 0); } }
        bf16x8 pf[4];
#pragma unroll
        for (int s = 0; s < 4; ++s) { float pv[8];
#pragma unroll
            for (int e = 0; e < 8; ++e) { const int jb = 2 * s + (e >> 2), r = e & 3, j = 16 * jb + 4 * g + r, df = il - j;
                float mk = 0.f; if (df >= 0) mk += exp2f(l2f * (float)df); if (df <= 0) mk += exp2f(l2b * (float)(-df));
                pv[e] = accS[jb][r] * mk; }
            u32x4 pw; pw.x = cvt_pk_bf16(pv[0], pv[1]); pw.y = cvt_pk_bf16(pv[2], pv[3]); pw.z = cvt_pk_bf16(pv[4], pv[5]); pw.w = cvt_pk_bf16(pv[6], pv[7]);
            pf[s] = __builtin_bit_cast(bf16x8, pw); }
        const float decf = exp2f(l2f * (float)(il + 1)), decb = exp2f(l2b * (float)(128 - il));
        f32x4 accO[8];
#pragma unroll
        for (int vb = 0; vb < 8; ++vb) { f32x4 o = (f32x4){0.f, 0.f, 0.f, 0.f};
#pragma unroll
            for (int s = 0; s < 4; ++s) { const bf16x8 vf = tr2(VI + (32 * s + 4 * g + q) * 288 + (16 * vb + 4 * p) * 2, 16 * 288);
                o = __builtin_amdgcn_mfma_f32_16x16x32_bf16(vf, pf[s], o, 0, 0, 0); }
            f32x4 tf = (f32x4){0.f, 0.f, 0.f, 0.f}, tb = (f32x4){0.f, 0.f, 0.f, 0.f};
#pragma unroll
            for (int ks = 0; ks < 2; ++ks) { const bf16x8 sf = *(const LAS bf16x8*)(SF + (16 * vb + l15) * 144 + (32 * ks + 8 * g) * 2);
                const bf16x8 sb = *(const LAS bf16x8*)(SB + (16 * vb + l15) * 144 + (32 * ks + 8 * g) * 2);
                tf = __builtin_amdgcn_mfma_f32_16x16x32_bf16(sf, qf[ks], tf, 0, 0, 0); tb = __builtin_amdgcn_mfma_f32_16x16x32_bf16(sb, qf[ks], tb, 0, 0, 0); }
            accO[vb] = o + tf * decf + tb * decb; __builtin_amdgcn_sched_barrier(0); }
        float sm = 0.f;
#pragma unroll
        for (int vb = 0; vb < 8; ++vb) sm += (accO[vb].x + accO[vb].y) + (accO[vb].z + accO[vb].w);
        sm += __shfl_xor(sm, 16); sm += __shfl_xor(sm, 32);
        const float mu = sm * (1.f / 128.f); float sq = 0.f;
#pragma unroll
        for (int vb = 0; vb < 8; ++vb) { accO[vb] = accO[vb] - mu; sq += (accO[vb].x * accO[vb].x + accO[vb].y * accO[vb].y) + (accO[vb].z * accO[vb].z + accO[vb].w * accO[vb].w); }
        sq += __shfl_xor(sq, 16); sq += __shfl_xor(sq, 32);
        const float rstd = 1.0f / sqrtf(sq * (1.f / 128.f) + EPS);
        __syncthreads();
#pragma unroll
        for (int vb = 0; vb < 8; ++vb) { const f32x4 gw = *(const f32x4*)(F.gn_w + h * 128 + 16 * vb + 4 * g); const f32x4 o = accO[vb] * rstd * gw;
            u32x2 ow; ow.x = cvt_pk_bf16(o.x, o.y); ow.y = cvt_pk_bf16(o.z, o.w);
            *(LAS u32x2*)(VI + il * 288 + (16 * vb + 4 * g) * 2) = ow; }
        __syncthreads();
        { const int row = tid >> 2, seg = tid & 3; const size_t go = (tok0 + row) * 1024 + h * 128 + seg * 32;
#pragma unroll
            for (int i = 0; i < 4; ++i) { const u32x4 o = *(const LAS u32x4*)(VI + row * 288 + seg * 64 + 16 * i); const u32x4 z = *(const u32x4*)(F.SZB + go + 8 * i);
                u32x4 r; r.x = cvt_pk_bf16(bflo(o.x) * bflo(z.x), bfhi(o.x) * bfhi(z.x)); r.y = cvt_pk_bf16(bflo(o.y) * bflo(z.y), bfhi(o.y) * bfhi(z.y));
                r.z = cvt_pk_bf16(bflo(o.z) * bflo(z.z), bfhi(o.z) * bfhi(z.z)); r.w = cvt_pk_bf16(bflo(o.w) * bflo(z.w), bfhi(o.w) * bfhi(z.w));
                *(u32x4*)(F.UB + go + 8 * i) = r; } }
        __syncthreads();
    }
}
struct SchedSq { int G, c; DI bool next(int i, pg8::Unit& u) const { const int L = i * G + c; if (L >= 256) return false; pg8::tile_of(L, 64, 4, u); return true; } };
struct EpiAB {
    const bf16_t* R; const bf16_t* SGB; bf16_t* MM;
    DI void mid(f32x4 (&acc)[2][2][4][2], const pg8::Unit& u, int wr, int wc, int fr, int fq) const { apply<false>(acc, u, wr, wc, fr, fq); }
    DI void operator()(const f32x4 (&acc)[2][2][4][2], const pg8::Unit& u, int wr, int wc, int fr, int fq) const { apply<true>(const_cast<f32x4 (&)[2][2][4][2]>(acc), u, wr, wc, fr, fq); }
    template <bool FIN> DI void apply(f32x4 (&acc)[2][2][4][2], const pg8::Unit& u, int wr, int wc, int fr, int fq) const {
        const bf16_t* src = FIN ? SGB : R;
        const size_t base = (size_t)(u.pm * 256 + wr * 64 + fr) * 1024 + u.pn * 256 + wc * 32 + 8 * fq;
#pragma unroll
        for (int am = 0; am < 4; ++am) { const int ai = am >> 1;
            u32x4 gv[4][2];
#pragma unroll
            for (int m = 2 * (am & 1); m < 2 * (am & 1) + 2; ++m)
#pragma unroll
                for (int bj = 0; bj < 2; ++bj) gv[m][bj] = *(const u32x4*)(src + base + (size_t)(ai * 128 + m * 16) * 1024 + bj * 128);
#pragma unroll
            for (int m = 2 * (am & 1); m < 2 * (am & 1) + 2; ++m)
#pragma unroll
                for (int bj = 0; bj < 2; ++bj) { const u32x4 gq = gv[m][bj];
                    f32x4 a = acc[ai][bj][m][0], b = acc[ai][bj][m][1];
                    a.x *= bflo(gq.x); a.y *= bfhi(gq.x); a.z *= bflo(gq.y); a.w *= bfhi(gq.y); b.x *= bflo(gq.z); b.y *= bfhi(gq.z); b.z *= bflo(gq.w); b.w *= bfhi(gq.w);
                    if (FIN) { u32x4 w; w.x = cvt_pk_bf16(a.x, a.y); w.y = cvt_pk_bf16(a.z, a.w); w.z = cvt_pk_bf16(b.x, b.y); w.w = cvt_pk_bf16(b.z, b.w);
                        *(u32x4*)(MM + base + (size_t)(ai * 128 + m * 16) * 1024 + bj * 128) = w; }
                    else { acc[ai][bj][m][0] = a; acc[ai][bj][m][1] = b; } }
            asm volatile("" ::: "memory");
        }
    }
};
struct EpiOut {
    const float* x; const float* MOD; float* out;
    DI void mid(f32x4 (&)[2][2][4][2], const pg8::Unit&, int, int, int, int) const {}
    DI void operator()(const f32x4 (&acc)[2][2][4][2], const pg8::Unit& u, int wr, int wc, int fr, int fq) const {
        const int col0 = u.pn * 256 + wc * 32 + 8 * fq; const float* gp = MOD + (u.pm >> 4) * 3072 + 2048 + col0;
        f32x4 gx[2][2];
#pragma unroll
        for (int bj = 0; bj < 2; ++bj)
#pragma unroll
            for (int n = 0; n < 2; ++n) gx[bj][n] = *(const f32x4*)(gp + bj * 128 + 4 * n);
#pragma unroll
        for (int ai = 0; ai < 2; ++ai)
#pragma unroll
            for (int m = 0; m < 4; ++m) { const size_t off = (size_t)(u.pm * 256 + ai * 128 + wr * 64 + m * 16 + fr) * 1024 + col0;
#pragma unroll
                for (int bj = 0; bj < 2; ++bj)
#pragma unroll
                    for (int n = 0; n < 2; ++n) { const f32x4 xv = *(const f32x4*)(x + off + bj * 128 + 4 * n); *(f32x4*)(out + off + bj * 128 + 4 * n) = xv + gx[bj][n] * acc[ai][bj][m][n]; }
                if (m & 1) asm volatile("" ::: "memory"); }
    }
};
DI void n6_ab(const Ctx& F) {
    const Tid T = opaque_tid();
    const size_t NT = (size_t)gridDim.x * 512, gt = (size_t)blockIdx.x * 512 + T.tid;
    for (size_t idx = gt; idx < (size_t)(MTOK / 4) * 1024; idx += NT) {
        const int n = (int)(idx & 1023), t0 = (int)(idx >> 10) * 4; float ya[4] = {0.f, 0.f, 0.f, 0.f}, yb[4] = {0.f, 0.f, 0.f, 0.f};
        for (int k = 0; k < 1024; ++k) { const float wa = F.w_a[(size_t)k * 1024 + n], wb = F.w_b[(size_t)k * 1024 + n];
#pragma unroll
            for (int j = 0; j < 4; ++j) { ya[j] += bf2f(F.P[(size_t)(t0 + j) * 1024 + k]) * wa; yb[j] += bf2f(F.UB[(size_t)(t0 + j) * 1024 + k]) * wb; } }
#pragma unroll
        for (int j = 0; j < 4; ++j) { const size_t o = (size_t)(t0 + j) * 1024 + n; const float sgb = bf2f(F.SGB[o]), sga = bf2f(F.R[o]) * sgb; F.MM[o] = f2bf(sga * ya[j] + sgb * yb[j]); }
    }
}
DI void n7_out(const Ctx& F) {
    const Tid T = opaque_tid();
    const size_t NT = (size_t)gridDim.x * 512, gt = (size_t)blockIdx.x * 512 + T.tid;
    for (size_t idx = gt; idx < (size_t)(MTOK / 4) * 1024; idx += NT) {
        const int n = (int)(idx & 1023), t0 = (int)(idx >> 10) * 4; float y[4] = {0.f, 0.f, 0.f, 0.f};
        for (int k = 0; k < 1024; ++k) { const float w = F.w_out[(size_t)k * 1024 + n];
#pragma unroll
            for (int j = 0; j < 4; ++j) y[j] += bf2f(F.MM[(size_t)(t0 + j) * 1024 + k]) * w; }
#pragma unroll
        for (int j = 0; j < 4; ++j) { const size_t o = (size_t)(t0 + j) * 1024 + n; F.out[o] = F.x[o] + F.MOD[((t0 + j) >> 12) * 3072 + 2048 + n] * y[j]; }
    }
}
DI void p8_final(const Ctx& F) {
    const Tid T = opaque_tid();
    const int gw = blockIdx.x * 8 + T.wave, NGW = gridDim.x * 8;
    for (int m = gw; m < MTOK; m += NGW) {
        f32x4* xr = (f32x4*)(F.out + (size_t)m * DM);
        f32x4 v[4]; float ss = 0.f;
#pragma unroll
        for (int j = 0; j < 4; ++j) { v[j] = xr[T.lane + 64 * j]; ss += (v[j].x * v[j].x + v[j].y * v[j].y) + (v[j].z * v[j].z + v[j].w * v[j].w); }
        const float rstd = 1.0f / sqrtf(wave_sum(ss) * (1.f / DM) + EPS);
#pragma unroll
        for (int j = 0; j < 4; ++j) { const f32x4 w = *(const f32x4*)(F.final_w + 4 * (T.lane + 64 * j)); xr[T.lane + 64 * j] = v[j] * rstd * w; }
    }
}

constexpr int NPH = 9;
__global__ void __launch_bounds__(512, 2) fwd_kernel(Args args) {
    extern __shared__ __attribute__((aligned(16))) unsigned char lds_raw[];
    cg::grid_group grid = cg::this_grid();
    Ctx F;
    F.lds = (LAS unsigned char*)lds_raw;
    F.x = args.in[0]; F.c = args.in[1]; F.ctx = args.in[2]; F.c_ctx = args.in[3]; F.norm_w = args.in[4]; F.ada_w = args.in[5]; F.ada_b = args.in[6]; F.w_in = args.in[7];
    F.conv_w = args.in[8]; F.conv_b = args.in[9]; F.decay_logit = args.in[10]; F.gn_w = args.in[11]; F.w_a = args.in[12]; F.w_b = args.in[13]; F.w_out = args.in[14]; F.final_w = args.in[15];
    F.out = args.out; unsigned char* ws = args.ws; F.ws = ws;
    F.MOD = (float*)(ws + WS_MOD); F.ROPE = (f32x2*)(ws + WS_ROPE);
    F.WA = (bf16_t*)(ws + WS_WA); F.WB = (bf16_t*)(ws + WS_WB); F.WOUT = (bf16_t*)(ws + WS_WOUT); F.WIN = (bf16_t*)(ws + WS_WIN); F.XM = (bf16_t*)(ws + WS_XM);
    F.KV = (bf16_t*)(ws + WS_KV); F.KVC = (bf16_t*)(ws + WS_KVC); F.HC = (bf16_t*)(ws + WS_HC); F.ST = (bf16_t*)(ws + WS_ST); F.MM = (bf16_t*)(ws + WS_MM);
    F.P = (bf16_t*)(ws + WS_P); F.Q = (bf16_t*)(ws + WS_Q); F.K = (bf16_t*)(ws + WS_K); F.V = (bf16_t*)(ws + WS_V); F.SZB = (bf16_t*)(ws + WS_SZB);
    F.KC = (bf16_t*)(ws + WS_KC); F.VC = (bf16_t*)(ws + WS_VC); F.UB = (bf16_t*)(ws + WS_UB);
    F.R = (bf16_t*)args.out; F.SGB = (bf16_t*)args.out + (size_t)MTOK * DM;
    F.RET = (float*)(ws + WS_RET);
    const int lo = args.ph_lo, hi = args.ph_hi; const unsigned naive = args.naive;
#define IN(k) (lo <= (k) && (k) < hi && ((MK_PHASES >> (k)) & 1))
#define NAIVE(k) (((naive & MK_NAIVE_AVAIL) >> (k)) & 1u)
#define SEAM(k) do { if (IN(k) && IN((k) + 1)) grid.sync(); } while (0)
    if (IN(0)) { p0_prologue(F); } SEAM(0);
    if (IN(1)) { p1_rows(F); } SEAM(1);
    if (IN(2)) {
        if (NAIVE(2)) n2_inproj(F);
        else { const char* const Ab[2] = {(const char*)F.XM, (const char*)F.XM}; const char* const Bb[2] = {(const char*)F.WIN, (const char*)F.WIN};
            Sched1 S{(int)gridDim.x, (int)blockIdx.x}; Epi1 E{F.ws, F.R, F.SGB, F.ROPE};
            pg8::gemm_phase<1, Epi1, Sched1>(F.lds, Ab, Bb, S, E); }
    } SEAM(2);
    if (IN(3)) { if (!NAIVE(3)) p3_kv(F); p3_ua(F); } SEAM(3);
    if (IN(4)) { if (NAIVE(4)) n4_recurrence(F); else p4_scan(F); } SEAM(4);
    if (IN(5)) { if (NAIVE(5)) n5_groupnorm(F); else p5_ret(F); } SEAM(5);
    if (IN(6)) {
        if (NAIVE(6)) n6_ab(F);
        else { const char* const Ab[2] = {(const char*)F.P, (const char*)F.UB}; const char* const Bb[2] = {(const char*)F.WA, (const char*)F.WB};
            SchedSq S{(int)gridDim.x, (int)blockIdx.x}; EpiAB E{F.R, F.SGB, F.MM};
            pg8::gemm_phase<2, EpiAB, SchedSq>(F.lds, Ab, Bb, S, E); }
    } SEAM(6);
    if (IN(7)) {
        if (NAIVE(7)) n7_out(F);
        else { const char* const Ab[2] = {(const char*)F.MM, (const char*)F.MM}; const char* const Bb[2] = {(const char*)F.WOUT, (const char*)F.WOUT};
            SchedSq S{(int)gridDim.x, (int)blockIdx.x}; EpiOut E{F.x, F.MOD, F.out};
            pg8::gemm_phase<1, EpiOut, SchedSq>(F.lds, Ab, Bb, S, E); }
    } SEAM(7);
    if (IN(8)) { p8_final(F); }
#undef IN
#undef NAIVE
#undef SEAM
}

extern "C" void kernel_launch(void* const* d_in, const int* in_sizes, int n_in, void* d_out, int out_size, void* d_ws, size_t ws_size, hipStream_t stream) {
    static int grid = 0;
    if (grid == 0) {
        if (n_in != 16 || out_size != MTOK * DM || ws_size < WS_END) { fprintf(stderr, "kernel_launch: unexpected shapes (n_in %d out %d ws %zu)\n", n_in, out_size, ws_size); grid = -1; return; }
        int dev = 0, cus = 0, per_cu = 0;
        hipGetDevice(&dev); hipDeviceGetAttribute(&cus, hipDeviceAttributeMultiprocessorCount, dev);
        hipFuncSetAttribute((const void*)fwd_kernel, hipFuncAttributeMaxDynamicSharedMemorySize, LDS_BYTES);
        hipOccupancyMaxActiveBlocksPerMultiprocessor(&per_cu, (const void*)fwd_kernel, 512, LDS_BYTES);
        if (per_cu < 1) { fprintf(stderr, "kernel_launch: occupancy query says %d blocks/CU\n", per_cu); per_cu = 1; }
        grid = cus;
        (void)hipGetLastError();
    }
    if (grid < 0) return;
    Args a{};
    for (int i = 0; i < 16; ++i) a.in[i] = (const float*)d_in[i];
    a.out = (float*)d_out; a.ws = (unsigned char*)d_ws; a.naive = MK_NAIVE_MASK;
#if MK_LAUNCH_PER_PHASE
    for (int ph = 0; ph < NPH; ++ph) { a.ph_lo = ph; a.ph_hi = ph + 1; hipLaunchKernelGGL(fwd_kernel, dim3(grid), dim3(512), LDS_BYTES, stream, a); }
#else
    a.ph_lo = 0; a.ph_hi = NPH;
    void* kargs[] = {&a};
    hipError_t e = hipLaunchCooperativeKernel((void*)fwd_kernel, dim3(grid), dim3(512), kargs, LDS_BYTES, stream);
    if (e != hipSuccess) fprintf(stderr, "kernel_launch: cooperative launch failed: %s (grid %d)\n", hipGetErrorString(e), grid);
#endif
}
```

```cpp
#include <hip/hip_runtime.h>
#include <cstdio>
#include <cstdint>

#ifndef MK_LAUNCH_PER_PHASE
#define MK_LAUNCH_PER_PHASE 0
#endif
#ifndef MK_NAIVE_MASK
#define MK_NAIVE_MASK 0x00u
#endif

#ifndef MK_REP_MASK
#define MK_REP_MASK 0u
#endif
#ifndef MK_PHASES
#define MK_PHASES 0x1ff
#endif
#ifndef MK_NAIVE_AVAIL
#define MK_NAIVE_AVAIL 0xffu
#endif
#define DI __device__ __forceinline__
#define LAS __attribute__((address_space(3)))
typedef unsigned short bf16_t;
typedef float f32x4 __attribute__((ext_vector_type(4)));
typedef float f32x2 __attribute__((ext_vector_type(2)));
typedef unsigned u32x4 __attribute__((ext_vector_type(4)));
typedef unsigned u32x2 __attribute__((ext_vector_type(2)));
typedef short bf16x8 __attribute__((ext_vector_type(8)));
typedef short s16x4 __attribute__((ext_vector_type(4)));
typedef short v4i16_t __attribute__((ext_vector_type(4)));

constexpr int NB = 4, SEQ = 4096, DM = 1024, MTOK = NB * SEQ, CTXL = 256, MCTX = NB * CTXL, MALL = MTOK + MCTX;
constexpr int NIN = 9216, NH = 8, DK = 64, DV = 128, CHK = 128, NCHK = SEQ / CHK;
constexpr float EPS = 1e-6f;
constexpr size_t MiB = 1u << 20;
constexpr size_t WS_MOD = 0;
constexpr size_t WS_ROPE = 65536;
constexpr size_t WS_WA = 2 * MiB, WS_WB = 4 * MiB, WS_WOUT = 6 * MiB, WS_WIN = 8 * MiB;
constexpr size_t WS_XM = 26 * MiB;
constexpr size_t WS_KV = 8 * MiB;
constexpr size_t WS_KVC = 40 * MiB;
constexpr size_t WS_RET = 8 * MiB;
constexpr size_t WS_HC = 60 * MiB;
constexpr size_t WS_ST = 60 * MiB;
constexpr size_t WS_MM = 60 * MiB;
constexpr size_t WS_P = 92 * MiB;
constexpr size_t WS_Q = 124 * MiB, WS_K = 140 * MiB, WS_V = 156 * MiB, WS_SZB = 188 * MiB;
constexpr size_t WS_KC = 220 * MiB, WS_VC = 221 * MiB;
constexpr size_t WS_UB = 223 * MiB;
constexpr size_t WS_END = 255 * MiB;
constexpr int LDS_BYTES = 147456;
constexpr int LDS_MISC = 139264;
constexpr size_t WS_BAR = 131072, WS_BAR_BYTES = 16384;

DI float bf2f(bf16_t v) { return __uint_as_float((unsigned)v << 16); }
DI float bflo(unsigned w) { return __uint_as_float(w << 16); }
DI float bfhi(unsigned w) { return __uint_as_float(w & 0xffff0000u); }
typedef __bf16 bf16x2_t __attribute__((ext_vector_type(2)));
DI unsigned cvt_pk_bf16(float lo, float hi) { const f32x2 f = {lo, hi}; const bf16x2_t v = __builtin_convertvector(f, bf16x2_t); return __builtin_bit_cast(unsigned, v); }
DI bf16_t f2bf(float f) { return (bf16_t)(cvt_pk_bf16(f, 0.f) & 0xffffu); }
DI float wave_sum(float v) {
#pragma unroll
    for (int o = 1; o < 64; o <<= 1) v += __shfl_xor(v, o);
    return v;
}
struct Tid { int tid, lane, wave; };
DI Tid opaque_tid() { int t = threadIdx.x; asm volatile("" : "+v"(t)); Tid r; r.tid = t; r.lane = t & 63; r.wave = __builtin_amdgcn_readfirstlane(t >> 6); return r; }
DI float siluf(float x) { return x * __builtin_amdgcn_rcpf(1.f + __expf(-x)); }
DI float log2_gamma(const float* decay_logit, int dir, int h) {
    const float x = decay_logit[dir * NH + h];
    const float ls = fminf(x, 0.f) - log1pf(expf(-fabsf(x)));
    return ls * 1.4426950408889634f;
}

namespace pg8 {
constexpr int BM = 256, BK = 64, HALF = 128, HTB = HALF * BK * 2, STAGE_BYTES = 8 * HTB, NXCD = 8, WGM = 8;
DI int lds_byte(int r, int c) { const int st = (r >> 4) * 2 + (c >> 5), rr = r & 15, cc = c & 31, ob = rr * 64 + cc * 2; return st * 1024 + (ob ^ (((ob >> 9) & 1) << 5)); }
DI void stage_rc(int b, int& R, int& C) { const int st = b / 1024, sb = b % 1024, swz = sb ^ (((sb >> 9) & 1) << 5); R = (st >> 1) * 16 + swz / 64; C = (st & 1) * 32 + (swz % 64) / 2; }
DI int perm32(int rho) { const int n = rho >> 4, i = rho & 15; return 8 * (i >> 2) + 4 * n + (i & 3); }
struct Unit { int pm, pn; };
DI void tile_of(int L, int nM, int nN, Unit& u) {
    const int nwg = nM * nN; int wgid = L;
    { const int q = nwg / NXCD, r = nwg % NXCD, xcd = wgid % NXCD, off = wgid / NXCD; wgid = (xcd < r ? xcd * (q + 1) : r * (q + 1) + (xcd - r) * q) + off; }
    const int nig = WGM * nN, gid = wgid / nig, fm = gid * WGM, gsz = (nM - fm) < WGM ? (nM - fm) : WGM;
    u.pm = fm + ((wgid % nig) % gsz); u.pn = (wgid % nig) / gsz;
}
template <int NSEG, class Epi, class Sched>
DI void gemm_phase(LAS unsigned char* lds, const char* const (&Ab)[2], const char* const (&Bb)[2], const Sched& S, const Epi& E) {
    constexpr int K = 1024, NTS = K / BK;
    constexpr int nt = NSEG * NTS;
    const Tid T = opaque_tid();
    const int tid = T.tid, wid = T.wave, lane = T.lane, wr = wid >> 2, wc = wid & 3, fr = lane & 15, fq = lane >> 4;
    unsigned voffA[2], voffB[2];
#pragma unroll
    for (int i = 0; i < 2; ++i) { int R, C; stage_rc(tid * 16 + i * 8192, R, C); const int Rb = (R & ~31) + perm32(R & 31);
        voffA[i] = (unsigned)(R * K + C) * 2u; voffB[i] = (unsigned)(Rb * K + C) * 2u; }
    constexpr size_t kstep = (size_t)(BK * 2);
    constexpr size_t hstep = (size_t)HALF * K * 2;
    constexpr size_t tstep = 2 * hstep;
    const unsigned ldsw = (unsigned)wid * 1024u;
    const int aoff = lds_byte(wr * 64 + fr, fq * 8), boff = lds_byte(wc * 32 + fr, fq * 8);
#define PG8_SA(b, h) (((b) * 2 + (h)) * HTB)
#define PG8_SB(b, h) ((4 + (b) * 2 + (h)) * HTB)
#define PG8_STAGE(bufoff, gbase, voff) do { _Pragma("unroll") for (int _i = 0; _i < 2; ++_i) \
        __builtin_amdgcn_global_load_lds((const unsigned*)((const char*)(gbase) + (voff)[_i]), (LAS unsigned*)(lds + (bufoff) + ldsw + _i * 8192), 16, 0, 0); } while (0)
#define PG8_LDA(dst, b, h) do { _Pragma("unroll") for (int m = 0; m < 4; ++m) _Pragma("unroll") for (int k = 0; k < 2; ++k) dst[m][k] = *(const LAS bf16x8*)(lds + PG8_SA(b, h) + aoff + m * 2048 + k * 1024); } while (0)
#define PG8_LDB(dst, b, h) do { _Pragma("unroll") for (int n = 0; n < 2; ++n) _Pragma("unroll") for (int k = 0; k < 2; ++k) dst[n][k] = *(const LAS bf16x8*)(lds + PG8_SB(b, h) + boff + n * 2048 + k * 1024); } while (0)
#define PG8_MMA(ai, bj, At, Bt) do { __builtin_amdgcn_s_setprio(1); _Pragma("unroll") for (int m = 0; m < 4; ++m) _Pragma("unroll") for (int n = 0; n < 2; ++n) _Pragma("unroll") for (int k = 0; k < 2; ++k) \
        acc[ai][bj][m][n] = __builtin_amdgcn_mfma_f32_16x16x32_bf16(Bt[n][k], At[m][k], acc[ai][bj][m][n], 0, 0, 0); __builtin_amdgcn_s_setprio(0); } while (0)
#define PG8_WAIT_V(n) asm volatile("s_waitcnt vmcnt(" #n ")" ::: "memory")
#define PG8_WAIT_L(n) asm volatile("s_waitcnt lgkmcnt(" #n ")" ::: "memory")
#define PG8_BAR __builtin_amdgcn_s_barrier()
#define PG8_SCHED __builtin_amdgcn_sched_barrier(0)
#define PG8_TA(u, t) (Ab[(t) / NTS] + (size_t)(u).pm * tstep + (size_t)((t) % NTS) * kstep)
#define PG8_TB(u, t) (Bb[(t) / NTS] + (size_t)(u).pn * tstep + (size_t)((t) % NTS) * kstep)
    Unit cur, nxt; int ui = 0;
    if (!S.next(0, cur)) return;
    f32x4 acc[2][2][4][2];
#pragma unroll
    for (int a = 0; a < 2; ++a)
#pragma unroll
        for (int b = 0; b < 2; ++b)
#pragma unroll
            for (int m = 0; m < 4; ++m)
#pragma unroll
                for (int n = 0; n < 2; ++n) acc[a][b][m][n] = (f32x4){0.f, 0.f, 0.f, 0.f};
    bf16x8 At[4][2], B0[2][2], B1[2][2];
    {
        const char* cA = PG8_TA(cur, 0); const char* cB = PG8_TB(cur, 0);
        PG8_STAGE(PG8_SB(0, 0), cB, voffB); PG8_STAGE(PG8_SB(0, 1), cB + hstep, voffB); PG8_STAGE(PG8_SA(0, 0), cA, voffA); PG8_STAGE(PG8_SA(0, 1), cA + hstep, voffA);
        if (wr == 1) PG8_BAR;
        PG8_WAIT_V(2); PG8_BAR;
        PG8_STAGE(PG8_SB(1, 0), cB + kstep, voffB); PG8_STAGE(PG8_SA(1, 0), cA + kstep, voffA); PG8_STAGE(PG8_SB(1, 1), cB + hstep + kstep, voffB);
        PG8_WAIT_V(6); PG8_BAR;
    }
    for (;;) {
        const bool has_next = S.next(ui + 1, nxt);
        const Unit nu = has_next ? nxt : cur;
        for (int t = 0; t < nt; t += 2) {
            if (NSEG == 2 && t == NTS) E.mid(acc, cur, wr, wc, fr, fq);
            const bool last = (t == nt - 2);
            const char* a1 = PG8_TA(cur, t + 1);
            const char* a2 = last ? PG8_TA(nu, 0) : PG8_TA(cur, t + 2); const char* b2 = last ? PG8_TB(nu, 0) : PG8_TB(cur, t + 2);
            const char* a3 = a2 + kstep; const char* b3 = b2 + kstep;
            PG8_LDB(B0, 0, 0); PG8_LDB(B1, 0, 1); PG8_SCHED; PG8_LDA(At, 0, 0); PG8_STAGE(PG8_SA(1, 1), a1 + hstep, voffA);
            PG8_WAIT_V(8); PG8_WAIT_L(0); PG8_BAR; PG8_MMA(0, 0, At, B0); PG8_MMA(0, 1, At, B1); PG8_BAR; PG8_SCHED;
            PG8_LDA(At, 0, 1); PG8_STAGE(PG8_SB(0, 0), b2, voffB); PG8_STAGE(PG8_SB(0, 1), b2 + hstep, voffB); PG8_STAGE(PG8_SA(0, 0), a2, voffA);
            PG8_WAIT_V(8); PG8_WAIT_L(0); PG8_BAR; PG8_MMA(1, 0, At, B0); PG8_MMA(1, 1, At, B1); PG8_BAR; PG8_SCHED;
            PG8_LDB(B0, 1, 0); PG8_LDB(B1, 1, 1); PG8_SCHED; PG8_LDA(At, 1, 0); PG8_STAGE(PG8_SA(0, 1), a2 + hstep, voffA);
            PG8_WAIT_V(8); PG8_WAIT_L(0); PG8_BAR; PG8_MMA(0, 0, At, B0); PG8_MMA(0, 1, At, B1); PG8_BAR; PG8_SCHED;
            PG8_LDA(At, 1, 1); PG8_STAGE(PG8_SB(1, 0), b3, voffB); PG8_STAGE(PG8_SB(1, 1), b3 + hstep, voffB); PG8_STAGE(PG8_SA(1, 0), a3, voffA);
            PG8_WAIT_V(8); PG8_WAIT_L(0); PG8_BAR; PG8_MMA(1, 0, At, B0); PG8_MMA(1, 1, At, B1); PG8_BAR; PG8_SCHED;
        }
        if (wr == 0) PG8_BAR;
        E(acc, cur, wr, wc, fr, fq);
        if (!has_next) break;
#pragma unroll
        for (int a = 0; a < 2; ++a)
#pragma unroll
            for (int b = 0; b < 2; ++b)
#pragma unroll
                for (int m = 0; m < 4; ++m)
#pragma unroll
                    for (int n = 0; n < 2; ++n) acc[a][b][m][n] = (f32x4){0.f, 0.f, 0.f, 0.f};
        cur = nxt; ++ui;
        if (wr == 1) PG8_BAR;
    }
    PG8_WAIT_V(0);
    PG8_BAR;
#undef PG8_SA
#undef PG8_SB
#undef PG8_STAGE
#undef PG8_LDA
#undef PG8_LDB
#undef PG8_MMA
#undef PG8_WAIT_V
#undef PG8_WAIT_L
#undef PG8_BAR
#undef PG8_SCHED
#undef PG8_TA
#undef PG8_TB
}
}


#define XB_TMO      128
#define XB_XCNT(j)  (256  + 64 * (j))
#define XB_XSUB(j)  (1280 + 64 * (j))
#define XB_XGEN(j)  (2304 + 64 * (j))
#define XB_TOP      3328
#define XB_TOPGEN   3392
#define XCD_BAR_WORDS 3456
#define XB_SPIN_CAP (1u << 18)
DI unsigned xb_ld(unsigned* p)              { return __hip_atomic_load(p, __ATOMIC_RELAXED, __HIP_MEMORY_SCOPE_AGENT); }
DI unsigned xb_add(unsigned* p, unsigned v) { return __hip_atomic_fetch_add(p, v, __ATOMIC_RELAXED, __HIP_MEMORY_SCOPE_AGENT); }
DI unsigned xb_xcc_id() { return (unsigned)__builtin_amdgcn_s_getreg((3 << 11) | 20) & 0xFu; }
#define XB_SPIN(cond, bar) do { unsigned _sp = 0; while (cond) { __builtin_amdgcn_s_sleep(1); \
    if ((++_sp & 255u) == 0u) { if (xb_ld(&(bar)[XB_TMO])) break; if (_sp > XB_SPIN_CAP) { atomicAdd(&(bar)[XB_TMO], 1u); break; } } } } while (0)
struct XcdBarrier { unsigned* bar; unsigned x; volatile LAS unsigned* st; };
DI XcdBarrier xcd_barrier_post(unsigned* bar, volatile LAS unsigned* st) {
    XcdBarrier b; b.bar = bar; b.x = xb_xcc_id(); b.st = st;
    if (threadIdx.x == 0) (void)xb_add(&bar[XB_XCNT(b.x)], 1u);
    return b;
}
DI void xcd_barrier_complete(unsigned* bar, unsigned x, unsigned& nloc, unsigned& nx) {
    const unsigned G = gridDim.x * gridDim.y * gridDim.z;
    unsigned sum, cnt, mine, sp = 0u;
    for (;;) {
        sum = 0u; cnt = 0u; mine = 0u;
#pragma unroll
        for (unsigned j = 0; j < 16; ++j) { const unsigned c = xb_ld(&bar[XB_XCNT(j)]); sum += c; cnt += (c > 0u) ? 1u : 0u; mine = (j == x) ? c : mine; }
        if (sum == G) break;
        __builtin_amdgcn_s_sleep(1);
        if ((++sp & 255u) == 0u) { if (xb_ld(&bar[XB_TMO])) break; if (sp > XB_SPIN_CAP) { atomicAdd(&bar[XB_TMO], 1u); break; } }
    }
    nloc = mine > 0u ? mine : 1u; nx = cnt > 0u ? cnt : 1u;
}
DI void xcd_barrier(const XcdBarrier& b) {
    asm volatile("s_waitcnt vmcnt(0)" ::: "memory");
    __syncthreads();
    if (threadIdx.x == 0) {
        unsigned* bar = b.bar;
        __builtin_amdgcn_s_waitcnt(0);
        unsigned nloc = b.st[0], nx = b.st[1];
        if (nloc == 0u) { xcd_barrier_complete(bar, b.x, nloc, nx); b.st[0] = nloc; b.st[1] = nx; }
        const unsigned old = xb_add(&bar[XB_XSUB(b.x)], 1u);
        const unsigned gen = old / nloc;
        if (old + 1u == (gen + 1u) * nloc) {
            __builtin_amdgcn_fence(__ATOMIC_RELEASE, "agent");
            asm volatile("s_waitcnt vmcnt(0)" ::: "memory");
            const unsigned og = xb_add(&bar[XB_TOP], 1u);
            const unsigned tg = og / nx;
            if (og + 1u == (tg + 1u) * nx) xb_add(&bar[XB_TOPGEN], 1u);
            else XB_SPIN(xb_ld(&bar[XB_TOPGEN]) == tg, bar);
            __builtin_amdgcn_fence(__ATOMIC_ACQUIRE, "agent");
            xb_add(&bar[XB_XGEN(b.x)], 1u);
            asm volatile("s_waitcnt vmcnt(0)" ::: "memory");
        } else {
            XB_SPIN(xb_ld(&bar[XB_XGEN(b.x)]) == gen, bar);
            __builtin_amdgcn_fence(__ATOMIC_ACQUIRE, "agent");
            asm volatile("s_waitcnt vmcnt(0)" ::: "memory");
        }
    }
    __syncthreads();
}

struct Args { const float* in[16]; float* out; unsigned char* ws; int ph_lo, ph_hi; unsigned naive; int pad; };
struct Ctx {
    LAS unsigned char* lds;
    const float *x, *c, *ctx, *c_ctx, *norm_w, *ada_w, *ada_b, *w_in, *conv_w, *conv_b, *decay_logit, *gn_w, *w_a, *w_b, *w_out, *final_w;
    float* out; unsigned char* ws;
    float* MOD; f32x2* ROPE;
    bf16_t *WA, *WB, *WOUT, *WIN, *XM, *KV, *KVC, *HC, *ST, *MM, *P, *Q, *K, *V, *SZB, *KC, *VC, *UB, *R, *SGB;
    float* RET;
};

DI int win_dest(int o) {
    if (o < 4096) { const int g = o >> 10, ch = o & 1023; return 256 * (ch >> 6) + 64 * g + (ch & 63); }
    if (o < 5120) { const int qk = (o - 4096) >> 9, oo = (o - 4096) & 511, head = oo >> 6, i = oo & 63, t = head >> 2, hh = head & 3;
        return 256 * (16 + 2 * qk + t) + (i < 32 ? 32 * hh + i : 128 + 32 * hh + (i - 32)); }
    if (o < 7168) return o;
    { const int gs = (o - 7168) >> 10, ch = (o - 7168) & 1023; return 256 * (28 + (ch >> 7)) + 128 * gs + (ch & 127); }
}
DI void p0_transpose_item(const float* W, int K, int N, bf16_t* WT, bool permute, LAS float* scr, int item, int lane) {
    const int nblk = N / 32, kb = item / nblk, nb = item % nblk, k0 = 64 * kb, n0 = 32 * nb;
#pragma unroll 8
    for (int i = 0; i < 32; ++i) { const int kk = 2 * i + (lane >> 5); scr[kk * 33 + (lane & 31)] = W[(size_t)(k0 + kk) * N + n0 + (lane & 31)]; }
    asm volatile("s_waitcnt lgkmcnt(0)" ::: "memory");
    const int c = lane & 7; const int d0 = permute ? win_dest(n0) : n0;
#pragma unroll
    for (int j = 0; j < 4; ++j) { const int n = (lane >> 3) + 8 * j; const LAS float* s = scr + (8 * c) * 33 + n;
        u32x4 o; o.x = cvt_pk_bf16(s[0 * 33], s[1 * 33]); o.y = cvt_pk_bf16(s[2 * 33], s[3 * 33]); o.z = cvt_pk_bf16(s[4 * 33], s[5 * 33]); o.w = cvt_pk_bf16(s[6 * 33], s[7 * 33]);
        *(u32x4*)(WT + (size_t)(d0 + n) * K + k0 + 8 * c) = o; }
    asm volatile("s_waitcnt lgkmcnt(0)" ::: "memory");
}
DI void p0_prologue(const Ctx& F) {
    const Tid T = opaque_tid();
    if (blockIdx.x < 48) {
        LAS float* red = (LAS float*)F.lds;
        const int n0 = 64 * blockIdx.x, k0 = 128 * T.wave;
        float a[5] = {0.f, 0.f, 0.f, 0.f, 0.f};
#pragma unroll 8
        for (int k = 0; k < 128; ++k) {
            const float w = F.ada_w[(size_t)(k0 + k) * 3072 + n0 + T.lane];
#pragma unroll
            for (int v = 0; v < 5; ++v) { const float cv = v < 4 ? F.c[v * 1024 + k0 + k] : F.c_ctx[k0 + k]; a[v] += siluf(cv) * w; }
        }
#pragma unroll
        for (int v = 0; v < 5; ++v) red[(T.wave * 5 + v) * 64 + T.lane] = a[v];
        __syncthreads();
        if (T.tid < 320) { const int v = T.tid >> 6, l = T.tid & 63; float s = F.ada_b[n0 + l];
#pragma unroll
            for (int w = 0; w < 8; ++w) s += red[(w * 5 + v) * 64 + l];
            F.MOD[v * 3072 + n0 + l] = s; }
        __syncthreads();
    }
    if (blockIdx.x == 48) {
        for (int e = T.tid; e < 1024; e += 512) { const int p = e >> 4, f = e & 15; const float inv = powf(10000.f, -(float)f / 16.f); const float ang = (float)p * inv;
            F.ROPE[e] = (f32x2){cosf(ang), sinf(ang)}; }
    }
    LAS float* scr = (LAS float*)(F.lds + T.wave * 16384);
    const int gw = blockIdx.x * 8 + T.wave, NGW = gridDim.x * 8;
    constexpr int I_IN = 16 * (NIN / 32), I_SQ = 16 * 32;
    for (int it = gw; it < I_IN + 3 * I_SQ; it += NGW) {
        int r = it;
        if (r < I_IN) { p0_transpose_item(F.w_in, 1024, NIN, F.WIN, true, scr, r, T.lane); continue; } r -= I_IN;
        if (r < I_SQ) { p0_transpose_item(F.w_a, 1024, 1024, F.WA, false, scr, r, T.lane); continue; } r -= I_SQ;
        if (r < I_SQ) { p0_transpose_item(F.w_b, 1024, 1024, F.WB, false, scr, r, T.lane); continue; } r -= I_SQ;
        p0_transpose_item(F.w_out, 1024, 1024, F.WOUT, false, scr, r, T.lane);
    }
}
DI void p1_rows(const Ctx& F) {
    const Tid T = opaque_tid();
    const int gw = blockIdx.x * 8 + T.wave, NGW = gridDim.x * 8;
    for (int m = gw; m < MALL; m += NGW) {
        const float* xr; int mb;
        if (m < MTOK) { xr = F.x + (size_t)m * DM; mb = m >> 12; } else { xr = F.ctx + (size_t)(m - MTOK) * DM; mb = 4; }
        f32x4 v[4]; float ss = 0.f;
#pragma unroll
        for (int j = 0; j < 4; ++j) { v[j] = ((const f32x4*)xr)[T.lane + 64 * j]; ss += (v[j].x * v[j].x + v[j].y * v[j].y) + (v[j].z * v[j].z + v[j].w * v[j].w); }
        const float rstd = 1.0f / sqrtf(wave_sum(ss) * (1.f / DM) + EPS);
        const float* mod = F.MOD + mb * 3072;
#pragma unroll
        for (int j = 0; j < 4; ++j) { const int col = 4 * (T.lane + 64 * j);
            const f32x4 w = *(const f32x4*)(F.norm_w + col), sh = *(const f32x4*)(mod + col), sc = *(const f32x4*)(mod + 1024 + col);
            const f32x4 y = (v[j] * rstd * w) * (sc + 1.0f) + sh;
            u32x2 o; o.x = cvt_pk_bf16(y.x, y.y); o.y = cvt_pk_bf16(y.z, y.w);
            *(u32x2*)(F.XM + (size_t)m * DM + col) = o; }
    }
}
struct Sched1 {
    int G, c;
    DI bool next(int i, pg8::Unit& u) const {
        const int L = i * G + c;
        if (L < 64 * 36) { pg8::tile_of(L, 64, 36, u); return true; }
        const int e = L - 64 * 36; if (e >= 24) return false;
        u.pm = 64 + e / 6; u.pn = 18 + e % 6; return true;
    }
};
struct Epi1 {
    unsigned char* ws; bf16_t *R, *SGB; const f32x2* rope;
    DI void mid(f32x4 (&)[2][2][4][2], const pg8::Unit&, int, int, int, int) const {}
    DI void operator()(const f32x4 (&acc)[2][2][4][2], const pg8::Unit& u, int wr, int wc, int fr, int fq) const {
        const int pn = u.pn, row0 = u.pm * 256 + wr * 64 + fr, x0 = wc * 32 + 8 * fq;
        const bool isctx = u.pm >= 64;
        if (pn < 16) {
            bf16_t* dst = (bf16_t*)(ws + (wc < 2 ? WS_HC : WS_P)) + 64 * pn + (x0 & 63);
#pragma unroll
            for (int ai = 0; ai < 2; ++ai)
#pragma unroll
                for (int m = 0; m < 4; ++m) { const size_t row = row0 + ai * 128 + m * 16;
                    f32x4 o[2];
#pragma unroll
                    for (int n = 0; n < 2; ++n) { const f32x4 a = acc[ai][0][m][n], b = acc[ai][1][m][n];
                        if (wc < 2) o[n] = a * b;
                        else { o[n].x = a.x * siluf(b.x); o[n].y = a.y * siluf(b.y); o[n].z = a.z * siluf(b.z); o[n].w = a.w * siluf(b.w); } }
                    u32x4 w; w.x = cvt_pk_bf16(o[0].x, o[0].y); w.y = cvt_pk_bf16(o[0].z, o[0].w); w.z = cvt_pk_bf16(o[1].x, o[1].y); w.w = cvt_pk_bf16(o[1].z, o[1].w);
                    *(u32x4*)(dst + row * 1024) = w; }
        } else if (pn < 20) {
            const int t = (pn - 16) & 1, isk = (pn - 16) >> 1, head = 4 * t + wc, i0 = 8 * fq;
            const float scale = isk ? 0.125f : 1.0f;
            bf16_t* base = (bf16_t*)(ws + (isk ? (isctx ? WS_KC : WS_K) : WS_Q));
#pragma unroll
            for (int ai = 0; ai < 2; ++ai)
#pragma unroll
                for (int m = 0; m < 4; ++m) { const int row = row0 + ai * 128 + m * 16; const int orow = isctx ? row - MTOK : row;
                    const int pos = row & 4095, pidx = (fq < 2) ? (pos >> 6) : (pos & 63);
                    const f32x2* rp = rope + pidx * 16 + (fq & 1) * 8;
                    float o1[8], o2[8];
#pragma unroll
                    for (int e = 0; e < 8; ++e) { f32x2 cs = rp[e]; if (isctx) cs = (f32x2){1.f, 0.f};
                        const float t1 = acc[ai][0][m][e >> 2][e & 3], t2 = acc[ai][1][m][e >> 2][e & 3];
                        o1[e] = (t1 * cs.x - t2 * cs.y) * scale; o2[e] = (t1 * cs.y + t2 * cs.x) * scale; }
                    u32x4 w1, w2; w1.x = cvt_pk_bf16(o1[0], o1[1]); w1.y = cvt_pk_bf16(o1[2], o1[3]); w1.z = cvt_pk_bf16(o1[4], o1[5]); w1.w = cvt_pk_bf16(o1[6], o1[7]);
                    w2.x = cvt_pk_bf16(o2[0], o2[1]); w2.y = cvt_pk_bf16(o2[2], o2[3]); w2.z = cvt_pk_bf16(o2[4], o2[5]); w2.w = cvt_pk_bf16(o2[6], o2[7]);
                    bf16_t* d = base + (size_t)orow * 512 + head * 64 + i0;
                    *(u32x4*)d = w1; *(u32x4*)(d + 32) = w2; }
        } else if (pn < 28) {
            const bool isz = pn >= 24;
            bf16_t* base = (bf16_t*)(ws + (isz ? WS_SZB : (isctx ? WS_VC : WS_V)));
            const int colt = 256 * (pn - (isz ? 24 : 20)) + x0;
#pragma unroll
            for (int ai = 0; ai < 2; ++ai)
#pragma unroll
                for (int m = 0; m < 4; ++m) { const int row = row0 + ai * 128 + m * 16; const int orow = isctx ? row - MTOK : row;
#pragma unroll
                    for (int bj = 0; bj < 2; ++bj) { f32x4 a = acc[ai][bj][m][0], b = acc[ai][bj][m][1];
                        if (isz) { a.x = siluf(a.x); a.y = siluf(a.y); a.z = siluf(a.z); a.w = siluf(a.w); b.x = siluf(b.x); b.y = siluf(b.y); b.z = siluf(b.z); b.w = siluf(b.w); }
                        u32x4 w; w.x = cvt_pk_bf16(a.x, a.y); w.y = cvt_pk_bf16(a.z, a.w); w.z = cvt_pk_bf16(b.x, b.y); w.w = cvt_pk_bf16(b.z, b.w);
                        *(u32x4*)(base + (size_t)orow * 1024 + colt + bj * 128) = w; } }
        } else {
            const int col = 128 * (pn - 28) + x0;
#pragma unroll
            for (int ai = 0; ai < 2; ++ai)
#pragma unroll
                for (int m = 0; m < 4; ++m) { const size_t row = row0 + ai * 128 + m * 16;
                    float rr[8], sg[8];
#pragma unroll
                    for (int e = 0; e < 8; ++e) { const float ga = acc[ai][0][m][e >> 2][e & 3], gb = acc[ai][1][m][e >> 2][e & 3];
                        const float ea = __expf(-ga), eb = __expf(-gb); sg[e] = 1.f / (1.f + eb); rr[e] = (1.f + eb) / (1.f + ea); }
                    u32x4 w1, w2; w1.x = cvt_pk_bf16(rr[0], rr[1]); w1.y = cvt_pk_bf16(rr[2], rr[3]); w1.z = cvt_pk_bf16(rr[4], rr[5]); w1.w = cvt_pk_bf16(rr[6], rr[7]);
                    w2.x = cvt_pk_bf16(sg[0], sg[1]); w2.y = cvt_pk_bf16(sg[2], sg[3]); w2.z = cvt_pk_bf16(sg[4], sg[5]); w2.w = cvt_pk_bf16(sg[6], sg[7]);
                    *(u32x4*)(R + row * 1024 + col) = w1; *(u32x4*)(SGB + row * 1024 + col) = w2; }
        }
    }
};
DI void n2_inproj(const Ctx& F) {
    const Tid T = opaque_tid();
    const size_t NT = (size_t)gridDim.x * 512, gt = (size_t)blockIdx.x * 512 + T.tid;
    for (size_t idx = gt; idx < (size_t)(MALL / 4) * 1024; idx += NT) {
        const int ch = (int)(idx & 1023), t0 = (int)(idx >> 10) * 4;
        const bool doqk = ch < 512 && (ch & 63) < 32;
        float a[12][4];
#pragma unroll
        for (int o = 0; o < 12; ++o)
#pragma unroll
            for (int j = 0; j < 4; ++j) a[o][j] = 0.f;
        for (int k = 0; k < 1024; ++k) {
            const float* wr = F.w_in + (size_t)k * NIN;
            float xv[4];
#pragma unroll
            for (int j = 0; j < 4; ++j) xv[j] = bf2f(F.XM[(size_t)(t0 + j) * 1024 + k]);
            float w[12];
            w[0] = wr[ch]; w[1] = wr[1024 + ch]; w[2] = wr[2048 + ch]; w[3] = wr[3072 + ch]; w[4] = wr[5120 + ch]; w[5] = wr[6144 + ch]; w[6] = wr[7168 + ch]; w[7] = wr[8192 + ch];
            if (doqk) { w[8] = wr[4096 + ch]; w[9] = wr[4096 + ch + 32]; w[10] = wr[4608 + ch]; w[11] = wr[4608 + ch + 32]; } else { w[8] = w[9] = w[10] = w[11] = 0.f; }
#pragma unroll
            for (int o = 0; o < 12; ++o)
#pragma unroll
                for (int j = 0; j < 4; ++j) a[o][j] += xv[j] * w[o];
        }
#pragma unroll
        for (int j = 0; j < 4; ++j) { const int t = t0 + j;
            if (t < MTOK) {
                const size_t o = (size_t)t * 1024 + ch;
                F.HC[o] = f2bf(a[2][j] * a[0][j]); F.P[o] = f2bf(siluf(a[3][j]) * a[1][j]); F.V[o] = f2bf(a[4][j]); F.SZB[o] = f2bf(siluf(a[5][j]));
                const float sga = 1.f / (1.f + __expf(-a[6][j])), sgb = 1.f / (1.f + __expf(-a[7][j]));
                F.R[o] = f2bf(sga / sgb); F.SGB[o] = f2bf(sgb);
                if (doqk) { const int i = ch & 63, pos = t & 4095; const int pidx = i < 16 ? (pos >> 6) : (pos & 63); const f32x2 cs = F.ROPE[pidx * 16 + (i & 15)];
                    const size_t q = (size_t)t * 512 + ch;
                    F.Q[q] = f2bf(a[8][j] * cs.x - a[9][j] * cs.y); F.Q[q + 32] = f2bf(a[8][j] * cs.y + a[9][j] * cs.x);
                    F.K[q] = f2bf((a[10][j] * cs.x - a[11][j] * cs.y) * 0.125f); F.K[q + 32] = f2bf((a[10][j] * cs.y + a[11][j] * cs.x) * 0.125f); }
            } else {
                const int tc = t - MTOK;
                F.VC[(size_t)tc * 1024 + ch] = f2bf(a[4][j]);
                if (doqk) { F.KC[(size_t)tc * 512 + ch] = f2bf(a[10][j] * 0.125f); F.KC[(size_t)tc * 512 + ch + 32] = f2bf(a[11][j] * 0.125f); }
            }
        }
    }
}
DI bf16x8 tr2(const LAS unsigned char* p, int delta) {
    const s16x4 lo = __builtin_bit_cast(s16x4, __builtin_amdgcn_ds_read_tr16_b64_v4i16((LAS v4i16_t*)p));
    const s16x4 hi = __builtin_bit_cast(s16x4, __builtin_amdgcn_ds_read_tr16_b64_v4i16((LAS v4i16_t*)(p + delta)));
    return __builtin_shufflevector(lo, hi, 0, 1, 2, 3, 4, 5, 6, 7);
}
DI u32x4 scale8(u32x4 w, float s) {
    u32x4 o; o.x = cvt_pk_bf16(bflo(w.x) * s, bfhi(w.x) * s); o.y = cvt_pk_bf16(bflo(w.y) * s, bfhi(w.y) * s); o.z = cvt_pk_bf16(bflo(w.z) * s, bfhi(w.z) * s); o.w = cvt_pk_bf16(bflo(w.w) * s, bfhi(w.w) * s); return o;
}
DI void p3_kv(const Ctx& F) {
    const Tid T = opaque_tid();
    LAS unsigned char* KFI = F.lds; LAS unsigned char* KBI = F.lds + 20480; LAS unsigned char* VI = F.lds + 40960;
    const int tid = T.tid, lane = T.lane, w = T.wave, g = lane >> 4, q = (lane & 15) >> 2, p = lane & 3;
    for (int it = blockIdx.x; it < 1024 + 64; it += gridDim.x) {
        int bh; const bf16_t *kp, *vp; bf16_t *of, *ob;
        if (it < 1024) { bh = it >> 5; const int c = it & 31; const size_t tok0 = (size_t)(bh >> 3) * SEQ + c * CHK;
            kp = (const bf16_t*)(F.ws + WS_K) + tok0 * 512 + (bh & 7) * 64; vp = (const bf16_t*)(F.ws + WS_V) + tok0 * 1024 + (bh & 7) * 128;
            of = (bf16_t*)(F.ws + WS_KV) + ((size_t)(0 * 32 + bh) * 32 + c) * 8192; ob = (bf16_t*)(F.ws + WS_KV) + ((size_t)(1 * 32 + bh) * 32 + c) * 8192; }
        else { const int e = it - 1024; bh = e >> 1; const int cc = e & 1; const size_t tok0 = (size_t)(bh >> 3) * CTXL + cc * CHK;
            kp = (const bf16_t*)(F.ws + WS_KC) + tok0 * 512 + (bh & 7) * 64; vp = (const bf16_t*)(F.ws + WS_VC) + tok0 * 1024 + (bh & 7) * 128;
            of = (bf16_t*)(F.ws + WS_KVC) + ((size_t)(0 * 32 + bh) * 2 + cc) * 8192; ob = (bf16_t*)(F.ws + WS_KVC) + ((size_t)(1 * 32 + bh) * 2 + cc) * 8192; }
        const float l2f = log2_gamma(F.decay_logit, 0, bh & 7), l2b = log2_gamma(F.decay_logit, 1, bh & 7);
        { const int row = tid >> 2, seg = tid & 3;
            const u32x4 k0 = *(const u32x4*)(kp + (size_t)row * 512 + seg * 16), k1 = *(const u32x4*)(kp + (size_t)row * 512 + seg * 16 + 8);
            const float df = exp2f(l2f * (float)(127 - row)), db = exp2f(l2b * (float)row);
            *(LAS u32x4*)(KFI + row * 160 + seg * 32) = scale8(k0, df); *(LAS u32x4*)(KFI + row * 160 + seg * 32 + 16) = scale8(k1, df);
            *(LAS u32x4*)(KBI + row * 160 + seg * 32) = scale8(k0, db); *(LAS u32x4*)(KBI + row * 160 + seg * 32 + 16) = scale8(k1, db);
#pragma unroll
            for (int i = 0; i < 4; ++i) *(LAS u32x4*)(VI + row * 288 + seg * 64 + 16 * i) = *(const u32x4*)(vp + (size_t)row * 1024 + seg * 32 + 8 * i);
        }
        __syncthreads();
        f32x4 acc[2][4];
#pragma unroll
        for (int d = 0; d < 2; ++d)
#pragma unroll
            for (int nb = 0; nb < 4; ++nb) acc[d][nb] = (f32x4){0.f, 0.f, 0.f, 0.f};
#pragma unroll
        for (int s = 0; s < 4; ++s) {
            const bf16x8 a = tr2(VI + (32 * s + 8 * g + q) * 288 + (16 * w + 4 * p) * 2, 4 * 288);
#pragma unroll
            for (int nb = 0; nb < 4; ++nb) {
                const bf16x8 bfw = tr2(KFI + (32 * s + 8 * g + q) * 160 + (16 * nb + 4 * p) * 2, 4 * 160);
                const bf16x8 bbw = tr2(KBI + (32 * s + 8 * g + q) * 160 + (16 * nb + 4 * p) * 2, 4 * 160);
                acc[0][nb] = __builtin_amdgcn_mfma_f32_16x16x32_bf16(a, bfw, acc[0][nb], 0, 0, 0);
                acc[1][nb] = __builtin_amdgcn_mfma_f32_16x16x32_bf16(a, bbw, acc[1][nb], 0, 0, 0);
            }
        }
#pragma unroll
        for (int nb = 0; nb < 4; ++nb)
#pragma unroll
            for (int r = 0; r < 4; ++r) { const int o = (16 * w + 4 * g + r) * 64 + 16 * nb + (lane & 15);
                of[o] = f2bf(acc[0][nb][r]); ob[o] = f2bf(acc[1][nb][r]); }
        __syncthreads();
    }
}
DI void p3_ua(const Ctx& F) {
    const Tid T = opaque_tid();
    const size_t NT = (size_t)gridDim.x * 512, gt = (size_t)blockIdx.x * 512 + T.tid;
    for (size_t idx = gt; idx < (size_t)MTOK * 128; idx += NT) {
        const int t = (int)(idx >> 7), c8 = (int)(idx & 127) * 8, pos = t & 4095;
        const bf16_t* hp = F.HC + (size_t)t * 1024 + c8;
        const u32x4 z = (u32x4){0u, 0u, 0u, 0u};
        const u32x4 h0 = pos > 0 ? *(const u32x4*)(hp - 1024) : z, h1 = *(const u32x4*)hp, h2 = pos < SEQ - 1 ? *(const u32x4*)(hp + 1024) : z;
        const u32x4 pv = *(const u32x4*)(F.P + (size_t)t * 1024 + c8);
        float o[8];
#pragma unroll
        for (int e = 0; e < 8; ++e) { const unsigned a = h0[e >> 1], b = h1[e >> 1], c = h2[e >> 1], pp = pv[e >> 1];
            const float x0 = (e & 1) ? bfhi(a) : bflo(a), x1 = (e & 1) ? bfhi(b) : bflo(b), x2 = (e & 1) ? bfhi(c) : bflo(c), pf = (e & 1) ? bfhi(pp) : bflo(pp);
            const float cv = F.conv_w[c8 + e] * x0 + F.conv_w[1024 + c8 + e] * x1 + F.conv_w[2048 + c8 + e] * x2 + F.conv_b[c8 + e];
            o[e] = pf * cv; }
        u32x4 w; w.x = cvt_pk_bf16(o[0], o[1]); w.y = cvt_pk_bf16(o[2], o[3]); w.z = cvt_pk_bf16(o[4], o[5]); w.w = cvt_pk_bf16(o[6], o[7]);
        *(u32x4*)(F.P + (size_t)t * 1024 + c8) = w;
    }
}
DI void p4_scan(const Ctx& F) {
    const Tid T = opaque_tid();
    const size_t NT = (size_t)gridDim.x * 512, gt = (size_t)blockIdx.x * 512 + T.tid;
    for (size_t idx = gt; idx < (size_t)2 * 32 * 4096; idx += NT) {
        const int e2 = (int)(idx & 4095), bh = (int)(idx >> 12) & 31, dir = (int)(idx >> 17);
        const float g = exp2f(log2_gamma(F.decay_logit, dir, bh & 7) * 128.f);
        const unsigned* kvc = (const unsigned*)(F.KVC + ((size_t)(dir * 32 + bh) * 2) * 8192) + e2;
        const unsigned* kv = (const unsigned*)(F.KV + ((size_t)(dir * 32 + bh) * 32) * 8192) + e2;
        unsigned* st = (unsigned*)(F.ST + ((size_t)(dir * 32 + bh) * 32) * 8192) + e2;
        const unsigned c0 = kvc[0], c1 = kvc[4096];
        float s0, s1;
        if (dir == 0) { s0 = g * bflo(c0) + bflo(c1); s1 = g * bfhi(c0) + bfhi(c1); } else { s0 = bflo(c0) + g * bflo(c1); s1 = bfhi(c0) + g * bfhi(c1); }
#pragma unroll 8
        for (int i = 0; i < 32; ++i) { const int c = dir == 0 ? i : 31 - i;
            const unsigned v = kv[(size_t)c * 4096];
            st[(size_t)c * 4096] = cvt_pk_bf16(s0, s1);
            s0 = g * s0 + bflo(v); s1 = g * s1 + bfhi(v); }
    }
}
DI void n4_recurrence(const Ctx& F) {
    const Tid T = opaque_tid();
    const int gw = blockIdx.x * 8 + T.wave, NGW = gridDim.x * 8, d = T.lane;
    for (int task = gw; task < 32 * 128; task += NGW) {
        const int bh = task >> 7, v = task & 127, b = bh >> 3, h = bh & 7;
        const float gf = exp2f(log2_gamma(F.decay_logit, 0, h)), gb = exp2f(log2_gamma(F.decay_logit, 1, h));
        float s = 0.f;
        for (int m = 0; m < CTXL; ++m) { const size_t t = (size_t)b * CTXL + m; s = gf * s + bf2f(F.KC[t * 512 + h * 64 + d]) * bf2f(F.VC[t * 1024 + h * 128 + v]); }
        const float sF = s; s = 0.f;
        for (int m = CTXL - 1; m >= 0; --m) { const size_t t = (size_t)b * CTXL + m; s = gb * s + bf2f(F.KC[t * 512 + h * 64 + d]) * bf2f(F.VC[t * 1024 + h * 128 + v]); }
        const float sB = s;
        s = sF;
        for (int n = 0; n < SEQ; ++n) { const size_t t = (size_t)b * SEQ + n; s = gf * s + bf2f(F.K[t * 512 + h * 64 + d]) * bf2f(F.V[t * 1024 + h * 128 + v]);
            const float o = wave_sum(bf2f(F.Q[t * 512 + h * 64 + d]) * s); if (d == 0) F.RET[t * 1024 + h * 128 + v] = o; }
        s = sB;
        for (int n = SEQ - 1; n >= 0; --n) { const size_t t = (size_t)b * SEQ + n; s = gb * s + bf2f(F.K[t * 512 + h * 64 + d]) * bf2f(F.V[t * 1024 + h * 128 + v]);
            const float o = wave_sum(bf2f(F.Q[t * 512 + h * 64 + d]) * s); if (d == 0) F.RET[t * 1024 + h * 128 + v] += o; }
    }
}
DI void n5_groupnorm(const Ctx& F) {
    const Tid T = opaque_tid();
    const int gw = blockIdx.x * 8 + T.wave, NGW = gridDim.x * 8;
    for (int task = gw; task < MTOK * NH; task += NGW) {
        const int t = task >> 3, h = task & 7; const size_t o = (size_t)t * 1024 + h * 128 + 2 * T.lane;
        const float a = F.RET[o], b = F.RET[o + 1];
        const float mu = wave_sum(a + b) * (1.f / 128.f); const float da = a - mu, db = b - mu;
        const float var = wave_sum(da * da + db * db) * (1.f / 128.f); const float rstd = 1.0f / sqrtf(var + EPS);
        const float ra = da * rstd * F.gn_w[h * 128 + 2 * T.lane], rb = db * rstd * F.gn_w[h * 128 + 2 * T.lane + 1];
        *(unsigned*)(F.UB + o) = cvt_pk_bf16(bf2f(F.SZB[o]) * ra, bf2f(F.SZB[o + 1]) * rb);
    }
}
DI void p5_ret(const Ctx& F) {
    const Tid T = opaque_tid();
    LAS unsigned char* KI = F.lds; LAS unsigned char* VI = F.lds + 20480; LAS unsigned char* SF = F.lds + 57344; LAS unsigned char* SB = F.lds + 75776;
    const int tid = T.tid, lane = T.lane, w = T.wave, g = lane >> 4, q = (lane & 15) >> 2, p = lane & 3, l15 = lane & 15;
    for (int it = blockIdx.x; it < 1024; it += gridDim.x) {
        const int bh = it >> 5, c = it & 31, h = bh & 7; const size_t tok0 = (size_t)(bh >> 3) * SEQ + c * CHK;
        const bf16_t* kp = F.K + tok0 * 512 + h * 64; const bf16_t* vp = F.V + tok0 * 1024 + h * 128; const bf16_t* qp = F.Q + tok0 * 512 + h * 64;
        const bf16_t* stf = F.ST + ((size_t)(0 * 32 + bh) * 32 + c) * 8192; const bf16_t* stb = F.ST + ((size_t)(1 * 32 + bh) * 32 + c) * 8192;
        const float l2f = log2_gamma(F.decay_logit, 0, h), l2b = log2_gamma(F.decay_logit, 1, h);
        { const int row = tid >> 2, seg = tid & 3;
#pragma unroll
            for (int i = 0; i < 2; ++i) *(LAS u32x4*)(KI + row * 160 + seg * 32 + 16 * i) = *(const u32x4*)(kp + (size_t)row * 512 + seg * 16 + 8 * i);
#pragma unroll
            for (int i = 0; i < 4; ++i) *(LAS u32x4*)(VI + row * 288 + seg * 64 + 16 * i) = *(const u32x4*)(vp + (size_t)row * 1024 + seg * 32 + 8 * i);
#pragma unroll
            for (int i = 0; i < 2; ++i) { *(LAS u32x4*)(SF + row * 144 + seg * 32 + 16 * i) = *(const u32x4*)(stf + row * 64 + seg * 16 + 8 * i);
                *(LAS u32x4*)(SB + row * 144 + seg * 32 + 16 * i) = *(const u32x4*)(stb + row * 64 + seg * 16 + 8 * i); }
        }
        const int il = 16 * w + l15;
        bf16x8 qf[2];
#pragma unroll
        for (int ks = 0; ks < 2; ++ks) qf[ks] = *(const bf16x8*)(qp + (size_t)il * 512 + 32 * ks + 8 * g);
        __syncthreads();
        f32x4 accS[8];
#pragma unroll
        for (int jb = 0; jb < 8; ++jb) { accS[jb] = (f32x4){0.f, 0.f, 0.f, 0.f};
#pragma unroll
            for (int ks = 0; ks < 2; ++ks) { const bf16x8 kf = *(const LAS bf16x8*)(KI + (16 * jb + l15) * 160 + (32 * ks + 8 * g) * 2);
                accS[jb] = __builtin_amdgcn_mfma_f32_16x16x32_bf16(kf, qf[ks], accS[jb], 0, 0, 0); } }
        bf16x8 pf[4];
#pragma unroll
        for (int s = 0; s < 4; ++s) { float pv[8];
#pragma unroll
            for (int e = 0; e < 8; ++e) { const int jb = 2 * s + (e >> 2), r = e & 3, j = 16 * jb + 4 * g + r, df = il - j;
                float mk = 0.f; if (df >= 0) mk += exp2f(l2f * (float)df); if (df <= 0) mk += exp2f(l2b * (float)(-df));
                pv[e] = accS[jb][r] * mk; }
            u32x4 pw; pw.x = cvt_pk_bf16(pv[0], pv[1]); pw.y = cvt_pk_bf16(pv[2], pv[3]); pw.z = cvt_pk_bf16(pv[4], pv[5]); pw.w = cvt_pk_bf16(pv[6], pv[7]);
            pf[s] = __builtin_bit_cast(bf16x8, pw); }
        const float decf = exp2f(l2f * (float)(il + 1)), decb = exp2f(l2b * (float)(128 - il));
        f32x4 accO[8];
#pragma unroll
        for (int vb = 0; vb < 8; ++vb) { f32x4 o = (f32x4){0.f, 0.f, 0.f, 0.f};
#pragma unroll
            for (int s = 0; s < 4; ++s) { const bf16x8 vf = tr2(VI + (32 * s + 4 * g + q) * 288 + (16 * vb + 4 * p) * 2, 16 * 288);
                o = __builtin_amdgcn_mfma_f32_16x16x32_bf16(vf, pf[s], o, 0, 0, 0); }
            f32x4 tf = (f32x4){0.f, 0.f, 0.f, 0.f}, tb = (f32x4){0.f, 0.f, 0.f, 0.f};
#pragma unroll
            for (int ks = 0; ks < 2; ++ks) { const bf16x8 sf = *(const LAS bf16x8*)(SF + (16 * vb + l15) * 144 + (32 * ks + 8 * g) * 2);
                const bf16x8 sb = *(const LAS bf16x8*)(SB + (16 * vb + l15) * 144 + (32 * ks + 8 * g) * 2);
                tf = __builtin_amdgcn_mfma_f32_16x16x32_bf16(sf, qf[ks], tf, 0, 0, 0); tb = __builtin_amdgcn_mfma_f32_16x16x32_bf16(sb, qf[ks], tb, 0, 0, 0); }
            accO[vb] = o + tf * decf + tb * decb; __builtin_amdgcn_sched_barrier(0); }
        float sm = 0.f;
#pragma unroll
        for (int vb = 0; vb < 8; ++vb) sm += (accO[vb].x + accO[vb].y) + (accO[vb].z + accO[vb].w);
        sm += __shfl_xor(sm, 16); sm += __shfl_xor(sm, 32);
        const float mu = sm * (1.f / 128.f); float sq = 0.f;
#pragma unroll
        for (int vb = 0; vb < 8; ++vb) { accO[vb] = accO[vb] - mu; sq += (accO[vb].x * accO[vb].x + accO[vb].y * accO[vb].y) + (accO[vb].z * accO[vb].z + accO[vb].w * accO[vb].w); }
        sq += __shfl_xor(sq, 16); sq += __shfl_xor(sq, 32);
        const float rstd = 1.0f / sqrtf(sq * (1.f / 128.f) + EPS);
        __syncthreads();
#pragma unroll
        for (int vb = 0; vb < 8; ++vb) { const f32x4 gw = *(const f32x4*)(F.gn_w + h * 128 + 16 * vb + 4 * g); const f32x4 o = accO[vb] * rstd * gw;
            u32x2 ow; ow.x = cvt_pk_bf16(o.x, o.y); ow.y = cvt_pk_bf16(o.z, o.w);
            *(LAS u32x2*)(VI + il * 288 + (16 * vb + 4 * g) * 2) = ow; }
        __syncthreads();
        { const int row = tid >> 2, seg = tid & 3; const size_t go = (tok0 + row) * 1024 + h * 128 + seg * 32;
#pragma unroll
            for (int i = 0; i < 4; ++i) { const u32x4 o = *(const LAS u32x4*)(VI + row * 288 + seg * 64 + 16 * i); const u32x4 z = *(const u32x4*)(F.SZB + go + 8 * i);
                u32x4 r; r.x = cvt_pk_bf16(bflo(o.x) * bflo(z.x), bfhi(o.x) * bfhi(z.x)); r.y = cvt_pk_bf16(bflo(o.y) * bflo(z.y), bfhi(o.y) * bfhi(z.y));
                r.z = cvt_pk_bf16(bflo(o.z) * bflo(z.z), bfhi(o.z) * bfhi(z.z)); r.w = cvt_pk_bf16(bflo(o.w) * bflo(z.w), bfhi(o.w) * bfhi(z.w));
                *(u32x4*)(F.UB + go + 8 * i) = r; } }
        __syncthreads();
    }
}
struct SchedSq { int G, c; DI bool next(int i, pg8::Unit& u) const { const int L = i * G + c; if (L >= 256) return false; pg8::tile_of(L, 64, 4, u); return true; } };
struct EpiAB {
    const bf16_t* R; const bf16_t* SGB; bf16_t* MM;
    DI void mid(f32x4 (&acc)[2][2][4][2], const pg8::Unit& u, int wr, int wc, int fr, int fq) const { apply<false>(acc, u, wr, wc, fr, fq); }
    DI void operator()(const f32x4 (&acc)[2][2][4][2], const pg8::Unit& u, int wr, int wc, int fr, int fq) const { apply<true>(const_cast<f32x4 (&)[2][2][4][2]>(acc), u, wr, wc, fr, fq); }
    template <bool FIN> DI void apply(f32x4 (&acc)[2][2][4][2], const pg8::Unit& u, int wr, int wc, int fr, int fq) const {
        const bf16_t* src = FIN ? SGB : R;
        const size_t base = (size_t)(u.pm * 256 + wr * 64 + fr) * 1024 + u.pn * 256 + wc * 32 + 8 * fq;
#pragma unroll
        for (int am = 0; am < 4; ++am) { const int ai = am >> 1;
            u32x4 gv[4][2];
#pragma unroll
            for (int m = 2 * (am & 1); m < 2 * (am & 1) + 2; ++m)
#pragma unroll
                for (int bj = 0; bj < 2; ++bj) gv[m][bj] = *(const u32x4*)(src + base + (size_t)(ai * 128 + m * 16) * 1024 + bj * 128);
#pragma unroll
            for (int m = 2 * (am & 1); m < 2 * (am & 1) + 2; ++m)
#pragma unroll
                for (int bj = 0; bj < 2; ++bj) { const u32x4 gq = gv[m][bj];
                    f32x4 a = acc[ai][bj][m][0], b = acc[ai][bj][m][1];
                    a.x *= bflo(gq.x); a.y *= bfhi(gq.x); a.z *= bflo(gq.y); a.w *= bfhi(gq.y); b.x *= bflo(gq.z); b.y *= bfhi(gq.z); b.z *= bflo(gq.w); b.w *= bfhi(gq.w);
                    if (FIN) { u32x4 w; w.x = cvt_pk_bf16(a.x, a.y); w.y = cvt_pk_bf16(a.z, a.w); w.z = cvt_pk_bf16(b.x, b.y); w.w = cvt_pk_bf16(b.z, b.w);
                        *(u32x4*)(MM + base + (size_t)(ai * 128 + m * 16) * 1024 + bj * 128) = w; }
                    else { acc[ai][bj][m][0] = a; acc[ai][bj][m][1] = b; } }
            asm volatile("" ::: "memory");
        }
    }
};
struct EpiOut {
    const float* x; const float* MOD; float* out;
    DI void mid(f32x4 (&)[2][2][4][2], const pg8::Unit&, int, int, int, int) const {}
    DI void operator()(const f32x4 (&acc)[2][2][4][2], const pg8::Unit& u, int wr, int wc, int fr, int fq) const {
        const int col0 = u.pn * 256 + wc * 32 + 8 * fq; const float* gp = MOD + (u.pm >> 4) * 3072 + 2048 + col0;
        f32x4 gx[2][2];
#pragma unroll
        for (int bj = 0; bj < 2; ++bj)
#pragma unroll
            for (int n = 0; n < 2; ++n) gx[bj][n] = *(const f32x4*)(gp + bj * 128 + 4 * n);
#pragma unroll
        for (int ai = 0; ai < 2; ++ai)
#pragma unroll
            for (int m = 0; m < 4; ++m) { const size_t off = (size_t)(u.pm * 256 + ai * 128 + wr * 64 + m * 16 + fr) * 1024 + col0;
#pragma unroll
                for (int bj = 0; bj < 2; ++bj)
#pragma unroll
                    for (int n = 0; n < 2; ++n) { const f32x4 xv = *(const f32x4*)(x + off + bj * 128 + 4 * n); *(f32x4*)(out + off + bj * 128 + 4 * n) = xv + gx[bj][n] * acc[ai][bj][m][n]; }
                if (m & 1) asm volatile("" ::: "memory"); }
    }
};
DI void n6_ab(const Ctx& F) {
    const Tid T = opaque_tid();
    const size_t NT = (size_t)gridDim.x * 512, gt = (size_t)blockIdx.x * 512 + T.tid;
    for (size_t idx = gt; idx < (size_t)(MTOK / 4) * 1024; idx += NT) {
        const int n = (int)(idx & 1023), t0 = (int)(idx >> 10) * 4; float ya[4] = {0.f, 0.f, 0.f, 0.f}, yb[4] = {0.f, 0.f, 0.f, 0.f};
        for (int k = 0; k < 1024; ++k) { const float wa = F.w_a[(size_t)k * 1024 + n], wb = F.w_b[(size_t)k * 1024 + n];
#pragma unroll
            for (int j = 0; j < 4; ++j) { ya[j] += bf2f(F.P[(size_t)(t0 + j) * 1024 + k]) * wa; yb[j] += bf2f(F.UB[(size_t)(t0 + j) * 1024 + k]) * wb; } }
#pragma unroll
        for (int j = 0; j < 4; ++j) { const size_t o = (size_t)(t0 + j) * 1024 + n; const float sgb = bf2f(F.SGB[o]), sga = bf2f(F.R[o]) * sgb; F.MM[o] = f2bf(sga * ya[j] + sgb * yb[j]); }
    }
}
DI void n7_out(const Ctx& F) {
    const Tid T = opaque_tid();
    const size_t NT = (size_t)gridDim.x * 512, gt = (size_t)blockIdx.x * 512 + T.tid;
    for (size_t idx = gt; idx < (size_t)(MTOK / 4) * 1024; idx += NT) {
        const int n = (int)(idx & 1023), t0 = (int)(idx >> 10) * 4; float y[4] = {0.f, 0.f, 0.f, 0.f};
        for (int k = 0; k < 1024; ++k) { const float w = F.w_out[(size_t)k * 1024 + n];
#pragma unroll
            for (int j = 0; j < 4; ++j) y[j] += bf2f(F.MM[(size_t)(t0 + j) * 1024 + k]) * w; }
#pragma unroll
        for (int j = 0; j < 4; ++j) { const size_t o = (size_t)(t0 + j) * 1024 + n; F.out[o] = F.x[o] + F.MOD[((t0 + j) >> 12) * 3072 + 2048 + n] * y[j]; }
    }
}
DI void p8_final(const Ctx& F) {
    const Tid T = opaque_tid();
    const int gw = blockIdx.x * 8 + T.wave, NGW = gridDim.x * 8;
    for (int m = gw; m < MTOK; m += NGW) {
        f32x4* xr = (f32x4*)(F.out + (size_t)m * DM);
        f32x4 v[4]; float ss = 0.f;
#pragma unroll
        for (int j = 0; j < 4; ++j) { v[j] = xr[T.lane + 64 * j]; ss += (v[j].x * v[j].x + v[j].y * v[j].y) + (v[j].z * v[j].z + v[j].w * v[j].w); }
        const float rstd = 1.0f / sqrtf(wave_sum(ss) * (1.f / DM) + EPS);
#pragma unroll
        for (int j = 0; j < 4; ++j) { const f32x4 w = *(const f32x4*)(F.final_w + 4 * (T.lane + 64 * j)); xr[T.lane + 64 * j] = v[j] * rstd * w; }
    }
}

constexpr int NPH = 9;
__global__ void __launch_bounds__(512, 2) fwd_kernel(Args args) {
    extern __shared__ __attribute__((aligned(16))) unsigned char lds_raw[];
    Ctx F;
    F.lds = (LAS unsigned char*)lds_raw;
    if (threadIdx.x < 16) ((LAS unsigned*)(F.lds + LDS_MISC))[threadIdx.x] = 0u;
    __syncthreads();
    const XcdBarrier bar = xcd_barrier_post((unsigned*)(args.ws + WS_BAR), (volatile LAS unsigned*)(F.lds + LDS_MISC));
    F.x = args.in[0]; F.c = args.in[1]; F.ctx = args.in[2]; F.c_ctx = args.in[3]; F.norm_w = args.in[4]; F.ada_w = args.in[5]; F.ada_b = args.in[6]; F.w_in = args.in[7];
    F.conv_w = args.in[8]; F.conv_b = args.in[9]; F.decay_logit = args.in[10]; F.gn_w = args.in[11]; F.w_a = args.in[12]; F.w_b = args.in[13]; F.w_out = args.in[14]; F.final_w = args.in[15];
    F.out = args.out; unsigned char* ws = args.ws; F.ws = ws;
    F.MOD = (float*)(ws + WS_MOD); F.ROPE = (f32x2*)(ws + WS_ROPE);
    F.WA = (bf16_t*)(ws + WS_WA); F.WB = (bf16_t*)(ws + WS_WB); F.WOUT = (bf16_t*)(ws + WS_WOUT); F.WIN = (bf16_t*)(ws + WS_WIN); F.XM = (bf16_t*)(ws + WS_XM);
    F.KV = (bf16_t*)(ws + WS_KV); F.KVC = (bf16_t*)(ws + WS_KVC); F.HC = (bf16_t*)(ws + WS_HC); F.ST = (bf16_t*)(ws + WS_ST); F.MM = (bf16_t*)(ws + WS_MM);
    F.P = (bf16_t*)(ws + WS_P); F.Q = (bf16_t*)(ws + WS_Q); F.K = (bf16_t*)(ws + WS_K); F.V = (bf16_t*)(ws + WS_V); F.SZB = (bf16_t*)(ws + WS_SZB);
    F.KC = (bf16_t*)(ws + WS_KC); F.VC = (bf16_t*)(ws + WS_VC); F.UB = (bf16_t*)(ws + WS_UB);
    F.R = (bf16_t*)args.out; F.SGB = (bf16_t*)args.out + (size_t)MTOK * DM;
    F.RET = (float*)(ws + WS_RET);
    const int lo = args.ph_lo, hi = args.ph_hi; const unsigned naive = args.naive;
#define IN(k) (lo <= (k) && (k) < hi && ((MK_PHASES >> (k)) & 1))
#define NAIVE(k) (((naive & MK_NAIVE_AVAIL) >> (k)) & 1u)
#define SEAM(k) do { if (IN(k) && IN((k) + 1)) xcd_barrier(bar); } while (0)
#define REP(k) for (int rep_ = 0; rep_ < 1 + (int)((MK_REP_MASK >> (k)) & 1u); ++rep_)
    if (IN(0)) REP(0) { p0_prologue(F); } SEAM(0);
    if (IN(1)) REP(1) { p1_rows(F); } SEAM(1);
    if (IN(2)) REP(2) {
        if (NAIVE(2)) n2_inproj(F);
        else { const char* const Ab[2] = {(const char*)F.XM, (const char*)F.XM}; const char* const Bb[2] = {(const char*)F.WIN, (const char*)F.WIN};
            Sched1 S{(int)gridDim.x, (int)blockIdx.x}; Epi1 E{F.ws, F.R, F.SGB, F.ROPE};
            pg8::gemm_phase<1, Epi1, Sched1>(F.lds, Ab, Bb, S, E); }
    } SEAM(2);
    if (IN(3)) { REP(3) { if (!NAIVE(3)) p3_kv(F); } p3_ua(F); } SEAM(3);
    if (IN(4)) REP(4) { if (NAIVE(4)) n4_recurrence(F); else p4_scan(F); } SEAM(4);
    if (IN(5)) REP(5) { if (NAIVE(5)) n5_groupnorm(F); else p5_ret(F); } SEAM(5);
    if (IN(6)) REP(6) {
        if (NAIVE(6)) n6_ab(F);
        else { const char* const Ab[2] = {(const char*)F.P, (const char*)F.UB}; const char* const Bb[2] = {(const char*)F.WA, (const char*)F.WB};
            SchedSq S{(int)gridDim.x, (int)blockIdx.x}; EpiAB E{F.R, F.SGB, F.MM};
            pg8::gemm_phase<2, EpiAB, SchedSq>(F.lds, Ab, Bb, S, E); }
    } SEAM(6);
    if (IN(7)) REP(7) {
        if (NAIVE(7)) n7_out(F);
        else { const char* const Ab[2] = {(const char*)F.MM, (const char*)F.MM}; const char* const Bb[2] = {(const char*)F.WOUT, (const char*)F.WOUT};
            SchedSq S{(int)gridDim.x, (int)blockIdx.x}; EpiOut E{F.x, F.MOD, F.out};
            pg8::gemm_phase<1, EpiOut, SchedSq>(F.lds, Ab, Bb, S, E); }
    } SEAM(7);
    if (IN(8)) { p8_final(F); }
#undef IN
#undef NAIVE
#undef SEAM
}

extern "C" void kernel_launch(void* const* d_in, const int* in_sizes, int n_in, void* d_out, int out_size, void* d_ws, size_t ws_size, hipStream_t stream) {
    static int grid = 0;
    if (grid == 0) {
        if (n_in != 16 || out_size != MTOK * DM || ws_size < WS_END) { fprintf(stderr, "kernel_launch: unexpected shapes (n_in %d out %d ws %zu)\n", n_in, out_size, ws_size); grid = -1; return; }
        int dev = 0, cus = 0, per_cu = 0;
        hipGetDevice(&dev); hipDeviceGetAttribute(&cus, hipDeviceAttributeMultiprocessorCount, dev);
        hipFuncSetAttribute((const void*)fwd_kernel, hipFuncAttributeMaxDynamicSharedMemorySize, LDS_BYTES);
        hipOccupancyMaxActiveBlocksPerMultiprocessor(&per_cu, (const void*)fwd_kernel, 512, LDS_BYTES);
        if (per_cu < 1) { fprintf(stderr, "kernel_launch: occupancy query says %d blocks/CU\n", per_cu); per_cu = 1; }
        grid = cus;
        (void)hipGetLastError();
    }
    if (grid < 0) return;
    Args a{};
    for (int i = 0; i < 16; ++i) a.in[i] = (const float*)d_in[i];
    a.out = (float*)d_out; a.ws = (unsigned char*)d_ws; a.naive = MK_NAIVE_MASK;
#if MK_LAUNCH_PER_PHASE
    for (int ph = 0; ph < NPH; ++ph) { a.ph_lo = ph; a.ph_hi = ph + 1; hipLaunchKernelGGL(fwd_kernel, dim3(grid), dim3(512), LDS_BYTES, stream, a); }
#else
    a.ph_lo = 0; a.ph_hi = NPH;
    hipMemsetAsync((unsigned char*)d_ws + WS_BAR, 0, WS_BAR_BYTES, stream);
    hipLaunchKernelGGL(fwd_kernel, dim3(grid), dim3(512), LDS_BYTES, stream, a);
#endif
}
```

```cpp
#include <hip/hip_runtime.h>
#include <cstdio>
#include <cstdint>

#ifndef MK_LAUNCH_PER_PHASE
#define MK_LAUNCH_PER_PHASE 0
#endif
#ifndef MK_NAIVE_MASK
#define MK_NAIVE_MASK 0x00u
#endif

#ifndef MK_REP_MASK
#define MK_REP_MASK 0u
#endif
#ifndef MK_PHASES
#define MK_PHASES 0x1ff
#endif
#ifndef MK_NAIVE_AVAIL
#define MK_NAIVE_AVAIL 0xffu
#endif
#define DI __device__ __forceinline__
#define LAS __attribute__((address_space(3)))
typedef unsigned short bf16_t;
typedef float f32x4 __attribute__((ext_vector_type(4)));
typedef float f32x2 __attribute__((ext_vector_type(2)));
typedef unsigned u32x4 __attribute__((ext_vector_type(4)));
typedef unsigned u32x2 __attribute__((ext_vector_type(2)));
typedef short bf16x8 __attribute__((ext_vector_type(8)));
typedef short s16x4 __attribute__((ext_vector_type(4)));
typedef short v4i16_t __attribute__((ext_vector_type(4)));

constexpr int NB = 4, SEQ = 4096, DM = 1024, MTOK = NB * SEQ, CTXL = 256, MCTX = NB * CTXL, MALL = MTOK + MCTX;
constexpr int NIN = 9216, NH = 8, DK = 64, DV = 128, CHK = 128, NCHK = SEQ / CHK;
constexpr float EPS = 1e-6f;
constexpr size_t MiB = 1u << 20;
constexpr size_t WS_MOD = 0;
constexpr size_t WS_ROPE = 65536;
constexpr size_t WS_WA = 2 * MiB, WS_WB = 4 * MiB, WS_WOUT = 6 * MiB, WS_WIN = 8 * MiB;
constexpr size_t WS_XM = 26 * MiB;
constexpr size_t WS_KV = 8 * MiB;
constexpr size_t WS_KVC = 40 * MiB;
constexpr size_t WS_RET = 8 * MiB;
constexpr size_t WS_HC = 60 * MiB;
constexpr size_t WS_ST = 60 * MiB;
constexpr size_t WS_MM = 60 * MiB;
constexpr size_t WS_P = 92 * MiB;
constexpr size_t WS_Q = 124 * MiB, WS_K = 140 * MiB, WS_V = 156 * MiB, WS_SZB = 188 * MiB;
constexpr size_t WS_KC = 220 * MiB, WS_VC = 221 * MiB;
constexpr size_t WS_UB = 223 * MiB;
constexpr size_t WS_END = 255 * MiB;
constexpr int LDS_BYTES = 147456;
constexpr int LDS_MISC = 139264;
constexpr size_t WS_BAR = 131072, WS_BAR_BYTES = 65536;
constexpr size_t WS_PCNT = WS_BAR + 16384, WS_SLOTS = 1 * MiB;
constexpr int LDS_TAB = 132096;

DI float bf2f(bf16_t v) { return __uint_as_float((unsigned)v << 16); }
DI float bflo(unsigned w) { return __uint_as_float(w << 16); }
DI float bfhi(unsigned w) { return __uint_as_float(w & 0xffff0000u); }
typedef __bf16 bf16x2_t __attribute__((ext_vector_type(2)));
DI unsigned cvt_pk_bf16(float lo, float hi) { const f32x2 f = {lo, hi}; const bf16x2_t v = __builtin_convertvector(f, bf16x2_t); return __builtin_bit_cast(unsigned, v); }
DI bf16_t f2bf(float f) { return (bf16_t)(cvt_pk_bf16(f, 0.f) & 0xffffu); }
DI float wave_sum(float v) {
#pragma unroll
    for (int o = 1; o < 64; o <<= 1) v += __shfl_xor(v, o);
    return v;
}
struct Tid { int tid, lane, wave; };
DI Tid opaque_tid() { int t = threadIdx.x; asm volatile("" : "+v"(t)); Tid r; r.tid = t; r.lane = t & 63; r.wave = __builtin_amdgcn_readfirstlane(t >> 6); return r; }
DI float siluf(float x) { return x * __builtin_amdgcn_rcpf(1.f + __expf(-x)); }
DI float log2_gamma(const float* decay_logit, int dir, int h) {
    const float x = decay_logit[dir * NH + h];
    const float ls = fminf(x, 0.f) - log1pf(expf(-fabsf(x)));
    return ls * 1.4426950408889634f;
}

namespace pg8 {
constexpr int BM = 256, BK = 64, HALF = 128, HTB = HALF * BK * 2, STAGE_BYTES = 8 * HTB, NXCD = 8, WGM = 8;
DI int lds_byte(int r, int c) { const int st = (r >> 4) * 2 + (c >> 5), rr = r & 15, cc = c & 31, ob = rr * 64 + cc * 2; return st * 1024 + (ob ^ (((ob >> 9) & 1) << 5)); }
DI void stage_rc(int b, int& R, int& C) { const int st = b / 1024, sb = b % 1024, swz = sb ^ (((sb >> 9) & 1) << 5); R = (st >> 1) * 16 + swz / 64; C = (st & 1) * 32 + (swz % 64) / 2; }
DI int perm32(int rho) { const int n = rho >> 4, i = rho & 15; return 8 * (i >> 2) + 4 * n + (i & 3); }
struct Unit { int pm, pn; };
DI void tile_of(int L, int nM, int nN, Unit& u) {
    const int nwg = nM * nN; int wgid = L;
    { const int q = nwg / NXCD, r = nwg % NXCD, xcd = wgid % NXCD, off = wgid / NXCD; wgid = (xcd < r ? xcd * (q + 1) : r * (q + 1) + (xcd - r) * q) + off; }
    const int nig = WGM * nN, gid = wgid / nig, fm = gid * WGM, gsz = (nM - fm) < WGM ? (nM - fm) : WGM;
    u.pm = fm + ((wgid % nig) % gsz); u.pn = (wgid % nig) / gsz;
}
template <int NSEG, class Epi, class Sched>
DI void gemm_phase(LAS unsigned char* lds, const char* const (&Ab)[2], const char* const (&Bb)[2], const Sched& S, const Epi& E) {
    constexpr int K = 1024, NTS = K / BK;
    constexpr int nt = NSEG * NTS;
    const Tid T = opaque_tid();
    const int tid = T.tid, wid = T.wave, lane = T.lane, wr = wid >> 2, wc = wid & 3, fr = lane & 15, fq = lane >> 4;
    unsigned voffA[2], voffB[2];
#pragma unroll
    for (int i = 0; i < 2; ++i) { int R, C; stage_rc(tid * 16 + i * 8192, R, C); const int Rb = (R & ~31) + perm32(R & 31);
        voffA[i] = (unsigned)(R * K + C) * 2u; voffB[i] = (unsigned)(Rb * K + C) * 2u; }
    constexpr size_t kstep = (size_t)(BK * 2);
    constexpr size_t hstep = (size_t)HALF * K * 2;
    constexpr size_t tstep = 2 * hstep;
    const unsigned ldsw = (unsigned)wid * 1024u;
    const int aoff = lds_byte(wr * 64 + fr, fq * 8), boff = lds_byte(wc * 32 + fr, fq * 8);
#define PG8_SA(b, h) (((b) * 2 + (h)) * HTB)
#define PG8_SB(b, h) ((4 + (b) * 2 + (h)) * HTB)
#define PG8_STAGE(bufoff, gbase, voff) do { _Pragma("unroll") for (int _i = 0; _i < 2; ++_i) \
        __builtin_amdgcn_global_load_lds((const unsigned*)((const char*)(gbase) + (voff)[_i]), (LAS unsigned*)(lds + (bufoff) + ldsw + _i * 8192), 16, 0, 0); } while (0)
#define PG8_LDA(dst, b, h) do { _Pragma("unroll") for (int m = 0; m < 4; ++m) _Pragma("unroll") for (int k = 0; k < 2; ++k) dst[m][k] = *(const LAS bf16x8*)(lds + PG8_SA(b, h) + aoff + m * 2048 + k * 1024); } while (0)
#define PG8_LDB(dst, b, h) do { _Pragma("unroll") for (int n = 0; n < 2; ++n) _Pragma("unroll") for (int k = 0; k < 2; ++k) dst[n][k] = *(const LAS bf16x8*)(lds + PG8_SB(b, h) + boff + n * 2048 + k * 1024); } while (0)
#define PG8_MMA(ai, bj, At, Bt) do { __builtin_amdgcn_s_setprio(1); _Pragma("unroll") for (int m = 0; m < 4; ++m) _Pragma("unroll") for (int n = 0; n < 2; ++n) _Pragma("unroll") for (int k = 0; k < 2; ++k) \
        acc[ai][bj][m][n] = __builtin_amdgcn_mfma_f32_16x16x32_bf16(Bt[n][k], At[m][k], acc[ai][bj][m][n], 0, 0, 0); __builtin_amdgcn_s_setprio(0); } while (0)
#define PG8_WAIT_V(n) asm volatile("s_waitcnt vmcnt(" #n ")" ::: "memory")
#define PG8_WAIT_L(n) asm volatile("s_waitcnt lgkmcnt(" #n ")" ::: "memory")
#define PG8_BAR __builtin_amdgcn_s_barrier()
#define PG8_SCHED __builtin_amdgcn_sched_barrier(0)
#define PG8_TA(u, t) (Ab[(t) / NTS] + (size_t)(u).pm * tstep + (size_t)((t) % NTS) * kstep)
#define PG8_TB(u, t) (Bb[(t) / NTS] + (size_t)(u).pn * tstep + (size_t)((t) % NTS) * kstep)
    Unit cur, nxt; int ui = 0;
    if (!S.next(0, cur)) return;
    f32x4 acc[2][2][4][2];
#pragma unroll
    for (int a = 0; a < 2; ++a)
#pragma unroll
        for (int b = 0; b < 2; ++b)
#pragma unroll
            for (int m = 0; m < 4; ++m)
#pragma unroll
                for (int n = 0; n < 2; ++n) acc[a][b][m][n] = (f32x4){0.f, 0.f, 0.f, 0.f};
    bf16x8 At[4][2], B0[2][2], B1[2][2];
    {
        const char* cA = PG8_TA(cur, 0); const char* cB = PG8_TB(cur, 0);
        PG8_STAGE(PG8_SB(0, 0), cB, voffB); PG8_STAGE(PG8_SB(0, 1), cB + hstep, voffB); PG8_STAGE(PG8_SA(0, 0), cA, voffA); PG8_STAGE(PG8_SA(0, 1), cA + hstep, voffA);
        if (wr == 1) PG8_BAR;
        PG8_WAIT_V(2); PG8_BAR;
        PG8_STAGE(PG8_SB(1, 0), cB + kstep, voffB); PG8_STAGE(PG8_SA(1, 0), cA + kstep, voffA); PG8_STAGE(PG8_SB(1, 1), cB + hstep + kstep, voffB);
        PG8_WAIT_V(6); PG8_BAR;
    }
    for (;;) {
        const bool has_next = S.next(ui + 1, nxt);
        const Unit nu = has_next ? nxt : cur;
        for (int t = 0; t < nt; t += 2) {
            if (NSEG == 2 && t == NTS) E.mid(acc, cur, wr, wc, fr, fq);
            const bool last = (t == nt - 2);
            const char* a1 = PG8_TA(cur, t + 1);
            const char* a2 = last ? PG8_TA(nu, 0) : PG8_TA(cur, t + 2); const char* b2 = last ? PG8_TB(nu, 0) : PG8_TB(cur, t + 2);
            const char* a3 = a2 + kstep; const char* b3 = b2 + kstep;
            PG8_LDB(B0, 0, 0); PG8_LDB(B1, 0, 1); PG8_SCHED; PG8_LDA(At, 0, 0); PG8_STAGE(PG8_SA(1, 1), a1 + hstep, voffA);
            PG8_WAIT_V(8); PG8_WAIT_L(0); PG8_BAR; PG8_MMA(0, 0, At, B0); PG8_MMA(0, 1, At, B1); PG8_BAR; PG8_SCHED;
            PG8_LDA(At, 0, 1); PG8_STAGE(PG8_SB(0, 0), b2, voffB); PG8_STAGE(PG8_SB(0, 1), b2 + hstep, voffB); PG8_STAGE(PG8_SA(0, 0), a2, voffA);
            PG8_WAIT_V(8); PG8_WAIT_L(0); PG8_BAR; PG8_MMA(1, 0, At, B0); PG8_MMA(1, 1, At, B1); PG8_BAR; PG8_SCHED;
            PG8_LDB(B0, 1, 0); PG8_LDB(B1, 1, 1); PG8_SCHED; PG8_LDA(At, 1, 0); PG8_STAGE(PG8_SA(0, 1), a2 + hstep, voffA);
            PG8_WAIT_V(8); PG8_WAIT_L(0); PG8_BAR; PG8_MMA(0, 0, At, B0); PG8_MMA(0, 1, At, B1); PG8_BAR; PG8_SCHED;
            PG8_LDA(At, 1, 1); PG8_STAGE(PG8_SB(1, 0), b3, voffB); PG8_STAGE(PG8_SB(1, 1), b3 + hstep, voffB); PG8_STAGE(PG8_SA(1, 0), a3, voffA);
            PG8_WAIT_V(8); PG8_WAIT_L(0); PG8_BAR; PG8_MMA(1, 0, At, B0); PG8_MMA(1, 1, At, B1); PG8_BAR; PG8_SCHED;
        }
        if (wr == 0) PG8_BAR;
        E(acc, cur, wr, wc, fr, fq);
        if (!has_next) break;
#pragma unroll
        for (int a = 0; a < 2; ++a)
#pragma unroll
            for (int b = 0; b < 2; ++b)
#pragma unroll
                for (int m = 0; m < 4; ++m)
#pragma unroll
                    for (int n = 0; n < 2; ++n) acc[a][b][m][n] = (f32x4){0.f, 0.f, 0.f, 0.f};
        cur = nxt; ++ui;
        if (wr == 1) PG8_BAR;
    }
    PG8_WAIT_V(0);
    PG8_BAR;
#undef PG8_SA
#undef PG8_SB
#undef PG8_STAGE
#undef PG8_LDA
#undef PG8_LDB
#undef PG8_MMA
#undef PG8_WAIT_V
#undef PG8_WAIT_L
#undef PG8_BAR
#undef PG8_SCHED
#undef PG8_TA
#undef PG8_TB
}
}


#define XB_TMO      128
#define XB_XCNT(j)  (256  + 64 * (j))
#define XB_XSUB(j)  (1280 + 64 * (j))
#define XB_XGEN(j)  (2304 + 64 * (j))
#define XB_TOP      3328
#define XB_TOPGEN   3392
#define XCD_BAR_WORDS 3456
#define XB_SPIN_CAP (1u << 18)
DI unsigned xb_ld(unsigned* p)              { return __hip_atomic_load(p, __ATOMIC_RELAXED, __HIP_MEMORY_SCOPE_AGENT); }
DI unsigned xb_add(unsigned* p, unsigned v) { return __hip_atomic_fetch_add(p, v, __ATOMIC_RELAXED, __HIP_MEMORY_SCOPE_AGENT); }
DI unsigned xb_xcc_id() { return (unsigned)__builtin_amdgcn_s_getreg((3 << 11) | 20) & 0xFu; }
#define XB_SPIN(cond, bar) do { unsigned _sp = 0; while (cond) { __builtin_amdgcn_s_sleep(1); \
    if ((++_sp & 255u) == 0u) { if (xb_ld(&(bar)[XB_TMO])) break; if (_sp > XB_SPIN_CAP) { atomicAdd(&(bar)[XB_TMO], 1u); break; } } } } while (0)
struct XcdBarrier { unsigned* bar; unsigned x; volatile LAS unsigned* st; };
DI XcdBarrier xcd_barrier_post(unsigned* bar, volatile LAS unsigned* st) {
    XcdBarrier b; b.bar = bar; b.x = xb_xcc_id(); b.st = st;
    if (threadIdx.x == 0) (void)xb_add(&bar[XB_XCNT(b.x)], 1u);
    return b;
}
DI void xcd_barrier_complete(unsigned* bar, unsigned x, unsigned& nloc, unsigned& nx) {
    const unsigned G = gridDim.x * gridDim.y * gridDim.z;
    unsigned sum, cnt, mine, sp = 0u;
    for (;;) {
        sum = 0u; cnt = 0u; mine = 0u;
#pragma unroll
        for (unsigned j = 0; j < 16; ++j) { const unsigned c = xb_ld(&bar[XB_XCNT(j)]); sum += c; cnt += (c > 0u) ? 1u : 0u; mine = (j == x) ? c : mine; }
        if (sum == G) break;
        __builtin_amdgcn_s_sleep(1);
        if ((++sp & 255u) == 0u) { if (xb_ld(&bar[XB_TMO])) break; if (sp > XB_SPIN_CAP) { atomicAdd(&bar[XB_TMO], 1u); break; } }
    }
    nloc = mine > 0u ? mine : 1u; nx = cnt > 0u ? cnt : 1u;
}
DI void xcd_barrier(const XcdBarrier& b) {
    asm volatile("s_waitcnt vmcnt(0)" ::: "memory");
    __syncthreads();
    if (threadIdx.x == 0) {
        unsigned* bar = b.bar;
        __builtin_amdgcn_s_waitcnt(0);
        unsigned nloc = b.st[0], nx = b.st[1];
        if (nloc == 0u) { xcd_barrier_complete(bar, b.x, nloc, nx); b.st[0] = nloc; b.st[1] = nx; }
        const unsigned old = xb_add(&bar[XB_XSUB(b.x)], 1u);
        const unsigned gen = old / nloc;
        if (old + 1u == (gen + 1u) * nloc) {
            __builtin_amdgcn_fence(__ATOMIC_RELEASE, "agent");
            asm volatile("s_waitcnt vmcnt(0)" ::: "memory");
            const unsigned og = xb_add(&bar[XB_TOP], 1u);
            const unsigned tg = og / nx;
            if (og + 1u == (tg + 1u) * nx) xb_add(&bar[XB_TOPGEN], 1u);
            else XB_SPIN(xb_ld(&bar[XB_TOPGEN]) == tg, bar);
            __builtin_amdgcn_fence(__ATOMIC_ACQUIRE, "agent");
            xb_add(&bar[XB_XGEN(b.x)], 1u);
            asm volatile("s_waitcnt vmcnt(0)" ::: "memory");
        } else {
            XB_SPIN(xb_ld(&bar[XB_XGEN(b.x)]) == gen, bar);
            __builtin_amdgcn_fence(__ATOMIC_ACQUIRE, "agent");
            asm volatile("s_waitcnt vmcnt(0)" ::: "memory");
        }
    }
    __syncthreads();
}

struct Args { const float* in[16]; float* out; unsigned char* ws; int ph_lo, ph_hi; unsigned naive; int pad; };
struct Ctx {
    LAS unsigned char* lds;
    const float *x, *c, *ctx, *c_ctx, *norm_w, *ada_w, *ada_b, *w_in, *conv_w, *conv_b, *decay_logit, *gn_w, *w_a, *w_b, *w_out, *final_w;
    float* out; unsigned char* ws;
    float* MOD; f32x2* ROPE;
    bf16_t *WA, *WB, *WOUT, *WIN, *XM, *KV, *KVC, *HC, *ST, *MM, *P, *Q, *K, *V, *SZB, *KC, *VC, *UB, *R, *SGB;
    float* RET;
};

DI int win_dest(int o) {
    if (o < 4096) { const int g = o >> 10, ch = o & 1023; return 256 * (ch >> 6) + 64 * g + (ch & 63); }
    if (o < 5120) { const int qk = (o - 4096) >> 9, oo = (o - 4096) & 511, head = oo >> 6, i = oo & 63, t = head >> 2, hh = head & 3;
        return 256 * (16 + 2 * qk + t) + (i < 32 ? 32 * hh + i : 128 + 32 * hh + (i - 32)); }
    if (o < 7168) return o;
    { const int gs = (o - 7168) >> 10, ch = (o - 7168) & 1023; return 256 * (28 + (ch >> 7)) + 128 * gs + (ch & 127); }
}
DI void p0_transpose_item(const float* W, int K, int N, bf16_t* WT, bool permute, LAS float* scr, int item, int lane) {
    const int nblk = N / 32, kb = item / nblk, nb = item % nblk, k0 = 64 * kb, n0 = 32 * nb;
#pragma unroll 8
    for (int i = 0; i < 32; ++i) { const int kk = 2 * i + (lane >> 5); scr[kk * 33 + (lane & 31)] = W[(size_t)(k0 + kk) * N + n0 + (lane & 31)]; }
    asm volatile("s_waitcnt lgkmcnt(0)" ::: "memory");
    const int c = lane & 7; const int d0 = permute ? win_dest(n0) : n0;
#pragma unroll
    for (int j = 0; j < 4; ++j) { const int n = (lane >> 3) + 8 * j; const LAS float* s = scr + (8 * c) * 33 + n;
        u32x4 o; o.x = cvt_pk_bf16(s[0 * 33], s[1 * 33]); o.y = cvt_pk_bf16(s[2 * 33], s[3 * 33]); o.z = cvt_pk_bf16(s[4 * 33], s[5 * 33]); o.w = cvt_pk_bf16(s[6 * 33], s[7 * 33]);
        *(u32x4*)(WT + (size_t)(d0 + n) * K + k0 + 8 * c) = o; }
    asm volatile("s_waitcnt lgkmcnt(0)" ::: "memory");
}
DI void p0_prologue(const Ctx& F) {
    const Tid T = opaque_tid();
    if (blockIdx.x < 48) {
        LAS float* red = (LAS float*)F.lds;
        const int n0 = 64 * blockIdx.x, k0 = 128 * T.wave;
        float a[5] = {0.f, 0.f, 0.f, 0.f, 0.f};
#pragma unroll 8
        for (int k = 0; k < 128; ++k) {
            const float w = F.ada_w[(size_t)(k0 + k) * 3072 + n0 + T.lane];
#pragma unroll
            for (int v = 0; v < 5; ++v) { const float cv = v < 4 ? F.c[v * 1024 + k0 + k] : F.c_ctx[k0 + k]; a[v] += siluf(cv) * w; }
        }
#pragma unroll
        for (int v = 0; v < 5; ++v) red[(T.wave * 5 + v) * 64 + T.lane] = a[v];
        __syncthreads();
        if (T.tid < 320) { const int v = T.tid >> 6, l = T.tid & 63; float s = F.ada_b[n0 + l];
#pragma unroll
            for (int w = 0; w < 8; ++w) s += red[(w * 5 + v) * 64 + l];
            F.MOD[v * 3072 + n0 + l] = s; }
        __syncthreads();
    }
    if (blockIdx.x == 48) {
        for (int e = T.tid; e < 1024; e += 512) { const int p = e >> 4, f = e & 15; const float inv = powf(10000.f, -(float)f / 16.f); const float ang = (float)p * inv;
            F.ROPE[e] = (f32x2){cosf(ang), sinf(ang)}; }
    }
    LAS float* scr = (LAS float*)(F.lds + T.wave * 16384);
    const int gw = blockIdx.x * 8 + T.wave, NGW = gridDim.x * 8;
    constexpr int I_IN = 16 * (NIN / 32), I_SQ = 16 * 32;
    for (int it = gw; it < I_IN + 3 * I_SQ; it += NGW) {
        int r = it;
        if (r < I_IN) { p0_transpose_item(F.w_in, 1024, NIN, F.WIN, true, scr, r, T.lane); continue; } r -= I_IN;
        if (r < I_SQ) { p0_transpose_item(F.w_a, 1024, 1024, F.WA, false, scr, r, T.lane); continue; } r -= I_SQ;
        if (r < I_SQ) { p0_transpose_item(F.w_b, 1024, 1024, F.WB, false, scr, r, T.lane); continue; } r -= I_SQ;
        p0_transpose_item(F.w_out, 1024, 1024, F.WOUT, false, scr, r, T.lane);
    }
}
DI void p1_rows(const Ctx& F) {
    const Tid T = opaque_tid();
    const int gw = blockIdx.x * 8 + T.wave, NGW = gridDim.x * 8;
    for (int m = gw; m < MALL; m += NGW) {
        const float* xr; int mb;
        if (m < MTOK) { xr = F.x + (size_t)m * DM; mb = m >> 12; } else { xr = F.ctx + (size_t)(m - MTOK) * DM; mb = 4; }
        f32x4 v[4]; float ss = 0.f;
#pragma unroll
        for (int j = 0; j < 4; ++j) { v[j] = ((const f32x4*)xr)[T.lane + 64 * j]; ss += (v[j].x * v[j].x + v[j].y * v[j].y) + (v[j].z * v[j].z + v[j].w * v[j].w); }
        const float rstd = 1.0f / sqrtf(wave_sum(ss) * (1.f / DM) + EPS);
        const float* mod = F.MOD + mb * 3072;
#pragma unroll
        for (int j = 0; j < 4; ++j) { const int col = 4 * (T.lane + 64 * j);
            const f32x4 w = *(const f32x4*)(F.norm_w + col), sh = *(const f32x4*)(mod + col), sc = *(const f32x4*)(mod + 1024 + col);
            const f32x4 y = (v[j] * rstd * w) * (sc + 1.0f) + sh;
            u32x2 o; o.x = cvt_pk_bf16(y.x, y.y); o.y = cvt_pk_bf16(y.z, y.w);
            *(u32x2*)(F.XM + (size_t)m * DM + col) = o; }
    }
}
struct Sched1 {
    int G, c;
    DI bool next(int i, pg8::Unit& u) const {
        const int L = i * G + c;
        if (L < 64 * 36) { pg8::tile_of(L, 64, 36, u); return true; }
        const int e = L - 64 * 36; if (e >= 24) return false;
        u.pm = 64 + e / 6; u.pn = 18 + e % 6; return true;
    }
};
struct Epi1 {
    unsigned char* ws; bf16_t *R, *SGB; const f32x2* rope;
    DI void mid(f32x4 (&)[2][2][4][2], const pg8::Unit&, int, int, int, int) const {}
    DI void operator()(const f32x4 (&acc)[2][2][4][2], const pg8::Unit& u, int wr, int wc, int fr, int fq) const {
        const int pn = u.pn, row0 = u.pm * 256 + wr * 64 + fr, x0 = wc * 32 + 8 * fq;
        const bool isctx = u.pm >= 64;
        if (pn < 16) {
            bf16_t* dst = (bf16_t*)(ws + (wc < 2 ? WS_HC : WS_P)) + 64 * pn + (x0 & 63);
#pragma unroll
            for (int ai = 0; ai < 2; ++ai)
#pragma unroll
                for (int m = 0; m < 4; ++m) { const size_t row = row0 + ai * 128 + m * 16;
                    f32x4 o[2];
#pragma unroll
                    for (int n = 0; n < 2; ++n) { const f32x4 a = acc[ai][0][m][n], b = acc[ai][1][m][n];
                        if (wc < 2) o[n] = a * b;
                        else { o[n].x = a.x * siluf(b.x); o[n].y = a.y * siluf(b.y); o[n].z = a.z * siluf(b.z); o[n].w = a.w * siluf(b.w); } }
                    u32x4 w; w.x = cvt_pk_bf16(o[0].x, o[0].y); w.y = cvt_pk_bf16(o[0].z, o[0].w); w.z = cvt_pk_bf16(o[1].x, o[1].y); w.w = cvt_pk_bf16(o[1].z, o[1].w);
                    *(u32x4*)(dst + row * 1024) = w; }
        } else if (pn < 20) {
            const int t = (pn - 16) & 1, isk = (pn - 16) >> 1, head = 4 * t + wc, i0 = 8 * fq;
            const float scale = isk ? 0.125f : 1.0f;
            bf16_t* base = (bf16_t*)(ws + (isk ? (isctx ? WS_KC : WS_K) : WS_Q));
#pragma unroll
            for (int ai = 0; ai < 2; ++ai)
#pragma unroll
                for (int m = 0; m < 4; ++m) { const int row = row0 + ai * 128 + m * 16; const int orow = isctx ? row - MTOK : row;
                    const int pos = row & 4095, pidx = (fq < 2) ? (pos >> 6) : (pos & 63);
                    const f32x2* rp = rope + pidx * 16 + (fq & 1) * 8;
                    float o1[8], o2[8];
#pragma unroll
                    for (int e = 0; e < 8; ++e) { f32x2 cs = rp[e]; if (isctx) cs = (f32x2){1.f, 0.f};
                        const float t1 = acc[ai][0][m][e >> 2][e & 3], t2 = acc[ai][1][m][e >> 2][e & 3];
                        o1[e] = (t1 * cs.x - t2 * cs.y) * scale; o2[e] = (t1 * cs.y + t2 * cs.x) * scale; }
                    u32x4 w1, w2; w1.x = cvt_pk_bf16(o1[0], o1[1]); w1.y = cvt_pk_bf16(o1[2], o1[3]); w1.z = cvt_pk_bf16(o1[4], o1[5]); w1.w = cvt_pk_bf16(o1[6], o1[7]);
                    w2.x = cvt_pk_bf16(o2[0], o2[1]); w2.y = cvt_pk_bf16(o2[2], o2[3]); w2.z = cvt_pk_bf16(o2[4], o2[5]); w2.w = cvt_pk_bf16(o2[6], o2[7]);
                    bf16_t* d = base + (size_t)orow * 512 + head * 64 + i0;
                    *(u32x4*)d = w1; *(u32x4*)(d + 32) = w2; }
        } else if (pn < 28) {
            const bool isz = pn >= 24;
            bf16_t* base = (bf16_t*)(ws + (isz ? WS_SZB : (isctx ? WS_VC : WS_V)));
            const int colt = 256 * (pn - (isz ? 24 : 20)) + x0;
#pragma unroll
            for (int ai = 0; ai < 2; ++ai)
#pragma unroll
                for (int m = 0; m < 4; ++m) { const int row = row0 + ai * 128 + m * 16; const int orow = isctx ? row - MTOK : row;
#pragma unroll
                    for (int bj = 0; bj < 2; ++bj) { f32x4 a = acc[ai][bj][m][0], b = acc[ai][bj][m][1];
                        if (isz) { a.x = siluf(a.x); a.y = siluf(a.y); a.z = siluf(a.z); a.w = siluf(a.w); b.x = siluf(b.x); b.y = siluf(b.y); b.z = siluf(b.z); b.w = siluf(b.w); }
                        u32x4 w; w.x = cvt_pk_bf16(a.x, a.y); w.y = cvt_pk_bf16(a.z, a.w); w.z = cvt_pk_bf16(b.x, b.y); w.w = cvt_pk_bf16(b.z, b.w);
                        *(u32x4*)(base + (size_t)orow * 1024 + colt + bj * 128) = w; } }
        } else {
            const int col = 128 * (pn - 28) + x0;
#pragma unroll
            for (int ai = 0; ai < 2; ++ai)
#pragma unroll
                for (int m = 0; m < 4; ++m) { const size_t row = row0 + ai * 128 + m * 16;
                    float rr[8], sg[8];
#pragma unroll
                    for (int e = 0; e < 8; ++e) { const float ga = acc[ai][0][m][e >> 2][e & 3], gb = acc[ai][1][m][e >> 2][e & 3];
                        const float ea = __expf(-ga), eb = __expf(-gb); sg[e] = 1.f / (1.f + eb); rr[e] = (1.f + eb) / (1.f + ea); }
                    u32x4 w1, w2; w1.x = cvt_pk_bf16(rr[0], rr[1]); w1.y = cvt_pk_bf16(rr[2], rr[3]); w1.z = cvt_pk_bf16(rr[4], rr[5]); w1.w = cvt_pk_bf16(rr[6], rr[7]);
                    w2.x = cvt_pk_bf16(sg[0], sg[1]); w2.y = cvt_pk_bf16(sg[2], sg[3]); w2.z = cvt_pk_bf16(sg[4], sg[5]); w2.w = cvt_pk_bf16(sg[6], sg[7]);
                    *(u32x4*)(R + row * 1024 + col) = w1; *(u32x4*)(SGB + row * 1024 + col) = w2; }
        }
    }
};
DI void n2_inproj(const Ctx& F) {
    const Tid T = opaque_tid();
    const size_t NT = (size_t)gridDim.x * 512, gt = (size_t)blockIdx.x * 512 + T.tid;
    for (size_t idx = gt; idx < (size_t)(MALL / 4) * 1024; idx += NT) {
        const int ch = (int)(idx & 1023), t0 = (int)(idx >> 10) * 4;
        const bool doqk = ch < 512 && (ch & 63) < 32;
        float a[12][4];
#pragma unroll
        for (int o = 0; o < 12; ++o)
#pragma unroll
            for (int j = 0; j < 4; ++j) a[o][j] = 0.f;
        for (int k = 0; k < 1024; ++k) {
            const float* wr = F.w_in + (size_t)k * NIN;
            float xv[4];
#pragma unroll
            for (int j = 0; j < 4; ++j) xv[j] = bf2f(F.XM[(size_t)(t0 + j) * 1024 + k]);
            float w[12];
            w[0] = wr[ch]; w[1] = wr[1024 + ch]; w[2] = wr[2048 + ch]; w[3] = wr[3072 + ch]; w[4] = wr[5120 + ch]; w[5] = wr[6144 + ch]; w[6] = wr[7168 + ch]; w[7] = wr[8192 + ch];
            if (doqk) { w[8] = wr[4096 + ch]; w[9] = wr[4096 + ch + 32]; w[10] = wr[4608 + ch]; w[11] = wr[4608 + ch + 32]; } else { w[8] = w[9] = w[10] = w[11] = 0.f; }
#pragma unroll
            for (int o = 0; o < 12; ++o)
#pragma unroll
                for (int j = 0; j < 4; ++j) a[o][j] += xv[j] * w[o];
        }
#pragma unroll
        for (int j = 0; j < 4; ++j) { const int t = t0 + j;
            if (t < MTOK) {
                const size_t o = (size_t)t * 1024 + ch;
                F.HC[o] = f2bf(a[2][j] * a[0][j]); F.P[o] = f2bf(siluf(a[3][j]) * a[1][j]); F.V[o] = f2bf(a[4][j]); F.SZB[o] = f2bf(siluf(a[5][j]));
                const float sga = 1.f / (1.f + __expf(-a[6][j])), sgb = 1.f / (1.f + __expf(-a[7][j]));
                F.R[o] = f2bf(sga / sgb); F.SGB[o] = f2bf(sgb);
                if (doqk) { const int i = ch & 63, pos = t & 4095; const int pidx = i < 16 ? (pos >> 6) : (pos & 63); const f32x2 cs = F.ROPE[pidx * 16 + (i & 15)];
                    const size_t q = (size_t)t * 512 + ch;
                    F.Q[q] = f2bf(a[8][j] * cs.x - a[9][j] * cs.y); F.Q[q + 32] = f2bf(a[8][j] * cs.y + a[9][j] * cs.x);
                    F.K[q] = f2bf((a[10][j] * cs.x - a[11][j] * cs.y) * 0.125f); F.K[q + 32] = f2bf((a[10][j] * cs.y + a[11][j] * cs.x) * 0.125f); }
            } else {
                const int tc = t - MTOK;
                F.VC[(size_t)tc * 1024 + ch] = f2bf(a[4][j]);
                if (doqk) { F.KC[(size_t)tc * 512 + ch] = f2bf(a[10][j] * 0.125f); F.KC[(size_t)tc * 512 + ch + 32] = f2bf(a[11][j] * 0.125f); }
            }
        }
    }
}
DI bf16x8 tr2(const LAS unsigned char* p, int delta) {
    const s16x4 lo = __builtin_bit_cast(s16x4, __builtin_amdgcn_ds_read_tr16_b64_v4i16((LAS v4i16_t*)p));
    const s16x4 hi = __builtin_bit_cast(s16x4, __builtin_amdgcn_ds_read_tr16_b64_v4i16((LAS v4i16_t*)(p + delta)));
    return __builtin_shufflevector(lo, hi, 0, 1, 2, 3, 4, 5, 6, 7);
}
DI u32x4 scale8(u32x4 w, float s) {
    u32x4 o; o.x = cvt_pk_bf16(bflo(w.x) * s, bfhi(w.x) * s); o.y = cvt_pk_bf16(bflo(w.y) * s, bfhi(w.y) * s); o.z = cvt_pk_bf16(bflo(w.z) * s, bfhi(w.z) * s); o.w = cvt_pk_bf16(bflo(w.w) * s, bfhi(w.w) * s); return o;
}
DI void p3_kv(const Ctx& F) {
    const Tid T = opaque_tid();
    LAS unsigned char* KFI = F.lds; LAS unsigned char* KBI = F.lds + 20480; LAS unsigned char* VI = F.lds + 40960;
    const int tid = T.tid, lane = T.lane, w = T.wave, g = lane >> 4, q = (lane & 15) >> 2, p = lane & 3;
    for (int it = blockIdx.x; it < 1024 + 64; it += gridDim.x) {
        int bh; const bf16_t *kp, *vp; bf16_t *of, *ob;
        if (it < 1024) { bh = it >> 5; const int c = it & 31; const size_t tok0 = (size_t)(bh >> 3) * SEQ + c * CHK;
            kp = (const bf16_t*)(F.ws + WS_K) + tok0 * 512 + (bh & 7) * 64; vp = (const bf16_t*)(F.ws + WS_V) + tok0 * 1024 + (bh & 7) * 128;
            of = (bf16_t*)(F.ws + WS_KV) + ((size_t)(0 * 32 + bh) * 32 + c) * 8192; ob = (bf16_t*)(F.ws + WS_KV) + ((size_t)(1 * 32 + bh) * 32 + c) * 8192; }
        else { const int e = it - 1024; bh = e >> 1; const int cc = e & 1; const size_t tok0 = (size_t)(bh >> 3) * CTXL + cc * CHK;
            kp = (const bf16_t*)(F.ws + WS_KC) + tok0 * 512 + (bh & 7) * 64; vp = (const bf16_t*)(F.ws + WS_VC) + tok0 * 1024 + (bh & 7) * 128;
            of = (bf16_t*)(F.ws + WS_KVC) + ((size_t)(0 * 32 + bh) * 2 + cc) * 8192; ob = (bf16_t*)(F.ws + WS_KVC) + ((size_t)(1 * 32 + bh) * 2 + cc) * 8192; }
        const float l2f = log2_gamma(F.decay_logit, 0, bh & 7), l2b = log2_gamma(F.decay_logit, 1, bh & 7);
        { const int row = tid >> 2, seg = tid & 3;
            const u32x4 k0 = *(const u32x4*)(kp + (size_t)row * 512 + seg * 16), k1 = *(const u32x4*)(kp + (size_t)row * 512 + seg * 16 + 8);
            const float df = exp2f(l2f * (float)(127 - row)), db = exp2f(l2b * (float)row);
            *(LAS u32x4*)(KFI + row * 160 + seg * 32) = scale8(k0, df); *(LAS u32x4*)(KFI + row * 160 + seg * 32 + 16) = scale8(k1, df);
            *(LAS u32x4*)(KBI + row * 160 + seg * 32) = scale8(k0, db); *(LAS u32x4*)(KBI + row * 160 + seg * 32 + 16) = scale8(k1, db);
#pragma unroll
            for (int i = 0; i < 4; ++i) *(LAS u32x4*)(VI + row * 288 + seg * 64 + 16 * i) = *(const u32x4*)(vp + (size_t)row * 1024 + seg * 32 + 8 * i);
        }
        __syncthreads();
        f32x4 acc[2][4];
#pragma unroll
        for (int d = 0; d < 2; ++d)
#pragma unroll
            for (int nb = 0; nb < 4; ++nb) acc[d][nb] = (f32x4){0.f, 0.f, 0.f, 0.f};
#pragma unroll
        for (int s = 0; s < 4; ++s) {
            const bf16x8 a = tr2(VI + (32 * s + 8 * g + q) * 288 + (16 * w + 4 * p) * 2, 4 * 288);
#pragma unroll
            for (int nb = 0; nb < 4; ++nb) {
                const bf16x8 bfw = tr2(KFI + (32 * s + 8 * g + q) * 160 + (16 * nb + 4 * p) * 2, 4 * 160);
                const bf16x8 bbw = tr2(KBI + (32 * s + 8 * g + q) * 160 + (16 * nb + 4 * p) * 2, 4 * 160);
                acc[0][nb] = __builtin_amdgcn_mfma_f32_16x16x32_bf16(a, bfw, acc[0][nb], 0, 0, 0);
                acc[1][nb] = __builtin_amdgcn_mfma_f32_16x16x32_bf16(a, bbw, acc[1][nb], 0, 0, 0);
            }
        }
#pragma unroll
        for (int nb = 0; nb < 4; ++nb)
#pragma unroll
            for (int r = 0; r < 4; ++r) { const int o = (16 * w + 4 * g + r) * 64 + 16 * nb + (lane & 15);
                of[o] = f2bf(acc[0][nb][r]); ob[o] = f2bf(acc[1][nb][r]); }
        __syncthreads();
    }
}
DI void p3_ua(const Ctx& F) {
    const Tid T = opaque_tid();
    const size_t NT = (size_t)gridDim.x * 512, gt = (size_t)blockIdx.x * 512 + T.tid;
    for (size_t idx = gt; idx < (size_t)MTOK * 128; idx += NT) {
        const int t = (int)(idx >> 7), c8 = (int)(idx & 127) * 8, pos = t & 4095;
        const bf16_t* hp = F.HC + (size_t)t * 1024 + c8;
        const u32x4 z = (u32x4){0u, 0u, 0u, 0u};
        const u32x4 h0 = pos > 0 ? *(const u32x4*)(hp - 1024) : z, h1 = *(const u32x4*)hp, h2 = pos < SEQ - 1 ? *(const u32x4*)(hp + 1024) : z;
        const u32x4 pv = *(const u32x4*)(F.P + (size_t)t * 1024 + c8);
        float o[8];
#pragma unroll
        for (int e = 0; e < 8; ++e) { const unsigned a = h0[e >> 1], b = h1[e >> 1], c = h2[e >> 1], pp = pv[e >> 1];
            const float x0 = (e & 1) ? bfhi(a) : bflo(a), x1 = (e & 1) ? bfhi(b) : bflo(b), x2 = (e & 1) ? bfhi(c) : bflo(c), pf = (e & 1) ? bfhi(pp) : bflo(pp);
            const float cv = F.conv_w[c8 + e] * x0 + F.conv_w[1024 + c8 + e] * x1 + F.conv_w[2048 + c8 + e] * x2 + F.conv_b[c8 + e];
            o[e] = pf * cv; }
        u32x4 w; w.x = cvt_pk_bf16(o[0], o[1]); w.y = cvt_pk_bf16(o[2], o[3]); w.z = cvt_pk_bf16(o[4], o[5]); w.w = cvt_pk_bf16(o[6], o[7]);
        *(u32x4*)(F.P + (size_t)t * 1024 + c8) = w;
    }
}
DI void p4_scan(const Ctx& F) {
    const Tid T = opaque_tid();
    const size_t NT = (size_t)gridDim.x * 512, gt = (size_t)blockIdx.x * 512 + T.tid;
    for (size_t idx = gt; idx < (size_t)2 * 32 * 4096; idx += NT) {
        const int e2 = (int)(idx & 4095), bh = (int)(idx >> 12) & 31, dir = (int)(idx >> 17);
        const float g = exp2f(log2_gamma(F.decay_logit, dir, bh & 7) * 128.f);
        const unsigned* kvc = (const unsigned*)(F.KVC + ((size_t)(dir * 32 + bh) * 2) * 8192) + e2;
        const unsigned* kv = (const unsigned*)(F.KV + ((size_t)(dir * 32 + bh) * 32) * 8192) + e2;
        unsigned* st = (unsigned*)(F.ST + ((size_t)(dir * 32 + bh) * 32) * 8192) + e2;
        const unsigned c0 = kvc[0], c1 = kvc[4096];
        float s0, s1;
        if (dir == 0) { s0 = g * bflo(c0) + bflo(c1); s1 = g * bfhi(c0) + bfhi(c1); } else { s0 = bflo(c0) + g * bflo(c1); s1 = bfhi(c0) + g * bfhi(c1); }
#pragma unroll 8
        for (int i = 0; i < 32; ++i) { const int c = dir == 0 ? i : 31 - i;
            const unsigned v = kv[(size_t)c * 4096];
            st[(size_t)c * 4096] = cvt_pk_bf16(s0, s1);
            s0 = g * s0 + bflo(v); s1 = g * s1 + bfhi(v); }
    }
}
DI void n4_recurrence(const Ctx& F) {
    const Tid T = opaque_tid();
    const int gw = blockIdx.x * 8 + T.wave, NGW = gridDim.x * 8, d = T.lane;
    for (int task = gw; task < 32 * 128; task += NGW) {
        const int bh = task >> 7, v = task & 127, b = bh >> 3, h = bh & 7;
        const float gf = exp2f(log2_gamma(F.decay_logit, 0, h)), gb = exp2f(log2_gamma(F.decay_logit, 1, h));
        float s = 0.f;
        for (int m = 0; m < CTXL; ++m) { const size_t t = (size_t)b * CTXL + m; s = gf * s + bf2f(F.KC[t * 512 + h * 64 + d]) * bf2f(F.VC[t * 1024 + h * 128 + v]); }
        const float sF = s; s = 0.f;
        for (int m = CTXL - 1; m >= 0; --m) { const size_t t = (size_t)b * CTXL + m; s = gb * s + bf2f(F.KC[t * 512 + h * 64 + d]) * bf2f(F.VC[t * 1024 + h * 128 + v]); }
        const float sB = s;
        s = sF;
        for (int n = 0; n < SEQ; ++n) { const size_t t = (size_t)b * SEQ + n; s = gf * s + bf2f(F.K[t * 512 + h * 64 + d]) * bf2f(F.V[t * 1024 + h * 128 + v]);
            const float o = wave_sum(bf2f(F.Q[t * 512 + h * 64 + d]) * s); if (d == 0) F.RET[t * 1024 + h * 128 + v] = o; }
        s = sB;
        for (int n = SEQ - 1; n >= 0; --n) { const size_t t = (size_t)b * SEQ + n; s = gb * s + bf2f(F.K[t * 512 + h * 64 + d]) * bf2f(F.V[t * 1024 + h * 128 + v]);
            const float o = wave_sum(bf2f(F.Q[t * 512 + h * 64 + d]) * s); if (d == 0) F.RET[t * 1024 + h * 128 + v] += o; }
    }
}
DI void n5_groupnorm(const Ctx& F) {
    const Tid T = opaque_tid();
    const int gw = blockIdx.x * 8 + T.wave, NGW = gridDim.x * 8;
    for (int task = gw; task < MTOK * NH; task += NGW) {
        const int t = task >> 3, h = task & 7; const size_t o = (size_t)t * 1024 + h * 128 + 2 * T.lane;
        const float a = F.RET[o], b = F.RET[o + 1];
        const float mu = wave_sum(a + b) * (1.f / 128.f); const float da = a - mu, db = b - mu;
        const float var = wave_sum(da * da + db * db) * (1.f / 128.f); const float rstd = 1.0f / sqrtf(var + EPS);
        const float ra = da * rstd * F.gn_w[h * 128 + 2 * T.lane], rb = db * rstd * F.gn_w[h * 128 + 2 * T.lane + 1];
        *(unsigned*)(F.UB + o) = cvt_pk_bf16(bf2f(F.SZB[o]) * ra, bf2f(F.SZB[o + 1]) * rb);
    }
}
DI void p5_ret(const Ctx& F) {
    const Tid T = opaque_tid();
    LAS unsigned char* KI = F.lds; LAS unsigned char* VI = F.lds + 20480; LAS unsigned char* SF = F.lds + 57344; LAS unsigned char* SB = F.lds + 75776;
    const int tid = T.tid, lane = T.lane, w = T.wave, g = lane >> 4, q = (lane & 15) >> 2, p = lane & 3, l15 = lane & 15;
    for (int it = blockIdx.x; it < 1024; it += gridDim.x) {
        const int bh = it >> 5, c = it & 31, h = bh & 7; const size_t tok0 = (size_t)(bh >> 3) * SEQ + c * CHK;
        const bf16_t* kp = F.K + tok0 * 512 + h * 64; const bf16_t* vp = F.V + tok0 * 1024 + h * 128; const bf16_t* qp = F.Q + tok0 * 512 + h * 64;
        const bf16_t* stf = F.ST + ((size_t)(0 * 32 + bh) * 32 + c) * 8192; const bf16_t* stb = F.ST + ((size_t)(1 * 32 + bh) * 32 + c) * 8192;
        const float l2f = log2_gamma(F.decay_logit, 0, h), l2b = log2_gamma(F.decay_logit, 1, h);
        { const int row = tid >> 2, seg = tid & 3;
#pragma unroll
            for (int i = 0; i < 2; ++i) *(LAS u32x4*)(KI + row * 160 + seg * 32 + 16 * i) = *(const u32x4*)(kp + (size_t)row * 512 + seg * 16 + 8 * i);
#pragma unroll
            for (int i = 0; i < 4; ++i) *(LAS u32x4*)(VI + row * 288 + seg * 64 + 16 * i) = *(const u32x4*)(vp + (size_t)row * 1024 + seg * 32 + 8 * i);
#pragma unroll
            for (int i = 0; i < 2; ++i) { *(LAS u32x4*)(SF + row * 144 + seg * 32 + 16 * i) = *(const u32x4*)(stf + row * 64 + seg * 16 + 8 * i);
                *(LAS u32x4*)(SB + row * 144 + seg * 32 + 16 * i) = *(const u32x4*)(stb + row * 64 + seg * 16 + 8 * i); }
        }
        const int il = 16 * w + l15;
        bf16x8 qf[2];
#pragma unroll
        for (int ks = 0; ks < 2; ++ks) qf[ks] = *(const bf16x8*)(qp + (size_t)il * 512 + 32 * ks + 8 * g);
        __syncthreads();
        f32x4 accS[8];
#pragma unroll
        for (int jb = 0; jb < 8; ++jb) { accS[jb] = (f32x4){0.f, 0.f, 0.f, 0.f};
#pragma unroll
            for (int ks = 0; ks < 2; ++ks) { const bf16x8 kf = *(const LAS bf16x8*)(KI + (16 * jb + l15) * 160 + (32 * ks + 8 * g) * 2);
                accS[jb] = __builtin_amdgcn_mfma_f32_16x16x32_bf16(kf, qf[ks], accS[jb], 0, 0, 0); } }
        bf16x8 pf[4];
#pragma unroll
        for (int s = 0; s < 4; ++s) { float pv[8];
#pragma unroll
            for (int e = 0; e < 8; ++e) { const int jb = 2 * s + (e >> 2), r = e & 3, j = 16 * jb + 4 * g + r, df = il - j;
                float mk = 0.f; if (df >= 0) mk += exp2f(l2f * (float)df); if (df <= 0) mk += exp2f(l2b * (float)(-df));
                pv[e] = accS[jb][r] * mk; }
            u32x4 pw; pw.x = cvt_pk_bf16(pv[0], pv[1]); pw.y = cvt_pk_bf16(pv[2], pv[3]); pw.z = cvt_pk_bf16(pv[4], pv[5]); pw.w = cvt_pk_bf16(pv[6], pv[7]);
            pf[s] = __builtin_bit_cast(bf16x8, pw); }
        const float decf = exp2f(l2f * (float)(il + 1)), decb = exp2f(l2b * (float)(128 - il));
        f32x4 accO[8];
#pragma unroll
        for (int vb = 0; vb < 8; ++vb) { f32x4 o = (f32x4){0.f, 0.f, 0.f, 0.f};
#pragma unroll
            for (int s = 0; s < 4; ++s) { const bf16x8 vf = tr2(VI + (32 * s + 4 * g + q) * 288 + (16 * vb + 4 * p) * 2, 16 * 288);
                o = __builtin_amdgcn_mfma_f32_16x16x32_bf16(vf, pf[s], o, 0, 0, 0); }
            f32x4 tf = (f32x4){0.f, 0.f, 0.f, 0.f}, tb = (f32x4){0.f, 0.f, 0.f, 0.f};
#pragma unroll
            for (int ks = 0; ks < 2; ++ks) { const bf16x8 sf = *(const LAS bf16x8*)(SF + (16 * vb + l15) * 144 + (32 * ks + 8 * g) * 2);
                const bf16x8 sb = *(const LAS bf16x8*)(SB + (16 * vb + l15) * 144 + (32 * ks + 8 * g) * 2);
                tf = __builtin_amdgcn_mfma_f32_16x16x32_bf16(sf, qf[ks], tf, 0, 0, 0); tb = __builtin_amdgcn_mfma_f32_16x16x32_bf16(sb, qf[ks], tb, 0, 0, 0); }
            accO[vb] = o + tf * decf + tb * decb; __builtin_amdgcn_sched_barrier(0); }
        float sm = 0.f;
#pragma unroll
        for (int vb = 0; vb < 8; ++vb) sm += (accO[vb].x + accO[vb].y) + (accO[vb].z + accO[vb].w);
        sm += __shfl_xor(sm, 16); sm += __shfl_xor(sm, 32);
        const float mu = sm * (1.f / 128.f); float sq = 0.f;
#pragma unroll
        for (int vb = 0; vb < 8; ++vb) { accO[vb] = accO[vb] - mu; sq += (accO[vb].x * accO[vb].x + accO[vb].y * accO[vb].y) + (accO[vb].z * accO[vb].z + accO[vb].w * accO[vb].w); }
        sq += __shfl_xor(sq, 16); sq += __shfl_xor(sq, 32);
        const float rstd = 1.0f / sqrtf(sq * (1.f / 128.f) + EPS);
        __syncthreads();
#pragma unroll
        for (int vb = 0; vb < 8; ++vb) { const f32x4 gw = *(const f32x4*)(F.gn_w + h * 128 + 16 * vb + 4 * g); const f32x4 o = accO[vb] * rstd * gw;
            u32x2 ow; ow.x = cvt_pk_bf16(o.x, o.y); ow.y = cvt_pk_bf16(o.z, o.w);
            *(LAS u32x2*)(VI + il * 288 + (16 * vb + 4 * g) * 2) = ow; }
        __syncthreads();
        { const int row = tid >> 2, seg = tid & 3; const size_t go = (tok0 + row) * 1024 + h * 128 + seg * 32;
#pragma unroll
            for (int i = 0; i < 4; ++i) { const u32x4 o = *(const LAS u32x4*)(VI + row * 288 + seg * 64 + 16 * i); const u32x4 z = *(const u32x4*)(F.SZB + go + 8 * i);
                u32x4 r; r.x = cvt_pk_bf16(bflo(o.x) * bflo(z.x), bfhi(o.x) * bfhi(z.x)); r.y = cvt_pk_bf16(bflo(o.y) * bflo(z.y), bfhi(o.y) * bfhi(z.y));
                r.z = cvt_pk_bf16(bflo(o.z) * bflo(z.z), bfhi(o.z) * bfhi(z.z)); r.w = cvt_pk_bf16(bflo(o.w) * bflo(z.w), bfhi(o.w) * bfhi(z.w));
                *(u32x4*)(F.UB + go + 8 * i) = r; } }
        __syncthreads();
    }
}
struct SchedSq { int G, c; DI bool next(int i, pg8::Unit& u) const { const int L = i * G + c; if (L >= 256) return false; pg8::tile_of(L, 64, 4, u); return true; } };
struct EpiAB {
    const bf16_t* R; const bf16_t* SGB; bf16_t* MM;
    DI void mid(f32x4 (&acc)[2][2][4][2], const pg8::Unit& u, int wr, int wc, int fr, int fq) const { apply<false>(acc, u, wr, wc, fr, fq); }
    DI void operator()(const f32x4 (&acc)[2][2][4][2], const pg8::Unit& u, int wr, int wc, int fr, int fq) const { apply<true>(const_cast<f32x4 (&)[2][2][4][2]>(acc), u, wr, wc, fr, fq); }
    template <bool FIN> DI void apply(f32x4 (&acc)[2][2][4][2], const pg8::Unit& u, int wr, int wc, int fr, int fq) const {
        const bf16_t* src = FIN ? SGB : R;
        const size_t base = (size_t)(u.pm * 256 + wr * 64 + fr) * 1024 + u.pn * 256 + wc * 32 + 8 * fq;
#pragma unroll
        for (int am = 0; am < 4; ++am) { const int ai = am >> 1;
            u32x4 gv[4][2];
#pragma unroll
            for (int m = 2 * (am & 1); m < 2 * (am & 1) + 2; ++m)
#pragma unroll
                for (int bj = 0; bj < 2; ++bj) gv[m][bj] = *(const u32x4*)(src + base + (size_t)(ai * 128 + m * 16) * 1024 + bj * 128);
#pragma unroll
            for (int m = 2 * (am & 1); m < 2 * (am & 1) + 2; ++m)
#pragma unroll
                for (int bj = 0; bj < 2; ++bj) { const u32x4 gq = gv[m][bj];
                    f32x4 a = acc[ai][bj][m][0], b = acc[ai][bj][m][1];
                    a.x *= bflo(gq.x); a.y *= bfhi(gq.x); a.z *= bflo(gq.y); a.w *= bfhi(gq.y); b.x *= bflo(gq.z); b.y *= bfhi(gq.z); b.z *= bflo(gq.w); b.w *= bfhi(gq.w);
                    if (FIN) { u32x4 w; w.x = cvt_pk_bf16(a.x, a.y); w.y = cvt_pk_bf16(a.z, a.w); w.z = cvt_pk_bf16(b.x, b.y); w.w = cvt_pk_bf16(b.z, b.w);
                        *(u32x4*)(MM + base + (size_t)(ai * 128 + m * 16) * 1024 + bj * 128) = w; }
                    else { acc[ai][bj][m][0] = a; acc[ai][bj][m][1] = b; } }
            asm volatile("" ::: "memory");
        }
    }
};
struct EpiOut {
    const float* x; const float* MOD; float* out;
    DI void mid(f32x4 (&)[2][2][4][2], const pg8::Unit&, int, int, int, int) const {}
    DI void operator()(const f32x4 (&acc)[2][2][4][2], const pg8::Unit& u, int wr, int wc, int fr, int fq) const {
        const int col0 = u.pn * 256 + wc * 32 + 8 * fq; const float* gp = MOD + (u.pm >> 4) * 3072 + 2048 + col0;
        f32x4 gx[2][2];
#pragma unroll
        for (int bj = 0; bj < 2; ++bj)
#pragma unroll
            for (int n = 0; n < 2; ++n) gx[bj][n] = *(const f32x4*)(gp + bj * 128 + 4 * n);
#pragma unroll
        for (int ai = 0; ai < 2; ++ai)
#pragma unroll
            for (int m = 0; m < 4; ++m) { const size_t off = (size_t)(u.pm * 256 + ai * 128 + wr * 64 + m * 16 + fr) * 1024 + col0;
#pragma unroll
                for (int bj = 0; bj < 2; ++bj)
#pragma unroll
                    for (int n = 0; n < 2; ++n) { const f32x4 xv = *(const f32x4*)(x + off + bj * 128 + 4 * n); *(f32x4*)(out + off + bj * 128 + 4 * n) = xv + gx[bj][n] * acc[ai][bj][m][n]; }
                if (m & 1) asm volatile("" ::: "memory"); }
    }
};
struct EpiOutNorm {
    const float* x; const float* MOD; float* out; const float* fw; float* slots; unsigned* cnt; LAS float* tab;
    DI void mid(f32x4 (&)[2][2][4][2], const pg8::Unit&, int, int, int, int) const {}
    DI void operator()(const f32x4 (&acc_)[2][2][4][2], const pg8::Unit& u, int wr, int wc, int fr, int fq) const {
        f32x4 (&acc)[2][2][4][2] = const_cast<f32x4 (&)[2][2][4][2]>(acc_);
        const int col0 = u.pn * 256 + wc * 32 + 8 * fq; const float* gp = MOD + (u.pm >> 4) * 3072 + 2048 + col0;
        f32x4 gx[2][2];
#pragma unroll
        for (int bj = 0; bj < 2; ++bj)
#pragma unroll
            for (int n = 0; n < 2; ++n) gx[bj][n] = *(const f32x4*)(gp + bj * 128 + 4 * n);
#pragma unroll
        for (int ai = 0; ai < 2; ++ai)
#pragma unroll
            for (int m = 0; m < 4; ++m) { const int row = u.pm * 256 + ai * 128 + wr * 64 + m * 16 + fr; const size_t off = (size_t)row * 1024 + col0; float ss = 0.f;
#pragma unroll
                for (int bj = 0; bj < 2; ++bj)
#pragma unroll
                    for (int n = 0; n < 2; ++n) { const f32x4 xv = *(const f32x4*)(x + off + bj * 128 + 4 * n); const f32x4 v = xv + gx[bj][n] * acc[ai][bj][m][n]; acc[ai][bj][m][n] = v;
                        ss += (v.x * v.x + v.y * v.y) + (v.z * v.z + v.w * v.w); }
                ss += __shfl_xor(ss, 16); ss += __shfl_xor(ss, 32);
                if (fq == 0) __hip_atomic_store(slots + (size_t)row * 16 + u.pn * 4 + wc, ss, __ATOMIC_RELAXED, __HIP_MEMORY_SCOPE_AGENT);
                if (m & 1) asm volatile("" ::: "memory"); }
        asm volatile("s_waitcnt vmcnt(0)" ::: "memory");
        __syncthreads();
        if (threadIdx.x == 0) {
            unsigned* c = cnt + 64 * u.pm;
            __hip_atomic_fetch_add(c, 1u, __ATOMIC_RELAXED, __HIP_MEMORY_SCOPE_AGENT);
            unsigned sp = 0;
            while (__hip_atomic_load(c, __ATOMIC_RELAXED, __HIP_MEMORY_SCOPE_AGENT) < 4u) { __builtin_amdgcn_s_sleep(1); if (++sp > (1u << 22)) break; }
            __builtin_amdgcn_fence(__ATOMIC_ACQUIRE, "agent");
            asm volatile("s_waitcnt vmcnt(0)" ::: "memory");
        }
        __syncthreads();
        { const int t = threadIdx.x, row = t >> 1, half = t & 1; const float* sp = slots + (size_t)(u.pm * 256 + row) * 16 + half * 8; float s = 0.f;
#pragma unroll
            for (int j = 0; j < 8; ++j) s += __hip_atomic_load(sp + j, __ATOMIC_RELAXED, __HIP_MEMORY_SCOPE_AGENT);
            s += __shfl_xor(s, 1);
            if (half == 0) tab[row] = 1.0f / sqrtf(s * (1.f / 1024.f) + EPS); }
        __syncthreads();
        f32x4 fv[2][2];
#pragma unroll
        for (int bj = 0; bj < 2; ++bj)
#pragma unroll
            for (int n = 0; n < 2; ++n) fv[bj][n] = *(const f32x4*)(fw + col0 + bj * 128 + 4 * n);
#pragma unroll
        for (int ai = 0; ai < 2; ++ai)
#pragma unroll
            for (int m = 0; m < 4; ++m) { const int rl = ai * 128 + wr * 64 + m * 16 + fr; const float r = tab[rl]; const size_t off = (size_t)(u.pm * 256 + rl) * 1024 + col0;
#pragma unroll
                for (int bj = 0; bj < 2; ++bj)
#pragma unroll
                    for (int n = 0; n < 2; ++n) *(f32x4*)(out + off + bj * 128 + 4 * n) = acc[ai][bj][m][n] * r * fv[bj][n]; }
    }
};
DI void n6_ab(const Ctx& F) {
    const Tid T = opaque_tid();
    const size_t NT = (size_t)gridDim.x * 512, gt = (size_t)blockIdx.x * 512 + T.tid;
    for (size_t idx = gt; idx < (size_t)(MTOK / 4) * 1024; idx += NT) {
        const int n = (int)(idx & 1023), t0 = (int)(idx >> 10) * 4; float ya[4] = {0.f, 0.f, 0.f, 0.f}, yb[4] = {0.f, 0.f, 0.f, 0.f};
        for (int k = 0; k < 1024; ++k) { const float wa = F.w_a[(size_t)k * 1024 + n], wb = F.w_b[(size_t)k * 1024 + n];
#pragma unroll
            for (int j = 0; j < 4; ++j) { ya[j] += bf2f(F.P[(size_t)(t0 + j) * 1024 + k]) * wa; yb[j] += bf2f(F.UB[(size_t)(t0 + j) * 1024 + k]) * wb; } }
#pragma unroll
        for (int j = 0; j < 4; ++j) { const size_t o = (size_t)(t0 + j) * 1024 + n; const float sgb = bf2f(F.SGB[o]), sga = bf2f(F.R[o]) * sgb; F.MM[o] = f2bf(sga * ya[j] + sgb * yb[j]); }
    }
}
DI void n7_out(const Ctx& F) {
    const Tid T = opaque_tid();
    const size_t NT = (size_t)gridDim.x * 512, gt = (size_t)blockIdx.x * 512 + T.tid;
    for (size_t idx = gt; idx < (size_t)(MTOK / 4) * 1024; idx += NT) {
        const int n = (int)(idx & 1023), t0 = (int)(idx >> 10) * 4; float y[4] = {0.f, 0.f, 0.f, 0.f};
        for (int k = 0; k < 1024; ++k) { const float w = F.w_out[(size_t)k * 1024 + n];
#pragma unroll
            for (int j = 0; j < 4; ++j) y[j] += bf2f(F.MM[(size_t)(t0 + j) * 1024 + k]) * w; }
#pragma unroll
        for (int j = 0; j < 4; ++j) { const size_t o = (size_t)(t0 + j) * 1024 + n; F.out[o] = F.x[o] + F.MOD[((t0 + j) >> 12) * 3072 + 2048 + n] * y[j]; }
    }
}
DI void p8_final(const Ctx& F) {
    const Tid T = opaque_tid();
    const int gw = blockIdx.x * 8 + T.wave, NGW = gridDim.x * 8;
    for (int m = gw; m < MTOK; m += NGW) {
        f32x4* xr = (f32x4*)(F.out + (size_t)m * DM);
        f32x4 v[4]; float ss = 0.f;
#pragma unroll
        for (int j = 0; j < 4; ++j) { v[j] = xr[T.lane + 64 * j]; ss += (v[j].x * v[j].x + v[j].y * v[j].y) + (v[j].z * v[j].z + v[j].w * v[j].w); }
        const float rstd = 1.0f / sqrtf(wave_sum(ss) * (1.f / DM) + EPS);
#pragma unroll
        for (int j = 0; j < 4; ++j) { const f32x4 w = *(const f32x4*)(F.final_w + 4 * (T.lane + 64 * j)); xr[T.lane + 64 * j] = v[j] * rstd * w; }
    }
}

constexpr int NPH = 9;
__global__ void __launch_bounds__(512, 2) fwd_kernel(Args args) {
    extern __shared__ __attribute__((aligned(16))) unsigned char lds_raw[];
    Ctx F;
    F.lds = (LAS unsigned char*)lds_raw;
    if (threadIdx.x < 16) ((LAS unsigned*)(F.lds + LDS_MISC))[threadIdx.x] = 0u;
    __syncthreads();
    const XcdBarrier bar = xcd_barrier_post((unsigned*)(args.ws + WS_BAR), (volatile LAS unsigned*)(F.lds + LDS_MISC));
    F.x = args.in[0]; F.c = args.in[1]; F.ctx = args.in[2]; F.c_ctx = args.in[3]; F.norm_w = args.in[4]; F.ada_w = args.in[5]; F.ada_b = args.in[6]; F.w_in = args.in[7];
    F.conv_w = args.in[8]; F.conv_b = args.in[9]; F.decay_logit = args.in[10]; F.gn_w = args.in[11]; F.w_a = args.in[12]; F.w_b = args.in[13]; F.w_out = args.in[14]; F.final_w = args.in[15];
    F.out = args.out; unsigned char* ws = args.ws; F.ws = ws;
    F.MOD = (float*)(ws + WS_MOD); F.ROPE = (f32x2*)(ws + WS_ROPE);
    F.WA = (bf16_t*)(ws + WS_WA); F.WB = (bf16_t*)(ws + WS_WB); F.WOUT = (bf16_t*)(ws + WS_WOUT); F.WIN = (bf16_t*)(ws + WS_WIN); F.XM = (bf16_t*)(ws + WS_XM);
    F.KV = (bf16_t*)(ws + WS_KV); F.KVC = (bf16_t*)(ws + WS_KVC); F.HC = (bf16_t*)(ws + WS_HC); F.ST = (bf16_t*)(ws + WS_ST); F.MM = (bf16_t*)(ws + WS_MM);
    F.P = (bf16_t*)(ws + WS_P); F.Q = (bf16_t*)(ws + WS_Q); F.K = (bf16_t*)(ws + WS_K); F.V = (bf16_t*)(ws + WS_V); F.SZB = (bf16_t*)(ws + WS_SZB);
    F.KC = (bf16_t*)(ws + WS_KC); F.VC = (bf16_t*)(ws + WS_VC); F.UB = (bf16_t*)(ws + WS_UB);
    F.R = (bf16_t*)args.out; F.SGB = (bf16_t*)args.out + (size_t)MTOK * DM;
    F.RET = (float*)(ws + WS_RET);
    const int lo = args.ph_lo, hi = args.ph_hi; const unsigned naive = args.naive;
#define IN(k) (lo <= (k) && (k) < hi && ((MK_PHASES >> (k)) & 1))
#define NAIVE(k) (((naive & MK_NAIVE_AVAIL) >> (k)) & 1u)
#define SEAM(k) do { if (IN(k) && IN((k) + 1)) xcd_barrier(bar); } while (0)
#define REP(k) for (int rep_ = 0; rep_ < 1 + (int)((MK_REP_MASK >> (k)) & 1u); ++rep_)
    if (IN(0)) REP(0) { p0_prologue(F); } SEAM(0);
    if (IN(1)) REP(1) { p1_rows(F); } SEAM(1);
    if (IN(2)) REP(2) {
        if (NAIVE(2)) n2_inproj(F);
        else { const char* const Ab[2] = {(const char*)F.XM, (const char*)F.XM}; const char* const Bb[2] = {(const char*)F.WIN, (const char*)F.WIN};
            Sched1 S{(int)gridDim.x, (int)blockIdx.x}; Epi1 E{F.ws, F.R, F.SGB, F.ROPE};
            pg8::gemm_phase<1, Epi1, Sched1>(F.lds, Ab, Bb, S, E); }
    } SEAM(2);
    if (IN(3)) { REP(3) { if (!NAIVE(3)) p3_kv(F); } p3_ua(F); } SEAM(3);
    if (IN(4)) REP(4) { if (NAIVE(4)) n4_recurrence(F); else p4_scan(F); } SEAM(4);
    if (IN(5)) REP(5) { if (NAIVE(5)) n5_groupnorm(F); else p5_ret(F); } SEAM(5);
    if (IN(6)) REP(6) {
        if (NAIVE(6)) n6_ab(F);
        else { const char* const Ab[2] = {(const char*)F.P, (const char*)F.UB}; const char* const Bb[2] = {(const char*)F.WA, (const char*)F.WB};
            SchedSq S{(int)gridDim.x, (int)blockIdx.x}; EpiAB E{F.R, F.SGB, F.MM};
            pg8::gemm_phase<2, EpiAB, SchedSq>(F.lds, Ab, Bb, S, E); }
    } SEAM(6);
    if (IN(7)) REP(7) {
        if (NAIVE(7)) n7_out(F);
        else { const char* const Ab[2] = {(const char*)F.MM, (const char*)F.MM}; const char* const Bb[2] = {(const char*)F.WOUT, (const char*)F.WOUT};
            SchedSq S{(int)gridDim.x, (int)blockIdx.x};
            EpiOutNorm E{F.x, F.MOD, F.out, F.final_w, (float*)(F.ws + WS_SLOTS), (unsigned*)(F.ws + WS_PCNT), (LAS float*)(F.lds + LDS_TAB)};
            pg8::gemm_phase<1, EpiOutNorm, SchedSq>(F.lds, Ab, Bb, S, E); }
    }
    if (NAIVE(7)) { SEAM(7); if (IN(8)) { p8_final(F); } }
#undef IN
#undef NAIVE
#undef SEAM
}

extern "C" void kernel_launch(void* const* d_in, const int* in_sizes, int n_in, void* d_out, int out_size, void* d_ws, size_t ws_size, hipStream_t stream) {
    static int grid = 0;
    if (grid == 0) {
        if (n_in != 16 || out_size != MTOK * DM || ws_size < WS_END) { fprintf(stderr, "kernel_launch: unexpected shapes (n_in %d out %d ws %zu)\n", n_in, out_size, ws_size); grid = -1; return; }
        int dev = 0, cus = 0, per_cu = 0;
        hipGetDevice(&dev); hipDeviceGetAttribute(&cus, hipDeviceAttributeMultiprocessorCount, dev);
        hipFuncSetAttribute((const void*)fwd_kernel, hipFuncAttributeMaxDynamicSharedMemorySize, LDS_BYTES);
        hipOccupancyMaxActiveBlocksPerMultiprocessor(&per_cu, (const void*)fwd_kernel, 512, LDS_BYTES);
        if (per_cu < 1) { fprintf(stderr, "kernel_launch: occupancy query says %d blocks/CU\n", per_cu); per_cu = 1; }
        grid = cus;
        (void)hipGetLastError();
    }
    if (grid < 0) return;
    Args a{};
    for (int i = 0; i < 16; ++i) a.in[i] = (const float*)d_in[i];
    a.out = (float*)d_out; a.ws = (unsigned char*)d_ws; a.naive = MK_NAIVE_MASK;
    hipMemsetAsync((unsigned char*)d_ws + WS_BAR, 0, WS_BAR_BYTES, stream);
#if MK_LAUNCH_PER_PHASE
    for (int ph = 0; ph < NPH; ++ph) { a.ph_lo = ph; a.ph_hi = ph + 1; hipLaunchKernelGGL(fwd_kernel, dim3(grid), dim3(512), LDS_BYTES, stream, a); }
#else
    a.ph_lo = 0; a.ph_hi = NPH;
    hipLaunchKernelGGL(fwd_kernel, dim3(grid), dim3(512), LDS_BYTES, stream, a);
#endif
}
```

```cpp
#include <hip/hip_runtime.h>
#include <cstdio>
#include <cstdint>

#ifndef MK_LAUNCH_PER_PHASE
#define MK_LAUNCH_PER_PHASE 0
#endif
#ifndef MK_NAIVE_MASK
#define MK_NAIVE_MASK 0x00u
#endif

#ifndef MK_REP_MASK
#define MK_REP_MASK 0u
#endif
#ifndef MK_PHASES
#define MK_PHASES 0x1ff
#endif
#ifndef MK_NAIVE_AVAIL
#define MK_NAIVE_AVAIL 0xffu
#endif
#define DI __device__ __forceinline__
#define LAS __attribute__((address_space(3)))
typedef unsigned short bf16_t;
typedef float f32x4 __attribute__((ext_vector_type(4)));
typedef float f32x2 __attribute__((ext_vector_type(2)));
typedef unsigned u32x4 __attribute__((ext_vector_type(4)));
typedef unsigned u32x2 __attribute__((ext_vector_type(2)));
typedef short bf16x8 __attribute__((ext_vector_type(8)));
typedef short s16x4 __attribute__((ext_vector_type(4)));
typedef short v4i16_t __attribute__((ext_vector_type(4)));

constexpr int NB = 4, SEQ = 4096, DM = 1024, MTOK = NB * SEQ, CTXL = 256, MCTX = NB * CTXL, MALL = MTOK + MCTX;
constexpr int NIN = 9216, NH = 8, DK = 64, DV = 128, CHK = 128, NCHK = SEQ / CHK;
constexpr float EPS = 1e-6f;
constexpr size_t MiB = 1u << 20;
constexpr size_t WS_MOD = 0;
constexpr size_t WS_ROPE = 65536;
constexpr size_t WS_WA = 2 * MiB, WS_WB = 4 * MiB, WS_WOUT = 6 * MiB, WS_WIN = 8 * MiB;
constexpr size_t WS_XM = 26 * MiB;
constexpr size_t WS_KV = 223 * MiB;
constexpr size_t WS_KVC = 40 * MiB;
constexpr size_t WS_RET = 8 * MiB;
constexpr size_t WS_HC = 60 * MiB;
constexpr size_t WS_ST = 60 * MiB;
constexpr size_t WS_MM = 60 * MiB;
constexpr size_t WS_P = 92 * MiB;
constexpr size_t WS_Q = 124 * MiB, WS_K = 140 * MiB, WS_V = 156 * MiB, WS_SZB = 188 * MiB;
constexpr size_t WS_KC = 220 * MiB, WS_VC = 221 * MiB;
constexpr size_t WS_UB = 223 * MiB;
constexpr size_t WS_END = 255 * MiB;
constexpr int LDS_BYTES = 147456;
constexpr int LDS_MISC = 139264;
constexpr size_t WS_BAR = 131072, WS_BAR_BYTES = 65536;
constexpr size_t WS_PCNT = WS_BAR + 16384, WS_SLOTS = 1 * MiB;
constexpr int LDS_TAB = 132096;

DI float bf2f(bf16_t v) { return __uint_as_float((unsigned)v << 16); }
DI float bflo(unsigned w) { return __uint_as_float(w << 16); }
DI float bfhi(unsigned w) { return __uint_as_float(w & 0xffff0000u); }
typedef __bf16 bf16x2_t __attribute__((ext_vector_type(2)));
DI unsigned cvt_pk_bf16(float lo, float hi) { const f32x2 f = {lo, hi}; const bf16x2_t v = __builtin_convertvector(f, bf16x2_t); return __builtin_bit_cast(unsigned, v); }
DI bf16_t f2bf(float f) { return (bf16_t)(cvt_pk_bf16(f, 0.f) & 0xffffu); }
DI float wave_sum(float v) {
#pragma unroll
    for (int o = 1; o < 64; o <<= 1) v += __shfl_xor(v, o);
    return v;
}
struct Tid { int tid, lane, wave; };
DI Tid opaque_tid() { int t = threadIdx.x; asm volatile("" : "+v"(t)); Tid r; r.tid = t; r.lane = t & 63; r.wave = __builtin_amdgcn_readfirstlane(t >> 6); return r; }
DI float siluf(float x) { return x * __builtin_amdgcn_rcpf(1.f + __expf(-x)); }
DI float log2_gamma(const float* decay_logit, int dir, int h) {
    const float x = decay_logit[dir * NH + h];
    const float ls = fminf(x, 0.f) - log1pf(expf(-fabsf(x)));
    return ls * 1.4426950408889634f;
}

namespace pg8 {
constexpr int BM = 256, BK = 64, HALF = 128, HTB = HALF * BK * 2, STAGE_BYTES = 8 * HTB, NXCD = 8, WGM = 8;
DI int lds_byte(int r, int c) { const int st = (r >> 4) * 2 + (c >> 5), rr = r & 15, cc = c & 31, ob = rr * 64 + cc * 2; return st * 1024 + (ob ^ (((ob >> 9) & 1) << 5)); }
DI void stage_rc(int b, int& R, int& C) { const int st = b / 1024, sb = b % 1024, swz = sb ^ (((sb >> 9) & 1) << 5); R = (st >> 1) * 16 + swz / 64; C = (st & 1) * 32 + (swz % 64) / 2; }
DI int perm32(int rho) { const int n = rho >> 4, i = rho & 15; return 8 * (i >> 2) + 4 * n + (i & 3); }
struct Unit { int pm, pn; };
DI void tile_of(int L, int nM, int nN, Unit& u) {
    const int nwg = nM * nN; int wgid = L;
    { const int q = nwg / NXCD, r = nwg % NXCD, xcd = wgid % NXCD, off = wgid / NXCD; wgid = (xcd < r ? xcd * (q + 1) : r * (q + 1) + (xcd - r) * q) + off; }
    const int nig = WGM * nN, gid = wgid / nig, fm = gid * WGM, gsz = (nM - fm) < WGM ? (nM - fm) : WGM;
    u.pm = fm + ((wgid % nig) % gsz); u.pn = (wgid % nig) / gsz;
}
template <int NSEG, class Epi, class Sched>
DI void gemm_phase(LAS unsigned char* lds, const char* const (&Ab)[2], const char* const (&Bb)[2], const Sched& S, const Epi& E) {
    constexpr int K = 1024, NTS = K / BK;
    constexpr int nt = NSEG * NTS;
    const Tid T = opaque_tid();
    const int tid = T.tid, wid = T.wave, lane = T.lane, wr = wid >> 2, wc = (wid & 3) ^ (wr << 1), fr = lane & 15, fq = lane >> 4;
    unsigned voffA[2], voffB[2];
#pragma unroll
    for (int i = 0; i < 2; ++i) { int R, C; stage_rc(tid * 16 + i * 8192, R, C); const int Rb = (R & ~31) + perm32(R & 31);
        voffA[i] = (unsigned)(R * K + C) * 2u; voffB[i] = (unsigned)(Rb * K + C) * 2u; }
    constexpr size_t kstep = (size_t)(BK * 2);
    constexpr size_t hstep = (size_t)HALF * K * 2;
    constexpr size_t tstep = 2 * hstep;
    const unsigned ldsw = (unsigned)wid * 1024u;
    const int aoff = lds_byte(wr * 64 + fr, fq * 8), boff = lds_byte(wc * 32 + fr, fq * 8);
#define PG8_SA(b, h) (((b) * 2 + (h)) * HTB)
#define PG8_SB(b, h) ((4 + (b) * 2 + (h)) * HTB)
#define PG8_STAGE(bufoff, gbase, voff) do { _Pragma("unroll") for (int _i = 0; _i < 2; ++_i) \
        __builtin_amdgcn_global_load_lds((const unsigned*)((const char*)(gbase) + (voff)[_i]), (LAS unsigned*)(lds + (bufoff) + ldsw + _i * 8192), 16, 0, 0); } while (0)
#define PG8_LDA(dst, b, h) do { _Pragma("unroll") for (int m = 0; m < 4; ++m) _Pragma("unroll") for (int k = 0; k < 2; ++k) dst[m][k] = *(const LAS bf16x8*)(lds + PG8_SA(b, h) + aoff + m * 2048 + k * 1024); } while (0)
#define PG8_LDB(dst, b, h) do { _Pragma("unroll") for (int n = 0; n < 2; ++n) _Pragma("unroll") for (int k = 0; k < 2; ++k) dst[n][k] = *(const LAS bf16x8*)(lds + PG8_SB(b, h) + boff + n * 2048 + k * 1024); } while (0)
#define PG8_MMA(ai, bj, At, Bt) do { __builtin_amdgcn_s_setprio(1); _Pragma("unroll") for (int m = 0; m < 4; ++m) _Pragma("unroll") for (int n = 0; n < 2; ++n) _Pragma("unroll") for (int k = 0; k < 2; ++k) \
        acc[ai][bj][m][n] = __builtin_amdgcn_mfma_f32_16x16x32_bf16(Bt[n][k], At[m][k], acc[ai][bj][m][n], 0, 0, 0); __builtin_amdgcn_s_setprio(0); } while (0)
#define PG8_WAIT_V(n) asm volatile("s_waitcnt vmcnt(" #n ")" ::: "memory")
#define PG8_WAIT_L(n) asm volatile("s_waitcnt lgkmcnt(" #n ")" ::: "memory")
#define PG8_BAR __builtin_amdgcn_s_barrier()
#define PG8_SCHED __builtin_amdgcn_sched_barrier(0)
#define PG8_TA(u, t) (Ab[(t) / NTS] + (size_t)(u).pm * tstep + (size_t)((t) % NTS) * kstep)
#define PG8_TB(u, t) (Bb[(t) / NTS] + (size_t)(u).pn * tstep + (size_t)((t) % NTS) * kstep)
    Unit cur, nxt; int ui = 0;
    if (!S.next(0, cur)) return;
    f32x4 acc[2][2][4][2];
#pragma unroll
    for (int a = 0; a < 2; ++a)
#pragma unroll
        for (int b = 0; b < 2; ++b)
#pragma unroll
            for (int m = 0; m < 4; ++m)
#pragma unroll
                for (int n = 0; n < 2; ++n) acc[a][b][m][n] = (f32x4){0.f, 0.f, 0.f, 0.f};
    bf16x8 At[4][2], B0[2][2], B1[2][2];
    {
        const char* cA = PG8_TA(cur, 0); const char* cB = PG8_TB(cur, 0);
        PG8_STAGE(PG8_SB(0, 0), cB, voffB); PG8_STAGE(PG8_SB(0, 1), cB + hstep, voffB); PG8_STAGE(PG8_SA(0, 0), cA, voffA); PG8_STAGE(PG8_SA(0, 1), cA + hstep, voffA);
        if (wr == 1) PG8_BAR;
        PG8_WAIT_V(2); PG8_BAR;
        PG8_STAGE(PG8_SB(1, 0), cB + kstep, voffB); PG8_STAGE(PG8_SA(1, 0), cA + kstep, voffA); PG8_STAGE(PG8_SB(1, 1), cB + hstep + kstep, voffB);
        PG8_WAIT_V(6); PG8_BAR;
    }
    for (;;) {
        const bool has_next = S.next(ui + 1, nxt);
        const Unit nu = has_next ? nxt : cur;
        for (int t = 0; t < nt; t += 2) {
            if (NSEG == 2 && t == NTS) E.mid(acc, cur, wr, wc, fr, fq);
            const bool last = (t == nt - 2);
            const char* a1 = PG8_TA(cur, t + 1);
            const char* a2 = last ? PG8_TA(nu, 0) : PG8_TA(cur, t + 2); const char* b2 = last ? PG8_TB(nu, 0) : PG8_TB(cur, t + 2);
            const char* a3 = a2 + kstep; const char* b3 = b2 + kstep;
            PG8_LDB(B0, 0, 0); PG8_LDB(B1, 0, 1); PG8_SCHED; PG8_LDA(At, 0, 0); PG8_STAGE(PG8_SA(1, 1), a1 + hstep, voffA);
            PG8_WAIT_V(8); PG8_WAIT_L(0); PG8_BAR; PG8_MMA(0, 0, At, B0); PG8_MMA(0, 1, At, B1); PG8_BAR; PG8_SCHED;
            PG8_LDA(At, 0, 1); PG8_STAGE(PG8_SB(0, 0), b2, voffB); PG8_STAGE(PG8_SB(0, 1), b2 + hstep, voffB); PG8_STAGE(PG8_SA(0, 0), a2, voffA);
            PG8_WAIT_V(8); PG8_WAIT_L(0); PG8_BAR; PG8_MMA(1, 0, At, B0); PG8_MMA(1, 1, At, B1); PG8_BAR; PG8_SCHED;
            PG8_LDB(B0, 1, 0); PG8_LDB(B1, 1, 1); PG8_SCHED; PG8_LDA(At, 1, 0); PG8_STAGE(PG8_SA(0, 1), a2 + hstep, voffA);
            PG8_WAIT_V(8); PG8_WAIT_L(0); PG8_BAR; PG8_MMA(0, 0, At, B0); PG8_MMA(0, 1, At, B1); PG8_BAR; PG8_SCHED;
            PG8_LDA(At, 1, 1); PG8_STAGE(PG8_SB(1, 0), b3, voffB); PG8_STAGE(PG8_SB(1, 1), b3 + hstep, voffB); PG8_STAGE(PG8_SA(1, 0), a3, voffA);
            PG8_WAIT_V(8); PG8_WAIT_L(0); PG8_BAR; PG8_MMA(1, 0, At, B0); PG8_MMA(1, 1, At, B1); PG8_BAR; PG8_SCHED;
        }
        if (wr == 0) PG8_BAR;
        E(acc, cur, wr, wc, fr, fq);
        if (!has_next) break;
#pragma unroll
        for (int a = 0; a < 2; ++a)
#pragma unroll
            for (int b = 0; b < 2; ++b)
#pragma unroll
                for (int m = 0; m < 4; ++m)
#pragma unroll
                    for (int n = 0; n < 2; ++n) acc[a][b][m][n] = (f32x4){0.f, 0.f, 0.f, 0.f};
        cur = nxt; ++ui;
        if (wr == 1) PG8_BAR;
    }
    PG8_WAIT_V(0);
    PG8_BAR;
#undef PG8_SA
#undef PG8_SB
#undef PG8_STAGE
#undef PG8_LDA
#undef PG8_LDB
#undef PG8_MMA
#undef PG8_WAIT_V
#undef PG8_WAIT_L
#undef PG8_BAR
#undef PG8_SCHED
#undef PG8_TA
#undef PG8_TB
}
}


#define XB_TMO      128
#define XB_XCNT(j)  (256  + 64 * (j))
#define XB_XSUB(j)  (1280 + 64 * (j))
#define XB_XGEN(j)  (2304 + 64 * (j))
#define XB_TOP      3328
#define XB_TOPGEN   3392
#define XCD_BAR_WORDS 3456
#define XB_SPIN_CAP (1u << 18)
DI unsigned xb_ld(unsigned* p)              { return __hip_atomic_load(p, __ATOMIC_RELAXED, __HIP_MEMORY_SCOPE_AGENT); }
DI unsigned xb_add(unsigned* p, unsigned v) { return __hip_atomic_fetch_add(p, v, __ATOMIC_RELAXED, __HIP_MEMORY_SCOPE_AGENT); }
DI unsigned xb_xcc_id() { return (unsigned)__builtin_amdgcn_s_getreg((3 << 11) | 20) & 0xFu; }
#define XB_SPIN(cond, bar) do { unsigned _sp = 0; while (cond) { __builtin_amdgcn_s_sleep(1); \
    if ((++_sp & 255u) == 0u) { if (xb_ld(&(bar)[XB_TMO])) break; if (_sp > XB_SPIN_CAP) { atomicAdd(&(bar)[XB_TMO], 1u); break; } } } } while (0)
struct XcdBarrier { unsigned* bar; unsigned x; volatile LAS unsigned* st; };
DI XcdBarrier xcd_barrier_post(unsigned* bar, volatile LAS unsigned* st) {
    XcdBarrier b; b.bar = bar; b.x = xb_xcc_id(); b.st = st;
    if (threadIdx.x == 0) (void)xb_add(&bar[XB_XCNT(b.x)], 1u);
    return b;
}
DI void xcd_barrier_complete(unsigned* bar, unsigned x, unsigned& nloc, unsigned& nx) {
    const unsigned G = gridDim.x * gridDim.y * gridDim.z;
    unsigned sum, cnt, mine, sp = 0u;
    for (;;) {
        sum = 0u; cnt = 0u; mine = 0u;
#pragma unroll
        for (unsigned j = 0; j < 16; ++j) { const unsigned c = xb_ld(&bar[XB_XCNT(j)]); sum += c; cnt += (c > 0u) ? 1u : 0u; mine = (j == x) ? c : mine; }
        if (sum == G) break;
        __builtin_amdgcn_s_sleep(1);
        if ((++sp & 255u) == 0u) { if (xb_ld(&bar[XB_TMO])) break; if (sp > XB_SPIN_CAP) { atomicAdd(&bar[XB_TMO], 1u); break; } }
    }
    nloc = mine > 0u ? mine : 1u; nx = cnt > 0u ? cnt : 1u;
}
DI void xcd_barrier(const XcdBarrier& b) {
    asm volatile("s_waitcnt vmcnt(0)" ::: "memory");
    __syncthreads();
    if (threadIdx.x == 0) {
        unsigned* bar = b.bar;
        __builtin_amdgcn_s_waitcnt(0);
        unsigned nloc = b.st[0], nx = b.st[1];
        if (nloc == 0u) { xcd_barrier_complete(bar, b.x, nloc, nx); b.st[0] = nloc; b.st[1] = nx; }
        const unsigned old = xb_add(&bar[XB_XSUB(b.x)], 1u);
        const unsigned gen = old / nloc;
        if (old + 1u == (gen + 1u) * nloc) {
            __builtin_amdgcn_fence(__ATOMIC_RELEASE, "agent");
            asm volatile("s_waitcnt vmcnt(0)" ::: "memory");
            const unsigned og = xb_add(&bar[XB_TOP], 1u);
            const unsigned tg = og / nx;
            if (og + 1u == (tg + 1u) * nx) xb_add(&bar[XB_TOPGEN], 1u);
            else XB_SPIN(xb_ld(&bar[XB_TOPGEN]) == tg, bar);
            __builtin_amdgcn_fence(__ATOMIC_ACQUIRE, "agent");
            xb_add(&bar[XB_XGEN(b.x)], 1u);
            asm volatile("s_waitcnt vmcnt(0)" ::: "memory");
        } else {
            XB_SPIN(xb_ld(&bar[XB_XGEN(b.x)]) == gen, bar);
            __builtin_amdgcn_fence(__ATOMIC_ACQUIRE, "agent");
            asm volatile("s_waitcnt vmcnt(0)" ::: "memory");
        }
    }
    __syncthreads();
}

struct Args { const float* in[16]; float* out; unsigned char* ws; int ph_lo, ph_hi; unsigned naive; int pad; };
struct Ctx {
    LAS unsigned char* lds;
    const float *x, *c, *ctx, *c_ctx, *norm_w, *ada_w, *ada_b, *w_in, *conv_w, *conv_b, *decay_logit, *gn_w, *w_a, *w_b, *w_out, *final_w;
    float* out; unsigned char* ws;
    float* MOD; f32x2* ROPE;
    bf16_t *WA, *WB, *WOUT, *WIN, *XM, *KV, *KVC, *HC, *ST, *MM, *P, *Q, *K, *V, *SZB, *KC, *VC, *UB, *R, *SGB;
    float* RET; float* S0;
};

DI int win_dest(int o) {
    if (o < 4096) { const int g = o >> 10, ch = o & 1023; return 256 * (ch >> 6) + 64 * g + (ch & 63); }
    if (o < 5120) { const int qk = (o - 4096) >> 9, oo = (o - 4096) & 511, head = oo >> 6, i = oo & 63, t = head >> 2, hh = head & 3;
        return 256 * (16 + 2 * qk + t) + (i < 32 ? 32 * hh + i : 128 + 32 * hh + (i - 32)); }
    if (o < 7168) return o;
    { const int gs = (o - 7168) >> 10, ch = (o - 7168) & 1023; return 256 * (28 + (ch >> 7)) + 128 * gs + (ch & 127); }
}
DI void p0_transpose_item(const float* W, int K, int N, bf16_t* WT, bool permute, LAS float* scr, int item, int lane) {
    const int nblk = N / 32, kb = item / nblk, nb = item % nblk, k0 = 64 * kb, n0 = 32 * nb;
#pragma unroll 8
    for (int i = 0; i < 32; ++i) { const int kk = 2 * i + (lane >> 5); scr[kk * 33 + (lane & 31)] = W[(size_t)(k0 + kk) * N + n0 + (lane & 31)]; }
    asm volatile("s_waitcnt lgkmcnt(0)" ::: "memory");
    const int c = lane & 7; const int d0 = permute ? win_dest(n0) : n0;
#pragma unroll
    for (int j = 0; j < 4; ++j) { const int n = (lane >> 3) + 8 * j; const LAS float* s = scr + (8 * c) * 33 + n;
        u32x4 o; o.x = cvt_pk_bf16(s[0 * 33], s[1 * 33]); o.y = cvt_pk_bf16(s[2 * 33], s[3 * 33]); o.z = cvt_pk_bf16(s[4 * 33], s[5 * 33]); o.w = cvt_pk_bf16(s[6 * 33], s[7 * 33]);
        *(u32x4*)(WT + (size_t)(d0 + n) * K + k0 + 8 * c) = o; }
    asm volatile("s_waitcnt lgkmcnt(0)" ::: "memory");
}
DI void p0_prologue(const Ctx& F) {
    const Tid T = opaque_tid();
    if (blockIdx.x < 48) {
        LAS float* red = (LAS float*)F.lds;
        const int n0 = 64 * blockIdx.x, k0 = 128 * T.wave;
        float a[5] = {0.f, 0.f, 0.f, 0.f, 0.f};
#pragma unroll 8
        for (int k = 0; k < 128; ++k) {
            const float w = F.ada_w[(size_t)(k0 + k) * 3072 + n0 + T.lane];
#pragma unroll
            for (int v = 0; v < 5; ++v) { const float cv = v < 4 ? F.c[v * 1024 + k0 + k] : F.c_ctx[k0 + k]; a[v] += siluf(cv) * w; }
        }
#pragma unroll
        for (int v = 0; v < 5; ++v) red[(T.wave * 5 + v) * 64 + T.lane] = a[v];
        __syncthreads();
        if (T.tid < 320) { const int v = T.tid >> 6, l = T.tid & 63; float s = F.ada_b[n0 + l];
#pragma unroll
            for (int w = 0; w < 8; ++w) s += red[(w * 5 + v) * 64 + l];
            F.MOD[v * 3072 + n0 + l] = s; }
        __syncthreads();
    }
    if (blockIdx.x == 48) {
        for (int e = T.tid; e < 1024; e += 512) { const int p = e >> 4, f = e & 15; const float inv = powf(10000.f, -(float)f / 16.f); const float ang = (float)p * inv;
            F.ROPE[e] = (f32x2){cosf(ang), sinf(ang)}; }
    }
    LAS float* scr = (LAS float*)(F.lds + T.wave * 16384);
    const int gw = blockIdx.x * 8 + T.wave, NGW = gridDim.x * 8;
    constexpr int I_IN = 16 * (NIN / 32), I_SQ = 16 * 32;
    for (int it = gw; it < I_IN + 3 * I_SQ; it += NGW) {
        int r = it;
        if (r < I_IN) { p0_transpose_item(F.w_in, 1024, NIN, F.WIN, true, scr, r, T.lane); continue; } r -= I_IN;
        if (r < I_SQ) { p0_transpose_item(F.w_a, 1024, 1024, F.WA, false, scr, r, T.lane); continue; } r -= I_SQ;
        if (r < I_SQ) { p0_transpose_item(F.w_b, 1024, 1024, F.WB, false, scr, r, T.lane); continue; } r -= I_SQ;
        p0_transpose_item(F.w_out, 1024, 1024, F.WOUT, false, scr, r, T.lane);
    }
}
DI void p1_rows(const Ctx& F) {
    const Tid T = opaque_tid();
    const int gw = blockIdx.x * 8 + T.wave, NGW = gridDim.x * 8;
    for (int m = gw; m < MALL; m += NGW) {
        const float* xr; int mb;
        if (m < MTOK) { xr = F.x + (size_t)m * DM; mb = m >> 12; } else { xr = F.ctx + (size_t)(m - MTOK) * DM; mb = 4; }
        f32x4 v[4]; float ss = 0.f;
#pragma unroll
        for (int j = 0; j < 4; ++j) { v[j] = ((const f32x4*)xr)[T.lane + 64 * j]; ss += (v[j].x * v[j].x + v[j].y * v[j].y) + (v[j].z * v[j].z + v[j].w * v[j].w); }
        const float rstd = 1.0f / sqrtf(wave_sum(ss) * (1.f / DM) + EPS);
        const float* mod = F.MOD + mb * 3072;
#pragma unroll
        for (int j = 0; j < 4; ++j) { const int col = 4 * (T.lane + 64 * j);
            const f32x4 w = *(const f32x4*)(F.norm_w + col), sh = *(const f32x4*)(mod + col), sc = *(const f32x4*)(mod + 1024 + col);
            const f32x4 y = (v[j] * rstd * w) * (sc + 1.0f) + sh;
            u32x2 o; o.x = cvt_pk_bf16(y.x, y.y); o.y = cvt_pk_bf16(y.z, y.w);
            *(u32x2*)(F.XM + (size_t)m * DM + col) = o; }
    }
}
struct Sched1 {
    int G, c;
    DI bool next(int i, pg8::Unit& u) const { const int L = i * G + c; if (L >= 64 * 36) return false; pg8::tile_of(L, 64, 36, u); return true; }
};
struct SchedCtx {
    int c;
    DI bool next(int i, pg8::Unit& u) const { if (i > 0 || c >= 24) return false; u.pm = 64 + c / 6; u.pn = 18 + c % 6; return true; }
};
struct Epi1 {
    unsigned char* ws; bf16_t *R, *SGB; const f32x2* rope;
    DI void mid(f32x4 (&)[2][2][4][2], const pg8::Unit&, int, int, int, int) const {}
    DI void operator()(const f32x4 (&acc)[2][2][4][2], const pg8::Unit& u, int wr, int wc, int fr, int fq) const {
        const int pn = u.pn, row0 = u.pm * 256 + wr * 64 + fr, x0 = wc * 32 + 8 * fq;
        const bool isctx = u.pm >= 64;
        if (pn < 16) {
            bf16_t* dst = (bf16_t*)(ws + (wc < 2 ? WS_HC : WS_P)) + 64 * pn + (x0 & 63);
#pragma unroll
            for (int ai = 0; ai < 2; ++ai)
#pragma unroll
                for (int m = 0; m < 4; ++m) { const size_t row = row0 + ai * 128 + m * 16;
                    f32x4 o[2];
#pragma unroll
                    for (int n = 0; n < 2; ++n) { const f32x4 a = acc[ai][0][m][n], b = acc[ai][1][m][n];
                        if (wc < 2) o[n] = a * b;
                        else { o[n].x = a.x * siluf(b.x); o[n].y = a.y * siluf(b.y); o[n].z = a.z * siluf(b.z); o[n].w = a.w * siluf(b.w); } }
                    u32x4 w; w.x = cvt_pk_bf16(o[0].x, o[0].y); w.y = cvt_pk_bf16(o[0].z, o[0].w); w.z = cvt_pk_bf16(o[1].x, o[1].y); w.w = cvt_pk_bf16(o[1].z, o[1].w);
                    *(u32x4*)(dst + row * 1024) = w; }
        } else if (pn < 20) {
            const int t = (pn - 16) & 1, isk = (pn - 16) >> 1, head = 4 * t + wc, i0 = 8 * fq;
            const float scale = isk ? 0.125f : 1.0f;
            bf16_t* base = (bf16_t*)(ws + (isk ? (isctx ? WS_KC : WS_K) : WS_Q));
#pragma unroll
            for (int ai = 0; ai < 2; ++ai)
#pragma unroll
                for (int m = 0; m < 4; ++m) { const int row = row0 + ai * 128 + m * 16; const int orow = isctx ? row - MTOK : row;
                    const int pos = row & 4095, pidx = (fq < 2) ? (pos >> 6) : (pos & 63);
                    const f32x2* rp = rope + pidx * 16 + (fq & 1) * 8;
                    float o1[8], o2[8];
#pragma unroll
                    for (int e = 0; e < 8; ++e) { f32x2 cs = rp[e]; if (isctx) cs = (f32x2){1.f, 0.f};
                        const float t1 = acc[ai][0][m][e >> 2][e & 3], t2 = acc[ai][1][m][e >> 2][e & 3];
                        o1[e] = (t1 * cs.x - t2 * cs.y) * scale; o2[e] = (t1 * cs.y + t2 * cs.x) * scale; }
                    u32x4 w1, w2; w1.x = cvt_pk_bf16(o1[0], o1[1]); w1.y = cvt_pk_bf16(o1[2], o1[3]); w1.z = cvt_pk_bf16(o1[4], o1[5]); w1.w = cvt_pk_bf16(o1[6], o1[7]);
                    w2.x = cvt_pk_bf16(o2[0], o2[1]); w2.y = cvt_pk_bf16(o2[2], o2[3]); w2.z = cvt_pk_bf16(o2[4], o2[5]); w2.w = cvt_pk_bf16(o2[6], o2[7]);
                    bf16_t* d = base + (size_t)orow * 512 + head * 64 + i0;
                    *(u32x4*)d = w1; *(u32x4*)(d + 32) = w2; }
        } else if (pn < 28) {
            const bool isz = pn >= 24;
            bf16_t* base = (bf16_t*)(ws + (isz ? WS_SZB : (isctx ? WS_VC : WS_V)));
            const int colt = 256 * (pn - (isz ? 24 : 20)) + x0;
#pragma unroll
            for (int ai = 0; ai < 2; ++ai)
#pragma unroll
                for (int m = 0; m < 4; ++m) { const int row = row0 + ai * 128 + m * 16; const int orow = isctx ? row - MTOK : row;
#pragma unroll
                    for (int bj = 0; bj < 2; ++bj) { f32x4 a = acc[ai][bj][m][0], b = acc[ai][bj][m][1];
                        u32x4 w; w.x = cvt_pk_bf16(a.x, a.y); w.y = cvt_pk_bf16(a.z, a.w); w.z = cvt_pk_bf16(b.x, b.y); w.w = cvt_pk_bf16(b.z, b.w);
                        *(u32x4*)(base + (size_t)orow * 1024 + colt + bj * 128) = w; } }
        } else {
            const int col = 128 * (pn - 28) + x0;
#pragma unroll
            for (int ai = 0; ai < 2; ++ai)
#pragma unroll
                for (int m = 0; m < 4; ++m) { const size_t row = row0 + ai * 128 + m * 16;
                    float rr[8], sg[8];
#pragma unroll
                    for (int e = 0; e < 8; ++e) { const float ga = acc[ai][0][m][e >> 2][e & 3], gb = acc[ai][1][m][e >> 2][e & 3];
                        const float ea = __expf(-ga), eb = __expf(-gb); sg[e] = 1.f / (1.f + eb); rr[e] = (1.f + eb) / (1.f + ea); }
                    u32x4 w1, w2; w1.x = cvt_pk_bf16(rr[0], rr[1]); w1.y = cvt_pk_bf16(rr[2], rr[3]); w1.z = cvt_pk_bf16(rr[4], rr[5]); w1.w = cvt_pk_bf16(rr[6], rr[7]);
                    w2.x = cvt_pk_bf16(sg[0], sg[1]); w2.y = cvt_pk_bf16(sg[2], sg[3]); w2.z = cvt_pk_bf16(sg[4], sg[5]); w2.w = cvt_pk_bf16(sg[6], sg[7]);
                    *(u32x4*)(R + row * 1024 + col) = w1; *(u32x4*)(SGB + row * 1024 + col) = w2; }
        }
    }
};
DI void n2_inproj(const Ctx& F) {
    const Tid T = opaque_tid();
    const size_t NT = (size_t)gridDim.x * 512, gt = (size_t)blockIdx.x * 512 + T.tid;
    for (size_t idx = gt; idx < (size_t)(MALL / 4) * 1024; idx += NT) {
        const int ch = (int)(idx & 1023), t0 = (int)(idx >> 10) * 4;
        const bool doqk = ch < 512 && (ch & 63) < 32;
        float a[12][4];
#pragma unroll
        for (int o = 0; o < 12; ++o)
#pragma unroll
            for (int j = 0; j < 4; ++j) a[o][j] = 0.f;
        for (int k = 0; k < 1024; ++k) {
            const float* wr = F.w_in + (size_t)k * NIN;
            float xv[4];
#pragma unroll
            for (int j = 0; j < 4; ++j) xv[j] = bf2f(F.XM[(size_t)(t0 + j) * 1024 + k]);
            float w[12];
            w[0] = wr[ch]; w[1] = wr[1024 + ch]; w[2] = wr[2048 + ch]; w[3] = wr[3072 + ch]; w[4] = wr[5120 + ch]; w[5] = wr[6144 + ch]; w[6] = wr[7168 + ch]; w[7] = wr[8192 + ch];
            if (doqk) { w[8] = wr[4096 + ch]; w[9] = wr[4096 + ch + 32]; w[10] = wr[4608 + ch]; w[11] = wr[4608 + ch + 32]; } else { w[8] = w[9] = w[10] = w[11] = 0.f; }
#pragma unroll
            for (int o = 0; o < 12; ++o)
#pragma unroll
                for (int j = 0; j < 4; ++j) a[o][j] += xv[j] * w[o];
        }
#pragma unroll
        for (int j = 0; j < 4; ++j) { const int t = t0 + j;
            if (t < MTOK) {
                const size_t o = (size_t)t * 1024 + ch;
                F.HC[o] = f2bf(a[2][j] * a[0][j]); F.P[o] = f2bf(siluf(a[3][j]) * a[1][j]); F.V[o] = f2bf(a[4][j]); F.SZB[o] = f2bf(a[5][j]);
                const float sga = 1.f / (1.f + __expf(-a[6][j])), sgb = 1.f / (1.f + __expf(-a[7][j]));
                F.R[o] = f2bf(sga / sgb); F.SGB[o] = f2bf(sgb);
                if (doqk) { const int i = ch & 63, pos = t & 4095; const int pidx = i < 16 ? (pos >> 6) : (pos & 63); const f32x2 cs = F.ROPE[pidx * 16 + (i & 15)];
                    const size_t q = (size_t)t * 512 + ch;
                    F.Q[q] = f2bf(a[8][j] * cs.x - a[9][j] * cs.y); F.Q[q + 32] = f2bf(a[8][j] * cs.y + a[9][j] * cs.x);
                    F.K[q] = f2bf((a[10][j] * cs.x - a[11][j] * cs.y) * 0.125f); F.K[q + 32] = f2bf((a[10][j] * cs.y + a[11][j] * cs.x) * 0.125f); }
            } else {
                const int tc = t - MTOK;
                F.VC[(size_t)tc * 1024 + ch] = f2bf(a[4][j]);
                if (doqk) { F.KC[(size_t)tc * 512 + ch] = f2bf(a[10][j] * 0.125f); F.KC[(size_t)tc * 512 + ch + 32] = f2bf(a[11][j] * 0.125f); }
            }
        }
    }
}
DI bf16x8 tr2(const LAS unsigned char* p, int delta) {
    const s16x4 lo = __builtin_bit_cast(s16x4, __builtin_amdgcn_ds_read_tr16_b64_v4i16((LAS v4i16_t*)p));
    const s16x4 hi = __builtin_bit_cast(s16x4, __builtin_amdgcn_ds_read_tr16_b64_v4i16((LAS v4i16_t*)(p + delta)));
    return __builtin_shufflevector(lo, hi, 0, 1, 2, 3, 4, 5, 6, 7);
}
DI u32x4 scale8(u32x4 w, float s) {
    u32x4 o; o.x = cvt_pk_bf16(bflo(w.x) * s, bfhi(w.x) * s); o.y = cvt_pk_bf16(bflo(w.y) * s, bfhi(w.y) * s); o.z = cvt_pk_bf16(bflo(w.z) * s, bfhi(w.z) * s); o.w = cvt_pk_bf16(bflo(w.w) * s, bfhi(w.w) * s); return o;
}
DI void p3_kv(const Ctx& F, int it0, int it1, int stride) {
    const Tid T = opaque_tid();
    LAS unsigned char* KFI = F.lds; LAS unsigned char* KBI = F.lds + 20480; LAS unsigned char* VI = F.lds + 40960;
    const int tid = T.tid, lane = T.lane, w = T.wave, g = lane >> 4, q = (lane & 15) >> 2, p = lane & 3;
    const int row = tid >> 2, seg = tid & 3;
    u32x4 pk[2], pv[4];
    auto prefetch = [&](int it) { const int bh = it >> 5, c = it & 31; const size_t tok0 = (size_t)(bh >> 3) * SEQ + c * CHK;
        const bf16_t* kp = F.K + tok0 * 512 + (bh & 7) * 64; const bf16_t* vp = F.V + tok0 * 1024 + (bh & 7) * 128;
        pk[0] = *(const u32x4*)(kp + (size_t)row * 512 + seg * 16); pk[1] = *(const u32x4*)(kp + (size_t)row * 512 + seg * 16 + 8);
#pragma unroll
        for (int i = 0; i < 4; ++i) pv[i] = *(const u32x4*)(vp + (size_t)row * 1024 + seg * 32 + 8 * i); };
    if (it0 < it1) prefetch(it0);
    for (int it = it0; it < it1; it += stride) {
        const int bh = it >> 5, c = it & 31;
        const float l2f = log2_gamma(F.decay_logit, 0, bh & 7), l2b = log2_gamma(F.decay_logit, 1, bh & 7);
        { const float df = __builtin_amdgcn_exp2f(l2f * (float)(127 - row)), db = __builtin_amdgcn_exp2f(l2b * (float)row);
            *(LAS u32x4*)(KFI + row * 160 + seg * 32) = scale8(pk[0], df); *(LAS u32x4*)(KFI + row * 160 + seg * 32 + 16) = scale8(pk[1], df);
            *(LAS u32x4*)(KBI + row * 160 + seg * 32) = scale8(pk[0], db); *(LAS u32x4*)(KBI + row * 160 + seg * 32 + 16) = scale8(pk[1], db);
#pragma unroll
            for (int i = 0; i < 4; ++i) *(LAS u32x4*)(VI + row * 288 + seg * 64 + 16 * i) = pv[i]; }
        __syncthreads();
        if (it + stride < it1) prefetch(it + stride);
        f32x4 acc[2][4];
#pragma unroll
        for (int d = 0; d < 2; ++d)
#pragma unroll
            for (int nb = 0; nb < 4; ++nb) acc[d][nb] = (f32x4){0.f, 0.f, 0.f, 0.f};
#pragma unroll
        for (int s2 = 0; s2 < 4; ++s2) {
            const bf16x8 vb = tr2(VI + (32 * s2 + 8 * g + q) * 288 + (16 * w + 4 * p) * 2, 4 * 288);
#pragma unroll
            for (int nb = 0; nb < 4; ++nb) {
                const bf16x8 kf = tr2(KFI + (32 * s2 + 8 * g + q) * 160 + (16 * nb + 4 * p) * 2, 4 * 160);
                const bf16x8 kb = tr2(KBI + (32 * s2 + 8 * g + q) * 160 + (16 * nb + 4 * p) * 2, 4 * 160);
                acc[0][nb] = __builtin_amdgcn_mfma_f32_16x16x32_bf16(kf, vb, acc[0][nb], 0, 0, 0);
                acc[1][nb] = __builtin_amdgcn_mfma_f32_16x16x32_bf16(kb, vb, acc[1][nb], 0, 0, 0);
            }
        }
        bf16_t* of = F.KV + ((size_t)(0 * 32 + bh) * 32 + c) * 8192; bf16_t* ob = F.KV + ((size_t)(1 * 32 + bh) * 32 + c) * 8192;
#pragma unroll
        for (int nb = 0; nb < 4; ++nb) { const int o = (16 * w + (lane & 15)) * 64 + 16 * nb + 4 * g;
            u32x2 a, b; a.x = cvt_pk_bf16(acc[0][nb].x, acc[0][nb].y); a.y = cvt_pk_bf16(acc[0][nb].z, acc[0][nb].w); b.x = cvt_pk_bf16(acc[1][nb].x, acc[1][nb].y); b.y = cvt_pk_bf16(acc[1][nb].z, acc[1][nb].w);
            *(u32x2*)(of + o) = a; *(u32x2*)(ob + o) = b; }
        __syncthreads();
    }
}
DI void p4_ctx_state(const Ctx& F, int bh) {
    const Tid T = opaque_tid();
    LAS unsigned char* KFI = F.lds; LAS unsigned char* KBI = F.lds + 20480; LAS unsigned char* VI = F.lds + 40960;
    const int tid = T.tid, lane = T.lane, w = T.wave, g = lane >> 4, q = (lane & 15) >> 2, p = lane & 3;
    const int row = tid >> 2, seg = tid & 3;
    const float l2f = log2_gamma(F.decay_logit, 0, bh & 7), l2b = log2_gamma(F.decay_logit, 1, bh & 7);
    f32x4 acc[2][4];
#pragma unroll
    for (int d = 0; d < 2; ++d)
#pragma unroll
        for (int nb = 0; nb < 4; ++nb) acc[d][nb] = (f32x4){0.f, 0.f, 0.f, 0.f};
    for (int cc = 0; cc < 2; ++cc) {
        const size_t tok0 = (size_t)(bh >> 3) * CTXL + cc * CHK; const int m = cc * CHK + row;
        const bf16_t* kp = F.KC + tok0 * 512 + (bh & 7) * 64; const bf16_t* vp = F.VC + tok0 * 1024 + (bh & 7) * 128;
        const u32x4 k0 = *(const u32x4*)(kp + (size_t)row * 512 + seg * 16), k1 = *(const u32x4*)(kp + (size_t)row * 512 + seg * 16 + 8);
        const float df = __builtin_amdgcn_exp2f(l2f * (float)(255 - m)), db = __builtin_amdgcn_exp2f(l2b * (float)m);
        *(LAS u32x4*)(KFI + row * 160 + seg * 32) = scale8(k0, df); *(LAS u32x4*)(KFI + row * 160 + seg * 32 + 16) = scale8(k1, df);
        *(LAS u32x4*)(KBI + row * 160 + seg * 32) = scale8(k0, db); *(LAS u32x4*)(KBI + row * 160 + seg * 32 + 16) = scale8(k1, db);
#pragma unroll
        for (int i = 0; i < 4; ++i) *(LAS u32x4*)(VI + row * 288 + seg * 64 + 16 * i) = *(const u32x4*)(vp + (size_t)row * 1024 + seg * 32 + 8 * i);
        __syncthreads();
#pragma unroll
        for (int s2 = 0; s2 < 4; ++s2) {
            const bf16x8 vb = tr2(VI + (32 * s2 + 8 * g + q) * 288 + (16 * w + 4 * p) * 2, 4 * 288);
#pragma unroll
            for (int nb = 0; nb < 4; ++nb) {
                const bf16x8 kf = tr2(KFI + (32 * s2 + 8 * g + q) * 160 + (16 * nb + 4 * p) * 2, 4 * 160);
                const bf16x8 kb = tr2(KBI + (32 * s2 + 8 * g + q) * 160 + (16 * nb + 4 * p) * 2, 4 * 160);
                acc[0][nb] = __builtin_amdgcn_mfma_f32_16x16x32_bf16(kf, vb, acc[0][nb], 0, 0, 0);
                acc[1][nb] = __builtin_amdgcn_mfma_f32_16x16x32_bf16(kb, vb, acc[1][nb], 0, 0, 0);
            }
        }
        __syncthreads();
    }
    float* of = F.S0 + (size_t)(0 * 32 + bh) * 8192; float* ob = F.S0 + (size_t)(1 * 32 + bh) * 8192;
#pragma unroll
    for (int nb = 0; nb < 4; ++nb) { const int o = (16 * w + (lane & 15)) * 64 + 16 * nb + 4 * g; *(f32x4*)(of + o) = acc[0][nb]; *(f32x4*)(ob + o) = acc[1][nb]; }
}
DI void p3_ua(const Ctx& F, int blk, int nblk) {
    const Tid T = opaque_tid();
    const size_t NT = (size_t)nblk * 512, gt = (size_t)blk * 512 + T.tid;
    for (size_t idx = gt; idx < (size_t)MTOK * 128; idx += NT) {
        const int t = (int)(idx >> 7), c8 = (int)(idx & 127) * 8, pos = t & 4095;
        const bf16_t* hp = F.HC + (size_t)t * 1024 + c8;
        const u32x4 z = (u32x4){0u, 0u, 0u, 0u};
        const u32x4 h0 = pos > 0 ? *(const u32x4*)(hp - 1024) : z, h1 = *(const u32x4*)hp, h2 = pos < SEQ - 1 ? *(const u32x4*)(hp + 1024) : z;
        const u32x4 pv = *(const u32x4*)(F.P + (size_t)t * 1024 + c8);
        float o[8];
#pragma unroll
        for (int e = 0; e < 8; ++e) { const unsigned a = h0[e >> 1], b = h1[e >> 1], c = h2[e >> 1], pp = pv[e >> 1];
            const float x0 = (e & 1) ? bfhi(a) : bflo(a), x1 = (e & 1) ? bfhi(b) : bflo(b), x2 = (e & 1) ? bfhi(c) : bflo(c), pf = (e & 1) ? bfhi(pp) : bflo(pp);
            const float cv = F.conv_w[c8 + e] * x0 + F.conv_w[1024 + c8 + e] * x1 + F.conv_w[2048 + c8 + e] * x2 + F.conv_b[c8 + e];
            o[e] = pf * cv; }
        u32x4 w; w.x = cvt_pk_bf16(o[0], o[1]); w.y = cvt_pk_bf16(o[2], o[3]); w.z = cvt_pk_bf16(o[4], o[5]); w.w = cvt_pk_bf16(o[6], o[7]);
        *(u32x4*)(F.P + (size_t)t * 1024 + c8) = w;
    }
}
DI void p4_scan(const Ctx& F) {
    const Tid T = opaque_tid();
    const size_t NT = (size_t)gridDim.x * 512, gt = (size_t)blockIdx.x * 512 + T.tid;
    for (size_t idx = gt; idx < (size_t)2 * 32 * 4096; idx += NT) {
        const int e2 = (int)(idx & 4095), bh = (int)(idx >> 12) & 31, dir = (int)(idx >> 17);
        const float g = exp2f(log2_gamma(F.decay_logit, dir, bh & 7) * 128.f);
        const unsigned* kv = (const unsigned*)(F.KV + ((size_t)(dir * 32 + bh) * 32) * 8192) + e2;
        unsigned* st = (unsigned*)(F.ST + ((size_t)(dir * 32 + bh) * 32) * 8192) + e2;
        float s0 = 0.f, s1 = 0.f;
#pragma unroll 8
        for (int i = 0; i < 32; ++i) { const int c = dir == 0 ? i : 31 - i;
            const unsigned v = kv[(size_t)c * 4096];
            st[(size_t)c * 4096] = cvt_pk_bf16(s0, s1);
            s0 = g * s0 + bflo(v); s1 = g * s1 + bfhi(v); }
    }
}
DI void n4_recurrence(const Ctx& F) {
    const Tid T = opaque_tid();
    const int gw = blockIdx.x * 8 + T.wave, NGW = gridDim.x * 8, d = T.lane;
    for (int task = gw; task < 32 * 128; task += NGW) {
        const int bh = task >> 7, v = task & 127, b = bh >> 3, h = bh & 7;
        const float gf = exp2f(log2_gamma(F.decay_logit, 0, h)), gb = exp2f(log2_gamma(F.decay_logit, 1, h));
        float s = 0.f;
        for (int m = 0; m < CTXL; ++m) { const size_t t = (size_t)b * CTXL + m; s = gf * s + bf2f(F.KC[t * 512 + h * 64 + d]) * bf2f(F.VC[t * 1024 + h * 128 + v]); }
        const float sF = s; s = 0.f;
        for (int m = CTXL - 1; m >= 0; --m) { const size_t t = (size_t)b * CTXL + m; s = gb * s + bf2f(F.KC[t * 512 + h * 64 + d]) * bf2f(F.VC[t * 1024 + h * 128 + v]); }
        const float sB = s;
        s = sF;
        for (int n = 0; n < SEQ; ++n) { const size_t t = (size_t)b * SEQ + n; s = gf * s + bf2f(F.K[t * 512 + h * 64 + d]) * bf2f(F.V[t * 1024 + h * 128 + v]);
            const float o = wave_sum(bf2f(F.Q[t * 512 + h * 64 + d]) * s); if (d == 0) F.RET[t * 1024 + h * 128 + v] = o; }
        s = sB;
        for (int n = SEQ - 1; n >= 0; --n) { const size_t t = (size_t)b * SEQ + n; s = gb * s + bf2f(F.K[t * 512 + h * 64 + d]) * bf2f(F.V[t * 1024 + h * 128 + v]);
            const float o = wave_sum(bf2f(F.Q[t * 512 + h * 64 + d]) * s); if (d == 0) F.RET[t * 1024 + h * 128 + v] += o; }
    }
}
DI void n5_groupnorm(const Ctx& F) {
    const Tid T = opaque_tid();
    const int gw = blockIdx.x * 8 + T.wave, NGW = gridDim.x * 8;
    for (int task = gw; task < MTOK * NH; task += NGW) {
        const int t = task >> 3, h = task & 7; const size_t o = (size_t)t * 1024 + h * 128 + 2 * T.lane;
        const float a = F.RET[o], b = F.RET[o + 1];
        const float mu = wave_sum(a + b) * (1.f / 128.f); const float da = a - mu, db = b - mu;
        const float var = wave_sum(da * da + db * db) * (1.f / 128.f); const float rstd = 1.0f / sqrtf(var + EPS);
        const float ra = da * rstd * F.gn_w[h * 128 + 2 * T.lane], rb = db * rstd * F.gn_w[h * 128 + 2 * T.lane + 1];
        *(unsigned*)(F.UB + o) = cvt_pk_bf16(siluf(bf2f(F.SZB[o])) * ra, siluf(bf2f(F.SZB[o + 1])) * rb);
    }
}
DI void p5_ret(const Ctx& F) {
    const Tid T = opaque_tid();
    LAS unsigned char* KI = F.lds; LAS unsigned char* VI = F.lds + 20480; LAS unsigned char* SF = F.lds + 57344; LAS unsigned char* SB = F.lds + 75776;
    LAS unsigned char* S0F = F.lds + 94208; LAS unsigned char* S0B = F.lds + 110592;
    const int tid = T.tid, lane = T.lane, w = T.wave, g = lane >> 4, q = (lane & 15) >> 2, p = lane & 3, l15 = lane & 15;
    const int row = tid >> 2, seg = tid & 3, il = 16 * w + l15;
    for (int base = blockIdx.x * 4; base < 1024; base += gridDim.x * 4) {
        const int bh = base >> 5, h = bh & 7;
        const float l2f = log2_gamma(F.decay_logit, 0, h), l2b = log2_gamma(F.decay_logit, 1, h);
        { const float* s0f = F.S0 + (size_t)(0 * 32 + bh) * 8192 + row * 64 + seg * 16; const float* s0b = F.S0 + (size_t)(1 * 32 + bh) * 8192 + row * 64 + seg * 16;
#pragma unroll
            for (int i = 0; i < 2; ++i) { const f32x4 a0 = *(const f32x4*)(s0f + 8 * i), a1 = *(const f32x4*)(s0f + 8 * i + 4), b0 = *(const f32x4*)(s0b + 8 * i), b1 = *(const f32x4*)(s0b + 8 * i + 4);
                u32x4 x, y; x.x = cvt_pk_bf16(a0.x, a0.y); x.y = cvt_pk_bf16(a0.z, a0.w); x.z = cvt_pk_bf16(a1.x, a1.y); x.w = cvt_pk_bf16(a1.z, a1.w);
                y.x = cvt_pk_bf16(b0.x, b0.y); y.y = cvt_pk_bf16(b0.z, b0.w); y.z = cvt_pk_bf16(b1.x, b1.y); y.w = cvt_pk_bf16(b1.z, b1.w);
                *(LAS u32x4*)(S0F + row * 128 + seg * 32 + 16 * i) = x; *(LAS u32x4*)(S0B + row * 128 + seg * 32 + 16 * i) = y; } }
        u32x4 pk[2], pv[4], pf0[2], pb0[2]; bf16x8 pq[2];
        auto prefetch = [&](int it) { const int c = it & 31; const size_t tok0 = (size_t)(bh >> 3) * SEQ + c * CHK;
            const bf16_t* kp = F.K + tok0 * 512 + h * 64; const bf16_t* vp = F.V + tok0 * 1024 + h * 128; const bf16_t* qp = F.Q + tok0 * 512 + h * 64;
            const bf16_t* stf = F.ST + ((size_t)(0 * 32 + bh) * 32 + c) * 8192; const bf16_t* stb = F.ST + ((size_t)(1 * 32 + bh) * 32 + c) * 8192;
#pragma unroll
            for (int i = 0; i < 2; ++i) { pk[i] = *(const u32x4*)(kp + (size_t)row * 512 + seg * 16 + 8 * i); pf0[i] = *(const u32x4*)(stf + row * 64 + seg * 16 + 8 * i); pb0[i] = *(const u32x4*)(stb + row * 64 + seg * 16 + 8 * i);
                pq[i] = *(const bf16x8*)(qp + (size_t)il * 512 + 32 * i + 8 * g); }
#pragma unroll
            for (int i = 0; i < 4; ++i) pv[i] = *(const u32x4*)(vp + (size_t)row * 1024 + seg * 32 + 8 * i); };
        prefetch(base);
        for (int k = 0; k < 4; ++k) {
            const int it = base + k, c = it & 31; const size_t tok0 = (size_t)(bh >> 3) * SEQ + c * CHK;
            { const float cf = __builtin_amdgcn_exp2f(l2f * 128.f * (float)c), cb = __builtin_amdgcn_exp2f(l2b * 128.f * (float)(31 - c));
#pragma unroll
                for (int i = 0; i < 2; ++i) { *(LAS u32x4*)(KI + row * 160 + seg * 32 + 16 * i) = pk[i];
                    const u32x4 x = *(const LAS u32x4*)(S0F + row * 128 + seg * 32 + 16 * i), y = *(const LAS u32x4*)(S0B + row * 128 + seg * 32 + 16 * i);
                    u32x4 of, ob;
#pragma unroll
                    for (int e = 0; e < 4; ++e) { of[e] = cvt_pk_bf16(bflo(pf0[i][e]) + cf * bflo(x[e]), bfhi(pf0[i][e]) + cf * bfhi(x[e])); ob[e] = cvt_pk_bf16(bflo(pb0[i][e]) + cb * bflo(y[e]), bfhi(pb0[i][e]) + cb * bfhi(y[e])); }
                    *(LAS u32x4*)(SF + row * 144 + seg * 32 + 16 * i) = of; *(LAS u32x4*)(SB + row * 144 + seg * 32 + 16 * i) = ob; }
#pragma unroll
                for (int i = 0; i < 4; ++i) *(LAS u32x4*)(VI + row * 288 + seg * 64 + 16 * i) = pv[i]; }
            bf16x8 qf[2]; qf[0] = pq[0]; qf[1] = pq[1];
            __syncthreads();
            if (k < 3) prefetch(it + 1);
            f32x4 accS[8];
#pragma unroll
            for (int jb = 0; jb < 8; ++jb) { accS[jb] = (f32x4){0.f, 0.f, 0.f, 0.f};
#pragma unroll
                for (int ks = 0; ks < 2; ++ks) { const bf16x8 kf = *(const LAS bf16x8*)(KI + (16 * jb + l15) * 160 + (32 * ks + 8 * g) * 2);
                    accS[jb] = __builtin_amdgcn_mfma_f32_16x16x32_bf16(kf, qf[ks], accS[jb], 0, 0, 0); } }
            bf16x8 pf[4];
#pragma unroll
            for (int s2 = 0; s2 < 4; ++s2) { float pe[8];
#pragma unroll
                for (int e = 0; e < 8; ++e) { const int jb = 2 * s2 + (e >> 2), r = e & 3, j = 16 * jb + 4 * g + r, df = il - j;
                    float mk = __builtin_amdgcn_exp2f((df >= 0 ? l2f : -l2b) * (float)df); if (df == 0) mk = 2.f;
                    pe[e] = accS[jb][r] * mk; }
                u32x4 pw; pw.x = cvt_pk_bf16(pe[0], pe[1]); pw.y = cvt_pk_bf16(pe[2], pe[3]); pw.z = cvt_pk_bf16(pe[4], pe[5]); pw.w = cvt_pk_bf16(pe[6], pe[7]);
                pf[s2] = __builtin_bit_cast(bf16x8, pw); }
            const float decf = __builtin_amdgcn_exp2f(l2f * (float)(il + 1)), decb = __builtin_amdgcn_exp2f(l2b * (float)(128 - il));
            f32x4 accO[8];
#pragma unroll
            for (int vb = 0; vb < 8; ++vb) { f32x4 o = (f32x4){0.f, 0.f, 0.f, 0.f};
#pragma unroll
                for (int s2 = 0; s2 < 4; ++s2) { const bf16x8 vf = tr2(VI + (32 * s2 + 4 * g + q) * 288 + (16 * vb + 4 * p) * 2, 16 * 288);
                    o = __builtin_amdgcn_mfma_f32_16x16x32_bf16(vf, pf[s2], o, 0, 0, 0); }
                f32x4 tf = (f32x4){0.f, 0.f, 0.f, 0.f}, tb = (f32x4){0.f, 0.f, 0.f, 0.f};
#pragma unroll
                for (int ks = 0; ks < 2; ++ks) { const bf16x8 sf = *(const LAS bf16x8*)(SF + (16 * vb + l15) * 144 + (32 * ks + 8 * g) * 2);
                    const bf16x8 sb = *(const LAS bf16x8*)(SB + (16 * vb + l15) * 144 + (32 * ks + 8 * g) * 2);
                    tf = __builtin_amdgcn_mfma_f32_16x16x32_bf16(sf, qf[ks], tf, 0, 0, 0); tb = __builtin_amdgcn_mfma_f32_16x16x32_bf16(sb, qf[ks], tb, 0, 0, 0); }
                accO[vb] = o + tf * decf + tb * decb; __builtin_amdgcn_sched_barrier(0); }
            float sm = 0.f;
#pragma unroll
            for (int vb = 0; vb < 8; ++vb) sm += (accO[vb].x + accO[vb].y) + (accO[vb].z + accO[vb].w);
            sm += __shfl_xor(sm, 16); sm += __shfl_xor(sm, 32);
            const float mu = sm * (1.f / 128.f); float sq = 0.f;
#pragma unroll
            for (int vb = 0; vb < 8; ++vb) { accO[vb] = accO[vb] - mu; sq += (accO[vb].x * accO[vb].x + accO[vb].y * accO[vb].y) + (accO[vb].z * accO[vb].z + accO[vb].w * accO[vb].w); }
            sq += __shfl_xor(sq, 16); sq += __shfl_xor(sq, 32);
            const float rstd = 1.0f / sqrtf(sq * (1.f / 128.f) + EPS);
            __syncthreads();
#pragma unroll
            for (int vb = 0; vb < 8; ++vb) { const f32x4 gw = *(const f32x4*)(F.gn_w + h * 128 + 16 * vb + 4 * g); const f32x4 o = accO[vb] * rstd * gw;
                u32x2 ow; ow.x = cvt_pk_bf16(o.x, o.y); ow.y = cvt_pk_bf16(o.z, o.w);
                *(LAS u32x2*)(VI + il * 288 + (16 * vb + 4 * g) * 2) = ow; }
            __syncthreads();
            { const size_t go = (tok0 + row) * 1024 + h * 128 + seg * 32;
#pragma unroll
                for (int i = 0; i < 4; ++i) { const u32x4 o = *(const LAS u32x4*)(VI + row * 288 + seg * 64 + 16 * i); const u32x4 z = *(const u32x4*)(F.SZB + go + 8 * i);
                    u32x4 r;
#pragma unroll
                    for (int e = 0; e < 4; ++e) r[e] = cvt_pk_bf16(bflo(o[e]) * siluf(bflo(z[e])), bfhi(o[e]) * siluf(bfhi(z[e])));
                    *(u32x4*)(F.UB + go + 8 * i) = r; } }
            __syncthreads();
        }
    }
}
struct SchedSq { int G, c; DI bool next(int i, pg8::Unit& u) const { const int L = i * G + c; if (L >= 256) return false; pg8::tile_of(L, 64, 4, u); return true; } };
struct EpiAB {
    const bf16_t* R; const bf16_t* SGB; bf16_t* MM;
    DI void mid(f32x4 (&acc)[2][2][4][2], const pg8::Unit& u, int wr, int wc, int fr, int fq) const { apply<false>(acc, u, wr, wc, fr, fq); }
    DI void operator()(const f32x4 (&acc)[2][2][4][2], const pg8::Unit& u, int wr, int wc, int fr, int fq) const { apply<true>(const_cast<f32x4 (&)[2][2][4][2]>(acc), u, wr, wc, fr, fq); }
    template <bool FIN> DI void apply(f32x4 (&acc)[2][2][4][2], const pg8::Unit& u, int wr, int wc, int fr, int fq) const {
        const bf16_t* src = FIN ? SGB : R;
        const size_t base = (size_t)(u.pm * 256 + wr * 64 + fr) * 1024 + u.pn * 256 + wc * 32 + 8 * fq;
#pragma unroll
        for (int am = 0; am < 4; ++am) { const int ai = am >> 1;
            u32x4 gv[4][2];
#pragma unroll
            for (int m = 2 * (am & 1); m < 2 * (am & 1) + 2; ++m)
#pragma unroll
                for (int bj = 0; bj < 2; ++bj) gv[m][bj] = *(const u32x4*)(src + base + (size_t)(ai * 128 + m * 16) * 1024 + bj * 128);
#pragma unroll
            for (int m = 2 * (am & 1); m < 2 * (am & 1) + 2; ++m)
#pragma unroll
                for (int bj = 0; bj < 2; ++bj) { const u32x4 gq = gv[m][bj];
                    f32x4 a = acc[ai][bj][m][0], b = acc[ai][bj][m][1];
                    a.x *= bflo(gq.x); a.y *= bfhi(gq.x); a.z *= bflo(gq.y); a.w *= bfhi(gq.y); b.x *= bflo(gq.z); b.y *= bfhi(gq.z); b.z *= bflo(gq.w); b.w *= bfhi(gq.w);
                    if (FIN) { u32x4 w; w.x = cvt_pk_bf16(a.x, a.y); w.y = cvt_pk_bf16(a.z, a.w); w.z = cvt_pk_bf16(b.x, b.y); w.w = cvt_pk_bf16(b.z, b.w);
                        *(u32x4*)(MM + base + (size_t)(ai * 128 + m * 16) * 1024 + bj * 128) = w; }
                    else { acc[ai][bj][m][0] = a; acc[ai][bj][m][1] = b; } }
            asm volatile("" ::: "memory");
        }
    }
};
struct EpiOut {
    const float* x; const float* MOD; float* out;
    DI void mid(f32x4 (&)[2][2][4][2], const pg8::Unit&, int, int, int, int) const {}
    DI void operator()(const f32x4 (&acc)[2][2][4][2], const pg8::Unit& u, int wr, int wc, int fr, int fq) const {
        const int col0 = u.pn * 256 + wc * 32 + 8 * fq; const float* gp = MOD + (u.pm >> 4) * 3072 + 2048 + col0;
        f32x4 gx[2][2];
#pragma unroll
        for (int bj = 0; bj < 2; ++bj)
#pragma unroll
            for (int n = 0; n < 2; ++n) gx[bj][n] = *(const f32x4*)(gp + bj * 128 + 4 * n);
#pragma unroll
        for (int ai = 0; ai < 2; ++ai)
#pragma unroll
            for (int m = 0; m < 4; ++m) { const size_t off = (size_t)(u.pm * 256 + ai * 128 + wr * 64 + m * 16 + fr) * 1024 + col0;
#pragma unroll
                for (int bj = 0; bj < 2; ++bj)
#pragma unroll
                    for (int n = 0; n < 2; ++n) { const f32x4 xv = *(const f32x4*)(x + off + bj * 128 + 4 * n); *(f32x4*)(out + off + bj * 128 + 4 * n) = xv + gx[bj][n] * acc[ai][bj][m][n]; }
                if (m & 1) asm volatile("" ::: "memory"); }
    }
};
struct EpiOutNorm {
    const float* x; const float* MOD; float* out; const float* fw; float* slots; unsigned* cnt; LAS float* tab;
    DI void mid(f32x4 (&)[2][2][4][2], const pg8::Unit&, int, int, int, int) const {}
    DI void operator()(const f32x4 (&acc_)[2][2][4][2], const pg8::Unit& u, int wr, int wc, int fr, int fq) const {
        f32x4 (&acc)[2][2][4][2] = const_cast<f32x4 (&)[2][2][4][2]>(acc_);
        const int col0 = u.pn * 256 + wc * 32 + 8 * fq; const float* gp = MOD + (u.pm >> 4) * 3072 + 2048 + col0;
        f32x4 gx[2][2];
#pragma unroll
        for (int bj = 0; bj < 2; ++bj)
#pragma unroll
            for (int n = 0; n < 2; ++n) gx[bj][n] = *(const f32x4*)(gp + bj * 128 + 4 * n);
#pragma unroll
        for (int ai = 0; ai < 2; ++ai)
#pragma unroll
            for (int m = 0; m < 4; ++m) { const int row = u.pm * 256 + ai * 128 + wr * 64 + m * 16 + fr; const size_t off = (size_t)row * 1024 + col0; float ss = 0.f;
#pragma unroll
                for (int bj = 0; bj < 2; ++bj)
#pragma unroll
                    for (int n = 0; n < 2; ++n) { const f32x4 xv = *(const f32x4*)(x + off + bj * 128 + 4 * n); const f32x4 v = xv + gx[bj][n] * acc[ai][bj][m][n]; acc[ai][bj][m][n] = v;
                        ss += (v.x * v.x + v.y * v.y) + (v.z * v.z + v.w * v.w); }
                ss += __shfl_xor(ss, 16); ss += __shfl_xor(ss, 32);
                if (fq == 0) __hip_atomic_store(slots + (size_t)row * 16 + u.pn * 4 + wc, ss, __ATOMIC_RELAXED, __HIP_MEMORY_SCOPE_AGENT);
                if (m & 1) asm volatile("" ::: "memory"); }
        asm volatile("s_waitcnt vmcnt(0)" ::: "memory");
        __syncthreads();
        if (threadIdx.x == 0) {
            unsigned* c = cnt + 64 * u.pm;
            __hip_atomic_fetch_add(c, 1u, __ATOMIC_RELAXED, __HIP_MEMORY_SCOPE_AGENT);
            unsigned sp = 0;
            while (__hip_atomic_load(c, __ATOMIC_RELAXED, __HIP_MEMORY_SCOPE_AGENT) < 4u) { __builtin_amdgcn_s_sleep(1); if (++sp > (1u << 22)) break; }
            __builtin_amdgcn_fence(__ATOMIC_ACQUIRE, "agent");
            asm volatile("s_waitcnt vmcnt(0)" ::: "memory");
        }
        __syncthreads();
        { const int t = threadIdx.x, row = t >> 1, half = t & 1; const float* sp = slots + (size_t)(u.pm * 256 + row) * 16 + half * 8; float s = 0.f;
#pragma unroll
            for (int j = 0; j < 8; ++j) s += __hip_atomic_load(sp + j, __ATOMIC_RELAXED, __HIP_MEMORY_SCOPE_AGENT);
            s += __shfl_xor(s, 1);
            if (half == 0) tab[row] = 1.0f / sqrtf(s * (1.f / 1024.f) + EPS); }
        __syncthreads();
        f32x4 fv[2][2];
#pragma unroll
        for (int bj = 0; bj < 2; ++bj)
#pragma unroll
            for (int n = 0; n < 2; ++n) fv[bj][n] = *(const f32x4*)(fw + col0 + bj * 128 + 4 * n);
#pragma unroll
        for (int ai = 0; ai < 2; ++ai)
#pragma unroll
            for (int m = 0; m < 4; ++m) { const int rl = ai * 128 + wr * 64 + m * 16 + fr; const float r = tab[rl]; const size_t off = (size_t)(u.pm * 256 + rl) * 1024 + col0;
#pragma unroll
                for (int bj = 0; bj < 2; ++bj)
#pragma unroll
                    for (int n = 0; n < 2; ++n) *(f32x4*)(out + off + bj * 128 + 4 * n) = acc[ai][bj][m][n] * r * fv[bj][n]; }
    }
};
DI void n6_ab(const Ctx& F) {
    const Tid T = opaque_tid();
    const size_t NT = (size_t)gridDim.x * 512, gt = (size_t)blockIdx.x * 512 + T.tid;
    for (size_t idx = gt; idx < (size_t)(MTOK / 4) * 1024; idx += NT) {
        const int n = (int)(idx & 1023), t0 = (int)(idx >> 10) * 4; float ya[4] = {0.f, 0.f, 0.f, 0.f}, yb[4] = {0.f, 0.f, 0.f, 0.f};
        for (int k = 0; k < 1024; ++k) { const float wa = F.w_a[(size_t)k * 1024 + n], wb = F.w_b[(size_t)k * 1024 + n];
#pragma unroll
            for (int j = 0; j < 4; ++j) { ya[j] += bf2f(F.P[(size_t)(t0 + j) * 1024 + k]) * wa; yb[j] += bf2f(F.UB[(size_t)(t0 + j) * 1024 + k]) * wb; } }
#pragma unroll
        for (int j = 0; j < 4; ++j) { const size_t o = (size_t)(t0 + j) * 1024 + n; const float sgb = bf2f(F.SGB[o]), sga = bf2f(F.R[o]) * sgb; F.MM[o] = f2bf(sga * ya[j] + sgb * yb[j]); }
    }
}
DI void n7_out(const Ctx& F) {
    const Tid T = opaque_tid();
    const size_t NT = (size_t)gridDim.x * 512, gt = (size_t)blockIdx.x * 512 + T.tid;
    for (size_t idx = gt; idx < (size_t)(MTOK / 4) * 1024; idx += NT) {
        const int n = (int)(idx & 1023), t0 = (int)(idx >> 10) * 4; float y[4] = {0.f, 0.f, 0.f, 0.f};
        for (int k = 0; k < 1024; ++k) { const float w = F.w_out[(size_t)k * 1024 + n];
#pragma unroll
            for (int j = 0; j < 4; ++j) y[j] += bf2f(F.MM[(size_t)(t0 + j) * 1024 + k]) * w; }
#pragma unroll
        for (int j = 0; j < 4; ++j) { const size_t o = (size_t)(t0 + j) * 1024 + n; F.out[o] = F.x[o] + F.MOD[((t0 + j) >> 12) * 3072 + 2048 + n] * y[j]; }
    }
}
DI void p8_final(const Ctx& F) {
    const Tid T = opaque_tid();
    const int gw = blockIdx.x * 8 + T.wave, NGW = gridDim.x * 8;
    for (int m = gw; m < MTOK; m += NGW) {
        f32x4* xr = (f32x4*)(F.out + (size_t)m * DM);
        f32x4 v[4]; float ss = 0.f;
#pragma unroll
        for (int j = 0; j < 4; ++j) { v[j] = xr[T.lane + 64 * j]; ss += (v[j].x * v[j].x + v[j].y * v[j].y) + (v[j].z * v[j].z + v[j].w * v[j].w); }
        const float rstd = 1.0f / sqrtf(wave_sum(ss) * (1.f / DM) + EPS);
#pragma unroll
        for (int j = 0; j < 4; ++j) { const f32x4 w = *(const f32x4*)(F.final_w + 4 * (T.lane + 64 * j)); xr[T.lane + 64 * j] = v[j] * rstd * w; }
    }
}

constexpr int NPH = 9;
__global__ void __launch_bounds__(512, 2) fwd_kernel(Args args) {
    extern __shared__ __attribute__((aligned(16))) unsigned char lds_raw[];
    Ctx F;
    F.lds = (LAS unsigned char*)lds_raw;
    if (threadIdx.x < 16) ((LAS unsigned*)(F.lds + LDS_MISC))[threadIdx.x] = 0u;
    __syncthreads();
    const XcdBarrier bar = xcd_barrier_post((unsigned*)(args.ws + WS_BAR), (volatile LAS unsigned*)(F.lds + LDS_MISC));
    F.x = args.in[0]; F.c = args.in[1]; F.ctx = args.in[2]; F.c_ctx = args.in[3]; F.norm_w = args.in[4]; F.ada_w = args.in[5]; F.ada_b = args.in[6]; F.w_in = args.in[7];
    F.conv_w = args.in[8]; F.conv_b = args.in[9]; F.decay_logit = args.in[10]; F.gn_w = args.in[11]; F.w_a = args.in[12]; F.w_b = args.in[13]; F.w_out = args.in[14]; F.final_w = args.in[15];
    F.out = args.out; unsigned char* ws = args.ws; F.ws = ws;
    F.MOD = (float*)(ws + WS_MOD); F.ROPE = (f32x2*)(ws + WS_ROPE);
    F.WA = (bf16_t*)(ws + WS_WA); F.WB = (bf16_t*)(ws + WS_WB); F.WOUT = (bf16_t*)(ws + WS_WOUT); F.WIN = (bf16_t*)(ws + WS_WIN); F.XM = (bf16_t*)(ws + WS_XM);
    F.KV = (bf16_t*)(ws + WS_KV); F.KVC = (bf16_t*)(ws + WS_KVC); F.HC = (bf16_t*)(ws + WS_HC); F.ST = (bf16_t*)(ws + WS_ST); F.MM = (bf16_t*)(ws + WS_MM);
    F.P = (bf16_t*)(ws + WS_P); F.Q = (bf16_t*)(ws + WS_Q); F.K = (bf16_t*)(ws + WS_K); F.V = (bf16_t*)(ws + WS_V); F.SZB = (bf16_t*)(ws + WS_SZB);
    F.KC = (bf16_t*)(ws + WS_KC); F.VC = (bf16_t*)(ws + WS_VC); F.UB = (bf16_t*)(ws + WS_UB);
    F.R = (bf16_t*)args.out; F.SGB = (bf16_t*)args.out + (size_t)MTOK * DM;
    F.RET = (float*)(ws + WS_RET); F.S0 = (float*)(ws + WS_KVC);
    const int lo = args.ph_lo, hi = args.ph_hi; const unsigned naive = args.naive;
#define IN(k) (lo <= (k) && (k) < hi && ((MK_PHASES >> (k)) & 1))
#define NAIVE(k) (((naive & MK_NAIVE_AVAIL) >> (k)) & 1u)
#define SEAM(k) do { if (IN(k) && IN((k) + 1)) xcd_barrier(bar); } while (0)
#define REP(k) for (int rep_ = 0; rep_ < 1 + (int)((MK_REP_MASK >> (k)) & 1u); ++rep_)
    if (IN(0)) REP(0) { p0_prologue(F); } SEAM(0);
    if (IN(1)) REP(1) { p1_rows(F); } SEAM(1);
    if (IN(2)) REP(2) {
        if (NAIVE(2)) n2_inproj(F);
        else { const char* const Ab[2] = {(const char*)F.XM, (const char*)F.XM}; const char* const Bb[2] = {(const char*)F.WIN, (const char*)F.WIN};
            Sched1 S{(int)gridDim.x, (int)blockIdx.x}; Epi1 E{F.ws, F.R, F.SGB, F.ROPE};
            pg8::gemm_phase<1, Epi1, Sched1>(F.lds, Ab, Bb, S, E); }
    } SEAM(2);
    if (IN(3)) {
        if (!NAIVE(3)) {
            const char* const Ab[2] = {(const char*)F.XM, (const char*)F.XM}; const char* const Bb[2] = {(const char*)F.WIN, (const char*)F.WIN};
            SchedCtx S{(int)blockIdx.x}; Epi1 E{F.ws, F.R, F.SGB, F.ROPE};
            pg8::gemm_phase<1, Epi1, SchedCtx>(F.lds, Ab, Bb, S, E);
            if (blockIdx.x >= 24) { REP(3) p3_kv(F, blockIdx.x - 24, 1024, gridDim.x - 24); p3_ua(F, blockIdx.x - 24, gridDim.x - 24); }
        } else p3_ua(F, blockIdx.x, gridDim.x);
    } SEAM(3);
    if (IN(4)) REP(4) { if (NAIVE(4)) n4_recurrence(F); else { if (blockIdx.x >= gridDim.x - 32) p4_ctx_state(F, blockIdx.x - (gridDim.x - 32)); p4_scan(F); } } SEAM(4);
    if (IN(5)) REP(5) { if (NAIVE(5)) n5_groupnorm(F); else p5_ret(F); } SEAM(5);
    if (IN(6)) REP(6) {
        if (NAIVE(6)) n6_ab(F);
        else { const char* const Ab[2] = {(const char*)F.P, (const char*)F.UB}; const char* const Bb[2] = {(const char*)F.WA, (const char*)F.WB};
            SchedSq S{(int)gridDim.x, (int)blockIdx.x}; EpiAB E{F.R, F.SGB, F.MM};
            pg8::gemm_phase<2, EpiAB, SchedSq>(F.lds, Ab, Bb, S, E); }
    } SEAM(6);
    if (IN(7)) REP(7) {
        if (NAIVE(7)) n7_out(F);
        else { const char* const Ab[2] = {(const char*)F.MM, (const char*)F.MM}; const char* const Bb[2] = {(const char*)F.WOUT, (const char*)F.WOUT};
            SchedSq S{(int)gridDim.x, (int)blockIdx.x};
            EpiOutNorm E{F.x, F.MOD, F.out, F.final_w, (float*)(F.ws + WS_SLOTS), (unsigned*)(F.ws + WS_PCNT), (LAS float*)(F.lds + LDS_TAB)};
            pg8::gemm_phase<1, EpiOutNorm, SchedSq>(F.lds, Ab, Bb, S, E); }
    }
    if (NAIVE(7)) { SEAM(7); if (IN(8)) { p8_final(F); } }
#undef IN
#undef NAIVE
#undef SEAM
}

extern "C" void kernel_launch(void* const* d_in, const int* in_sizes, int n_in, void* d_out, int out_size, void* d_ws, size_t ws_size, hipStream_t stream) {
    static int grid = 0;
    if (grid == 0) {
        if (n_in != 16 || out_size != MTOK * DM || ws_size < WS_END) { fprintf(stderr, "kernel_launch: unexpected shapes (n_in %d out %d ws %zu)\n", n_in, out_size, ws_size); grid = -1; return; }
        int dev = 0, cus = 0, per_cu = 0;
        hipGetDevice(&dev); hipDeviceGetAttribute(&cus, hipDeviceAttributeMultiprocessorCount, dev);
        hipFuncSetAttribute((const void*)fwd_kernel, hipFuncAttributeMaxDynamicSharedMemorySize, LDS_BYTES);
        hipOccupancyMaxActiveBlocksPerMultiprocessor(&per_cu, (const void*)fwd_kernel, 512, LDS_BYTES);
        if (per_cu < 1) { fprintf(stderr, "kernel_launch: occupancy query says %d blocks/CU\n", per_cu); per_cu = 1; }
        grid = cus;
        (void)hipGetLastError();
    }
    if (grid < 0) return;
    Args a{};
    for (int i = 0; i < 16; ++i) a.in[i] = (const float*)d_in[i];
    a.out = (float*)d_out; a.ws = (unsigned char*)d_ws; a.naive = MK_NAIVE_MASK;
    hipMemsetAsync((unsigned char*)d_ws + WS_BAR, 0, WS_BAR_BYTES, stream);
#if MK_LAUNCH_PER_PHASE
    for (int ph = 0; ph < NPH; ++ph) { a.ph_lo = ph; a.ph_hi = ph + 1; hipLaunchKernelGGL(fwd_kernel, dim3(grid), dim3(512), LDS_BYTES, stream, a); }
#else
    a.ph_lo = 0; a.ph_hi = NPH;
    hipLaunchKernelGGL(fwd_kernel, dim3(grid), dim3(512), LDS_BYTES, stream, a);
#endif
}
```

```cpp
#include <hip/hip_runtime.h>
#include <cstdio>
#include <cstdint>

#ifndef MK_LAUNCH_PER_PHASE
#define MK_LAUNCH_PER_PHASE 0
#endif
#ifndef MK_NAIVE_MASK
#define MK_NAIVE_MASK 0x00u
#endif

#ifndef MK_REP_MASK
#define MK_REP_MASK 0u
#endif
#ifndef MK_PHASES
#define MK_PHASES 0x1ff
#endif
#ifndef MK_NAIVE_AVAIL
#define MK_NAIVE_AVAIL 0xffu
#endif
#define DI __device__ __forceinline__
#define LAS __attribute__((address_space(3)))
typedef unsigned short bf16_t;
typedef float f32x4 __attribute__((ext_vector_type(4)));
typedef float f32x2 __attribute__((ext_vector_type(2)));
typedef unsigned u32x4 __attribute__((ext_vector_type(4)));
typedef unsigned u32x2 __attribute__((ext_vector_type(2)));
typedef short bf16x8 __attribute__((ext_vector_type(8)));
typedef short s16x4 __attribute__((ext_vector_type(4)));
typedef short v4i16_t __attribute__((ext_vector_type(4)));

constexpr int NB = 4, SEQ = 4096, DM = 1024, MTOK = NB * SEQ, CTXL = 256, MCTX = NB * CTXL, MALL = MTOK + MCTX;
constexpr int NIN = 9216, NH = 8, DK = 64, DV = 128, CHK = 128, NCHK = SEQ / CHK;
constexpr float EPS = 1e-6f;
constexpr size_t MiB = 1u << 20;
constexpr size_t WS_MOD = 0;
constexpr size_t WS_ROPE = 65536;
constexpr size_t WS_WA = 2 * MiB, WS_WB = 4 * MiB, WS_WOUT = 6 * MiB, WS_WIN = 8 * MiB;
constexpr size_t WS_XM = 26 * MiB;
constexpr size_t WS_KV = 223 * MiB;
constexpr size_t WS_KVC = 40 * MiB;
constexpr size_t WS_RET = 8 * MiB;
constexpr size_t WS_HC = 60 * MiB;
constexpr size_t WS_ST = 60 * MiB;
constexpr size_t WS_MM = 60 * MiB;
constexpr size_t WS_P = 92 * MiB;
constexpr size_t WS_Q = 124 * MiB, WS_K = 140 * MiB, WS_V = 156 * MiB, WS_SZB = 188 * MiB;
constexpr size_t WS_KC = 220 * MiB, WS_VC = 221 * MiB;
constexpr size_t WS_UB = 223 * MiB;
constexpr size_t WS_END = 255 * MiB;
constexpr int LDS_BYTES = 147456;
constexpr int LDS_MISC = 139264;
constexpr size_t WS_BAR = 131072, WS_BAR_BYTES = 65536;
constexpr size_t WS_PCNT = WS_BAR + 16384, WS_SLOTS = 1 * MiB;
constexpr int LDS_TAB = 132096;

DI float bf2f(bf16_t v) { return __uint_as_float((unsigned)v << 16); }
DI float bflo(unsigned w) { return __uint_as_float(w << 16); }
DI float bfhi(unsigned w) { return __uint_as_float(w & 0xffff0000u); }
typedef __bf16 bf16x2_t __attribute__((ext_vector_type(2)));
DI unsigned cvt_pk_bf16(float lo, float hi) { const f32x2 f = {lo, hi}; const bf16x2_t v = __builtin_convertvector(f, bf16x2_t); return __builtin_bit_cast(unsigned, v); }
DI bf16_t f2bf(float f) { return (bf16_t)(cvt_pk_bf16(f, 0.f) & 0xffffu); }
DI float wave_sum(float v) {
#pragma unroll
    for (int o = 1; o < 64; o <<= 1) v += __shfl_xor(v, o);
    return v;
}
struct Tid { int tid, lane, wave; };
DI Tid opaque_tid() { int t = threadIdx.x; asm volatile("" : "+v"(t)); Tid r; r.tid = t; r.lane = t & 63; r.wave = __builtin_amdgcn_readfirstlane(t >> 6); return r; }
DI float siluf(float x) { return x * __builtin_amdgcn_rcpf(1.f + __expf(-x)); }
DI float log2_gamma(const float* decay_logit, int dir, int h) {
    const float x = decay_logit[dir * NH + h];
    const float ls = fminf(x, 0.f) - log1pf(expf(-fabsf(x)));
    return ls * 1.4426950408889634f;
}

namespace pg8 {
constexpr int BM = 256, BK = 64, HALF = 128, HTB = HALF * BK * 2, STAGE_BYTES = 8 * HTB, NXCD = 8, WGM = 8;
DI int lds_byte(int r, int c) { const int st = (r >> 4) * 2 + (c >> 5), rr = r & 15, cc = c & 31, ob = rr * 64 + cc * 2; return st * 1024 + (ob ^ (((ob >> 9) & 1) << 5)); }
DI void stage_rc(int b, int& R, int& C) { const int st = b / 1024, sb = b % 1024, swz = sb ^ (((sb >> 9) & 1) << 5); R = (st >> 1) * 16 + swz / 64; C = (st & 1) * 32 + (swz % 64) / 2; }
DI int perm32(int rho) { const int n = rho >> 4, i = rho & 15; return 8 * (i >> 2) + 4 * n + (i & 3); }
struct Unit { int pm, pn; };
DI void tile_of(int L, int nM, int nN, Unit& u) {
    const int nwg = nM * nN; int wgid = L;
    { const int q = nwg / NXCD, r = nwg % NXCD, xcd = wgid % NXCD, off = wgid / NXCD; wgid = (xcd < r ? xcd * (q + 1) : r * (q + 1) + (xcd - r) * q) + off; }
    const int nig = WGM * nN, gid = wgid / nig, fm = gid * WGM, gsz = (nM - fm) < WGM ? (nM - fm) : WGM;
    u.pm = fm + ((wgid % nig) % gsz); u.pn = (wgid % nig) / gsz;
}
template <int NSEG, class Epi, class Sched>
DI void gemm_phase(LAS unsigned char* lds, const char* const (&Ab)[2], const char* const (&Bb)[2], const Sched& S, const Epi& E) {
    constexpr int K = 1024, NTS = K / BK;
    constexpr int nt = NSEG * NTS;
    const Tid T = opaque_tid();
    const int tid = T.tid, wid = T.wave, lane = T.lane, wr = wid >> 2, wc = (wid & 3) ^ (wr << 1), fr = lane & 15, fq = lane >> 4;
    unsigned voffA[2], voffB[2];
#pragma unroll
    for (int i = 0; i < 2; ++i) { int R, C; stage_rc(tid * 16 + i * 8192, R, C); const int Rb = (R & ~31) + perm32(R & 31);
        voffA[i] = (unsigned)(R * K + C) * 2u; voffB[i] = (unsigned)(Rb * K + C) * 2u; }
    constexpr size_t kstep = (size_t)(BK * 2);
    constexpr size_t hstep = (size_t)HALF * K * 2;
    constexpr size_t tstep = 2 * hstep;
    const unsigned ldsw = (unsigned)wid * 1024u;
    const int aoff = lds_byte(wr * 64 + fr, fq * 8), boff = lds_byte(wc * 32 + fr, fq * 8);
#define PG8_SA(b, h) (((b) * 2 + (h)) * HTB)
#define PG8_SB(b, h) ((4 + (b) * 2 + (h)) * HTB)
#define PG8_STAGE(bufoff, gbase, voff) do { _Pragma("unroll") for (int _i = 0; _i < 2; ++_i) \
        __builtin_amdgcn_global_load_lds((const unsigned*)((const char*)(gbase) + (voff)[_i]), (LAS unsigned*)(lds + (bufoff) + ldsw + _i * 8192), 16, 0, 0); } while (0)
#define PG8_LDA(dst, b, h) do { _Pragma("unroll") for (int m = 0; m < 4; ++m) _Pragma("unroll") for (int k = 0; k < 2; ++k) dst[m][k] = *(const LAS bf16x8*)(lds + PG8_SA(b, h) + aoff + m * 2048 + k * 1024); } while (0)
#define PG8_LDB(dst, b, h) do { _Pragma("unroll") for (int n = 0; n < 2; ++n) _Pragma("unroll") for (int k = 0; k < 2; ++k) dst[n][k] = *(const LAS bf16x8*)(lds + PG8_SB(b, h) + boff + n * 2048 + k * 1024); } while (0)
#define PG8_MMA(ai, bj, At, Bt) do { __builtin_amdgcn_s_setprio(1); _Pragma("unroll") for (int m = 0; m < 4; ++m) _Pragma("unroll") for (int n = 0; n < 2; ++n) _Pragma("unroll") for (int k = 0; k < 2; ++k) \
        acc[ai][bj][m][n] = __builtin_amdgcn_mfma_f32_16x16x32_bf16(Bt[n][k], At[m][k], acc[ai][bj][m][n], 0, 0, 0); __builtin_amdgcn_s_setprio(0); } while (0)
#define PG8_WAIT_V(n) asm volatile("s_waitcnt vmcnt(" #n ")" ::: "memory")
#define PG8_WAIT_L(n) asm volatile("s_waitcnt lgkmcnt(" #n ")" ::: "memory")
#define PG8_BAR __builtin_amdgcn_s_barrier()
#define PG8_SCHED __builtin_amdgcn_sched_barrier(0)
#define PG8_TA(u, t) (Ab[(t) / NTS] + (size_t)(u).pm * tstep + (size_t)((t) % NTS) * kstep)
#define PG8_TB(u, t) (Bb[(t) / NTS] + (size_t)(u).pn * tstep + (size_t)((t) % NTS) * kstep)
    Unit cur, nxt; int ui = 0;
    if (!S.next(0, cur)) return;
    f32x4 acc[2][2][4][2];
#pragma unroll
    for (int a = 0; a < 2; ++a)
#pragma unroll
        for (int b = 0; b < 2; ++b)
#pragma unroll
            for (int m = 0; m < 4; ++m)
#pragma unroll
                for (int n = 0; n < 2; ++n) acc[a][b][m][n] = (f32x4){0.f, 0.f, 0.f, 0.f};
    bf16x8 At[4][2], B0[2][2], B1[2][2];
    {
        const char* cA = PG8_TA(cur, 0); const char* cB = PG8_TB(cur, 0);
        PG8_STAGE(PG8_SB(0, 0), cB, voffB); PG8_STAGE(PG8_SB(0, 1), cB + hstep, voffB); PG8_STAGE(PG8_SA(0, 0), cA, voffA); PG8_STAGE(PG8_SA(0, 1), cA + hstep, voffA);
        if (wr == 1) PG8_BAR;
        PG8_WAIT_V(2); PG8_BAR;
        PG8_STAGE(PG8_SB(1, 0), cB + kstep, voffB); PG8_STAGE(PG8_SA(1, 0), cA + kstep, voffA); PG8_STAGE(PG8_SB(1, 1), cB + hstep + kstep, voffB);
        PG8_WAIT_V(6); PG8_BAR;
    }
    for (;;) {
        const bool has_next = S.next(ui + 1, nxt);
        const Unit nu = has_next ? nxt : cur;
        for (int t = 0; t < nt; t += 2) {
            if (NSEG == 2 && t == NTS) E.mid(acc, cur, wr, wc, fr, fq);
            const bool last = (t == nt - 2);
            const char* a1 = PG8_TA(cur, t + 1);
            const char* a2 = last ? PG8_TA(nu, 0) : PG8_TA(cur, t + 2); const char* b2 = last ? PG8_TB(nu, 0) : PG8_TB(cur, t + 2);
            const char* a3 = a2 + kstep; const char* b3 = b2 + kstep;
            PG8_LDB(B0, 0, 0); PG8_LDB(B1, 0, 1); PG8_SCHED; PG8_LDA(At, 0, 0); PG8_STAGE(PG8_SA(1, 1), a1 + hstep, voffA);
            PG8_WAIT_V(8); PG8_WAIT_L(0); PG8_BAR; PG8_MMA(0, 0, At, B0); PG8_MMA(0, 1, At, B1); PG8_BAR; PG8_SCHED;
            PG8_LDA(At, 0, 1); PG8_STAGE(PG8_SB(0, 0), b2, voffB); PG8_STAGE(PG8_SB(0, 1), b2 + hstep, voffB); PG8_STAGE(PG8_SA(0, 0), a2, voffA);
            PG8_WAIT_V(8); PG8_WAIT_L(0); PG8_BAR; PG8_MMA(1, 0, At, B0); PG8_MMA(1, 1, At, B1); PG8_BAR; PG8_SCHED;
            PG8_LDB(B0, 1, 0); PG8_LDB(B1, 1, 1); PG8_SCHED; PG8_LDA(At, 1, 0); PG8_STAGE(PG8_SA(0, 1), a2 + hstep, voffA);
            PG8_WAIT_V(8); PG8_WAIT_L(0); PG8_BAR; PG8_MMA(0, 0, At, B0); PG8_MMA(0, 1, At, B1); PG8_BAR; PG8_SCHED;
            PG8_LDA(At, 1, 1); PG8_STAGE(PG8_SB(1, 0), b3, voffB); PG8_STAGE(PG8_SB(1, 1), b3 + hstep, voffB); PG8_STAGE(PG8_SA(1, 0), a3, voffA);
            PG8_WAIT_V(8); PG8_WAIT_L(0); PG8_BAR; PG8_MMA(1, 0, At, B0); PG8_MMA(1, 1, At, B1); PG8_BAR; PG8_SCHED;
        }
        if (wr == 0) PG8_BAR;
        E(acc, cur, wr, wc, fr, fq);
        if (!has_next) break;
#pragma unroll
        for (int a = 0; a < 2; ++a)
#pragma unroll
            for (int b = 0; b < 2; ++b)
#pragma unroll
                for (int m = 0; m < 4; ++m)
#pragma unroll
                    for (int n = 0; n < 2; ++n) acc[a][b][m][n] = (f32x4){0.f, 0.f, 0.f, 0.f};
        cur = nxt; ++ui;
        if (wr == 1) PG8_BAR;
    }
    PG8_WAIT_V(0);
    PG8_BAR;
#undef PG8_SA
#undef PG8_SB
#undef PG8_STAGE
#undef PG8_LDA
#undef PG8_LDB
#undef PG8_MMA
#undef PG8_WAIT_V
#undef PG8_WAIT_L
#undef PG8_BAR
#undef PG8_SCHED
#undef PG8_TA
#undef PG8_TB
}
}


#define XB_TMO      128
#define XB_XCNT(j)  (256  + 64 * (j))
#define XB_XSUB(j)  (1280 + 64 * (j))
#define XB_XGEN(j)  (2304 + 64 * (j))
#define XB_TOP      3328
#define XB_TOPGEN   3392
#define XCD_BAR_WORDS 3456
#define XB_SPIN_CAP (1u << 18)
DI unsigned xb_ld(unsigned* p)              { return __hip_atomic_load(p, __ATOMIC_RELAXED, __HIP_MEMORY_SCOPE_AGENT); }
DI unsigned xb_add(unsigned* p, unsigned v) { return __hip_atomic_fetch_add(p, v, __ATOMIC_RELAXED, __HIP_MEMORY_SCOPE_AGENT); }
DI unsigned xb_xcc_id() { return (unsigned)__builtin_amdgcn_s_getreg((3 << 11) | 20) & 0xFu; }
#define XB_SPIN(cond, bar) do { unsigned _sp = 0; while (cond) { __builtin_amdgcn_s_sleep(1); \
    if ((++_sp & 255u) == 0u) { if (xb_ld(&(bar)[XB_TMO])) break; if (_sp > XB_SPIN_CAP) { atomicAdd(&(bar)[XB_TMO], 1u); break; } } } } while (0)
struct XcdBarrier { unsigned* bar; unsigned x; volatile LAS unsigned* st; };
DI XcdBarrier xcd_barrier_post(unsigned* bar, volatile LAS unsigned* st) {
    XcdBarrier b; b.bar = bar; b.x = xb_xcc_id(); b.st = st;
    if (threadIdx.x == 0) (void)xb_add(&bar[XB_XCNT(b.x)], 1u);
    return b;
}
DI void xcd_barrier_complete(unsigned* bar, unsigned x, unsigned& nloc, unsigned& nx) {
    const unsigned G = gridDim.x * gridDim.y * gridDim.z;
    unsigned sum, cnt, mine, sp = 0u;
    for (;;) {
        sum = 0u; cnt = 0u; mine = 0u;
#pragma unroll
        for (unsigned j = 0; j < 16; ++j) { const unsigned c = xb_ld(&bar[XB_XCNT(j)]); sum += c; cnt += (c > 0u) ? 1u : 0u; mine = (j == x) ? c : mine; }
        if (sum == G) break;
        __builtin_amdgcn_s_sleep(1);
        if ((++sp & 255u) == 0u) { if (xb_ld(&bar[XB_TMO])) break; if (sp > XB_SPIN_CAP) { atomicAdd(&bar[XB_TMO], 1u); break; } }
    }
    nloc = mine > 0u ? mine : 1u; nx = cnt > 0u ? cnt : 1u;
}
DI void xcd_barrier(const XcdBarrier& b) {
    asm volatile("s_waitcnt vmcnt(0)" ::: "memory");
    __syncthreads();
    if (threadIdx.x == 0) {
        unsigned* bar = b.bar;
        __builtin_amdgcn_s_waitcnt(0);
        unsigned nloc = b.st[0], nx = b.st[1];
        if (nloc == 0u) { xcd_barrier_complete(bar, b.x, nloc, nx); b.st[0] = nloc; b.st[1] = nx; }
        const unsigned old = xb_add(&bar[XB_XSUB(b.x)], 1u);
        const unsigned gen = old / nloc;
        if (old + 1u == (gen + 1u) * nloc) {
            __builtin_amdgcn_fence(__ATOMIC_RELEASE, "agent");
            asm volatile("s_waitcnt vmcnt(0)" ::: "memory");
            const unsigned og = xb_add(&bar[XB_TOP], 1u);
            const unsigned tg = og / nx;
            if (og + 1u == (tg + 1u) * nx) xb_add(&bar[XB_TOPGEN], 1u);
            else XB_SPIN(xb_ld(&bar[XB_TOPGEN]) == tg, bar);
            __builtin_amdgcn_fence(__ATOMIC_ACQUIRE, "agent");
            xb_add(&bar[XB_XGEN(b.x)], 1u);
            asm volatile("s_waitcnt vmcnt(0)" ::: "memory");
        } else {
            XB_SPIN(xb_ld(&bar[XB_XGEN(b.x)]) == gen, bar);
            __builtin_amdgcn_fence(__ATOMIC_ACQUIRE, "agent");
            asm volatile("s_waitcnt vmcnt(0)" ::: "memory");
        }
    }
    __syncthreads();
}

struct Args { const float* in[16]; float* out; unsigned char* ws; int ph_lo, ph_hi; unsigned naive; int pad; };
struct Ctx {
    LAS unsigned char* lds;
    const float *x, *c, *ctx, *c_ctx, *norm_w, *ada_w, *ada_b, *w_in, *conv_w, *conv_b, *decay_logit, *gn_w, *w_a, *w_b, *w_out, *final_w;
    float* out; unsigned char* ws;
    float* MOD; f32x2* ROPE;
    bf16_t *WA, *WB, *WOUT, *WIN, *XM, *KV, *KVC, *HC, *ST, *MM, *P, *Q, *K, *V, *SZB, *KC, *VC, *UB, *R, *SGB;
    float* RET; float* S0;
};

DI int win_dest(int o) {
    if (o < 4096) { const int g = o >> 10, ch = o & 1023; return 256 * (ch >> 6) + 64 * g + (ch & 63); }
    if (o < 5120) { const int qk = (o - 4096) >> 9, oo = (o - 4096) & 511, head = oo >> 6, i = oo & 63, t = head >> 2, hh = head & 3;
        return 256 * (16 + 2 * qk + t) + (i < 32 ? 32 * hh + i : 128 + 32 * hh + (i - 32)); }
    if (o < 7168) return o;
    { const int gs = (o - 7168) >> 10, ch = (o - 7168) & 1023; return 256 * (28 + (ch >> 7)) + 128 * gs + (ch & 127); }
}
DI void p0_transpose_item(const float* W, int K, int N, bf16_t* WT, bool permute, LAS float* scr, int item, int lane) {
    const int nblk = N / 32, kb = item / nblk, nb = item % nblk, k0 = 64 * kb, n0 = 32 * nb;
    float rv[32];
#pragma unroll
    for (int i = 0; i < 32; ++i) rv[i] = W[(size_t)(k0 + 2 * i + (lane >> 5)) * N + n0 + (lane & 31)];
#pragma unroll
    for (int i = 0; i < 32; ++i) scr[(2 * i + (lane >> 5)) * 33 + (lane & 31)] = rv[i];
    asm volatile("s_waitcnt lgkmcnt(0)" ::: "memory");
    const int c = lane & 7; const int d0 = permute ? win_dest(n0) : n0;
#pragma unroll
    for (int j = 0; j < 4; ++j) { const int n = (lane >> 3) + 8 * j; const LAS float* s = scr + (8 * c) * 33 + n;
        u32x4 o; o.x = cvt_pk_bf16(s[0 * 33], s[1 * 33]); o.y = cvt_pk_bf16(s[2 * 33], s[3 * 33]); o.z = cvt_pk_bf16(s[4 * 33], s[5 * 33]); o.w = cvt_pk_bf16(s[6 * 33], s[7 * 33]);
        *(u32x4*)(WT + (size_t)(d0 + n) * K + k0 + 8 * c) = o; }
    asm volatile("s_waitcnt lgkmcnt(0)" ::: "memory");
}
DI void p0_prologue(const Ctx& F) {
    const Tid T = opaque_tid();
    if (blockIdx.x < 48) {
        LAS float* red = (LAS float*)F.lds;
        LAS float* sl = (LAS float*)(F.lds + 16384);
        for (int e = T.tid; e < 5 * 1024; e += 512) { const int v = e >> 10, k = e & 1023; sl[e] = siluf(v < 4 ? F.c[v * 1024 + k] : F.c_ctx[k]); }
        __syncthreads();
        const int n0 = 64 * blockIdx.x, k0 = 128 * T.wave;
        float a[5] = {0.f, 0.f, 0.f, 0.f, 0.f};
#pragma unroll 4
        for (int kb = 0; kb < 128; kb += 32) {
            float wv[32];
#pragma unroll
            for (int k = 0; k < 32; ++k) wv[k] = F.ada_w[(size_t)(k0 + kb + k) * 3072 + n0 + T.lane];
#pragma unroll
            for (int k = 0; k < 32; ++k)
#pragma unroll
                for (int v = 0; v < 5; ++v) a[v] += sl[v * 1024 + k0 + kb + k] * wv[k];
        }
#pragma unroll
        for (int v = 0; v < 5; ++v) red[(T.wave * 5 + v) * 64 + T.lane] = a[v];
        __syncthreads();
        if (T.tid < 320) { const int v = T.tid >> 6, l = T.tid & 63; float s = F.ada_b[n0 + l];
#pragma unroll
            for (int w = 0; w < 8; ++w) s += red[(w * 5 + v) * 64 + l];
            F.MOD[v * 3072 + n0 + l] = s; }
        __syncthreads();
    }
    if (blockIdx.x == 48) {
        for (int e = T.tid; e < 1024; e += 512) { const int p = e >> 4, f = e & 15; const float inv = powf(10000.f, -(float)f / 16.f); const float ang = (float)p * inv;
            F.ROPE[e] = (f32x2){cosf(ang), sinf(ang)}; }
    }
    LAS float* scr = (LAS float*)(F.lds + T.wave * 16384);
    const int gw = blockIdx.x * 8 + T.wave, NGW = gridDim.x * 8;
    constexpr int I_IN = 16 * (NIN / 32), I_SQ = 16 * 32;
    for (int it = gw; it < I_IN + 3 * I_SQ; it += NGW) {
        int r = it;
        if (r < I_IN) { p0_transpose_item(F.w_in, 1024, NIN, F.WIN, true, scr, r, T.lane); continue; } r -= I_IN;
        if (r < I_SQ) { p0_transpose_item(F.w_a, 1024, 1024, F.WA, false, scr, r, T.lane); continue; } r -= I_SQ;
        if (r < I_SQ) { p0_transpose_item(F.w_b, 1024, 1024, F.WB, false, scr, r, T.lane); continue; } r -= I_SQ;
        p0_transpose_item(F.w_out, 1024, 1024, F.WOUT, false, scr, r, T.lane);
    }
}
DI void p1_rows(const Ctx& F) {
    const Tid T = opaque_tid();
    const int gw = blockIdx.x * 8 + T.wave, NGW = gridDim.x * 8;
    constexpr int RB = 4;
    for (int m0 = gw * RB; m0 < MALL; m0 += NGW * RB) {
        f32x4 v[RB][4]; float ss[RB];
#pragma unroll
        for (int r = 0; r < RB; ++r) { const int m = m0 + r; const float* xr = m < MTOK ? F.x + (size_t)m * DM : F.ctx + (size_t)(m - MTOK) * DM;
#pragma unroll
            for (int j = 0; j < 4; ++j) v[r][j] = ((const f32x4*)xr)[T.lane + 64 * j]; }
#pragma unroll
        for (int r = 0; r < RB; ++r) { float s = 0.f;
#pragma unroll
            for (int j = 0; j < 4; ++j) s += (v[r][j].x * v[r][j].x + v[r][j].y * v[r][j].y) + (v[r][j].z * v[r][j].z + v[r][j].w * v[r][j].w);
            ss[r] = s; }
#pragma unroll
        for (int o = 1; o < 64; o <<= 1)
#pragma unroll
            for (int r = 0; r < RB; ++r) ss[r] += __shfl_xor(ss[r], o);
        const int mb = m0 < MTOK ? (m0 >> 12) : 4; const float* mod = F.MOD + mb * 3072;
#pragma unroll
        for (int j = 0; j < 4; ++j) { const int col = 4 * (T.lane + 64 * j);
            const f32x4 w = *(const f32x4*)(F.norm_w + col), sh = *(const f32x4*)(mod + col), sc = *(const f32x4*)(mod + 1024 + col);
#pragma unroll
            for (int r = 0; r < RB; ++r) { const float rstd = 1.0f / sqrtf(ss[r] * (1.f / DM) + EPS);
                const f32x4 y = (v[r][j] * rstd * w) * (sc + 1.0f) + sh;
                u32x2 o; o.x = cvt_pk_bf16(y.x, y.y); o.y = cvt_pk_bf16(y.z, y.w);
                *(u32x2*)(F.XM + (size_t)(m0 + r) * DM + col) = o; } }
    }
}
struct Sched1 {
    int G, c;
    DI bool next(int i, pg8::Unit& u) const { const int L = i * G + c; if (L >= 64 * 36) return false; pg8::tile_of(L, 64, 36, u); return true; }
};
struct SchedCtx {
    int c;
    DI bool next(int i, pg8::Unit& u) const { if (i > 0 || c >= 24) return false; u.pm = 64 + c / 6; u.pn = 18 + c % 6; return true; }
};
struct Epi1 {
    unsigned char* ws; bf16_t *R, *SGB; const f32x2* rope;
    DI void mid(f32x4 (&)[2][2][4][2], const pg8::Unit&, int, int, int, int) const {}
    DI void operator()(const f32x4 (&acc)[2][2][4][2], const pg8::Unit& u, int wr, int wc, int fr, int fq) const {
        const int pn = u.pn, row0 = u.pm * 256 + wr * 64 + fr, x0 = wc * 32 + 8 * fq;
        const bool isctx = u.pm >= 64;
        if (pn < 16) {
            bf16_t* dst = (bf16_t*)(ws + (wc < 2 ? WS_HC : WS_P)) + 64 * pn + (x0 & 63);
#pragma unroll
            for (int ai = 0; ai < 2; ++ai)
#pragma unroll
                for (int m = 0; m < 4; ++m) { const size_t row = row0 + ai * 128 + m * 16;
                    f32x4 o[2];
#pragma unroll
                    for (int n = 0; n < 2; ++n) { const f32x4 a = acc[ai][0][m][n], b = acc[ai][1][m][n];
                        if (wc < 2) o[n] = a * b;
                        else { o[n].x = a.x * siluf(b.x); o[n].y = a.y * siluf(b.y); o[n].z = a.z * siluf(b.z); o[n].w = a.w * siluf(b.w); } }
                    u32x4 w; w.x = cvt_pk_bf16(o[0].x, o[0].y); w.y = cvt_pk_bf16(o[0].z, o[0].w); w.z = cvt_pk_bf16(o[1].x, o[1].y); w.w = cvt_pk_bf16(o[1].z, o[1].w);
                    *(u32x4*)(dst + row * 1024) = w; }
        } else if (pn < 20) {
            const int t = (pn - 16) & 1, isk = (pn - 16) >> 1, head = 4 * t + wc, i0 = 8 * fq;
            const float scale = isk ? 0.125f : 1.0f;
            bf16_t* base = (bf16_t*)(ws + (isk ? (isctx ? WS_KC : WS_K) : WS_Q));
#pragma unroll
            for (int ai = 0; ai < 2; ++ai)
#pragma unroll
                for (int m = 0; m < 4; ++m) { const int row = row0 + ai * 128 + m * 16; const int orow = isctx ? row - MTOK : row;
                    const int pos = row & 4095, pidx = (fq < 2) ? (pos >> 6) : (pos & 63);
                    const f32x2* rp = rope + pidx * 16 + (fq & 1) * 8;
                    float o1[8], o2[8];
#pragma unroll
                    for (int e = 0; e < 8; ++e) { f32x2 cs = rp[e]; if (isctx) cs = (f32x2){1.f, 0.f};
                        const float t1 = acc[ai][0][m][e >> 2][e & 3], t2 = acc[ai][1][m][e >> 2][e & 3];
                        o1[e] = (t1 * cs.x - t2 * cs.y) * scale; o2[e] = (t1 * cs.y + t2 * cs.x) * scale; }
                    u32x4 w1, w2; w1.x = cvt_pk_bf16(o1[0], o1[1]); w1.y = cvt_pk_bf16(o1[2], o1[3]); w1.z = cvt_pk_bf16(o1[4], o1[5]); w1.w = cvt_pk_bf16(o1[6], o1[7]);
                    w2.x = cvt_pk_bf16(o2[0], o2[1]); w2.y = cvt_pk_bf16(o2[2], o2[3]); w2.z = cvt_pk_bf16(o2[4], o2[5]); w2.w = cvt_pk_bf16(o2[6], o2[7]);
                    bf16_t* d = base + (size_t)orow * 512 + head * 64 + i0;
                    *(u32x4*)d = w1; *(u32x4*)(d + 32) = w2; }
        } else if (pn < 28) {
            const bool isz = pn >= 24;
            bf16_t* base = (bf16_t*)(ws + (isz ? WS_SZB : (isctx ? WS_VC : WS_V)));
            const int colt = 256 * (pn - (isz ? 24 : 20)) + x0;
#pragma unroll
            for (int ai = 0; ai < 2; ++ai)
#pragma unroll
                for (int m = 0; m < 4; ++m) { const int row = row0 + ai * 128 + m * 16; const int orow = isctx ? row - MTOK : row;
#pragma unroll
                    for (int bj = 0; bj < 2; ++bj) { f32x4 a = acc[ai][bj][m][0], b = acc[ai][bj][m][1];
                        u32x4 w; w.x = cvt_pk_bf16(a.x, a.y); w.y = cvt_pk_bf16(a.z, a.w); w.z = cvt_pk_bf16(b.x, b.y); w.w = cvt_pk_bf16(b.z, b.w);
                        *(u32x4*)(base + (size_t)orow * 1024 + colt + bj * 128) = w; } }
        } else {
            const int col = 128 * (pn - 28) + x0;
#pragma unroll
            for (int ai = 0; ai < 2; ++ai)
#pragma unroll
                for (int m = 0; m < 4; ++m) { const size_t row = row0 + ai * 128 + m * 16;
                    float rr[8], sg[8];
#pragma unroll
                    for (int e = 0; e < 8; ++e) { const float ga = acc[ai][0][m][e >> 2][e & 3], gb = acc[ai][1][m][e >> 2][e & 3];
                        const float ea = __expf(-ga), eb = __expf(-gb); sg[e] = 1.f / (1.f + eb); rr[e] = (1.f + eb) / (1.f + ea); }
                    u32x4 w1, w2; w1.x = cvt_pk_bf16(rr[0], rr[1]); w1.y = cvt_pk_bf16(rr[2], rr[3]); w1.z = cvt_pk_bf16(rr[4], rr[5]); w1.w = cvt_pk_bf16(rr[6], rr[7]);
                    w2.x = cvt_pk_bf16(sg[0], sg[1]); w2.y = cvt_pk_bf16(sg[2], sg[3]); w2.z = cvt_pk_bf16(sg[4], sg[5]); w2.w = cvt_pk_bf16(sg[6], sg[7]);
                    *(u32x4*)(R + row * 1024 + col) = w1; *(u32x4*)(SGB + row * 1024 + col) = w2; }
        }
    }
};
DI void n2_inproj(const Ctx& F) {
    const Tid T = opaque_tid();
    const size_t NT = (size_t)gridDim.x * 512, gt = (size_t)blockIdx.x * 512 + T.tid;
    for (size_t idx = gt; idx < (size_t)(MALL / 4) * 1024; idx += NT) {
        const int ch = (int)(idx & 1023), t0 = (int)(idx >> 10) * 4;
        const bool doqk = ch < 512 && (ch & 63) < 32;
        float a[12][4];
#pragma unroll
        for (int o = 0; o < 12; ++o)
#pragma unroll
            for (int j = 0; j < 4; ++j) a[o][j] = 0.f;
        for (int k = 0; k < 1024; ++k) {
            const float* wr = F.w_in + (size_t)k * NIN;
            float xv[4];
#pragma unroll
            for (int j = 0; j < 4; ++j) xv[j] = bf2f(F.XM[(size_t)(t0 + j) * 1024 + k]);
            float w[12];
            w[0] = wr[ch]; w[1] = wr[1024 + ch]; w[2] = wr[2048 + ch]; w[3] = wr[3072 + ch]; w[4] = wr[5120 + ch]; w[5] = wr[6144 + ch]; w[6] = wr[7168 + ch]; w[7] = wr[8192 + ch];
            if (doqk) { w[8] = wr[4096 + ch]; w[9] = wr[4096 + ch + 32]; w[10] = wr[4608 + ch]; w[11] = wr[4608 + ch + 32]; } else { w[8] = w[9] = w[10] = w[11] = 0.f; }
#pragma unroll
            for (int o = 0; o < 12; ++o)
#pragma unroll
                for (int j = 0; j < 4; ++j) a[o][j] += xv[j] * w[o];
        }
#pragma unroll
        for (int j = 0; j < 4; ++j) { const int t = t0 + j;
            if (t < MTOK) {
                const size_t o = (size_t)t * 1024 + ch;
                F.HC[o] = f2bf(a[2][j] * a[0][j]); F.P[o] = f2bf(siluf(a[3][j]) * a[1][j]); F.V[o] = f2bf(a[4][j]); F.SZB[o] = f2bf(a[5][j]);
                const float sga = 1.f / (1.f + __expf(-a[6][j])), sgb = 1.f / (1.f + __expf(-a[7][j]));
                F.R[o] = f2bf(sga / sgb); F.SGB[o] = f2bf(sgb);
                if (doqk) { const int i = ch & 63, pos = t & 4095; const int pidx = i < 16 ? (pos >> 6) : (pos & 63); const f32x2 cs = F.ROPE[pidx * 16 + (i & 15)];
                    const size_t q = (size_t)t * 512 + ch;
                    F.Q[q] = f2bf(a[8][j] * cs.x - a[9][j] * cs.y); F.Q[q + 32] = f2bf(a[8][j] * cs.y + a[9][j] * cs.x);
                    F.K[q] = f2bf((a[10][j] * cs.x - a[11][j] * cs.y) * 0.125f); F.K[q + 32] = f2bf((a[10][j] * cs.y + a[11][j] * cs.x) * 0.125f); }
            } else {
                const int tc = t - MTOK;
                F.VC[(size_t)tc * 1024 + ch] = f2bf(a[4][j]);
                if (doqk) { F.KC[(size_t)tc * 512 + ch] = f2bf(a[10][j] * 0.125f); F.KC[(size_t)tc * 512 + ch + 32] = f2bf(a[11][j] * 0.125f); }
            }
        }
    }
}
DI bf16x8 tr2(const LAS unsigned char* p, int delta) {
    const s16x4 lo = __builtin_bit_cast(s16x4, __builtin_amdgcn_ds_read_tr16_b64_v4i16((LAS v4i16_t*)p));
    const s16x4 hi = __builtin_bit_cast(s16x4, __builtin_amdgcn_ds_read_tr16_b64_v4i16((LAS v4i16_t*)(p + delta)));
    return __builtin_shufflevector(lo, hi, 0, 1, 2, 3, 4, 5, 6, 7);
}
DI u32x4 scale8(u32x4 w, float s) {
    u32x4 o; o.x = cvt_pk_bf16(bflo(w.x) * s, bfhi(w.x) * s); o.y = cvt_pk_bf16(bflo(w.y) * s, bfhi(w.y) * s); o.z = cvt_pk_bf16(bflo(w.z) * s, bfhi(w.z) * s); o.w = cvt_pk_bf16(bflo(w.w) * s, bfhi(w.w) * s); return o;
}
DI void p3_kv(const Ctx& F, int it0, int it1, int stride) {
    const Tid T = opaque_tid();
    LAS unsigned char* KFI = F.lds; LAS unsigned char* KBI = F.lds + 20480; LAS unsigned char* VI = F.lds + 40960;
    const int tid = T.tid, lane = T.lane, w = T.wave, g = lane >> 4, q = (lane & 15) >> 2, p = lane & 3;
    const int row = tid >> 2, seg = tid & 3;
    u32x4 pk[2], pv[4];
    auto prefetch = [&](int it) { const int bh = it >> 5, c = it & 31; const size_t tok0 = (size_t)(bh >> 3) * SEQ + c * CHK;
        const bf16_t* kp = F.K + tok0 * 512 + (bh & 7) * 64; const bf16_t* vp = F.V + tok0 * 1024 + (bh & 7) * 128;
        pk[0] = *(const u32x4*)(kp + (size_t)row * 512 + seg * 16); pk[1] = *(const u32x4*)(kp + (size_t)row * 512 + seg * 16 + 8);
#pragma unroll
        for (int i = 0; i < 4; ++i) pv[i] = *(const u32x4*)(vp + (size_t)row * 1024 + seg * 32 + 8 * i); };
    if (it0 < it1) prefetch(it0);
    for (int it = it0; it < it1; it += stride) {
        const int bh = it >> 5, c = it & 31;
        const float l2f = log2_gamma(F.decay_logit, 0, bh & 7), l2b = log2_gamma(F.decay_logit, 1, bh & 7);
        { const float df = __builtin_amdgcn_exp2f(l2f * (float)(127 - row)), db = __builtin_amdgcn_exp2f(l2b * (float)row);
            *(LAS u32x4*)(KFI + row * 160 + seg * 32) = scale8(pk[0], df); *(LAS u32x4*)(KFI + row * 160 + seg * 32 + 16) = scale8(pk[1], df);
            *(LAS u32x4*)(KBI + row * 160 + seg * 32) = scale8(pk[0], db); *(LAS u32x4*)(KBI + row * 160 + seg * 32 + 16) = scale8(pk[1], db);
#pragma unroll
            for (int i = 0; i < 4; ++i) *(LAS u32x4*)(VI + row * 288 + seg * 64 + 16 * i) = pv[i]; }
        __syncthreads();
        if (it + stride < it1) prefetch(it + stride);
        f32x4 acc[2][4];
#pragma unroll
        for (int d = 0; d < 2; ++d)
#pragma unroll
            for (int nb = 0; nb < 4; ++nb) acc[d][nb] = (f32x4){0.f, 0.f, 0.f, 0.f};
#pragma unroll
        for (int s2 = 0; s2 < 4; ++s2) {
            const bf16x8 vb = tr2(VI + (32 * s2 + 8 * g + q) * 288 + (16 * w + 4 * p) * 2, 4 * 288);
#pragma unroll
            for (int nb = 0; nb < 4; ++nb) {
                const bf16x8 kf = tr2(KFI + (32 * s2 + 8 * g + q) * 160 + (16 * nb + 4 * p) * 2, 4 * 160);
                const bf16x8 kb = tr2(KBI + (32 * s2 + 8 * g + q) * 160 + (16 * nb + 4 * p) * 2, 4 * 160);
                acc[0][nb] = __builtin_amdgcn_mfma_f32_16x16x32_bf16(kf, vb, acc[0][nb], 0, 0, 0);
                acc[1][nb] = __builtin_amdgcn_mfma_f32_16x16x32_bf16(kb, vb, acc[1][nb], 0, 0, 0);
            }
        }
        bf16_t* of = F.KV + ((size_t)(0 * 32 + bh) * 32 + c) * 8192; bf16_t* ob = F.KV + ((size_t)(1 * 32 + bh) * 32 + c) * 8192;
#pragma unroll
        for (int nb = 0; nb < 4; ++nb) { const int o = (16 * w + (lane & 15)) * 64 + 16 * nb + 4 * g;
            u32x2 a, b; a.x = cvt_pk_bf16(acc[0][nb].x, acc[0][nb].y); a.y = cvt_pk_bf16(acc[0][nb].z, acc[0][nb].w); b.x = cvt_pk_bf16(acc[1][nb].x, acc[1][nb].y); b.y = cvt_pk_bf16(acc[1][nb].z, acc[1][nb].w);
            *(u32x2*)(of + o) = a; *(u32x2*)(ob + o) = b; }
        __syncthreads();
    }
}
DI void p4_ctx_state(const Ctx& F, int bh) {
    const Tid T = opaque_tid();
    LAS unsigned char* KFI = F.lds; LAS unsigned char* KBI = F.lds + 20480; LAS unsigned char* VI = F.lds + 40960;
    const int tid = T.tid, lane = T.lane, w = T.wave, g = lane >> 4, q = (lane & 15) >> 2, p = lane & 3;
    const int row = tid >> 2, seg = tid & 3;
    const float l2f = log2_gamma(F.decay_logit, 0, bh & 7), l2b = log2_gamma(F.decay_logit, 1, bh & 7);
    f32x4 acc[2][4];
#pragma unroll
    for (int d = 0; d < 2; ++d)
#pragma unroll
        for (int nb = 0; nb < 4; ++nb) acc[d][nb] = (f32x4){0.f, 0.f, 0.f, 0.f};
    for (int cc = 0; cc < 2; ++cc) {
        const size_t tok0 = (size_t)(bh >> 3) * CTXL + cc * CHK; const int m = cc * CHK + row;
        const bf16_t* kp = F.KC + tok0 * 512 + (bh & 7) * 64; const bf16_t* vp = F.VC + tok0 * 1024 + (bh & 7) * 128;
        const u32x4 k0 = *(const u32x4*)(kp + (size_t)row * 512 + seg * 16), k1 = *(const u32x4*)(kp + (size_t)row * 512 + seg * 16 + 8);
        const float df = __builtin_amdgcn_exp2f(l2f * (float)(255 - m)), db = __builtin_amdgcn_exp2f(l2b * (float)m);
        *(LAS u32x4*)(KFI + row * 160 + seg * 32) = scale8(k0, df); *(LAS u32x4*)(KFI + row * 160 + seg * 32 + 16) = scale8(k1, df);
        *(LAS u32x4*)(KBI + row * 160 + seg * 32) = scale8(k0, db); *(LAS u32x4*)(KBI + row * 160 + seg * 32 + 16) = scale8(k1, db);
#pragma unroll
        for (int i = 0; i < 4; ++i) *(LAS u32x4*)(VI + row * 288 + seg * 64 + 16 * i) = *(const u32x4*)(vp + (size_t)row * 1024 + seg * 32 + 8 * i);
        __syncthreads();
#pragma unroll
        for (int s2 = 0; s2 < 4; ++s2) {
            const bf16x8 vb = tr2(VI + (32 * s2 + 8 * g + q) * 288 + (16 * w + 4 * p) * 2, 4 * 288);
#pragma unroll
            for (int nb = 0; nb < 4; ++nb) {
                const bf16x8 kf = tr2(KFI + (32 * s2 + 8 * g + q) * 160 + (16 * nb + 4 * p) * 2, 4 * 160);
                const bf16x8 kb = tr2(KBI + (32 * s2 + 8 * g + q) * 160 + (16 * nb + 4 * p) * 2, 4 * 160);
                acc[0][nb] = __builtin_amdgcn_mfma_f32_16x16x32_bf16(kf, vb, acc[0][nb], 0, 0, 0);
                acc[1][nb] = __builtin_amdgcn_mfma_f32_16x16x32_bf16(kb, vb, acc[1][nb], 0, 0, 0);
            }
        }
        __syncthreads();
    }
    float* of = F.S0 + (size_t)(0 * 32 + bh) * 8192; float* ob = F.S0 + (size_t)(1 * 32 + bh) * 8192;
#pragma unroll
    for (int nb = 0; nb < 4; ++nb) { const int o = (16 * w + (lane & 15)) * 64 + 16 * nb + 4 * g; *(f32x4*)(of + o) = acc[0][nb]; *(f32x4*)(ob + o) = acc[1][nb]; }
}
DI void p3_ua(const Ctx& F, int blk, int nblk) {
    const Tid T = opaque_tid();
    const size_t NT = (size_t)nblk * 512, gt = (size_t)blk * 512 + T.tid;
    for (size_t idx = gt; idx < (size_t)MTOK * 128; idx += NT) {
        const int t = (int)(idx >> 7), c8 = (int)(idx & 127) * 8, pos = t & 4095;
        const bf16_t* hp = F.HC + (size_t)t * 1024 + c8;
        const u32x4 z = (u32x4){0u, 0u, 0u, 0u};
        const u32x4 h0 = pos > 0 ? *(const u32x4*)(hp - 1024) : z, h1 = *(const u32x4*)hp, h2 = pos < SEQ - 1 ? *(const u32x4*)(hp + 1024) : z;
        const u32x4 pv = *(const u32x4*)(F.P + (size_t)t * 1024 + c8);
        float o[8];
#pragma unroll
        for (int e = 0; e < 8; ++e) { const unsigned a = h0[e >> 1], b = h1[e >> 1], c = h2[e >> 1], pp = pv[e >> 1];
            const float x0 = (e & 1) ? bfhi(a) : bflo(a), x1 = (e & 1) ? bfhi(b) : bflo(b), x2 = (e & 1) ? bfhi(c) : bflo(c), pf = (e & 1) ? bfhi(pp) : bflo(pp);
            const float cv = F.conv_w[c8 + e] * x0 + F.conv_w[1024 + c8 + e] * x1 + F.conv_w[2048 + c8 + e] * x2 + F.conv_b[c8 + e];
            o[e] = pf * cv; }
        u32x4 w; w.x = cvt_pk_bf16(o[0], o[1]); w.y = cvt_pk_bf16(o[2], o[3]); w.z = cvt_pk_bf16(o[4], o[5]); w.w = cvt_pk_bf16(o[6], o[7]);
        *(u32x4*)(F.P + (size_t)t * 1024 + c8) = w;
    }
}
DI void p4_scan(const Ctx& F) {
    const Tid T = opaque_tid();
    const size_t NT = (size_t)gridDim.x * 512, gt = (size_t)blockIdx.x * 512 + T.tid;
    for (size_t idx = gt; idx < (size_t)2 * 32 * 2048; idx += NT) {
        const int e4 = (int)(idx & 2047), bh = (int)(idx >> 11) & 31, dir = (int)(idx >> 16);
        const float g = exp2f(log2_gamma(F.decay_logit, dir, bh & 7) * 128.f);
        const u32x2* kv = (const u32x2*)(F.KV + ((size_t)(dir * 32 + bh) * 32) * 8192) + e4;
        u32x2* st = (u32x2*)(F.ST + ((size_t)(dir * 32 + bh) * 32) * 8192) + e4;
        float s0 = 0.f, s1 = 0.f, s2 = 0.f, s3 = 0.f;
        u32x2 v[32];
#pragma unroll
        for (int i = 0; i < 32; ++i) v[i] = kv[(size_t)(dir == 0 ? i : 31 - i) * 2048];
#pragma unroll
        for (int i = 0; i < 32; ++i) { const int c = dir == 0 ? i : 31 - i;
            u32x2 o; o.x = cvt_pk_bf16(s0, s1); o.y = cvt_pk_bf16(s2, s3); st[(size_t)c * 2048] = o;
            s0 = g * s0 + bflo(v[i].x); s1 = g * s1 + bfhi(v[i].x); s2 = g * s2 + bflo(v[i].y); s3 = g * s3 + bfhi(v[i].y); }
    }
}
DI void n4_recurrence(const Ctx& F) {
    const Tid T = opaque_tid();
    const int gw = blockIdx.x * 8 + T.wave, NGW = gridDim.x * 8, d = T.lane;
    for (int task = gw; task < 32 * 128; task += NGW) {
        const int bh = task >> 7, v = task & 127, b = bh >> 3, h = bh & 7;
        const float gf = exp2f(log2_gamma(F.decay_logit, 0, h)), gb = exp2f(log2_gamma(F.decay_logit, 1, h));
        float s = 0.f;
        for (int m = 0; m < CTXL; ++m) { const size_t t = (size_t)b * CTXL + m; s = gf * s + bf2f(F.KC[t * 512 + h * 64 + d]) * bf2f(F.VC[t * 1024 + h * 128 + v]); }
        const float sF = s; s = 0.f;
        for (int m = CTXL - 1; m >= 0; --m) { const size_t t = (size_t)b * CTXL + m; s = gb * s + bf2f(F.KC[t * 512 + h * 64 + d]) * bf2f(F.VC[t * 1024 + h * 128 + v]); }
        const float sB = s;
        s = sF;
        for (int n = 0; n < SEQ; ++n) { const size_t t = (size_t)b * SEQ + n; s = gf * s + bf2f(F.K[t * 512 + h * 64 + d]) * bf2f(F.V[t * 1024 + h * 128 + v]);
            const float o = wave_sum(bf2f(F.Q[t * 512 + h * 64 + d]) * s); if (d == 0) F.RET[t * 1024 + h * 128 + v] = o; }
        s = sB;
        for (int n = SEQ - 1; n >= 0; --n) { const size_t t = (size_t)b * SEQ + n; s = gb * s + bf2f(F.K[t * 512 + h * 64 + d]) * bf2f(F.V[t * 1024 + h * 128 + v]);
            const float o = wave_sum(bf2f(F.Q[t * 512 + h * 64 + d]) * s); if (d == 0) F.RET[t * 1024 + h * 128 + v] += o; }
    }
}
DI void n5_groupnorm(const Ctx& F) {
    const Tid T = opaque_tid();
    const int gw = blockIdx.x * 8 + T.wave, NGW = gridDim.x * 8;
    for (int task = gw; task < MTOK * NH; task += NGW) {
        const int t = task >> 3, h = task & 7; const size_t o = (size_t)t * 1024 + h * 128 + 2 * T.lane;
        const float a = F.RET[o], b = F.RET[o + 1];
        const float mu = wave_sum(a + b) * (1.f / 128.f); const float da = a - mu, db = b - mu;
        const float var = wave_sum(da * da + db * db) * (1.f / 128.f); const float rstd = 1.0f / sqrtf(var + EPS);
        const float ra = da * rstd * F.gn_w[h * 128 + 2 * T.lane], rb = db * rstd * F.gn_w[h * 128 + 2 * T.lane + 1];
        *(unsigned*)(F.UB + o) = cvt_pk_bf16(siluf(bf2f(F.SZB[o])) * ra, siluf(bf2f(F.SZB[o + 1])) * rb);
    }
}
DI void p5_ret(const Ctx& F) {
    const Tid T = opaque_tid();
    LAS unsigned char* KI = F.lds; LAS unsigned char* VI = F.lds + 20480; LAS unsigned char* SF = F.lds + 57344; LAS unsigned char* SB = F.lds + 75776;
    LAS unsigned char* S0F = F.lds + 94208; LAS unsigned char* S0B = F.lds + 110592;
    const int tid = T.tid, lane = T.lane, w = T.wave, g = lane >> 4, q = (lane & 15) >> 2, p = lane & 3, l15 = lane & 15;
    const int row = tid >> 2, seg = tid & 3, il = 16 * w + l15;
    for (int base = blockIdx.x * 4; base < 1024; base += gridDim.x * 4) {
        const int bh = base >> 5, h = bh & 7;
        const float l2f = log2_gamma(F.decay_logit, 0, h), l2b = log2_gamma(F.decay_logit, 1, h);
        { const float* s0f = F.S0 + (size_t)(0 * 32 + bh) * 8192 + row * 64 + seg * 16; const float* s0b = F.S0 + (size_t)(1 * 32 + bh) * 8192 + row * 64 + seg * 16;
#pragma unroll
            for (int i = 0; i < 2; ++i) { const f32x4 a0 = *(const f32x4*)(s0f + 8 * i), a1 = *(const f32x4*)(s0f + 8 * i + 4), b0 = *(const f32x4*)(s0b + 8 * i), b1 = *(const f32x4*)(s0b + 8 * i + 4);
                u32x4 x, y; x.x = cvt_pk_bf16(a0.x, a0.y); x.y = cvt_pk_bf16(a0.z, a0.w); x.z = cvt_pk_bf16(a1.x, a1.y); x.w = cvt_pk_bf16(a1.z, a1.w);
                y.x = cvt_pk_bf16(b0.x, b0.y); y.y = cvt_pk_bf16(b0.z, b0.w); y.z = cvt_pk_bf16(b1.x, b1.y); y.w = cvt_pk_bf16(b1.z, b1.w);
                *(LAS u32x4*)(S0F + row * 128 + seg * 32 + 16 * i) = x; *(LAS u32x4*)(S0B + row * 128 + seg * 32 + 16 * i) = y; } }
        u32x4 pk[2], pv[4], pf0[2], pb0[2]; bf16x8 pq[2];
        auto prefetch = [&](int it) { const int c = it & 31; const size_t tok0 = (size_t)(bh >> 3) * SEQ + c * CHK;
            const bf16_t* kp = F.K + tok0 * 512 + h * 64; const bf16_t* vp = F.V + tok0 * 1024 + h * 128; const bf16_t* qp = F.Q + tok0 * 512 + h * 64;
            const bf16_t* stf = F.ST + ((size_t)(0 * 32 + bh) * 32 + c) * 8192; const bf16_t* stb = F.ST + ((size_t)(1 * 32 + bh) * 32 + c) * 8192;
#pragma unroll
            for (int i = 0; i < 2; ++i) { pk[i] = *(const u32x4*)(kp + (size_t)row * 512 + seg * 16 + 8 * i); pf0[i] = *(const u32x4*)(stf + row * 64 + seg * 16 + 8 * i); pb0[i] = *(const u32x4*)(stb + row * 64 + seg * 16 + 8 * i);
                pq[i] = *(const bf16x8*)(qp + (size_t)il * 512 + 32 * i + 8 * g); }
#pragma unroll
            for (int i = 0; i < 4; ++i) pv[i] = *(const u32x4*)(vp + (size_t)row * 1024 + seg * 32 + 8 * i); };
        prefetch(base);
        for (int k = 0; k < 4; ++k) {
            const int it = base + k, c = it & 31; const size_t tok0 = (size_t)(bh >> 3) * SEQ + c * CHK;
            { const float cf = __builtin_amdgcn_exp2f(l2f * 128.f * (float)c), cb = __builtin_amdgcn_exp2f(l2b * 128.f * (float)(31 - c));
#pragma unroll
                for (int i = 0; i < 2; ++i) { *(LAS u32x4*)(KI + row * 160 + seg * 32 + 16 * i) = pk[i];
                    const u32x4 x = *(const LAS u32x4*)(S0F + row * 128 + seg * 32 + 16 * i), y = *(const LAS u32x4*)(S0B + row * 128 + seg * 32 + 16 * i);
                    u32x4 of, ob;
#pragma unroll
                    for (int e = 0; e < 4; ++e) { of[e] = cvt_pk_bf16(bflo(pf0[i][e]) + cf * bflo(x[e]), bfhi(pf0[i][e]) + cf * bfhi(x[e])); ob[e] = cvt_pk_bf16(bflo(pb0[i][e]) + cb * bflo(y[e]), bfhi(pb0[i][e]) + cb * bfhi(y[e])); }
                    *(LAS u32x4*)(SF + row * 144 + seg * 32 + 16 * i) = of; *(LAS u32x4*)(SB + row * 144 + seg * 32 + 16 * i) = ob; }
#pragma unroll
                for (int i = 0; i < 4; ++i) *(LAS u32x4*)(VI + row * 288 + seg * 64 + 16 * i) = pv[i]; }
            bf16x8 qf[2]; qf[0] = pq[0]; qf[1] = pq[1];
            __syncthreads();
            if (k < 3) prefetch(it + 1);
            f32x4 accS[8];
#pragma unroll
            for (int jb = 0; jb < 8; ++jb) { accS[jb] = (f32x4){0.f, 0.f, 0.f, 0.f};
#pragma unroll
                for (int ks = 0; ks < 2; ++ks) { const bf16x8 kf = *(const LAS bf16x8*)(KI + (16 * jb + l15) * 160 + (32 * ks + 8 * g) * 2);
                    accS[jb] = __builtin_amdgcn_mfma_f32_16x16x32_bf16(kf, qf[ks], accS[jb], 0, 0, 0); } }
            bf16x8 pf[4];
#pragma unroll
            for (int s2 = 0; s2 < 4; ++s2) { float pe[8];
#pragma unroll
                for (int e = 0; e < 8; ++e) { const int jb = 2 * s2 + (e >> 2), r = e & 3, j = 16 * jb + 4 * g + r, df = il - j;
                    float mk = __builtin_amdgcn_exp2f((df >= 0 ? l2f : -l2b) * (float)df); if (df == 0) mk = 2.f;
                    pe[e] = accS[jb][r] * mk; }
                u32x4 pw; pw.x = cvt_pk_bf16(pe[0], pe[1]); pw.y = cvt_pk_bf16(pe[2], pe[3]); pw.z = cvt_pk_bf16(pe[4], pe[5]); pw.w = cvt_pk_bf16(pe[6], pe[7]);
                pf[s2] = __builtin_bit_cast(bf16x8, pw); }
            const float decf = __builtin_amdgcn_exp2f(l2f * (float)(il + 1)), decb = __builtin_amdgcn_exp2f(l2b * (float)(128 - il));
            f32x4 accO[8];
#pragma unroll
            for (int vb = 0; vb < 8; ++vb) { f32x4 o = (f32x4){0.f, 0.f, 0.f, 0.f};
#pragma unroll
                for (int s2 = 0; s2 < 4; ++s2) { const bf16x8 vf = tr2(VI + (32 * s2 + 4 * g + q) * 288 + (16 * vb + 4 * p) * 2, 16 * 288);
                    o = __builtin_amdgcn_mfma_f32_16x16x32_bf16(vf, pf[s2], o, 0, 0, 0); }
                f32x4 tf = (f32x4){0.f, 0.f, 0.f, 0.f}, tb = (f32x4){0.f, 0.f, 0.f, 0.f};
#pragma unroll
                for (int ks = 0; ks < 2; ++ks) { const bf16x8 sf = *(const LAS bf16x8*)(SF + (16 * vb + l15) * 144 + (32 * ks + 8 * g) * 2);
                    const bf16x8 sb = *(const LAS bf16x8*)(SB + (16 * vb + l15) * 144 + (32 * ks + 8 * g) * 2);
                    tf = __builtin_amdgcn_mfma_f32_16x16x32_bf16(sf, qf[ks], tf, 0, 0, 0); tb = __builtin_amdgcn_mfma_f32_16x16x32_bf16(sb, qf[ks], tb, 0, 0, 0); }
                accO[vb] = o + tf * decf + tb * decb; __builtin_amdgcn_sched_barrier(0); }
            float sm = 0.f;
#pragma unroll
            for (int vb = 0; vb < 8; ++vb) sm += (accO[vb].x + accO[vb].y) + (accO[vb].z + accO[vb].w);
            sm += __shfl_xor(sm, 16); sm += __shfl_xor(sm, 32);
            const float mu = sm * (1.f / 128.f); float sq = 0.f;
#pragma unroll
            for (int vb = 0; vb < 8; ++vb) { accO[vb] = accO[vb] - mu; sq += (accO[vb].x * accO[vb].x + accO[vb].y * accO[vb].y) + (accO[vb].z * accO[vb].z + accO[vb].w * accO[vb].w); }
            sq += __shfl_xor(sq, 16); sq += __shfl_xor(sq, 32);
            const float rstd = 1.0f / sqrtf(sq * (1.f / 128.f) + EPS);
            __syncthreads();
#pragma unroll
            for (int vb = 0; vb < 8; ++vb) { const f32x4 gw = *(const f32x4*)(F.gn_w + h * 128 + 16 * vb + 4 * g); const f32x4 o = accO[vb] * rstd * gw;
                u32x2 ow; ow.x = cvt_pk_bf16(o.x, o.y); ow.y = cvt_pk_bf16(o.z, o.w);
                *(LAS u32x2*)(VI + il * 288 + (16 * vb + 4 * g) * 2) = ow; }
            __syncthreads();
            { const size_t go = (tok0 + row) * 1024 + h * 128 + seg * 32;
#pragma unroll
                for (int i = 0; i < 4; ++i) { const u32x4 o = *(const LAS u32x4*)(VI + row * 288 + seg * 64 + 16 * i); const u32x4 z = *(const u32x4*)(F.SZB + go + 8 * i);
                    u32x4 r;
#pragma unroll
                    for (int e = 0; e < 4; ++e) r[e] = cvt_pk_bf16(bflo(o[e]) * siluf(bflo(z[e])), bfhi(o[e]) * siluf(bfhi(z[e])));
                    *(u32x4*)(F.UB + go + 8 * i) = r; } }
            __syncthreads();
        }
    }
}
struct SchedSq { int G, c; DI bool next(int i, pg8::Unit& u) const { const int L = i * G + c; if (L >= 256) return false; pg8::tile_of(L, 64, 4, u); return true; } };
struct EpiAB {
    const bf16_t* R; const bf16_t* SGB; bf16_t* MM;
    DI void mid(f32x4 (&acc)[2][2][4][2], const pg8::Unit& u, int wr, int wc, int fr, int fq) const { apply<false>(acc, u, wr, wc, fr, fq); }
    DI void operator()(const f32x4 (&acc)[2][2][4][2], const pg8::Unit& u, int wr, int wc, int fr, int fq) const { apply<true>(const_cast<f32x4 (&)[2][2][4][2]>(acc), u, wr, wc, fr, fq); }
    template <bool FIN> DI void apply(f32x4 (&acc)[2][2][4][2], const pg8::Unit& u, int wr, int wc, int fr, int fq) const {
        const bf16_t* src = FIN ? SGB : R;
        const size_t base = (size_t)(u.pm * 256 + wr * 64 + fr) * 1024 + u.pn * 256 + wc * 32 + 8 * fq;
#pragma unroll
        for (int am = 0; am < 4; ++am) { const int ai = am >> 1;
            u32x4 gv[4][2];
#pragma unroll
            for (int m = 2 * (am & 1); m < 2 * (am & 1) + 2; ++m)
#pragma unroll
                for (int bj = 0; bj < 2; ++bj) gv[m][bj] = *(const u32x4*)(src + base + (size_t)(ai * 128 + m * 16) * 1024 + bj * 128);
#pragma unroll
            for (int m = 2 * (am & 1); m < 2 * (am & 1) + 2; ++m)
#pragma unroll
                for (int bj = 0; bj < 2; ++bj) { const u32x4 gq = gv[m][bj];
                    f32x4 a = acc[ai][bj][m][0], b = acc[ai][bj][m][1];
                    a.x *= bflo(gq.x); a.y *= bfhi(gq.x); a.z *= bflo(gq.y); a.w *= bfhi(gq.y); b.x *= bflo(gq.z); b.y *= bfhi(gq.z); b.z *= bflo(gq.w); b.w *= bfhi(gq.w);
                    if (FIN) { u32x4 w; w.x = cvt_pk_bf16(a.x, a.y); w.y = cvt_pk_bf16(a.z, a.w); w.z = cvt_pk_bf16(b.x, b.y); w.w = cvt_pk_bf16(b.z, b.w);
                        *(u32x4*)(MM + base + (size_t)(ai * 128 + m * 16) * 1024 + bj * 128) = w; }
                    else { acc[ai][bj][m][0] = a; acc[ai][bj][m][1] = b; } }
            asm volatile("" ::: "memory");
        }
    }
};
struct EpiOut {
    const float* x; const float* MOD; float* out;
    DI void mid(f32x4 (&)[2][2][4][2], const pg8::Unit&, int, int, int, int) const {}
    DI void operator()(const f32x4 (&acc)[2][2][4][2], const pg8::Unit& u, int wr, int wc, int fr, int fq) const {
        const int col0 = u.pn * 256 + wc * 32 + 8 * fq; const float* gp = MOD + (u.pm >> 4) * 3072 + 2048 + col0;
        f32x4 gx[2][2];
#pragma unroll
        for (int bj = 0; bj < 2; ++bj)
#pragma unroll
            for (int n = 0; n < 2; ++n) gx[bj][n] = *(const f32x4*)(gp + bj * 128 + 4 * n);
#pragma unroll
        for (int ai = 0; ai < 2; ++ai)
#pragma unroll
            for (int m = 0; m < 4; ++m) { const size_t off = (size_t)(u.pm * 256 + ai * 128 + wr * 64 + m * 16 + fr) * 1024 + col0;
#pragma unroll
                for (int bj = 0; bj < 2; ++bj)
#pragma unroll
                    for (int n = 0; n < 2; ++n) { const f32x4 xv = *(const f32x4*)(x + off + bj * 128 + 4 * n); *(f32x4*)(out + off + bj * 128 + 4 * n) = xv + gx[bj][n] * acc[ai][bj][m][n]; }
                if (m & 1) asm volatile("" ::: "memory"); }
    }
};
struct EpiOutNorm {
    const float* x; const float* MOD; float* out; const float* fw; float* slots; unsigned* cnt; LAS float* tab;
    DI void mid(f32x4 (&)[2][2][4][2], const pg8::Unit&, int, int, int, int) const {}
    DI void operator()(const f32x4 (&acc_)[2][2][4][2], const pg8::Unit& u, int wr, int wc, int fr, int fq) const {
        f32x4 (&acc)[2][2][4][2] = const_cast<f32x4 (&)[2][2][4][2]>(acc_);
        const int col0 = u.pn * 256 + wc * 32 + 8 * fq; const float* gp = MOD + (u.pm >> 4) * 3072 + 2048 + col0;
        f32x4 gx[2][2];
#pragma unroll
        for (int bj = 0; bj < 2; ++bj)
#pragma unroll
            for (int n = 0; n < 2; ++n) gx[bj][n] = *(const f32x4*)(gp + bj * 128 + 4 * n);
#pragma unroll
        for (int ai = 0; ai < 2; ++ai)
#pragma unroll
            for (int m = 0; m < 4; ++m) { const int row = u.pm * 256 + ai * 128 + wr * 64 + m * 16 + fr; const size_t off = (size_t)row * 1024 + col0; float ss = 0.f;
#pragma unroll
                for (int bj = 0; bj < 2; ++bj)
#pragma unroll
                    for (int n = 0; n < 2; ++n) { const f32x4 xv = *(const f32x4*)(x + off + bj * 128 + 4 * n); const f32x4 v = xv + gx[bj][n] * acc[ai][bj][m][n]; acc[ai][bj][m][n] = v;
                        ss += (v.x * v.x + v.y * v.y) + (v.z * v.z + v.w * v.w); }
                ss += __shfl_xor(ss, 16); ss += __shfl_xor(ss, 32);
                if (fq == 0) __hip_atomic_store(slots + (size_t)row * 16 + u.pn * 4 + wc, ss, __ATOMIC_RELAXED, __HIP_MEMORY_SCOPE_AGENT);
                if (m & 1) asm volatile("" ::: "memory"); }
        asm volatile("s_waitcnt vmcnt(0)" ::: "memory");
        __syncthreads();
        if (threadIdx.x == 0) {
            unsigned* c = cnt + 64 * u.pm;
            __hip_atomic_fetch_add(c, 1u, __ATOMIC_RELAXED, __HIP_MEMORY_SCOPE_AGENT);
            unsigned sp = 0;
            while (__hip_atomic_load(c, __ATOMIC_RELAXED, __HIP_MEMORY_SCOPE_AGENT) < 4u) { __builtin_amdgcn_s_sleep(1); if (++sp > (1u << 22)) break; }
            __builtin_amdgcn_fence(__ATOMIC_ACQUIRE, "agent");
            asm volatile("s_waitcnt vmcnt(0)" ::: "memory");
        }
        __syncthreads();
        { const int t = threadIdx.x, row = t >> 1, half = t & 1; const float* sp = slots + (size_t)(u.pm * 256 + row) * 16 + half * 8; float s = 0.f;
#pragma unroll
            for (int j = 0; j < 8; ++j) s += __hip_atomic_load(sp + j, __ATOMIC_RELAXED, __HIP_MEMORY_SCOPE_AGENT);
            s += __shfl_xor(s, 1);
            if (half == 0) tab[row] = 1.0f / sqrtf(s * (1.f / 1024.f) + EPS); }
        __syncthreads();
        f32x4 fv[2][2];
#pragma unroll
        for (int bj = 0; bj < 2; ++bj)
#pragma unroll
            for (int n = 0; n < 2; ++n) fv[bj][n] = *(const f32x4*)(fw + col0 + bj * 128 + 4 * n);
#pragma unroll
        for (int ai = 0; ai < 2; ++ai)
#pragma unroll
            for (int m = 0; m < 4; ++m) { const int rl = ai * 128 + wr * 64 + m * 16 + fr; const float r = tab[rl]; const size_t off = (size_t)(u.pm * 256 + rl) * 1024 + col0;
#pragma unroll
                for (int bj = 0; bj < 2; ++bj)
#pragma unroll
                    for (int n = 0; n < 2; ++n) *(f32x4*)(out + off + bj * 128 + 4 * n) = acc[ai][bj][m][n] * r * fv[bj][n]; }
    }
};
DI void n6_ab(const Ctx& F) {
    const Tid T = opaque_tid();
    const size_t NT = (size_t)gridDim.x * 512, gt = (size_t)blockIdx.x * 512 + T.tid;
    for (size_t idx = gt; idx < (size_t)(MTOK / 4) * 1024; idx += NT) {
        const int n = (int)(idx & 1023), t0 = (int)(idx >> 10) * 4; float ya[4] = {0.f, 0.f, 0.f, 0.f}, yb[4] = {0.f, 0.f, 0.f, 0.f};
        for (int k = 0; k < 1024; ++k) { const float wa = F.w_a[(size_t)k * 1024 + n], wb = F.w_b[(size_t)k * 1024 + n];
#pragma unroll
            for (int j = 0; j < 4; ++j) { ya[j] += bf2f(F.P[(size_t)(t0 + j) * 1024 + k]) * wa; yb[j] += bf2f(F.UB[(size_t)(t0 + j) * 1024 + k]) * wb; } }
#pragma unroll
        for (int j = 0; j < 4; ++j) { const size_t o = (size_t)(t0 + j) * 1024 + n; const float sgb = bf2f(F.SGB[o]), sga = bf2f(F.R[o]) * sgb; F.MM[o] = f2bf(sga * ya[j] + sgb * yb[j]); }
    }
}
DI void n7_out(const Ctx& F) {
    const Tid T = opaque_tid();
    const size_t NT = (size_t)gridDim.x * 512, gt = (size_t)blockIdx.x * 512 + T.tid;
    for (size_t idx = gt; idx < (size_t)(MTOK / 4) * 1024; idx += NT) {
        const int n = (int)(idx & 1023), t0 = (int)(idx >> 10) * 4; float y[4] = {0.f, 0.f, 0.f, 0.f};
        for (int k = 0; k < 1024; ++k) { const float w = F.w_out[(size_t)k * 1024 + n];
#pragma unroll
            for (int j = 0; j < 4; ++j) y[j] += bf2f(F.MM[(size_t)(t0 + j) * 1024 + k]) * w; }
#pragma unroll
        for (int j = 0; j < 4; ++j) { const size_t o = (size_t)(t0 + j) * 1024 + n; F.out[o] = F.x[o] + F.MOD[((t0 + j) >> 12) * 3072 + 2048 + n] * y[j]; }
    }
}
DI void p8_final(const Ctx& F) {
    const Tid T = opaque_tid();
    const int gw = blockIdx.x * 8 + T.wave, NGW = gridDim.x * 8;
    for (int m = gw; m < MTOK; m += NGW) {
        f32x4* xr = (f32x4*)(F.out + (size_t)m * DM);
        f32x4 v[4]; float ss = 0.f;
#pragma unroll
        for (int j = 0; j < 4; ++j) { v[j] = xr[T.lane + 64 * j]; ss += (v[j].x * v[j].x + v[j].y * v[j].y) + (v[j].z * v[j].z + v[j].w * v[j].w); }
        const float rstd = 1.0f / sqrtf(wave_sum(ss) * (1.f / DM) + EPS);
#pragma unroll
        for (int j = 0; j < 4; ++j) { const f32x4 w = *(const f32x4*)(F.final_w + 4 * (T.lane + 64 * j)); xr[T.lane + 64 * j] = v[j] * rstd * w; }
    }
}

constexpr int NPH = 9;
__global__ void __launch_bounds__(512, 2) fwd_kernel(Args args) {
    extern __shared__ __attribute__((aligned(16))) unsigned char lds_raw[];
    Ctx F;
    F.lds = (LAS unsigned char*)lds_raw;
    if (threadIdx.x < 16) ((LAS unsigned*)(F.lds + LDS_MISC))[threadIdx.x] = 0u;
    __syncthreads();
    const XcdBarrier bar = xcd_barrier_post((unsigned*)(args.ws + WS_BAR), (volatile LAS unsigned*)(F.lds + LDS_MISC));
    F.x = args.in[0]; F.c = args.in[1]; F.ctx = args.in[2]; F.c_ctx = args.in[3]; F.norm_w = args.in[4]; F.ada_w = args.in[5]; F.ada_b = args.in[6]; F.w_in = args.in[7];
    F.conv_w = args.in[8]; F.conv_b = args.in[9]; F.decay_logit = args.in[10]; F.gn_w = args.in[11]; F.w_a = args.in[12]; F.w_b = args.in[13]; F.w_out = args.in[14]; F.final_w = args.in[15];
    F.out = args.out; unsigned char* ws = args.ws; F.ws = ws;
    F.MOD = (float*)(ws + WS_MOD); F.ROPE = (f32x2*)(ws + WS_ROPE);
    F.WA = (bf16_t*)(ws + WS_WA); F.WB = (bf16_t*)(ws + WS_WB); F.WOUT = (bf16_t*)(ws + WS_WOUT); F.WIN = (bf16_t*)(ws + WS_WIN); F.XM = (bf16_t*)(ws + WS_XM);
    F.KV = (bf16_t*)(ws + WS_KV); F.KVC = (bf16_t*)(ws + WS_KVC); F.HC = (bf16_t*)(ws + WS_HC); F.ST = (bf16_t*)(ws + WS_ST); F.MM = (bf16_t*)(ws + WS_MM);
    F.P = (bf16_t*)(ws + WS_P); F.Q = (bf16_t*)(ws + WS_Q); F.K = (bf16_t*)(ws + WS_K); F.V = (bf16_t*)(ws + WS_V); F.SZB = (bf16_t*)(ws + WS_SZB);
    F.KC = (bf16_t*)(ws + WS_KC); F.VC = (bf16_t*)(ws + WS_VC); F.UB = (bf16_t*)(ws + WS_UB);
    F.R = (bf16_t*)args.out; F.SGB = (bf16_t*)args.out + (size_t)MTOK * DM;
    F.RET = (float*)(ws + WS_RET); F.S0 = (float*)(ws + WS_KVC);
    const int lo = args.ph_lo, hi = args.ph_hi; const unsigned naive = args.naive;
#define IN(k) (lo <= (k) && (k) < hi && ((MK_PHASES >> (k)) & 1))
#define NAIVE(k) (((naive & MK_NAIVE_AVAIL) >> (k)) & 1u)
#define SEAM(k) do { if (IN(k) && IN((k) + 1)) xcd_barrier(bar); } while (0)
#define REP(k) for (int rep_ = 0; rep_ < 1 + (int)((MK_REP_MASK >> (k)) & 1u); ++rep_)
    if (IN(0)) REP(0) { p0_prologue(F); } SEAM(0);
    if (IN(1)) REP(1) { p1_rows(F); } SEAM(1);
    if (IN(2)) REP(2) {
        if (NAIVE(2)) n2_inproj(F);
        else { const char* const Ab[2] = {(const char*)F.XM, (const char*)F.XM}; const char* const Bb[2] = {(const char*)F.WIN, (const char*)F.WIN};
            Sched1 S{(int)gridDim.x, (int)blockIdx.x}; Epi1 E{F.ws, F.R, F.SGB, F.ROPE};
            pg8::gemm_phase<1, Epi1, Sched1>(F.lds, Ab, Bb, S, E); }
    } SEAM(2);
    if (IN(3)) {
        if (!NAIVE(3)) {
            const char* const Ab[2] = {(const char*)F.XM, (const char*)F.XM}; const char* const Bb[2] = {(const char*)F.WIN, (const char*)F.WIN};
            SchedCtx S{(int)blockIdx.x}; Epi1 E{F.ws, F.R, F.SGB, F.ROPE};
            pg8::gemm_phase<1, Epi1, SchedCtx>(F.lds, Ab, Bb, S, E);
            if (blockIdx.x >= 24) { REP(3) p3_kv(F, blockIdx.x - 24, 1024, gridDim.x - 24); p3_ua(F, blockIdx.x - 24, gridDim.x - 24); }
        } else p3_ua(F, blockIdx.x, gridDim.x);
    } SEAM(3);
    if (IN(4)) REP(4) { if (NAIVE(4)) n4_recurrence(F); else { if (blockIdx.x >= gridDim.x - 32) p4_ctx_state(F, blockIdx.x - (gridDim.x - 32)); p4_scan(F); } } SEAM(4);
    if (IN(5)) REP(5) { if (NAIVE(5)) n5_groupnorm(F); else p5_ret(F); } SEAM(5);
    if (IN(6)) REP(6) {
        if (NAIVE(6)) n6_ab(F);
        else { const char* const Ab[2] = {(const char*)F.P, (const char*)F.UB}; const char* const Bb[2] = {(const char*)F.WA, (const char*)F.WB};
            SchedSq S{(int)gridDim.x, (int)blockIdx.x}; EpiAB E{F.R, F.SGB, F.MM};
            pg8::gemm_phase<2, EpiAB, SchedSq>(F.lds, Ab, Bb, S, E); }
    } SEAM(6);
    if (IN(7)) REP(7) {
        if (NAIVE(7)) n7_out(F);
        else { const char* const Ab[2] = {(const char*)F.MM, (const char*)F.MM}; const char* const Bb[2] = {(const char*)F.WOUT, (const char*)F.WOUT};
            SchedSq S{(int)gridDim.x, (int)blockIdx.x};
            EpiOutNorm E{F.x, F.MOD, F.out, F.final_w, (float*)(F.ws + WS_SLOTS), (unsigned*)(F.ws + WS_PCNT), (LAS float*)(F.lds + LDS_TAB)};
            pg8::gemm_phase<1, EpiOutNorm, SchedSq>(F.lds, Ab, Bb, S, E); }
    }
    if (NAIVE(7)) { SEAM(7); if (IN(8)) { p8_final(F); } }
#undef IN
#undef NAIVE
#undef SEAM
}

extern "C" void kernel_launch(void* const* d_in, const int* in_sizes, int n_in, void* d_out, int out_size, void* d_ws, size_t ws_size, hipStream_t stream) {
    static int grid = 0;
    if (grid == 0) {
        if (n_in != 16 || out_size != MTOK * DM || ws_size < WS_END) { fprintf(stderr, "kernel_launch: unexpected shapes (n_in %d out %d ws %zu)\n", n_in, out_size, ws_size); grid = -1; return; }
        int dev = 0, cus = 0, per_cu = 0;
        hipGetDevice(&dev); hipDeviceGetAttribute(&cus, hipDeviceAttributeMultiprocessorCount, dev);
        hipFuncSetAttribute((const void*)fwd_kernel, hipFuncAttributeMaxDynamicSharedMemorySize, LDS_BYTES);
        hipOccupancyMaxActiveBlocksPerMultiprocessor(&per_cu, (const void*)fwd_kernel, 512, LDS_BYTES);
        if (per_cu < 1) { fprintf(stderr, "kernel_launch: occupancy query says %d blocks/CU\n", per_cu); per_cu = 1; }
        grid = cus;
        (void)hipGetLastError();
    }
    if (grid < 0) return;
    Args a{};
    for (int i = 0; i < 16; ++i) a.in[i] = (const float*)d_in[i];
    a.out = (float*)d_out; a.ws = (unsigned char*)d_ws; a.naive = MK_NAIVE_MASK;
    hipMemsetAsync((unsigned char*)d_ws + WS_BAR, 0, WS_BAR_BYTES, stream);
#if MK_LAUNCH_PER_PHASE
    for (int ph = 0; ph < NPH; ++ph) { a.ph_lo = ph; a.ph_hi = ph + 1; hipLaunchKernelGGL(fwd_kernel, dim3(grid), dim3(512), LDS_BYTES, stream, a); }
#else
    a.ph_lo = 0; a.ph_hi = NPH;
    hipLaunchKernelGGL(fwd_kernel, dim3(grid), dim3(512), LDS_BYTES, stream, a);
#endif
}
```

```cpp
#include <hip/hip_runtime.h>
#include <cstdio>
#include <cstdint>

#ifndef MK_LAUNCH_PER_PHASE
#define MK_LAUNCH_PER_PHASE 0
#endif
#ifndef MK_NAIVE_MASK
#define MK_NAIVE_MASK 0x00u
#endif

#ifndef MK_REP_MASK
#define MK_REP_MASK 0u
#endif
#ifndef MK_PHASES
#define MK_PHASES 0x1ff
#endif
#ifndef MK_NAIVE_AVAIL
#define MK_NAIVE_AVAIL 0xffu
#endif
#define DI __device__ __forceinline__
#define LAS __attribute__((address_space(3)))
typedef unsigned short bf16_t;
typedef float f32x4 __attribute__((ext_vector_type(4)));
typedef float f32x2 __attribute__((ext_vector_type(2)));
typedef unsigned u32x4 __attribute__((ext_vector_type(4)));
typedef unsigned u32x2 __attribute__((ext_vector_type(2)));
typedef short bf16x8 __attribute__((ext_vector_type(8)));
typedef short s16x4 __attribute__((ext_vector_type(4)));
typedef short v4i16_t __attribute__((ext_vector_type(4)));

constexpr int NB = 4, SEQ = 4096, DM = 1024, MTOK = NB * SEQ, CTXL = 256, MCTX = NB * CTXL, MALL = MTOK + MCTX;
constexpr int NIN = 9216, NH = 8, DK = 64, DV = 128, CHK = 128, NCHK = SEQ / CHK;
constexpr float EPS = 1e-6f;
constexpr size_t MiB = 1u << 20;
constexpr size_t WS_MOD = 0;
constexpr size_t WS_ROPE = 65536;
constexpr size_t WS_WA = 2 * MiB, WS_WB = 4 * MiB, WS_WOUT = 6 * MiB, WS_WIN = 8 * MiB;
constexpr size_t WS_XM = 26 * MiB;
constexpr size_t WS_KV = 223 * MiB;
constexpr size_t WS_KVC = 40 * MiB;
constexpr size_t WS_RET = 8 * MiB;
constexpr size_t WS_HC = 60 * MiB;
constexpr size_t WS_ST = 60 * MiB;
constexpr size_t WS_MM = 60 * MiB;
constexpr size_t WS_P = 92 * MiB;
constexpr size_t WS_Q = 124 * MiB, WS_K = 140 * MiB, WS_V = 156 * MiB, WS_SZB = 188 * MiB;
constexpr size_t WS_KC = 220 * MiB, WS_VC = 221 * MiB;
constexpr size_t WS_UB = 223 * MiB;
constexpr size_t WS_END = 255 * MiB;
constexpr int LDS_BYTES = 147456;
constexpr int LDS_MISC = 139264;
constexpr size_t WS_BAR = 131072, WS_BAR_BYTES = 65536;
constexpr size_t WS_PCNT = WS_BAR + 16384, WS_SLOTS = 1 * MiB;
constexpr int LDS_TAB = 132096;

DI float bf2f(bf16_t v) { return __uint_as_float((unsigned)v << 16); }
DI float bflo(unsigned w) { return __uint_as_float(w << 16); }
DI float bfhi(unsigned w) { return __uint_as_float(w & 0xffff0000u); }
typedef __bf16 bf16x2_t __attribute__((ext_vector_type(2)));
DI unsigned cvt_pk_bf16(float lo, float hi) { const f32x2 f = {lo, hi}; const bf16x2_t v = __builtin_convertvector(f, bf16x2_t); return __builtin_bit_cast(unsigned, v); }
DI bf16_t f2bf(float f) { return (bf16_t)(cvt_pk_bf16(f, 0.f) & 0xffffu); }
DI float wave_sum(float v) {
#pragma unroll
    for (int o = 1; o < 64; o <<= 1) v += __shfl_xor(v, o);
    return v;
}
struct Tid { int tid, lane, wave; };
DI Tid opaque_tid() { int t = threadIdx.x; asm volatile("" : "+v"(t)); Tid r; r.tid = t; r.lane = t & 63; r.wave = __builtin_amdgcn_readfirstlane(t >> 6); return r; }
DI float siluf(float x) { return x * __builtin_amdgcn_rcpf(1.f + __expf(-x)); }
DI float log2_gamma(const float* decay_logit, int dir, int h) {
    const float x = decay_logit[dir * NH + h];
    const float ls = fminf(x, 0.f) - log1pf(expf(-fabsf(x)));
    return ls * 1.4426950408889634f;
}

namespace pg8 {
constexpr int BM = 256, BK = 64, HALF = 128, HTB = HALF * BK * 2, STAGE_BYTES = 8 * HTB, NXCD = 8, WGM = 8;
DI int lds_byte(int r, int c) { const int st = (r >> 4) * 2 + (c >> 5), rr = r & 15, cc = c & 31, ob = rr * 64 + cc * 2; return st * 1024 + (ob ^ (((ob >> 9) & 1) << 5)); }
DI void stage_rc(int b, int& R, int& C) { const int st = b / 1024, sb = b % 1024, swz = sb ^ (((sb >> 9) & 1) << 5); R = (st >> 1) * 16 + swz / 64; C = (st & 1) * 32 + (swz % 64) / 2; }
DI int perm32(int rho) { const int n = rho >> 4, i = rho & 15; return 8 * (i >> 2) + 4 * n + (i & 3); }
struct Unit { int pm, pn; };
DI void tile_of(int L, int nM, int nN, Unit& u) {
    const int nwg = nM * nN; int wgid = L;
    { const int q = nwg / NXCD, r = nwg % NXCD, xcd = wgid % NXCD, off = wgid / NXCD; wgid = (xcd < r ? xcd * (q + 1) : r * (q + 1) + (xcd - r) * q) + off; }
    const int nig = WGM * nN, gid = wgid / nig, fm = gid * WGM, gsz = (nM - fm) < WGM ? (nM - fm) : WGM;
    u.pm = fm + ((wgid % nig) % gsz); u.pn = (wgid % nig) / gsz;
}
template <int NSEG, class Epi, class Sched>
DI void gemm_phase(LAS unsigned char* lds, const char* const (&Ab)[2], const char* const (&Bb)[2], const Sched& S, const Epi& E) {
    constexpr int K = 1024, NTS = K / BK;
    constexpr int nt = NSEG * NTS;
    const Tid T = opaque_tid();
    const int tid = T.tid, wid = T.wave, lane = T.lane, wr = wid >> 2, wc = (wid & 3) ^ (wr << 1), fr = lane & 15, fq = lane >> 4;
    unsigned voffA[2], voffB[2];
#pragma unroll
    for (int i = 0; i < 2; ++i) { int R, C; stage_rc(tid * 16 + i * 8192, R, C); const int Rb = (R & ~31) + perm32(R & 31);
        voffA[i] = (unsigned)(R * K + C) * 2u; voffB[i] = (unsigned)(Rb * K + C) * 2u; }
    constexpr size_t kstep = (size_t)(BK * 2);
    constexpr size_t hstep = (size_t)HALF * K * 2;
    constexpr size_t tstep = 2 * hstep;
    const unsigned ldsw = (unsigned)wid * 1024u;
    const int aoff = lds_byte(wr * 64 + fr, fq * 8), boff = lds_byte(wc * 32 + fr, fq * 8);
#define PG8_SA(b, h) (((b) * 2 + (h)) * HTB)
#define PG8_SB(b, h) ((4 + (b) * 2 + (h)) * HTB)
#define PG8_STAGE(bufoff, gbase, voff) do { _Pragma("unroll") for (int _i = 0; _i < 2; ++_i) \
        __builtin_amdgcn_global_load_lds((const unsigned*)((const char*)(gbase) + (voff)[_i]), (LAS unsigned*)(lds + (bufoff) + ldsw + _i * 8192), 16, 0, 0); } while (0)
#define PG8_LDA(dst, b, h) do { _Pragma("unroll") for (int m = 0; m < 4; ++m) _Pragma("unroll") for (int k = 0; k < 2; ++k) dst[m][k] = *(const LAS bf16x8*)(lds + PG8_SA(b, h) + aoff + m * 2048 + k * 1024); } while (0)
#define PG8_LDB(dst, b, h) do { _Pragma("unroll") for (int n = 0; n < 2; ++n) _Pragma("unroll") for (int k = 0; k < 2; ++k) dst[n][k] = *(const LAS bf16x8*)(lds + PG8_SB(b, h) + boff + n * 2048 + k * 1024); } while (0)
#define PG8_MMA(ai, bj, At, Bt) do { __builtin_amdgcn_s_setprio(1); _Pragma("unroll") for (int m = 0; m < 4; ++m) _Pragma("unroll") for (int n = 0; n < 2; ++n) _Pragma("unroll") for (int k = 0; k < 2; ++k) \
        acc[ai][bj][m][n] = __builtin_amdgcn_mfma_f32_16x16x32_bf16(Bt[n][k], At[m][k], acc[ai][bj][m][n], 0, 0, 0); __builtin_amdgcn_s_setprio(0); } while (0)
#define PG8_WAIT_V(n) asm volatile("s_waitcnt vmcnt(" #n ")" ::: "memory")
#define PG8_WAIT_L(n) asm volatile("s_waitcnt lgkmcnt(" #n ")" ::: "memory")
#define PG8_WAIT_VR(sel) asm volatile("s_cmp_lt_i32 %0, 8\n\ts_cbranch_scc1 .Lw8_%=\n\ts_cmp_lt_i32 %0, 16\n\ts_cbranch_scc1 .Lw16_%=\n\ts_waitcnt vmcnt(24)\n\ts_branch .Lwe_%=\n.Lw16_%=:\n\ts_waitcnt vmcnt(16)\n\ts_branch .Lwe_%=\n.Lw8_%=:\n\ts_waitcnt vmcnt(8)\n.Lwe_%=:" :: "s"(sel) : "memory", "scc")
#define PG8_BAR __builtin_amdgcn_s_barrier()
#define PG8_SCHED __builtin_amdgcn_sched_barrier(0)
#define PG8_TA(u, t) (Ab[(t) / NTS] + (size_t)(u).pm * tstep + (size_t)((t) % NTS) * kstep)
#define PG8_TB(u, t) (Bb[(t) / NTS] + (size_t)(u).pn * tstep + (size_t)((t) % NTS) * kstep)
    Unit cur, nxt; int ui = 0;
    if (!S.next(0, cur)) return;
    f32x4 acc[2][2][4][2];
#pragma unroll
    for (int a = 0; a < 2; ++a)
#pragma unroll
        for (int b = 0; b < 2; ++b)
#pragma unroll
            for (int m = 0; m < 4; ++m)
#pragma unroll
                for (int n = 0; n < 2; ++n) acc[a][b][m][n] = (f32x4){0.f, 0.f, 0.f, 0.f};
    bf16x8 At[4][2], B0[2][2], B1[2][2];
    {
        const char* cA = PG8_TA(cur, 0); const char* cB = PG8_TB(cur, 0);
        PG8_STAGE(PG8_SB(0, 0), cB, voffB); PG8_STAGE(PG8_SB(0, 1), cB + hstep, voffB); PG8_STAGE(PG8_SA(0, 0), cA, voffA); PG8_STAGE(PG8_SA(0, 1), cA + hstep, voffA);
        if (wr == 1) PG8_BAR;
        PG8_WAIT_V(2); PG8_BAR;
        PG8_STAGE(PG8_SB(1, 0), cB + kstep, voffB); PG8_STAGE(PG8_SA(1, 0), cA + kstep, voffA); PG8_STAGE(PG8_SB(1, 1), cB + hstep + kstep, voffB);
        PG8_WAIT_V(6); PG8_BAR;
    }
    for (;;) {
        const bool has_next = S.next(ui + 1, nxt);
        const Unit nu = has_next ? nxt : cur;
        for (int t = 0; t < nt; t += 2) {
            if (NSEG == 2 && t == NTS) E.mid(acc, cur, wr, wc, fr, fq);
            const bool last = (t == nt - 2);
            const char* a1 = PG8_TA(cur, t + 1);
            const char* a2 = last ? PG8_TA(nu, 0) : PG8_TA(cur, t + 2); const char* b2 = last ? PG8_TB(nu, 0) : PG8_TB(cur, t + 2);
            const char* a3 = a2 + kstep; const char* b3 = b2 + kstep;
            PG8_LDB(B0, 0, 0); PG8_LDB(B1, 0, 1); PG8_SCHED; PG8_LDA(At, 0, 0); PG8_STAGE(PG8_SA(1, 1), a1 + hstep, voffA);
            PG8_WAIT_V(8); PG8_WAIT_L(0); PG8_BAR; PG8_MMA(0, 0, At, B0); PG8_MMA(0, 1, At, B1); PG8_BAR; PG8_SCHED;
            PG8_LDA(At, 0, 1); PG8_STAGE(PG8_SB(0, 0), b2, voffB); PG8_STAGE(PG8_SB(0, 1), b2 + hstep, voffB); PG8_STAGE(PG8_SA(0, 0), a2, voffA);
            PG8_WAIT_V(8); PG8_WAIT_L(0); PG8_BAR; PG8_MMA(1, 0, At, B0); PG8_MMA(1, 1, At, B1); PG8_BAR; PG8_SCHED;
            PG8_LDB(B0, 1, 0); PG8_LDB(B1, 1, 1); PG8_SCHED; PG8_LDA(At, 1, 0); PG8_STAGE(PG8_SA(0, 1), a2 + hstep, voffA);
            PG8_WAIT_V(8); PG8_WAIT_L(0); PG8_BAR; PG8_MMA(0, 0, At, B0); PG8_MMA(0, 1, At, B1); PG8_BAR; PG8_SCHED;
            PG8_LDA(At, 1, 1); PG8_STAGE(PG8_SB(1, 0), b3, voffB); PG8_STAGE(PG8_SB(1, 1), b3 + hstep, voffB); PG8_STAGE(PG8_SA(1, 0), a3, voffA);
            PG8_WAIT_V(8); PG8_WAIT_L(0); PG8_BAR; PG8_MMA(1, 0, At, B0); PG8_MMA(1, 1, At, B1); PG8_BAR; PG8_SCHED;
        }
        if (wr == 0) PG8_BAR;
        E(acc, cur, wr, wc, fr, fq);
        if (!has_next) break;
#pragma unroll
        for (int a = 0; a < 2; ++a)
#pragma unroll
            for (int b = 0; b < 2; ++b)
#pragma unroll
                for (int m = 0; m < 4; ++m)
#pragma unroll
                    for (int n = 0; n < 2; ++n) acc[a][b][m][n] = (f32x4){0.f, 0.f, 0.f, 0.f};
        cur = nxt; ++ui;
        if (wr == 1) PG8_BAR;
    }
    PG8_WAIT_V(0);
    PG8_BAR;
#undef PG8_SA
#undef PG8_SB
#undef PG8_STAGE
#undef PG8_LDA
#undef PG8_LDB
#undef PG8_MMA
#undef PG8_WAIT_V
#undef PG8_WAIT_L
#undef PG8_WAIT_VR
#undef PG8_BAR
#undef PG8_SCHED
#undef PG8_TA
#undef PG8_TB
}
}


#define XB_TMO      128
#define XB_XCNT(j)  (256  + 64 * (j))
#define XB_XSUB(j)  (1280 + 64 * (j))
#define XB_XGEN(j)  (2304 + 64 * (j))
#define XB_TOP      3328
#define XB_TOPGEN   3392
#define XCD_BAR_WORDS 3456
#define XB_SPIN_CAP (1u << 18)
DI unsigned xb_ld(unsigned* p)              { return __hip_atomic_load(p, __ATOMIC_RELAXED, __HIP_MEMORY_SCOPE_AGENT); }
DI unsigned xb_add(unsigned* p, unsigned v) { return __hip_atomic_fetch_add(p, v, __ATOMIC_RELAXED, __HIP_MEMORY_SCOPE_AGENT); }
DI unsigned xb_xcc_id() { return (unsigned)__builtin_amdgcn_s_getreg((3 << 11) | 20) & 0xFu; }
#define XB_SPIN(cond, bar) do { unsigned _sp = 0; while (cond) { __builtin_amdgcn_s_sleep(1); \
    if ((++_sp & 255u) == 0u) { if (xb_ld(&(bar)[XB_TMO])) break; if (_sp > XB_SPIN_CAP) { atomicAdd(&(bar)[XB_TMO], 1u); break; } } } } while (0)
struct XcdBarrier { unsigned* bar; unsigned x; volatile LAS unsigned* st; };
DI XcdBarrier xcd_barrier_post(unsigned* bar, volatile LAS unsigned* st) {
    XcdBarrier b; b.bar = bar; b.x = xb_xcc_id(); b.st = st;
    if (threadIdx.x == 0) (void)xb_add(&bar[XB_XCNT(b.x)], 1u);
    return b;
}
DI void xcd_barrier_complete(unsigned* bar, unsigned x, unsigned& nloc, unsigned& nx) {
    const unsigned G = gridDim.x * gridDim.y * gridDim.z;
    unsigned sum, cnt, mine, sp = 0u;
    for (;;) {
        sum = 0u; cnt = 0u; mine = 0u;
#pragma unroll
        for (unsigned j = 0; j < 16; ++j) { const unsigned c = xb_ld(&bar[XB_XCNT(j)]); sum += c; cnt += (c > 0u) ? 1u : 0u; mine = (j == x) ? c : mine; }
        if (sum == G) break;
        __builtin_amdgcn_s_sleep(1);
        if ((++sp & 255u) == 0u) { if (xb_ld(&bar[XB_TMO])) break; if (sp > XB_SPIN_CAP) { atomicAdd(&bar[XB_TMO], 1u); break; } }
    }
    nloc = mine > 0u ? mine : 1u; nx = cnt > 0u ? cnt : 1u;
}
DI void xcd_barrier(const XcdBarrier& b) {
    asm volatile("s_waitcnt vmcnt(0)" ::: "memory");
    __syncthreads();
    if (threadIdx.x == 0) {
        unsigned* bar = b.bar;
        __builtin_amdgcn_s_waitcnt(0);
        unsigned nloc = b.st[0], nx = b.st[1];
        if (nloc == 0u) { xcd_barrier_complete(bar, b.x, nloc, nx); b.st[0] = nloc; b.st[1] = nx; }
        const unsigned old = xb_add(&bar[XB_XSUB(b.x)], 1u);
        const unsigned gen = old / nloc;
        if (old + 1u == (gen + 1u) * nloc) {
            __builtin_amdgcn_fence(__ATOMIC_RELEASE, "agent");
            asm volatile("s_waitcnt vmcnt(0)" ::: "memory");
            const unsigned og = xb_add(&bar[XB_TOP], 1u);
            const unsigned tg = og / nx;
            if (og + 1u == (tg + 1u) * nx) xb_add(&bar[XB_TOPGEN], 1u);
            else XB_SPIN(xb_ld(&bar[XB_TOPGEN]) == tg, bar);
            __builtin_amdgcn_fence(__ATOMIC_ACQUIRE, "agent");
            xb_add(&bar[XB_XGEN(b.x)], 1u);
            asm volatile("s_waitcnt vmcnt(0)" ::: "memory");
        } else {
            XB_SPIN(xb_ld(&bar[XB_XGEN(b.x)]) == gen, bar);
            __builtin_amdgcn_fence(__ATOMIC_ACQUIRE, "agent");
            asm volatile("s_waitcnt vmcnt(0)" ::: "memory");
        }
    }
    __syncthreads();
}

struct Args { const float* in[16]; float* out; unsigned char* ws; int ph_lo, ph_hi; unsigned naive; int pad; };
struct Ctx {
    LAS unsigned char* lds;
    const float *x, *c, *ctx, *c_ctx, *norm_w, *ada_w, *ada_b, *w_in, *conv_w, *conv_b, *decay_logit, *gn_w, *w_a, *w_b, *w_out, *final_w;
    float* out; unsigned char* ws;
    float* MOD; f32x2* ROPE;
    bf16_t *WA, *WB, *WOUT, *WIN, *XM, *KV, *KVC, *HC, *ST, *MM, *P, *Q, *K, *V, *SZB, *KC, *VC, *UB, *R, *SGB;
    float* RET; float* S0;
};

DI int win_dest(int o) {
    if (o < 4096) { const int g = o >> 10, ch = o & 1023; return 256 * (ch >> 6) + 64 * g + (ch & 63); }
    if (o < 5120) { const int qk = (o - 4096) >> 9, oo = (o - 4096) & 511, head = oo >> 6, i = oo & 63, t = head >> 2, hh = head & 3;
        return 256 * (16 + 2 * qk + t) + (i < 32 ? 32 * hh + i : 128 + 32 * hh + (i - 32)); }
    if (o < 7168) return o;
    { const int gs = (o - 7168) >> 10, ch = (o - 7168) & 1023; return 256 * (28 + (ch >> 7)) + 128 * gs + (ch & 127); }
}
DI void p0_transpose_item(const float* W, int K, int N, bf16_t* WT, bool permute, LAS float* scr, int item, int lane) {
    const int nblk = N / 32, kb = item / nblk, nb = item % nblk, k0 = 64 * kb, n0 = 32 * nb;
    float rv[32];
#pragma unroll
    for (int i = 0; i < 32; ++i) rv[i] = W[(size_t)(k0 + 2 * i + (lane >> 5)) * N + n0 + (lane & 31)];
#pragma unroll
    for (int i = 0; i < 32; ++i) scr[(2 * i + (lane >> 5)) * 33 + (lane & 31)] = rv[i];
    asm volatile("s_waitcnt lgkmcnt(0)" ::: "memory");
    const int c = lane & 7; const int d0 = permute ? win_dest(n0) : n0;
#pragma unroll
    for (int j = 0; j < 4; ++j) { const int n = (lane >> 3) + 8 * j; const LAS float* s = scr + (8 * c) * 33 + n;
        u32x4 o; o.x = cvt_pk_bf16(s[0 * 33], s[1 * 33]); o.y = cvt_pk_bf16(s[2 * 33], s[3 * 33]); o.z = cvt_pk_bf16(s[4 * 33], s[5 * 33]); o.w = cvt_pk_bf16(s[6 * 33], s[7 * 33]);
        *(u32x4*)(WT + (size_t)(d0 + n) * K + k0 + 8 * c) = o; }
    asm volatile("s_waitcnt lgkmcnt(0)" ::: "memory");
}
DI void p0_prologue(const Ctx& F) {
    const Tid T = opaque_tid();
    if (blockIdx.x < 48) {
        LAS float* red = (LAS float*)F.lds;
        LAS float* sl = (LAS float*)(F.lds + 16384);
        for (int e = T.tid; e < 5 * 1024; e += 512) { const int v = e >> 10, k = e & 1023; sl[e] = siluf(v < 4 ? F.c[v * 1024 + k] : F.c_ctx[k]); }
        __syncthreads();
        const int n0 = 64 * blockIdx.x, k0 = 128 * T.wave;
        float a[5] = {0.f, 0.f, 0.f, 0.f, 0.f};
#pragma unroll 4
        for (int kb = 0; kb < 128; kb += 32) {
            float wv[32];
#pragma unroll
            for (int k = 0; k < 32; ++k) wv[k] = F.ada_w[(size_t)(k0 + kb + k) * 3072 + n0 + T.lane];
#pragma unroll
            for (int k = 0; k < 32; ++k)
#pragma unroll
                for (int v = 0; v < 5; ++v) a[v] += sl[v * 1024 + k0 + kb + k] * wv[k];
        }
#pragma unroll
        for (int v = 0; v < 5; ++v) red[(T.wave * 5 + v) * 64 + T.lane] = a[v];
        __syncthreads();
        if (T.tid < 320) { const int v = T.tid >> 6, l = T.tid & 63; float s = F.ada_b[n0 + l];
#pragma unroll
            for (int w = 0; w < 8; ++w) s += red[(w * 5 + v) * 64 + l];
            F.MOD[v * 3072 + n0 + l] = s; }
        __syncthreads();
    }
    if (blockIdx.x == 48) {
        for (int e = T.tid; e < 1024; e += 512) { const int p = e >> 4, f = e & 15; const float inv = powf(10000.f, -(float)f / 16.f); const float ang = (float)p * inv;
            F.ROPE[e] = (f32x2){cosf(ang), sinf(ang)}; }
    }
    LAS float* scr = (LAS float*)(F.lds + T.wave * 16384);
    const int gw = blockIdx.x * 8 + T.wave, NGW = gridDim.x * 8;
    constexpr int I_IN = 16 * (NIN / 32), I_SQ = 16 * 32;
    for (int it = gw; it < I_IN + 3 * I_SQ; it += NGW) {
        int r = it;
        if (r < I_IN) { p0_transpose_item(F.w_in, 1024, NIN, F.WIN, true, scr, r, T.lane); continue; } r -= I_IN;
        if (r < I_SQ) { p0_transpose_item(F.w_a, 1024, 1024, F.WA, false, scr, r, T.lane); continue; } r -= I_SQ;
        if (r < I_SQ) { p0_transpose_item(F.w_b, 1024, 1024, F.WB, false, scr, r, T.lane); continue; } r -= I_SQ;
        p0_transpose_item(F.w_out, 1024, 1024, F.WOUT, false, scr, r, T.lane);
    }
}
DI void p1_rows(const Ctx& F) {
    const Tid T = opaque_tid();
    const int gw = blockIdx.x * 8 + T.wave, NGW = gridDim.x * 8;
    constexpr int RB = 4;
    for (int m0 = gw * RB; m0 < MALL; m0 += NGW * RB) {
        f32x4 v[RB][4]; float ss[RB];
#pragma unroll
        for (int r = 0; r < RB; ++r) { const int m = m0 + r; const float* xr = m < MTOK ? F.x + (size_t)m * DM : F.ctx + (size_t)(m - MTOK) * DM;
#pragma unroll
            for (int j = 0; j < 4; ++j) v[r][j] = ((const f32x4*)xr)[T.lane + 64 * j]; }
#pragma unroll
        for (int r = 0; r < RB; ++r) { float s = 0.f;
#pragma unroll
            for (int j = 0; j < 4; ++j) s += (v[r][j].x * v[r][j].x + v[r][j].y * v[r][j].y) + (v[r][j].z * v[r][j].z + v[r][j].w * v[r][j].w);
            ss[r] = s; }
#pragma unroll
        for (int o = 1; o < 64; o <<= 1)
#pragma unroll
            for (int r = 0; r < RB; ++r) ss[r] += __shfl_xor(ss[r], o);
        const int mb = m0 < MTOK ? (m0 >> 12) : 4; const float* mod = F.MOD + mb * 3072;
#pragma unroll
        for (int j = 0; j < 4; ++j) { const int col = 4 * (T.lane + 64 * j);
            const f32x4 w = *(const f32x4*)(F.norm_w + col), sh = *(const f32x4*)(mod + col), sc = *(const f32x4*)(mod + 1024 + col);
#pragma unroll
            for (int r = 0; r < RB; ++r) { const float rstd = __builtin_amdgcn_rsqf(ss[r] * (1.f / DM) + EPS);
                const f32x4 y = (v[r][j] * rstd * w) * (sc + 1.0f) + sh;
                u32x2 o; o.x = cvt_pk_bf16(y.x, y.y); o.y = cvt_pk_bf16(y.z, y.w);
                *(u32x2*)(F.XM + (size_t)(m0 + r) * DM + col) = o; } }
    }
}
struct Sched1 {
    int G, c;
    DI bool next(int i, pg8::Unit& u) const { const int L = i * G + c; if (L >= 64 * 36) return false; pg8::tile_of(L, 64, 36, u); return true; }
};
struct SchedCtx {
    int c;
    DI bool next(int i, pg8::Unit& u) const { if (i > 0 || c >= 24) return false; u.pm = 64 + c / 6; u.pn = 18 + c % 6; return true; }
};
struct Epi1 {
    unsigned char* ws; bf16_t *R, *SGB; const f32x2* rope;
    DI int vm_ops(const pg8::Unit& u) const { return u.pn < 16 ? 8 : 16; }
    DI void mid(f32x4 (&)[2][2][4][2], const pg8::Unit&, int, int, int, int) const {}
    DI void operator()(const f32x4 (&acc)[2][2][4][2], const pg8::Unit& u, int wr, int wc, int fr, int fq) const {
        const int pn = u.pn, row0 = u.pm * 256 + wr * 64 + fr, x0 = wc * 32 + 8 * fq;
        const bool isctx = u.pm >= 64;
        if (pn < 16) {
            bf16_t* dst = (bf16_t*)(ws + (wc < 2 ? WS_HC : WS_P)) + 64 * pn + (x0 & 63);
#pragma unroll
            for (int ai = 0; ai < 2; ++ai)
#pragma unroll
                for (int m = 0; m < 4; ++m) { const size_t row = row0 + ai * 128 + m * 16;
                    f32x4 o[2];
#pragma unroll
                    for (int n = 0; n < 2; ++n) { const f32x4 a = acc[ai][0][m][n], b = acc[ai][1][m][n];
                        if (wc < 2) o[n] = a * b;
                        else { o[n].x = a.x * siluf(b.x); o[n].y = a.y * siluf(b.y); o[n].z = a.z * siluf(b.z); o[n].w = a.w * siluf(b.w); } }
                    u32x4 w; w.x = cvt_pk_bf16(o[0].x, o[0].y); w.y = cvt_pk_bf16(o[0].z, o[0].w); w.z = cvt_pk_bf16(o[1].x, o[1].y); w.w = cvt_pk_bf16(o[1].z, o[1].w);
                    *(u32x4*)(dst + row * 1024) = w; }
        } else if (pn < 20) {
            const int t = (pn - 16) & 1, isk = (pn - 16) >> 1, head = 4 * t + wc, i0 = 8 * fq;
            const float scale = isk ? 0.125f : 1.0f;
            bf16_t* base = (bf16_t*)(ws + (isk ? (isctx ? WS_KC : WS_K) : WS_Q));
#pragma unroll
            for (int ai = 0; ai < 2; ++ai)
#pragma unroll
                for (int m = 0; m < 4; ++m) { const int row = row0 + ai * 128 + m * 16; const int orow = isctx ? row - MTOK : row;
                    const int pos = row & 4095, pidx = (fq < 2) ? (pos >> 6) : (pos & 63);
                    const f32x2* rp = rope + pidx * 16 + (fq & 1) * 8;
                    float o1[8], o2[8];
#pragma unroll
                    for (int e = 0; e < 8; ++e) { f32x2 cs = rp[e]; if (isctx) cs = (f32x2){1.f, 0.f};
                        const float t1 = acc[ai][0][m][e >> 2][e & 3], t2 = acc[ai][1][m][e >> 2][e & 3];
                        o1[e] = (t1 * cs.x - t2 * cs.y) * scale; o2[e] = (t1 * cs.y + t2 * cs.x) * scale; }
                    u32x4 w1, w2; w1.x = cvt_pk_bf16(o1[0], o1[1]); w1.y = cvt_pk_bf16(o1[2], o1[3]); w1.z = cvt_pk_bf16(o1[4], o1[5]); w1.w = cvt_pk_bf16(o1[6], o1[7]);
                    w2.x = cvt_pk_bf16(o2[0], o2[1]); w2.y = cvt_pk_bf16(o2[2], o2[3]); w2.z = cvt_pk_bf16(o2[4], o2[5]); w2.w = cvt_pk_bf16(o2[6], o2[7]);
                    bf16_t* d = base + (size_t)orow * 512 + head * 64 + i0;
                    *(u32x4*)d = w1; *(u32x4*)(d + 32) = w2; }
        } else if (pn < 28) {
            const bool isz = pn >= 24;
            bf16_t* base = (bf16_t*)(ws + (isz ? WS_SZB : (isctx ? WS_VC : WS_V)));
            const int colt = 256 * (pn - (isz ? 24 : 20)) + x0;
#pragma unroll
            for (int ai = 0; ai < 2; ++ai)
#pragma unroll
                for (int m = 0; m < 4; ++m) { const int row = row0 + ai * 128 + m * 16; const int orow = isctx ? row - MTOK : row;
#pragma unroll
                    for (int bj = 0; bj < 2; ++bj) { f32x4 a = acc[ai][bj][m][0], b = acc[ai][bj][m][1];
                        u32x4 w; w.x = cvt_pk_bf16(a.x, a.y); w.y = cvt_pk_bf16(a.z, a.w); w.z = cvt_pk_bf16(b.x, b.y); w.w = cvt_pk_bf16(b.z, b.w);
                        if (isz) __builtin_nontemporal_store(w, (u32x4*)(base + (size_t)orow * 1024 + colt + bj * 128)); else *(u32x4*)(base + (size_t)orow * 1024 + colt + bj * 128) = w; } }
        } else {
            const int col = 128 * (pn - 28) + x0;
#pragma unroll
            for (int ai = 0; ai < 2; ++ai)
#pragma unroll
                for (int m = 0; m < 4; ++m) { const size_t row = row0 + ai * 128 + m * 16;
                    float rr[8], sg[8];
#pragma unroll
                    for (int e = 0; e < 8; ++e) { const float ga = acc[ai][0][m][e >> 2][e & 3], gb = acc[ai][1][m][e >> 2][e & 3];
                        const float ea = 1.f + __expf(-ga), eb = 1.f + __expf(-gb); sg[e] = __builtin_amdgcn_rcpf(eb); rr[e] = eb * __builtin_amdgcn_rcpf(ea); }
                    u32x4 w1, w2; w1.x = cvt_pk_bf16(rr[0], rr[1]); w1.y = cvt_pk_bf16(rr[2], rr[3]); w1.z = cvt_pk_bf16(rr[4], rr[5]); w1.w = cvt_pk_bf16(rr[6], rr[7]);
                    w2.x = cvt_pk_bf16(sg[0], sg[1]); w2.y = cvt_pk_bf16(sg[2], sg[3]); w2.z = cvt_pk_bf16(sg[4], sg[5]); w2.w = cvt_pk_bf16(sg[6], sg[7]);
                    __builtin_nontemporal_store(w1, (u32x4*)(R + row * 1024 + col)); __builtin_nontemporal_store(w2, (u32x4*)(SGB + row * 1024 + col)); }
        }
    }
};
DI void n2_inproj(const Ctx& F) {
    const Tid T = opaque_tid();
    const size_t NT = (size_t)gridDim.x * 512, gt = (size_t)blockIdx.x * 512 + T.tid;
    for (size_t idx = gt; idx < (size_t)(MALL / 4) * 1024; idx += NT) {
        const int ch = (int)(idx & 1023), t0 = (int)(idx >> 10) * 4;
        const bool doqk = ch < 512 && (ch & 63) < 32;
        float a[12][4];
#pragma unroll
        for (int o = 0; o < 12; ++o)
#pragma unroll
            for (int j = 0; j < 4; ++j) a[o][j] = 0.f;
        for (int k = 0; k < 1024; ++k) {
            const float* wr = F.w_in + (size_t)k * NIN;
            float xv[4];
#pragma unroll
            for (int j = 0; j < 4; ++j) xv[j] = bf2f(F.XM[(size_t)(t0 + j) * 1024 + k]);
            float w[12];
            w[0] = wr[ch]; w[1] = wr[1024 + ch]; w[2] = wr[2048 + ch]; w[3] = wr[3072 + ch]; w[4] = wr[5120 + ch]; w[5] = wr[6144 + ch]; w[6] = wr[7168 + ch]; w[7] = wr[8192 + ch];
            if (doqk) { w[8] = wr[4096 + ch]; w[9] = wr[4096 + ch + 32]; w[10] = wr[4608 + ch]; w[11] = wr[4608 + ch + 32]; } else { w[8] = w[9] = w[10] = w[11] = 0.f; }
#pragma unroll
            for (int o = 0; o < 12; ++o)
#pragma unroll
                for (int j = 0; j < 4; ++j) a[o][j] += xv[j] * w[o];
        }
#pragma unroll
        for (int j = 0; j < 4; ++j) { const int t = t0 + j;
            if (t < MTOK) {
                const size_t o = (size_t)t * 1024 + ch;
                F.HC[o] = f2bf(a[2][j] * a[0][j]); F.P[o] = f2bf(siluf(a[3][j]) * a[1][j]); F.V[o] = f2bf(a[4][j]); F.SZB[o] = f2bf(a[5][j]);
                const float sga = 1.f / (1.f + __expf(-a[6][j])), sgb = 1.f / (1.f + __expf(-a[7][j]));
                F.R[o] = f2bf(sga / sgb); F.SGB[o] = f2bf(sgb);
                if (doqk) { const int i = ch & 63, pos = t & 4095; const int pidx = i < 16 ? (pos >> 6) : (pos & 63); const f32x2 cs = F.ROPE[pidx * 16 + (i & 15)];
                    const size_t q = (size_t)t * 512 + ch;
                    F.Q[q] = f2bf(a[8][j] * cs.x - a[9][j] * cs.y); F.Q[q + 32] = f2bf(a[8][j] * cs.y + a[9][j] * cs.x);
                    F.K[q] = f2bf((a[10][j] * cs.x - a[11][j] * cs.y) * 0.125f); F.K[q + 32] = f2bf((a[10][j] * cs.y + a[11][j] * cs.x) * 0.125f); }
            } else {
                const int tc = t - MTOK;
                F.VC[(size_t)tc * 1024 + ch] = f2bf(a[4][j]);
                if (doqk) { F.KC[(size_t)tc * 512 + ch] = f2bf(a[10][j] * 0.125f); F.KC[(size_t)tc * 512 + ch + 32] = f2bf(a[11][j] * 0.125f); }
            }
        }
    }
}
DI bf16x8 tr2(const LAS unsigned char* p, int delta) {
    const s16x4 lo = __builtin_bit_cast(s16x4, __builtin_amdgcn_ds_read_tr16_b64_v4i16((LAS v4i16_t*)p));
    const s16x4 hi = __builtin_bit_cast(s16x4, __builtin_amdgcn_ds_read_tr16_b64_v4i16((LAS v4i16_t*)(p + delta)));
    return __builtin_shufflevector(lo, hi, 0, 1, 2, 3, 4, 5, 6, 7);
}
DI u32x4 scale8(u32x4 w, float s) {
    u32x4 o; o.x = cvt_pk_bf16(bflo(w.x) * s, bfhi(w.x) * s); o.y = cvt_pk_bf16(bflo(w.y) * s, bfhi(w.y) * s); o.z = cvt_pk_bf16(bflo(w.z) * s, bfhi(w.z) * s); o.w = cvt_pk_bf16(bflo(w.w) * s, bfhi(w.w) * s); return o;
}
DI void p3_kv(const Ctx& F, int it0, int it1, int stride) {
    const Tid T = opaque_tid();
    LAS unsigned char* KFI = F.lds; LAS unsigned char* KBI = F.lds + 20480; LAS unsigned char* VI = F.lds + 40960;
    const int tid = T.tid, lane = T.lane, w = T.wave, g = lane >> 4, q = (lane & 15) >> 2, p = lane & 3;
    const int row = tid >> 2, seg = tid & 3;
    u32x4 pk[2], pv[4];
    auto prefetch = [&](int it) { const int bh = it >> 5, c = it & 31; const size_t tok0 = (size_t)(bh >> 3) * SEQ + c * CHK;
        const bf16_t* kp = F.K + tok0 * 512 + (bh & 7) * 64; const bf16_t* vp = F.V + tok0 * 1024 + (bh & 7) * 128;
        pk[0] = *(const u32x4*)(kp + (size_t)row * 512 + seg * 16); pk[1] = *(const u32x4*)(kp + (size_t)row * 512 + seg * 16 + 8);
#pragma unroll
        for (int i = 0; i < 4; ++i) pv[i] = *(const u32x4*)(vp + (size_t)row * 1024 + seg * 32 + 8 * i); };
    if (it0 < it1) prefetch(it0);
    for (int it = it0; it < it1; it += stride) {
        const int bh = it >> 5, c = it & 31;
        const float l2f = log2_gamma(F.decay_logit, 0, bh & 7), l2b = log2_gamma(F.decay_logit, 1, bh & 7);
        { const float df = __builtin_amdgcn_exp2f(l2f * (float)(127 - row)), db = __builtin_amdgcn_exp2f(l2b * (float)row);
            *(LAS u32x4*)(KFI + row * 160 + seg * 32) = scale8(pk[0], df); *(LAS u32x4*)(KFI + row * 160 + seg * 32 + 16) = scale8(pk[1], df);
            *(LAS u32x4*)(KBI + row * 160 + seg * 32) = scale8(pk[0], db); *(LAS u32x4*)(KBI + row * 160 + seg * 32 + 16) = scale8(pk[1], db);
#pragma unroll
            for (int i = 0; i < 4; ++i) *(LAS u32x4*)(VI + row * 288 + seg * 64 + 16 * i) = pv[i]; }
        __syncthreads();
        if (it + stride < it1) prefetch(it + stride);
        f32x4 acc[2][4];
#pragma unroll
        for (int d = 0; d < 2; ++d)
#pragma unroll
            for (int nb = 0; nb < 4; ++nb) acc[d][nb] = (f32x4){0.f, 0.f, 0.f, 0.f};
#pragma unroll
        for (int s2 = 0; s2 < 4; ++s2) {
            const bf16x8 vb = tr2(VI + (32 * s2 + 8 * g + q) * 288 + (16 * w + 4 * p) * 2, 4 * 288);
#pragma unroll
            for (int nb = 0; nb < 4; ++nb) {
                const bf16x8 kf = tr2(KFI + (32 * s2 + 8 * g + q) * 160 + (16 * nb + 4 * p) * 2, 4 * 160);
                const bf16x8 kb = tr2(KBI + (32 * s2 + 8 * g + q) * 160 + (16 * nb + 4 * p) * 2, 4 * 160);
                acc[0][nb] = __builtin_amdgcn_mfma_f32_16x16x32_bf16(kf, vb, acc[0][nb], 0, 0, 0);
                acc[1][nb] = __builtin_amdgcn_mfma_f32_16x16x32_bf16(kb, vb, acc[1][nb], 0, 0, 0);
            }
        }
        bf16_t* of = F.KV + ((size_t)(0 * 32 + bh) * 32 + c) * 8192; bf16_t* ob = F.KV + ((size_t)(1 * 32 + bh) * 32 + c) * 8192;
#pragma unroll
        for (int nb = 0; nb < 4; ++nb) { const int o = (16 * w + (lane & 15)) * 64 + 16 * nb + 4 * g;
            u32x2 a, b; a.x = cvt_pk_bf16(acc[0][nb].x, acc[0][nb].y); a.y = cvt_pk_bf16(acc[0][nb].z, acc[0][nb].w); b.x = cvt_pk_bf16(acc[1][nb].x, acc[1][nb].y); b.y = cvt_pk_bf16(acc[1][nb].z, acc[1][nb].w);
            *(u32x2*)(of + o) = a; *(u32x2*)(ob + o) = b; }
        __syncthreads();
    }
}
DI void p4_ctx_state(const Ctx& F, int bh) {
    const Tid T = opaque_tid();
    LAS unsigned char* KFI = F.lds; LAS unsigned char* KBI = F.lds + 20480; LAS unsigned char* VI = F.lds + 40960;
    const int tid = T.tid, lane = T.lane, w = T.wave, g = lane >> 4, q = (lane & 15) >> 2, p = lane & 3;
    const int row = tid >> 2, seg = tid & 3;
    const float l2f = log2_gamma(F.decay_logit, 0, bh & 7), l2b = log2_gamma(F.decay_logit, 1, bh & 7);
    f32x4 acc[2][4];
#pragma unroll
    for (int d = 0; d < 2; ++d)
#pragma unroll
        for (int nb = 0; nb < 4; ++nb) acc[d][nb] = (f32x4){0.f, 0.f, 0.f, 0.f};
    for (int cc = 0; cc < 2; ++cc) {
        const size_t tok0 = (size_t)(bh >> 3) * CTXL + cc * CHK; const int m = cc * CHK + row;
        const bf16_t* kp = F.KC + tok0 * 512 + (bh & 7) * 64; const bf16_t* vp = F.VC + tok0 * 1024 + (bh & 7) * 128;
        const u32x4 k0 = *(const u32x4*)(kp + (size_t)row * 512 + seg * 16), k1 = *(const u32x4*)(kp + (size_t)row * 512 + seg * 16 + 8);
        const float df = __builtin_amdgcn_exp2f(l2f * (float)(255 - m)), db = __builtin_amdgcn_exp2f(l2b * (float)m);
        *(LAS u32x4*)(KFI + row * 160 + seg * 32) = scale8(k0, df); *(LAS u32x4*)(KFI + row * 160 + seg * 32 + 16) = scale8(k1, df);
        *(LAS u32x4*)(KBI + row * 160 + seg * 32) = scale8(k0, db); *(LAS u32x4*)(KBI + row * 160 + seg * 32 + 16) = scale8(k1, db);
#pragma unroll
        for (int i = 0; i < 4; ++i) *(LAS u32x4*)(VI + row * 288 + seg * 64 + 16 * i) = *(const u32x4*)(vp + (size_t)row * 1024 + seg * 32 + 8 * i);
        __syncthreads();
#pragma unroll
        for (int s2 = 0; s2 < 4; ++s2) {
            const bf16x8 vb = tr2(VI + (32 * s2 + 8 * g + q) * 288 + (16 * w + 4 * p) * 2, 4 * 288);
#pragma unroll
            for (int nb = 0; nb < 4; ++nb) {
                const bf16x8 kf = tr2(KFI + (32 * s2 + 8 * g + q) * 160 + (16 * nb + 4 * p) * 2, 4 * 160);
                const bf16x8 kb = tr2(KBI + (32 * s2 + 8 * g + q) * 160 + (16 * nb + 4 * p) * 2, 4 * 160);
                acc[0][nb] = __builtin_amdgcn_mfma_f32_16x16x32_bf16(kf, vb, acc[0][nb], 0, 0, 0);
                acc[1][nb] = __builtin_amdgcn_mfma_f32_16x16x32_bf16(kb, vb, acc[1][nb], 0, 0, 0);
            }
        }
        __syncthreads();
    }
    float* of = F.S0 + (size_t)(0 * 32 + bh) * 8192; float* ob = F.S0 + (size_t)(1 * 32 + bh) * 8192;
#pragma unroll
    for (int nb = 0; nb < 4; ++nb) { const int o = (16 * w + (lane & 15)) * 64 + 16 * nb + 4 * g; *(f32x4*)(of + o) = acc[0][nb]; *(f32x4*)(ob + o) = acc[1][nb]; }
}
DI void p3_ua(const Ctx& F, int blk, int nblk) {
    const Tid T = opaque_tid();
    const size_t NT = (size_t)nblk * 512, gt = (size_t)blk * 512 + T.tid;
    for (size_t idx = gt; idx < (size_t)MTOK * 128; idx += NT) {
        const int t = (int)(idx >> 7), c8 = (int)(idx & 127) * 8, pos = t & 4095;
        const bf16_t* hp = F.HC + (size_t)t * 1024 + c8;
        const u32x4 z = (u32x4){0u, 0u, 0u, 0u};
        const u32x4 h0 = pos > 0 ? *(const u32x4*)(hp - 1024) : z, h1 = *(const u32x4*)hp, h2 = pos < SEQ - 1 ? *(const u32x4*)(hp + 1024) : z;
        const u32x4 pv = *(const u32x4*)(F.P + (size_t)t * 1024 + c8);
        float o[8];
#pragma unroll
        for (int e = 0; e < 8; ++e) { const unsigned a = h0[e >> 1], b = h1[e >> 1], c = h2[e >> 1], pp = pv[e >> 1];
            const float x0 = (e & 1) ? bfhi(a) : bflo(a), x1 = (e & 1) ? bfhi(b) : bflo(b), x2 = (e & 1) ? bfhi(c) : bflo(c), pf = (e & 1) ? bfhi(pp) : bflo(pp);
            const float cv = F.conv_w[c8 + e] * x0 + F.conv_w[1024 + c8 + e] * x1 + F.conv_w[2048 + c8 + e] * x2 + F.conv_b[c8 + e];
            o[e] = pf * cv; }
        u32x4 w; w.x = cvt_pk_bf16(o[0], o[1]); w.y = cvt_pk_bf16(o[2], o[3]); w.z = cvt_pk_bf16(o[4], o[5]); w.w = cvt_pk_bf16(o[6], o[7]);
        *(u32x4*)(F.P + (size_t)t * 1024 + c8) = w;
    }
}
DI void p4_scan(const Ctx& F) {
    const Tid T = opaque_tid();
    const size_t NT = (size_t)gridDim.x * 512, gt = (size_t)blockIdx.x * 512 + T.tid;
    for (size_t idx = gt; idx < (size_t)2 * 32 * 2048; idx += NT) {
        const int e4 = (int)(idx & 2047), bh = (int)(idx >> 11) & 31, dir = (int)(idx >> 16);
        const float g = exp2f(log2_gamma(F.decay_logit, dir, bh & 7) * 128.f);
        const u32x2* kv = (const u32x2*)(F.KV + ((size_t)(dir * 32 + bh) * 32) * 8192) + e4;
        u32x2* st = (u32x2*)(F.ST + ((size_t)(dir * 32 + bh) * 32) * 8192) + e4;
        float s0 = 0.f, s1 = 0.f, s2 = 0.f, s3 = 0.f;
        u32x2 v[32];
#pragma unroll
        for (int i = 0; i < 32; ++i) v[i] = kv[(size_t)(dir == 0 ? i : 31 - i) * 2048];
#pragma unroll
        for (int i = 0; i < 32; ++i) { const int c = dir == 0 ? i : 31 - i;
            u32x2 o; o.x = cvt_pk_bf16(s0, s1); o.y = cvt_pk_bf16(s2, s3); st[(size_t)c * 2048] = o;
            s0 = g * s0 + bflo(v[i].x); s1 = g * s1 + bfhi(v[i].x); s2 = g * s2 + bflo(v[i].y); s3 = g * s3 + bfhi(v[i].y); }
    }
}
DI void n4_recurrence(const Ctx& F) {
    const Tid T = opaque_tid();
    const int gw = blockIdx.x * 8 + T.wave, NGW = gridDim.x * 8, d = T.lane;
    for (int task = gw; task < 32 * 128; task += NGW) {
        const int bh = task >> 7, v = task & 127, b = bh >> 3, h = bh & 7;
        const float gf = exp2f(log2_gamma(F.decay_logit, 0, h)), gb = exp2f(log2_gamma(F.decay_logit, 1, h));
        float s = 0.f;
        for (int m = 0; m < CTXL; ++m) { const size_t t = (size_t)b * CTXL + m; s = gf * s + bf2f(F.KC[t * 512 + h * 64 + d]) * bf2f(F.VC[t * 1024 + h * 128 + v]); }
        const float sF = s; s = 0.f;
        for (int m = CTXL - 1; m >= 0; --m) { const size_t t = (size_t)b * CTXL + m; s = gb * s + bf2f(F.KC[t * 512 + h * 64 + d]) * bf2f(F.VC[t * 1024 + h * 128 + v]); }
        const float sB = s;
        s = sF;
        for (int n = 0; n < SEQ; ++n) { const size_t t = (size_t)b * SEQ + n; s = gf * s + bf2f(F.K[t * 512 + h * 64 + d]) * bf2f(F.V[t * 1024 + h * 128 + v]);
            const float o = wave_sum(bf2f(F.Q[t * 512 + h * 64 + d]) * s); if (d == 0) F.RET[t * 1024 + h * 128 + v] = o; }
        s = sB;
        for (int n = SEQ - 1; n >= 0; --n) { const size_t t = (size_t)b * SEQ + n; s = gb * s + bf2f(F.K[t * 512 + h * 64 + d]) * bf2f(F.V[t * 1024 + h * 128 + v]);
            const float o = wave_sum(bf2f(F.Q[t * 512 + h * 64 + d]) * s); if (d == 0) F.RET[t * 1024 + h * 128 + v] += o; }
    }
}
DI void n5_groupnorm(const Ctx& F) {
    const Tid T = opaque_tid();
    const int gw = blockIdx.x * 8 + T.wave, NGW = gridDim.x * 8;
    for (int task = gw; task < MTOK * NH; task += NGW) {
        const int t = task >> 3, h = task & 7; const size_t o = (size_t)t * 1024 + h * 128 + 2 * T.lane;
        const float a = F.RET[o], b = F.RET[o + 1];
        const float mu = wave_sum(a + b) * (1.f / 128.f); const float da = a - mu, db = b - mu;
        const float var = wave_sum(da * da + db * db) * (1.f / 128.f); const float rstd = 1.0f / sqrtf(var + EPS);
        const float ra = da * rstd * F.gn_w[h * 128 + 2 * T.lane], rb = db * rstd * F.gn_w[h * 128 + 2 * T.lane + 1];
        *(unsigned*)(F.UB + o) = cvt_pk_bf16(siluf(bf2f(F.SZB[o])) * ra, siluf(bf2f(F.SZB[o + 1])) * rb);
    }
}
DI void p5_ret(const Ctx& F) {
    const Tid T = opaque_tid();
    LAS unsigned char* KI = F.lds; LAS unsigned char* VI = F.lds + 20480; LAS unsigned char* SF = F.lds + 57344; LAS unsigned char* SB = F.lds + 75776;
    LAS unsigned char* S0F = F.lds + 94208; LAS unsigned char* S0B = F.lds + 110592;
    const int tid = T.tid, lane = T.lane, w = T.wave, g = lane >> 4, q = (lane & 15) >> 2, p = lane & 3, l15 = lane & 15;
    const int row = tid >> 2, seg = tid & 3, il = 16 * w + l15;
    for (int base = blockIdx.x * 4; base < 1024; base += gridDim.x * 4) {
        const int bh = base >> 5, h = bh & 7;
        const float l2f = log2_gamma(F.decay_logit, 0, h), l2b = log2_gamma(F.decay_logit, 1, h);
        { const float* s0f = F.S0 + (size_t)(0 * 32 + bh) * 8192 + row * 64 + seg * 16; const float* s0b = F.S0 + (size_t)(1 * 32 + bh) * 8192 + row * 64 + seg * 16;
#pragma unroll
            for (int i = 0; i < 2; ++i) { const f32x4 a0 = *(const f32x4*)(s0f + 8 * i), a1 = *(const f32x4*)(s0f + 8 * i + 4), b0 = *(const f32x4*)(s0b + 8 * i), b1 = *(const f32x4*)(s0b + 8 * i + 4);
                u32x4 x, y; x.x = cvt_pk_bf16(a0.x, a0.y); x.y = cvt_pk_bf16(a0.z, a0.w); x.z = cvt_pk_bf16(a1.x, a1.y); x.w = cvt_pk_bf16(a1.z, a1.w);
                y.x = cvt_pk_bf16(b0.x, b0.y); y.y = cvt_pk_bf16(b0.z, b0.w); y.z = cvt_pk_bf16(b1.x, b1.y); y.w = cvt_pk_bf16(b1.z, b1.w);
                *(LAS u32x4*)(S0F + row * 128 + seg * 32 + 16 * i) = x; *(LAS u32x4*)(S0B + row * 128 + seg * 32 + 16 * i) = y; } }
        u32x4 pk[2], pv[4], pf0[2], pb0[2]; bf16x8 pq[2];
        auto prefetch = [&](int it) { const int c = it & 31; const size_t tok0 = (size_t)(bh >> 3) * SEQ + c * CHK;
            const bf16_t* kp = F.K + tok0 * 512 + h * 64; const bf16_t* vp = F.V + tok0 * 1024 + h * 128; const bf16_t* qp = F.Q + tok0 * 512 + h * 64;
            const bf16_t* stf = F.ST + ((size_t)(0 * 32 + bh) * 32 + c) * 8192; const bf16_t* stb = F.ST + ((size_t)(1 * 32 + bh) * 32 + c) * 8192;
#pragma unroll
            for (int i = 0; i < 2; ++i) { pk[i] = *(const u32x4*)(kp + (size_t)row * 512 + seg * 16 + 8 * i); pf0[i] = *(const u32x4*)(stf + row * 64 + seg * 16 + 8 * i); pb0[i] = *(const u32x4*)(stb + row * 64 + seg * 16 + 8 * i);
                pq[i] = *(const bf16x8*)(qp + (size_t)il * 512 + 32 * i + 8 * g); }
#pragma unroll
            for (int i = 0; i < 4; ++i) pv[i] = *(const u32x4*)(vp + (size_t)row * 1024 + seg * 32 + 8 * i); };
        prefetch(base);
        for (int k = 0; k < 4; ++k) {
            const int it = base + k, c = it & 31; const size_t tok0 = (size_t)(bh >> 3) * SEQ + c * CHK;
            { const float cf = __builtin_amdgcn_exp2f(l2f * 128.f * (float)c), cb = __builtin_amdgcn_exp2f(l2b * 128.f * (float)(31 - c));
#pragma unroll
                for (int i = 0; i < 2; ++i) { *(LAS u32x4*)(KI + row * 160 + seg * 32 + 16 * i) = pk[i];
                    const u32x4 x = *(const LAS u32x4*)(S0F + row * 128 + seg * 32 + 16 * i), y = *(const LAS u32x4*)(S0B + row * 128 + seg * 32 + 16 * i);
                    u32x4 of, ob;
#pragma unroll
                    for (int e = 0; e < 4; ++e) { of[e] = cvt_pk_bf16(bflo(pf0[i][e]) + cf * bflo(x[e]), bfhi(pf0[i][e]) + cf * bfhi(x[e])); ob[e] = cvt_pk_bf16(bflo(pb0[i][e]) + cb * bflo(y[e]), bfhi(pb0[i][e]) + cb * bfhi(y[e])); }
                    *(LAS u32x4*)(SF + row * 144 + seg * 32 + 16 * i) = of; *(LAS u32x4*)(SB + row * 144 + seg * 32 + 16 * i) = ob; }
#pragma unroll
                for (int i = 0; i < 4; ++i) *(LAS u32x4*)(VI + row * 288 + seg * 64 + 16 * i) = pv[i]; }
            bf16x8 qf[2]; qf[0] = pq[0]; qf[1] = pq[1];
            __syncthreads();
            if (k < 3) prefetch(it + 1);
            f32x4 accS[8];
#pragma unroll
            for (int jb = 0; jb < 8; ++jb) { accS[jb] = (f32x4){0.f, 0.f, 0.f, 0.f};
#pragma unroll
                for (int ks = 0; ks < 2; ++ks) { const bf16x8 kf = *(const LAS bf16x8*)(KI + (16 * jb + l15) * 160 + (32 * ks + 8 * g) * 2);
                    accS[jb] = __builtin_amdgcn_mfma_f32_16x16x32_bf16(kf, qf[ks], accS[jb], 0, 0, 0); } }
            bf16x8 pf[4];
#pragma unroll
            for (int s2 = 0; s2 < 4; ++s2) { float pe[8];
#pragma unroll
                for (int e = 0; e < 8; ++e) { const int jb = 2 * s2 + (e >> 2), r = e & 3, j = 16 * jb + 4 * g + r, df = il - j;
                    float mk = __builtin_amdgcn_exp2f((df >= 0 ? l2f : -l2b) * (float)df); if (df == 0) mk = 2.f;
                    pe[e] = accS[jb][r] * mk; }
                u32x4 pw; pw.x = cvt_pk_bf16(pe[0], pe[1]); pw.y = cvt_pk_bf16(pe[2], pe[3]); pw.z = cvt_pk_bf16(pe[4], pe[5]); pw.w = cvt_pk_bf16(pe[6], pe[7]);
                pf[s2] = __builtin_bit_cast(bf16x8, pw); }
            const float decf = __builtin_amdgcn_exp2f(l2f * (float)(il + 1)), decb = __builtin_amdgcn_exp2f(l2b * (float)(128 - il));
            f32x4 accO[8];
#pragma unroll
            for (int vb = 0; vb < 8; ++vb) { f32x4 o = (f32x4){0.f, 0.f, 0.f, 0.f};
#pragma unroll
                for (int s2 = 0; s2 < 4; ++s2) { const bf16x8 vf = tr2(VI + (32 * s2 + 4 * g + q) * 288 + (16 * vb + 4 * p) * 2, 16 * 288);
                    o = __builtin_amdgcn_mfma_f32_16x16x32_bf16(vf, pf[s2], o, 0, 0, 0); }
                f32x4 tf = (f32x4){0.f, 0.f, 0.f, 0.f}, tb = (f32x4){0.f, 0.f, 0.f, 0.f};
#pragma unroll
                for (int ks = 0; ks < 2; ++ks) { const bf16x8 sf = *(const LAS bf16x8*)(SF + (16 * vb + l15) * 144 + (32 * ks + 8 * g) * 2);
                    const bf16x8 sb = *(const LAS bf16x8*)(SB + (16 * vb + l15) * 144 + (32 * ks + 8 * g) * 2);
                    tf = __builtin_amdgcn_mfma_f32_16x16x32_bf16(sf, qf[ks], tf, 0, 0, 0); tb = __builtin_amdgcn_mfma_f32_16x16x32_bf16(sb, qf[ks], tb, 0, 0, 0); }
                accO[vb] = o + tf * decf + tb * decb; __builtin_amdgcn_sched_barrier(0); }
            float sm = 0.f;
#pragma unroll
            for (int vb = 0; vb < 8; ++vb) sm += (accO[vb].x + accO[vb].y) + (accO[vb].z + accO[vb].w);
            sm += __shfl_xor(sm, 16); sm += __shfl_xor(sm, 32);
            const float mu = sm * (1.f / 128.f); float sq = 0.f;
#pragma unroll
            for (int vb = 0; vb < 8; ++vb) { accO[vb] = accO[vb] - mu; sq += (accO[vb].x * accO[vb].x + accO[vb].y * accO[vb].y) + (accO[vb].z * accO[vb].z + accO[vb].w * accO[vb].w); }
            sq += __shfl_xor(sq, 16); sq += __shfl_xor(sq, 32);
            const float rstd = 1.0f / sqrtf(sq * (1.f / 128.f) + EPS);
            __syncthreads();
#pragma unroll
            for (int vb = 0; vb < 8; ++vb) { const f32x4 gw = *(const f32x4*)(F.gn_w + h * 128 + 16 * vb + 4 * g); const f32x4 o = accO[vb] * rstd * gw;
                u32x2 ow; ow.x = cvt_pk_bf16(o.x, o.y); ow.y = cvt_pk_bf16(o.z, o.w);
                *(LAS u32x2*)(VI + il * 288 + (16 * vb + 4 * g) * 2) = ow; }
            __syncthreads();
            { const size_t go = (tok0 + row) * 1024 + h * 128 + seg * 32;
#pragma unroll
                for (int i = 0; i < 4; ++i) { const u32x4 o = *(const LAS u32x4*)(VI + row * 288 + seg * 64 + 16 * i); const u32x4 z = *(const u32x4*)(F.SZB + go + 8 * i);
                    u32x4 r;
#pragma unroll
                    for (int e = 0; e < 4; ++e) r[e] = cvt_pk_bf16(bflo(o[e]) * siluf(bflo(z[e])), bfhi(o[e]) * siluf(bfhi(z[e])));
                    *(u32x4*)(F.UB + go + 8 * i) = r; } }
            __syncthreads();
        }
    }
}
struct SchedSq { int G, c; DI bool next(int i, pg8::Unit& u) const { const int L = i * G + c; if (L >= 256) return false; pg8::tile_of(L, 64, 4, u); return true; } };
struct EpiAB {
    const bf16_t* R; const bf16_t* SGB; bf16_t* MM;
    DI int vm_ops(const pg8::Unit&) const { return 0; }
    DI void mid(f32x4 (&acc)[2][2][4][2], const pg8::Unit& u, int wr, int wc, int fr, int fq) const { apply<false>(acc, u, wr, wc, fr, fq); }
    DI void operator()(const f32x4 (&acc)[2][2][4][2], const pg8::Unit& u, int wr, int wc, int fr, int fq) const { apply<true>(const_cast<f32x4 (&)[2][2][4][2]>(acc), u, wr, wc, fr, fq); }
    template <bool FIN> DI void apply(f32x4 (&acc)[2][2][4][2], const pg8::Unit& u, int wr, int wc, int fr, int fq) const {
        const bf16_t* src = FIN ? SGB : R;
        const size_t base = (size_t)(u.pm * 256 + wr * 64 + fr) * 1024 + u.pn * 256 + wc * 32 + 8 * fq;
#pragma unroll
        for (int am = 0; am < 4; ++am) { const int ai = am >> 1;
            u32x4 gv[4][2];
#pragma unroll
            for (int m = 2 * (am & 1); m < 2 * (am & 1) + 2; ++m)
#pragma unroll
                for (int bj = 0; bj < 2; ++bj) gv[m][bj] = *(const u32x4*)(src + base + (size_t)(ai * 128 + m * 16) * 1024 + bj * 128);
#pragma unroll
            for (int m = 2 * (am & 1); m < 2 * (am & 1) + 2; ++m)
#pragma unroll
                for (int bj = 0; bj < 2; ++bj) { const u32x4 gq = gv[m][bj];
                    f32x4 a = acc[ai][bj][m][0], b = acc[ai][bj][m][1];
                    a.x *= bflo(gq.x); a.y *= bfhi(gq.x); a.z *= bflo(gq.y); a.w *= bfhi(gq.y); b.x *= bflo(gq.z); b.y *= bfhi(gq.z); b.z *= bflo(gq.w); b.w *= bfhi(gq.w);
                    if (FIN) { u32x4 w; w.x = cvt_pk_bf16(a.x, a.y); w.y = cvt_pk_bf16(a.z, a.w); w.z = cvt_pk_bf16(b.x, b.y); w.w = cvt_pk_bf16(b.z, b.w);
                        *(u32x4*)(MM + base + (size_t)(ai * 128 + m * 16) * 1024 + bj * 128) = w; }
                    else { acc[ai][bj][m][0] = a; acc[ai][bj][m][1] = b; } }
            asm volatile("" ::: "memory");
        }
    }
};
struct EpiOut {
    const float* x; const float* MOD; float* out;
    DI int vm_ops(const pg8::Unit&) const { return 0; }
    DI void mid(f32x4 (&)[2][2][4][2], const pg8::Unit&, int, int, int, int) const {}
    DI void operator()(const f32x4 (&acc)[2][2][4][2], const pg8::Unit& u, int wr, int wc, int fr, int fq) const {
        const int col0 = u.pn * 256 + wc * 32 + 8 * fq; const float* gp = MOD + (u.pm >> 4) * 3072 + 2048 + col0;
        f32x4 gx[2][2];
#pragma unroll
        for (int bj = 0; bj < 2; ++bj)
#pragma unroll
            for (int n = 0; n < 2; ++n) gx[bj][n] = *(const f32x4*)(gp + bj * 128 + 4 * n);
#pragma unroll
        for (int ai = 0; ai < 2; ++ai)
#pragma unroll
            for (int m = 0; m < 4; ++m) { const size_t off = (size_t)(u.pm * 256 + ai * 128 + wr * 64 + m * 16 + fr) * 1024 + col0;
#pragma unroll
                for (int bj = 0; bj < 2; ++bj)
#pragma unroll
                    for (int n = 0; n < 2; ++n) { const f32x4 xv = *(const f32x4*)(x + off + bj * 128 + 4 * n); *(f32x4*)(out + off + bj * 128 + 4 * n) = xv + gx[bj][n] * acc[ai][bj][m][n]; }
                if (m & 1) asm volatile("" ::: "memory"); }
    }
};
struct EpiOutNorm {
    const float* x; const float* MOD; float* out; const float* fw; float* slots; unsigned* cnt; LAS float* tab;
    DI int vm_ops(const pg8::Unit&) const { return 0; }
    DI void mid(f32x4 (&)[2][2][4][2], const pg8::Unit&, int, int, int, int) const {}
    DI void operator()(const f32x4 (&acc_)[2][2][4][2], const pg8::Unit& u, int wr, int wc, int fr, int fq) const {
        f32x4 (&acc)[2][2][4][2] = const_cast<f32x4 (&)[2][2][4][2]>(acc_);
        const int col0 = u.pn * 256 + wc * 32 + 8 * fq; const float* gp = MOD + (u.pm >> 4) * 3072 + 2048 + col0;
        f32x4 gx[2][2];
#pragma unroll
        for (int bj = 0; bj < 2; ++bj)
#pragma unroll
            for (int n = 0; n < 2; ++n) gx[bj][n] = *(const f32x4*)(gp + bj * 128 + 4 * n);
#pragma unroll
        for (int ai = 0; ai < 2; ++ai)
#pragma unroll
            for (int m = 0; m < 4; ++m) { const int row = u.pm * 256 + ai * 128 + wr * 64 + m * 16 + fr; const size_t off = (size_t)row * 1024 + col0; float ss = 0.f;
#pragma unroll
                for (int bj = 0; bj < 2; ++bj)
#pragma unroll
                    for (int n = 0; n < 2; ++n) { const f32x4 xv = *(const f32x4*)(x + off + bj * 128 + 4 * n); const f32x4 v = xv + gx[bj][n] * acc[ai][bj][m][n]; acc[ai][bj][m][n] = v;
                        ss += (v.x * v.x + v.y * v.y) + (v.z * v.z + v.w * v.w); }
                ss += __shfl_xor(ss, 16); ss += __shfl_xor(ss, 32);
                if (fq == 0) __hip_atomic_store(slots + (size_t)row * 16 + u.pn * 4 + wc, ss, __ATOMIC_RELAXED, __HIP_MEMORY_SCOPE_AGENT);
                if (m & 1) asm volatile("" ::: "memory"); }
        asm volatile("s_waitcnt vmcnt(0)" ::: "memory");
        __syncthreads();
        if (threadIdx.x == 0) {
            unsigned* c = cnt + 64 * u.pm;
            __hip_atomic_fetch_add(c, 1u, __ATOMIC_RELAXED, __HIP_MEMORY_SCOPE_AGENT);
            unsigned sp = 0;
            while (__hip_atomic_load(c, __ATOMIC_RELAXED, __HIP_MEMORY_SCOPE_AGENT) < 4u) { __builtin_amdgcn_s_sleep(1); if (++sp > (1u << 22)) break; }
            __builtin_amdgcn_fence(__ATOMIC_ACQUIRE, "agent");
            asm volatile("s_waitcnt vmcnt(0)" ::: "memory");
        }
        __syncthreads();
        { const int t = threadIdx.x, row = t >> 1, half = t & 1; const float* sp = slots + (size_t)(u.pm * 256 + row) * 16 + half * 8; float s = 0.f;
#pragma unroll
            for (int j = 0; j < 8; ++j) s += __hip_atomic_load(sp + j, __ATOMIC_RELAXED, __HIP_MEMORY_SCOPE_AGENT);
            s += __shfl_xor(s, 1);
            if (half == 0) tab[row] = 1.0f / sqrtf(s * (1.f / 1024.f) + EPS); }
        __syncthreads();
        f32x4 fv[2][2];
#pragma unroll
        for (int bj = 0; bj < 2; ++bj)
#pragma unroll
            for (int n = 0; n < 2; ++n) fv[bj][n] = *(const f32x4*)(fw + col0 + bj * 128 + 4 * n);
#pragma unroll
        for (int ai = 0; ai < 2; ++ai)
#pragma unroll
            for (int m = 0; m < 4; ++m) { const int rl = ai * 128 + wr * 64 + m * 16 + fr; const float r = tab[rl]; const size_t off = (size_t)(u.pm * 256 + rl) * 1024 + col0;
#pragma unroll
                for (int bj = 0; bj < 2; ++bj)
#pragma unroll
                    for (int n = 0; n < 2; ++n) *(f32x4*)(out + off + bj * 128 + 4 * n) = acc[ai][bj][m][n] * r * fv[bj][n]; }
    }
};
DI void n6_ab(const Ctx& F) {
    const Tid T = opaque_tid();
    const size_t NT = (size_t)gridDim.x * 512, gt = (size_t)blockIdx.x * 512 + T.tid;
    for (size_t idx = gt; idx < (size_t)(MTOK / 4) * 1024; idx += NT) {
        const int n = (int)(idx & 1023), t0 = (int)(idx >> 10) * 4; float ya[4] = {0.f, 0.f, 0.f, 0.f}, yb[4] = {0.f, 0.f, 0.f, 0.f};
        for (int k = 0; k < 1024; ++k) { const float wa = F.w_a[(size_t)k * 1024 + n], wb = F.w_b[(size_t)k * 1024 + n];
#pragma unroll
            for (int j = 0; j < 4; ++j) { ya[j] += bf2f(F.P[(size_t)(t0 + j) * 1024 + k]) * wa; yb[j] += bf2f(F.UB[(size_t)(t0 + j) * 1024 + k]) * wb; } }
#pragma unroll
        for (int j = 0; j < 4; ++j) { const size_t o = (size_t)(t0 + j) * 1024 + n; const float sgb = bf2f(F.SGB[o]), sga = bf2f(F.R[o]) * sgb; F.MM[o] = f2bf(sga * ya[j] + sgb * yb[j]); }
    }
}
DI void n7_out(const Ctx& F) {
    const Tid T = opaque_tid();
    const size_t NT = (size_t)gridDim.x * 512, gt = (size_t)blockIdx.x * 512 + T.tid;
    for (size_t idx = gt; idx < (size_t)(MTOK / 4) * 1024; idx += NT) {
        const int n = (int)(idx & 1023), t0 = (int)(idx >> 10) * 4; float y[4] = {0.f, 0.f, 0.f, 0.f};
        for (int k = 0; k < 1024; ++k) { const float w = F.w_out[(size_t)k * 1024 + n];
#pragma unroll
            for (int j = 0; j < 4; ++j) y[j] += bf2f(F.MM[(size_t)(t0 + j) * 1024 + k]) * w; }
#pragma unroll
        for (int j = 0; j < 4; ++j) { const size_t o = (size_t)(t0 + j) * 1024 + n; F.out[o] = F.x[o] + F.MOD[((t0 + j) >> 12) * 3072 + 2048 + n] * y[j]; }
    }
}
DI void p8_final(const Ctx& F) {
    const Tid T = opaque_tid();
    const int gw = blockIdx.x * 8 + T.wave, NGW = gridDim.x * 8;
    for (int m = gw; m < MTOK; m += NGW) {
        f32x4* xr = (f32x4*)(F.out + (size_t)m * DM);
        f32x4 v[4]; float ss = 0.f;
#pragma unroll
        for (int j = 0; j < 4; ++j) { v[j] = xr[T.lane + 64 * j]; ss += (v[j].x * v[j].x + v[j].y * v[j].y) + (v[j].z * v[j].z + v[j].w * v[j].w); }
        const float rstd = 1.0f / sqrtf(wave_sum(ss) * (1.f / DM) + EPS);
#pragma unroll
        for (int j = 0; j < 4; ++j) { const f32x4 w = *(const f32x4*)(F.final_w + 4 * (T.lane + 64 * j)); xr[T.lane + 64 * j] = v[j] * rstd * w; }
    }
}

constexpr int NPH = 9;
__global__ void __launch_bounds__(512, 2) fwd_kernel(Args args) {
    extern __shared__ __attribute__((aligned(16))) unsigned char lds_raw[];
    Ctx F;
    F.lds = (LAS unsigned char*)lds_raw;
    if (threadIdx.x < 16) ((LAS unsigned*)(F.lds + LDS_MISC))[threadIdx.x] = 0u;
    __syncthreads();
    const XcdBarrier bar = xcd_barrier_post((unsigned*)(args.ws + WS_BAR), (volatile LAS unsigned*)(F.lds + LDS_MISC));
    F.x = args.in[0]; F.c = args.in[1]; F.ctx = args.in[2]; F.c_ctx = args.in[3]; F.norm_w = args.in[4]; F.ada_w = args.in[5]; F.ada_b = args.in[6]; F.w_in = args.in[7];
    F.conv_w = args.in[8]; F.conv_b = args.in[9]; F.decay_logit = args.in[10]; F.gn_w = args.in[11]; F.w_a = args.in[12]; F.w_b = args.in[13]; F.w_out = args.in[14]; F.final_w = args.in[15];
    F.out = args.out; unsigned char* ws = args.ws; F.ws = ws;
    F.MOD = (float*)(ws + WS_MOD); F.ROPE = (f32x2*)(ws + WS_ROPE);
    F.WA = (bf16_t*)(ws + WS_WA); F.WB = (bf16_t*)(ws + WS_WB); F.WOUT = (bf16_t*)(ws + WS_WOUT); F.WIN = (bf16_t*)(ws + WS_WIN); F.XM = (bf16_t*)(ws + WS_XM);
    F.KV = (bf16_t*)(ws + WS_KV); F.KVC = (bf16_t*)(ws + WS_KVC); F.HC = (bf16_t*)(ws + WS_HC); F.ST = (bf16_t*)(ws + WS_ST); F.MM = (bf16_t*)(ws + WS_MM);
    F.P = (bf16_t*)(ws + WS_P); F.Q = (bf16_t*)(ws + WS_Q); F.K = (bf16_t*)(ws + WS_K); F.V = (bf16_t*)(ws + WS_V); F.SZB = (bf16_t*)(ws + WS_SZB);
    F.KC = (bf16_t*)(ws + WS_KC); F.VC = (bf16_t*)(ws + WS_VC); F.UB = (bf16_t*)(ws + WS_UB);
    F.R = (bf16_t*)args.out; F.SGB = (bf16_t*)args.out + (size_t)MTOK * DM;
    F.RET = (float*)(ws + WS_RET); F.S0 = (float*)(ws + WS_KVC);
    const int lo = args.ph_lo, hi = args.ph_hi; const unsigned naive = args.naive;
#define IN(k) (lo <= (k) && (k) < hi && ((MK_PHASES >> (k)) & 1))
#define NAIVE(k) (((naive & MK_NAIVE_AVAIL) >> (k)) & 1u)
#define SEAM(k) do { if (IN(k) && IN((k) + 1)) xcd_barrier(bar); } while (0)
#define REP(k) for (int rep_ = 0; rep_ < 1 + (int)((MK_REP_MASK >> (k)) & 1u); ++rep_)
    if (IN(0)) REP(0) { p0_prologue(F); } SEAM(0);
    if (IN(1)) REP(1) { p1_rows(F); } SEAM(1);
    if (IN(2)) REP(2) {
        if (NAIVE(2)) n2_inproj(F);
        else { const char* const Ab[2] = {(const char*)F.XM, (const char*)F.XM}; const char* const Bb[2] = {(const char*)F.WIN, (const char*)F.WIN};
            Sched1 S{(int)gridDim.x, (int)blockIdx.x}; Epi1 E{F.ws, F.R, F.SGB, F.ROPE};
            pg8::gemm_phase<1, Epi1, Sched1>(F.lds, Ab, Bb, S, E); }
    } SEAM(2);
    if (IN(3)) {
        if (!NAIVE(3)) {
            const char* const Ab[2] = {(const char*)F.XM, (const char*)F.XM}; const char* const Bb[2] = {(const char*)F.WIN, (const char*)F.WIN};
            SchedCtx S{(int)blockIdx.x}; Epi1 E{F.ws, F.R, F.SGB, F.ROPE};
            pg8::gemm_phase<1, Epi1, SchedCtx>(F.lds, Ab, Bb, S, E);
            if (blockIdx.x >= 24) { REP(3) p3_kv(F, blockIdx.x - 24, 1024, gridDim.x - 24); p3_ua(F, blockIdx.x - 24, gridDim.x - 24); }
        } else p3_ua(F, blockIdx.x, gridDim.x);
    } SEAM(3);
    if (IN(4)) REP(4) { if (NAIVE(4)) n4_recurrence(F); else { if (blockIdx.x >= gridDim.x - 32) p4_ctx_state(F, blockIdx.x - (gridDim.x - 32)); p4_scan(F); } } SEAM(4);
    if (IN(5)) REP(5) { if (NAIVE(5)) n5_groupnorm(F); else p5_ret(F); } SEAM(5);
    if (IN(6)) REP(6) {
        if (NAIVE(6)) n6_ab(F);
        else { const char* const Ab[2] = {(const char*)F.P, (const char*)F.UB}; const char* const Bb[2] = {(const char*)F.WA, (const char*)F.WB};
            SchedSq S{(int)gridDim.x, (int)blockIdx.x}; EpiAB E{F.R, F.SGB, F.MM};
            pg8::gemm_phase<2, EpiAB, SchedSq>(F.lds, Ab, Bb, S, E); }
    } SEAM(6);
    if (IN(7)) {
        const char* const Ab[2] = {(const char*)F.MM, (const char*)F.MM}; const char* const Bb[2] = {(const char*)F.WOUT, (const char*)F.WOUT};
        SchedSq S{(int)gridDim.x, (int)blockIdx.x};
        if (NAIVE(7)) n7_out(F);
        else if (gridDim.x == 256) {
            EpiOutNorm E{F.x, F.MOD, F.out, F.final_w, (float*)(F.ws + WS_SLOTS), (unsigned*)(F.ws + WS_PCNT), (LAS float*)(F.lds + LDS_TAB)};
            pg8::gemm_phase<1, EpiOutNorm, SchedSq>(F.lds, Ab, Bb, S, E); }
        else { EpiOut E{F.x, F.MOD, F.out}; pg8::gemm_phase<1, EpiOut, SchedSq>(F.lds, Ab, Bb, S, E); }
    }
    if (NAIVE(7) || gridDim.x != 256) { SEAM(7); if (IN(8)) { p8_final(F); } }
#undef IN
#undef NAIVE
#undef SEAM
}

extern "C" void kernel_launch(void* const* d_in, const int* in_sizes, int n_in, void* d_out, int out_size, void* d_ws, size_t ws_size, hipStream_t stream) {
    static int grid = 0;
    if (grid == 0) {
        if (n_in != 16 || out_size != MTOK * DM || ws_size < WS_END) { fprintf(stderr, "kernel_launch: unexpected shapes (n_in %d out %d ws %zu)\n", n_in, out_size, ws_size); grid = -1; return; }
        int dev = 0, cus = 0, per_cu = 0;
        hipGetDevice(&dev); hipDeviceGetAttribute(&cus, hipDeviceAttributeMultiprocessorCount, dev);
        hipFuncSetAttribute((const void*)fwd_kernel, hipFuncAttributeMaxDynamicSharedMemorySize, LDS_BYTES);
        hipOccupancyMaxActiveBlocksPerMultiprocessor(&per_cu, (const void*)fwd_kernel, 512, LDS_BYTES);
        if (per_cu < 1) { fprintf(stderr, "kernel_launch: occupancy query says %d blocks/CU\n", per_cu); per_cu = 1; }
        grid = cus;
        (void)hipGetLastError();
    }
    if (grid < 0) return;
    Args a{};
    for (int i = 0; i < 16; ++i) a.in[i] = (const float*)d_in[i];
    a.out = (float*)d_out; a.ws = (unsigned char*)d_ws; a.naive = MK_NAIVE_MASK;
    hipMemsetAsync((unsigned char*)d_ws + WS_BAR, 0, WS_BAR_BYTES, stream);
#if MK_LAUNCH_PER_PHASE
    for (int ph = 0; ph < NPH; ++ph) { a.ph_lo = ph; a.ph_hi = ph + 1; hipLaunchKernelGGL(fwd_kernel, dim3(grid), dim3(512), LDS_BYTES, stream, a); }
#else
    a.ph_lo = 0; a.ph_hi = NPH;
    hipLaunchKernelGGL(fwd_kernel, dim3(grid), dim3(512), LDS_BYTES, stream, a);
#endif
}
```

```cpp
#include <hip/hip_runtime.h>
#include <cstdio>
#include <cstdint>

#ifndef MK_LAUNCH_PER_PHASE
#define MK_LAUNCH_PER_PHASE 0
#endif
#ifndef MK_NAIVE_MASK
#define MK_NAIVE_MASK 0x00u
#endif

#ifndef MK_REP_MASK
#define MK_REP_MASK 0u
#endif
#ifndef MK_PHASES
#define MK_PHASES 0x1ff
#endif
#ifndef MK_NAIVE_AVAIL
#define MK_NAIVE_AVAIL 0xffu
#endif
#define DI __device__ __forceinline__
#define LAS __attribute__((address_space(3)))
typedef unsigned short bf16_t;
typedef float f32x4 __attribute__((ext_vector_type(4)));
typedef float f32x2 __attribute__((ext_vector_type(2)));
typedef unsigned u32x4 __attribute__((ext_vector_type(4)));
typedef unsigned u32x2 __attribute__((ext_vector_type(2)));
typedef short bf16x8 __attribute__((ext_vector_type(8)));
typedef short s16x4 __attribute__((ext_vector_type(4)));
typedef short v4i16_t __attribute__((ext_vector_type(4)));

constexpr int NB = 4, SEQ = 4096, DM = 1024, MTOK = NB * SEQ, CTXL = 256, MCTX = NB * CTXL, MALL = MTOK + MCTX;
constexpr int NIN = 9216, NH = 8, DK = 64, DV = 128, CHK = 128, NCHK = SEQ / CHK;
constexpr float EPS = 1e-6f;
constexpr size_t MiB = 1u << 20;
constexpr size_t WS_MOD = 0;
constexpr size_t WS_ROPE = 65536;
constexpr size_t WS_WA = 2 * MiB, WS_WB = 4 * MiB, WS_WOUT = 6 * MiB, WS_WIN = 8 * MiB;
constexpr size_t WS_XM = 26 * MiB;
constexpr size_t WS_KV = 223 * MiB;
constexpr size_t WS_KVC = 40 * MiB;
constexpr size_t WS_RET = 8 * MiB;
constexpr size_t WS_HC = 60 * MiB;
constexpr size_t WS_ST = 60 * MiB;
constexpr size_t WS_MM = 60 * MiB;
constexpr size_t WS_P = 92 * MiB;
constexpr size_t WS_Q = 124 * MiB, WS_K = 140 * MiB, WS_V = 156 * MiB, WS_SZB = 188 * MiB;
constexpr size_t WS_KC = 220 * MiB, WS_VC = 221 * MiB;
constexpr size_t WS_UB = 223 * MiB;
constexpr size_t WS_END = 255 * MiB;
constexpr int LDS_BYTES = 147456;
constexpr int LDS_MISC = 139264;
constexpr size_t WS_BAR = 131072, WS_BAR_BYTES = 65536;
constexpr size_t WS_PCNT = WS_BAR + 16384, WS_SLOTS = 1 * MiB;
constexpr int LDS_TAB = 132096;

DI float bf2f(bf16_t v) { return __uint_as_float((unsigned)v << 16); }
DI float bflo(unsigned w) { return __uint_as_float(w << 16); }
DI float bfhi(unsigned w) { return __uint_as_float(w & 0xffff0000u); }
typedef __bf16 bf16x2_t __attribute__((ext_vector_type(2)));
DI unsigned cvt_pk_bf16(float lo, float hi) { const f32x2 f = {lo, hi}; const bf16x2_t v = __builtin_convertvector(f, bf16x2_t); return __builtin_bit_cast(unsigned, v); }
DI bf16_t f2bf(float f) { return (bf16_t)(cvt_pk_bf16(f, 0.f) & 0xffffu); }
DI float wave_sum(float v) {
#pragma unroll
    for (int o = 1; o < 64; o <<= 1) v += __shfl_xor(v, o);
    return v;
}
struct Tid { int tid, lane, wave; };
DI Tid opaque_tid() { int t = threadIdx.x; asm volatile("" : "+v"(t)); Tid r; r.tid = t; r.lane = t & 63; r.wave = __builtin_amdgcn_readfirstlane(t >> 6); return r; }
DI float siluf(float x) { return x * __builtin_amdgcn_rcpf(1.f + __expf(-x)); }
DI float log2_gamma(const float* decay_logit, int dir, int h) {
    const float x = decay_logit[dir * NH + h];
    const float ls = fminf(x, 0.f) - log1pf(expf(-fabsf(x)));
    return ls * 1.4426950408889634f;
}

namespace pg8 {
constexpr int BM = 256, BK = 64, HALF = 128, HTB = HALF * BK * 2, STAGE_BYTES = 8 * HTB, NXCD = 8, WGM = 8;
DI int lds_byte(int r, int c) { const int st = (r >> 4) * 2 + (c >> 5), rr = r & 15, cc = c & 31, ob = rr * 64 + cc * 2; return st * 1024 + (ob ^ (((ob >> 9) & 1) << 5)); }
DI void stage_rc(int b, int& R, int& C) { const int st = b / 1024, sb = b % 1024, swz = sb ^ (((sb >> 9) & 1) << 5); R = (st >> 1) * 16 + swz / 64; C = (st & 1) * 32 + (swz % 64) / 2; }
DI int perm32(int rho) { const int n = rho >> 4, i = rho & 15; return 8 * (i >> 2) + 4 * n + (i & 3); }
struct Unit { int pm, pn; };
DI void tile_of(int L, int nM, int nN, Unit& u) {
    const int nwg = nM * nN; int wgid = L;
    { const int q = nwg / NXCD, r = nwg % NXCD, xcd = wgid % NXCD, off = wgid / NXCD; wgid = (xcd < r ? xcd * (q + 1) : r * (q + 1) + (xcd - r) * q) + off; }
    const int nig = WGM * nN, gid = wgid / nig, fm = gid * WGM, gsz = (nM - fm) < WGM ? (nM - fm) : WGM;
    u.pm = fm + ((wgid % nig) % gsz); u.pn = (wgid % nig) / gsz;
}
template <int NSEG, class Epi, class Sched>
DI void gemm_phase(LAS unsigned char* lds, const char* const (&Ab)[2], const char* const (&Bb)[2], const Sched& S, const Epi& E) {
    constexpr int K = 1024, NTS = K / BK;
    constexpr int nt = NSEG * NTS;
    const Tid T = opaque_tid();
    const int tid = T.tid, wid = T.wave, lane = T.lane, wr = wid >> 2, wc = (wid & 3) ^ (wr << 1), fr = lane & 15, fq = lane >> 4;
    unsigned voffA[2], voffB[2];
#pragma unroll
    for (int i = 0; i < 2; ++i) { int R, C; stage_rc(tid * 16 + i * 8192, R, C); const int Rb = (R & ~31) + perm32(R & 31);
        voffA[i] = (unsigned)(R * K + C) * 2u; voffB[i] = (unsigned)(Rb * K + C) * 2u; }
    constexpr size_t kstep = (size_t)(BK * 2);
    constexpr size_t hstep = (size_t)HALF * K * 2;
    constexpr size_t tstep = 2 * hstep;
    const unsigned ldsw = (unsigned)wid * 1024u;
    const int aoff = lds_byte(wr * 64 + fr, fq * 8), boff = lds_byte(wc * 32 + fr, fq * 8);
#define PG8_SA(b, h) (((b) * 2 + (h)) * HTB)
#define PG8_SB(b, h) ((4 + (b) * 2 + (h)) * HTB)
#define PG8_STAGE(bufoff, gbase, voff) do { _Pragma("unroll") for (int _i = 0; _i < 2; ++_i) \
        __builtin_amdgcn_global_load_lds((const unsigned*)((const char*)(gbase) + (voff)[_i]), (LAS unsigned*)(lds + (bufoff) + ldsw + _i * 8192), 16, 0, 0); } while (0)
#define PG8_LDA(dst, b, h) do { _Pragma("unroll") for (int m = 0; m < 4; ++m) _Pragma("unroll") for (int k = 0; k < 2; ++k) dst[m][k] = *(const LAS bf16x8*)(lds + PG8_SA(b, h) + aoff + m * 2048 + k * 1024); } while (0)
#define PG8_LDB(dst, b, h) do { _Pragma("unroll") for (int n = 0; n < 2; ++n) _Pragma("unroll") for (int k = 0; k < 2; ++k) dst[n][k] = *(const LAS bf16x8*)(lds + PG8_SB(b, h) + boff + n * 2048 + k * 1024); } while (0)
#define PG8_MMA(ai, bj, At, Bt) do { __builtin_amdgcn_s_setprio(1); _Pragma("unroll") for (int m = 0; m < 4; ++m) _Pragma("unroll") for (int n = 0; n < 2; ++n) _Pragma("unroll") for (int k = 0; k < 2; ++k) \
        acc[ai][bj][m][n] = __builtin_amdgcn_mfma_f32_16x16x32_bf16(Bt[n][k], At[m][k], acc[ai][bj][m][n], 0, 0, 0); __builtin_amdgcn_s_setprio(0); } while (0)
#define PG8_WAIT_V(n) asm volatile("s_waitcnt vmcnt(" #n ")" ::: "memory")
#define PG8_WAIT_L(n) asm volatile("s_waitcnt lgkmcnt(" #n ")" ::: "memory")
#define PG8_WAIT_VR(sel) asm volatile("s_cmp_lt_i32 %0, 8\n\ts_cbranch_scc1 .Lw8_%=\n\ts_cmp_lt_i32 %0, 16\n\ts_cbranch_scc1 .Lw16_%=\n\ts_waitcnt vmcnt(24)\n\ts_branch .Lwe_%=\n.Lw16_%=:\n\ts_waitcnt vmcnt(16)\n\ts_branch .Lwe_%=\n.Lw8_%=:\n\ts_waitcnt vmcnt(8)\n.Lwe_%=:" :: "s"(sel) : "memory", "scc")
#define PG8_BAR __builtin_amdgcn_s_barrier()
#define PG8_SCHED __builtin_amdgcn_sched_barrier(0)
#define PG8_TA(u, t) (Ab[(t) / NTS] + (size_t)(u).pm * tstep + (size_t)((t) % NTS) * kstep)
#define PG8_TB(u, t) (Bb[(t) / NTS] + (size_t)(u).pn * tstep + (size_t)((t) % NTS) * kstep)
    Unit cur, nxt; int ui = 0;
    if (!S.next(0, cur)) return;
    f32x4 acc[2][2][4][2];
#pragma unroll
    for (int a = 0; a < 2; ++a)
#pragma unroll
        for (int b = 0; b < 2; ++b)
#pragma unroll
            for (int m = 0; m < 4; ++m)
#pragma unroll
                for (int n = 0; n < 2; ++n) acc[a][b][m][n] = (f32x4){0.f, 0.f, 0.f, 0.f};
    bf16x8 At[4][2], B0[2][2], B1[2][2];
    {
        const char* cA = PG8_TA(cur, 0); const char* cB = PG8_TB(cur, 0);
        PG8_STAGE(PG8_SB(0, 0), cB, voffB); PG8_STAGE(PG8_SB(0, 1), cB + hstep, voffB); PG8_STAGE(PG8_SA(0, 0), cA, voffA); PG8_STAGE(PG8_SA(0, 1), cA + hstep, voffA);
        if (wr == 1) PG8_BAR;
        PG8_WAIT_V(2); PG8_BAR;
        PG8_STAGE(PG8_SB(1, 0), cB + kstep, voffB); PG8_STAGE(PG8_SA(1, 0), cA + kstep, voffA); PG8_STAGE(PG8_SB(1, 1), cB + hstep + kstep, voffB);
        PG8_WAIT_V(6); PG8_BAR;
    }
    for (;;) {
        const bool has_next = S.next(ui + 1, nxt);
        const Unit nu = has_next ? nxt : cur;
        for (int t = 0; t < nt; t += 2) {
            if (NSEG == 2 && t == NTS) E.mid(acc, cur, wr, wc, fr, fq);
            const bool last = (t == nt - 2);
            const char* a1 = PG8_TA(cur, t + 1);
            const char* a2 = last ? PG8_TA(nu, 0) : PG8_TA(cur, t + 2); const char* b2 = last ? PG8_TB(nu, 0) : PG8_TB(cur, t + 2);
            const char* a3 = a2 + kstep; const char* b3 = b2 + kstep;
            PG8_LDB(B0, 0, 0); PG8_LDB(B1, 0, 1); PG8_SCHED; PG8_LDA(At, 0, 0); PG8_STAGE(PG8_SA(1, 1), a1 + hstep, voffA);
            PG8_WAIT_V(8); PG8_WAIT_L(0); PG8_BAR; PG8_MMA(0, 0, At, B0); PG8_MMA(0, 1, At, B1); PG8_BAR; PG8_SCHED;
            PG8_LDA(At, 0, 1); PG8_STAGE(PG8_SB(0, 0), b2, voffB); PG8_STAGE(PG8_SB(0, 1), b2 + hstep, voffB); PG8_STAGE(PG8_SA(0, 0), a2, voffA);
            PG8_WAIT_V(8); PG8_WAIT_L(0); PG8_BAR; PG8_MMA(1, 0, At, B0); PG8_MMA(1, 1, At, B1); PG8_BAR; PG8_SCHED;
            PG8_LDB(B0, 1, 0); PG8_LDB(B1, 1, 1); PG8_SCHED; PG8_LDA(At, 1, 0); PG8_STAGE(PG8_SA(0, 1), a2 + hstep, voffA);
            PG8_WAIT_V(8); PG8_WAIT_L(0); PG8_BAR; PG8_MMA(0, 0, At, B0); PG8_MMA(0, 1, At, B1); PG8_BAR; PG8_SCHED;
            PG8_LDA(At, 1, 1); PG8_STAGE(PG8_SB(1, 0), b3, voffB); PG8_STAGE(PG8_SB(1, 1), b3 + hstep, voffB); PG8_STAGE(PG8_SA(1, 0), a3, voffA);
            PG8_WAIT_V(8); PG8_WAIT_L(0); PG8_BAR; PG8_MMA(1, 0, At, B0); PG8_MMA(1, 1, At, B1); PG8_BAR; PG8_SCHED;
        }
        if (wr == 0) PG8_BAR;
        E(acc, cur, wr, wc, fr, fq);
        if (!has_next) break;
#pragma unroll
        for (int a = 0; a < 2; ++a)
#pragma unroll
            for (int b = 0; b < 2; ++b)
#pragma unroll
                for (int m = 0; m < 4; ++m)
#pragma unroll
                    for (int n = 0; n < 2; ++n) acc[a][b][m][n] = (f32x4){0.f, 0.f, 0.f, 0.f};
        cur = nxt; ++ui;
        if (wr == 1) PG8_BAR;
    }
    PG8_WAIT_V(0);
    PG8_BAR;
#undef PG8_SA
#undef PG8_SB
#undef PG8_STAGE
#undef PG8_LDA
#undef PG8_LDB
#undef PG8_MMA
#undef PG8_WAIT_V
#undef PG8_WAIT_L
#undef PG8_WAIT_VR
#undef PG8_BAR
#undef PG8_SCHED
#undef PG8_TA
#undef PG8_TB
}
}


#define XB_TMO      128
#define XB_XCNT(j)  (256  + 64 * (j))
#define XB_XSUB(j)  (1280 + 64 * (j))
#define XB_XGEN(j)  (2304 + 64 * (j))
#define XB_TOP      3328
#define XB_TOPGEN   3392
#define XCD_BAR_WORDS 3456
#define XB_SPIN_CAP (1u << 18)
DI unsigned xb_ld(unsigned* p)              { return __hip_atomic_load(p, __ATOMIC_RELAXED, __HIP_MEMORY_SCOPE_AGENT); }
DI unsigned xb_add(unsigned* p, unsigned v) { return __hip_atomic_fetch_add(p, v, __ATOMIC_RELAXED, __HIP_MEMORY_SCOPE_AGENT); }
DI unsigned xb_xcc_id() { return (unsigned)__builtin_amdgcn_s_getreg((3 << 11) | 20) & 0xFu; }
#define XB_SPIN(cond, bar) do { unsigned _sp = 0; while (cond) { __builtin_amdgcn_s_sleep(1); \
    if ((++_sp & 255u) == 0u) { if (xb_ld(&(bar)[XB_TMO])) break; if (_sp > XB_SPIN_CAP) { atomicAdd(&(bar)[XB_TMO], 1u); break; } } } } while (0)
struct XcdBarrier { unsigned* bar; unsigned x; volatile LAS unsigned* st; };
DI XcdBarrier xcd_barrier_post(unsigned* bar, volatile LAS unsigned* st) {
    XcdBarrier b; b.bar = bar; b.x = xb_xcc_id(); b.st = st;
    if (threadIdx.x == 0) (void)xb_add(&bar[XB_XCNT(b.x)], 1u);
    return b;
}
DI void xcd_barrier_complete(unsigned* bar, unsigned x, unsigned& nloc, unsigned& nx) {
    const unsigned G = gridDim.x * gridDim.y * gridDim.z;
    unsigned sum, cnt, mine, sp = 0u;
    for (;;) {
        sum = 0u; cnt = 0u; mine = 0u;
#pragma unroll
        for (unsigned j = 0; j < 16; ++j) { const unsigned c = xb_ld(&bar[XB_XCNT(j)]); sum += c; cnt += (c > 0u) ? 1u : 0u; mine = (j == x) ? c : mine; }
        if (sum == G) break;
        __builtin_amdgcn_s_sleep(1);
        if ((++sp & 255u) == 0u) { if (xb_ld(&bar[XB_TMO])) break; if (sp > XB_SPIN_CAP) { atomicAdd(&bar[XB_TMO], 1u); break; } }
    }
    nloc = mine > 0u ? mine : 1u; nx = cnt > 0u ? cnt : 1u;
}
DI void xcd_barrier(const XcdBarrier& b) {
    asm volatile("s_waitcnt vmcnt(0)" ::: "memory");
    __syncthreads();
    if (threadIdx.x == 0) {
        unsigned* bar = b.bar;
        __builtin_amdgcn_s_waitcnt(0);
        unsigned nloc = b.st[0], nx = b.st[1];
        if (nloc == 0u) { xcd_barrier_complete(bar, b.x, nloc, nx); b.st[0] = nloc; b.st[1] = nx; }
        const unsigned old = xb_add(&bar[XB_XSUB(b.x)], 1u);
        const unsigned gen = old / nloc;
        if (old + 1u == (gen + 1u) * nloc) {
            __builtin_amdgcn_fence(__ATOMIC_RELEASE, "agent");
            asm volatile("s_waitcnt vmcnt(0)" ::: "memory");
            const unsigned og = xb_add(&bar[XB_TOP], 1u);
            const unsigned tg = og / nx;
            if (og + 1u == (tg + 1u) * nx) xb_add(&bar[XB_TOPGEN], 1u);
            else XB_SPIN(xb_ld(&bar[XB_TOPGEN]) == tg, bar);
            __builtin_amdgcn_fence(__ATOMIC_ACQUIRE, "agent");
            xb_add(&bar[XB_XGEN(b.x)], 1u);
            asm volatile("s_waitcnt vmcnt(0)" ::: "memory");
        } else {
            XB_SPIN(xb_ld(&bar[XB_XGEN(b.x)]) == gen, bar);
            __builtin_amdgcn_fence(__ATOMIC_ACQUIRE, "agent");
            asm volatile("s_waitcnt vmcnt(0)" ::: "memory");
        }
    }
    __syncthreads();
}

struct Args { const float* in[16]; float* out; unsigned char* ws; int ph_lo, ph_hi; unsigned naive; int pad; };
struct Ctx {
    LAS unsigned char* lds;
    const float *x, *c, *ctx, *c_ctx, *norm_w, *ada_w, *ada_b, *w_in, *conv_w, *conv_b, *decay_logit, *gn_w, *w_a, *w_b, *w_out, *final_w;
    float* out; unsigned char* ws;
    float* MOD; f32x2* ROPE;
    bf16_t *WA, *WB, *WOUT, *WIN, *XM, *KV, *KVC, *HC, *ST, *MM, *P, *Q, *K, *V, *SZB, *KC, *VC, *UB, *R, *SGB;
    float* RET; float* S0;
};

DI int win_dest(int o) {
    if (o < 4096) { const int g = o >> 10, ch = o & 1023; return 256 * (ch >> 6) + 64 * g + (ch & 63); }
    if (o < 5120) { const int qk = (o - 4096) >> 9, oo = (o - 4096) & 511, head = oo >> 6, i = oo & 63, t = head >> 2, hh = head & 3;
        return 256 * (16 + 2 * qk + t) + (i < 32 ? 32 * hh + i : 128 + 32 * hh + (i - 32)); }
    if (o < 7168) return o;
    { const int gs = (o - 7168) >> 10, ch = (o - 7168) & 1023; return 256 * (28 + (ch >> 7)) + 128 * gs + (ch & 127); }
}
DI void p0_transpose_item(const float* W, int K, int N, bf16_t* WT, bool permute, LAS float* scr, int item, int lane) {
    const int nblk = N / 32, kb = item / nblk, nb = item % nblk, k0 = 64 * kb, n0 = 32 * nb;
    float rv[32];
#pragma unroll
    for (int i = 0; i < 32; ++i) rv[i] = W[(size_t)(k0 + 2 * i + (lane >> 5)) * N + n0 + (lane & 31)];
#pragma unroll
    for (int i = 0; i < 32; ++i) scr[(2 * i + (lane >> 5)) * 33 + (lane & 31)] = rv[i];
    asm volatile("s_waitcnt lgkmcnt(0)" ::: "memory");
    const int c = lane & 7; const int d0 = permute ? win_dest(n0) : n0;
#pragma unroll
    for (int j = 0; j < 4; ++j) { const int n = (lane >> 3) + 8 * j; const LAS float* s = scr + (8 * c) * 33 + n;
        u32x4 o; o.x = cvt_pk_bf16(s[0 * 33], s[1 * 33]); o.y = cvt_pk_bf16(s[2 * 33], s[3 * 33]); o.z = cvt_pk_bf16(s[4 * 33], s[5 * 33]); o.w = cvt_pk_bf16(s[6 * 33], s[7 * 33]);
        *(u32x4*)(WT + (size_t)(d0 + n) * K + k0 + 8 * c) = o; }
    asm volatile("s_waitcnt lgkmcnt(0)" ::: "memory");
}
DI void p0_prologue(const Ctx& F) {
    const Tid T = opaque_tid();
    if (blockIdx.x < 48) {
        LAS float* red = (LAS float*)F.lds;
        LAS float* sl = (LAS float*)(F.lds + 16384);
        for (int e = T.tid; e < 5 * 1024; e += 512) { const int v = e >> 10, k = e & 1023; sl[e] = siluf(v < 4 ? F.c[v * 1024 + k] : F.c_ctx[k]); }
        __syncthreads();
        const int n0 = 64 * blockIdx.x, k0 = 128 * T.wave;
        float a[5] = {0.f, 0.f, 0.f, 0.f, 0.f};
#pragma unroll 4
        for (int kb = 0; kb < 128; kb += 32) {
            float wv[32];
#pragma unroll
            for (int k = 0; k < 32; ++k) wv[k] = F.ada_w[(size_t)(k0 + kb + k) * 3072 + n0 + T.lane];
#pragma unroll
            for (int k = 0; k < 32; ++k)
#pragma unroll
                for (int v = 0; v < 5; ++v) a[v] += sl[v * 1024 + k0 + kb + k] * wv[k];
        }
#pragma unroll
        for (int v = 0; v < 5; ++v) red[(T.wave * 5 + v) * 64 + T.lane] = a[v];
        __syncthreads();
        if (T.tid < 320) { const int v = T.tid >> 6, l = T.tid & 63; float s = F.ada_b[n0 + l];
#pragma unroll
            for (int w = 0; w < 8; ++w) s += red[(w * 5 + v) * 64 + l];
            F.MOD[v * 3072 + n0 + l] = s; }
        __syncthreads();
    }
    if (blockIdx.x == 48) {
        for (int e = T.tid; e < 1024; e += 512) { const int p = e >> 4, f = e & 15; const float inv = powf(10000.f, -(float)f / 16.f); const float ang = (float)p * inv;
            F.ROPE[e] = (f32x2){cosf(ang), sinf(ang)}; }
    }
    LAS float* scr = (LAS float*)(F.lds + T.wave * 16384);
    const int gw = blockIdx.x * 8 + T.wave, NGW = gridDim.x * 8;
    constexpr int I_IN = 16 * (NIN / 32), I_SQ = 16 * 32;
    for (int it = gw; it < I_IN + 3 * I_SQ; it += NGW) {
        int r = it;
        if (r < I_IN) { p0_transpose_item(F.w_in, 1024, NIN, F.WIN, true, scr, r, T.lane); continue; } r -= I_IN;
        if (r < I_SQ) { p0_transpose_item(F.w_a, 1024, 1024, F.WA, false, scr, r, T.lane); continue; } r -= I_SQ;
        if (r < I_SQ) { p0_transpose_item(F.w_b, 1024, 1024, F.WB, false, scr, r, T.lane); continue; } r -= I_SQ;
        p0_transpose_item(F.w_out, 1024, 1024, F.WOUT, false, scr, r, T.lane);
    }
}
DI void p1_rows(const Ctx& F) {
    const Tid T = opaque_tid();
    const int gw = blockIdx.x * 8 + T.wave, NGW = gridDim.x * 8;
    constexpr int RB = 4;
    for (int m0 = gw * RB; m0 < MALL; m0 += NGW * RB) {
        f32x4 v[RB][4]; float ss[RB];
#pragma unroll
        for (int r = 0; r < RB; ++r) { const int m = m0 + r; const float* xr = m < MTOK ? F.x + (size_t)m * DM : F.ctx + (size_t)(m - MTOK) * DM;
#pragma unroll
            for (int j = 0; j < 4; ++j) v[r][j] = ((const f32x4*)xr)[T.lane + 64 * j]; }
#pragma unroll
        for (int r = 0; r < RB; ++r) { float s = 0.f;
#pragma unroll
            for (int j = 0; j < 4; ++j) s += (v[r][j].x * v[r][j].x + v[r][j].y * v[r][j].y) + (v[r][j].z * v[r][j].z + v[r][j].w * v[r][j].w);
            ss[r] = s; }
#pragma unroll
        for (int o = 1; o < 64; o <<= 1)
#pragma unroll
            for (int r = 0; r < RB; ++r) ss[r] += __shfl_xor(ss[r], o);
        const int mb = m0 < MTOK ? (m0 >> 12) : 4; const float* mod = F.MOD + mb * 3072;
#pragma unroll
        for (int j = 0; j < 4; ++j) { const int col = 4 * (T.lane + 64 * j);
            const f32x4 w = *(const f32x4*)(F.norm_w + col), sh = *(const f32x4*)(mod + col), sc = *(const f32x4*)(mod + 1024 + col);
#pragma unroll
            for (int r = 0; r < RB; ++r) { const float rstd = __builtin_amdgcn_rsqf(ss[r] * (1.f / DM) + EPS);
                const f32x4 y = (v[r][j] * rstd * w) * (sc + 1.0f) + sh;
                u32x2 o; o.x = cvt_pk_bf16(y.x, y.y); o.y = cvt_pk_bf16(y.z, y.w);
                *(u32x2*)(F.XM + (size_t)(m0 + r) * DM + col) = o; } }
    }
}
struct Sched1 {
    int G, c;
    DI bool next(int i, pg8::Unit& u) const { const int L = i * G + c; if (L >= 64 * 36) return false; pg8::tile_of(L, 64, 36, u); return true; }
};
struct SchedCtx {
    int c;
    DI bool next(int i, pg8::Unit& u) const { if (i > 0 || c >= 24) return false; u.pm = 64 + c / 6; u.pn = 18 + c % 6; return true; }
};
struct Epi1 {
    unsigned char* ws; bf16_t *R, *SGB; const f32x2* rope;
    DI int vm_ops(const pg8::Unit& u) const { return u.pn < 16 ? 8 : 16; }
    DI void mid(f32x4 (&)[2][2][4][2], const pg8::Unit&, int, int, int, int) const {}
    DI void operator()(const f32x4 (&acc)[2][2][4][2], const pg8::Unit& u, int wr, int wc, int fr, int fq) const {
        const int pn = u.pn, row0 = u.pm * 256 + wr * 64 + fr, x0 = wc * 32 + 8 * fq;
        const bool isctx = u.pm >= 64;
        if (pn < 16) {
            bf16_t* dst = (bf16_t*)(ws + (wc < 2 ? WS_HC : WS_P)) + 64 * pn + (x0 & 63);
#pragma unroll
            for (int ai = 0; ai < 2; ++ai)
#pragma unroll
                for (int m = 0; m < 4; ++m) { const size_t row = row0 + ai * 128 + m * 16;
                    f32x4 o[2];
#pragma unroll
                    for (int n = 0; n < 2; ++n) { const f32x4 a = acc[ai][0][m][n], b = acc[ai][1][m][n];
                        if (wc < 2) o[n] = a * b;
                        else { o[n].x = a.x * siluf(b.x); o[n].y = a.y * siluf(b.y); o[n].z = a.z * siluf(b.z); o[n].w = a.w * siluf(b.w); } }
                    u32x4 w; w.x = cvt_pk_bf16(o[0].x, o[0].y); w.y = cvt_pk_bf16(o[0].z, o[0].w); w.z = cvt_pk_bf16(o[1].x, o[1].y); w.w = cvt_pk_bf16(o[1].z, o[1].w);
                    *(u32x4*)(dst + row * 1024) = w; }
        } else if (pn < 20) {
            const int t = (pn - 16) & 1, isk = (pn - 16) >> 1, head = 4 * t + wc, i0 = 8 * fq;
            const float scale = isk ? 0.125f : 1.0f;
            bf16_t* base = (bf16_t*)(ws + (isk ? (isctx ? WS_KC : WS_K) : WS_Q));
#pragma unroll
            for (int ai = 0; ai < 2; ++ai)
#pragma unroll
                for (int m = 0; m < 4; ++m) { const int row = row0 + ai * 128 + m * 16; const int orow = isctx ? row - MTOK : row;
                    const int pos = row & 4095, pidx = (fq < 2) ? (pos >> 6) : (pos & 63);
                    const f32x2* rp = rope + pidx * 16 + (fq & 1) * 8;
                    float o1[8], o2[8];
#pragma unroll
                    for (int e = 0; e < 8; ++e) { f32x2 cs = rp[e]; if (isctx) cs = (f32x2){1.f, 0.f};
                        const float t1 = acc[ai][0][m][e >> 2][e & 3], t2 = acc[ai][1][m][e >> 2][e & 3];
                        o1[e] = (t1 * cs.x - t2 * cs.y) * scale; o2[e] = (t1 * cs.y + t2 * cs.x) * scale; }
                    u32x4 w1, w2; w1.x = cvt_pk_bf16(o1[0], o1[1]); w1.y = cvt_pk_bf16(o1[2], o1[3]); w1.z = cvt_pk_bf16(o1[4], o1[5]); w1.w = cvt_pk_bf16(o1[6], o1[7]);
                    w2.x = cvt_pk_bf16(o2[0], o2[1]); w2.y = cvt_pk_bf16(o2[2], o2[3]); w2.z = cvt_pk_bf16(o2[4], o2[5]); w2.w = cvt_pk_bf16(o2[6], o2[7]);
                    bf16_t* d = base + (size_t)orow * 512 + head * 64 + i0;
                    *(u32x4*)d = w1; *(u32x4*)(d + 32) = w2; }
        } else if (pn < 28) {
            const bool isz = pn >= 24;
            bf16_t* base = (bf16_t*)(ws + (isz ? WS_SZB : (isctx ? WS_VC : WS_V)));
            const int colt = 256 * (pn - (isz ? 24 : 20)) + x0;
#pragma unroll
            for (int ai = 0; ai < 2; ++ai)
#pragma unroll
                for (int m = 0; m < 4; ++m) { const int row = row0 + ai * 128 + m * 16; const int orow = isctx ? row - MTOK : row;
#pragma unroll
                    for (int bj = 0; bj < 2; ++bj) { f32x4 a = acc[ai][bj][m][0], b = acc[ai][bj][m][1];
                        u32x4 w; w.x = cvt_pk_bf16(a.x, a.y); w.y = cvt_pk_bf16(a.z, a.w); w.z = cvt_pk_bf16(b.x, b.y); w.w = cvt_pk_bf16(b.z, b.w);
                        if (isz) __builtin_nontemporal_store(w, (u32x4*)(base + (size_t)orow * 1024 + colt + bj * 128)); else *(u32x4*)(base + (size_t)orow * 1024 + colt + bj * 128) = w; } }
        } else {
            const int col = 128 * (pn - 28) + x0;
#pragma unroll
            for (int ai = 0; ai < 2; ++ai)
#pragma unroll
                for (int m = 0; m < 4; ++m) { const size_t row = row0 + ai * 128 + m * 16;
                    float rr[8], sg[8];
#pragma unroll
                    for (int e = 0; e < 8; ++e) { const float ga = acc[ai][0][m][e >> 2][e & 3], gb = acc[ai][1][m][e >> 2][e & 3];
                        const float ea = 1.f + __expf(-ga), eb = 1.f + __expf(-gb); sg[e] = __builtin_amdgcn_rcpf(eb); rr[e] = eb * __builtin_amdgcn_rcpf(ea); }
                    u32x4 w1, w2; w1.x = cvt_pk_bf16(rr[0], rr[1]); w1.y = cvt_pk_bf16(rr[2], rr[3]); w1.z = cvt_pk_bf16(rr[4], rr[5]); w1.w = cvt_pk_bf16(rr[6], rr[7]);
                    w2.x = cvt_pk_bf16(sg[0], sg[1]); w2.y = cvt_pk_bf16(sg[2], sg[3]); w2.z = cvt_pk_bf16(sg[4], sg[5]); w2.w = cvt_pk_bf16(sg[6], sg[7]);
                    __builtin_nontemporal_store(w1, (u32x4*)(R + row * 1024 + col)); __builtin_nontemporal_store(w2, (u32x4*)(SGB + row * 1024 + col)); }
        }
    }
};
DI void n2_inproj(const Ctx& F) {
    const Tid T = opaque_tid();
    const size_t NT = (size_t)gridDim.x * 512, gt = (size_t)blockIdx.x * 512 + T.tid;
    for (size_t idx = gt; idx < (size_t)(MALL / 4) * 1024; idx += NT) {
        const int ch = (int)(idx & 1023), t0 = (int)(idx >> 10) * 4;
        const bool doqk = ch < 512 && (ch & 63) < 32;
        float a[12][4];
#pragma unroll
        for (int o = 0; o < 12; ++o)
#pragma unroll
            for (int j = 0; j < 4; ++j) a[o][j] = 0.f;
        for (int k = 0; k < 1024; ++k) {
            const float* wr = F.w_in + (size_t)k * NIN;
            float xv[4];
#pragma unroll
            for (int j = 0; j < 4; ++j) xv[j] = bf2f(F.XM[(size_t)(t0 + j) * 1024 + k]);
            float w[12];
            w[0] = wr[ch]; w[1] = wr[1024 + ch]; w[2] = wr[2048 + ch]; w[3] = wr[3072 + ch]; w[4] = wr[5120 + ch]; w[5] = wr[6144 + ch]; w[6] = wr[7168 + ch]; w[7] = wr[8192 + ch];
            if (doqk) { w[8] = wr[4096 + ch]; w[9] = wr[4096 + ch + 32]; w[10] = wr[4608 + ch]; w[11] = wr[4608 + ch + 32]; } else { w[8] = w[9] = w[10] = w[11] = 0.f; }
#pragma unroll
            for (int o = 0; o < 12; ++o)
#pragma unroll
                for (int j = 0; j < 4; ++j) a[o][j] += xv[j] * w[o];
        }
#pragma unroll
        for (int j = 0; j < 4; ++j) { const int t = t0 + j;
            if (t < MTOK) {
                const size_t o = (size_t)t * 1024 + ch;
                F.HC[o] = f2bf(a[2][j] * a[0][j]); F.P[o] = f2bf(siluf(a[3][j]) * a[1][j]); F.V[o] = f2bf(a[4][j]); F.SZB[o] = f2bf(a[5][j]);
                const float sga = 1.f / (1.f + __expf(-a[6][j])), sgb = 1.f / (1.f + __expf(-a[7][j]));
                F.R[o] = f2bf(sga / sgb); F.SGB[o] = f2bf(sgb);
                if (doqk) { const int i = ch & 63, pos = t & 4095; const int pidx = i < 16 ? (pos >> 6) : (pos & 63); const f32x2 cs = F.ROPE[pidx * 16 + (i & 15)];
                    const size_t q = (size_t)t * 512 + ch;
                    F.Q[q] = f2bf(a[8][j] * cs.x - a[9][j] * cs.y); F.Q[q + 32] = f2bf(a[8][j] * cs.y + a[9][j] * cs.x);
                    F.K[q] = f2bf((a[10][j] * cs.x - a[11][j] * cs.y) * 0.125f); F.K[q + 32] = f2bf((a[10][j] * cs.y + a[11][j] * cs.x) * 0.125f); }
            } else {
                const int tc = t - MTOK;
                F.VC[(size_t)tc * 1024 + ch] = f2bf(a[4][j]);
                if (doqk) { F.KC[(size_t)tc * 512 + ch] = f2bf(a[10][j] * 0.125f); F.KC[(size_t)tc * 512 + ch + 32] = f2bf(a[11][j] * 0.125f); }
            }
        }
    }
}
DI bf16x8 tr2(const LAS unsigned char* p, int delta) {
    const s16x4 lo = __builtin_bit_cast(s16x4, __builtin_amdgcn_ds_read_tr16_b64_v4i16((LAS v4i16_t*)p));
    const s16x4 hi = __builtin_bit_cast(s16x4, __builtin_amdgcn_ds_read_tr16_b64_v4i16((LAS v4i16_t*)(p + delta)));
    return __builtin_shufflevector(lo, hi, 0, 1, 2, 3, 4, 5, 6, 7);
}
DI u32x4 scale8(u32x4 w, float s) {
    u32x4 o; o.x = cvt_pk_bf16(bflo(w.x) * s, bfhi(w.x) * s); o.y = cvt_pk_bf16(bflo(w.y) * s, bfhi(w.y) * s); o.z = cvt_pk_bf16(bflo(w.z) * s, bfhi(w.z) * s); o.w = cvt_pk_bf16(bflo(w.w) * s, bfhi(w.w) * s); return o;
}
DI void p3_kv(const Ctx& F, int it0, int it1, int stride) {
    const Tid T = opaque_tid();
    LAS unsigned char* KFI = F.lds; LAS unsigned char* KBI = F.lds + 20480; LAS unsigned char* VI = F.lds + 40960;
    const int tid = T.tid, lane = T.lane, w = T.wave, g = lane >> 4, q = (lane & 15) >> 2, p = lane & 3;
    const int row = tid >> 2, seg = tid & 3;
    u32x4 pk[2], pv[4];
    auto prefetch = [&](int it) { const int bh = it >> 5, c = it & 31; const size_t tok0 = (size_t)(bh >> 3) * SEQ + c * CHK;
        const bf16_t* kp = F.K + tok0 * 512 + (bh & 7) * 64; const bf16_t* vp = F.V + tok0 * 1024 + (bh & 7) * 128;
        pk[0] = *(const u32x4*)(kp + (size_t)row * 512 + seg * 16); pk[1] = *(const u32x4*)(kp + (size_t)row * 512 + seg * 16 + 8);
#pragma unroll
        for (int i = 0; i < 4; ++i) pv[i] = *(const u32x4*)(vp + (size_t)row * 1024 + seg * 32 + 8 * i); };
    if (it0 < it1) prefetch(it0);
    for (int it = it0; it < it1; it += stride) {
        const int bh = it >> 5, c = it & 31;
        const float l2f = log2_gamma(F.decay_logit, 0, bh & 7), l2b = log2_gamma(F.decay_logit, 1, bh & 7);
        { const float df = __builtin_amdgcn_exp2f(l2f * (float)(127 - row)), db = __builtin_amdgcn_exp2f(l2b * (float)row);
            *(LAS u32x4*)(KFI + row * 160 + seg * 32) = scale8(pk[0], df); *(LAS u32x4*)(KFI + row * 160 + seg * 32 + 16) = scale8(pk[1], df);
            *(LAS u32x4*)(KBI + row * 160 + seg * 32) = scale8(pk[0], db); *(LAS u32x4*)(KBI + row * 160 + seg * 32 + 16) = scale8(pk[1], db);
#pragma unroll
            for (int i = 0; i < 4; ++i) *(LAS u32x4*)(VI + row * 288 + seg * 64 + 16 * i) = pv[i]; }
        __syncthreads();
        if (it + stride < it1) prefetch(it + stride);
        f32x4 acc[2][4];
#pragma unroll
        for (int d = 0; d < 2; ++d)
#pragma unroll
            for (int nb = 0; nb < 4; ++nb) acc[d][nb] = (f32x4){0.f, 0.f, 0.f, 0.f};
#pragma unroll
        for (int s2 = 0; s2 < 4; ++s2) {
            const bf16x8 vb = tr2(VI + (32 * s2 + 8 * g + q) * 288 + (16 * w + 4 * p) * 2, 4 * 288);
#pragma unroll
            for (int nb = 0; nb < 4; ++nb) {
                const bf16x8 kf = tr2(KFI + (32 * s2 + 8 * g + q) * 160 + (16 * nb + 4 * p) * 2, 4 * 160);
                const bf16x8 kb = tr2(KBI + (32 * s2 + 8 * g + q) * 160 + (16 * nb + 4 * p) * 2, 4 * 160);
                acc[0][nb] = __builtin_amdgcn_mfma_f32_16x16x32_bf16(kf, vb, acc[0][nb], 0, 0, 0);
                acc[1][nb] = __builtin_amdgcn_mfma_f32_16x16x32_bf16(kb, vb, acc[1][nb], 0, 0, 0);
            }
        }
        bf16_t* of = F.KV + ((size_t)(0 * 32 + bh) * 32 + c) * 8192; bf16_t* ob = F.KV + ((size_t)(1 * 32 + bh) * 32 + c) * 8192;
#pragma unroll
        for (int nb = 0; nb < 4; ++nb) { const int o = (16 * w + (lane & 15)) * 64 + 16 * nb + 4 * g;
            u32x2 a, b; a.x = cvt_pk_bf16(acc[0][nb].x, acc[0][nb].y); a.y = cvt_pk_bf16(acc[0][nb].z, acc[0][nb].w); b.x = cvt_pk_bf16(acc[1][nb].x, acc[1][nb].y); b.y = cvt_pk_bf16(acc[1][nb].z, acc[1][nb].w);
            *(u32x2*)(of + o) = a; *(u32x2*)(ob + o) = b; }
        __syncthreads();
    }
}
DI void p4_ctx_state(const Ctx& F, int bh) {
    const Tid T = opaque_tid();
    LAS unsigned char* KFI = F.lds; LAS unsigned char* KBI = F.lds + 20480; LAS unsigned char* VI = F.lds + 40960;
    const int tid = T.tid, lane = T.lane, w = T.wave, g = lane >> 4, q = (lane & 15) >> 2, p = lane & 3;
    const int row = tid >> 2, seg = tid & 3;
    const float l2f = log2_gamma(F.decay_logit, 0, bh & 7), l2b = log2_gamma(F.decay_logit, 1, bh & 7);
    f32x4 acc[2][4];
#pragma unroll
    for (int d = 0; d < 2; ++d)
#pragma unroll
        for (int nb = 0; nb < 4; ++nb) acc[d][nb] = (f32x4){0.f, 0.f, 0.f, 0.f};
    for (int cc = 0; cc < 2; ++cc) {
        const size_t tok0 = (size_t)(bh >> 3) * CTXL + cc * CHK; const int m = cc * CHK + row;
        const bf16_t* kp = F.KC + tok0 * 512 + (bh & 7) * 64; const bf16_t* vp = F.VC + tok0 * 1024 + (bh & 7) * 128;
        const u32x4 k0 = *(const u32x4*)(kp + (size_t)row * 512 + seg * 16), k1 = *(const u32x4*)(kp + (size_t)row * 512 + seg * 16 + 8);
        const float df = __builtin_amdgcn_exp2f(l2f * (float)(255 - m)), db = __builtin_amdgcn_exp2f(l2b * (float)m);
        *(LAS u32x4*)(KFI + row * 160 + seg * 32) = scale8(k0, df); *(LAS u32x4*)(KFI + row * 160 + seg * 32 + 16) = scale8(k1, df);
        *(LAS u32x4*)(KBI + row * 160 + seg * 32) = scale8(k0, db); *(LAS u32x4*)(KBI + row * 160 + seg * 32 + 16) = scale8(k1, db);
#pragma unroll
        for (int i = 0; i < 4; ++i) *(LAS u32x4*)(VI + row * 288 + seg * 64 + 16 * i) = *(const u32x4*)(vp + (size_t)row * 1024 + seg * 32 + 8 * i);
        __syncthreads();
#pragma unroll
        for (int s2 = 0; s2 < 4; ++s2) {
            const bf16x8 vb = tr2(VI + (32 * s2 + 8 * g + q) * 288 + (16 * w + 4 * p) * 2, 4 * 288);
#pragma unroll
            for (int nb = 0; nb < 4; ++nb) {
                const bf16x8 kf = tr2(KFI + (32 * s2 + 8 * g + q) * 160 + (16 * nb + 4 * p) * 2, 4 * 160);
                const bf16x8 kb = tr2(KBI + (32 * s2 + 8 * g + q) * 160 + (16 * nb + 4 * p) * 2, 4 * 160);
                acc[0][nb] = __builtin_amdgcn_mfma_f32_16x16x32_bf16(kf, vb, acc[0][nb], 0, 0, 0);
                acc[1][nb] = __builtin_amdgcn_mfma_f32_16x16x32_bf16(kb, vb, acc[1][nb], 0, 0, 0);
            }
        }
        __syncthreads();
    }
    float* of = F.S0 + (size_t)(0 * 32 + bh) * 8192; float* ob = F.S0 + (size_t)(1 * 32 + bh) * 8192;
#pragma unroll
    for (int nb = 0; nb < 4; ++nb) { const int o = (16 * w + (lane & 15)) * 64 + 16 * nb + 4 * g; *(f32x4*)(of + o) = acc[0][nb]; *(f32x4*)(ob + o) = acc[1][nb]; }
}
DI void p3_ua(const Ctx& F, int blk, int nblk) {
    const Tid T = opaque_tid();
    const size_t NT = (size_t)nblk * 512, gt = (size_t)blk * 512 + T.tid;
    for (size_t idx = gt; idx < (size_t)MTOK * 128; idx += NT) {
        const int t = (int)(idx >> 7), c8 = (int)(idx & 127) * 8, pos = t & 4095;
        const bf16_t* hp = F.HC + (size_t)t * 1024 + c8;
        const u32x4 z = (u32x4){0u, 0u, 0u, 0u};
        const u32x4 h0 = pos > 0 ? *(const u32x4*)(hp - 1024) : z, h1 = *(const u32x4*)hp, h2 = pos < SEQ - 1 ? *(const u32x4*)(hp + 1024) : z;
        const u32x4 pv = *(const u32x4*)(F.P + (size_t)t * 1024 + c8);
        float o[8];
#pragma unroll
        for (int e = 0; e < 8; ++e) { const unsigned a = h0[e >> 1], b = h1[e >> 1], c = h2[e >> 1], pp = pv[e >> 1];
            const float x0 = (e & 1) ? bfhi(a) : bflo(a), x1 = (e & 1) ? bfhi(b) : bflo(b), x2 = (e & 1) ? bfhi(c) : bflo(c), pf = (e & 1) ? bfhi(pp) : bflo(pp);
            const float cv = F.conv_w[c8 + e] * x0 + F.conv_w[1024 + c8 + e] * x1 + F.conv_w[2048 + c8 + e] * x2 + F.conv_b[c8 + e];
            o[e] = pf * cv; }
        u32x4 w; w.x = cvt_pk_bf16(o[0], o[1]); w.y = cvt_pk_bf16(o[2], o[3]); w.z = cvt_pk_bf16(o[4], o[5]); w.w = cvt_pk_bf16(o[6], o[7]);
        *(u32x4*)(F.P + (size_t)t * 1024 + c8) = w;
    }
}
DI void p4_scan(const Ctx& F, int blk, int nblk) {
    const Tid T = opaque_tid();
    const size_t NT = (size_t)nblk * 512, gt = (size_t)blk * 512 + T.tid;
    for (size_t idx = gt; idx < (size_t)2 * 32 * 2048; idx += NT) {
        const int e4 = (int)(idx & 2047), bh = (int)(idx >> 11) & 31, dir = (int)(idx >> 16);
        const float g = exp2f(log2_gamma(F.decay_logit, dir, bh & 7) * 128.f);
        const u32x2* kv = (const u32x2*)(F.KV + ((size_t)(dir * 32 + bh) * 32) * 8192) + e4;
        u32x2* st = (u32x2*)(F.ST + ((size_t)(dir * 32 + bh) * 32) * 8192) + e4;
        float s0 = 0.f, s1 = 0.f, s2 = 0.f, s3 = 0.f;
        u32x2 v[32];
#pragma unroll
        for (int i = 0; i < 32; ++i) v[i] = kv[(size_t)(dir == 0 ? i : 31 - i) * 2048];
#pragma unroll
        for (int i = 0; i < 32; ++i) { const int c = dir == 0 ? i : 31 - i;
            u32x2 o; o.x = cvt_pk_bf16(s0, s1); o.y = cvt_pk_bf16(s2, s3); st[(size_t)c * 2048] = o;
            s0 = g * s0 + bflo(v[i].x); s1 = g * s1 + bfhi(v[i].x); s2 = g * s2 + bflo(v[i].y); s3 = g * s3 + bfhi(v[i].y); }
    }
}
DI void n4_recurrence(const Ctx& F) {
    const Tid T = opaque_tid();
    const int gw = blockIdx.x * 8 + T.wave, NGW = gridDim.x * 8, d = T.lane;
    for (int task = gw; task < 32 * 128; task += NGW) {
        const int bh = task >> 7, v = task & 127, b = bh >> 3, h = bh & 7;
        const float gf = exp2f(log2_gamma(F.decay_logit, 0, h)), gb = exp2f(log2_gamma(F.decay_logit, 1, h));
        float s = 0.f;
        for (int m = 0; m < CTXL; ++m) { const size_t t = (size_t)b * CTXL + m; s = gf * s + bf2f(F.KC[t * 512 + h * 64 + d]) * bf2f(F.VC[t * 1024 + h * 128 + v]); }
        const float sF = s; s = 0.f;
        for (int m = CTXL - 1; m >= 0; --m) { const size_t t = (size_t)b * CTXL + m; s = gb * s + bf2f(F.KC[t * 512 + h * 64 + d]) * bf2f(F.VC[t * 1024 + h * 128 + v]); }
        const float sB = s;
        s = sF;
        for (int n = 0; n < SEQ; ++n) { const size_t t = (size_t)b * SEQ + n; s = gf * s + bf2f(F.K[t * 512 + h * 64 + d]) * bf2f(F.V[t * 1024 + h * 128 + v]);
            const float o = wave_sum(bf2f(F.Q[t * 512 + h * 64 + d]) * s); if (d == 0) F.RET[t * 1024 + h * 128 + v] = o; }
        s = sB;
        for (int n = SEQ - 1; n >= 0; --n) { const size_t t = (size_t)b * SEQ + n; s = gb * s + bf2f(F.K[t * 512 + h * 64 + d]) * bf2f(F.V[t * 1024 + h * 128 + v]);
            const float o = wave_sum(bf2f(F.Q[t * 512 + h * 64 + d]) * s); if (d == 0) F.RET[t * 1024 + h * 128 + v] += o; }
    }
}
DI void n5_groupnorm(const Ctx& F) {
    const Tid T = opaque_tid();
    const int gw = blockIdx.x * 8 + T.wave, NGW = gridDim.x * 8;
    for (int task = gw; task < MTOK * NH; task += NGW) {
        const int t = task >> 3, h = task & 7; const size_t o = (size_t)t * 1024 + h * 128 + 2 * T.lane;
        const float a = F.RET[o], b = F.RET[o + 1];
        const float mu = wave_sum(a + b) * (1.f / 128.f); const float da = a - mu, db = b - mu;
        const float var = wave_sum(da * da + db * db) * (1.f / 128.f); const float rstd = 1.0f / sqrtf(var + EPS);
        const float ra = da * rstd * F.gn_w[h * 128 + 2 * T.lane], rb = db * rstd * F.gn_w[h * 128 + 2 * T.lane + 1];
        *(unsigned*)(F.UB + o) = cvt_pk_bf16(siluf(bf2f(F.SZB[o])) * ra, siluf(bf2f(F.SZB[o + 1])) * rb);
    }
}
DI void p5_ret(const Ctx& F) {
    const Tid T = opaque_tid();
    LAS unsigned char* KI = F.lds; LAS unsigned char* VI = F.lds + 20480; LAS unsigned char* SF = F.lds + 57344; LAS unsigned char* SB = F.lds + 75776;
    LAS unsigned char* S0F = F.lds + 94208; LAS unsigned char* S0B = F.lds + 110592;
    const int tid = T.tid, lane = T.lane, w = T.wave, g = lane >> 4, q = (lane & 15) >> 2, p = lane & 3, l15 = lane & 15;
    const int row = tid >> 2, seg = tid & 3, il = 16 * w + l15;
    for (int base = blockIdx.x * 4; base < 1024; base += gridDim.x * 4) {
        const int bh = base >> 5, h = bh & 7;
        const float l2f = log2_gamma(F.decay_logit, 0, h), l2b = log2_gamma(F.decay_logit, 1, h);
        { const float* s0f = F.S0 + (size_t)(0 * 32 + bh) * 8192 + row * 64 + seg * 16; const float* s0b = F.S0 + (size_t)(1 * 32 + bh) * 8192 + row * 64 + seg * 16;
#pragma unroll
            for (int i = 0; i < 2; ++i) { const f32x4 a0 = *(const f32x4*)(s0f + 8 * i), a1 = *(const f32x4*)(s0f + 8 * i + 4), b0 = *(const f32x4*)(s0b + 8 * i), b1 = *(const f32x4*)(s0b + 8 * i + 4);
                u32x4 x, y; x.x = cvt_pk_bf16(a0.x, a0.y); x.y = cvt_pk_bf16(a0.z, a0.w); x.z = cvt_pk_bf16(a1.x, a1.y); x.w = cvt_pk_bf16(a1.z, a1.w);
                y.x = cvt_pk_bf16(b0.x, b0.y); y.y = cvt_pk_bf16(b0.z, b0.w); y.z = cvt_pk_bf16(b1.x, b1.y); y.w = cvt_pk_bf16(b1.z, b1.w);
                *(LAS u32x4*)(S0F + row * 128 + seg * 32 + 16 * i) = x; *(LAS u32x4*)(S0B + row * 128 + seg * 32 + 16 * i) = y; } }
        u32x4 pk[2], pv[4], pf0[2], pb0[2]; bf16x8 pq[2];
        auto prefetch = [&](int it) { const int c = it & 31; const size_t tok0 = (size_t)(bh >> 3) * SEQ + c * CHK;
            const bf16_t* kp = F.K + tok0 * 512 + h * 64; const bf16_t* vp = F.V + tok0 * 1024 + h * 128; const bf16_t* qp = F.Q + tok0 * 512 + h * 64;
            const bf16_t* stf = F.ST + ((size_t)(0 * 32 + bh) * 32 + c) * 8192; const bf16_t* stb = F.ST + ((size_t)(1 * 32 + bh) * 32 + c) * 8192;
#pragma unroll
            for (int i = 0; i < 2; ++i) { pk[i] = *(const u32x4*)(kp + (size_t)row * 512 + seg * 16 + 8 * i); pf0[i] = *(const u32x4*)(stf + row * 64 + seg * 16 + 8 * i); pb0[i] = *(const u32x4*)(stb + row * 64 + seg * 16 + 8 * i);
                pq[i] = *(const bf16x8*)(qp + (size_t)il * 512 + 32 * i + 8 * g); }
#pragma unroll
            for (int i = 0; i < 4; ++i) pv[i] = *(const u32x4*)(vp + (size_t)row * 1024 + seg * 32 + 8 * i); };
        prefetch(base);
        for (int k = 0; k < 4; ++k) {
            const int it = base + k, c = it & 31; const size_t tok0 = (size_t)(bh >> 3) * SEQ + c * CHK;
            { const float cf = __builtin_amdgcn_exp2f(l2f * 128.f * (float)c), cb = __builtin_amdgcn_exp2f(l2b * 128.f * (float)(31 - c));
#pragma unroll
                for (int i = 0; i < 2; ++i) { *(LAS u32x4*)(KI + row * 160 + seg * 32 + 16 * i) = pk[i];
                    const u32x4 x = *(const LAS u32x4*)(S0F + row * 128 + seg * 32 + 16 * i), y = *(const LAS u32x4*)(S0B + row * 128 + seg * 32 + 16 * i);
                    u32x4 of, ob;
#pragma unroll
                    for (int e = 0; e < 4; ++e) { of[e] = cvt_pk_bf16(bflo(pf0[i][e]) + cf * bflo(x[e]), bfhi(pf0[i][e]) + cf * bfhi(x[e])); ob[e] = cvt_pk_bf16(bflo(pb0[i][e]) + cb * bflo(y[e]), bfhi(pb0[i][e]) + cb * bfhi(y[e])); }
                    *(LAS u32x4*)(SF + row * 144 + seg * 32 + 16 * i) = of; *(LAS u32x4*)(SB + row * 144 + seg * 32 + 16 * i) = ob; }
#pragma unroll
                for (int i = 0; i < 4; ++i) *(LAS u32x4*)(VI + row * 288 + seg * 64 + 16 * i) = pv[i]; }
            bf16x8 qf[2]; qf[0] = pq[0]; qf[1] = pq[1];
            __syncthreads();
            if (k < 3) prefetch(it + 1);
            f32x4 accS[8];
#pragma unroll
            for (int jb = 0; jb < 8; ++jb) { accS[jb] = (f32x4){0.f, 0.f, 0.f, 0.f};
#pragma unroll
                for (int ks = 0; ks < 2; ++ks) { const bf16x8 kf = *(const LAS bf16x8*)(KI + (16 * jb + l15) * 160 + (32 * ks + 8 * g) * 2);
                    accS[jb] = __builtin_amdgcn_mfma_f32_16x16x32_bf16(kf, qf[ks], accS[jb], 0, 0, 0); } }
            bf16x8 pf[4];
#pragma unroll
            for (int s2 = 0; s2 < 4; ++s2) { float pe[8];
#pragma unroll
                for (int e = 0; e < 8; ++e) { const int jb = 2 * s2 + (e >> 2), r = e & 3, j = 16 * jb + 4 * g + r, df = il - j;
                    float mk = __builtin_amdgcn_exp2f((df >= 0 ? l2f : -l2b) * (float)df); if (df == 0) mk = 2.f;
                    pe[e] = accS[jb][r] * mk; }
                u32x4 pw; pw.x = cvt_pk_bf16(pe[0], pe[1]); pw.y = cvt_pk_bf16(pe[2], pe[3]); pw.z = cvt_pk_bf16(pe[4], pe[5]); pw.w = cvt_pk_bf16(pe[6], pe[7]);
                pf[s2] = __builtin_bit_cast(bf16x8, pw); }
            const float decf = __builtin_amdgcn_exp2f(l2f * (float)(il + 1)), decb = __builtin_amdgcn_exp2f(l2b * (float)(128 - il));
            f32x4 accO[8];
#pragma unroll
            for (int vb = 0; vb < 8; ++vb) { f32x4 o = (f32x4){0.f, 0.f, 0.f, 0.f};
#pragma unroll
                for (int s2 = 0; s2 < 4; ++s2) { const bf16x8 vf = tr2(VI + (32 * s2 + 4 * g + q) * 288 + (16 * vb + 4 * p) * 2, 16 * 288);
                    o = __builtin_amdgcn_mfma_f32_16x16x32_bf16(vf, pf[s2], o, 0, 0, 0); }
                f32x4 tf = (f32x4){0.f, 0.f, 0.f, 0.f}, tb = (f32x4){0.f, 0.f, 0.f, 0.f};
#pragma unroll
                for (int ks = 0; ks < 2; ++ks) { const bf16x8 sf = *(const LAS bf16x8*)(SF + (16 * vb + l15) * 144 + (32 * ks + 8 * g) * 2);
                    const bf16x8 sb = *(const LAS bf16x8*)(SB + (16 * vb + l15) * 144 + (32 * ks + 8 * g) * 2);
                    tf = __builtin_amdgcn_mfma_f32_16x16x32_bf16(sf, qf[ks], tf, 0, 0, 0); tb = __builtin_amdgcn_mfma_f32_16x16x32_bf16(sb, qf[ks], tb, 0, 0, 0); }
                accO[vb] = o + tf * decf + tb * decb; __builtin_amdgcn_sched_barrier(0); }
            float sm = 0.f;
#pragma unroll
            for (int vb = 0; vb < 8; ++vb) sm += (accO[vb].x + accO[vb].y) + (accO[vb].z + accO[vb].w);
            sm += __shfl_xor(sm, 16); sm += __shfl_xor(sm, 32);
            const float mu = sm * (1.f / 128.f); float sq = 0.f;
#pragma unroll
            for (int vb = 0; vb < 8; ++vb) { accO[vb] = accO[vb] - mu; sq += (accO[vb].x * accO[vb].x + accO[vb].y * accO[vb].y) + (accO[vb].z * accO[vb].z + accO[vb].w * accO[vb].w); }
            sq += __shfl_xor(sq, 16); sq += __shfl_xor(sq, 32);
            const float rstd = 1.0f / sqrtf(sq * (1.f / 128.f) + EPS);
            __syncthreads();
#pragma unroll
            for (int vb = 0; vb < 8; ++vb) { const f32x4 gw = *(const f32x4*)(F.gn_w + h * 128 + 16 * vb + 4 * g); const f32x4 o = accO[vb] * rstd * gw;
                u32x2 ow; ow.x = cvt_pk_bf16(o.x, o.y); ow.y = cvt_pk_bf16(o.z, o.w);
                *(LAS u32x2*)(VI + il * 288 + (16 * vb + 4 * g) * 2) = ow; }
            __syncthreads();
            { const size_t go = (tok0 + row) * 1024 + h * 128 + seg * 32;
#pragma unroll
                for (int i = 0; i < 4; ++i) { const u32x4 o = *(const LAS u32x4*)(VI + row * 288 + seg * 64 + 16 * i); const u32x4 z = *(const u32x4*)(F.SZB + go + 8 * i);
                    u32x4 r;
#pragma unroll
                    for (int e = 0; e < 4; ++e) r[e] = cvt_pk_bf16(bflo(o[e]) * siluf(bflo(z[e])), bfhi(o[e]) * siluf(bfhi(z[e])));
                    *(u32x4*)(F.UB + go + 8 * i) = r; } }
            __syncthreads();
        }
    }
}
struct SchedSq { int G, c; DI bool next(int i, pg8::Unit& u) const { const int L = i * G + c; if (L >= 256) return false; pg8::tile_of(L, 64, 4, u); return true; } };
struct EpiAB {
    const bf16_t* R; const bf16_t* SGB; bf16_t* MM;
    DI int vm_ops(const pg8::Unit&) const { return 0; }
    DI void mid(f32x4 (&acc)[2][2][4][2], const pg8::Unit& u, int wr, int wc, int fr, int fq) const { apply<false>(acc, u, wr, wc, fr, fq); }
    DI void operator()(const f32x4 (&acc)[2][2][4][2], const pg8::Unit& u, int wr, int wc, int fr, int fq) const { apply<true>(const_cast<f32x4 (&)[2][2][4][2]>(acc), u, wr, wc, fr, fq); }
    template <bool FIN> DI void apply(f32x4 (&acc)[2][2][4][2], const pg8::Unit& u, int wr, int wc, int fr, int fq) const {
        const bf16_t* src = FIN ? SGB : R;
        const size_t base = (size_t)(u.pm * 256 + wr * 64 + fr) * 1024 + u.pn * 256 + wc * 32 + 8 * fq;
#pragma unroll
        for (int am = 0; am < 4; ++am) { const int ai = am >> 1;
            u32x4 gv[4][2];
#pragma unroll
            for (int m = 2 * (am & 1); m < 2 * (am & 1) + 2; ++m)
#pragma unroll
                for (int bj = 0; bj < 2; ++bj) gv[m][bj] = *(const u32x4*)(src + base + (size_t)(ai * 128 + m * 16) * 1024 + bj * 128);
#pragma unroll
            for (int m = 2 * (am & 1); m < 2 * (am & 1) + 2; ++m)
#pragma unroll
                for (int bj = 0; bj < 2; ++bj) { const u32x4 gq = gv[m][bj];
                    f32x4 a = acc[ai][bj][m][0], b = acc[ai][bj][m][1];
                    a.x *= bflo(gq.x); a.y *= bfhi(gq.x); a.z *= bflo(gq.y); a.w *= bfhi(gq.y); b.x *= bflo(gq.z); b.y *= bfhi(gq.z); b.z *= bflo(gq.w); b.w *= bfhi(gq.w);
                    if (FIN) { u32x4 w; w.x = cvt_pk_bf16(a.x, a.y); w.y = cvt_pk_bf16(a.z, a.w); w.z = cvt_pk_bf16(b.x, b.y); w.w = cvt_pk_bf16(b.z, b.w);
                        *(u32x4*)(MM + base + (size_t)(ai * 128 + m * 16) * 1024 + bj * 128) = w; }
                    else { acc[ai][bj][m][0] = a; acc[ai][bj][m][1] = b; } }
            asm volatile("" ::: "memory");
        }
    }
};
struct EpiOut {
    const float* x; const float* MOD; float* out;
    DI int vm_ops(const pg8::Unit&) const { return 0; }
    DI void mid(f32x4 (&)[2][2][4][2], const pg8::Unit&, int, int, int, int) const {}
    DI void operator()(const f32x4 (&acc)[2][2][4][2], const pg8::Unit& u, int wr, int wc, int fr, int fq) const {
        const int col0 = u.pn * 256 + wc * 32 + 8 * fq; const float* gp = MOD + (u.pm >> 4) * 3072 + 2048 + col0;
        f32x4 gx[2][2];
#pragma unroll
        for (int bj = 0; bj < 2; ++bj)
#pragma unroll
            for (int n = 0; n < 2; ++n) gx[bj][n] = *(const f32x4*)(gp + bj * 128 + 4 * n);
#pragma unroll
        for (int ai = 0; ai < 2; ++ai)
#pragma unroll
            for (int m = 0; m < 4; ++m) { const size_t off = (size_t)(u.pm * 256 + ai * 128 + wr * 64 + m * 16 + fr) * 1024 + col0;
#pragma unroll
                for (int bj = 0; bj < 2; ++bj)
#pragma unroll
                    for (int n = 0; n < 2; ++n) { const f32x4 xv = *(const f32x4*)(x + off + bj * 128 + 4 * n); *(f32x4*)(out + off + bj * 128 + 4 * n) = xv + gx[bj][n] * acc[ai][bj][m][n]; }
                if (m & 1) asm volatile("" ::: "memory"); }
    }
};
struct EpiOutNorm {
    const float* x; const float* MOD; float* out; const float* fw; float* slots; unsigned* cnt; LAS float* tab;
    DI int vm_ops(const pg8::Unit&) const { return 0; }
    DI void mid(f32x4 (&)[2][2][4][2], const pg8::Unit&, int, int, int, int) const {}
    DI void operator()(const f32x4 (&acc_)[2][2][4][2], const pg8::Unit& u, int wr, int wc, int fr, int fq) const {
        f32x4 (&acc)[2][2][4][2] = const_cast<f32x4 (&)[2][2][4][2]>(acc_);
        const int col0 = u.pn * 256 + wc * 32 + 8 * fq; const float* gp = MOD + (u.pm >> 4) * 3072 + 2048 + col0;
        f32x4 gx[2][2];
#pragma unroll
        for (int bj = 0; bj < 2; ++bj)
#pragma unroll
            for (int n = 0; n < 2; ++n) gx[bj][n] = *(const f32x4*)(gp + bj * 128 + 4 * n);
#pragma unroll
        for (int ai = 0; ai < 2; ++ai)
#pragma unroll
            for (int m = 0; m < 4; ++m) { const int row = u.pm * 256 + ai * 128 + wr * 64 + m * 16 + fr; const size_t off = (size_t)row * 1024 + col0; float ss = 0.f;
#pragma unroll
                for (int bj = 0; bj < 2; ++bj)
#pragma unroll
                    for (int n = 0; n < 2; ++n) { const f32x4 xv = *(const f32x4*)(x + off + bj * 128 + 4 * n); const f32x4 v = xv + gx[bj][n] * acc[ai][bj][m][n]; acc[ai][bj][m][n] = v;
                        ss += (v.x * v.x + v.y * v.y) + (v.z * v.z + v.w * v.w); }
                ss += __shfl_xor(ss, 16); ss += __shfl_xor(ss, 32);
                if (fq == 0) __hip_atomic_store(slots + (size_t)row * 16 + u.pn * 4 + wc, ss, __ATOMIC_RELAXED, __HIP_MEMORY_SCOPE_AGENT);
                if (m & 1) asm volatile("" ::: "memory"); }
        asm volatile("s_waitcnt vmcnt(0)" ::: "memory");
        __syncthreads();
        if (threadIdx.x == 0) {
            unsigned* c = cnt + 64 * u.pm;
            __hip_atomic_fetch_add(c, 1u, __ATOMIC_RELAXED, __HIP_MEMORY_SCOPE_AGENT);
            unsigned sp = 0;
            while (__hip_atomic_load(c, __ATOMIC_RELAXED, __HIP_MEMORY_SCOPE_AGENT) < 4u) { __builtin_amdgcn_s_sleep(1); if (++sp > (1u << 22)) break; }
            __builtin_amdgcn_fence(__ATOMIC_ACQUIRE, "agent");
            asm volatile("s_waitcnt vmcnt(0)" ::: "memory");
        }
        __syncthreads();
        { const int t = threadIdx.x, row = t >> 1, half = t & 1; const float* sp = slots + (size_t)(u.pm * 256 + row) * 16 + half * 8; float s = 0.f;
#pragma unroll
            for (int j = 0; j < 8; ++j) s += __hip_atomic_load(sp + j, __ATOMIC_RELAXED, __HIP_MEMORY_SCOPE_AGENT);
            s += __shfl_xor(s, 1);
            if (half == 0) tab[row] = 1.0f / sqrtf(s * (1.f / 1024.f) + EPS); }
        __syncthreads();
        f32x4 fv[2][2];
#pragma unroll
        for (int bj = 0; bj < 2; ++bj)
#pragma unroll
            for (int n = 0; n < 2; ++n) fv[bj][n] = *(const f32x4*)(fw + col0 + bj * 128 + 4 * n);
#pragma unroll
        for (int ai = 0; ai < 2; ++ai)
#pragma unroll
            for (int m = 0; m < 4; ++m) { const int rl = ai * 128 + wr * 64 + m * 16 + fr; const float r = tab[rl]; const size_t off = (size_t)(u.pm * 256 + rl) * 1024 + col0;
#pragma unroll
                for (int bj = 0; bj < 2; ++bj)
#pragma unroll
                    for (int n = 0; n < 2; ++n) *(f32x4*)(out + off + bj * 128 + 4 * n) = acc[ai][bj][m][n] * r * fv[bj][n]; }
    }
};
DI void n6_ab(const Ctx& F) {
    const Tid T = opaque_tid();
    const size_t NT = (size_t)gridDim.x * 512, gt = (size_t)blockIdx.x * 512 + T.tid;
    for (size_t idx = gt; idx < (size_t)(MTOK / 4) * 1024; idx += NT) {
        const int n = (int)(idx & 1023), t0 = (int)(idx >> 10) * 4; float ya[4] = {0.f, 0.f, 0.f, 0.f}, yb[4] = {0.f, 0.f, 0.f, 0.f};
        for (int k = 0; k < 1024; ++k) { const float wa = F.w_a[(size_t)k * 1024 + n], wb = F.w_b[(size_t)k * 1024 + n];
#pragma unroll
            for (int j = 0; j < 4; ++j) { ya[j] += bf2f(F.P[(size_t)(t0 + j) * 1024 + k]) * wa; yb[j] += bf2f(F.UB[(size_t)(t0 + j) * 1024 + k]) * wb; } }
#pragma unroll
        for (int j = 0; j < 4; ++j) { const size_t o = (size_t)(t0 + j) * 1024 + n; const float sgb = bf2f(F.SGB[o]), sga = bf2f(F.R[o]) * sgb; F.MM[o] = f2bf(sga * ya[j] + sgb * yb[j]); }
    }
}
DI void n7_out(const Ctx& F) {
    const Tid T = opaque_tid();
    const size_t NT = (size_t)gridDim.x * 512, gt = (size_t)blockIdx.x * 512 + T.tid;
    for (size_t idx = gt; idx < (size_t)(MTOK / 4) * 1024; idx += NT) {
        const int n = (int)(idx & 1023), t0 = (int)(idx >> 10) * 4; float y[4] = {0.f, 0.f, 0.f, 0.f};
        for (int k = 0; k < 1024; ++k) { const float w = F.w_out[(size_t)k * 1024 + n];
#pragma unroll
            for (int j = 0; j < 4; ++j) y[j] += bf2f(F.MM[(size_t)(t0 + j) * 1024 + k]) * w; }
#pragma unroll
        for (int j = 0; j < 4; ++j) { const size_t o = (size_t)(t0 + j) * 1024 + n; F.out[o] = F.x[o] + F.MOD[((t0 + j) >> 12) * 3072 + 2048 + n] * y[j]; }
    }
}
DI void p8_final(const Ctx& F) {
    const Tid T = opaque_tid();
    const int gw = blockIdx.x * 8 + T.wave, NGW = gridDim.x * 8;
    for (int m = gw; m < MTOK; m += NGW) {
        f32x4* xr = (f32x4*)(F.out + (size_t)m * DM);
        f32x4 v[4]; float ss = 0.f;
#pragma unroll
        for (int j = 0; j < 4; ++j) { v[j] = xr[T.lane + 64 * j]; ss += (v[j].x * v[j].x + v[j].y * v[j].y) + (v[j].z * v[j].z + v[j].w * v[j].w); }
        const float rstd = 1.0f / sqrtf(wave_sum(ss) * (1.f / DM) + EPS);
#pragma unroll
        for (int j = 0; j < 4; ++j) { const f32x4 w = *(const f32x4*)(F.final_w + 4 * (T.lane + 64 * j)); xr[T.lane + 64 * j] = v[j] * rstd * w; }
    }
}

constexpr int NPH = 9;
__global__ void __launch_bounds__(512, 2) fwd_kernel(Args args) {
    extern __shared__ __attribute__((aligned(16))) unsigned char lds_raw[];
    Ctx F;
    F.lds = (LAS unsigned char*)lds_raw;
    if (threadIdx.x < 16) ((LAS unsigned*)(F.lds + LDS_MISC))[threadIdx.x] = 0u;
    __syncthreads();
    const XcdBarrier bar = xcd_barrier_post((unsigned*)(args.ws + WS_BAR), (volatile LAS unsigned*)(F.lds + LDS_MISC));
    F.x = args.in[0]; F.c = args.in[1]; F.ctx = args.in[2]; F.c_ctx = args.in[3]; F.norm_w = args.in[4]; F.ada_w = args.in[5]; F.ada_b = args.in[6]; F.w_in = args.in[7];
    F.conv_w = args.in[8]; F.conv_b = args.in[9]; F.decay_logit = args.in[10]; F.gn_w = args.in[11]; F.w_a = args.in[12]; F.w_b = args.in[13]; F.w_out = args.in[14]; F.final_w = args.in[15];
    F.out = args.out; unsigned char* ws = args.ws; F.ws = ws;
    F.MOD = (float*)(ws + WS_MOD); F.ROPE = (f32x2*)(ws + WS_ROPE);
    F.WA = (bf16_t*)(ws + WS_WA); F.WB = (bf16_t*)(ws + WS_WB); F.WOUT = (bf16_t*)(ws + WS_WOUT); F.WIN = (bf16_t*)(ws + WS_WIN); F.XM = (bf16_t*)(ws + WS_XM);
    F.KV = (bf16_t*)(ws + WS_KV); F.KVC = (bf16_t*)(ws + WS_KVC); F.HC = (bf16_t*)(ws + WS_HC); F.ST = (bf16_t*)(ws + WS_ST); F.MM = (bf16_t*)(ws + WS_MM);
    F.P = (bf16_t*)(ws + WS_P); F.Q = (bf16_t*)(ws + WS_Q); F.K = (bf16_t*)(ws + WS_K); F.V = (bf16_t*)(ws + WS_V); F.SZB = (bf16_t*)(ws + WS_SZB);
    F.KC = (bf16_t*)(ws + WS_KC); F.VC = (bf16_t*)(ws + WS_VC); F.UB = (bf16_t*)(ws + WS_UB);
    F.R = (bf16_t*)args.out; F.SGB = (bf16_t*)args.out + (size_t)MTOK * DM;
    F.RET = (float*)(ws + WS_RET); F.S0 = (float*)(ws + WS_KVC);
    const int lo = args.ph_lo, hi = args.ph_hi; const unsigned naive = args.naive;
#define IN(k) (lo <= (k) && (k) < hi && ((MK_PHASES >> (k)) & 1))
#define NAIVE(k) (((naive & MK_NAIVE_AVAIL) >> (k)) & 1u)
#define SEAM(k) do { if (IN(k) && IN((k) + 1)) xcd_barrier(bar); } while (0)
#define REP(k) for (int rep_ = 0; rep_ < 1 + (int)((MK_REP_MASK >> (k)) & 1u); ++rep_)
    if (IN(0)) REP(0) { p0_prologue(F); } SEAM(0);
    if (IN(1)) REP(1) { p1_rows(F); } SEAM(1);
    if (IN(2)) REP(2) {
        if (NAIVE(2)) n2_inproj(F);
        else { const char* const Ab[2] = {(const char*)F.XM, (const char*)F.XM}; const char* const Bb[2] = {(const char*)F.WIN, (const char*)F.WIN};
            Sched1 S{(int)gridDim.x, (int)blockIdx.x}; Epi1 E{F.ws, F.R, F.SGB, F.ROPE};
            pg8::gemm_phase<1, Epi1, Sched1>(F.lds, Ab, Bb, S, E); }
    } SEAM(2);
    if (IN(3)) {
        if (!NAIVE(3)) {
            const char* const Ab[2] = {(const char*)F.XM, (const char*)F.XM}; const char* const Bb[2] = {(const char*)F.WIN, (const char*)F.WIN};
            SchedCtx S{(int)blockIdx.x}; Epi1 E{F.ws, F.R, F.SGB, F.ROPE};
            pg8::gemm_phase<1, Epi1, SchedCtx>(F.lds, Ab, Bb, S, E);
            if (blockIdx.x >= 24) { REP(3) p3_kv(F, blockIdx.x - 24, 1024, gridDim.x - 24); p3_ua(F, blockIdx.x - 24, gridDim.x - 24); }
        } else p3_ua(F, blockIdx.x, gridDim.x);
    } SEAM(3);
    if (IN(4)) REP(4) { if (NAIVE(4)) n4_recurrence(F); else { if (blockIdx.x >= gridDim.x - 32) p4_ctx_state(F, blockIdx.x - (gridDim.x - 32)); else p4_scan(F, blockIdx.x, gridDim.x - 32); } } SEAM(4);
    if (IN(5)) REP(5) { if (NAIVE(5)) n5_groupnorm(F); else p5_ret(F); } SEAM(5);
    if (IN(6)) REP(6) {
        if (NAIVE(6)) n6_ab(F);
        else { const char* const Ab[2] = {(const char*)F.P, (const char*)F.UB}; const char* const Bb[2] = {(const char*)F.WA, (const char*)F.WB};
            SchedSq S{(int)gridDim.x, (int)blockIdx.x}; EpiAB E{F.R, F.SGB, F.MM};
            pg8::gemm_phase<2, EpiAB, SchedSq>(F.lds, Ab, Bb, S, E); }
    } SEAM(6);
    if (IN(7)) {
        const char* const Ab[2] = {(const char*)F.MM, (const char*)F.MM}; const char* const Bb[2] = {(const char*)F.WOUT, (const char*)F.WOUT};
        SchedSq S{(int)gridDim.x, (int)blockIdx.x};
        if (NAIVE(7)) n7_out(F);
        else if (gridDim.x == 256) {
            EpiOutNorm E{F.x, F.MOD, F.out, F.final_w, (float*)(F.ws + WS_SLOTS), (unsigned*)(F.ws + WS_PCNT), (LAS float*)(F.lds + LDS_TAB)};
            pg8::gemm_phase<1, EpiOutNorm, SchedSq>(F.lds, Ab, Bb, S, E); }
        else { EpiOut E{F.x, F.MOD, F.out}; pg8::gemm_phase<1, EpiOut, SchedSq>(F.lds, Ab, Bb, S, E); }
    }
    if (NAIVE(7) || gridDim.x != 256) { SEAM(7); if (IN(8)) { p8_final(F); } }
#undef IN
#undef NAIVE
#undef SEAM
}

extern "C" void kernel_launch(void* const* d_in, const int* in_sizes, int n_in, void* d_out, int out_size, void* d_ws, size_t ws_size, hipStream_t stream) {
    static int grid = 0;
    if (grid == 0) {
        if (n_in != 16 || out_size != MTOK * DM || ws_size < WS_END) { fprintf(stderr, "kernel_launch: unexpected shapes (n_in %d out %d ws %zu)\n", n_in, out_size, ws_size); grid = -1; return; }
        int dev = 0, cus = 0, per_cu = 0;
        hipGetDevice(&dev); hipDeviceGetAttribute(&cus, hipDeviceAttributeMultiprocessorCount, dev);
        hipFuncSetAttribute((const void*)fwd_kernel, hipFuncAttributeMaxDynamicSharedMemorySize, LDS_BYTES);
        hipOccupancyMaxActiveBlocksPerMultiprocessor(&per_cu, (const void*)fwd_kernel, 512, LDS_BYTES);
        if (per_cu < 1) { fprintf(stderr, "kernel_launch: occupancy query says %d blocks/CU\n", per_cu); per_cu = 1; }
        grid = cus;
        (void)hipGetLastError();
    }
    if (grid < 0) return;
    Args a{};
    for (int i = 0; i < 16; ++i) a.in[i] = (const float*)d_in[i];
    a.out = (float*)d_out; a.ws = (unsigned char*)d_ws; a.naive = MK_NAIVE_MASK;
    hipMemsetAsync((unsigned char*)d_ws + WS_BAR, 0, WS_BAR_BYTES, stream);
#if MK_LAUNCH_PER_PHASE
    for (int ph = 0; ph < NPH; ++ph) { a.ph_lo = ph; a.ph_hi = ph + 1; hipLaunchKernelGGL(fwd_kernel, dim3(grid), dim3(512), LDS_BYTES, stream, a); }
#else
    a.ph_lo = 0; a.ph_hi = NPH;
    hipLaunchKernelGGL(fwd_kernel, dim3(grid), dim3(512), LDS_BYTES, stream, a);
#endif
}
```

```cpp
#include <hip/hip_runtime.h>
#include <cstdio>
#include <cstdint>

#ifndef MK_LAUNCH_PER_PHASE
#define MK_LAUNCH_PER_PHASE 0
#endif
#ifndef MK_NAIVE_MASK
#define MK_NAIVE_MASK 0x00u
#endif

#ifndef MK_REP_MASK
#define MK_REP_MASK 0u
#endif
#ifndef MK_PHASES
#define MK_PHASES 0x1ff
#endif
#ifndef MK_NAIVE_AVAIL
#define MK_NAIVE_AVAIL 0xffu
#endif
#define DI __device__ __forceinline__
#define LAS __attribute__((address_space(3)))
typedef unsigned short bf16_t;
typedef float f32x4 __attribute__((ext_vector_type(4)));
typedef float f32x2 __attribute__((ext_vector_type(2)));
typedef unsigned u32x4 __attribute__((ext_vector_type(4)));
typedef unsigned u32x2 __attribute__((ext_vector_type(2)));
typedef short bf16x8 __attribute__((ext_vector_type(8)));
typedef short s16x4 __attribute__((ext_vector_type(4)));
typedef short v4i16_t __attribute__((ext_vector_type(4)));

constexpr int NB = 4, SEQ = 4096, DM = 1024, MTOK = NB * SEQ, CTXL = 256, MCTX = NB * CTXL, MALL = MTOK + MCTX;
constexpr int NIN = 9216, NH = 8, DK = 64, DV = 128, CHK = 128, NCHK = SEQ / CHK;
constexpr float EPS = 1e-6f;
constexpr size_t MiB = 1u << 20;
constexpr size_t WS_MOD = 0;
constexpr size_t WS_ROPE = 65536;
constexpr size_t WS_WA = 2 * MiB, WS_WB = 4 * MiB, WS_WOUT = 6 * MiB, WS_WIN = 8 * MiB;
constexpr size_t WS_XM = 26 * MiB;
constexpr size_t WS_KV = 223 * MiB;
constexpr size_t WS_KVC = 40 * MiB;
constexpr size_t WS_RET = 8 * MiB;
constexpr size_t WS_HC = 60 * MiB;
constexpr size_t WS_ST = 60 * MiB;
constexpr size_t WS_MM = 60 * MiB;
constexpr size_t WS_P = 92 * MiB;
constexpr size_t WS_Q = 124 * MiB, WS_K = 140 * MiB, WS_V = 156 * MiB, WS_SZB = 188 * MiB;
constexpr size_t WS_KC = 220 * MiB, WS_VC = 221 * MiB;
constexpr size_t WS_UB = 223 * MiB;
constexpr size_t WS_END = 255 * MiB;
constexpr int LDS_BYTES = 147456;
constexpr int LDS_MISC = 139264;
constexpr size_t WS_BAR = 131072, WS_BAR_BYTES = 65536;
constexpr size_t WS_PCNT = WS_BAR + 16384, WS_SLOTS = 1 * MiB;
constexpr int LDS_TAB = 132096;

DI float bf2f(bf16_t v) { return __uint_as_float((unsigned)v << 16); }
DI float bflo(unsigned w) { return __uint_as_float(w << 16); }
DI float bfhi(unsigned w) { return __uint_as_float(w & 0xffff0000u); }
typedef __bf16 bf16x2_t __attribute__((ext_vector_type(2)));
DI unsigned cvt_pk_bf16(float lo, float hi) { const f32x2 f = {lo, hi}; const bf16x2_t v = __builtin_convertvector(f, bf16x2_t); return __builtin_bit_cast(unsigned, v); }
DI bf16_t f2bf(float f) { return (bf16_t)(cvt_pk_bf16(f, 0.f) & 0xffffu); }
DI float wave_sum(float v) {
#pragma unroll
    for (int o = 1; o < 64; o <<= 1) v += __shfl_xor(v, o);
    return v;
}
struct Tid { int tid, lane, wave; };
DI Tid opaque_tid() { int t = threadIdx.x; asm volatile("" : "+v"(t)); Tid r; r.tid = t; r.lane = t & 63; r.wave = __builtin_amdgcn_readfirstlane(t >> 6); return r; }
DI float siluf(float x) { return x * __builtin_amdgcn_rcpf(1.f + __expf(-x)); }
DI float log2_gamma(const float* decay_logit, int dir, int h) {
    const float x = decay_logit[dir * NH + h];
    const float ls = fminf(x, 0.f) - log1pf(expf(-fabsf(x)));
    return ls * 1.4426950408889634f;
}

namespace pg8 {
constexpr int BM = 256, BK = 64, HALF = 128, HTB = HALF * BK * 2, STAGE_BYTES = 8 * HTB, NXCD = 8, WGM = 4;
DI int lds_byte(int r, int c) { const int st = (r >> 4) * 2 + (c >> 5), rr = r & 15, cc = c & 31, ob = rr * 64 + cc * 2; return st * 1024 + (ob ^ (((ob >> 9) & 1) << 5)); }
DI void stage_rc(int b, int& R, int& C) { const int st = b / 1024, sb = b % 1024, swz = sb ^ (((sb >> 9) & 1) << 5); R = (st >> 1) * 16 + swz / 64; C = (st & 1) * 32 + (swz % 64) / 2; }
DI int perm32(int rho) { const int n = rho >> 4, i = rho & 15; return 8 * (i >> 2) + 4 * n + (i & 3); }
struct Unit { int pm, pn; };
DI void tile_of(int L, int nM, int nN, Unit& u) {
    const int nwg = nM * nN; int wgid = L;
    { const int q = nwg / NXCD, r = nwg % NXCD, xcd = wgid % NXCD, off = wgid / NXCD; wgid = (xcd < r ? xcd * (q + 1) : r * (q + 1) + (xcd - r) * q) + off; }
    const int nig = WGM * nN, gid = wgid / nig, fm = gid * WGM, gsz = (nM - fm) < WGM ? (nM - fm) : WGM;
    u.pm = fm + ((wgid % nig) % gsz); u.pn = (wgid % nig) / gsz;
}
template <int NSEG, class Epi, class Sched>
DI void gemm_phase(LAS unsigned char* lds, const char* const (&Ab)[2], const char* const (&Bb)[2], const Sched& S, const Epi& E) {
    constexpr int K = 1024, NTS = K / BK;
    constexpr int nt = NSEG * NTS;
    const Tid T = opaque_tid();
    const int tid = T.tid, wid = T.wave, lane = T.lane, wr = wid >> 2, wc = (wid & 3) ^ (wr << 1), fr = lane & 15, fq = lane >> 4;
    unsigned voffA[2], voffB[2];
#pragma unroll
    for (int i = 0; i < 2; ++i) { int R, C; stage_rc(tid * 16 + i * 8192, R, C); const int Rb = (R & ~31) + perm32(R & 31);
        voffA[i] = (unsigned)(R * K + C) * 2u; voffB[i] = (unsigned)(Rb * K + C) * 2u; }
    constexpr size_t kstep = (size_t)(BK * 2);
    constexpr size_t hstep = (size_t)HALF * K * 2;
    constexpr size_t tstep = 2 * hstep;
    const unsigned ldsw = (unsigned)wid * 1024u;
    const int aoff = lds_byte(wr * 64 + fr, fq * 8), boff = lds_byte(wc * 32 + fr, fq * 8);
#define PG8_SA(b, h) (((b) * 2 + (h)) * HTB)
#define PG8_SB(b, h) ((4 + (b) * 2 + (h)) * HTB)
#define PG8_STAGE(bufoff, gbase, voff) do { _Pragma("unroll") for (int _i = 0; _i < 2; ++_i) \
        __builtin_amdgcn_global_load_lds((const unsigned*)((const char*)(gbase) + (voff)[_i]), (LAS unsigned*)(lds + (bufoff) + ldsw + _i * 8192), 16, 0, 0); } while (0)
#define PG8_LDA(dst, b, h) do { _Pragma("unroll") for (int m = 0; m < 4; ++m) _Pragma("unroll") for (int k = 0; k < 2; ++k) dst[m][k] = *(const LAS bf16x8*)(lds + PG8_SA(b, h) + aoff + m * 2048 + k * 1024); } while (0)
#define PG8_LDB(dst, b, h) do { _Pragma("unroll") for (int n = 0; n < 2; ++n) _Pragma("unroll") for (int k = 0; k < 2; ++k) dst[n][k] = *(const LAS bf16x8*)(lds + PG8_SB(b, h) + boff + n * 2048 + k * 1024); } while (0)
#define PG8_MMA(ai, bj, At, Bt) do { __builtin_amdgcn_s_setprio(1); _Pragma("unroll") for (int m = 0; m < 4; ++m) _Pragma("unroll") for (int n = 0; n < 2; ++n) _Pragma("unroll") for (int k = 0; k < 2; ++k) \
        acc[ai][bj][m][n] = __builtin_amdgcn_mfma_f32_16x16x32_bf16(Bt[n][k], At[m][k], acc[ai][bj][m][n], 0, 0, 0); __builtin_amdgcn_s_setprio(0); } while (0)
#define PG8_WAIT_V(n) asm volatile("s_waitcnt vmcnt(" #n ")" ::: "memory")
#define PG8_WAIT_L(n) asm volatile("s_waitcnt lgkmcnt(" #n ")" ::: "memory")
#define PG8_WAIT_VR(sel) asm volatile("s_cmp_lt_i32 %0, 8\n\ts_cbranch_scc1 .Lw8_%=\n\ts_cmp_lt_i32 %0, 16\n\ts_cbranch_scc1 .Lw16_%=\n\ts_waitcnt vmcnt(24)\n\ts_branch .Lwe_%=\n.Lw16_%=:\n\ts_waitcnt vmcnt(16)\n\ts_branch .Lwe_%=\n.Lw8_%=:\n\ts_waitcnt vmcnt(8)\n.Lwe_%=:" :: "s"(sel) : "memory", "scc")
#define PG8_BAR __builtin_amdgcn_s_barrier()
#define PG8_SCHED __builtin_amdgcn_sched_barrier(0)
#define PG8_TA(u, t) (Ab[(t) / NTS] + (size_t)(u).pm * tstep + (size_t)((t) % NTS) * kstep)
#define PG8_TB(u, t) (Bb[(t) / NTS] + (size_t)(u).pn * tstep + (size_t)((t) % NTS) * kstep)
    Unit cur, nxt; int ui = 0;
    if (!S.next(0, cur)) return;
    f32x4 acc[2][2][4][2];
#pragma unroll
    for (int a = 0; a < 2; ++a)
#pragma unroll
        for (int b = 0; b < 2; ++b)
#pragma unroll
            for (int m = 0; m < 4; ++m)
#pragma unroll
                for (int n = 0; n < 2; ++n) acc[a][b][m][n] = (f32x4){0.f, 0.f, 0.f, 0.f};
    bf16x8 At[4][2], B0[2][2], B1[2][2];
    {
        const char* cA = PG8_TA(cur, 0); const char* cB = PG8_TB(cur, 0);
        PG8_STAGE(PG8_SB(0, 0), cB, voffB); PG8_STAGE(PG8_SB(0, 1), cB + hstep, voffB); PG8_STAGE(PG8_SA(0, 0), cA, voffA); PG8_STAGE(PG8_SA(0, 1), cA + hstep, voffA);
        if (wr == 1) PG8_BAR;
        PG8_WAIT_V(2); PG8_BAR;
        PG8_STAGE(PG8_SB(1, 0), cB + kstep, voffB); PG8_STAGE(PG8_SA(1, 0), cA + kstep, voffA); PG8_STAGE(PG8_SB(1, 1), cB + hstep + kstep, voffB);
        PG8_WAIT_V(6); PG8_BAR;
    }
    for (;;) {
        const bool has_next = S.next(ui + 1, nxt);
        const Unit nu = has_next ? nxt : cur;
        for (int t = 0; t < nt; t += 2) {
            if (NSEG == 2 && t == NTS) E.mid(acc, cur, wr, wc, fr, fq);
            const bool last = (t == nt - 2);
            const char* a1 = PG8_TA(cur, t + 1);
            const char* a2 = last ? PG8_TA(nu, 0) : PG8_TA(cur, t + 2); const char* b2 = last ? PG8_TB(nu, 0) : PG8_TB(cur, t + 2);
            const char* a3 = a2 + kstep; const char* b3 = b2 + kstep;
            PG8_LDB(B0, 0, 0); PG8_LDB(B1, 0, 1); PG8_SCHED; PG8_LDA(At, 0, 0); PG8_STAGE(PG8_SA(1, 1), a1 + hstep, voffA);
            PG8_WAIT_V(8); PG8_WAIT_L(0); PG8_BAR; PG8_MMA(0, 0, At, B0); PG8_MMA(0, 1, At, B1); PG8_BAR; PG8_SCHED;
            PG8_LDA(At, 0, 1); PG8_STAGE(PG8_SB(0, 0), b2, voffB); PG8_STAGE(PG8_SB(0, 1), b2 + hstep, voffB); PG8_STAGE(PG8_SA(0, 0), a2, voffA);
            PG8_WAIT_V(8); PG8_WAIT_L(0); PG8_BAR; PG8_MMA(1, 0, At, B0); PG8_MMA(1, 1, At, B1); PG8_BAR; PG8_SCHED;
            PG8_LDB(B0, 1, 0); PG8_LDB(B1, 1, 1); PG8_SCHED; PG8_LDA(At, 1, 0); PG8_STAGE(PG8_SA(0, 1), a2 + hstep, voffA);
            PG8_WAIT_V(8); PG8_WAIT_L(0); PG8_BAR; PG8_MMA(0, 0, At, B0); PG8_MMA(0, 1, At, B1); PG8_BAR; PG8_SCHED;
            PG8_LDA(At, 1, 1); PG8_STAGE(PG8_SB(1, 0), b3, voffB); PG8_STAGE(PG8_SB(1, 1), b3 + hstep, voffB); PG8_STAGE(PG8_SA(1, 0), a3, voffA);
            PG8_WAIT_V(8); PG8_WAIT_L(0); PG8_BAR; PG8_MMA(1, 0, At, B0); PG8_MMA(1, 1, At, B1); PG8_BAR; PG8_SCHED;
        }
        if (wr == 0) PG8_BAR;
        E(acc, cur, wr, wc, fr, fq);
        if (!has_next) break;
#pragma unroll
        for (int a = 0; a < 2; ++a)
#pragma unroll
            for (int b = 0; b < 2; ++b)
#pragma unroll
                for (int m = 0; m < 4; ++m)
#pragma unroll
                    for (int n = 0; n < 2; ++n) acc[a][b][m][n] = (f32x4){0.f, 0.f, 0.f, 0.f};
        cur = nxt; ++ui;
        if (wr == 1) PG8_BAR;
    }
    PG8_WAIT_V(0);
    PG8_BAR;
#undef PG8_SA
#undef PG8_SB
#undef PG8_STAGE
#undef PG8_LDA
#undef PG8_LDB
#undef PG8_MMA
#undef PG8_WAIT_V
#undef PG8_WAIT_L
#undef PG8_WAIT_VR
#undef PG8_BAR
#undef PG8_SCHED
#undef PG8_TA
#undef PG8_TB
}
}


#define XB_TMO      128
#define XB_XCNT(j)  (256  + 64 * (j))
#define XB_XSUB(j)  (1280 + 64 * (j))
#define XB_XGEN(j)  (2304 + 64 * (j))
#define XB_TOP      3328
#define XB_TOPGEN   3392
#define XCD_BAR_WORDS 3456
#define XB_SPIN_CAP (1u << 18)
DI unsigned xb_ld(unsigned* p)              { return __hip_atomic_load(p, __ATOMIC_RELAXED, __HIP_MEMORY_SCOPE_AGENT); }
DI unsigned xb_add(unsigned* p, unsigned v) { return __hip_atomic_fetch_add(p, v, __ATOMIC_RELAXED, __HIP_MEMORY_SCOPE_AGENT); }
DI unsigned xb_xcc_id() { return (unsigned)__builtin_amdgcn_s_getreg((3 << 11) | 20) & 0xFu; }
#define XB_SPIN(cond, bar) do { unsigned _sp = 0; while (cond) { __builtin_amdgcn_s_sleep(1); \
    if ((++_sp & 255u) == 0u) { if (xb_ld(&(bar)[XB_TMO])) break; if (_sp > XB_SPIN_CAP) { atomicAdd(&(bar)[XB_TMO], 1u); break; } } } } while (0)
struct XcdBarrier { unsigned* bar; unsigned x; volatile LAS unsigned* st; };
DI XcdBarrier xcd_barrier_post(unsigned* bar, volatile LAS unsigned* st) {
    XcdBarrier b; b.bar = bar; b.x = xb_xcc_id(); b.st = st;
    if (threadIdx.x == 0) (void)xb_add(&bar[XB_XCNT(b.x)], 1u);
    return b;
}
DI void xcd_barrier_complete(unsigned* bar, unsigned x, unsigned& nloc, unsigned& nx) {
    const unsigned G = gridDim.x * gridDim.y * gridDim.z;
    unsigned sum, cnt, mine, sp = 0u;
    for (;;) {
        sum = 0u; cnt = 0u; mine = 0u;
#pragma unroll
        for (unsigned j = 0; j < 16; ++j) { const unsigned c = xb_ld(&bar[XB_XCNT(j)]); sum += c; cnt += (c > 0u) ? 1u : 0u; mine = (j == x) ? c : mine; }
        if (sum == G) break;
        __builtin_amdgcn_s_sleep(1);
        if ((++sp & 255u) == 0u) { if (xb_ld(&bar[XB_TMO])) break; if (sp > XB_SPIN_CAP) { atomicAdd(&bar[XB_TMO], 1u); break; } }
    }
    nloc = mine > 0u ? mine : 1u; nx = cnt > 0u ? cnt : 1u;
}
DI void xcd_barrier(const XcdBarrier& b) {
    asm volatile("s_waitcnt vmcnt(0)" ::: "memory");
    __syncthreads();
    if (threadIdx.x == 0) {
        unsigned* bar = b.bar;
        __builtin_amdgcn_s_waitcnt(0);
        unsigned nloc = b.st[0], nx = b.st[1];
        if (nloc == 0u) { xcd_barrier_complete(bar, b.x, nloc, nx); b.st[0] = nloc; b.st[1] = nx; }
        const unsigned old = xb_add(&bar[XB_XSUB(b.x)], 1u);
        const unsigned gen = old / nloc;
        if (old + 1u == (gen + 1u) * nloc) {
            __builtin_amdgcn_fence(__ATOMIC_RELEASE, "agent");
            asm volatile("s_waitcnt vmcnt(0)" ::: "memory");
            const unsigned og = xb_add(&bar[XB_TOP], 1u);
            const unsigned tg = og / nx;
            if (og + 1u == (tg + 1u) * nx) xb_add(&bar[XB_TOPGEN], 1u);
            else XB_SPIN(xb_ld(&bar[XB_TOPGEN]) == tg, bar);
            __builtin_amdgcn_fence(__ATOMIC_ACQUIRE, "agent");
            xb_add(&bar[XB_XGEN(b.x)], 1u);
            asm volatile("s_waitcnt vmcnt(0)" ::: "memory");
        } else {
            XB_SPIN(xb_ld(&bar[XB_XGEN(b.x)]) == gen, bar);
            __builtin_amdgcn_fence(__ATOMIC_ACQUIRE, "agent");
            asm volatile("s_waitcnt vmcnt(0)" ::: "memory");
        }
    }
    __syncthreads();
}

struct Args { const float* in[16]; float* out; unsigned char* ws; int ph_lo, ph_hi; unsigned naive; int pad; };
struct Ctx {
    LAS unsigned char* lds;
    const float *x, *c, *ctx, *c_ctx, *norm_w, *ada_w, *ada_b, *w_in, *conv_w, *conv_b, *decay_logit, *gn_w, *w_a, *w_b, *w_out, *final_w;
    float* out; unsigned char* ws;
    float* MOD; f32x2* ROPE;
    bf16_t *WA, *WB, *WOUT, *WIN, *XM, *KV, *KVC, *HC, *ST, *MM, *P, *Q, *K, *V, *SZB, *KC, *VC, *UB, *R, *SGB;
    float* RET; float* S0;
};

DI int win_dest(int o) {
    if (o < 4096) { const int g = o >> 10, ch = o & 1023; return 256 * (ch >> 6) + 64 * g + (ch & 63); }
    if (o < 5120) { const int qk = (o - 4096) >> 9, oo = (o - 4096) & 511, head = oo >> 6, i = oo & 63, t = head >> 2, hh = head & 3;
        return 256 * (16 + 2 * qk + t) + (i < 32 ? 32 * hh + i : 128 + 32 * hh + (i - 32)); }
    if (o < 7168) return o;
    { const int gs = (o - 7168) >> 10, ch = (o - 7168) & 1023; return 256 * (28 + (ch >> 7)) + 128 * gs + (ch & 127); }
}
DI void p0_transpose_item(const float* W, int K, int N, bf16_t* WT, bool permute, LAS float* scr, int item, int lane) {
    const int nblk = N / 32, kb = item / nblk, nb = item % nblk, k0 = 64 * kb, n0 = 32 * nb;
    float rv[32];
#pragma unroll
    for (int i = 0; i < 32; ++i) rv[i] = W[(size_t)(k0 + 2 * i + (lane >> 5)) * N + n0 + (lane & 31)];
#pragma unroll
    for (int i = 0; i < 32; ++i) scr[(2 * i + (lane >> 5)) * 33 + (lane & 31)] = rv[i];
    asm volatile("s_waitcnt lgkmcnt(0)" ::: "memory");
    const int c = lane & 7; const int d0 = permute ? win_dest(n0) : n0;
#pragma unroll
    for (int j = 0; j < 4; ++j) { const int n = (lane >> 3) + 8 * j; const LAS float* s = scr + (8 * c) * 33 + n;
        u32x4 o; o.x = cvt_pk_bf16(s[0 * 33], s[1 * 33]); o.y = cvt_pk_bf16(s[2 * 33], s[3 * 33]); o.z = cvt_pk_bf16(s[4 * 33], s[5 * 33]); o.w = cvt_pk_bf16(s[6 * 33], s[7 * 33]);
        *(u32x4*)(WT + (size_t)(d0 + n) * K + k0 + 8 * c) = o; }
    asm volatile("s_waitcnt lgkmcnt(0)" ::: "memory");
}
DI void p0_prologue(const Ctx& F) {
    const Tid T = opaque_tid();
    if (blockIdx.x < 48) {
        LAS float* red = (LAS float*)F.lds;
        LAS float* sl = (LAS float*)(F.lds + 16384);
        for (int e = T.tid; e < 5 * 1024; e += 512) { const int v = e >> 10, k = e & 1023; sl[e] = siluf(v < 4 ? F.c[v * 1024 + k] : F.c_ctx[k]); }
        __syncthreads();
        const int n0 = 64 * blockIdx.x, k0 = 128 * T.wave;
        float a[5] = {0.f, 0.f, 0.f, 0.f, 0.f};
#pragma unroll 4
        for (int kb = 0; kb < 128; kb += 32) {
            float wv[32];
#pragma unroll
            for (int k = 0; k < 32; ++k) wv[k] = F.ada_w[(size_t)(k0 + kb + k) * 3072 + n0 + T.lane];
#pragma unroll
            for (int k = 0; k < 32; ++k)
#pragma unroll
                for (int v = 0; v < 5; ++v) a[v] += sl[v * 1024 + k0 + kb + k] * wv[k];
        }
#pragma unroll
        for (int v = 0; v < 5; ++v) red[(T.wave * 5 + v) * 64 + T.lane] = a[v];
        __syncthreads();
        if (T.tid < 320) { const int v = T.tid >> 6, l = T.tid & 63; float s = F.ada_b[n0 + l];
#pragma unroll
            for (int w = 0; w < 8; ++w) s += red[(w * 5 + v) * 64 + l];
            F.MOD[v * 3072 + n0 + l] = s; }
        __syncthreads();
    }
    if (blockIdx.x == 48) {
        for (int e = T.tid; e < 1024; e += 512) { const int p = e >> 4, f = e & 15; const float inv = powf(10000.f, -(float)f / 16.f); const float ang = (float)p * inv;
            F.ROPE[e] = (f32x2){cosf(ang), sinf(ang)}; }
    }
    LAS float* scr = (LAS float*)(F.lds + T.wave * 16384);
    const int gw = blockIdx.x * 8 + T.wave, NGW = gridDim.x * 8;
    constexpr int I_IN = 16 * (NIN / 32), I_SQ = 16 * 32;
    for (int it = gw; it < I_IN + 3 * I_SQ; it += NGW) {
        int r = it;
        if (r < I_IN) { p0_transpose_item(F.w_in, 1024, NIN, F.WIN, true, scr, r, T.lane); continue; } r -= I_IN;
        if (r < I_SQ) { p0_transpose_item(F.w_a, 1024, 1024, F.WA, false, scr, r, T.lane); continue; } r -= I_SQ;
        if (r < I_SQ) { p0_transpose_item(F.w_b, 1024, 1024, F.WB, false, scr, r, T.lane); continue; } r -= I_SQ;
        p0_transpose_item(F.w_out, 1024, 1024, F.WOUT, false, scr, r, T.lane);
    }
}
DI void p1_rows(const Ctx& F) {
    const Tid T = opaque_tid();
    const int gw = blockIdx.x * 8 + T.wave, NGW = gridDim.x * 8;
    constexpr int RB = 4;
    for (int m0 = gw * RB; m0 < MALL; m0 += NGW * RB) {
        f32x4 v[RB][4]; float ss[RB];
#pragma unroll
        for (int r = 0; r < RB; ++r) { const int m = m0 + r; const float* xr = m < MTOK ? F.x + (size_t)m * DM : F.ctx + (size_t)(m - MTOK) * DM;
#pragma unroll
            for (int j = 0; j < 4; ++j) v[r][j] = ((const f32x4*)xr)[T.lane + 64 * j]; }
#pragma unroll
        for (int r = 0; r < RB; ++r) { float s = 0.f;
#pragma unroll
            for (int j = 0; j < 4; ++j) s += (v[r][j].x * v[r][j].x + v[r][j].y * v[r][j].y) + (v[r][j].z * v[r][j].z + v[r][j].w * v[r][j].w);
            ss[r] = s; }
#pragma unroll
        for (int o = 1; o < 64; o <<= 1)
#pragma unroll
            for (int r = 0; r < RB; ++r) ss[r] += __shfl_xor(ss[r], o);
        const int mb = m0 < MTOK ? (m0 >> 12) : 4; const float* mod = F.MOD + mb * 3072;
#pragma unroll
        for (int j = 0; j < 4; ++j) { const int col = 4 * (T.lane + 64 * j);
            const f32x4 w = *(const f32x4*)(F.norm_w + col), sh = *(const f32x4*)(mod + col), sc = *(const f32x4*)(mod + 1024 + col);
#pragma unroll
            for (int r = 0; r < RB; ++r) { const float rstd = __builtin_amdgcn_rsqf(ss[r] * (1.f / DM) + EPS);
                const f32x4 y = (v[r][j] * rstd * w) * (sc + 1.0f) + sh;
                u32x2 o; o.x = cvt_pk_bf16(y.x, y.y); o.y = cvt_pk_bf16(y.z, y.w);
                *(u32x2*)(F.XM + (size_t)(m0 + r) * DM + col) = o; } }
    }
}
struct Sched1 {
    int G, c;
    DI bool next(int i, pg8::Unit& u) const { const int L = i * G + c; if (L >= 64 * 36) return false; pg8::tile_of(L, 64, 36, u); return true; }
};
struct SchedCtx {
    int c;
    DI bool next(int i, pg8::Unit& u) const { if (i > 0 || c >= 24) return false; u.pm = 64 + c / 6; u.pn = 18 + c % 6; return true; }
};
struct Epi1 {
    unsigned char* ws; bf16_t *R, *SGB; const f32x2* rope;
    DI int vm_ops(const pg8::Unit& u) const { return u.pn < 16 ? 8 : 16; }
    DI void mid(f32x4 (&)[2][2][4][2], const pg8::Unit&, int, int, int, int) const {}
    DI void operator()(const f32x4 (&acc)[2][2][4][2], const pg8::Unit& u, int wr, int wc, int fr, int fq) const {
        const int pn = u.pn, row0 = u.pm * 256 + wr * 64 + fr, x0 = wc * 32 + 8 * fq;
        const bool isctx = u.pm >= 64;
        if (pn < 16) {
            bf16_t* dst = (bf16_t*)(ws + (wc < 2 ? WS_HC : WS_P)) + 64 * pn + (x0 & 63);
#pragma unroll
            for (int ai = 0; ai < 2; ++ai)
#pragma unroll
                for (int m = 0; m < 4; ++m) { const size_t row = row0 + ai * 128 + m * 16;
                    f32x4 o[2];
#pragma unroll
                    for (int n = 0; n < 2; ++n) { const f32x4 a = acc[ai][0][m][n], b = acc[ai][1][m][n];
                        if (wc < 2) o[n] = a * b;
                        else { o[n].x = a.x * siluf(b.x); o[n].y = a.y * siluf(b.y); o[n].z = a.z * siluf(b.z); o[n].w = a.w * siluf(b.w); } }
                    u32x4 w; w.x = cvt_pk_bf16(o[0].x, o[0].y); w.y = cvt_pk_bf16(o[0].z, o[0].w); w.z = cvt_pk_bf16(o[1].x, o[1].y); w.w = cvt_pk_bf16(o[1].z, o[1].w);
                    *(u32x4*)(dst + row * 1024) = w; }
        } else if (pn < 20) {
            const int t = (pn - 16) & 1, isk = (pn - 16) >> 1, head = 4 * t + wc, i0 = 8 * fq;
            const float scale = isk ? 0.125f : 1.0f;
            bf16_t* base = (bf16_t*)(ws + (isk ? (isctx ? WS_KC : WS_K) : WS_Q));
#pragma unroll
            for (int ai = 0; ai < 2; ++ai)
#pragma unroll
                for (int m = 0; m < 4; ++m) { const int row = row0 + ai * 128 + m * 16; const int orow = isctx ? row - MTOK : row;
                    const int pos = row & 4095, pidx = (fq < 2) ? (pos >> 6) : (pos & 63);
                    const f32x2* rp = rope + pidx * 16 + (fq & 1) * 8;
                    float o1[8], o2[8];
#pragma unroll
                    for (int e = 0; e < 8; ++e) { f32x2 cs = rp[e]; if (isctx) cs = (f32x2){1.f, 0.f};
                        const float t1 = acc[ai][0][m][e >> 2][e & 3], t2 = acc[ai][1][m][e >> 2][e & 3];
                        o1[e] = (t1 * cs.x - t2 * cs.y) * scale; o2[e] = (t1 * cs.y + t2 * cs.x) * scale; }
                    u32x4 w1, w2; w1.x = cvt_pk_bf16(o1[0], o1[1]); w1.y = cvt_pk_bf16(o1[2], o1[3]); w1.z = cvt_pk_bf16(o1[4], o1[5]); w1.w = cvt_pk_bf16(o1[6], o1[7]);
                    w2.x = cvt_pk_bf16(o2[0], o2[1]); w2.y = cvt_pk_bf16(o2[2], o2[3]); w2.z = cvt_pk_bf16(o2[4], o2[5]); w2.w = cvt_pk_bf16(o2[6], o2[7]);
                    bf16_t* d = base + (size_t)orow * 512 + head * 64 + i0;
                    *(u32x4*)d = w1; *(u32x4*)(d + 32) = w2; }
        } else if (pn < 28) {
            const bool isz = pn >= 24;
            bf16_t* base = (bf16_t*)(ws + (isz ? WS_SZB : (isctx ? WS_VC : WS_V)));
            const int colt = 256 * (pn - (isz ? 24 : 20)) + x0;
#pragma unroll
            for (int ai = 0; ai < 2; ++ai)
#pragma unroll
                for (int m = 0; m < 4; ++m) { const int row = row0 + ai * 128 + m * 16; const int orow = isctx ? row - MTOK : row;
#pragma unroll
                    for (int bj = 0; bj < 2; ++bj) { f32x4 a = acc[ai][bj][m][0], b = acc[ai][bj][m][1];
                        u32x4 w; w.x = cvt_pk_bf16(a.x, a.y); w.y = cvt_pk_bf16(a.z, a.w); w.z = cvt_pk_bf16(b.x, b.y); w.w = cvt_pk_bf16(b.z, b.w);
                        if (isz) __builtin_nontemporal_store(w, (u32x4*)(base + (size_t)orow * 1024 + colt + bj * 128)); else *(u32x4*)(base + (size_t)orow * 1024 + colt + bj * 128) = w; } }
        } else {
            const int col = 128 * (pn - 28) + x0;
#pragma unroll
            for (int ai = 0; ai < 2; ++ai)
#pragma unroll
                for (int m = 0; m < 4; ++m) { const size_t row = row0 + ai * 128 + m * 16;
                    float rr[8], sg[8];
#pragma unroll
                    for (int e = 0; e < 8; ++e) { const float ga = acc[ai][0][m][e >> 2][e & 3], gb = acc[ai][1][m][e >> 2][e & 3];
                        const float ea = 1.f + __expf(-ga), eb = 1.f + __expf(-gb); sg[e] = __builtin_amdgcn_rcpf(eb); rr[e] = eb * __builtin_amdgcn_rcpf(ea); }
                    u32x4 w1, w2; w1.x = cvt_pk_bf16(rr[0], rr[1]); w1.y = cvt_pk_bf16(rr[2], rr[3]); w1.z = cvt_pk_bf16(rr[4], rr[5]); w1.w = cvt_pk_bf16(rr[6], rr[7]);
                    w2.x = cvt_pk_bf16(sg[0], sg[1]); w2.y = cvt_pk_bf16(sg[2], sg[3]); w2.z = cvt_pk_bf16(sg[4], sg[5]); w2.w = cvt_pk_bf16(sg[6], sg[7]);
                    __builtin_nontemporal_store(w1, (u32x4*)(R + row * 1024 + col)); __builtin_nontemporal_store(w2, (u32x4*)(SGB + row * 1024 + col)); }
        }
    }
};
DI void n2_inproj(const Ctx& F) {
    const Tid T = opaque_tid();
    const size_t NT = (size_t)gridDim.x * 512, gt = (size_t)blockIdx.x * 512 + T.tid;
    for (size_t idx = gt; idx < (size_t)(MALL / 4) * 1024; idx += NT) {
        const int ch = (int)(idx & 1023), t0 = (int)(idx >> 10) * 4;
        const bool doqk = ch < 512 && (ch & 63) < 32;
        float a[12][4];
#pragma unroll
        for (int o = 0; o < 12; ++o)
#pragma unroll
            for (int j = 0; j < 4; ++j) a[o][j] = 0.f;
        for (int k = 0; k < 1024; ++k) {
            const float* wr = F.w_in + (size_t)k * NIN;
            float xv[4];
#pragma unroll
            for (int j = 0; j < 4; ++j) xv[j] = bf2f(F.XM[(size_t)(t0 + j) * 1024 + k]);
            float w[12];
            w[0] = wr[ch]; w[1] = wr[1024 + ch]; w[2] = wr[2048 + ch]; w[3] = wr[3072 + ch]; w[4] = wr[5120 + ch]; w[5] = wr[6144 + ch]; w[6] = wr[7168 + ch]; w[7] = wr[8192 + ch];
            if (doqk) { w[8] = wr[4096 + ch]; w[9] = wr[4096 + ch + 32]; w[10] = wr[4608 + ch]; w[11] = wr[4608 + ch + 32]; } else { w[8] = w[9] = w[10] = w[11] = 0.f; }
#pragma unroll
            for (int o = 0; o < 12; ++o)
#pragma unroll
                for (int j = 0; j < 4; ++j) a[o][j] += xv[j] * w[o];
        }
#pragma unroll
        for (int j = 0; j < 4; ++j) { const int t = t0 + j;
            if (t < MTOK) {
                const size_t o = (size_t)t * 1024 + ch;
                F.HC[o] = f2bf(a[2][j] * a[0][j]); F.P[o] = f2bf(siluf(a[3][j]) * a[1][j]); F.V[o] = f2bf(a[4][j]); F.SZB[o] = f2bf(a[5][j]);
                const float sga = 1.f / (1.f + __expf(-a[6][j])), sgb = 1.f / (1.f + __expf(-a[7][j]));
                F.R[o] = f2bf(sga / sgb); F.SGB[o] = f2bf(sgb);
                if (doqk) { const int i = ch & 63, pos = t & 4095; const int pidx = i < 16 ? (pos >> 6) : (pos & 63); const f32x2 cs = F.ROPE[pidx * 16 + (i & 15)];
                    const size_t q = (size_t)t * 512 + ch;
                    F.Q[q] = f2bf(a[8][j] * cs.x - a[9][j] * cs.y); F.Q[q + 32] = f2bf(a[8][j] * cs.y + a[9][j] * cs.x);
                    F.K[q] = f2bf((a[10][j] * cs.x - a[11][j] * cs.y) * 0.125f); F.K[q + 32] = f2bf((a[10][j] * cs.y + a[11][j] * cs.x) * 0.125f); }
            } else {
                const int tc = t - MTOK;
                F.VC[(size_t)tc * 1024 + ch] = f2bf(a[4][j]);
                if (doqk) { F.KC[(size_t)tc * 512 + ch] = f2bf(a[10][j] * 0.125f); F.KC[(size_t)tc * 512 + ch + 32] = f2bf(a[11][j] * 0.125f); }
            }
        }
    }
}
DI bf16x8 tr2(const LAS unsigned char* p, int delta) {
    const s16x4 lo = __builtin_bit_cast(s16x4, __builtin_amdgcn_ds_read_tr16_b64_v4i16((LAS v4i16_t*)p));
    const s16x4 hi = __builtin_bit_cast(s16x4, __builtin_amdgcn_ds_read_tr16_b64_v4i16((LAS v4i16_t*)(p + delta)));
    return __builtin_shufflevector(lo, hi, 0, 1, 2, 3, 4, 5, 6, 7);
}
DI u32x4 scale8(u32x4 w, float s) {
    u32x4 o; o.x = cvt_pk_bf16(bflo(w.x) * s, bfhi(w.x) * s); o.y = cvt_pk_bf16(bflo(w.y) * s, bfhi(w.y) * s); o.z = cvt_pk_bf16(bflo(w.z) * s, bfhi(w.z) * s); o.w = cvt_pk_bf16(bflo(w.w) * s, bfhi(w.w) * s); return o;
}
DI void p3_kv(const Ctx& F, int it0, int it1, int stride) {
    const Tid T = opaque_tid();
    LAS unsigned char* KFI = F.lds; LAS unsigned char* KBI = F.lds + 20480; LAS unsigned char* VI = F.lds + 40960;
    const int tid = T.tid, lane = T.lane, w = T.wave, g = lane >> 4, q = (lane & 15) >> 2, p = lane & 3;
    const int row = tid >> 2, seg = tid & 3;
    u32x4 pk[2], pv[4];
    auto prefetch = [&](int it) { const int bh = it >> 5, c = it & 31; const size_t tok0 = (size_t)(bh >> 3) * SEQ + c * CHK;
        const bf16_t* kp = F.K + tok0 * 512 + (bh & 7) * 64; const bf16_t* vp = F.V + tok0 * 1024 + (bh & 7) * 128;
        pk[0] = *(const u32x4*)(kp + (size_t)row * 512 + seg * 16); pk[1] = *(const u32x4*)(kp + (size_t)row * 512 + seg * 16 + 8);
#pragma unroll
        for (int i = 0; i < 4; ++i) pv[i] = *(const u32x4*)(vp + (size_t)row * 1024 + seg * 32 + 8 * i); };
    if (it0 < it1) prefetch(it0);
    for (int it = it0; it < it1; it += stride) {
        const int bh = it >> 5, c = it & 31;
        const float l2f = log2_gamma(F.decay_logit, 0, bh & 7), l2b = log2_gamma(F.decay_logit, 1, bh & 7);
        { const float df = __builtin_amdgcn_exp2f(l2f * (float)(127 - row)), db = __builtin_amdgcn_exp2f(l2b * (float)row);
            *(LAS u32x4*)(KFI + row * 160 + seg * 32) = scale8(pk[0], df); *(LAS u32x4*)(KFI + row * 160 + seg * 32 + 16) = scale8(pk[1], df);
            *(LAS u32x4*)(KBI + row * 160 + seg * 32) = scale8(pk[0], db); *(LAS u32x4*)(KBI + row * 160 + seg * 32 + 16) = scale8(pk[1], db);
#pragma unroll
            for (int i = 0; i < 4; ++i) *(LAS u32x4*)(VI + row * 288 + seg * 64 + 16 * i) = pv[i]; }
        __syncthreads();
        if (it + stride < it1) prefetch(it + stride);
        f32x4 acc[2][4];
#pragma unroll
        for (int d = 0; d < 2; ++d)
#pragma unroll
            for (int nb = 0; nb < 4; ++nb) acc[d][nb] = (f32x4){0.f, 0.f, 0.f, 0.f};
#pragma unroll
        for (int s2 = 0; s2 < 4; ++s2) {
            const bf16x8 vb = tr2(VI + (32 * s2 + 8 * g + q) * 288 + (16 * w + 4 * p) * 2, 4 * 288);
#pragma unroll
            for (int nb = 0; nb < 4; ++nb) {
                const bf16x8 kf = tr2(KFI + (32 * s2 + 8 * g + q) * 160 + (16 * nb + 4 * p) * 2, 4 * 160);
                const bf16x8 kb = tr2(KBI + (32 * s2 + 8 * g + q) * 160 + (16 * nb + 4 * p) * 2, 4 * 160);
                acc[0][nb] = __builtin_amdgcn_mfma_f32_16x16x32_bf16(kf, vb, acc[0][nb], 0, 0, 0);
                acc[1][nb] = __builtin_amdgcn_mfma_f32_16x16x32_bf16(kb, vb, acc[1][nb], 0, 0, 0);
            }
        }
        bf16_t* of = F.KV + ((size_t)(0 * 32 + bh) * 32 + c) * 8192; bf16_t* ob = F.KV + ((size_t)(1 * 32 + bh) * 32 + c) * 8192;
#pragma unroll
        for (int nb = 0; nb < 4; ++nb) { const int o = (16 * w + (lane & 15)) * 64 + 16 * nb + 4 * g;
            u32x2 a, b; a.x = cvt_pk_bf16(acc[0][nb].x, acc[0][nb].y); a.y = cvt_pk_bf16(acc[0][nb].z, acc[0][nb].w); b.x = cvt_pk_bf16(acc[1][nb].x, acc[1][nb].y); b.y = cvt_pk_bf16(acc[1][nb].z, acc[1][nb].w);
            *(u32x2*)(of + o) = a; *(u32x2*)(ob + o) = b; }
        __syncthreads();
    }
}
DI void p4_ctx_state(const Ctx& F, int bh) {
    const Tid T = opaque_tid();
    LAS unsigned char* KFI = F.lds; LAS unsigned char* KBI = F.lds + 20480; LAS unsigned char* VI = F.lds + 40960;
    const int tid = T.tid, lane = T.lane, w = T.wave, g = lane >> 4, q = (lane & 15) >> 2, p = lane & 3;
    const int row = tid >> 2, seg = tid & 3;
    const float l2f = log2_gamma(F.decay_logit, 0, bh & 7), l2b = log2_gamma(F.decay_logit, 1, bh & 7);
    f32x4 acc[2][4];
#pragma unroll
    for (int d = 0; d < 2; ++d)
#pragma unroll
        for (int nb = 0; nb < 4; ++nb) acc[d][nb] = (f32x4){0.f, 0.f, 0.f, 0.f};
    for (int cc = 0; cc < 2; ++cc) {
        const size_t tok0 = (size_t)(bh >> 3) * CTXL + cc * CHK; const int m = cc * CHK + row;
        const bf16_t* kp = F.KC + tok0 * 512 + (bh & 7) * 64; const bf16_t* vp = F.VC + tok0 * 1024 + (bh & 7) * 128;
        const u32x4 k0 = *(const u32x4*)(kp + (size_t)row * 512 + seg * 16), k1 = *(const u32x4*)(kp + (size_t)row * 512 + seg * 16 + 8);
        const float df = __builtin_amdgcn_exp2f(l2f * (float)(255 - m)), db = __builtin_amdgcn_exp2f(l2b * (float)m);
        *(LAS u32x4*)(KFI + row * 160 + seg * 32) = scale8(k0, df); *(LAS u32x4*)(KFI + row * 160 + seg * 32 + 16) = scale8(k1, df);
        *(LAS u32x4*)(KBI + row * 160 + seg * 32) = scale8(k0, db); *(LAS u32x4*)(KBI + row * 160 + seg * 32 + 16) = scale8(k1, db);
#pragma unroll
        for (int i = 0; i < 4; ++i) *(LAS u32x4*)(VI + row * 288 + seg * 64 + 16 * i) = *(const u32x4*)(vp + (size_t)row * 1024 + seg * 32 + 8 * i);
        __syncthreads();
#pragma unroll
        for (int s2 = 0; s2 < 4; ++s2) {
            const bf16x8 vb = tr2(VI + (32 * s2 + 8 * g + q) * 288 + (16 * w + 4 * p) * 2, 4 * 288);
#pragma unroll
            for (int nb = 0; nb < 4; ++nb) {
                const bf16x8 kf = tr2(KFI + (32 * s2 + 8 * g + q) * 160 + (16 * nb + 4 * p) * 2, 4 * 160);
                const bf16x8 kb = tr2(KBI + (32 * s2 + 8 * g + q) * 160 + (16 * nb + 4 * p) * 2, 4 * 160);
                acc[0][nb] = __builtin_amdgcn_mfma_f32_16x16x32_bf16(kf, vb, acc[0][nb], 0, 0, 0);
                acc[1][nb] = __builtin_amdgcn_mfma_f32_16x16x32_bf16(kb, vb, acc[1][nb], 0, 0, 0);
            }
        }
        __syncthreads();
    }
    float* of = F.S0 + (size_t)(0 * 32 + bh) * 8192; float* ob = F.S0 + (size_t)(1 * 32 + bh) * 8192;
#pragma unroll
    for (int nb = 0; nb < 4; ++nb) { const int o = (16 * w + (lane & 15)) * 64 + 16 * nb + 4 * g; *(f32x4*)(of + o) = acc[0][nb]; *(f32x4*)(ob + o) = acc[1][nb]; }
}
DI void p3_ua(const Ctx& F, int blk, int nblk) {
    const Tid T = opaque_tid();
    const size_t NT = (size_t)nblk * 512, gt = (size_t)blk * 512 + T.tid;
    for (size_t idx = gt; idx < (size_t)MTOK * 128; idx += NT) {
        const int t = (int)(idx >> 7), c8 = (int)(idx & 127) * 8, pos = t & 4095;
        const bf16_t* hp = F.HC + (size_t)t * 1024 + c8;
        const u32x4 z = (u32x4){0u, 0u, 0u, 0u};
        const u32x4 h0 = pos > 0 ? *(const u32x4*)(hp - 1024) : z, h1 = *(const u32x4*)hp, h2 = pos < SEQ - 1 ? *(const u32x4*)(hp + 1024) : z;
        const u32x4 pv = *(const u32x4*)(F.P + (size_t)t * 1024 + c8);
        float o[8];
#pragma unroll
        for (int e = 0; e < 8; ++e) { const unsigned a = h0[e >> 1], b = h1[e >> 1], c = h2[e >> 1], pp = pv[e >> 1];
            const float x0 = (e & 1) ? bfhi(a) : bflo(a), x1 = (e & 1) ? bfhi(b) : bflo(b), x2 = (e & 1) ? bfhi(c) : bflo(c), pf = (e & 1) ? bfhi(pp) : bflo(pp);
            const float cv = F.conv_w[c8 + e] * x0 + F.conv_w[1024 + c8 + e] * x1 + F.conv_w[2048 + c8 + e] * x2 + F.conv_b[c8 + e];
            o[e] = pf * cv; }
        u32x4 w; w.x = cvt_pk_bf16(o[0], o[1]); w.y = cvt_pk_bf16(o[2], o[3]); w.z = cvt_pk_bf16(o[4], o[5]); w.w = cvt_pk_bf16(o[6], o[7]);
        *(u32x4*)(F.P + (size_t)t * 1024 + c8) = w;
    }
}
DI void p4_scan(const Ctx& F, int blk, int nblk) {
    const Tid T = opaque_tid();
    const size_t NT = (size_t)nblk * 512, gt = (size_t)blk * 512 + T.tid;
    for (size_t idx = gt; idx < (size_t)2 * 32 * 2048; idx += NT) {
        const int e4 = (int)(idx & 2047), bh = (int)(idx >> 11) & 31, dir = (int)(idx >> 16);
        const float g = exp2f(log2_gamma(F.decay_logit, dir, bh & 7) * 128.f);
        const u32x2* kv = (const u32x2*)(F.KV + ((size_t)(dir * 32 + bh) * 32) * 8192) + e4;
        u32x2* st = (u32x2*)(F.ST + ((size_t)(dir * 32 + bh) * 32) * 8192) + e4;
        float s0 = 0.f, s1 = 0.f, s2 = 0.f, s3 = 0.f;
        u32x2 v[32];
#pragma unroll
        for (int i = 0; i < 32; ++i) v[i] = kv[(size_t)(dir == 0 ? i : 31 - i) * 2048];
#pragma unroll
        for (int i = 0; i < 32; ++i) { const int c = dir == 0 ? i : 31 - i;
            u32x2 o; o.x = cvt_pk_bf16(s0, s1); o.y = cvt_pk_bf16(s2, s3); st[(size_t)c * 2048] = o;
            s0 = g * s0 + bflo(v[i].x); s1 = g * s1 + bfhi(v[i].x); s2 = g * s2 + bflo(v[i].y); s3 = g * s3 + bfhi(v[i].y); }
    }
}
DI void n4_recurrence(const Ctx& F) {
    const Tid T = opaque_tid();
    const int gw = blockIdx.x * 8 + T.wave, NGW = gridDim.x * 8, d = T.lane;
    for (int task = gw; task < 32 * 128; task += NGW) {
        const int bh = task >> 7, v = task & 127, b = bh >> 3, h = bh & 7;
        const float gf = exp2f(log2_gamma(F.decay_logit, 0, h)), gb = exp2f(log2_gamma(F.decay_logit, 1, h));
        float s = 0.f;
        for (int m = 0; m < CTXL; ++m) { const size_t t = (size_t)b * CTXL + m; s = gf * s + bf2f(F.KC[t * 512 + h * 64 + d]) * bf2f(F.VC[t * 1024 + h * 128 + v]); }
        const float sF = s; s = 0.f;
        for (int m = CTXL - 1; m >= 0; --m) { const size_t t = (size_t)b * CTXL + m; s = gb * s + bf2f(F.KC[t * 512 + h * 64 + d]) * bf2f(F.VC[t * 1024 + h * 128 + v]); }
        const float sB = s;
        s = sF;
        for (int n = 0; n < SEQ; ++n) { const size_t t = (size_t)b * SEQ + n; s = gf * s + bf2f(F.K[t * 512 + h * 64 + d]) * bf2f(F.V[t * 1024 + h * 128 + v]);
            const float o = wave_sum(bf2f(F.Q[t * 512 + h * 64 + d]) * s); if (d == 0) F.RET[t * 1024 + h * 128 + v] = o; }
        s = sB;
        for (int n = SEQ - 1; n >= 0; --n) { const size_t t = (size_t)b * SEQ + n; s = gb * s + bf2f(F.K[t * 512 + h * 64 + d]) * bf2f(F.V[t * 1024 + h * 128 + v]);
            const float o = wave_sum(bf2f(F.Q[t * 512 + h * 64 + d]) * s); if (d == 0) F.RET[t * 1024 + h * 128 + v] += o; }
    }
}
DI void n5_groupnorm(const Ctx& F) {
    const Tid T = opaque_tid();
    const int gw = blockIdx.x * 8 + T.wave, NGW = gridDim.x * 8;
    for (int task = gw; task < MTOK * NH; task += NGW) {
        const int t = task >> 3, h = task & 7; const size_t o = (size_t)t * 1024 + h * 128 + 2 * T.lane;
        const float a = F.RET[o], b = F.RET[o + 1];
        const float mu = wave_sum(a + b) * (1.f / 128.f); const float da = a - mu, db = b - mu;
        const float var = wave_sum(da * da + db * db) * (1.f / 128.f); const float rstd = 1.0f / sqrtf(var + EPS);
        const float ra = da * rstd * F.gn_w[h * 128 + 2 * T.lane], rb = db * rstd * F.gn_w[h * 128 + 2 * T.lane + 1];
        *(unsigned*)(F.UB + o) = cvt_pk_bf16(siluf(bf2f(F.SZB[o])) * ra, siluf(bf2f(F.SZB[o + 1])) * rb);
    }
}
DI void p5_ret(const Ctx& F) {
    const Tid T = opaque_tid();
    LAS unsigned char* KI = F.lds; LAS unsigned char* VI = F.lds + 20480; LAS unsigned char* SF = F.lds + 57344; LAS unsigned char* SB = F.lds + 75776;
    LAS unsigned char* S0F = F.lds + 94208; LAS unsigned char* S0B = F.lds + 110592;
    const int tid = T.tid, lane = T.lane, w = T.wave, g = lane >> 4, q = (lane & 15) >> 2, p = lane & 3, l15 = lane & 15;
    const int row = tid >> 2, seg = tid & 3, il = 16 * w + l15;
    for (int base = blockIdx.x * 4; base < 1024; base += gridDim.x * 4) {
        const int bh = base >> 5, h = bh & 7;
        const float l2f = log2_gamma(F.decay_logit, 0, h), l2b = log2_gamma(F.decay_logit, 1, h);
        { const float* s0f = F.S0 + (size_t)(0 * 32 + bh) * 8192 + row * 64 + seg * 16; const float* s0b = F.S0 + (size_t)(1 * 32 + bh) * 8192 + row * 64 + seg * 16;
#pragma unroll
            for (int i = 0; i < 2; ++i) { const f32x4 a0 = *(const f32x4*)(s0f + 8 * i), a1 = *(const f32x4*)(s0f + 8 * i + 4), b0 = *(const f32x4*)(s0b + 8 * i), b1 = *(const f32x4*)(s0b + 8 * i + 4);
                u32x4 x, y; x.x = cvt_pk_bf16(a0.x, a0.y); x.y = cvt_pk_bf16(a0.z, a0.w); x.z = cvt_pk_bf16(a1.x, a1.y); x.w = cvt_pk_bf16(a1.z, a1.w);
                y.x = cvt_pk_bf16(b0.x, b0.y); y.y = cvt_pk_bf16(b0.z, b0.w); y.z = cvt_pk_bf16(b1.x, b1.y); y.w = cvt_pk_bf16(b1.z, b1.w);
                *(LAS u32x4*)(S0F + row * 128 + seg * 32 + 16 * i) = x; *(LAS u32x4*)(S0B + row * 128 + seg * 32 + 16 * i) = y; } }
        u32x4 pk[2], pv[4], pf0[2], pb0[2]; bf16x8 pq[2];
        auto prefetch = [&](int it) { const int c = it & 31; const size_t tok0 = (size_t)(bh >> 3) * SEQ + c * CHK;
            const bf16_t* kp = F.K + tok0 * 512 + h * 64; const bf16_t* vp = F.V + tok0 * 1024 + h * 128; const bf16_t* qp = F.Q + tok0 * 512 + h * 64;
            const bf16_t* stf = F.ST + ((size_t)(0 * 32 + bh) * 32 + c) * 8192; const bf16_t* stb = F.ST + ((size_t)(1 * 32 + bh) * 32 + c) * 8192;
#pragma unroll
            for (int i = 0; i < 2; ++i) { pk[i] = *(const u32x4*)(kp + (size_t)row * 512 + seg * 16 + 8 * i); pf0[i] = *(const u32x4*)(stf + row * 64 + seg * 16 + 8 * i); pb0[i] = *(const u32x4*)(stb + row * 64 + seg * 16 + 8 * i);
                pq[i] = *(const bf16x8*)(qp + (size_t)il * 512 + 32 * i + 8 * g); }
#pragma unroll
            for (int i = 0; i < 4; ++i) pv[i] = *(const u32x4*)(vp + (size_t)row * 1024 + seg * 32 + 8 * i); };
        prefetch(base);
        for (int k = 0; k < 4; ++k) {
            const int it = base + k, c = it & 31; const size_t tok0 = (size_t)(bh >> 3) * SEQ + c * CHK;
            { const float cf = __builtin_amdgcn_exp2f(l2f * 128.f * (float)c), cb = __builtin_amdgcn_exp2f(l2b * 128.f * (float)(31 - c));
#pragma unroll
                for (int i = 0; i < 2; ++i) { *(LAS u32x4*)(KI + row * 160 + seg * 32 + 16 * i) = pk[i];
                    const u32x4 x = *(const LAS u32x4*)(S0F + row * 128 + seg * 32 + 16 * i), y = *(const LAS u32x4*)(S0B + row * 128 + seg * 32 + 16 * i);
                    u32x4 of, ob;
#pragma unroll
                    for (int e = 0; e < 4; ++e) { of[e] = cvt_pk_bf16(bflo(pf0[i][e]) + cf * bflo(x[e]), bfhi(pf0[i][e]) + cf * bfhi(x[e])); ob[e] = cvt_pk_bf16(bflo(pb0[i][e]) + cb * bflo(y[e]), bfhi(pb0[i][e]) + cb * bfhi(y[e])); }
                    *(LAS u32x4*)(SF + row * 144 + seg * 32 + 16 * i) = of; *(LAS u32x4*)(SB + row * 144 + seg * 32 + 16 * i) = ob; }
#pragma unroll
                for (int i = 0; i < 4; ++i) *(LAS u32x4*)(VI + row * 288 + seg * 64 + 16 * i) = pv[i]; }
            bf16x8 qf[2]; qf[0] = pq[0]; qf[1] = pq[1];
            __syncthreads();
            if (k < 3) prefetch(it + 1);
            f32x4 accS[8];
#pragma unroll
            for (int jb = 0; jb < 8; ++jb) { accS[jb] = (f32x4){0.f, 0.f, 0.f, 0.f};
#pragma unroll
                for (int ks = 0; ks < 2; ++ks) { const bf16x8 kf = *(const LAS bf16x8*)(KI + (16 * jb + l15) * 160 + (32 * ks + 8 * g) * 2);
                    accS[jb] = __builtin_amdgcn_mfma_f32_16x16x32_bf16(kf, qf[ks], accS[jb], 0, 0, 0); } }
            bf16x8 pf[4];
#pragma unroll
            for (int s2 = 0; s2 < 4; ++s2) { float pe[8];
#pragma unroll
                for (int e = 0; e < 8; ++e) { const int jb = 2 * s2 + (e >> 2), r = e & 3, j = 16 * jb + 4 * g + r, df = il - j;
                    float mk = __builtin_amdgcn_exp2f((df >= 0 ? l2f : -l2b) * (float)df); if (df == 0) mk = 2.f;
                    pe[e] = accS[jb][r] * mk; }
                u32x4 pw; pw.x = cvt_pk_bf16(pe[0], pe[1]); pw.y = cvt_pk_bf16(pe[2], pe[3]); pw.z = cvt_pk_bf16(pe[4], pe[5]); pw.w = cvt_pk_bf16(pe[6], pe[7]);
                pf[s2] = __builtin_bit_cast(bf16x8, pw); }
            const float decf = __builtin_amdgcn_exp2f(l2f * (float)(il + 1)), decb = __builtin_amdgcn_exp2f(l2b * (float)(128 - il));
            f32x4 accO[8];
#pragma unroll
            for (int vb = 0; vb < 8; ++vb) { f32x4 o = (f32x4){0.f, 0.f, 0.f, 0.f};
#pragma unroll
                for (int s2 = 0; s2 < 4; ++s2) { const bf16x8 vf = tr2(VI + (32 * s2 + 4 * g + q) * 288 + (16 * vb + 4 * p) * 2, 16 * 288);
                    o = __builtin_amdgcn_mfma_f32_16x16x32_bf16(vf, pf[s2], o, 0, 0, 0); }
                f32x4 tf = (f32x4){0.f, 0.f, 0.f, 0.f}, tb = (f32x4){0.f, 0.f, 0.f, 0.f};
#pragma unroll
                for (int ks = 0; ks < 2; ++ks) { const bf16x8 sf = *(const LAS bf16x8*)(SF + (16 * vb + l15) * 144 + (32 * ks + 8 * g) * 2);
                    const bf16x8 sb = *(const LAS bf16x8*)(SB + (16 * vb + l15) * 144 + (32 * ks + 8 * g) * 2);
                    tf = __builtin_amdgcn_mfma_f32_16x16x32_bf16(sf, qf[ks], tf, 0, 0, 0); tb = __builtin_amdgcn_mfma_f32_16x16x32_bf16(sb, qf[ks], tb, 0, 0, 0); }
                accO[vb] = o + tf * decf + tb * decb; __builtin_amdgcn_sched_barrier(0); }
            float sm = 0.f;
#pragma unroll
            for (int vb = 0; vb < 8; ++vb) sm += (accO[vb].x + accO[vb].y) + (accO[vb].z + accO[vb].w);
            sm += __shfl_xor(sm, 16); sm += __shfl_xor(sm, 32);
            const float mu = sm * (1.f / 128.f); float sq = 0.f;
#pragma unroll
            for (int vb = 0; vb < 8; ++vb) { accO[vb] = accO[vb] - mu; sq += (accO[vb].x * accO[vb].x + accO[vb].y * accO[vb].y) + (accO[vb].z * accO[vb].z + accO[vb].w * accO[vb].w); }
            sq += __shfl_xor(sq, 16); sq += __shfl_xor(sq, 32);
            const float rstd = 1.0f / sqrtf(sq * (1.f / 128.f) + EPS);
            __syncthreads();
#pragma unroll
            for (int vb = 0; vb < 8; ++vb) { const f32x4 gw = *(const f32x4*)(F.gn_w + h * 128 + 16 * vb + 4 * g); const f32x4 o = accO[vb] * rstd * gw;
                u32x2 ow; ow.x = cvt_pk_bf16(o.x, o.y); ow.y = cvt_pk_bf16(o.z, o.w);
                *(LAS u32x2*)(VI + il * 288 + (16 * vb + 4 * g) * 2) = ow; }
            __syncthreads();
            { const size_t go = (tok0 + row) * 1024 + h * 128 + seg * 32;
#pragma unroll
                for (int i = 0; i < 4; ++i) { const u32x4 o = *(const LAS u32x4*)(VI + row * 288 + seg * 64 + 16 * i); const u32x4 z = *(const u32x4*)(F.SZB + go + 8 * i);
                    u32x4 r;
#pragma unroll
                    for (int e = 0; e < 4; ++e) r[e] = cvt_pk_bf16(bflo(o[e]) * siluf(bflo(z[e])), bfhi(o[e]) * siluf(bfhi(z[e])));
                    *(u32x4*)(F.UB + go + 8 * i) = r; } }
            __syncthreads();
        }
    }
}
struct SchedSq { int G, c; DI bool next(int i, pg8::Unit& u) const { const int L = i * G + c; if (L >= 256) return false; pg8::tile_of(L, 64, 4, u); return true; } };
struct EpiAB {
    const bf16_t* R; const bf16_t* SGB; bf16_t* MM;
    DI int vm_ops(const pg8::Unit&) const { return 0; }
    DI void mid(f32x4 (&acc)[2][2][4][2], const pg8::Unit& u, int wr, int wc, int fr, int fq) const { apply<false>(acc, u, wr, wc, fr, fq); }
    DI void operator()(const f32x4 (&acc)[2][2][4][2], const pg8::Unit& u, int wr, int wc, int fr, int fq) const { apply<true>(const_cast<f32x4 (&)[2][2][4][2]>(acc), u, wr, wc, fr, fq); }
    template <bool FIN> DI void apply(f32x4 (&acc)[2][2][4][2], const pg8::Unit& u, int wr, int wc, int fr, int fq) const {
        const bf16_t* src = FIN ? SGB : R;
        const size_t base = (size_t)(u.pm * 256 + wr * 64 + fr) * 1024 + u.pn * 256 + wc * 32 + 8 * fq;
#pragma unroll
        for (int am = 0; am < 4; ++am) { const int ai = am >> 1;
            u32x4 gv[4][2];
#pragma unroll
            for (int m = 2 * (am & 1); m < 2 * (am & 1) + 2; ++m)
#pragma unroll
                for (int bj = 0; bj < 2; ++bj) gv[m][bj] = *(const u32x4*)(src + base + (size_t)(ai * 128 + m * 16) * 1024 + bj * 128);
#pragma unroll
            for (int m = 2 * (am & 1); m < 2 * (am & 1) + 2; ++m)
#pragma unroll
                for (int bj = 0; bj < 2; ++bj) { const u32x4 gq = gv[m][bj];
                    f32x4 a = acc[ai][bj][m][0], b = acc[ai][bj][m][1];
                    a.x *= bflo(gq.x); a.y *= bfhi(gq.x); a.z *= bflo(gq.y); a.w *= bfhi(gq.y); b.x *= bflo(gq.z); b.y *= bfhi(gq.z); b.z *= bflo(gq.w); b.w *= bfhi(gq.w);
                    if (FIN) { u32x4 w; w.x = cvt_pk_bf16(a.x, a.y); w.y = cvt_pk_bf16(a.z, a.w); w.z = cvt_pk_bf16(b.x, b.y); w.w = cvt_pk_bf16(b.z, b.w);
                        *(u32x4*)(MM + base + (size_t)(ai * 128 + m * 16) * 1024 + bj * 128) = w; }
                    else { acc[ai][bj][m][0] = a; acc[ai][bj][m][1] = b; } }
            asm volatile("" ::: "memory");
        }
    }
};
struct EpiOut {
    const float* x; const float* MOD; float* out;
    DI int vm_ops(const pg8::Unit&) const { return 0; }
    DI void mid(f32x4 (&)[2][2][4][2], const pg8::Unit&, int, int, int, int) const {}
    DI void operator()(const f32x4 (&acc)[2][2][4][2], const pg8::Unit& u, int wr, int wc, int fr, int fq) const {
        const int col0 = u.pn * 256 + wc * 32 + 8 * fq; const float* gp = MOD + (u.pm >> 4) * 3072 + 2048 + col0;
        f32x4 gx[2][2];
#pragma unroll
        for (int bj = 0; bj < 2; ++bj)
#pragma unroll
            for (int n = 0; n < 2; ++n) gx[bj][n] = *(const f32x4*)(gp + bj * 128 + 4 * n);
#pragma unroll
        for (int ai = 0; ai < 2; ++ai)
#pragma unroll
            for (int m = 0; m < 4; ++m) { const size_t off = (size_t)(u.pm * 256 + ai * 128 + wr * 64 + m * 16 + fr) * 1024 + col0;
#pragma unroll
                for (int bj = 0; bj < 2; ++bj)
#pragma unroll
                    for (int n = 0; n < 2; ++n) { const f32x4 xv = *(const f32x4*)(x + off + bj * 128 + 4 * n); *(f32x4*)(out + off + bj * 128 + 4 * n) = xv + gx[bj][n] * acc[ai][bj][m][n]; }
                if (m & 1) asm volatile("" ::: "memory"); }
    }
};
struct EpiOutNorm {
    const float* x; const float* MOD; float* out; const float* fw; float* slots; unsigned* cnt; LAS float* tab;
    DI int vm_ops(const pg8::Unit&) const { return 0; }
    DI void mid(f32x4 (&)[2][2][4][2], const pg8::Unit&, int, int, int, int) const {}
    DI void operator()(const f32x4 (&acc_)[2][2][4][2], const pg8::Unit& u, int wr, int wc, int fr, int fq) const {
        f32x4 (&acc)[2][2][4][2] = const_cast<f32x4 (&)[2][2][4][2]>(acc_);
        const int col0 = u.pn * 256 + wc * 32 + 8 * fq; const float* gp = MOD + (u.pm >> 4) * 3072 + 2048 + col0;
        f32x4 gx[2][2];
#pragma unroll
        for (int bj = 0; bj < 2; ++bj)
#pragma unroll
            for (int n = 0; n < 2; ++n) gx[bj][n] = *(const f32x4*)(gp + bj * 128 + 4 * n);
#pragma unroll
        for (int ai = 0; ai < 2; ++ai)
#pragma unroll
            for (int m = 0; m < 4; ++m) { const int row = u.pm * 256 + ai * 128 + wr * 64 + m * 16 + fr; const size_t off = (size_t)row * 1024 + col0; float ss = 0.f;
#pragma unroll
                for (int bj = 0; bj < 2; ++bj)
#pragma unroll
                    for (int n = 0; n < 2; ++n) { const f32x4 xv = *(const f32x4*)(x + off + bj * 128 + 4 * n); const f32x4 v = xv + gx[bj][n] * acc[ai][bj][m][n]; acc[ai][bj][m][n] = v;
                        ss += (v.x * v.x + v.y * v.y) + (v.z * v.z + v.w * v.w); }
                ss += __shfl_xor(ss, 16); ss += __shfl_xor(ss, 32);
                if (fq == 0) __hip_atomic_store(slots + (size_t)row * 16 + u.pn * 4 + wc, ss, __ATOMIC_RELAXED, __HIP_MEMORY_SCOPE_AGENT);
                if (m & 1) asm volatile("" ::: "memory"); }
        asm volatile("s_waitcnt vmcnt(0)" ::: "memory");
        __syncthreads();
        if (threadIdx.x == 0) {
            unsigned* c = cnt + 64 * u.pm;
            __hip_atomic_fetch_add(c, 1u, __ATOMIC_RELAXED, __HIP_MEMORY_SCOPE_AGENT);
            unsigned sp = 0;
            while (__hip_atomic_load(c, __ATOMIC_RELAXED, __HIP_MEMORY_SCOPE_AGENT) < 4u) { __builtin_amdgcn_s_sleep(1); if (++sp > (1u << 22)) break; }
            __builtin_amdgcn_fence(__ATOMIC_ACQUIRE, "agent");
            asm volatile("s_waitcnt vmcnt(0)" ::: "memory");
        }
        __syncthreads();
        { const int t = threadIdx.x, row = t >> 1, half = t & 1; const float* sp = slots + (size_t)(u.pm * 256 + row) * 16 + half * 8; float s = 0.f;
#pragma unroll
            for (int j = 0; j < 8; ++j) s += __hip_atomic_load(sp + j, __ATOMIC_RELAXED, __HIP_MEMORY_SCOPE_AGENT);
            s += __shfl_xor(s, 1);
            if (half == 0) tab[row] = 1.0f / sqrtf(s * (1.f / 1024.f) + EPS); }
        __syncthreads();
        f32x4 fv[2][2];
#pragma unroll
        for (int bj = 0; bj < 2; ++bj)
#pragma unroll
            for (int n = 0; n < 2; ++n) fv[bj][n] = *(const f32x4*)(fw + col0 + bj * 128 + 4 * n);
#pragma unroll
        for (int ai = 0; ai < 2; ++ai)
#pragma unroll
            for (int m = 0; m < 4; ++m) { const int rl = ai * 128 + wr * 64 + m * 16 + fr; const float r = tab[rl]; const size_t off = (size_t)(u.pm * 256 + rl) * 1024 + col0;
#pragma unroll
                for (int bj = 0; bj < 2; ++bj)
#pragma unroll
                    for (int n = 0; n < 2; ++n) *(f32x4*)(out + off + bj * 128 + 4 * n) = acc[ai][bj][m][n] * r * fv[bj][n]; }
    }
};
DI void n6_ab(const Ctx& F) {
    const Tid T = opaque_tid();
    const size_t NT = (size_t)gridDim.x * 512, gt = (size_t)blockIdx.x * 512 + T.tid;
    for (size_t idx = gt; idx < (size_t)(MTOK / 4) * 1024; idx += NT) {
        const int n = (int)(idx & 1023), t0 = (int)(idx >> 10) * 4; float ya[4] = {0.f, 0.f, 0.f, 0.f}, yb[4] = {0.f, 0.f, 0.f, 0.f};
        for (int k = 0; k < 1024; ++k) { const float wa = F.w_a[(size_t)k * 1024 + n], wb = F.w_b[(size_t)k * 1024 + n];
#pragma unroll
            for (int j = 0; j < 4; ++j) { ya[j] += bf2f(F.P[(size_t)(t0 + j) * 1024 + k]) * wa; yb[j] += bf2f(F.UB[(size_t)(t0 + j) * 1024 + k]) * wb; } }
#pragma unroll
        for (int j = 0; j < 4; ++j) { const size_t o = (size_t)(t0 + j) * 1024 + n; const float sgb = bf2f(F.SGB[o]), sga = bf2f(F.R[o]) * sgb; F.MM[o] = f2bf(sga * ya[j] + sgb * yb[j]); }
    }
}
DI void n7_out(const Ctx& F) {
    const Tid T = opaque_tid();
    const size_t NT = (size_t)gridDim.x * 512, gt = (size_t)blockIdx.x * 512 + T.tid;
    for (size_t idx = gt; idx < (size_t)(MTOK / 4) * 1024; idx += NT) {
        const int n = (int)(idx & 1023), t0 = (int)(idx >> 10) * 4; float y[4] = {0.f, 0.f, 0.f, 0.f};
        for (int k = 0; k < 1024; ++k) { const float w = F.w_out[(size_t)k * 1024 + n];
#pragma unroll
            for (int j = 0; j < 4; ++j) y[j] += bf2f(F.MM[(size_t)(t0 + j) * 1024 + k]) * w; }
#pragma unroll
        for (int j = 0; j < 4; ++j) { const size_t o = (size_t)(t0 + j) * 1024 + n; F.out[o] = F.x[o] + F.MOD[((t0 + j) >> 12) * 3072 + 2048 + n] * y[j]; }
    }
}
DI void p8_final(const Ctx& F) {
    const Tid T = opaque_tid();
    const int gw = blockIdx.x * 8 + T.wave, NGW = gridDim.x * 8;
    for (int m = gw; m < MTOK; m += NGW) {
        f32x4* xr = (f32x4*)(F.out + (size_t)m * DM);
        f32x4 v[4]; float ss = 0.f;
#pragma unroll
        for (int j = 0; j < 4; ++j) { v[j] = xr[T.lane + 64 * j]; ss += (v[j].x * v[j].x + v[j].y * v[j].y) + (v[j].z * v[j].z + v[j].w * v[j].w); }
        const float rstd = 1.0f / sqrtf(wave_sum(ss) * (1.f / DM) + EPS);
#pragma unroll
        for (int j = 0; j < 4; ++j) { const f32x4 w = *(const f32x4*)(F.final_w + 4 * (T.lane + 64 * j)); xr[T.lane + 64 * j] = v[j] * rstd * w; }
    }
}

constexpr int NPH = 9;
__global__ void __launch_bounds__(512, 2) fwd_kernel(Args args) {
    extern __shared__ __attribute__((aligned(16))) unsigned char lds_raw[];
    Ctx F;
    F.lds = (LAS unsigned char*)lds_raw;
    if (threadIdx.x < 16) ((LAS unsigned*)(F.lds + LDS_MISC))[threadIdx.x] = 0u;
    __syncthreads();
    const XcdBarrier bar = xcd_barrier_post((unsigned*)(args.ws + WS_BAR), (volatile LAS unsigned*)(F.lds + LDS_MISC));
    F.x = args.in[0]; F.c = args.in[1]; F.ctx = args.in[2]; F.c_ctx = args.in[3]; F.norm_w = args.in[4]; F.ada_w = args.in[5]; F.ada_b = args.in[6]; F.w_in = args.in[7];
    F.conv_w = args.in[8]; F.conv_b = args.in[9]; F.decay_logit = args.in[10]; F.gn_w = args.in[11]; F.w_a = args.in[12]; F.w_b = args.in[13]; F.w_out = args.in[14]; F.final_w = args.in[15];
    F.out = args.out; unsigned char* ws = args.ws; F.ws = ws;
    F.MOD = (float*)(ws + WS_MOD); F.ROPE = (f32x2*)(ws + WS_ROPE);
    F.WA = (bf16_t*)(ws + WS_WA); F.WB = (bf16_t*)(ws + WS_WB); F.WOUT = (bf16_t*)(ws + WS_WOUT); F.WIN = (bf16_t*)(ws + WS_WIN); F.XM = (bf16_t*)(ws + WS_XM);
    F.KV = (bf16_t*)(ws + WS_KV); F.KVC = (bf16_t*)(ws + WS_KVC); F.HC = (bf16_t*)(ws + WS_HC); F.ST = (bf16_t*)(ws + WS_ST); F.MM = (bf16_t*)(ws + WS_MM);
    F.P = (bf16_t*)(ws + WS_P); F.Q = (bf16_t*)(ws + WS_Q); F.K = (bf16_t*)(ws + WS_K); F.V = (bf16_t*)(ws + WS_V); F.SZB = (bf16_t*)(ws + WS_SZB);
    F.KC = (bf16_t*)(ws + WS_KC); F.VC = (bf16_t*)(ws + WS_VC); F.UB = (bf16_t*)(ws + WS_UB);
    F.R = (bf16_t*)args.out; F.SGB = (bf16_t*)args.out + (size_t)MTOK * DM;
    F.RET = (float*)(ws + WS_RET); F.S0 = (float*)(ws + WS_KVC);
    const int lo = args.ph_lo, hi = args.ph_hi; const unsigned naive = args.naive;
#define IN(k) (lo <= (k) && (k) < hi && ((MK_PHASES >> (k)) & 1))
#define NAIVE(k) (((naive & MK_NAIVE_AVAIL) >> (k)) & 1u)
#define SEAM(k) do { if (IN(k) && IN((k) + 1)) xcd_barrier(bar); } while (0)
#define REP(k) for (int rep_ = 0; rep_ < 1 + (int)((MK_REP_MASK >> (k)) & 1u); ++rep_)
    if (IN(0)) REP(0) { p0_prologue(F); } SEAM(0);
    if (IN(1)) REP(1) { p1_rows(F); } SEAM(1);
    if (IN(2)) REP(2) {
        if (NAIVE(2)) n2_inproj(F);
        else { const char* const Ab[2] = {(const char*)F.XM, (const char*)F.XM}; const char* const Bb[2] = {(const char*)F.WIN, (const char*)F.WIN};
            Sched1 S{(int)gridDim.x, (int)blockIdx.x}; Epi1 E{F.ws, F.R, F.SGB, F.ROPE};
            pg8::gemm_phase<1, Epi1, Sched1>(F.lds, Ab, Bb, S, E); }
    } SEAM(2);
    if (IN(3)) {
        if (!NAIVE(3)) {
            const char* const Ab[2] = {(const char*)F.XM, (const char*)F.XM}; const char* const Bb[2] = {(const char*)F.WIN, (const char*)F.WIN};
            SchedCtx S{(int)blockIdx.x}; Epi1 E{F.ws, F.R, F.SGB, F.ROPE};
            pg8::gemm_phase<1, Epi1, SchedCtx>(F.lds, Ab, Bb, S, E);
            if (blockIdx.x >= 24) { REP(3) p3_kv(F, blockIdx.x - 24, 1024, gridDim.x - 24); p3_ua(F, blockIdx.x - 24, gridDim.x - 24); }
        } else p3_ua(F, blockIdx.x, gridDim.x);
    } SEAM(3);
    if (IN(4)) REP(4) { if (NAIVE(4)) n4_recurrence(F); else { if (blockIdx.x >= gridDim.x - 32) p4_ctx_state(F, blockIdx.x - (gridDim.x - 32)); else p4_scan(F, blockIdx.x, gridDim.x - 32); } } SEAM(4);
    if (IN(5)) REP(5) { if (NAIVE(5)) n5_groupnorm(F); else p5_ret(F); } SEAM(5);
    if (IN(6)) REP(6) {
        if (NAIVE(6)) n6_ab(F);
        else { const char* const Ab[2] = {(const char*)F.P, (const char*)F.UB}; const char* const Bb[2] = {(const char*)F.WA, (const char*)F.WB};
            SchedSq S{(int)gridDim.x, (int)blockIdx.x}; EpiAB E{F.R, F.SGB, F.MM};
            pg8::gemm_phase<2, EpiAB, SchedSq>(F.lds, Ab, Bb, S, E); }
    } SEAM(6);
    if (IN(7)) {
        const char* const Ab[2] = {(const char*)F.MM, (const char*)F.MM}; const char* const Bb[2] = {(const char*)F.WOUT, (const char*)F.WOUT};
        SchedSq S{(int)gridDim.x, (int)blockIdx.x};
        if (NAIVE(7)) n7_out(F);
        else if (gridDim.x == 256) {
            EpiOutNorm E{F.x, F.MOD, F.out, F.final_w, (float*)(F.ws + WS_SLOTS), (unsigned*)(F.ws + WS_PCNT), (LAS float*)(F.lds + LDS_TAB)};
            pg8::gemm_phase<1, EpiOutNorm, SchedSq>(F.lds, Ab, Bb, S, E); }
        else { EpiOut E{F.x, F.MOD, F.out}; pg8::gemm_phase<1, EpiOut, SchedSq>(F.lds, Ab, Bb, S, E); }
    }
    if (NAIVE(7) || gridDim.x != 256) { SEAM(7); if (IN(8)) { p8_final(F); } }
#undef IN
#undef NAIVE
#undef SEAM
}

extern "C" void kernel_launch(void* const* d_in, const int* in_sizes, int n_in, void* d_out, int out_size, void* d_ws, size_t ws_size, hipStream_t stream) {
    static int grid = 0;
    if (grid == 0) {
        if (n_in != 16 || out_size != MTOK * DM || ws_size < WS_END) { fprintf(stderr, "kernel_launch: unexpected shapes (n_in %d out %d ws %zu)\n", n_in, out_size, ws_size); grid = -1; return; }
        int dev = 0, cus = 0, per_cu = 0;
        hipGetDevice(&dev); hipDeviceGetAttribute(&cus, hipDeviceAttributeMultiprocessorCount, dev);
        hipFuncSetAttribute((const void*)fwd_kernel, hipFuncAttributeMaxDynamicSharedMemorySize, LDS_BYTES);
        hipOccupancyMaxActiveBlocksPerMultiprocessor(&per_cu, (const void*)fwd_kernel, 512, LDS_BYTES);
        if (per_cu < 1) { fprintf(stderr, "kernel_launch: occupancy query says %d blocks/CU\n", per_cu); per_cu = 1; }
        grid = cus;
        (void)hipGetLastError();
    }
    if (grid < 0) return;
    Args a{};
    for (int i = 0; i < 16; ++i) a.in[i] = (const float*)d_in[i];
    a.out = (float*)d_out; a.ws = (unsigned char*)d_ws; a.naive = MK_NAIVE_MASK;
    hipMemsetAsync((unsigned char*)d_ws + WS_BAR, 0, WS_BAR_BYTES, stream);
#if MK_LAUNCH_PER_PHASE
    for (int ph = 0; ph < NPH; ++ph) { a.ph_lo = ph; a.ph_hi = ph + 1; hipLaunchKernelGGL(fwd_kernel, dim3(grid), dim3(512), LDS_BYTES, stream, a); }
#else
    a.ph_lo = 0; a.ph_hi = NPH;
    hipLaunchKernelGGL(fwd_kernel, dim3(grid), dim3(512), LDS_BYTES, stream, a);
#endif
}
```

```cpp
#include <hip/hip_runtime.h>
#include <cstdio>
#include <cstdint>

#ifndef MK_LAUNCH_PER_PHASE
#define MK_LAUNCH_PER_PHASE 0
#endif
#ifndef MK_NAIVE_MASK
#define MK_NAIVE_MASK 0x00u
#endif

#ifndef MK_REP_MASK
#define MK_REP_MASK 0u
#endif
#ifndef MK_PHASES
#define MK_PHASES 0x1ff
#endif
#ifndef MK_NAIVE_AVAIL
#define MK_NAIVE_AVAIL 0xffu
#endif
#define DI __device__ __forceinline__
#define LAS __attribute__((address_space(3)))
typedef unsigned short bf16_t;
typedef float f32x4 __attribute__((ext_vector_type(4)));
typedef float f32x2 __attribute__((ext_vector_type(2)));
typedef unsigned u32x4 __attribute__((ext_vector_type(4)));
typedef unsigned u32x2 __attribute__((ext_vector_type(2)));
typedef short bf16x8 __attribute__((ext_vector_type(8)));
typedef short s16x4 __attribute__((ext_vector_type(4)));
typedef short v4i16_t __attribute__((ext_vector_type(4)));

constexpr int NB = 4, SEQ = 4096, DM = 1024, MTOK = NB * SEQ, CTXL = 256, MCTX = NB * CTXL, MALL = MTOK + MCTX;
constexpr int NIN = 9216, NH = 8, DK = 64, DV = 128, CHK = 128, NCHK = SEQ / CHK;
constexpr float EPS = 1e-6f;
constexpr size_t MiB = 1u << 20;
constexpr size_t WS_MOD = 0;
constexpr size_t WS_ROPE = 65536;
constexpr size_t WS_WA = 2 * MiB, WS_WB = 4 * MiB, WS_WOUT = 6 * MiB, WS_WIN = 8 * MiB;
constexpr size_t WS_XM = 26 * MiB;
constexpr size_t WS_KV = 223 * MiB;
constexpr size_t WS_KVC = 40 * MiB;
constexpr size_t WS_RET = 8 * MiB;
constexpr size_t WS_HC = 60 * MiB;
constexpr size_t WS_ST = 60 * MiB;
constexpr size_t WS_MM = 60 * MiB;
constexpr size_t WS_P = 92 * MiB;
constexpr size_t WS_Q = 124 * MiB, WS_K = 140 * MiB, WS_V = 156 * MiB, WS_SZB = 188 * MiB;
constexpr size_t WS_KC = 220 * MiB, WS_VC = 221 * MiB;
constexpr size_t WS_UB = 223 * MiB;
constexpr size_t WS_END = 255 * MiB;
constexpr int LDS_BYTES = 147456;
constexpr int LDS_MISC = 139264;
constexpr size_t WS_BAR = 131072, WS_BAR_BYTES = 65536;
constexpr size_t WS_PCNT = WS_BAR + 16384, WS_SLOTS = 1 * MiB;
constexpr size_t WS_FLAG = 98304;
constexpr unsigned CTL_MAGIC = 0x600DF1A6u;
constexpr int LDS_TAB = 132096;

DI float bf2f(bf16_t v) { return __uint_as_float((unsigned)v << 16); }
DI float bflo(unsigned w) { return __uint_as_float(w << 16); }
DI float bfhi(unsigned w) { return __uint_as_float(w & 0xffff0000u); }
typedef __bf16 bf16x2_t __attribute__((ext_vector_type(2)));
DI unsigned cvt_pk_bf16(float lo, float hi) { const f32x2 f = {lo, hi}; const bf16x2_t v = __builtin_convertvector(f, bf16x2_t); return __builtin_bit_cast(unsigned, v); }
DI bf16_t f2bf(float f) { return (bf16_t)(cvt_pk_bf16(f, 0.f) & 0xffffu); }
DI float wave_sum(float v) {
#pragma unroll
    for (int o = 1; o < 64; o <<= 1) v += __shfl_xor(v, o);
    return v;
}
struct Tid { int tid, lane, wave; };
DI Tid opaque_tid() { int t = threadIdx.x; asm volatile("" : "+v"(t)); Tid r; r.tid = t; r.lane = t & 63; r.wave = __builtin_amdgcn_readfirstlane(t >> 6); return r; }
DI float siluf(float x) { return x * __builtin_amdgcn_rcpf(1.f + __expf(-x)); }
DI float log2_gamma(const float* decay_logit, int dir, int h) {
    const float x = decay_logit[dir * NH + h];
    const float ls = fminf(x, 0.f) - log1pf(expf(-fabsf(x)));
    return ls * 1.4426950408889634f;
}

namespace pg8 {
constexpr int BM = 256, BK = 64, HALF = 128, HTB = HALF * BK * 2, STAGE_BYTES = 8 * HTB, NXCD = 8, WGM = 4;
DI int lds_byte(int r, int c) { const int st = (r >> 4) * 2 + (c >> 5), rr = r & 15, cc = c & 31, ob = rr * 64 + cc * 2; return st * 1024 + (ob ^ (((ob >> 9) & 1) << 5)); }
DI void stage_rc(int b, int& R, int& C) { const int st = b / 1024, sb = b % 1024, swz = sb ^ (((sb >> 9) & 1) << 5); R = (st >> 1) * 16 + swz / 64; C = (st & 1) * 32 + (swz % 64) / 2; }
DI int perm32(int rho) { const int n = rho >> 4, i = rho & 15; return 8 * (i >> 2) + 4 * n + (i & 3); }
struct Unit { int pm, pn; };
DI void tile_of(int L, int nM, int nN, Unit& u) {
    const int nwg = nM * nN; int wgid = L;
    { const int q = nwg / NXCD, r = nwg % NXCD, xcd = wgid % NXCD, off = wgid / NXCD; wgid = (xcd < r ? xcd * (q + 1) : r * (q + 1) + (xcd - r) * q) + off; }
    const int nig = WGM * nN, gid = wgid / nig, fm = gid * WGM, gsz = (nM - fm) < WGM ? (nM - fm) : WGM;
    u.pm = fm + ((wgid % nig) % gsz); u.pn = (wgid % nig) / gsz;
}
template <int NSEG, class Epi, class Sched>
DI void gemm_phase(LAS unsigned char* lds, const char* const (&Ab)[2], const char* const (&Bb)[2], const Sched& S, const Epi& E) {
    constexpr int K = 1024, NTS = K / BK;
    constexpr int nt = NSEG * NTS;
    const Tid T = opaque_tid();
    const int tid = T.tid, wid = T.wave, lane = T.lane, wr = wid >> 2, wc = (wid & 3) ^ (wr << 1), fr = lane & 15, fq = lane >> 4;
    unsigned voffA[2], voffB[2];
#pragma unroll
    for (int i = 0; i < 2; ++i) { int R, C; stage_rc(tid * 16 + i * 8192, R, C); const int Rb = (R & ~31) + perm32(R & 31);
        voffA[i] = (unsigned)(R * K + C) * 2u; voffB[i] = (unsigned)(Rb * K + C) * 2u; }
    constexpr size_t kstep = (size_t)(BK * 2);
    constexpr size_t hstep = (size_t)HALF * K * 2;
    constexpr size_t tstep = 2 * hstep;
    const unsigned ldsw = (unsigned)wid * 1024u;
    const int aoff = lds_byte(wr * 64 + fr, fq * 8), boff = lds_byte(wc * 32 + fr, fq * 8);
#define PG8_SA(b, h) (((b) * 2 + (h)) * HTB)
#define PG8_SB(b, h) ((4 + (b) * 2 + (h)) * HTB)
#define PG8_STAGE(bufoff, gbase, voff) do { _Pragma("unroll") for (int _i = 0; _i < 2; ++_i) \
        __builtin_amdgcn_global_load_lds((const unsigned*)((const char*)(gbase) + (voff)[_i]), (LAS unsigned*)(lds + (bufoff) + ldsw + _i * 8192), 16, 0, 0); } while (0)
#define PG8_LDA(dst, b, h) do { _Pragma("unroll") for (int m = 0; m < 4; ++m) _Pragma("unroll") for (int k = 0; k < 2; ++k) dst[m][k] = *(const LAS bf16x8*)(lds + PG8_SA(b, h) + aoff + m * 2048 + k * 1024); } while (0)
#define PG8_LDB(dst, b, h) do { _Pragma("unroll") for (int n = 0; n < 2; ++n) _Pragma("unroll") for (int k = 0; k < 2; ++k) dst[n][k] = *(const LAS bf16x8*)(lds + PG8_SB(b, h) + boff + n * 2048 + k * 1024); } while (0)
#define PG8_MMA(ai, bj, At, Bt) do { __builtin_amdgcn_s_setprio(1); _Pragma("unroll") for (int m = 0; m < 4; ++m) _Pragma("unroll") for (int n = 0; n < 2; ++n) _Pragma("unroll") for (int k = 0; k < 2; ++k) \
        acc[ai][bj][m][n] = __builtin_amdgcn_mfma_f32_16x16x32_bf16(Bt[n][k], At[m][k], acc[ai][bj][m][n], 0, 0, 0); __builtin_amdgcn_s_setprio(0); } while (0)
#define PG8_WAIT_V(n) asm volatile("s_waitcnt vmcnt(" #n ")" ::: "memory")
#define PG8_WAIT_L(n) asm volatile("s_waitcnt lgkmcnt(" #n ")" ::: "memory")
#define PG8_WAIT_VR(sel) asm volatile("s_cmp_lt_i32 %0, 8\n\ts_cbranch_scc1 .Lw8_%=\n\ts_cmp_lt_i32 %0, 16\n\ts_cbranch_scc1 .Lw16_%=\n\ts_waitcnt vmcnt(24)\n\ts_branch .Lwe_%=\n.Lw16_%=:\n\ts_waitcnt vmcnt(16)\n\ts_branch .Lwe_%=\n.Lw8_%=:\n\ts_waitcnt vmcnt(8)\n.Lwe_%=:" :: "s"(sel) : "memory", "scc")
#define PG8_BAR __builtin_amdgcn_s_barrier()
#define PG8_SCHED __builtin_amdgcn_sched_barrier(0)
#define PG8_TA(u, t) (Ab[(t) / NTS] + (size_t)(u).pm * tstep + (size_t)((t) % NTS) * kstep)
#define PG8_TB(u, t) (Bb[(t) / NTS] + (size_t)(u).pn * tstep + (size_t)((t) % NTS) * kstep)
    Unit cur, nxt; int ui = 0;
    if (!S.next(0, cur)) return;
    f32x4 acc[2][2][4][2];
#pragma unroll
    for (int a = 0; a < 2; ++a)
#pragma unroll
        for (int b = 0; b < 2; ++b)
#pragma unroll
            for (int m = 0; m < 4; ++m)
#pragma unroll
                for (int n = 0; n < 2; ++n) acc[a][b][m][n] = (f32x4){0.f, 0.f, 0.f, 0.f};
    bf16x8 At[4][2], B0[2][2], B1[2][2];
    {
        const char* cA = PG8_TA(cur, 0); const char* cB = PG8_TB(cur, 0);
        PG8_STAGE(PG8_SB(0, 0), cB, voffB); PG8_STAGE(PG8_SB(0, 1), cB + hstep, voffB); PG8_STAGE(PG8_SA(0, 0), cA, voffA); PG8_STAGE(PG8_SA(0, 1), cA + hstep, voffA);
        if (wr == 1) PG8_BAR;
        PG8_WAIT_V(2); PG8_BAR;
        PG8_STAGE(PG8_SB(1, 0), cB + kstep, voffB); PG8_STAGE(PG8_SA(1, 0), cA + kstep, voffA); PG8_STAGE(PG8_SB(1, 1), cB + hstep + kstep, voffB);
        PG8_WAIT_V(6); PG8_BAR;
    }
    for (;;) {
        const bool has_next = S.next(ui + 1, nxt);
        const Unit nu = has_next ? nxt : cur;
        for (int t = 0; t < nt; t += 2) {
            if (NSEG == 2 && t == NTS) E.mid(acc, cur, wr, wc, fr, fq);
            const bool last = (t == nt - 2);
            const char* a1 = PG8_TA(cur, t + 1);
            const char* a2 = last ? PG8_TA(nu, 0) : PG8_TA(cur, t + 2); const char* b2 = last ? PG8_TB(nu, 0) : PG8_TB(cur, t + 2);
            const char* a3 = a2 + kstep; const char* b3 = b2 + kstep;
            PG8_LDB(B0, 0, 0); PG8_LDB(B1, 0, 1); PG8_SCHED; PG8_LDA(At, 0, 0); PG8_STAGE(PG8_SA(1, 1), a1 + hstep, voffA);
            PG8_WAIT_V(8); PG8_WAIT_L(0); PG8_BAR; PG8_MMA(0, 0, At, B0); PG8_MMA(0, 1, At, B1); PG8_BAR; PG8_SCHED;
            PG8_LDA(At, 0, 1); PG8_STAGE(PG8_SB(0, 0), b2, voffB); PG8_STAGE(PG8_SB(0, 1), b2 + hstep, voffB); PG8_STAGE(PG8_SA(0, 0), a2, voffA);
            PG8_WAIT_V(8); PG8_WAIT_L(0); PG8_BAR; PG8_MMA(1, 0, At, B0); PG8_MMA(1, 1, At, B1); PG8_BAR; PG8_SCHED;
            PG8_LDB(B0, 1, 0); PG8_LDB(B1, 1, 1); PG8_SCHED; PG8_LDA(At, 1, 0); PG8_STAGE(PG8_SA(0, 1), a2 + hstep, voffA);
            PG8_WAIT_V(8); PG8_WAIT_L(0); PG8_BAR; PG8_MMA(0, 0, At, B0); PG8_MMA(0, 1, At, B1); PG8_BAR; PG8_SCHED;
            PG8_LDA(At, 1, 1); PG8_STAGE(PG8_SB(1, 0), b3, voffB); PG8_STAGE(PG8_SB(1, 1), b3 + hstep, voffB); PG8_STAGE(PG8_SA(1, 0), a3, voffA);
            PG8_WAIT_V(8); PG8_WAIT_L(0); PG8_BAR; PG8_MMA(1, 0, At, B0); PG8_MMA(1, 1, At, B1); PG8_BAR; PG8_SCHED;
        }
        if (wr == 0) PG8_BAR;
        E(acc, cur, wr, wc, fr, fq);
        if (!has_next) break;
#pragma unroll
        for (int a = 0; a < 2; ++a)
#pragma unroll
            for (int b = 0; b < 2; ++b)
#pragma unroll
                for (int m = 0; m < 4; ++m)
#pragma unroll
                    for (int n = 0; n < 2; ++n) acc[a][b][m][n] = (f32x4){0.f, 0.f, 0.f, 0.f};
        cur = nxt; ++ui;
        if (wr == 1) PG8_BAR;
    }
    PG8_WAIT_V(0);
    PG8_BAR;
#undef PG8_SA
#undef PG8_SB
#undef PG8_STAGE
#undef PG8_LDA
#undef PG8_LDB
#undef PG8_MMA
#undef PG8_WAIT_V
#undef PG8_WAIT_L
#undef PG8_WAIT_VR
#undef PG8_BAR
#undef PG8_SCHED
#undef PG8_TA
#undef PG8_TB
}
}


#define XB_TMO      128
#define XB_XCNT(j)  (256  + 64 * (j))
#define XB_XSUB(j)  (1280 + 64 * (j))
#define XB_XGEN(j)  (2304 + 64 * (j))
#define XB_TOP      3328
#define XB_TOPGEN   3392
#define XCD_BAR_WORDS 3456
#define XB_SPIN_CAP (1u << 18)
DI unsigned xb_ld(unsigned* p)              { return __hip_atomic_load(p, __ATOMIC_RELAXED, __HIP_MEMORY_SCOPE_AGENT); }
DI unsigned xb_add(unsigned* p, unsigned v) { return __hip_atomic_fetch_add(p, v, __ATOMIC_RELAXED, __HIP_MEMORY_SCOPE_AGENT); }
DI unsigned xb_xcc_id() { return (unsigned)__builtin_amdgcn_s_getreg((3 << 11) | 20) & 0xFu; }
#define XB_SPIN(cond, bar) do { unsigned _sp = 0; while (cond) { __builtin_amdgcn_s_sleep(1); \
    if ((++_sp & 255u) == 0u) { if (xb_ld(&(bar)[XB_TMO])) break; if (_sp > XB_SPIN_CAP) { atomicAdd(&(bar)[XB_TMO], 1u); break; } } } } while (0)
struct XcdBarrier { unsigned* bar; unsigned x; volatile LAS unsigned* st; };
DI XcdBarrier xcd_barrier_post(unsigned* bar, volatile LAS unsigned* st) {
    XcdBarrier b; b.bar = bar; b.x = xb_xcc_id(); b.st = st;
    if (threadIdx.x == 0) (void)xb_add(&bar[XB_XCNT(b.x)], 1u);
    return b;
}
DI void xcd_barrier_complete(unsigned* bar, unsigned x, unsigned& nloc, unsigned& nx) {
    const unsigned G = gridDim.x * gridDim.y * gridDim.z;
    unsigned sum, cnt, mine, sp = 0u;
    for (;;) {
        sum = 0u; cnt = 0u; mine = 0u;
#pragma unroll
        for (unsigned j = 0; j < 16; ++j) { const unsigned c = xb_ld(&bar[XB_XCNT(j)]); sum += c; cnt += (c > 0u) ? 1u : 0u; mine = (j == x) ? c : mine; }
        if (sum == G) break;
        __builtin_amdgcn_s_sleep(1);
        if ((++sp & 255u) == 0u) { if (xb_ld(&bar[XB_TMO])) break; if (sp > XB_SPIN_CAP) { atomicAdd(&bar[XB_TMO], 1u); break; } }
    }
    nloc = mine > 0u ? mine : 1u; nx = cnt > 0u ? cnt : 1u;
}
DI void xcd_barrier(const XcdBarrier& b) {
    asm volatile("s_waitcnt vmcnt(0)" ::: "memory");
    __syncthreads();
    if (threadIdx.x == 0) {
        unsigned* bar = b.bar;
        __builtin_amdgcn_s_waitcnt(0);
        unsigned nloc = b.st[0], nx = b.st[1];
        if (nloc == 0u) { xcd_barrier_complete(bar, b.x, nloc, nx); b.st[0] = nloc; b.st[1] = nx; }
        const unsigned old = xb_add(&bar[XB_XSUB(b.x)], 1u);
        const unsigned gen = old / nloc;
        if (old + 1u == (gen + 1u) * nloc) {
            __builtin_amdgcn_fence(__ATOMIC_RELEASE, "agent");
            asm volatile("s_waitcnt vmcnt(0)" ::: "memory");
            const unsigned og = xb_add(&bar[XB_TOP], 1u);
            const unsigned tg = og / nx;
            if (og + 1u == (tg + 1u) * nx) xb_add(&bar[XB_TOPGEN], 1u);
            else XB_SPIN(xb_ld(&bar[XB_TOPGEN]) == tg, bar);
            __builtin_amdgcn_fence(__ATOMIC_ACQUIRE, "agent");
            xb_add(&bar[XB_XGEN(b.x)], 1u);
            asm volatile("s_waitcnt vmcnt(0)" ::: "memory");
        } else {
            XB_SPIN(xb_ld(&bar[XB_XGEN(b.x)]) == gen, bar);
            __builtin_amdgcn_fence(__ATOMIC_ACQUIRE, "agent");
            asm volatile("s_waitcnt vmcnt(0)" ::: "memory");
        }
    }
    __syncthreads();
}

struct Args { const float* in[16]; float* out; unsigned char* ws; int ph_lo, ph_hi; unsigned naive; int pad; };
struct Ctx {
    LAS unsigned char* lds;
    const float *x, *c, *ctx, *c_ctx, *norm_w, *ada_w, *ada_b, *w_in, *conv_w, *conv_b, *decay_logit, *gn_w, *w_a, *w_b, *w_out, *final_w;
    float* out; unsigned char* ws;
    float* MOD; f32x2* ROPE;
    bf16_t *WA, *WB, *WOUT, *WIN, *XM, *KV, *KVC, *HC, *ST, *MM, *P, *Q, *K, *V, *SZB, *KC, *VC, *UB, *R, *SGB;
    float* RET; float* S0;
};

DI int win_dest(int o) {
    if (o < 4096) { const int g = o >> 10, ch = o & 1023; return 256 * (ch >> 6) + 64 * g + (ch & 63); }
    if (o < 5120) { const int qk = (o - 4096) >> 9, oo = (o - 4096) & 511, head = oo >> 6, i = oo & 63, t = head >> 2, hh = head & 3;
        return 256 * (16 + 2 * qk + t) + (i < 32 ? 32 * hh + i : 128 + 32 * hh + (i - 32)); }
    if (o < 7168) return o;
    { const int gs = (o - 7168) >> 10, ch = (o - 7168) & 1023; return 256 * (28 + (ch >> 7)) + 128 * gs + (ch & 127); }
}
DI void p0_transpose_item(const float* W, int K, int N, bf16_t* WT, bool permute, LAS float* scr, int item, int lane) {
    const int nblk = N / 32, kb = item / nblk, nb = item % nblk, k0 = 64 * kb, n0 = 32 * nb;
    float rv[32];
#pragma unroll
    for (int i = 0; i < 32; ++i) rv[i] = W[(size_t)(k0 + 2 * i + (lane >> 5)) * N + n0 + (lane & 31)];
#pragma unroll
    for (int i = 0; i < 32; ++i) scr[(2 * i + (lane >> 5)) * 33 + (lane & 31)] = rv[i];
    asm volatile("s_waitcnt lgkmcnt(0)" ::: "memory");
    const int c = lane & 7; const int d0 = permute ? win_dest(n0) : n0;
#pragma unroll
    for (int j = 0; j < 4; ++j) { const int n = (lane >> 3) + 8 * j; const LAS float* s = scr + (8 * c) * 33 + n;
        u32x4 o; o.x = cvt_pk_bf16(s[0 * 33], s[1 * 33]); o.y = cvt_pk_bf16(s[2 * 33], s[3 * 33]); o.z = cvt_pk_bf16(s[4 * 33], s[5 * 33]); o.w = cvt_pk_bf16(s[6 * 33], s[7 * 33]);
        *(u32x4*)(WT + (size_t)(d0 + n) * K + k0 + 8 * c) = o; }
    asm volatile("s_waitcnt lgkmcnt(0)" ::: "memory");
}
DI void p0_prologue(const Ctx& F) {
    const Tid T = opaque_tid();
    if (blockIdx.x < 48) {
        LAS float* red = (LAS float*)F.lds;
        LAS float* sl = (LAS float*)(F.lds + 16384);
        for (int e = T.tid; e < 5 * 1024; e += 512) { const int v = e >> 10, k = e & 1023; sl[e] = siluf(v < 4 ? F.c[v * 1024 + k] : F.c_ctx[k]); }
        __syncthreads();
        const int n0 = 64 * blockIdx.x, k0 = 128 * T.wave;
        float a[5] = {0.f, 0.f, 0.f, 0.f, 0.f};
#pragma unroll 4
        for (int kb = 0; kb < 128; kb += 32) {
            float wv[32];
#pragma unroll
            for (int k = 0; k < 32; ++k) wv[k] = F.ada_w[(size_t)(k0 + kb + k) * 3072 + n0 + T.lane];
#pragma unroll
            for (int k = 0; k < 32; ++k)
#pragma unroll
                for (int v = 0; v < 5; ++v) a[v] += sl[v * 1024 + k0 + kb + k] * wv[k];
        }
#pragma unroll
        for (int v = 0; v < 5; ++v) red[(T.wave * 5 + v) * 64 + T.lane] = a[v];
        __syncthreads();
        if (T.tid < 320) { const int v = T.tid >> 6, l = T.tid & 63; float s = F.ada_b[n0 + l];
#pragma unroll
            for (int w = 0; w < 8; ++w) s += red[(w * 5 + v) * 64 + l];
            F.MOD[v * 3072 + n0 + l] = s; }
        __syncthreads();
    }
    if (blockIdx.x == 48) {
        for (int e = T.tid; e < 1024; e += 512) { const int p = e >> 4, f = e & 15; const float inv = powf(10000.f, -(float)f / 16.f); const float ang = (float)p * inv;
            F.ROPE[e] = (f32x2){cosf(ang), sinf(ang)}; }
    }
    LAS float* scr = (LAS float*)(F.lds + T.wave * 16384);
    const int gw = blockIdx.x * 8 + T.wave, NGW = gridDim.x * 8;
    constexpr int I_IN = 16 * (NIN / 32), I_SQ = 16 * 32;
    for (int it = gw; it < I_IN + 3 * I_SQ; it += NGW) {
        int r = it;
        if (r < I_IN) { p0_transpose_item(F.w_in, 1024, NIN, F.WIN, true, scr, r, T.lane); continue; } r -= I_IN;
        if (r < I_SQ) { p0_transpose_item(F.w_a, 1024, 1024, F.WA, false, scr, r, T.lane); continue; } r -= I_SQ;
        if (r < I_SQ) { p0_transpose_item(F.w_b, 1024, 1024, F.WB, false, scr, r, T.lane); continue; } r -= I_SQ;
        p0_transpose_item(F.w_out, 1024, 1024, F.WOUT, false, scr, r, T.lane);
    }
}
DI void p1_rows(const Ctx& F) {
    const Tid T = opaque_tid();
    const int gw = blockIdx.x * 8 + T.wave, NGW = gridDim.x * 8;
    constexpr int RB = 4;
    for (int m0 = gw * RB; m0 < MALL; m0 += NGW * RB) {
        f32x4 v[RB][4]; float ss[RB];
#pragma unroll
        for (int r = 0; r < RB; ++r) { const int m = m0 + r; const float* xr = m < MTOK ? F.x + (size_t)m * DM : F.ctx + (size_t)(m - MTOK) * DM;
#pragma unroll
            for (int j = 0; j < 4; ++j) v[r][j] = ((const f32x4*)xr)[T.lane + 64 * j]; }
#pragma unroll
        for (int r = 0; r < RB; ++r) { float s = 0.f;
#pragma unroll
            for (int j = 0; j < 4; ++j) s += (v[r][j].x * v[r][j].x + v[r][j].y * v[r][j].y) + (v[r][j].z * v[r][j].z + v[r][j].w * v[r][j].w);
            ss[r] = s; }
#pragma unroll
        for (int o = 1; o < 64; o <<= 1)
#pragma unroll
            for (int r = 0; r < RB; ++r) ss[r] += __shfl_xor(ss[r], o);
        const int mb = m0 < MTOK ? (m0 >> 12) : 4; const float* mod = F.MOD + mb * 3072;
#pragma unroll
        for (int j = 0; j < 4; ++j) { const int col = 4 * (T.lane + 64 * j);
            const f32x4 w = *(const f32x4*)(F.norm_w + col), sh = *(const f32x4*)(mod + col), sc = *(const f32x4*)(mod + 1024 + col);
#pragma unroll
            for (int r = 0; r < RB; ++r) { const float rstd = __builtin_amdgcn_rsqf(ss[r] * (1.f / DM) + EPS);
                const f32x4 y = (v[r][j] * rstd * w) * (sc + 1.0f) + sh;
                u32x2 o; o.x = cvt_pk_bf16(y.x, y.y); o.y = cvt_pk_bf16(y.z, y.w);
                *(u32x2*)(F.XM + (size_t)(m0 + r) * DM + col) = o; } }
    }
}
struct Sched1 {
    int G, c;
    DI bool next(int i, pg8::Unit& u) const { const int L = i * G + c; if (L >= 64 * 36) return false; pg8::tile_of(L, 64, 36, u); return true; }
};
struct SchedCtx {
    int c;
    DI bool next(int i, pg8::Unit& u) const { if (i > 0 || c >= 24) return false; u.pm = 64 + c / 6; u.pn = 18 + c % 6; return true; }
};
struct Epi1 {
    unsigned char* ws; bf16_t *R, *SGB; const f32x2* rope;
    DI int vm_ops(const pg8::Unit& u) const { return u.pn < 16 ? 8 : 16; }
    DI void mid(f32x4 (&)[2][2][4][2], const pg8::Unit&, int, int, int, int) const {}
    DI void operator()(const f32x4 (&acc)[2][2][4][2], const pg8::Unit& u, int wr, int wc, int fr, int fq) const {
        const int pn = u.pn, row0 = u.pm * 256 + wr * 64 + fr, x0 = wc * 32 + 8 * fq;
        const bool isctx = u.pm >= 64;
        if (pn < 16) {
            bf16_t* dst = (bf16_t*)(ws + (wc < 2 ? WS_HC : WS_P)) + 64 * pn + (x0 & 63);
#pragma unroll
            for (int ai = 0; ai < 2; ++ai)
#pragma unroll
                for (int m = 0; m < 4; ++m) { const size_t row = row0 + ai * 128 + m * 16;
                    f32x4 o[2];
#pragma unroll
                    for (int n = 0; n < 2; ++n) { const f32x4 a = acc[ai][0][m][n], b = acc[ai][1][m][n];
                        if (wc < 2) o[n] = a * b;
                        else { o[n].x = a.x * siluf(b.x); o[n].y = a.y * siluf(b.y); o[n].z = a.z * siluf(b.z); o[n].w = a.w * siluf(b.w); } }
                    u32x4 w; w.x = cvt_pk_bf16(o[0].x, o[0].y); w.y = cvt_pk_bf16(o[0].z, o[0].w); w.z = cvt_pk_bf16(o[1].x, o[1].y); w.w = cvt_pk_bf16(o[1].z, o[1].w);
                    *(u32x4*)(dst + row * 1024) = w; }
        } else if (pn < 20) {
            const int t = (pn - 16) & 1, isk = (pn - 16) >> 1, head = 4 * t + wc, i0 = 8 * fq;
            const float scale = isk ? 0.125f : 1.0f;
            bf16_t* base = (bf16_t*)(ws + (isk ? (isctx ? WS_KC : WS_K) : WS_Q));
#pragma unroll
            for (int ai = 0; ai < 2; ++ai)
#pragma unroll
                for (int m = 0; m < 4; ++m) { const int row = row0 + ai * 128 + m * 16; const int orow = isctx ? row - MTOK : row;
                    const int pos = row & 4095, pidx = (fq < 2) ? (pos >> 6) : (pos & 63);
                    const f32x2* rp = rope + pidx * 16 + (fq & 1) * 8;
                    float o1[8], o2[8];
#pragma unroll
                    for (int e = 0; e < 8; ++e) { f32x2 cs = rp[e]; if (isctx) cs = (f32x2){1.f, 0.f};
                        const float t1 = acc[ai][0][m][e >> 2][e & 3], t2 = acc[ai][1][m][e >> 2][e & 3];
                        o1[e] = (t1 * cs.x - t2 * cs.y) * scale; o2[e] = (t1 * cs.y + t2 * cs.x) * scale; }
                    u32x4 w1, w2; w1.x = cvt_pk_bf16(o1[0], o1[1]); w1.y = cvt_pk_bf16(o1[2], o1[3]); w1.z = cvt_pk_bf16(o1[4], o1[5]); w1.w = cvt_pk_bf16(o1[6], o1[7]);
                    w2.x = cvt_pk_bf16(o2[0], o2[1]); w2.y = cvt_pk_bf16(o2[2], o2[3]); w2.z = cvt_pk_bf16(o2[4], o2[5]); w2.w = cvt_pk_bf16(o2[6], o2[7]);
                    bf16_t* d = base + (size_t)orow * 512 + head * 64 + i0;
                    *(u32x4*)d = w1; *(u32x4*)(d + 32) = w2; }
        } else if (pn < 28) {
            const bool isz = pn >= 24;
            bf16_t* base = (bf16_t*)(ws + (isz ? WS_SZB : (isctx ? WS_VC : WS_V)));
            const int colt = 256 * (pn - (isz ? 24 : 20)) + x0;
#pragma unroll
            for (int ai = 0; ai < 2; ++ai)
#pragma unroll
                for (int m = 0; m < 4; ++m) { const int row = row0 + ai * 128 + m * 16; const int orow = isctx ? row - MTOK : row;
#pragma unroll
                    for (int bj = 0; bj < 2; ++bj) { f32x4 a = acc[ai][bj][m][0], b = acc[ai][bj][m][1];
                        u32x4 w; w.x = cvt_pk_bf16(a.x, a.y); w.y = cvt_pk_bf16(a.z, a.w); w.z = cvt_pk_bf16(b.x, b.y); w.w = cvt_pk_bf16(b.z, b.w);
                        if (isz) __builtin_nontemporal_store(w, (u32x4*)(base + (size_t)orow * 1024 + colt + bj * 128)); else *(u32x4*)(base + (size_t)orow * 1024 + colt + bj * 128) = w; } }
        } else {
            const int col = 128 * (pn - 28) + x0;
#pragma unroll
            for (int ai = 0; ai < 2; ++ai)
#pragma unroll
                for (int m = 0; m < 4; ++m) { const size_t row = row0 + ai * 128 + m * 16;
                    float rr[8], sg[8];
#pragma unroll
                    for (int e = 0; e < 8; ++e) { const float ga = acc[ai][0][m][e >> 2][e & 3], gb = acc[ai][1][m][e >> 2][e & 3];
                        const float ea = 1.f + __expf(-ga), eb = 1.f + __expf(-gb); sg[e] = __builtin_amdgcn_rcpf(eb); rr[e] = eb * __builtin_amdgcn_rcpf(ea); }
                    u32x4 w1, w2; w1.x = cvt_pk_bf16(rr[0], rr[1]); w1.y = cvt_pk_bf16(rr[2], rr[3]); w1.z = cvt_pk_bf16(rr[4], rr[5]); w1.w = cvt_pk_bf16(rr[6], rr[7]);
                    w2.x = cvt_pk_bf16(sg[0], sg[1]); w2.y = cvt_pk_bf16(sg[2], sg[3]); w2.z = cvt_pk_bf16(sg[4], sg[5]); w2.w = cvt_pk_bf16(sg[6], sg[7]);
                    __builtin_nontemporal_store(w1, (u32x4*)(R + row * 1024 + col)); __builtin_nontemporal_store(w2, (u32x4*)(SGB + row * 1024 + col)); }
        }
    }
};
DI void n2_inproj(const Ctx& F) {
    const Tid T = opaque_tid();
    const size_t NT = (size_t)gridDim.x * 512, gt = (size_t)blockIdx.x * 512 + T.tid;
    for (size_t idx = gt; idx < (size_t)(MALL / 4) * 1024; idx += NT) {
        const int ch = (int)(idx & 1023), t0 = (int)(idx >> 10) * 4;
        const bool doqk = ch < 512 && (ch & 63) < 32;
        float a[12][4];
#pragma unroll
        for (int o = 0; o < 12; ++o)
#pragma unroll
            for (int j = 0; j < 4; ++j) a[o][j] = 0.f;
        for (int k = 0; k < 1024; ++k) {
            const float* wr = F.w_in + (size_t)k * NIN;
            float xv[4];
#pragma unroll
            for (int j = 0; j < 4; ++j) xv[j] = bf2f(F.XM[(size_t)(t0 + j) * 1024 + k]);
            float w[12];
            w[0] = wr[ch]; w[1] = wr[1024 + ch]; w[2] = wr[2048 + ch]; w[3] = wr[3072 + ch]; w[4] = wr[5120 + ch]; w[5] = wr[6144 + ch]; w[6] = wr[7168 + ch]; w[7] = wr[8192 + ch];
            if (doqk) { w[8] = wr[4096 + ch]; w[9] = wr[4096 + ch + 32]; w[10] = wr[4608 + ch]; w[11] = wr[4608 + ch + 32]; } else { w[8] = w[9] = w[10] = w[11] = 0.f; }
#pragma unroll
            for (int o = 0; o < 12; ++o)
#pragma unroll
                for (int j = 0; j < 4; ++j) a[o][j] += xv[j] * w[o];
        }
#pragma unroll
        for (int j = 0; j < 4; ++j) { const int t = t0 + j;
            if (t < MTOK) {
                const size_t o = (size_t)t * 1024 + ch;
                F.HC[o] = f2bf(a[2][j] * a[0][j]); F.P[o] = f2bf(siluf(a[3][j]) * a[1][j]); F.V[o] = f2bf(a[4][j]); F.SZB[o] = f2bf(a[5][j]);
                const float sga = 1.f / (1.f + __expf(-a[6][j])), sgb = 1.f / (1.f + __expf(-a[7][j]));
                F.R[o] = f2bf(sga / sgb); F.SGB[o] = f2bf(sgb);
                if (doqk) { const int i = ch & 63, pos = t & 4095; const int pidx = i < 16 ? (pos >> 6) : (pos & 63); const f32x2 cs = F.ROPE[pidx * 16 + (i & 15)];
                    const size_t q = (size_t)t * 512 + ch;
                    F.Q[q] = f2bf(a[8][j] * cs.x - a[9][j] * cs.y); F.Q[q + 32] = f2bf(a[8][j] * cs.y + a[9][j] * cs.x);
                    F.K[q] = f2bf((a[10][j] * cs.x - a[11][j] * cs.y) * 0.125f); F.K[q + 32] = f2bf((a[10][j] * cs.y + a[11][j] * cs.x) * 0.125f); }
            } else {
                const int tc = t - MTOK;
                F.VC[(size_t)tc * 1024 + ch] = f2bf(a[4][j]);
                if (doqk) { F.KC[(size_t)tc * 512 + ch] = f2bf(a[10][j] * 0.125f); F.KC[(size_t)tc * 512 + ch + 32] = f2bf(a[11][j] * 0.125f); }
            }
        }
    }
}
DI bf16x8 tr2(const LAS unsigned char* p, int delta) {
    const s16x4 lo = __builtin_bit_cast(s16x4, __builtin_amdgcn_ds_read_tr16_b64_v4i16((LAS v4i16_t*)p));
    const s16x4 hi = __builtin_bit_cast(s16x4, __builtin_amdgcn_ds_read_tr16_b64_v4i16((LAS v4i16_t*)(p + delta)));
    return __builtin_shufflevector(lo, hi, 0, 1, 2, 3, 4, 5, 6, 7);
}
DI u32x4 scale8(u32x4 w, float s) {
    u32x4 o; o.x = cvt_pk_bf16(bflo(w.x) * s, bfhi(w.x) * s); o.y = cvt_pk_bf16(bflo(w.y) * s, bfhi(w.y) * s); o.z = cvt_pk_bf16(bflo(w.z) * s, bfhi(w.z) * s); o.w = cvt_pk_bf16(bflo(w.w) * s, bfhi(w.w) * s); return o;
}
DI void p3_kv(const Ctx& F, int it0, int it1, int stride) {
    const Tid T = opaque_tid();
    LAS unsigned char* KFI = F.lds; LAS unsigned char* KBI = F.lds + 20480; LAS unsigned char* VI = F.lds + 40960;
    const int tid = T.tid, lane = T.lane, w = T.wave, g = lane >> 4, q = (lane & 15) >> 2, p = lane & 3;
    const int row = tid >> 2, seg = tid & 3;
    u32x4 pk[2], pv[4];
    auto prefetch = [&](int it) { const int bh = it >> 5, c = it & 31; const size_t tok0 = (size_t)(bh >> 3) * SEQ + c * CHK;
        const bf16_t* kp = F.K + tok0 * 512 + (bh & 7) * 64; const bf16_t* vp = F.V + tok0 * 1024 + (bh & 7) * 128;
        pk[0] = *(const u32x4*)(kp + (size_t)row * 512 + seg * 16); pk[1] = *(const u32x4*)(kp + (size_t)row * 512 + seg * 16 + 8);
#pragma unroll
        for (int i = 0; i < 4; ++i) pv[i] = *(const u32x4*)(vp + (size_t)row * 1024 + seg * 32 + 8 * i); };
    if (it0 < it1) prefetch(it0);
    for (int it = it0; it < it1; it += stride) {
        const int bh = it >> 5, c = it & 31;
        const float l2f = log2_gamma(F.decay_logit, 0, bh & 7), l2b = log2_gamma(F.decay_logit, 1, bh & 7);
        { const float df = __builtin_amdgcn_exp2f(l2f * (float)(127 - row)), db = __builtin_amdgcn_exp2f(l2b * (float)row);
            *(LAS u32x4*)(KFI + row * 160 + seg * 32) = scale8(pk[0], df); *(LAS u32x4*)(KFI + row * 160 + seg * 32 + 16) = scale8(pk[1], df);
            *(LAS u32x4*)(KBI + row * 160 + seg * 32) = scale8(pk[0], db); *(LAS u32x4*)(KBI + row * 160 + seg * 32 + 16) = scale8(pk[1], db);
#pragma unroll
            for (int i = 0; i < 4; ++i) *(LAS u32x4*)(VI + row * 288 + seg * 64 + 16 * i) = pv[i]; }
        __syncthreads();
        if (it + stride < it1) prefetch(it + stride);
        f32x4 acc[2][4];
#pragma unroll
        for (int d = 0; d < 2; ++d)
#pragma unroll
            for (int nb = 0; nb < 4; ++nb) acc[d][nb] = (f32x4){0.f, 0.f, 0.f, 0.f};
#pragma unroll
        for (int s2 = 0; s2 < 4; ++s2) {
            const bf16x8 vb = tr2(VI + (32 * s2 + 8 * g + q) * 288 + (16 * w + 4 * p) * 2, 4 * 288);
#pragma unroll
            for (int nb = 0; nb < 4; ++nb) {
                const bf16x8 kf = tr2(KFI + (32 * s2 + 8 * g + q) * 160 + (16 * nb + 4 * p) * 2, 4 * 160);
                const bf16x8 kb = tr2(KBI + (32 * s2 + 8 * g + q) * 160 + (16 * nb + 4 * p) * 2, 4 * 160);
                acc[0][nb] = __builtin_amdgcn_mfma_f32_16x16x32_bf16(kf, vb, acc[0][nb], 0, 0, 0);
                acc[1][nb] = __builtin_amdgcn_mfma_f32_16x16x32_bf16(kb, vb, acc[1][nb], 0, 0, 0);
            }
        }
        bf16_t* of = F.KV + ((size_t)(0 * 32 + bh) * 32 + c) * 8192; bf16_t* ob = F.KV + ((size_t)(1 * 32 + bh) * 32 + c) * 8192;
#pragma unroll
        for (int nb = 0; nb < 4; ++nb) { const int o = (16 * w + (lane & 15)) * 64 + 16 * nb + 4 * g;
            u32x2 a, b; a.x = cvt_pk_bf16(acc[0][nb].x, acc[0][nb].y); a.y = cvt_pk_bf16(acc[0][nb].z, acc[0][nb].w); b.x = cvt_pk_bf16(acc[1][nb].x, acc[1][nb].y); b.y = cvt_pk_bf16(acc[1][nb].z, acc[1][nb].w);
            *(u32x2*)(of + o) = a; *(u32x2*)(ob + o) = b; }
        __syncthreads();
    }
}
DI void p4_ctx_state(const Ctx& F, int bh) {
    const Tid T = opaque_tid();
    LAS unsigned char* KFI = F.lds; LAS unsigned char* KBI = F.lds + 20480; LAS unsigned char* VI = F.lds + 40960;
    const int tid = T.tid, lane = T.lane, w = T.wave, g = lane >> 4, q = (lane & 15) >> 2, p = lane & 3;
    const int row = tid >> 2, seg = tid & 3;
    const float l2f = log2_gamma(F.decay_logit, 0, bh & 7), l2b = log2_gamma(F.decay_logit, 1, bh & 7);
    f32x4 acc[2][4];
#pragma unroll
    for (int d = 0; d < 2; ++d)
#pragma unroll
        for (int nb = 0; nb < 4; ++nb) acc[d][nb] = (f32x4){0.f, 0.f, 0.f, 0.f};
    for (int cc = 0; cc < 2; ++cc) {
        const size_t tok0 = (size_t)(bh >> 3) * CTXL + cc * CHK; const int m = cc * CHK + row;
        const bf16_t* kp = F.KC + tok0 * 512 + (bh & 7) * 64; const bf16_t* vp = F.VC + tok0 * 1024 + (bh & 7) * 128;
        const u32x4 k0 = *(const u32x4*)(kp + (size_t)row * 512 + seg * 16), k1 = *(const u32x4*)(kp + (size_t)row * 512 + seg * 16 + 8);
        const float df = __builtin_amdgcn_exp2f(l2f * (float)(255 - m)), db = __builtin_amdgcn_exp2f(l2b * (float)m);
        *(LAS u32x4*)(KFI + row * 160 + seg * 32) = scale8(k0, df); *(LAS u32x4*)(KFI + row * 160 + seg * 32 + 16) = scale8(k1, df);
        *(LAS u32x4*)(KBI + row * 160 + seg * 32) = scale8(k0, db); *(LAS u32x4*)(KBI + row * 160 + seg * 32 + 16) = scale8(k1, db);
#pragma unroll
        for (int i = 0; i < 4; ++i) *(LAS u32x4*)(VI + row * 288 + seg * 64 + 16 * i) = *(const u32x4*)(vp + (size_t)row * 1024 + seg * 32 + 8 * i);
        __syncthreads();
#pragma unroll
        for (int s2 = 0; s2 < 4; ++s2) {
            const bf16x8 vb = tr2(VI + (32 * s2 + 8 * g + q) * 288 + (16 * w + 4 * p) * 2, 4 * 288);
#pragma unroll
            for (int nb = 0; nb < 4; ++nb) {
                const bf16x8 kf = tr2(KFI + (32 * s2 + 8 * g + q) * 160 + (16 * nb + 4 * p) * 2, 4 * 160);
                const bf16x8 kb = tr2(KBI + (32 * s2 + 8 * g + q) * 160 + (16 * nb + 4 * p) * 2, 4 * 160);
                acc[0][nb] = __builtin_amdgcn_mfma_f32_16x16x32_bf16(kf, vb, acc[0][nb], 0, 0, 0);
                acc[1][nb] = __builtin_amdgcn_mfma_f32_16x16x32_bf16(kb, vb, acc[1][nb], 0, 0, 0);
            }
        }
        __syncthreads();
    }
    float* of = F.S0 + (size_t)(0 * 32 + bh) * 8192; float* ob = F.S0 + (size_t)(1 * 32 + bh) * 8192;
#pragma unroll
    for (int nb = 0; nb < 4; ++nb) { const int o = (16 * w + (lane & 15)) * 64 + 16 * nb + 4 * g; *(f32x4*)(of + o) = acc[0][nb]; *(f32x4*)(ob + o) = acc[1][nb]; }
}
DI void p3_ua(const Ctx& F, int blk, int nblk) {
    const Tid T = opaque_tid();
    const size_t NT = (size_t)nblk * 512, gt = (size_t)blk * 512 + T.tid;
    for (size_t idx = gt; idx < (size_t)MTOK * 128; idx += NT) {
        const int t = (int)(idx >> 7), c8 = (int)(idx & 127) * 8, pos = t & 4095;
        const bf16_t* hp = F.HC + (size_t)t * 1024 + c8;
        const u32x4 z = (u32x4){0u, 0u, 0u, 0u};
        const u32x4 h0 = pos > 0 ? *(const u32x4*)(hp - 1024) : z, h1 = *(const u32x4*)hp, h2 = pos < SEQ - 1 ? *(const u32x4*)(hp + 1024) : z;
        const u32x4 pv = *(const u32x4*)(F.P + (size_t)t * 1024 + c8);
        float o[8];
#pragma unroll
        for (int e = 0; e < 8; ++e) { const unsigned a = h0[e >> 1], b = h1[e >> 1], c = h2[e >> 1], pp = pv[e >> 1];
            const float x0 = (e & 1) ? bfhi(a) : bflo(a), x1 = (e & 1) ? bfhi(b) : bflo(b), x2 = (e & 1) ? bfhi(c) : bflo(c), pf = (e & 1) ? bfhi(pp) : bflo(pp);
            const float cv = F.conv_w[c8 + e] * x0 + F.conv_w[1024 + c8 + e] * x1 + F.conv_w[2048 + c8 + e] * x2 + F.conv_b[c8 + e];
            o[e] = pf * cv; }
        u32x4 w; w.x = cvt_pk_bf16(o[0], o[1]); w.y = cvt_pk_bf16(o[2], o[3]); w.z = cvt_pk_bf16(o[4], o[5]); w.w = cvt_pk_bf16(o[6], o[7]);
        *(u32x4*)(F.P + (size_t)t * 1024 + c8) = w;
    }
}
DI void p4_scan(const Ctx& F, int blk, int nblk) {
    const Tid T = opaque_tid();
    const size_t NT = (size_t)nblk * 512, gt = (size_t)blk * 512 + T.tid;
    for (size_t idx = gt; idx < (size_t)2 * 32 * 2048; idx += NT) {
        const int e4 = (int)(idx & 2047), bh = (int)(idx >> 11) & 31, dir = (int)(idx >> 16);
        const float g = exp2f(log2_gamma(F.decay_logit, dir, bh & 7) * 128.f);
        const u32x2* kv = (const u32x2*)(F.KV + ((size_t)(dir * 32 + bh) * 32) * 8192) + e4;
        u32x2* st = (u32x2*)(F.ST + ((size_t)(dir * 32 + bh) * 32) * 8192) + e4;
        float s0 = 0.f, s1 = 0.f, s2 = 0.f, s3 = 0.f;
        u32x2 v[32];
#pragma unroll
        for (int i = 0; i < 32; ++i) v[i] = kv[(size_t)(dir == 0 ? i : 31 - i) * 2048];
#pragma unroll
        for (int i = 0; i < 32; ++i) { const int c = dir == 0 ? i : 31 - i;
            u32x2 o; o.x = cvt_pk_bf16(s0, s1); o.y = cvt_pk_bf16(s2, s3); st[(size_t)c * 2048] = o;
            s0 = g * s0 + bflo(v[i].x); s1 = g * s1 + bfhi(v[i].x); s2 = g * s2 + bflo(v[i].y); s3 = g * s3 + bfhi(v[i].y); }
    }
}
DI void n4_recurrence(const Ctx& F) {
    const Tid T = opaque_tid();
    const int gw = blockIdx.x * 8 + T.wave, NGW = gridDim.x * 8, d = T.lane;
    for (int task = gw; task < 32 * 128; task += NGW) {
        const int bh = task >> 7, v = task & 127, b = bh >> 3, h = bh & 7;
        const float gf = exp2f(log2_gamma(F.decay_logit, 0, h)), gb = exp2f(log2_gamma(F.decay_logit, 1, h));
        float s = 0.f;
        for (int m = 0; m < CTXL; ++m) { const size_t t = (size_t)b * CTXL + m; s = gf * s + bf2f(F.KC[t * 512 + h * 64 + d]) * bf2f(F.VC[t * 1024 + h * 128 + v]); }
        const float sF = s; s = 0.f;
        for (int m = CTXL - 1; m >= 0; --m) { const size_t t = (size_t)b * CTXL + m; s = gb * s + bf2f(F.KC[t * 512 + h * 64 + d]) * bf2f(F.VC[t * 1024 + h * 128 + v]); }
        const float sB = s;
        s = sF;
        for (int n = 0; n < SEQ; ++n) { const size_t t = (size_t)b * SEQ + n; s = gf * s + bf2f(F.K[t * 512 + h * 64 + d]) * bf2f(F.V[t * 1024 + h * 128 + v]);
            const float o = wave_sum(bf2f(F.Q[t * 512 + h * 64 + d]) * s); if (d == 0) F.RET[t * 1024 + h * 128 + v] = o; }
        s = sB;
        for (int n = SEQ - 1; n >= 0; --n) { const size_t t = (size_t)b * SEQ + n; s = gb * s + bf2f(F.K[t * 512 + h * 64 + d]) * bf2f(F.V[t * 1024 + h * 128 + v]);
            const float o = wave_sum(bf2f(F.Q[t * 512 + h * 64 + d]) * s); if (d == 0) F.RET[t * 1024 + h * 128 + v] += o; }
    }
}
DI void n5_groupnorm(const Ctx& F) {
    const Tid T = opaque_tid();
    const int gw = blockIdx.x * 8 + T.wave, NGW = gridDim.x * 8;
    for (int task = gw; task < MTOK * NH; task += NGW) {
        const int t = task >> 3, h = task & 7; const size_t o = (size_t)t * 1024 + h * 128 + 2 * T.lane;
        const float a = F.RET[o], b = F.RET[o + 1];
        const float mu = wave_sum(a + b) * (1.f / 128.f); const float da = a - mu, db = b - mu;
        const float var = wave_sum(da * da + db * db) * (1.f / 128.f); const float rstd = 1.0f / sqrtf(var + EPS);
        const float ra = da * rstd * F.gn_w[h * 128 + 2 * T.lane], rb = db * rstd * F.gn_w[h * 128 + 2 * T.lane + 1];
        *(unsigned*)(F.UB + o) = cvt_pk_bf16(siluf(bf2f(F.SZB[o])) * ra, siluf(bf2f(F.SZB[o + 1])) * rb);
    }
}
DI void p5_ret(const Ctx& F) {
    const Tid T = opaque_tid();
    LAS unsigned char* KI = F.lds; LAS unsigned char* VI = F.lds + 20480; LAS unsigned char* SF = F.lds + 57344; LAS unsigned char* SB = F.lds + 75776;
    LAS unsigned char* S0F = F.lds + 94208; LAS unsigned char* S0B = F.lds + 110592;
    const int tid = T.tid, lane = T.lane, w = T.wave, g = lane >> 4, q = (lane & 15) >> 2, p = lane & 3, l15 = lane & 15;
    const int row = tid >> 2, seg = tid & 3, il = 16 * w + l15;
    for (int base = blockIdx.x * 4; base < 1024; base += gridDim.x * 4) {
        const int bh = base >> 5, h = bh & 7;
        const float l2f = log2_gamma(F.decay_logit, 0, h), l2b = log2_gamma(F.decay_logit, 1, h);
        { const float* s0f = F.S0 + (size_t)(0 * 32 + bh) * 8192 + row * 64 + seg * 16; const float* s0b = F.S0 + (size_t)(1 * 32 + bh) * 8192 + row * 64 + seg * 16;
#pragma unroll
            for (int i = 0; i < 2; ++i) { const f32x4 a0 = *(const f32x4*)(s0f + 8 * i), a1 = *(const f32x4*)(s0f + 8 * i + 4), b0 = *(const f32x4*)(s0b + 8 * i), b1 = *(const f32x4*)(s0b + 8 * i + 4);
                u32x4 x, y; x.x = cvt_pk_bf16(a0.x, a0.y); x.y = cvt_pk_bf16(a0.z, a0.w); x.z = cvt_pk_bf16(a1.x, a1.y); x.w = cvt_pk_bf16(a1.z, a1.w);
                y.x = cvt_pk_bf16(b0.x, b0.y); y.y = cvt_pk_bf16(b0.z, b0.w); y.z = cvt_pk_bf16(b1.x, b1.y); y.w = cvt_pk_bf16(b1.z, b1.w);
                *(LAS u32x4*)(S0F + row * 128 + seg * 32 + 16 * i) = x; *(LAS u32x4*)(S0B + row * 128 + seg * 32 + 16 * i) = y; } }
        u32x4 pk[2], pv[4], pf0[2], pb0[2]; bf16x8 pq[2];
        auto prefetch = [&](int it) { const int c = it & 31; const size_t tok0 = (size_t)(bh >> 3) * SEQ + c * CHK;
            const bf16_t* kp = F.K + tok0 * 512 + h * 64; const bf16_t* vp = F.V + tok0 * 1024 + h * 128; const bf16_t* qp = F.Q + tok0 * 512 + h * 64;
            const bf16_t* stf = F.ST + ((size_t)(0 * 32 + bh) * 32 + c) * 8192; const bf16_t* stb = F.ST + ((size_t)(1 * 32 + bh) * 32 + c) * 8192;
#pragma unroll
            for (int i = 0; i < 2; ++i) { pk[i] = *(const u32x4*)(kp + (size_t)row * 512 + seg * 16 + 8 * i); pf0[i] = *(const u32x4*)(stf + row * 64 + seg * 16 + 8 * i); pb0[i] = *(const u32x4*)(stb + row * 64 + seg * 16 + 8 * i);
                pq[i] = *(const bf16x8*)(qp + (size_t)il * 512 + 32 * i + 8 * g); }
#pragma unroll
            for (int i = 0; i < 4; ++i) pv[i] = *(const u32x4*)(vp + (size_t)row * 1024 + seg * 32 + 8 * i); };
        prefetch(base);
        for (int k = 0; k < 4; ++k) {
            const int it = base + k, c = it & 31; const size_t tok0 = (size_t)(bh >> 3) * SEQ + c * CHK;
            { const float cf = __builtin_amdgcn_exp2f(l2f * 128.f * (float)c), cb = __builtin_amdgcn_exp2f(l2b * 128.f * (float)(31 - c));
#pragma unroll
                for (int i = 0; i < 2; ++i) { *(LAS u32x4*)(KI + row * 160 + seg * 32 + 16 * i) = pk[i];
                    const u32x4 x = *(const LAS u32x4*)(S0F + row * 128 + seg * 32 + 16 * i), y = *(const LAS u32x4*)(S0B + row * 128 + seg * 32 + 16 * i);
                    u32x4 of, ob;
#pragma unroll
                    for (int e = 0; e < 4; ++e) { of[e] = cvt_pk_bf16(bflo(pf0[i][e]) + cf * bflo(x[e]), bfhi(pf0[i][e]) + cf * bfhi(x[e])); ob[e] = cvt_pk_bf16(bflo(pb0[i][e]) + cb * bflo(y[e]), bfhi(pb0[i][e]) + cb * bfhi(y[e])); }
                    *(LAS u32x4*)(SF + row * 144 + seg * 32 + 16 * i) = of; *(LAS u32x4*)(SB + row * 144 + seg * 32 + 16 * i) = ob; }
#pragma unroll
                for (int i = 0; i < 4; ++i) *(LAS u32x4*)(VI + row * 288 + seg * 64 + 16 * i) = pv[i]; }
            bf16x8 qf[2]; qf[0] = pq[0]; qf[1] = pq[1];
            __syncthreads();
            if (k < 3) prefetch(it + 1);
            f32x4 accS[8];
#pragma unroll
            for (int jb = 0; jb < 8; ++jb) { accS[jb] = (f32x4){0.f, 0.f, 0.f, 0.f};
#pragma unroll
                for (int ks = 0; ks < 2; ++ks) { const bf16x8 kf = *(const LAS bf16x8*)(KI + (16 * jb + l15) * 160 + (32 * ks + 8 * g) * 2);
                    accS[jb] = __builtin_amdgcn_mfma_f32_16x16x32_bf16(kf, qf[ks], accS[jb], 0, 0, 0); } }
            bf16x8 pf[4];
#pragma unroll
            for (int s2 = 0; s2 < 4; ++s2) { float pe[8];
#pragma unroll
                for (int e = 0; e < 8; ++e) { const int jb = 2 * s2 + (e >> 2), r = e & 3, j = 16 * jb + 4 * g + r, df = il - j;
                    float mk = __builtin_amdgcn_exp2f((df >= 0 ? l2f : -l2b) * (float)df); if (df == 0) mk = 2.f;
                    pe[e] = accS[jb][r] * mk; }
                u32x4 pw; pw.x = cvt_pk_bf16(pe[0], pe[1]); pw.y = cvt_pk_bf16(pe[2], pe[3]); pw.z = cvt_pk_bf16(pe[4], pe[5]); pw.w = cvt_pk_bf16(pe[6], pe[7]);
                pf[s2] = __builtin_bit_cast(bf16x8, pw); }
            const float decf = __builtin_amdgcn_exp2f(l2f * (float)(il + 1)), decb = __builtin_amdgcn_exp2f(l2b * (float)(128 - il));
            f32x4 accO[8];
#pragma unroll
            for (int vb = 0; vb < 8; ++vb) { f32x4 o = (f32x4){0.f, 0.f, 0.f, 0.f};
#pragma unroll
                for (int s2 = 0; s2 < 4; ++s2) { const bf16x8 vf = tr2(VI + (32 * s2 + 4 * g + q) * 288 + (16 * vb + 4 * p) * 2, 16 * 288);
                    o = __builtin_amdgcn_mfma_f32_16x16x32_bf16(vf, pf[s2], o, 0, 0, 0); }
                f32x4 tf = (f32x4){0.f, 0.f, 0.f, 0.f}, tb = (f32x4){0.f, 0.f, 0.f, 0.f};
#pragma unroll
                for (int ks = 0; ks < 2; ++ks) { const bf16x8 sf = *(const LAS bf16x8*)(SF + (16 * vb + l15) * 144 + (32 * ks + 8 * g) * 2);
                    const bf16x8 sb = *(const LAS bf16x8*)(SB + (16 * vb + l15) * 144 + (32 * ks + 8 * g) * 2);
                    tf = __builtin_amdgcn_mfma_f32_16x16x32_bf16(sf, qf[ks], tf, 0, 0, 0); tb = __builtin_amdgcn_mfma_f32_16x16x32_bf16(sb, qf[ks], tb, 0, 0, 0); }
                accO[vb] = o + tf * decf + tb * decb; __builtin_amdgcn_sched_barrier(0); }
            float sm = 0.f;
#pragma unroll
            for (int vb = 0; vb < 8; ++vb) sm += (accO[vb].x + accO[vb].y) + (accO[vb].z + accO[vb].w);
            sm += __shfl_xor(sm, 16); sm += __shfl_xor(sm, 32);
            const float mu = sm * (1.f / 128.f); float sq = 0.f;
#pragma unroll
            for (int vb = 0; vb < 8; ++vb) { accO[vb] = accO[vb] - mu; sq += (accO[vb].x * accO[vb].x + accO[vb].y * accO[vb].y) + (accO[vb].z * accO[vb].z + accO[vb].w * accO[vb].w); }
            sq += __shfl_xor(sq, 16); sq += __shfl_xor(sq, 32);
            const float rstd = 1.0f / sqrtf(sq * (1.f / 128.f) + EPS);
            __syncthreads();
#pragma unroll
            for (int vb = 0; vb < 8; ++vb) { const f32x4 gw = *(const f32x4*)(F.gn_w + h * 128 + 16 * vb + 4 * g); const f32x4 o = accO[vb] * rstd * gw;
                u32x2 ow; ow.x = cvt_pk_bf16(o.x, o.y); ow.y = cvt_pk_bf16(o.z, o.w);
                *(LAS u32x2*)(VI + il * 288 + (16 * vb + 4 * g) * 2) = ow; }
            __syncthreads();
            { const size_t go = (tok0 + row) * 1024 + h * 128 + seg * 32;
#pragma unroll
                for (int i = 0; i < 4; ++i) { const u32x4 o = *(const LAS u32x4*)(VI + row * 288 + seg * 64 + 16 * i); const u32x4 z = *(const u32x4*)(F.SZB + go + 8 * i);
                    u32x4 r;
#pragma unroll
                    for (int e = 0; e < 4; ++e) r[e] = cvt_pk_bf16(bflo(o[e]) * siluf(bflo(z[e])), bfhi(o[e]) * siluf(bfhi(z[e])));
                    *(u32x4*)(F.UB + go + 8 * i) = r; } }
            __syncthreads();
        }
    }
}
struct SchedSq { int G, c; DI bool next(int i, pg8::Unit& u) const { const int L = i * G + c; if (L >= 256) return false; pg8::tile_of(L, 64, 4, u); return true; } };
struct EpiAB {
    const bf16_t* R; const bf16_t* SGB; bf16_t* MM;
    DI int vm_ops(const pg8::Unit&) const { return 0; }
    DI void mid(f32x4 (&acc)[2][2][4][2], const pg8::Unit& u, int wr, int wc, int fr, int fq) const { apply<false>(acc, u, wr, wc, fr, fq); }
    DI void operator()(const f32x4 (&acc)[2][2][4][2], const pg8::Unit& u, int wr, int wc, int fr, int fq) const { apply<true>(const_cast<f32x4 (&)[2][2][4][2]>(acc), u, wr, wc, fr, fq); }
    template <bool FIN> DI void apply(f32x4 (&acc)[2][2][4][2], const pg8::Unit& u, int wr, int wc, int fr, int fq) const {
        const bf16_t* src = FIN ? SGB : R;
        const size_t base = (size_t)(u.pm * 256 + wr * 64 + fr) * 1024 + u.pn * 256 + wc * 32 + 8 * fq;
#pragma unroll
        for (int am = 0; am < 4; ++am) { const int ai = am >> 1;
            u32x4 gv[4][2];
#pragma unroll
            for (int m = 2 * (am & 1); m < 2 * (am & 1) + 2; ++m)
#pragma unroll
                for (int bj = 0; bj < 2; ++bj) gv[m][bj] = *(const u32x4*)(src + base + (size_t)(ai * 128 + m * 16) * 1024 + bj * 128);
#pragma unroll
            for (int m = 2 * (am & 1); m < 2 * (am & 1) + 2; ++m)
#pragma unroll
                for (int bj = 0; bj < 2; ++bj) { const u32x4 gq = gv[m][bj];
                    f32x4 a = acc[ai][bj][m][0], b = acc[ai][bj][m][1];
                    a.x *= bflo(gq.x); a.y *= bfhi(gq.x); a.z *= bflo(gq.y); a.w *= bfhi(gq.y); b.x *= bflo(gq.z); b.y *= bfhi(gq.z); b.z *= bflo(gq.w); b.w *= bfhi(gq.w);
                    if (FIN) { u32x4 w; w.x = cvt_pk_bf16(a.x, a.y); w.y = cvt_pk_bf16(a.z, a.w); w.z = cvt_pk_bf16(b.x, b.y); w.w = cvt_pk_bf16(b.z, b.w);
                        *(u32x4*)(MM + base + (size_t)(ai * 128 + m * 16) * 1024 + bj * 128) = w; }
                    else { acc[ai][bj][m][0] = a; acc[ai][bj][m][1] = b; } }
            asm volatile("" ::: "memory");
        }
    }
};
struct EpiOut {
    const float* x; const float* MOD; float* out;
    DI int vm_ops(const pg8::Unit&) const { return 0; }
    DI void mid(f32x4 (&)[2][2][4][2], const pg8::Unit&, int, int, int, int) const {}
    DI void operator()(const f32x4 (&acc)[2][2][4][2], const pg8::Unit& u, int wr, int wc, int fr, int fq) const {
        const int col0 = u.pn * 256 + wc * 32 + 8 * fq; const float* gp = MOD + (u.pm >> 4) * 3072 + 2048 + col0;
        f32x4 gx[2][2];
#pragma unroll
        for (int bj = 0; bj < 2; ++bj)
#pragma unroll
            for (int n = 0; n < 2; ++n) gx[bj][n] = *(const f32x4*)(gp + bj * 128 + 4 * n);
#pragma unroll
        for (int ai = 0; ai < 2; ++ai)
#pragma unroll
            for (int m = 0; m < 4; ++m) { const size_t off = (size_t)(u.pm * 256 + ai * 128 + wr * 64 + m * 16 + fr) * 1024 + col0;
#pragma unroll
                for (int bj = 0; bj < 2; ++bj)
#pragma unroll
                    for (int n = 0; n < 2; ++n) { const f32x4 xv = *(const f32x4*)(x + off + bj * 128 + 4 * n); *(f32x4*)(out + off + bj * 128 + 4 * n) = xv + gx[bj][n] * acc[ai][bj][m][n]; }
                if (m & 1) asm volatile("" ::: "memory"); }
    }
};
struct EpiOutNorm {
    const float* x; const float* MOD; float* out; const float* fw; float* slots; unsigned* cnt; LAS float* tab;
    DI int vm_ops(const pg8::Unit&) const { return 0; }
    DI void mid(f32x4 (&)[2][2][4][2], const pg8::Unit&, int, int, int, int) const {}
    DI void operator()(const f32x4 (&acc_)[2][2][4][2], const pg8::Unit& u, int wr, int wc, int fr, int fq) const {
        f32x4 (&acc)[2][2][4][2] = const_cast<f32x4 (&)[2][2][4][2]>(acc_);
        const int col0 = u.pn * 256 + wc * 32 + 8 * fq; const float* gp = MOD + (u.pm >> 4) * 3072 + 2048 + col0;
        f32x4 gx[2][2];
#pragma unroll
        for (int bj = 0; bj < 2; ++bj)
#pragma unroll
            for (int n = 0; n < 2; ++n) gx[bj][n] = *(const f32x4*)(gp + bj * 128 + 4 * n);
#pragma unroll
        for (int ai = 0; ai < 2; ++ai)
#pragma unroll
            for (int m = 0; m < 4; ++m) { const int row = u.pm * 256 + ai * 128 + wr * 64 + m * 16 + fr; const size_t off = (size_t)row * 1024 + col0; float ss = 0.f;
#pragma unroll
                for (int bj = 0; bj < 2; ++bj)
#pragma unroll
                    for (int n = 0; n < 2; ++n) { const f32x4 xv = *(const f32x4*)(x + off + bj * 128 + 4 * n); const f32x4 v = xv + gx[bj][n] * acc[ai][bj][m][n]; acc[ai][bj][m][n] = v;
                        ss += (v.x * v.x + v.y * v.y) + (v.z * v.z + v.w * v.w); }
                ss += __shfl_xor(ss, 16); ss += __shfl_xor(ss, 32);
                if (fq == 0) __hip_atomic_store(slots + (size_t)row * 16 + u.pn * 4 + wc, ss, __ATOMIC_RELAXED, __HIP_MEMORY_SCOPE_AGENT);
                if (m & 1) asm volatile("" ::: "memory"); }
        asm volatile("s_waitcnt vmcnt(0)" ::: "memory");
        __syncthreads();
        if (threadIdx.x == 0) {
            unsigned* c = cnt + 64 * u.pm;
            __hip_atomic_fetch_add(c, 1u, __ATOMIC_RELAXED, __HIP_MEMORY_SCOPE_AGENT);
            unsigned sp = 0;
            while (__hip_atomic_load(c, __ATOMIC_RELAXED, __HIP_MEMORY_SCOPE_AGENT) < 4u) { __builtin_amdgcn_s_sleep(1); if (++sp > (1u << 22)) break; }
            __builtin_amdgcn_fence(__ATOMIC_ACQUIRE, "agent");
            asm volatile("s_waitcnt vmcnt(0)" ::: "memory");
        }
        __syncthreads();
        { const int t = threadIdx.x, row = t >> 1, half = t & 1; const float* sp = slots + (size_t)(u.pm * 256 + row) * 16 + half * 8; float s = 0.f;
#pragma unroll
            for (int j = 0; j < 8; ++j) s += __hip_atomic_load(sp + j, __ATOMIC_RELAXED, __HIP_MEMORY_SCOPE_AGENT);
            s += __shfl_xor(s, 1);
            if (half == 0) tab[row] = 1.0f / sqrtf(s * (1.f / 1024.f) + EPS); }
        __syncthreads();
        f32x4 fv[2][2];
#pragma unroll
        for (int bj = 0; bj < 2; ++bj)
#pragma unroll
            for (int n = 0; n < 2; ++n) fv[bj][n] = *(const f32x4*)(fw + col0 + bj * 128 + 4 * n);
#pragma unroll
        for (int ai = 0; ai < 2; ++ai)
#pragma unroll
            for (int m = 0; m < 4; ++m) { const int rl = ai * 128 + wr * 64 + m * 16 + fr; const float r = tab[rl]; const size_t off = (size_t)(u.pm * 256 + rl) * 1024 + col0;
#pragma unroll
                for (int bj = 0; bj < 2; ++bj)
#pragma unroll
                    for (int n = 0; n < 2; ++n) *(f32x4*)(out + off + bj * 128 + 4 * n) = acc[ai][bj][m][n] * r * fv[bj][n]; }
    }
};
DI void n6_ab(const Ctx& F) {
    const Tid T = opaque_tid();
    const size_t NT = (size_t)gridDim.x * 512, gt = (size_t)blockIdx.x * 512 + T.tid;
    for (size_t idx = gt; idx < (size_t)(MTOK / 4) * 1024; idx += NT) {
        const int n = (int)(idx & 1023), t0 = (int)(idx >> 10) * 4; float ya[4] = {0.f, 0.f, 0.f, 0.f}, yb[4] = {0.f, 0.f, 0.f, 0.f};
        for (int k = 0; k < 1024; ++k) { const float wa = F.w_a[(size_t)k * 1024 + n], wb = F.w_b[(size_t)k * 1024 + n];
#pragma unroll
            for (int j = 0; j < 4; ++j) { ya[j] += bf2f(F.P[(size_t)(t0 + j) * 1024 + k]) * wa; yb[j] += bf2f(F.UB[(size_t)(t0 + j) * 1024 + k]) * wb; } }
#pragma unroll
        for (int j = 0; j < 4; ++j) { const size_t o = (size_t)(t0 + j) * 1024 + n; const float sgb = bf2f(F.SGB[o]), sga = bf2f(F.R[o]) * sgb; F.MM[o] = f2bf(sga * ya[j] + sgb * yb[j]); }
    }
}
DI void n7_out(const Ctx& F) {
    const Tid T = opaque_tid();
    const size_t NT = (size_t)gridDim.x * 512, gt = (size_t)blockIdx.x * 512 + T.tid;
    for (size_t idx = gt; idx < (size_t)(MTOK / 4) * 1024; idx += NT) {
        const int n = (int)(idx & 1023), t0 = (int)(idx >> 10) * 4; float y[4] = {0.f, 0.f, 0.f, 0.f};
        for (int k = 0; k < 1024; ++k) { const float w = F.w_out[(size_t)k * 1024 + n];
#pragma unroll
            for (int j = 0; j < 4; ++j) y[j] += bf2f(F.MM[(size_t)(t0 + j) * 1024 + k]) * w; }
#pragma unroll
        for (int j = 0; j < 4; ++j) { const size_t o = (size_t)(t0 + j) * 1024 + n; F.out[o] = F.x[o] + F.MOD[((t0 + j) >> 12) * 3072 + 2048 + n] * y[j]; }
    }
}
DI void p8_final(const Ctx& F) {
    const Tid T = opaque_tid();
    const int gw = blockIdx.x * 8 + T.wave, NGW = gridDim.x * 8;
    for (int m = gw; m < MTOK; m += NGW) {
        f32x4* xr = (f32x4*)(F.out + (size_t)m * DM);
        f32x4 v[4]; float ss = 0.f;
#pragma unroll
        for (int j = 0; j < 4; ++j) { v[j] = xr[T.lane + 64 * j]; ss += (v[j].x * v[j].x + v[j].y * v[j].y) + (v[j].z * v[j].z + v[j].w * v[j].w); }
        const float rstd = 1.0f / sqrtf(wave_sum(ss) * (1.f / DM) + EPS);
#pragma unroll
        for (int j = 0; j < 4; ++j) { const f32x4 w = *(const f32x4*)(F.final_w + 4 * (T.lane + 64 * j)); xr[T.lane + 64 * j] = v[j] * rstd * w; }
    }
}

constexpr int NPH = 9;
__global__ void __launch_bounds__(512, 2) fwd_kernel(Args args) {
    extern __shared__ __attribute__((aligned(16))) unsigned char lds_raw[];
    Ctx F;
    F.lds = (LAS unsigned char*)lds_raw;
    if (threadIdx.x < 16) ((LAS unsigned*)(F.lds + LDS_MISC))[threadIdx.x] = 0u;
#if !MK_LAUNCH_PER_PHASE
    {
        unsigned* flag = (unsigned*)(args.ws + WS_FLAG); unsigned* done = flag + 64;
        if (blockIdx.x == 0) {
            for (unsigned i = threadIdx.x; i < WS_BAR_BYTES / 16; i += 512) ((u32x4*)(args.ws + WS_BAR))[i] = (u32x4){0u, 0u, 0u, 0u};
            if (threadIdx.x == 0) __hip_atomic_store(done, 0u, __ATOMIC_RELAXED, __HIP_MEMORY_SCOPE_AGENT);
            asm volatile("s_waitcnt vmcnt(0)" ::: "memory");
            __syncthreads();
            if (threadIdx.x == 0) { __builtin_amdgcn_fence(__ATOMIC_RELEASE, "agent"); asm volatile("s_waitcnt vmcnt(0)" ::: "memory");
                __hip_atomic_store(flag, CTL_MAGIC, __ATOMIC_RELAXED, __HIP_MEMORY_SCOPE_AGENT); }
        } else if (threadIdx.x == 0) {
            unsigned sp = 0;
            while (__hip_atomic_load(flag, __ATOMIC_RELAXED, __HIP_MEMORY_SCOPE_AGENT) != CTL_MAGIC) { __builtin_amdgcn_s_sleep(1); if (++sp > (1u << 22)) break; }
            __builtin_amdgcn_fence(__ATOMIC_ACQUIRE, "agent"); asm volatile("s_waitcnt vmcnt(0)" ::: "memory");
        }
    }
#endif
    __syncthreads();
    const XcdBarrier bar = xcd_barrier_post((unsigned*)(args.ws + WS_BAR), (volatile LAS unsigned*)(F.lds + LDS_MISC));
    F.x = args.in[0]; F.c = args.in[1]; F.ctx = args.in[2]; F.c_ctx = args.in[3]; F.norm_w = args.in[4]; F.ada_w = args.in[5]; F.ada_b = args.in[6]; F.w_in = args.in[7];
    F.conv_w = args.in[8]; F.conv_b = args.in[9]; F.decay_logit = args.in[10]; F.gn_w = args.in[11]; F.w_a = args.in[12]; F.w_b = args.in[13]; F.w_out = args.in[14]; F.final_w = args.in[15];
    F.out = args.out; unsigned char* ws = args.ws; F.ws = ws;
    F.MOD = (float*)(ws + WS_MOD); F.ROPE = (f32x2*)(ws + WS_ROPE);
    F.WA = (bf16_t*)(ws + WS_WA); F.WB = (bf16_t*)(ws + WS_WB); F.WOUT = (bf16_t*)(ws + WS_WOUT); F.WIN = (bf16_t*)(ws + WS_WIN); F.XM = (bf16_t*)(ws + WS_XM);
    F.KV = (bf16_t*)(ws + WS_KV); F.KVC = (bf16_t*)(ws + WS_KVC); F.HC = (bf16_t*)(ws + WS_HC); F.ST = (bf16_t*)(ws + WS_ST); F.MM = (bf16_t*)(ws + WS_MM);
    F.P = (bf16_t*)(ws + WS_P); F.Q = (bf16_t*)(ws + WS_Q); F.K = (bf16_t*)(ws + WS_K); F.V = (bf16_t*)(ws + WS_V); F.SZB = (bf16_t*)(ws + WS_SZB);
    F.KC = (bf16_t*)(ws + WS_KC); F.VC = (bf16_t*)(ws + WS_VC); F.UB = (bf16_t*)(ws + WS_UB);
    F.R = (bf16_t*)args.out; F.SGB = (bf16_t*)args.out + (size_t)MTOK * DM;
    F.RET = (float*)(ws + WS_RET); F.S0 = (float*)(ws + WS_KVC);
    const int lo = args.ph_lo, hi = args.ph_hi; const unsigned naive = args.naive;
#define IN(k) (lo <= (k) && (k) < hi && ((MK_PHASES >> (k)) & 1))
#define NAIVE(k) (((naive & MK_NAIVE_AVAIL) >> (k)) & 1u)
#define SEAM(k) do { if (IN(k) && IN((k) + 1)) xcd_barrier(bar); } while (0)
#define REP(k) for (int rep_ = 0; rep_ < 1 + (int)((MK_REP_MASK >> (k)) & 1u); ++rep_)
    if (IN(0)) REP(0) { p0_prologue(F); } SEAM(0);
    if (IN(1)) REP(1) { p1_rows(F); } SEAM(1);
    if (IN(2)) REP(2) {
        if (NAIVE(2)) n2_inproj(F);
        else { const char* const Ab[2] = {(const char*)F.XM, (const char*)F.XM}; const char* const Bb[2] = {(const char*)F.WIN, (const char*)F.WIN};
            Sched1 S{(int)gridDim.x, (int)blockIdx.x}; Epi1 E{F.ws, F.R, F.SGB, F.ROPE};
            pg8::gemm_phase<1, Epi1, Sched1>(F.lds, Ab, Bb, S, E); }
    } SEAM(2);
    if (IN(3)) {
        if (!NAIVE(3)) {
            const char* const Ab[2] = {(const char*)F.XM, (const char*)F.XM}; const char* const Bb[2] = {(const char*)F.WIN, (const char*)F.WIN};
            SchedCtx S{(int)blockIdx.x}; Epi1 E{F.ws, F.R, F.SGB, F.ROPE};
            pg8::gemm_phase<1, Epi1, SchedCtx>(F.lds, Ab, Bb, S, E);
            if (blockIdx.x >= 24) { REP(3) p3_kv(F, blockIdx.x - 24, 1024, gridDim.x - 24); p3_ua(F, blockIdx.x - 24, gridDim.x - 24); }
        } else p3_ua(F, blockIdx.x, gridDim.x);
    } SEAM(3);
    if (IN(4)) REP(4) { if (NAIVE(4)) n4_recurrence(F); else { if (blockIdx.x >= gridDim.x - 32) p4_ctx_state(F, blockIdx.x - (gridDim.x - 32)); else p4_scan(F, blockIdx.x, gridDim.x - 32); } } SEAM(4);
    if (IN(5)) REP(5) { if (NAIVE(5)) n5_groupnorm(F); else p5_ret(F); } SEAM(5);
    if (IN(6)) REP(6) {
        if (NAIVE(6)) n6_ab(F);
        else { const char* const Ab[2] = {(const char*)F.P, (const char*)F.UB}; const char* const Bb[2] = {(const char*)F.WA, (const char*)F.WB};
            SchedSq S{(int)gridDim.x, (int)blockIdx.x}; EpiAB E{F.R, F.SGB, F.MM};
            pg8::gemm_phase<2, EpiAB, SchedSq>(F.lds, Ab, Bb, S, E); }
    } SEAM(6);
    if (IN(7)) {
        const char* const Ab[2] = {(const char*)F.MM, (const char*)F.MM}; const char* const Bb[2] = {(const char*)F.WOUT, (const char*)F.WOUT};
        SchedSq S{(int)gridDim.x, (int)blockIdx.x};
        if (NAIVE(7)) n7_out(F);
        else if (gridDim.x == 256) {
            EpiOutNorm E{F.x, F.MOD, F.out, F.final_w, (float*)(F.ws + WS_SLOTS), (unsigned*)(F.ws + WS_PCNT), (LAS float*)(F.lds + LDS_TAB)};
            pg8::gemm_phase<1, EpiOutNorm, SchedSq>(F.lds, Ab, Bb, S, E); }
        else { EpiOut E{F.x, F.MOD, F.out}; pg8::gemm_phase<1, EpiOut, SchedSq>(F.lds, Ab, Bb, S, E); }
    }
    if (NAIVE(7) || gridDim.x != 256) { SEAM(7); if (IN(8)) { p8_final(F); } }
#if !MK_LAUNCH_PER_PHASE
    __syncthreads();
    if (threadIdx.x == 0) { unsigned* flag = (unsigned*)(args.ws + WS_FLAG); unsigned* done = flag + 64;
        if (__hip_atomic_fetch_add(done, 1u, __ATOMIC_RELAXED, __HIP_MEMORY_SCOPE_AGENT) == gridDim.x - 1) __hip_atomic_store(flag, 0u, __ATOMIC_RELAXED, __HIP_MEMORY_SCOPE_AGENT); }
#endif
#undef IN
#undef NAIVE
#undef SEAM
}

extern "C" void kernel_launch(void* const* d_in, const int* in_sizes, int n_in, void* d_out, int out_size, void* d_ws, size_t ws_size, hipStream_t stream) {
    static int grid = 0;
    if (grid == 0) {
        if (n_in != 16 || out_size != MTOK * DM || ws_size < WS_END) { fprintf(stderr, "kernel_launch: unexpected shapes (n_in %d out %d ws %zu)\n", n_in, out_size, ws_size); grid = -1; return; }
        int dev = 0, cus = 0, per_cu = 0;
        hipGetDevice(&dev); hipDeviceGetAttribute(&cus, hipDeviceAttributeMultiprocessorCount, dev);
        hipFuncSetAttribute((const void*)fwd_kernel, hipFuncAttributeMaxDynamicSharedMemorySize, LDS_BYTES);
        hipOccupancyMaxActiveBlocksPerMultiprocessor(&per_cu, (const void*)fwd_kernel, 512, LDS_BYTES);
        if (per_cu < 1) { fprintf(stderr, "kernel_launch: occupancy query says %d blocks/CU\n", per_cu); per_cu = 1; }
        grid = cus;
        (void)hipGetLastError();
    }
    if (grid < 0) return;
    Args a{};
    for (int i = 0; i < 16; ++i) a.in[i] = (const float*)d_in[i];
    a.out = (float*)d_out; a.ws = (unsigned char*)d_ws; a.naive = MK_NAIVE_MASK;
#if MK_LAUNCH_PER_PHASE
    hipMemsetAsync((unsigned char*)d_ws + WS_BAR, 0, WS_BAR_BYTES, stream);
#endif
#if MK_LAUNCH_PER_PHASE
    for (int ph = 0; ph < NPH; ++ph) { a.ph_lo = ph; a.ph_hi = ph + 1; hipLaunchKernelGGL(fwd_kernel, dim3(grid), dim3(512), LDS_BYTES, stream, a); }
#else
    a.ph_lo = 0; a.ph_hi = NPH;
    hipLaunchKernelGGL(fwd_kernel, dim3(grid), dim3(512), LDS_BYTES, stream, a);
#endif
}
```

```cpp
#include <hip/hip_runtime.h>
#include <cstdio>
#include <cstdint>

#ifndef MK_LAUNCH_PER_PHASE
#define MK_LAUNCH_PER_PHASE 0
#endif
#ifndef MK_NAIVE_MASK
#define MK_NAIVE_MASK 0x00u
#endif

#ifndef MK_REP_MASK
#define MK_REP_MASK 0u
#endif
#ifndef MK_PHASES
#define MK_PHASES 0x1ff
#endif
#ifndef MK_NAIVE_AVAIL
#define MK_NAIVE_AVAIL 0xffu
#endif
#define DI __device__ __forceinline__
#define LAS __attribute__((address_space(3)))
typedef unsigned short bf16_t;
typedef float f32x4 __attribute__((ext_vector_type(4)));
typedef float f32x2 __attribute__((ext_vector_type(2)));
typedef unsigned u32x4 __attribute__((ext_vector_type(4)));
typedef unsigned u32x2 __attribute__((ext_vector_type(2)));
typedef short bf16x8 __attribute__((ext_vector_type(8)));
typedef short s16x4 __attribute__((ext_vector_type(4)));
typedef short v4i16_t __attribute__((ext_vector_type(4)));

constexpr int NB = 4, SEQ = 4096, DM = 1024, MTOK = NB * SEQ, CTXL = 256, MCTX = NB * CTXL, MALL = MTOK + MCTX;
constexpr int NIN = 9216, NH = 8, DK = 64, DV = 128, CHK = 128, NCHK = SEQ / CHK;
constexpr float EPS = 1e-6f;
constexpr size_t MiB = 1u << 20;
constexpr size_t WS_MOD = 0;
constexpr size_t WS_ROPE = 65536;
constexpr size_t WS_WA = 2 * MiB, WS_WB = 4 * MiB, WS_WOUT = 6 * MiB, WS_WIN = 8 * MiB;
constexpr size_t WS_XM = 26 * MiB;
constexpr size_t WS_KV = 223 * MiB;
constexpr size_t WS_KVC = 40 * MiB;
constexpr size_t WS_RET = 8 * MiB;
constexpr size_t WS_HC = 60 * MiB;
constexpr size_t WS_ST = 60 * MiB;
constexpr size_t WS_MM = 60 * MiB;
constexpr size_t WS_P = 92 * MiB;
constexpr size_t WS_Q = 124 * MiB, WS_K = 140 * MiB, WS_V = 156 * MiB, WS_SZB = 188 * MiB;
constexpr size_t WS_KC = 220 * MiB, WS_VC = 221 * MiB;
constexpr size_t WS_UB = 223 * MiB;
constexpr size_t WS_END = 255 * MiB;
constexpr int LDS_BYTES = 147456;
constexpr int LDS_MISC = 139264;
constexpr size_t WS_BAR = 131072, WS_BAR_BYTES = 65536;
constexpr size_t WS_PCNT = WS_BAR + 16384, WS_SLOTS = 1 * MiB;
constexpr size_t WS_FLAG = 98304;
constexpr unsigned CTL_MAGIC = 0x600DF1A6u;
constexpr int LDS_TAB = 132096;

DI float bf2f(bf16_t v) { return __uint_as_float((unsigned)v << 16); }
DI float bflo(unsigned w) { return __uint_as_float(w << 16); }
DI float bfhi(unsigned w) { return __uint_as_float(w & 0xffff0000u); }
typedef __bf16 bf16x2_t __attribute__((ext_vector_type(2)));
DI unsigned cvt_pk_bf16(float lo, float hi) { const f32x2 f = {lo, hi}; const bf16x2_t v = __builtin_convertvector(f, bf16x2_t); return __builtin_bit_cast(unsigned, v); }
DI bf16_t f2bf(float f) { return (bf16_t)(cvt_pk_bf16(f, 0.f) & 0xffffu); }
DI float wave_sum(float v) {
#pragma unroll
    for (int o = 1; o < 64; o <<= 1) v += __shfl_xor(v, o);
    return v;
}
struct Tid { int tid, lane, wave; };
DI Tid opaque_tid() { int t = threadIdx.x; asm volatile("" : "+v"(t)); Tid r; r.tid = t; r.lane = t & 63; r.wave = __builtin_amdgcn_readfirstlane(t >> 6); return r; }
DI float siluf(float x) { return x * __builtin_amdgcn_rcpf(1.f + __expf(-x)); }
DI float log2_gamma(const float* decay_logit, int dir, int h) {
    const float x = decay_logit[dir * NH + h];
    const float ls = fminf(x, 0.f) - log1pf(expf(-fabsf(x)));
    return ls * 1.4426950408889634f;
}

namespace pg8 {
constexpr int BM = 256, BK = 64, HALF = 128, HTB = HALF * BK * 2, STAGE_BYTES = 8 * HTB, NXCD = 8, WGM = 4;
DI int lds_byte(int r, int c) { const int st = (r >> 4) * 2 + (c >> 5), rr = r & 15, cc = c & 31, ob = rr * 64 + cc * 2; return st * 1024 + (ob ^ (((ob >> 9) & 1) << 5)); }
DI void stage_rc(int b, int& R, int& C) { const int st = b / 1024, sb = b % 1024, swz = sb ^ (((sb >> 9) & 1) << 5); R = (st >> 1) * 16 + swz / 64; C = (st & 1) * 32 + (swz % 64) / 2; }
DI int perm32(int rho) { const int n = rho >> 4, i = rho & 15; return 8 * (i >> 2) + 4 * n + (i & 3); }
struct Unit { int pm, pn; };
DI void tile_of(int L, int nM, int nN, Unit& u) {
    const int nwg = nM * nN; int wgid = L;
    { const int q = nwg / NXCD, r = nwg % NXCD, xcd = wgid % NXCD, off = wgid / NXCD; wgid = (xcd < r ? xcd * (q + 1) : r * (q + 1) + (xcd - r) * q) + off; }
    const int nig = WGM * nN, gid = wgid / nig, fm = gid * WGM, gsz = (nM - fm) < WGM ? (nM - fm) : WGM;
    u.pm = fm + ((wgid % nig) % gsz); u.pn = (wgid % nig) / gsz;
}
template <int NSEG, class Epi, class Sched>
DI void gemm_phase(LAS unsigned char* lds, const char* const (&Ab)[2], const char* const (&Bb)[2], const Sched& S, const Epi& E) {
    constexpr int K = 1024, NTS = K / BK;
    constexpr int nt = NSEG * NTS;
    const Tid T = opaque_tid();
    const int tid = T.tid, wid = T.wave, lane = T.lane, wr = wid >> 2, wc = (wid & 3) ^ (wr << 1), fr = lane & 15, fq = lane >> 4;
    unsigned voffA[2], voffB[2];
#pragma unroll
    for (int i = 0; i < 2; ++i) { int R, C; stage_rc(tid * 16 + i * 8192, R, C); const int Rb = (R & ~31) + perm32(R & 31);
        voffA[i] = (unsigned)(R * K + C) * 2u; voffB[i] = (unsigned)(Rb * K + C) * 2u; }
    constexpr size_t kstep = (size_t)(BK * 2);
    constexpr size_t hstep = (size_t)HALF * K * 2;
    constexpr size_t tstep = 2 * hstep;
    const unsigned ldsw = (unsigned)wid * 1024u;
    const int aoff = lds_byte(wr * 64 + fr, fq * 8), boff = lds_byte(wc * 32 + fr, fq * 8);
#define PG8_SA(b, h) (((b) * 2 + (h)) * HTB)
#define PG8_SB(b, h) ((4 + (b) * 2 + (h)) * HTB)
#define PG8_STAGE(bufoff, gbase, voff) do { _Pragma("unroll") for (int _i = 0; _i < 2; ++_i) \
        __builtin_amdgcn_global_load_lds((const unsigned*)((const char*)(gbase) + (voff)[_i]), (LAS unsigned*)(lds + (bufoff) + ldsw + _i * 8192), 16, 0, 0); } while (0)
#define PG8_LDA(dst, b, h) do { _Pragma("unroll") for (int m = 0; m < 4; ++m) _Pragma("unroll") for (int k = 0; k < 2; ++k) dst[m][k] = *(const LAS bf16x8*)(lds + PG8_SA(b, h) + aoff + m * 2048 + k * 1024); } while (0)
#define PG8_LDB(dst, b, h) do { _Pragma("unroll") for (int n = 0; n < 2; ++n) _Pragma("unroll") for (int k = 0; k < 2; ++k) dst[n][k] = *(const LAS bf16x8*)(lds + PG8_SB(b, h) + boff + n * 2048 + k * 1024); } while (0)
#define PG8_MMA(ai, bj, At, Bt) do { __builtin_amdgcn_s_setprio(1); _Pragma("unroll") for (int m = 0; m < 4; ++m) _Pragma("unroll") for (int n = 0; n < 2; ++n) _Pragma("unroll") for (int k = 0; k < 2; ++k) \
        acc[ai][bj][m][n] = __builtin_amdgcn_mfma_f32_16x16x32_bf16(Bt[n][k], At[m][k], acc[ai][bj][m][n], 0, 0, 0); __builtin_amdgcn_s_setprio(0); } while (0)
#define PG8_WAIT_V(n) asm volatile("s_waitcnt vmcnt(" #n ")" ::: "memory")
#define PG8_WAIT_L(n) asm volatile("s_waitcnt lgkmcnt(" #n ")" ::: "memory")
#define PG8_WAIT_VR(sel) asm volatile("s_cmp_lt_i32 %0, 8\n\ts_cbranch_scc1 .Lw8_%=\n\ts_cmp_lt_i32 %0, 16\n\ts_cbranch_scc1 .Lw16_%=\n\ts_waitcnt vmcnt(24)\n\ts_branch .Lwe_%=\n.Lw16_%=:\n\ts_waitcnt vmcnt(16)\n\ts_branch .Lwe_%=\n.Lw8_%=:\n\ts_waitcnt vmcnt(8)\n.Lwe_%=:" :: "s"(sel) : "memory", "scc")
#define PG8_BAR __builtin_amdgcn_s_barrier()
#define PG8_SCHED __builtin_amdgcn_sched_barrier(0)
#define PG8_TA(u, t) (Ab[(t) / NTS] + (size_t)(u).pm * tstep + (size_t)((t) % NTS) * kstep)
#define PG8_TB(u, t) (Bb[(t) / NTS] + (size_t)(u).pn * tstep + (size_t)((t) % NTS) * kstep)
    Unit cur, nxt; int ui = 0;
    if (!S.next(0, cur)) return;
    f32x4 acc[2][2][4][2];
#pragma unroll
    for (int a = 0; a < 2; ++a)
#pragma unroll
        for (int b = 0; b < 2; ++b)
#pragma unroll
            for (int m = 0; m < 4; ++m)
#pragma unroll
                for (int n = 0; n < 2; ++n) acc[a][b][m][n] = (f32x4){0.f, 0.f, 0.f, 0.f};
    bf16x8 At[4][2], B0[2][2], B1[2][2];
    {
        const char* cA = PG8_TA(cur, 0); const char* cB = PG8_TB(cur, 0);
        PG8_STAGE(PG8_SB(0, 0), cB, voffB); PG8_STAGE(PG8_SB(0, 1), cB + hstep, voffB); PG8_STAGE(PG8_SA(0, 0), cA, voffA); PG8_STAGE(PG8_SA(0, 1), cA + hstep, voffA);
        if (wr == 1) PG8_BAR;
        PG8_WAIT_V(2); PG8_BAR;
        PG8_STAGE(PG8_SB(1, 0), cB + kstep, voffB); PG8_STAGE(PG8_SA(1, 0), cA + kstep, voffA); PG8_STAGE(PG8_SB(1, 1), cB + hstep + kstep, voffB);
        PG8_WAIT_V(6); PG8_BAR;
    }
    for (;;) {
        const bool has_next = S.next(ui + 1, nxt);
        const Unit nu = has_next ? nxt : cur;
        for (int t = 0; t < nt; t += 2) {
            if (NSEG == 2 && t == NTS) E.mid(acc, cur, wr, wc, fr, fq);
            const bool last = (t == nt - 2);
            const char* a1 = PG8_TA(cur, t + 1);
            const char* a2 = last ? PG8_TA(nu, 0) : PG8_TA(cur, t + 2); const char* b2 = last ? PG8_TB(nu, 0) : PG8_TB(cur, t + 2);
            const char* a3 = a2 + kstep; const char* b3 = b2 + kstep;
            PG8_LDB(B0, 0, 0); PG8_LDB(B1, 0, 1); PG8_SCHED; PG8_LDA(At, 0, 0); PG8_STAGE(PG8_SA(1, 1), a1 + hstep, voffA);
            PG8_WAIT_V(8); PG8_WAIT_L(0); PG8_BAR; PG8_MMA(0, 0, At, B0); PG8_MMA(0, 1, At, B1); PG8_BAR; PG8_SCHED;
            PG8_LDA(At, 0, 1); PG8_STAGE(PG8_SB(0, 0), b2, voffB); PG8_STAGE(PG8_SB(0, 1), b2 + hstep, voffB); PG8_STAGE(PG8_SA(0, 0), a2, voffA);
            PG8_WAIT_V(8); PG8_WAIT_L(0); PG8_BAR; PG8_MMA(1, 0, At, B0); PG8_MMA(1, 1, At, B1); PG8_BAR; PG8_SCHED;
            PG8_LDB(B0, 1, 0); PG8_LDB(B1, 1, 1); PG8_SCHED; PG8_LDA(At, 1, 0); PG8_STAGE(PG8_SA(0, 1), a2 + hstep, voffA);
            PG8_WAIT_V(8); PG8_WAIT_L(0); PG8_BAR; PG8_MMA(0, 0, At, B0); PG8_MMA(0, 1, At, B1); PG8_BAR; PG8_SCHED;
            PG8_LDA(At, 1, 1); PG8_STAGE(PG8_SB(1, 0), b3, voffB); PG8_STAGE(PG8_SB(1, 1), b3 + hstep, voffB); PG8_STAGE(PG8_SA(1, 0), a3, voffA);
            PG8_WAIT_V(8); PG8_WAIT_L(0); PG8_BAR; PG8_MMA(1, 0, At, B0); PG8_MMA(1, 1, At, B1); PG8_BAR; PG8_SCHED;
        }
        if (wr == 0) PG8_BAR;
        E(acc, cur, wr, wc, fr, fq);
        if (!has_next) break;
#pragma unroll
        for (int a = 0; a < 2; ++a)
#pragma unroll
            for (int b = 0; b < 2; ++b)
#pragma unroll
                for (int m = 0; m < 4; ++m)
#pragma unroll
                    for (int n = 0; n < 2; ++n) acc[a][b][m][n] = (f32x4){0.f, 0.f, 0.f, 0.f};
        cur = nxt; ++ui;
        if (wr == 1) PG8_BAR;
    }
    PG8_WAIT_V(0);
    PG8_BAR;
#undef PG8_SA
#undef PG8_SB
#undef PG8_STAGE
#undef PG8_LDA
#undef PG8_LDB
#undef PG8_MMA
#undef PG8_WAIT_V
#undef PG8_WAIT_L
#undef PG8_WAIT_VR
#undef PG8_BAR
#undef PG8_SCHED
#undef PG8_TA
#undef PG8_TB
}
}


#define XB_TMO      128
#define XB_XCNT(j)  (256  + 64 * (j))
#define XB_XSUB(j)  (1280 + 64 * (j))
#define XB_XGEN(j)  (2304 + 64 * (j))
#define XB_TOP      3328
#define XB_TOPGEN   3392
#define XCD_BAR_WORDS 3456
#define XB_SPIN_CAP (1u << 18)
DI unsigned xb_ld(unsigned* p)              { return __hip_atomic_load(p, __ATOMIC_RELAXED, __HIP_MEMORY_SCOPE_AGENT); }
DI unsigned xb_add(unsigned* p, unsigned v) { return __hip_atomic_fetch_add(p, v, __ATOMIC_RELAXED, __HIP_MEMORY_SCOPE_AGENT); }
DI unsigned xb_xcc_id() { return (unsigned)__builtin_amdgcn_s_getreg((3 << 11) | 20) & 0xFu; }
#define XB_SPIN(cond, bar) do { unsigned _sp = 0; while (cond) { __builtin_amdgcn_s_sleep(1); \
    if ((++_sp & 255u) == 0u) { if (xb_ld(&(bar)[XB_TMO])) break; if (_sp > XB_SPIN_CAP) { atomicAdd(&(bar)[XB_TMO], 1u); break; } } } } while (0)
struct XcdBarrier { unsigned* bar; unsigned x; volatile LAS unsigned* st; };
DI XcdBarrier xcd_barrier_post(unsigned* bar, volatile LAS unsigned* st) {
    XcdBarrier b; b.bar = bar; b.x = xb_xcc_id(); b.st = st;
    if (threadIdx.x == 0) (void)xb_add(&bar[XB_XCNT(b.x)], 1u);
    return b;
}
DI void xcd_barrier_complete(unsigned* bar, unsigned x, unsigned& nloc, unsigned& nx) {
    const unsigned G = gridDim.x * gridDim.y * gridDim.z;
    unsigned sum, cnt, mine, sp = 0u;
    for (;;) {
        sum = 0u; cnt = 0u; mine = 0u;
#pragma unroll
        for (unsigned j = 0; j < 16; ++j) { const unsigned c = xb_ld(&bar[XB_XCNT(j)]); sum += c; cnt += (c > 0u) ? 1u : 0u; mine = (j == x) ? c : mine; }
        if (sum == G) break;
        __builtin_amdgcn_s_sleep(1);
        if ((++sp & 255u) == 0u) { if (xb_ld(&bar[XB_TMO])) break; if (sp > XB_SPIN_CAP) { atomicAdd(&bar[XB_TMO], 1u); break; } }
    }
    nloc = mine > 0u ? mine : 1u; nx = cnt > 0u ? cnt : 1u;
}
DI void xcd_barrier(const XcdBarrier& b) {
    asm volatile("s_waitcnt vmcnt(0)" ::: "memory");
    __syncthreads();
    if (threadIdx.x == 0) {
        unsigned* bar = b.bar;
        __builtin_amdgcn_s_waitcnt(0);
        unsigned nloc = b.st[0], nx = b.st[1];
        if (nloc == 0u) { xcd_barrier_complete(bar, b.x, nloc, nx); b.st[0] = nloc; b.st[1] = nx; }
        const unsigned old = xb_add(&bar[XB_XSUB(b.x)], 1u);
        const unsigned gen = old / nloc;
        if (old + 1u == (gen + 1u) * nloc) {
            __builtin_amdgcn_fence(__ATOMIC_RELEASE, "agent");
            asm volatile("s_waitcnt vmcnt(0)" ::: "memory");
            const unsigned og = xb_add(&bar[XB_TOP], 1u);
            const unsigned tg = og / nx;
            if (og + 1u == (tg + 1u) * nx) xb_add(&bar[XB_TOPGEN], 1u);
            else XB_SPIN(xb_ld(&bar[XB_TOPGEN]) == tg, bar);
            __builtin_amdgcn_fence(__ATOMIC_ACQUIRE, "agent");
            xb_add(&bar[XB_XGEN(b.x)], 1u);
            asm volatile("s_waitcnt vmcnt(0)" ::: "memory");
        } else {
            XB_SPIN(xb_ld(&bar[XB_XGEN(b.x)]) == gen, bar);
            __builtin_amdgcn_fence(__ATOMIC_ACQUIRE, "agent");
            asm volatile("s_waitcnt vmcnt(0)" ::: "memory");
        }
    }
    __syncthreads();
}

struct Args { const float* in[16]; float* out; unsigned char* ws; int ph_lo, ph_hi; unsigned naive; int pad; };
struct Ctx {
    LAS unsigned char* lds;
    const float *x, *c, *ctx, *c_ctx, *norm_w, *ada_w, *ada_b, *w_in, *conv_w, *conv_b, *decay_logit, *gn_w, *w_a, *w_b, *w_out, *final_w;
    float* out; unsigned char* ws;
    float* MOD; f32x2* ROPE;
    bf16_t *WA, *WB, *WOUT, *WIN, *XM, *KV, *KVC, *HC, *ST, *MM, *P, *Q, *K, *V, *SZB, *KC, *VC, *UB, *R, *SGB;
    float* RET; float* S0;
};

DI int win_dest(int o) {
    if (o < 4096) { const int g = o >> 10, ch = o & 1023; return 256 * (ch >> 6) + 64 * g + (ch & 63); }
    if (o < 5120) { const int qk = (o - 4096) >> 9, oo = (o - 4096) & 511, head = oo >> 6, i = oo & 63, t = head >> 2, hh = head & 3;
        return 256 * (16 + 2 * qk + t) + (i < 32 ? 32 * hh + i : 128 + 32 * hh + (i - 32)); }
    if (o < 7168) return o;
    { const int gs = (o - 7168) >> 10, ch = (o - 7168) & 1023; return 256 * (28 + (ch >> 7)) + 128 * gs + (ch & 127); }
}
DI void p0_transpose_item(const float* W, int K, int N, bf16_t* WT, bool permute, LAS float* scr, int item, int lane) {
    const int nblk = N / 32, kb = item / nblk, nb = item % nblk, k0 = 64 * kb, n0 = 32 * nb;
    f32x4 rv[8];
#pragma unroll
    for (int i = 0; i < 8; ++i) rv[i] = *(const f32x4*)(W + (size_t)(k0 + 8 * i + (lane >> 3)) * N + n0 + 4 * (lane & 7));
#pragma unroll
    for (int i = 0; i < 8; ++i) { LAS float* d = scr + (8 * i + (lane >> 3)) * 33 + 4 * (lane & 7); d[0] = rv[i].x; d[1] = rv[i].y; d[2] = rv[i].z; d[3] = rv[i].w; }
    asm volatile("s_waitcnt lgkmcnt(0)" ::: "memory");
    const int c = lane & 7; const int d0 = permute ? win_dest(n0) : n0;
#pragma unroll
    for (int j = 0; j < 4; ++j) { const int n = (lane >> 3) + 8 * j; const LAS float* sp = scr + (8 * c) * 33 + n;
        u32x4 o; o.x = cvt_pk_bf16(sp[0 * 33], sp[1 * 33]); o.y = cvt_pk_bf16(sp[2 * 33], sp[3 * 33]); o.z = cvt_pk_bf16(sp[4 * 33], sp[5 * 33]); o.w = cvt_pk_bf16(sp[6 * 33], sp[7 * 33]);
        *(u32x4*)(WT + (size_t)(d0 + n) * K + k0 + 8 * c) = o; }
    asm volatile("s_waitcnt lgkmcnt(0)" ::: "memory");
}
DI void p0_prologue(const Ctx& F) {
    const Tid T = opaque_tid();
    if (blockIdx.x < 48) {
        LAS float* red = (LAS float*)F.lds;
        LAS float* sl = (LAS float*)(F.lds + 16384);
        for (int e = T.tid; e < 5 * 1024; e += 512) { const int v = e >> 10, k = e & 1023; sl[e] = siluf(v < 4 ? F.c[v * 1024 + k] : F.c_ctx[k]); }
        __syncthreads();
        const int n0 = 64 * blockIdx.x, k0 = 128 * T.wave, r4 = T.lane >> 4, c4 = T.lane & 15;
        f32x4 a[5];
#pragma unroll
        for (int v = 0; v < 5; ++v) a[v] = (f32x4){0.f, 0.f, 0.f, 0.f};
#pragma unroll 1
        for (int ib = 0; ib < 32; ib += 8) {
            f32x4 wv[8];
#pragma unroll
            for (int i = 0; i < 8; ++i) wv[i] = *(const f32x4*)(F.ada_w + (size_t)(k0 + 4 * (ib + i) + r4) * 3072 + n0 + 4 * c4);
#pragma unroll
            for (int i = 0; i < 8; ++i) {
#pragma unroll
                for (int v = 0; v < 5; ++v) a[v] += wv[i] * sl[v * 1024 + k0 + 4 * (ib + i) + r4];
                __builtin_amdgcn_sched_barrier(0); }
        }
#pragma unroll
        for (int v = 0; v < 5; ++v) {
#pragma unroll
            for (int e = 0; e < 4; ++e) { float t = a[v][e]; t += __shfl_xor(t, 16); t += __shfl_xor(t, 32); a[v][e] = t; }
            if (r4 == 0) { LAS float* d = red + (T.wave * 5 + v) * 64 + 4 * c4; d[0] = a[v].x; d[1] = a[v].y; d[2] = a[v].z; d[3] = a[v].w; } }
        __syncthreads();
        if (T.tid < 320) { const int v = T.tid >> 6, l = T.tid & 63; float s = F.ada_b[n0 + l];
#pragma unroll
            for (int w = 0; w < 8; ++w) s += red[(w * 5 + v) * 64 + l];
            F.MOD[v * 3072 + n0 + l] = s; }
        __syncthreads();
    }
    if (blockIdx.x == 48) {
        for (int e = T.tid; e < 1024; e += 512) { const int p = e >> 4, f = e & 15; const float inv = powf(10000.f, -(float)f / 16.f); const float ang = (float)p * inv;
            F.ROPE[e] = (f32x2){cosf(ang), sinf(ang)}; }
    }
    LAS float* scr = (LAS float*)(F.lds + T.wave * 16384);
    const int gw = blockIdx.x * 8 + T.wave, NGW = gridDim.x * 8;
    constexpr int I_IN = 16 * (NIN / 32), I_SQ = 16 * 32;
    for (int it = gw; it < I_IN + 3 * I_SQ; it += NGW) {
        int r = it;
        if (r < I_IN) { p0_transpose_item(F.w_in, 1024, NIN, F.WIN, true, scr, r, T.lane); continue; } r -= I_IN;
        if (r < I_SQ) { p0_transpose_item(F.w_a, 1024, 1024, F.WA, false, scr, r, T.lane); continue; } r -= I_SQ;
        if (r < I_SQ) { p0_transpose_item(F.w_b, 1024, 1024, F.WB, false, scr, r, T.lane); continue; } r -= I_SQ;
        p0_transpose_item(F.w_out, 1024, 1024, F.WOUT, false, scr, r, T.lane);
    }
}
template <int RB> DI void p1_row_group(const Ctx& F, const Tid& T, int m0) {
    f32x4 v[RB][2][2]; float ss[RB];
#pragma unroll
    for (int r = 0; r < RB; ++r) { const int m = m0 + r; const float* xr = m < MTOK ? F.x + (size_t)m * DM : F.ctx + (size_t)(m - MTOK) * DM;
#pragma unroll
        for (int j = 0; j < 2; ++j)
#pragma unroll
            for (int h = 0; h < 2; ++h) v[r][j][h] = ((const f32x4*)xr)[2 * (T.lane + 64 * j) + h]; }
#pragma unroll
    for (int r = 0; r < RB; ++r) { float s = 0.f;
#pragma unroll
        for (int j = 0; j < 2; ++j)
#pragma unroll
            for (int h = 0; h < 2; ++h) { const f32x4 t = v[r][j][h]; s += (t.x * t.x + t.y * t.y) + (t.z * t.z + t.w * t.w); }
        ss[r] = s; }
#pragma unroll
    for (int o = 1; o < 64; o <<= 1)
#pragma unroll
        for (int r = 0; r < RB; ++r) ss[r] += __shfl_xor(ss[r], o);
    const int mb = m0 < MTOK ? (m0 >> 12) : 4; const float* mod = F.MOD + mb * 3072;
#pragma unroll
    for (int j = 0; j < 2; ++j) { const int col = 8 * (T.lane + 64 * j);
        f32x4 w[2], sh[2], sc[2];
#pragma unroll
        for (int h = 0; h < 2; ++h) { w[h] = *(const f32x4*)(F.norm_w + col + 4 * h); sh[h] = *(const f32x4*)(mod + col + 4 * h); sc[h] = *(const f32x4*)(mod + 1024 + col + 4 * h); }
#pragma unroll
        for (int r = 0; r < RB; ++r) { const float rstd = __builtin_amdgcn_rsqf(ss[r] * (1.f / DM) + EPS);
            const f32x4 y0 = (v[r][j][0] * rstd * w[0]) * (sc[0] + 1.0f) + sh[0], y1 = (v[r][j][1] * rstd * w[1]) * (sc[1] + 1.0f) + sh[1];
            u32x4 o; o.x = cvt_pk_bf16(y0.x, y0.y); o.y = cvt_pk_bf16(y0.z, y0.w); o.z = cvt_pk_bf16(y1.x, y1.y); o.w = cvt_pk_bf16(y1.z, y1.w);
            *(u32x4*)(F.XM + (size_t)(m0 + r) * DM + col) = o; } }
}
DI void p1_rows(const Ctx& F) {
    const Tid T = opaque_tid();
    const int gw = blockIdx.x * 8 + T.wave, NGW = gridDim.x * 8;
    for (int m0 = gw * 8; m0 < MTOK; m0 += NGW * 8) p1_row_group<8>(F, T, m0);
    for (int m0 = MTOK + gw; m0 < MALL; m0 += NGW) p1_row_group<1>(F, T, m0);
}
struct Sched1 {
    int G, c;
    DI bool next(int i, pg8::Unit& u) const { const int L = i * G + c; if (L >= 64 * 36) return false; pg8::tile_of(L, 64, 36, u); return true; }
};
struct SchedCtx {
    int c;
    DI bool next(int i, pg8::Unit& u) const { if (i > 0 || c >= 24) return false; u.pm = 64 + c / 6; u.pn = 18 + c % 6; return true; }
};
struct Epi1 {
    unsigned char* ws; bf16_t *R, *SGB; const f32x2* rope;
    DI int vm_ops(const pg8::Unit& u) const { return u.pn < 16 ? 8 : 16; }
    DI void mid(f32x4 (&)[2][2][4][2], const pg8::Unit&, int, int, int, int) const {}
    DI void operator()(const f32x4 (&acc)[2][2][4][2], const pg8::Unit& u, int wr, int wc, int fr, int fq) const {
        const int pn = u.pn, row0 = u.pm * 256 + wr * 64 + fr, x0 = wc * 32 + 8 * fq;
        const bool isctx = u.pm >= 64;
        if (pn < 16) {
            bf16_t* dst = (bf16_t*)(ws + (wc < 2 ? WS_HC : WS_P)) + 64 * pn + (x0 & 63);
#pragma unroll
            for (int ai = 0; ai < 2; ++ai)
#pragma unroll
                for (int m = 0; m < 4; ++m) { const size_t row = row0 + ai * 128 + m * 16;
                    f32x4 o[2];
#pragma unroll
                    for (int n = 0; n < 2; ++n) { const f32x4 a = acc[ai][0][m][n], b = acc[ai][1][m][n];
                        if (wc < 2) o[n] = a * b;
                        else { o[n].x = a.x * siluf(b.x); o[n].y = a.y * siluf(b.y); o[n].z = a.z * siluf(b.z); o[n].w = a.w * siluf(b.w); } }
                    u32x4 w; w.x = cvt_pk_bf16(o[0].x, o[0].y); w.y = cvt_pk_bf16(o[0].z, o[0].w); w.z = cvt_pk_bf16(o[1].x, o[1].y); w.w = cvt_pk_bf16(o[1].z, o[1].w);
                    *(u32x4*)(dst + row * 1024) = w; }
        } else if (pn < 20) {
            const int t = (pn - 16) & 1, isk = (pn - 16) >> 1, head = 4 * t + wc, i0 = 8 * fq;
            const float scale = isk ? 0.125f : 1.0f;
            bf16_t* base = (bf16_t*)(ws + (isk ? (isctx ? WS_KC : WS_K) : WS_Q));
#pragma unroll
            for (int ai = 0; ai < 2; ++ai)
#pragma unroll
                for (int m = 0; m < 4; ++m) { const int row = row0 + ai * 128 + m * 16; const int orow = isctx ? row - MTOK : row;
                    const int pos = row & 4095, pidx = (fq < 2) ? (pos >> 6) : (pos & 63);
                    const f32x2* rp = rope + pidx * 16 + (fq & 1) * 8;
                    float o1[8], o2[8];
#pragma unroll
                    for (int e = 0; e < 8; ++e) { f32x2 cs = rp[e]; if (isctx) cs = (f32x2){1.f, 0.f};
                        const float t1 = acc[ai][0][m][e >> 2][e & 3], t2 = acc[ai][1][m][e >> 2][e & 3];
                        o1[e] = (t1 * cs.x - t2 * cs.y) * scale; o2[e] = (t1 * cs.y + t2 * cs.x) * scale; }
                    u32x4 w1, w2; w1.x = cvt_pk_bf16(o1[0], o1[1]); w1.y = cvt_pk_bf16(o1[2], o1[3]); w1.z = cvt_pk_bf16(o1[4], o1[5]); w1.w = cvt_pk_bf16(o1[6], o1[7]);
                    w2.x = cvt_pk_bf16(o2[0], o2[1]); w2.y = cvt_pk_bf16(o2[2], o2[3]); w2.z = cvt_pk_bf16(o2[4], o2[5]); w2.w = cvt_pk_bf16(o2[6], o2[7]);
                    bf16_t* d = base + (size_t)orow * 512 + head * 64 + i0;
                    *(u32x4*)d = w1; *(u32x4*)(d + 32) = w2; }
        } else if (pn < 28) {
            const bool isz = pn >= 24;
            bf16_t* base = (bf16_t*)(ws + (isz ? WS_SZB : (isctx ? WS_VC : WS_V)));
            const int colt = 256 * (pn - (isz ? 24 : 20)) + x0;
#pragma unroll
            for (int ai = 0; ai < 2; ++ai)
#pragma unroll
                for (int m = 0; m < 4; ++m) { const int row = row0 + ai * 128 + m * 16; const int orow = isctx ? row - MTOK : row;
#pragma unroll
                    for (int bj = 0; bj < 2; ++bj) { f32x4 a = acc[ai][bj][m][0], b = acc[ai][bj][m][1];
                        u32x4 w; w.x = cvt_pk_bf16(a.x, a.y); w.y = cvt_pk_bf16(a.z, a.w); w.z = cvt_pk_bf16(b.x, b.y); w.w = cvt_pk_bf16(b.z, b.w);
                        if (isz) __builtin_nontemporal_store(w, (u32x4*)(base + (size_t)orow * 1024 + colt + bj * 128)); else *(u32x4*)(base + (size_t)orow * 1024 + colt + bj * 128) = w; } }
        } else {
            const int col = 128 * (pn - 28) + x0;
#pragma unroll
            for (int ai = 0; ai < 2; ++ai)
#pragma unroll
                for (int m = 0; m < 4; ++m) { const size_t row = row0 + ai * 128 + m * 16;
                    float rr[8], sg[8];
#pragma unroll
                    for (int e = 0; e < 8; ++e) { const float ga = acc[ai][0][m][e >> 2][e & 3], gb = acc[ai][1][m][e >> 2][e & 3];
                        const float ea = 1.f + __expf(-ga), eb = 1.f + __expf(-gb); sg[e] = __builtin_amdgcn_rcpf(eb); rr[e] = eb * __builtin_amdgcn_rcpf(ea); }
                    u32x4 w1, w2; w1.x = cvt_pk_bf16(rr[0], rr[1]); w1.y = cvt_pk_bf16(rr[2], rr[3]); w1.z = cvt_pk_bf16(rr[4], rr[5]); w1.w = cvt_pk_bf16(rr[6], rr[7]);
                    w2.x = cvt_pk_bf16(sg[0], sg[1]); w2.y = cvt_pk_bf16(sg[2], sg[3]); w2.z = cvt_pk_bf16(sg[4], sg[5]); w2.w = cvt_pk_bf16(sg[6], sg[7]);
                    __builtin_nontemporal_store(w1, (u32x4*)(R + row * 1024 + col)); __builtin_nontemporal_store(w2, (u32x4*)(SGB + row * 1024 + col)); }
        }
    }
};
DI void n2_inproj(const Ctx& F) {
    const Tid T = opaque_tid();
    const size_t NT = (size_t)gridDim.x * 512, gt = (size_t)blockIdx.x * 512 + T.tid;
    for (size_t idx = gt; idx < (size_t)(MALL / 4) * 1024; idx += NT) {
        const int ch = (int)(idx & 1023), t0 = (int)(idx >> 10) * 4;
        const bool doqk = ch < 512 && (ch & 63) < 32;
        float a[12][4];
#pragma unroll
        for (int o = 0; o < 12; ++o)
#pragma unroll
            for (int j = 0; j < 4; ++j) a[o][j] = 0.f;
        for (int k = 0; k < 1024; ++k) {
            const float* wr = F.w_in + (size_t)k * NIN;
            float xv[4];
#pragma unroll
            for (int j = 0; j < 4; ++j) xv[j] = bf2f(F.XM[(size_t)(t0 + j) * 1024 + k]);
            float w[12];
            w[0] = wr[ch]; w[1] = wr[1024 + ch]; w[2] = wr[2048 + ch]; w[3] = wr[3072 + ch]; w[4] = wr[5120 + ch]; w[5] = wr[6144 + ch]; w[6] = wr[7168 + ch]; w[7] = wr[8192 + ch];
            if (doqk) { w[8] = wr[4096 + ch]; w[9] = wr[4096 + ch + 32]; w[10] = wr[4608 + ch]; w[11] = wr[4608 + ch + 32]; } else { w[8] = w[9] = w[10] = w[11] = 0.f; }
#pragma unroll
            for (int o = 0; o < 12; ++o)
#pragma unroll
                for (int j = 0; j < 4; ++j) a[o][j] += xv[j] * w[o];
        }
#pragma unroll
        for (int j = 0; j < 4; ++j) { const int t = t0 + j;
            if (t < MTOK) {
                const size_t o = (size_t)t * 1024 + ch;
                F.HC[o] = f2bf(a[2][j] * a[0][j]); F.P[o] = f2bf(siluf(a[3][j]) * a[1][j]); F.V[o] = f2bf(a[4][j]); F.SZB[o] = f2bf(a[5][j]);
                const float sga = 1.f / (1.f + __expf(-a[6][j])), sgb = 1.f / (1.f + __expf(-a[7][j]));
                F.R[o] = f2bf(sga / sgb); F.SGB[o] = f2bf(sgb);
                if (doqk) { const int i = ch & 63, pos = t & 4095; const int pidx = i < 16 ? (pos >> 6) : (pos & 63); const f32x2 cs = F.ROPE[pidx * 16 + (i & 15)];
                    const size_t q = (size_t)t * 512 + ch;
                    F.Q[q] = f2bf(a[8][j] * cs.x - a[9][j] * cs.y); F.Q[q + 32] = f2bf(a[8][j] * cs.y + a[9][j] * cs.x);
                    F.K[q] = f2bf((a[10][j] * cs.x - a[11][j] * cs.y) * 0.125f); F.K[q + 32] = f2bf((a[10][j] * cs.y + a[11][j] * cs.x) * 0.125f); }
            } else {
                const int tc = t - MTOK;
                F.VC[(size_t)tc * 1024 + ch] = f2bf(a[4][j]);
                if (doqk) { F.KC[(size_t)tc * 512 + ch] = f2bf(a[10][j] * 0.125f); F.KC[(size_t)tc * 512 + ch + 32] = f2bf(a[11][j] * 0.125f); }
            }
        }
    }
}
DI bf16x8 tr2(const LAS unsigned char* p, int delta) {
    const s16x4 lo = __builtin_bit_cast(s16x4, __builtin_amdgcn_ds_read_tr16_b64_v4i16((LAS v4i16_t*)p));
    const s16x4 hi = __builtin_bit_cast(s16x4, __builtin_amdgcn_ds_read_tr16_b64_v4i16((LAS v4i16_t*)(p + delta)));
    return __builtin_shufflevector(lo, hi, 0, 1, 2, 3, 4, 5, 6, 7);
}
DI u32x4 scale8(u32x4 w, float s) {
    u32x4 o; o.x = cvt_pk_bf16(bflo(w.x) * s, bfhi(w.x) * s); o.y = cvt_pk_bf16(bflo(w.y) * s, bfhi(w.y) * s); o.z = cvt_pk_bf16(bflo(w.z) * s, bfhi(w.z) * s); o.w = cvt_pk_bf16(bflo(w.w) * s, bfhi(w.w) * s); return o;
}
DI void p3_kv(const Ctx& F, int it0, int it1, int stride) {
    const Tid T = opaque_tid();
    LAS unsigned char* KFI = F.lds; LAS unsigned char* KBI = F.lds + 20480; LAS unsigned char* VI = F.lds + 40960;
    const int tid = T.tid, lane = T.lane, w = T.wave, g = lane >> 4, q = (lane & 15) >> 2, p = lane & 3;
    const int row = tid >> 2, seg = tid & 3;
    u32x4 pk[2], pv[4];
    auto prefetch = [&](int it) { const int bh = it >> 5, c = it & 31; const size_t tok0 = (size_t)(bh >> 3) * SEQ + c * CHK;
        const bf16_t* kp = F.K + tok0 * 512 + (bh & 7) * 64; const bf16_t* vp = F.V + tok0 * 1024 + (bh & 7) * 128;
        pk[0] = *(const u32x4*)(kp + (size_t)row * 512 + seg * 16); pk[1] = *(const u32x4*)(kp + (size_t)row * 512 + seg * 16 + 8);
#pragma unroll
        for (int i = 0; i < 4; ++i) pv[i] = *(const u32x4*)(vp + (size_t)row * 1024 + seg * 32 + 8 * i); };
    if (it0 < it1) prefetch(it0);
    for (int it = it0; it < it1; it += stride) {
        const int bh = it >> 5, c = it & 31;
        const float l2f = log2_gamma(F.decay_logit, 0, bh & 7), l2b = log2_gamma(F.decay_logit, 1, bh & 7);
        { const float df = __builtin_amdgcn_exp2f(l2f * (float)(127 - row)), db = __builtin_amdgcn_exp2f(l2b * (float)row);
            *(LAS u32x4*)(KFI + row * 160 + seg * 32) = scale8(pk[0], df); *(LAS u32x4*)(KFI + row * 160 + seg * 32 + 16) = scale8(pk[1], df);
            *(LAS u32x4*)(KBI + row * 160 + seg * 32) = scale8(pk[0], db); *(LAS u32x4*)(KBI + row * 160 + seg * 32 + 16) = scale8(pk[1], db);
#pragma unroll
            for (int i = 0; i < 4; ++i) *(LAS u32x4*)(VI + row * 288 + seg * 64 + 16 * i) = pv[i]; }
        __syncthreads();
        if (it + stride < it1) prefetch(it + stride);
        f32x4 acc[2][4];
#pragma unroll
        for (int d = 0; d < 2; ++d)
#pragma unroll
            for (int nb = 0; nb < 4; ++nb) acc[d][nb] = (f32x4){0.f, 0.f, 0.f, 0.f};
#pragma unroll
        for (int s2 = 0; s2 < 4; ++s2) {
            const bf16x8 vb = tr2(VI + (32 * s2 + 8 * g + q) * 288 + (16 * w + 4 * p) * 2, 4 * 288);
#pragma unroll
            for (int nb = 0; nb < 4; ++nb) {
                const bf16x8 kf = tr2(KFI + (32 * s2 + 8 * g + q) * 160 + (16 * nb + 4 * p) * 2, 4 * 160);
                const bf16x8 kb = tr2(KBI + (32 * s2 + 8 * g + q) * 160 + (16 * nb + 4 * p) * 2, 4 * 160);
                acc[0][nb] = __builtin_amdgcn_mfma_f32_16x16x32_bf16(kf, vb, acc[0][nb], 0, 0, 0);
                acc[1][nb] = __builtin_amdgcn_mfma_f32_16x16x32_bf16(kb, vb, acc[1][nb], 0, 0, 0);
            }
        }
        bf16_t* of = F.KV + ((size_t)(0 * 32 + bh) * 32 + c) * 8192; bf16_t* ob = F.KV + ((size_t)(1 * 32 + bh) * 32 + c) * 8192;
#pragma unroll
        for (int nb = 0; nb < 4; ++nb) { const int o = (16 * w + (lane & 15)) * 64 + 16 * nb + 4 * g;
            u32x2 a, b; a.x = cvt_pk_bf16(acc[0][nb].x, acc[0][nb].y); a.y = cvt_pk_bf16(acc[0][nb].z, acc[0][nb].w); b.x = cvt_pk_bf16(acc[1][nb].x, acc[1][nb].y); b.y = cvt_pk_bf16(acc[1][nb].z, acc[1][nb].w);
            *(u32x2*)(of + o) = a; *(u32x2*)(ob + o) = b; }
        __syncthreads();
    }
}
DI void p4_ctx_state(const Ctx& F, int bh) {
    const Tid T = opaque_tid();
    LAS unsigned char* KFI = F.lds; LAS unsigned char* KBI = F.lds + 20480; LAS unsigned char* VI = F.lds + 40960;
    const int tid = T.tid, lane = T.lane, w = T.wave, g = lane >> 4, q = (lane & 15) >> 2, p = lane & 3;
    const int row = tid >> 2, seg = tid & 3;
    const float l2f = log2_gamma(F.decay_logit, 0, bh & 7), l2b = log2_gamma(F.decay_logit, 1, bh & 7);
    f32x4 acc[2][4];
#pragma unroll
    for (int d = 0; d < 2; ++d)
#pragma unroll
        for (int nb = 0; nb < 4; ++nb) acc[d][nb] = (f32x4){0.f, 0.f, 0.f, 0.f};
    for (int cc = 0; cc < 2; ++cc) {
        const size_t tok0 = (size_t)(bh >> 3) * CTXL + cc * CHK; const int m = cc * CHK + row;
        const bf16_t* kp = F.KC + tok0 * 512 + (bh & 7) * 64; const bf16_t* vp = F.VC + tok0 * 1024 + (bh & 7) * 128;
        const u32x4 k0 = *(const u32x4*)(kp + (size_t)row * 512 + seg * 16), k1 = *(const u32x4*)(kp + (size_t)row * 512 + seg * 16 + 8);
        const float df = __builtin_amdgcn_exp2f(l2f * (float)(255 - m)), db = __builtin_amdgcn_exp2f(l2b * (float)m);
        *(LAS u32x4*)(KFI + row * 160 + seg * 32) = scale8(k0, df); *(LAS u32x4*)(KFI + row * 160 + seg * 32 + 16) = scale8(k1, df);
        *(LAS u32x4*)(KBI + row * 160 + seg * 32) = scale8(k0, db); *(LAS u32x4*)(KBI + row * 160 + seg * 32 + 16) = scale8(k1, db);
#pragma unroll
        for (int i = 0; i < 4; ++i) *(LAS u32x4*)(VI + row * 288 + seg * 64 + 16 * i) = *(const u32x4*)(vp + (size_t)row * 1024 + seg * 32 + 8 * i);
        __syncthreads();
#pragma unroll
        for (int s2 = 0; s2 < 4; ++s2) {
            const bf16x8 vb = tr2(VI + (32 * s2 + 8 * g + q) * 288 + (16 * w + 4 * p) * 2, 4 * 288);
#pragma unroll
            for (int nb = 0; nb < 4; ++nb) {
                const bf16x8 kf = tr2(KFI + (32 * s2 + 8 * g + q) * 160 + (16 * nb + 4 * p) * 2, 4 * 160);
                const bf16x8 kb = tr2(KBI + (32 * s2 + 8 * g + q) * 160 + (16 * nb + 4 * p) * 2, 4 * 160);
                acc[0][nb] = __builtin_amdgcn_mfma_f32_16x16x32_bf16(kf, vb, acc[0][nb], 0, 0, 0);
                acc[1][nb] = __builtin_amdgcn_mfma_f32_16x16x32_bf16(kb, vb, acc[1][nb], 0, 0, 0);
            }
        }
        __syncthreads();
    }
    float* of = F.S0 + (size_t)(0 * 32 + bh) * 8192; float* ob = F.S0 + (size_t)(1 * 32 + bh) * 8192;
#pragma unroll
    for (int nb = 0; nb < 4; ++nb) { const int o = (16 * w + (lane & 15)) * 64 + 16 * nb + 4 * g; *(f32x4*)(of + o) = acc[0][nb]; *(f32x4*)(ob + o) = acc[1][nb]; }
}
DI void p3_ua(const Ctx& F, int blk, int nblk) {
    const Tid T = opaque_tid();
    const size_t NT = (size_t)nblk * 512, gt = (size_t)blk * 512 + T.tid;
    for (size_t idx = gt; idx < (size_t)MTOK * 128; idx += NT) {
        const int t = (int)(idx >> 7), c8 = (int)(idx & 127) * 8, pos = t & 4095;
        const bf16_t* hp = F.HC + (size_t)t * 1024 + c8;
        const u32x4 z = (u32x4){0u, 0u, 0u, 0u};
        const u32x4 h0 = pos > 0 ? *(const u32x4*)(hp - 1024) : z, h1 = *(const u32x4*)hp, h2 = pos < SEQ - 1 ? *(const u32x4*)(hp + 1024) : z;
        const u32x4 pv = *(const u32x4*)(F.P + (size_t)t * 1024 + c8);
        float o[8];
#pragma unroll
        for (int e = 0; e < 8; ++e) { const unsigned a = h0[e >> 1], b = h1[e >> 1], c = h2[e >> 1], pp = pv[e >> 1];
            const float x0 = (e & 1) ? bfhi(a) : bflo(a), x1 = (e & 1) ? bfhi(b) : bflo(b), x2 = (e & 1) ? bfhi(c) : bflo(c), pf = (e & 1) ? bfhi(pp) : bflo(pp);
            const float cv = F.conv_w[c8 + e] * x0 + F.conv_w[1024 + c8 + e] * x1 + F.conv_w[2048 + c8 + e] * x2 + F.conv_b[c8 + e];
            o[e] = pf * cv; }
        u32x4 w; w.x = cvt_pk_bf16(o[0], o[1]); w.y = cvt_pk_bf16(o[2], o[3]); w.z = cvt_pk_bf16(o[4], o[5]); w.w = cvt_pk_bf16(o[6], o[7]);
        *(u32x4*)(F.P + (size_t)t * 1024 + c8) = w;
    }
}
DI void p4_scan(const Ctx& F, int blk, int nblk) {
    const Tid T = opaque_tid();
    const size_t NT = (size_t)nblk * 512, gt = (size_t)blk * 512 + T.tid;
    for (size_t idx = gt; idx < (size_t)2 * 32 * 2048; idx += NT) {
        const int e4 = (int)(idx & 2047), bh = (int)(idx >> 11) & 31, dir = (int)(idx >> 16);
        const float g = exp2f(log2_gamma(F.decay_logit, dir, bh & 7) * 128.f);
        const u32x2* kv = (const u32x2*)(F.KV + ((size_t)(dir * 32 + bh) * 32) * 8192) + e4;
        u32x2* st = (u32x2*)(F.ST + ((size_t)(dir * 32 + bh) * 32) * 8192) + e4;
        float s0 = 0.f, s1 = 0.f, s2 = 0.f, s3 = 0.f;
        u32x2 v[32];
#pragma unroll
        for (int i = 0; i < 32; ++i) v[i] = kv[(size_t)(dir == 0 ? i : 31 - i) * 2048];
#pragma unroll
        for (int i = 0; i < 32; ++i) { const int c = dir == 0 ? i : 31 - i;
            u32x2 o; o.x = cvt_pk_bf16(s0, s1); o.y = cvt_pk_bf16(s2, s3); st[(size_t)c * 2048] = o;
            s0 = g * s0 + bflo(v[i].x); s1 = g * s1 + bfhi(v[i].x); s2 = g * s2 + bflo(v[i].y); s3 = g * s3 + bfhi(v[i].y); }
    }
}
DI void n4_recurrence(const Ctx& F) {
    const Tid T = opaque_tid();
    const int gw = blockIdx.x * 8 + T.wave, NGW = gridDim.x * 8, d = T.lane;
    for (int task = gw; task < 32 * 128; task += NGW) {
        const int bh = task >> 7, v = task & 127, b = bh >> 3, h = bh & 7;
        const float gf = exp2f(log2_gamma(F.decay_logit, 0, h)), gb = exp2f(log2_gamma(F.decay_logit, 1, h));
        float s = 0.f;
        for (int m = 0; m < CTXL; ++m) { const size_t t = (size_t)b * CTXL + m; s = gf * s + bf2f(F.KC[t * 512 + h * 64 + d]) * bf2f(F.VC[t * 1024 + h * 128 + v]); }
        const float sF = s; s = 0.f;
        for (int m = CTXL - 1; m >= 0; --m) { const size_t t = (size_t)b * CTXL + m; s = gb * s + bf2f(F.KC[t * 512 + h * 64 + d]) * bf2f(F.VC[t * 1024 + h * 128 + v]); }
        const float sB = s;
        s = sF;
        for (int n = 0; n < SEQ; ++n) { const size_t t = (size_t)b * SEQ + n; s = gf * s + bf2f(F.K[t * 512 + h * 64 + d]) * bf2f(F.V[t * 1024 + h * 128 + v]);
            const float o = wave_sum(bf2f(F.Q[t * 512 + h * 64 + d]) * s); if (d == 0) F.RET[t * 1024 + h * 128 + v] = o; }
        s = sB;
        for (int n = SEQ - 1; n >= 0; --n) { const size_t t = (size_t)b * SEQ + n; s = gb * s + bf2f(F.K[t * 512 + h * 64 + d]) * bf2f(F.V[t * 1024 + h * 128 + v]);
            const float o = wave_sum(bf2f(F.Q[t * 512 + h * 64 + d]) * s); if (d == 0) F.RET[t * 1024 + h * 128 + v] += o; }
    }
}
DI void n5_groupnorm(const Ctx& F) {
    const Tid T = opaque_tid();
    const int gw = blockIdx.x * 8 + T.wave, NGW = gridDim.x * 8;
    for (int task = gw; task < MTOK * NH; task += NGW) {
        const int t = task >> 3, h = task & 7; const size_t o = (size_t)t * 1024 + h * 128 + 2 * T.lane;
        const float a = F.RET[o], b = F.RET[o + 1];
        const float mu = wave_sum(a + b) * (1.f / 128.f); const float da = a - mu, db = b - mu;
        const float var = wave_sum(da * da + db * db) * (1.f / 128.f); const float rstd = 1.0f / sqrtf(var + EPS);
        const float ra = da * rstd * F.gn_w[h * 128 + 2 * T.lane], rb = db * rstd * F.gn_w[h * 128 + 2 * T.lane + 1];
        *(unsigned*)(F.UB + o) = cvt_pk_bf16(siluf(bf2f(F.SZB[o])) * ra, siluf(bf2f(F.SZB[o + 1])) * rb);
    }
}
DI void p5_ret(const Ctx& F) {
    const Tid T = opaque_tid();
    LAS unsigned char* KI = F.lds; LAS unsigned char* VI = F.lds + 20480; LAS unsigned char* SF = F.lds + 57344; LAS unsigned char* SB = F.lds + 75776;
    LAS unsigned char* S0F = F.lds + 94208; LAS unsigned char* S0B = F.lds + 110592;
    const int tid = T.tid, lane = T.lane, w = T.wave, g = lane >> 4, q = (lane & 15) >> 2, p = lane & 3, l15 = lane & 15;
    const int row = tid >> 2, seg = tid & 3, il = 16 * w + l15;
    for (int base = blockIdx.x * 4; base < 1024; base += gridDim.x * 4) {
        const int bh = base >> 5, h = bh & 7;
        const float l2f = log2_gamma(F.decay_logit, 0, h), l2b = log2_gamma(F.decay_logit, 1, h);
        { const float* s0f = F.S0 + (size_t)(0 * 32 + bh) * 8192 + row * 64 + seg * 16; const float* s0b = F.S0 + (size_t)(1 * 32 + bh) * 8192 + row * 64 + seg * 16;
#pragma unroll
            for (int i = 0; i < 2; ++i) { const f32x4 a0 = *(const f32x4*)(s0f + 8 * i), a1 = *(const f32x4*)(s0f + 8 * i + 4), b0 = *(const f32x4*)(s0b + 8 * i), b1 = *(const f32x4*)(s0b + 8 * i + 4);
                u32x4 x, y; x.x = cvt_pk_bf16(a0.x, a0.y); x.y = cvt_pk_bf16(a0.z, a0.w); x.z = cvt_pk_bf16(a1.x, a1.y); x.w = cvt_pk_bf16(a1.z, a1.w);
                y.x = cvt_pk_bf16(b0.x, b0.y); y.y = cvt_pk_bf16(b0.z, b0.w); y.z = cvt_pk_bf16(b1.x, b1.y); y.w = cvt_pk_bf16(b1.z, b1.w);
                *(LAS u32x4*)(S0F + row * 128 + seg * 32 + 16 * i) = x; *(LAS u32x4*)(S0B + row * 128 + seg * 32 + 16 * i) = y; } }
        u32x4 pk[2], pv[4], pf0[2], pb0[2]; bf16x8 pq[2];
        auto prefetch = [&](int it) { const int c = it & 31; const size_t tok0 = (size_t)(bh >> 3) * SEQ + c * CHK;
            const bf16_t* kp = F.K + tok0 * 512 + h * 64; const bf16_t* vp = F.V + tok0 * 1024 + h * 128; const bf16_t* qp = F.Q + tok0 * 512 + h * 64;
            const bf16_t* stf = F.ST + ((size_t)(0 * 32 + bh) * 32 + c) * 8192; const bf16_t* stb = F.ST + ((size_t)(1 * 32 + bh) * 32 + c) * 8192;
#pragma unroll
            for (int i = 0; i < 2; ++i) { pk[i] = *(const u32x4*)(kp + (size_t)row * 512 + seg * 16 + 8 * i); pf0[i] = *(const u32x4*)(stf + row * 64 + seg * 16 + 8 * i); pb0[i] = *(const u32x4*)(stb + row * 64 + seg * 16 + 8 * i);
                pq[i] = *(const bf16x8*)(qp + (size_t)il * 512 + 32 * i + 8 * g); }
#pragma unroll
            for (int i = 0; i < 4; ++i) pv[i] = *(const u32x4*)(vp + (size_t)row * 1024 + seg * 32 + 8 * i); };
        prefetch(base);
        for (int k = 0; k < 4; ++k) {
            const int it = base + k, c = it & 31; const size_t tok0 = (size_t)(bh >> 3) * SEQ + c * CHK;
            { const float cf = __builtin_amdgcn_exp2f(l2f * 128.f * (float)c), cb = __builtin_amdgcn_exp2f(l2b * 128.f * (float)(31 - c));
#pragma unroll
                for (int i = 0; i < 2; ++i) { *(LAS u32x4*)(KI + row * 160 + seg * 32 + 16 * i) = pk[i];
                    const u32x4 x = *(const LAS u32x4*)(S0F + row * 128 + seg * 32 + 16 * i), y = *(const LAS u32x4*)(S0B + row * 128 + seg * 32 + 16 * i);
                    u32x4 of, ob;
#pragma unroll
                    for (int e = 0; e < 4; ++e) { of[e] = cvt_pk_bf16(bflo(pf0[i][e]) + cf * bflo(x[e]), bfhi(pf0[i][e]) + cf * bfhi(x[e])); ob[e] = cvt_pk_bf16(bflo(pb0[i][e]) + cb * bflo(y[e]), bfhi(pb0[i][e]) + cb * bfhi(y[e])); }
                    *(LAS u32x4*)(SF + row * 144 + seg * 32 + 16 * i) = of; *(LAS u32x4*)(SB + row * 144 + seg * 32 + 16 * i) = ob; }
#pragma unroll
                for (int i = 0; i < 4; ++i) *(LAS u32x4*)(VI + row * 288 + seg * 64 + 16 * i) = pv[i]; }
            bf16x8 qf[2]; qf[0] = pq[0]; qf[1] = pq[1];
            __syncthreads();
            if (k < 3) prefetch(it + 1);
            f32x4 accS[8];
#pragma unroll
            for (int jb = 0; jb < 8; ++jb) { accS[jb] = (f32x4){0.f, 0.f, 0.f, 0.f};
#pragma unroll
                for (int ks = 0; ks < 2; ++ks) { const bf16x8 kf = *(const LAS bf16x8*)(KI + (16 * jb + l15) * 160 + (32 * ks + 8 * g) * 2);
                    accS[jb] = __builtin_amdgcn_mfma_f32_16x16x32_bf16(kf, qf[ks], accS[jb], 0, 0, 0); } }
            bf16x8 pf[4];
#pragma unroll
            for (int s2 = 0; s2 < 4; ++s2) { float pe[8];
#pragma unroll
                for (int e = 0; e < 8; ++e) { const int jb = 2 * s2 + (e >> 2), r = e & 3, j = 16 * jb + 4 * g + r, df = il - j;
                    float mk = __builtin_amdgcn_exp2f((df >= 0 ? l2f : -l2b) * (float)df); if (df == 0) mk = 2.f;
                    pe[e] = accS[jb][r] * mk; }
                u32x4 pw; pw.x = cvt_pk_bf16(pe[0], pe[1]); pw.y = cvt_pk_bf16(pe[2], pe[3]); pw.z = cvt_pk_bf16(pe[4], pe[5]); pw.w = cvt_pk_bf16(pe[6], pe[7]);
                pf[s2] = __builtin_bit_cast(bf16x8, pw); }
            const float decf = __builtin_amdgcn_exp2f(l2f * (float)(il + 1)), decb = __builtin_amdgcn_exp2f(l2b * (float)(128 - il));
            f32x4 accO[8];
#pragma unroll
            for (int vb = 0; vb < 8; ++vb) { f32x4 o = (f32x4){0.f, 0.f, 0.f, 0.f};
#pragma unroll
                for (int s2 = 0; s2 < 4; ++s2) { const bf16x8 vf = tr2(VI + (32 * s2 + 4 * g + q) * 288 + (16 * vb + 4 * p) * 2, 16 * 288);
                    o = __builtin_amdgcn_mfma_f32_16x16x32_bf16(vf, pf[s2], o, 0, 0, 0); }
                f32x4 tf = (f32x4){0.f, 0.f, 0.f, 0.f}, tb = (f32x4){0.f, 0.f, 0.f, 0.f};
#pragma unroll
                for (int ks = 0; ks < 2; ++ks) { const bf16x8 sf = *(const LAS bf16x8*)(SF + (16 * vb + l15) * 144 + (32 * ks + 8 * g) * 2);
                    const bf16x8 sb = *(const LAS bf16x8*)(SB + (16 * vb + l15) * 144 + (32 * ks + 8 * g) * 2);
                    tf = __builtin_amdgcn_mfma_f32_16x16x32_bf16(sf, qf[ks], tf, 0, 0, 0); tb = __builtin_amdgcn_mfma_f32_16x16x32_bf16(sb, qf[ks], tb, 0, 0, 0); }
                accO[vb] = o + tf * decf + tb * decb; __builtin_amdgcn_sched_barrier(0); }
            float sm = 0.f;
#pragma unroll
            for (int vb = 0; vb < 8; ++vb) sm += (accO[vb].x + accO[vb].y) + (accO[vb].z + accO[vb].w);
            sm += __shfl_xor(sm, 16); sm += __shfl_xor(sm, 32);
            const float mu = sm * (1.f / 128.f); float sq = 0.f;
#pragma unroll
            for (int vb = 0; vb < 8; ++vb) { accO[vb] = accO[vb] - mu; sq += (accO[vb].x * accO[vb].x + accO[vb].y * accO[vb].y) + (accO[vb].z * accO[vb].z + accO[vb].w * accO[vb].w); }
            sq += __shfl_xor(sq, 16); sq += __shfl_xor(sq, 32);
            const float rstd = 1.0f / sqrtf(sq * (1.f / 128.f) + EPS);
            __syncthreads();
#pragma unroll
            for (int vb = 0; vb < 8; ++vb) { const f32x4 gw = *(const f32x4*)(F.gn_w + h * 128 + 16 * vb + 4 * g); const f32x4 o = accO[vb] * rstd * gw;
                u32x2 ow; ow.x = cvt_pk_bf16(o.x, o.y); ow.y = cvt_pk_bf16(o.z, o.w);
                *(LAS u32x2*)(VI + il * 288 + (16 * vb + 4 * g) * 2) = ow; }
            __syncthreads();
            { const size_t go = (tok0 + row) * 1024 + h * 128 + seg * 32;
#pragma unroll
                for (int i = 0; i < 4; ++i) { const u32x4 o = *(const LAS u32x4*)(VI + row * 288 + seg * 64 + 16 * i); const u32x4 z = *(const u32x4*)(F.SZB + go + 8 * i);
                    u32x4 r;
#pragma unroll
                    for (int e = 0; e < 4; ++e) r[e] = cvt_pk_bf16(bflo(o[e]) * siluf(bflo(z[e])), bfhi(o[e]) * siluf(bfhi(z[e])));
                    *(u32x4*)(F.UB + go + 8 * i) = r; } }
            __syncthreads();
        }
    }
}
struct SchedSq { int G, c; DI bool next(int i, pg8::Unit& u) const { const int L = i * G + c; if (L >= 256) return false; pg8::tile_of(L, 64, 4, u); return true; } };
struct EpiAB {
    const bf16_t* R; const bf16_t* SGB; bf16_t* MM;
    DI int vm_ops(const pg8::Unit&) const { return 0; }
    DI void mid(f32x4 (&acc)[2][2][4][2], const pg8::Unit& u, int wr, int wc, int fr, int fq) const { apply<false>(acc, u, wr, wc, fr, fq); }
    DI void operator()(const f32x4 (&acc)[2][2][4][2], const pg8::Unit& u, int wr, int wc, int fr, int fq) const { apply<true>(const_cast<f32x4 (&)[2][2][4][2]>(acc), u, wr, wc, fr, fq); }
    template <bool FIN> DI void apply(f32x4 (&acc)[2][2][4][2], const pg8::Unit& u, int wr, int wc, int fr, int fq) const {
        const bf16_t* src = FIN ? SGB : R;
        const size_t base = (size_t)(u.pm * 256 + wr * 64 + fr) * 1024 + u.pn * 256 + wc * 32 + 8 * fq;
#pragma unroll
        for (int am = 0; am < 4; ++am) { const int ai = am >> 1;
            u32x4 gv[4][2];
#pragma unroll
            for (int m = 2 * (am & 1); m < 2 * (am & 1) + 2; ++m)
#pragma unroll
                for (int bj = 0; bj < 2; ++bj) gv[m][bj] = *(const u32x4*)(src + base + (size_t)(ai * 128 + m * 16) * 1024 + bj * 128);
#pragma unroll
            for (int m = 2 * (am & 1); m < 2 * (am & 1) + 2; ++m)
#pragma unroll
                for (int bj = 0; bj < 2; ++bj) { const u32x4 gq = gv[m][bj];
                    f32x4 a = acc[ai][bj][m][0], b = acc[ai][bj][m][1];
                    a.x *= bflo(gq.x); a.y *= bfhi(gq.x); a.z *= bflo(gq.y); a.w *= bfhi(gq.y); b.x *= bflo(gq.z); b.y *= bfhi(gq.z); b.z *= bflo(gq.w); b.w *= bfhi(gq.w);
                    if (FIN) { u32x4 w; w.x = cvt_pk_bf16(a.x, a.y); w.y = cvt_pk_bf16(a.z, a.w); w.z = cvt_pk_bf16(b.x, b.y); w.w = cvt_pk_bf16(b.z, b.w);
                        *(u32x4*)(MM + base + (size_t)(ai * 128 + m * 16) * 1024 + bj * 128) = w; }
                    else { acc[ai][bj][m][0] = a; acc[ai][bj][m][1] = b; } }
            asm volatile("" ::: "memory");
        }
    }
};
struct EpiOut {
    const float* x; const float* MOD; float* out;
    DI int vm_ops(const pg8::Unit&) const { return 0; }
    DI void mid(f32x4 (&)[2][2][4][2], const pg8::Unit&, int, int, int, int) const {}
    DI void operator()(const f32x4 (&acc)[2][2][4][2], const pg8::Unit& u, int wr, int wc, int fr, int fq) const {
        const int col0 = u.pn * 256 + wc * 32 + 8 * fq; const float* gp = MOD + (u.pm >> 4) * 3072 + 2048 + col0;
        f32x4 gx[2][2];
#pragma unroll
        for (int bj = 0; bj < 2; ++bj)
#pragma unroll
            for (int n = 0; n < 2; ++n) gx[bj][n] = *(const f32x4*)(gp + bj * 128 + 4 * n);
#pragma unroll
        for (int ai = 0; ai < 2; ++ai)
#pragma unroll
            for (int m = 0; m < 4; ++m) { const size_t off = (size_t)(u.pm * 256 + ai * 128 + wr * 64 + m * 16 + fr) * 1024 + col0;
#pragma unroll
                for (int bj = 0; bj < 2; ++bj)
#pragma unroll
                    for (int n = 0; n < 2; ++n) { const f32x4 xv = *(const f32x4*)(x + off + bj * 128 + 4 * n); *(f32x4*)(out + off + bj * 128 + 4 * n) = xv + gx[bj][n] * acc[ai][bj][m][n]; }
                if (m & 1) asm volatile("" ::: "memory"); }
    }
};
struct EpiOutNorm {
    const float* x; const float* MOD; float* out; const float* fw; float* slots; unsigned* cnt; LAS float* tab;
    DI int vm_ops(const pg8::Unit&) const { return 0; }
    DI void mid(f32x4 (&)[2][2][4][2], const pg8::Unit&, int, int, int, int) const {}
    DI void operator()(const f32x4 (&acc_)[2][2][4][2], const pg8::Unit& u, int wr, int wc, int fr, int fq) const {
        f32x4 (&acc)[2][2][4][2] = const_cast<f32x4 (&)[2][2][4][2]>(acc_);
        const int col0 = u.pn * 256 + wc * 32 + 8 * fq; const float* gp = MOD + (u.pm >> 4) * 3072 + 2048 + col0;
        f32x4 gx[2][2];
#pragma unroll
        for (int bj = 0; bj < 2; ++bj)
#pragma unroll
            for (int n = 0; n < 2; ++n) gx[bj][n] = *(const f32x4*)(gp + bj * 128 + 4 * n);
#pragma unroll
        for (int ai = 0; ai < 2; ++ai)
#pragma unroll
            for (int m = 0; m < 4; ++m) { const int row = u.pm * 256 + ai * 128 + wr * 64 + m * 16 + fr; const size_t off = (size_t)row * 1024 + col0; float ss = 0.f;
#pragma unroll
                for (int bj = 0; bj < 2; ++bj)
#pragma unroll
                    for (int n = 0; n < 2; ++n) { const f32x4 xv = *(const f32x4*)(x + off + bj * 128 + 4 * n); const f32x4 v = xv + gx[bj][n] * acc[ai][bj][m][n]; acc[ai][bj][m][n] = v;
                        ss += (v.x * v.x + v.y * v.y) + (v.z * v.z + v.w * v.w); }
                ss += __shfl_xor(ss, 16); ss += __shfl_xor(ss, 32);
                if (fq == 0) __hip_atomic_store(slots + (size_t)row * 16 + u.pn * 4 + wc, ss, __ATOMIC_RELAXED, __HIP_MEMORY_SCOPE_AGENT);
                if (m & 1) asm volatile("" ::: "memory"); }
        asm volatile("s_waitcnt vmcnt(0)" ::: "memory");
        __syncthreads();
        if (threadIdx.x == 0) {
            unsigned* c = cnt + 64 * u.pm;
            __hip_atomic_fetch_add(c, 1u, __ATOMIC_RELAXED, __HIP_MEMORY_SCOPE_AGENT);
            unsigned sp = 0;
            while (__hip_atomic_load(c, __ATOMIC_RELAXED, __HIP_MEMORY_SCOPE_AGENT) < 4u) { __builtin_amdgcn_s_sleep(1); if (++sp > (1u << 22)) break; }
            __builtin_amdgcn_fence(__ATOMIC_ACQUIRE, "agent");
            asm volatile("s_waitcnt vmcnt(0)" ::: "memory");
        }
        __syncthreads();
        { const int t = threadIdx.x, row = t >> 1, half = t & 1; const float* sp = slots + (size_t)(u.pm * 256 + row) * 16 + half * 8; float s = 0.f;
#pragma unroll
            for (int j = 0; j < 8; ++j) s += __hip_atomic_load(sp + j, __ATOMIC_RELAXED, __HIP_MEMORY_SCOPE_AGENT);
            s += __shfl_xor(s, 1);
            if (half == 0) tab[row] = 1.0f / sqrtf(s * (1.f / 1024.f) + EPS); }
        __syncthreads();
        f32x4 fv[2][2];
#pragma unroll
        for (int bj = 0; bj < 2; ++bj)
#pragma unroll
            for (int n = 0; n < 2; ++n) fv[bj][n] = *(const f32x4*)(fw + col0 + bj * 128 + 4 * n);
#pragma unroll
        for (int ai = 0; ai < 2; ++ai)
#pragma unroll
            for (int m = 0; m < 4; ++m) { const int rl = ai * 128 + wr * 64 + m * 16 + fr; const float r = tab[rl]; const size_t off = (size_t)(u.pm * 256 + rl) * 1024 + col0;
#pragma unroll
                for (int bj = 0; bj < 2; ++bj)
#pragma unroll
                    for (int n = 0; n < 2; ++n) *(f32x4*)(out + off + bj * 128 + 4 * n) = acc[ai][bj][m][n] * r * fv[bj][n]; }
    }
};
DI void n6_ab(const Ctx& F) {
    const Tid T = opaque_tid();
    const size_t NT = (size_t)gridDim.x * 512, gt = (size_t)blockIdx.x * 512 + T.tid;
    for (size_t idx = gt; idx < (size_t)(MTOK / 4) * 1024; idx += NT) {
        const int n = (int)(idx & 1023), t0 = (int)(idx >> 10) * 4; float ya[4] = {0.f, 0.f, 0.f, 0.f}, yb[4] = {0.f, 0.f, 0.f, 0.f};
        for (int k = 0; k < 1024; ++k) { const float wa = F.w_a[(size_t)k * 1024 + n], wb = F.w_b[(size_t)k * 1024 + n];
#pragma unroll
            for (int j = 0; j < 4; ++j) { ya[j] += bf2f(F.P[(size_t)(t0 + j) * 1024 + k]) * wa; yb[j] += bf2f(F.UB[(size_t)(t0 + j) * 1024 + k]) * wb; } }
#pragma unroll
        for (int j = 0; j < 4; ++j) { const size_t o = (size_t)(t0 + j) * 1024 + n; const float sgb = bf2f(F.SGB[o]), sga = bf2f(F.R[o]) * sgb; F.MM[o] = f2bf(sga * ya[j] + sgb * yb[j]); }
    }
}
DI void n7_out(const Ctx& F) {
    const Tid T = opaque_tid();
    const size_t NT = (size_t)gridDim.x * 512, gt = (size_t)blockIdx.x * 512 + T.tid;
    for (size_t idx = gt; idx < (size_t)(MTOK / 4) * 1024; idx += NT) {
        const int n = (int)(idx & 1023), t0 = (int)(idx >> 10) * 4; float y[4] = {0.f, 0.f, 0.f, 0.f};
        for (int k = 0; k < 1024; ++k) { const float w = F.w_out[(size_t)k * 1024 + n];
#pragma unroll
            for (int j = 0; j < 4; ++j) y[j] += bf2f(F.MM[(size_t)(t0 + j) * 1024 + k]) * w; }
#pragma unroll
        for (int j = 0; j < 4; ++j) { const size_t o = (size_t)(t0 + j) * 1024 + n; F.out[o] = F.x[o] + F.MOD[((t0 + j) >> 12) * 3072 + 2048 + n] * y[j]; }
    }
}
DI void p8_final(const Ctx& F) {
    const Tid T = opaque_tid();
    const int gw = blockIdx.x * 8 + T.wave, NGW = gridDim.x * 8;
    for (int m = gw; m < MTOK; m += NGW) {
        f32x4* xr = (f32x4*)(F.out + (size_t)m * DM);
        f32x4 v[4]; float ss = 0.f;
#pragma unroll
        for (int j = 0; j < 4; ++j) { v[j] = xr[T.lane + 64 * j]; ss += (v[j].x * v[j].x + v[j].y * v[j].y) + (v[j].z * v[j].z + v[j].w * v[j].w); }
        const float rstd = 1.0f / sqrtf(wave_sum(ss) * (1.f / DM) + EPS);
#pragma unroll
        for (int j = 0; j < 4; ++j) { const f32x4 w = *(const f32x4*)(F.final_w + 4 * (T.lane + 64 * j)); xr[T.lane + 64 * j] = v[j] * rstd * w; }
    }
}

constexpr int NPH = 9;
__global__ void __launch_bounds__(512, 2) fwd_kernel(Args args) {
    extern __shared__ __attribute__((aligned(16))) unsigned char lds_raw[];
    Ctx F;
    F.lds = (LAS unsigned char*)lds_raw;
    if (threadIdx.x < 16) ((LAS unsigned*)(F.lds + LDS_MISC))[threadIdx.x] = 0u;
#if !MK_LAUNCH_PER_PHASE
    {
        unsigned* flag = (unsigned*)(args.ws + WS_FLAG); unsigned* done = flag + 64;
        if (blockIdx.x == 0) {
            for (unsigned i = threadIdx.x; i < WS_BAR_BYTES / 16; i += 512) ((u32x4*)(args.ws + WS_BAR))[i] = (u32x4){0u, 0u, 0u, 0u};
            if (threadIdx.x == 0) __hip_atomic_store(done, 0u, __ATOMIC_RELAXED, __HIP_MEMORY_SCOPE_AGENT);
            asm volatile("s_waitcnt vmcnt(0)" ::: "memory");
            __syncthreads();
            if (threadIdx.x == 0) { __builtin_amdgcn_fence(__ATOMIC_RELEASE, "agent"); asm volatile("s_waitcnt vmcnt(0)" ::: "memory");
                __hip_atomic_store(flag, CTL_MAGIC, __ATOMIC_RELAXED, __HIP_MEMORY_SCOPE_AGENT); }
        } else if (threadIdx.x == 0) {
            unsigned sp = 0;
            while (__hip_atomic_load(flag, __ATOMIC_RELAXED, __HIP_MEMORY_SCOPE_AGENT) != CTL_MAGIC) { __builtin_amdgcn_s_sleep(1); if (++sp > (1u << 22)) break; }
            __builtin_amdgcn_fence(__ATOMIC_ACQUIRE, "agent"); asm volatile("s_waitcnt vmcnt(0)" ::: "memory");
        }
    }
#endif
    __syncthreads();
    const XcdBarrier bar = xcd_barrier_post((unsigned*)(args.ws + WS_BAR), (volatile LAS unsigned*)(F.lds + LDS_MISC));
    F.x = args.in[0]; F.c = args.in[1]; F.ctx = args.in[2]; F.c_ctx = args.in[3]; F.norm_w = args.in[4]; F.ada_w = args.in[5]; F.ada_b = args.in[6]; F.w_in = args.in[7];
    F.conv_w = args.in[8]; F.conv_b = args.in[9]; F.decay_logit = args.in[10]; F.gn_w = args.in[11]; F.w_a = args.in[12]; F.w_b = args.in[13]; F.w_out = args.in[14]; F.final_w = args.in[15];
    F.out = args.out; unsigned char* ws = args.ws; F.ws = ws;
    F.MOD = (float*)(ws + WS_MOD); F.ROPE = (f32x2*)(ws + WS_ROPE);
    F.WA = (bf16_t*)(ws + WS_WA); F.WB = (bf16_t*)(ws + WS_WB); F.WOUT = (bf16_t*)(ws + WS_WOUT); F.WIN = (bf16_t*)(ws + WS_WIN); F.XM = (bf16_t*)(ws + WS_XM);
    F.KV = (bf16_t*)(ws + WS_KV); F.KVC = (bf16_t*)(ws + WS_KVC); F.HC = (bf16_t*)(ws + WS_HC); F.ST = (bf16_t*)(ws + WS_ST); F.MM = (bf16_t*)(ws + WS_MM);
    F.P = (bf16_t*)(ws + WS_P); F.Q = (bf16_t*)(ws + WS_Q); F.K = (bf16_t*)(ws + WS_K); F.V = (bf16_t*)(ws + WS_V); F.SZB = (bf16_t*)(ws + WS_SZB);
    F.KC = (bf16_t*)(ws + WS_KC); F.VC = (bf16_t*)(ws + WS_VC); F.UB = (bf16_t*)(ws + WS_UB);
    F.R = (bf16_t*)args.out; F.SGB = (bf16_t*)args.out + (size_t)MTOK * DM;
    F.RET = (float*)(ws + WS_RET); F.S0 = (float*)(ws + WS_KVC);
    const int lo = args.ph_lo, hi = args.ph_hi; const unsigned naive = args.naive;
#define IN(k) (lo <= (k) && (k) < hi && ((MK_PHASES >> (k)) & 1))
#define NAIVE(k) (((naive & MK_NAIVE_AVAIL) >> (k)) & 1u)
#define SEAM(k) do { if (IN(k) && IN((k) + 1)) xcd_barrier(bar); } while (0)
#define REP(k) for (int rep_ = 0; rep_ < 1 + (int)((MK_REP_MASK >> (k)) & 1u); ++rep_)
    if (IN(0)) REP(0) { p0_prologue(F); } SEAM(0);
    if (IN(1)) REP(1) { p1_rows(F); } SEAM(1);
    if (IN(2)) REP(2) {
        if (NAIVE(2)) n2_inproj(F);
        else { const char* const Ab[2] = {(const char*)F.XM, (const char*)F.XM}; const char* const Bb[2] = {(const char*)F.WIN, (const char*)F.WIN};
            Sched1 S{(int)gridDim.x, (int)blockIdx.x}; Epi1 E{F.ws, F.R, F.SGB, F.ROPE};
            pg8::gemm_phase<1, Epi1, Sched1>(F.lds, Ab, Bb, S, E); }
    } SEAM(2);
    if (IN(3)) {
        if (!NAIVE(3)) {
            const char* const Ab[2] = {(const char*)F.XM, (const char*)F.XM}; const char* const Bb[2] = {(const char*)F.WIN, (const char*)F.WIN};
            SchedCtx S{(int)blockIdx.x}; Epi1 E{F.ws, F.R, F.SGB, F.ROPE};
            pg8::gemm_phase<1, Epi1, SchedCtx>(F.lds, Ab, Bb, S, E);
            if (blockIdx.x >= 24) { REP(3) p3_kv(F, blockIdx.x - 24, 1024, gridDim.x - 24); p3_ua(F, blockIdx.x - 24, gridDim.x - 24); }
        } else p3_ua(F, blockIdx.x, gridDim.x);
    } SEAM(3);
    if (IN(4)) REP(4) { if (NAIVE(4)) n4_recurrence(F); else { if (blockIdx.x >= gridDim.x - 32) p4_ctx_state(F, blockIdx.x - (gridDim.x - 32)); else p4_scan(F, blockIdx.x, gridDim.x - 32); } } SEAM(4);
    if (IN(5)) REP(5) { if (NAIVE(5)) n5_groupnorm(F); else p5_ret(F); } SEAM(5);
    if (IN(6)) REP(6) {
        if (NAIVE(6)) n6_ab(F);
        else { const char* const Ab[2] = {(const char*)F.P, (const char*)F.UB}; const char* const Bb[2] = {(const char*)F.WA, (const char*)F.WB};
            SchedSq S{(int)gridDim.x, (int)blockIdx.x}; EpiAB E{F.R, F.SGB, F.MM};
            pg8::gemm_phase<2, EpiAB, SchedSq>(F.lds, Ab, Bb, S, E); }
    } SEAM(6);
    if (IN(7)) {
        const char* const Ab[2] = {(const char*)F.MM, (const char*)F.MM}; const char* const Bb[2] = {(const char*)F.WOUT, (const char*)F.WOUT};
        SchedSq S{(int)gridDim.x, (int)blockIdx.x};
        if (NAIVE(7)) n7_out(F);
        else if (gridDim.x == 256) {
            EpiOutNorm E{F.x, F.MOD, F.out, F.final_w, (float*)(F.ws + WS_SLOTS), (unsigned*)(F.ws + WS_PCNT), (LAS float*)(F.lds + LDS_TAB)};
            pg8::gemm_phase<1, EpiOutNorm, SchedSq>(F.lds, Ab, Bb, S, E); }
        else { EpiOut E{F.x, F.MOD, F.out}; pg8::gemm_phase<1, EpiOut, SchedSq>(F.lds, Ab, Bb, S, E); }
    }
    if (NAIVE(7) || gridDim.x != 256) { SEAM(7); if (IN(8)) { p8_final(F); } }
#if !MK_LAUNCH_PER_PHASE
    __syncthreads();
    if (threadIdx.x == 0) { unsigned* flag = (unsigned*)(args.ws + WS_FLAG); unsigned* done = flag + 64;
        if (__hip_atomic_fetch_add(done, 1u, __ATOMIC_RELAXED, __HIP_MEMORY_SCOPE_AGENT) == gridDim.x - 1) __hip_atomic_store(flag, 0u, __ATOMIC_RELAXED, __HIP_MEMORY_SCOPE_AGENT); }
#endif
#undef IN
#undef NAIVE
#undef SEAM
}

extern "C" void kernel_launch(void* const* d_in, const int* in_sizes, int n_in, void* d_out, int out_size, void* d_ws, size_t ws_size, hipStream_t stream) {
    static int grid = 0;
    if (grid == 0) {
        if (n_in != 16 || out_size != MTOK * DM || ws_size < WS_END) { fprintf(stderr, "kernel_launch: unexpected shapes (n_in %d out %d ws %zu)\n", n_in, out_size, ws_size); grid = -1; return; }
        int dev = 0, cus = 0, per_cu = 0;
        hipGetDevice(&dev); hipDeviceGetAttribute(&cus, hipDeviceAttributeMultiprocessorCount, dev);
        hipFuncSetAttribute((const void*)fwd_kernel, hipFuncAttributeMaxDynamicSharedMemorySize, LDS_BYTES);
        hipOccupancyMaxActiveBlocksPerMultiprocessor(&per_cu, (const void*)fwd_kernel, 512, LDS_BYTES);
        if (per_cu < 1) { fprintf(stderr, "kernel_launch: occupancy query says %d blocks/CU\n", per_cu); per_cu = 1; }
        grid = cus;
        (void)hipGetLastError();
    }
    if (grid < 0) return;
    Args a{};
    for (int i = 0; i < 16; ++i) a.in[i] = (const float*)d_in[i];
    a.out = (float*)d_out; a.ws = (unsigned char*)d_ws; a.naive = MK_NAIVE_MASK;
#if MK_LAUNCH_PER_PHASE
    hipMemsetAsync((unsigned char*)d_ws + WS_BAR, 0, WS_BAR_BYTES, stream);
#endif
#if MK_LAUNCH_PER_PHASE
    for (int ph = 0; ph < NPH; ++ph) { a.ph_lo = ph; a.ph_hi = ph + 1; hipLaunchKernelGGL(fwd_kernel, dim3(grid), dim3(512), LDS_BYTES, stream, a); }
#else
    a.ph_lo = 0; a.ph_hi = NPH;
    hipLaunchKernelGGL(fwd_kernel, dim3(grid), dim3(512), LDS_BYTES, stream, a);
#endif
}
```

```cpp
#include <hip/hip_runtime.h>
#include <cstdio>
#include <cstdint>

#ifndef MK_LAUNCH_PER_PHASE
#define MK_LAUNCH_PER_PHASE 0
#endif
#ifndef MK_NAIVE_MASK
#define MK_NAIVE_MASK 0x00u
#endif

#ifndef MK_REP_MASK
#define MK_REP_MASK 0u
#endif
#ifndef MK_PHASES
#define MK_PHASES 0x1ff
#endif
#ifndef MK_NAIVE_AVAIL
#define MK_NAIVE_AVAIL 0xffu
#endif
#define DI __device__ __forceinline__
#define LAS __attribute__((address_space(3)))
typedef unsigned short bf16_t;
typedef float f32x4 __attribute__((ext_vector_type(4)));
typedef float f32x2 __attribute__((ext_vector_type(2)));
typedef unsigned u32x4 __attribute__((ext_vector_type(4)));
typedef unsigned u32x2 __attribute__((ext_vector_type(2)));
typedef short bf16x8 __attribute__((ext_vector_type(8)));
typedef short s16x4 __attribute__((ext_vector_type(4)));
typedef short v4i16_t __attribute__((ext_vector_type(4)));

constexpr int NB = 4, SEQ = 4096, DM = 1024, MTOK = NB * SEQ, CTXL = 256, MCTX = NB * CTXL, MALL = MTOK + MCTX;
constexpr int NIN = 9216, NH = 8, DK = 64, DV = 128, CHK = 128, NCHK = SEQ / CHK;
constexpr float EPS = 1e-6f;
constexpr size_t MiB = 1u << 20;
constexpr size_t WS_MOD = 0;
constexpr size_t WS_ROPE = 65536;
constexpr size_t WS_WA = 2 * MiB, WS_WB = 4 * MiB, WS_WOUT = 6 * MiB, WS_WIN = 8 * MiB;
constexpr size_t WS_XM = 26 * MiB;
constexpr size_t WS_KV = 223 * MiB;
constexpr size_t WS_KVC = 40 * MiB;
constexpr size_t WS_RET = 8 * MiB;
constexpr size_t WS_HC = 60 * MiB;
constexpr size_t WS_ST = 60 * MiB;
constexpr size_t WS_MM = 60 * MiB;
constexpr size_t WS_P = 92 * MiB;
constexpr size_t WS_Q = 124 * MiB, WS_K = 140 * MiB, WS_V = 156 * MiB, WS_SZB = 188 * MiB;
constexpr size_t WS_KC = 220 * MiB, WS_VC = 221 * MiB;
constexpr size_t WS_UB = 223 * MiB;
constexpr size_t WS_END = 255 * MiB;
constexpr int LDS_BYTES = 147456;
constexpr int LDS_MISC = 139264;
constexpr size_t WS_BAR = 131072, WS_BAR_BYTES = 65536;
constexpr size_t WS_PCNT = WS_BAR + 16384, WS_SLOTS = 1 * MiB;
constexpr size_t WS_FLAG = 98304;
constexpr unsigned CTL_MAGIC = 0x600DF1A6u;
constexpr int LDS_TAB = 132096;

DI float bf2f(bf16_t v) { return __uint_as_float((unsigned)v << 16); }
DI float bflo(unsigned w) { return __uint_as_float(w << 16); }
DI float bfhi(unsigned w) { return __uint_as_float(w & 0xffff0000u); }
typedef __bf16 bf16x2_t __attribute__((ext_vector_type(2)));
DI unsigned cvt_pk_bf16(float lo, float hi) { const f32x2 f = {lo, hi}; const bf16x2_t v = __builtin_convertvector(f, bf16x2_t); return __builtin_bit_cast(unsigned, v); }
DI bf16_t f2bf(float f) { return (bf16_t)(cvt_pk_bf16(f, 0.f) & 0xffffu); }
DI float wave_sum(float v) {
#pragma unroll
    for (int o = 1; o < 64; o <<= 1) v += __shfl_xor(v, o);
    return v;
}
struct Tid { int tid, lane, wave; };
DI Tid opaque_tid() { int t = threadIdx.x; asm volatile("" : "+v"(t)); Tid r; r.tid = t; r.lane = t & 63; r.wave = __builtin_amdgcn_readfirstlane(t >> 6); return r; }
DI float siluf(float x) { return x * __builtin_amdgcn_rcpf(1.f + __expf(-x)); }
DI float log2_gamma(const float* decay_logit, int dir, int h) {
    const float x = decay_logit[dir * NH + h];
    const float ls = fminf(x, 0.f) - log1pf(expf(-fabsf(x)));
    return ls * 1.4426950408889634f;
}

namespace pg8 {
constexpr int BM = 256, BK = 64, HALF = 128, HTB = HALF * BK * 2, STAGE_BYTES = 8 * HTB, NXCD = 8, WGM = 4;
DI int lds_byte(int r, int c) { const int st = (r >> 4) * 2 + (c >> 5), rr = r & 15, cc = c & 31, ob = rr * 64 + cc * 2; return st * 1024 + (ob ^ (((ob >> 9) & 1) << 5)); }
DI void stage_rc(int b, int& R, int& C) { const int st = b / 1024, sb = b % 1024, swz = sb ^ (((sb >> 9) & 1) << 5); R = (st >> 1) * 16 + swz / 64; C = (st & 1) * 32 + (swz % 64) / 2; }
DI int perm32(int rho) { const int n = rho >> 4, i = rho & 15; return 8 * (i >> 2) + 4 * n + (i & 3); }
struct Unit { int pm, pn; };
DI void tile_of(int L, int nM, int nN, Unit& u) {
    const int nwg = nM * nN; int wgid = L;
    { const int q = nwg / NXCD, r = nwg % NXCD, xcd = wgid % NXCD, off = wgid / NXCD; wgid = (xcd < r ? xcd * (q + 1) : r * (q + 1) + (xcd - r) * q) + off; }
    const int nig = WGM * nN, gid = wgid / nig, fm = gid * WGM, gsz = (nM - fm) < WGM ? (nM - fm) : WGM;
    u.pm = fm + ((wgid % nig) % gsz); u.pn = (wgid % nig) / gsz;
}
template <int NSEG, class Epi, class Sched>
DI void gemm_phase(LAS unsigned char* lds, const char* const (&Ab)[2], const char* const (&Bb)[2], const Sched& S, const Epi& E) {
    constexpr int K = 1024, NTS = K / BK;
    constexpr int nt = NSEG * NTS;
    const Tid T = opaque_tid();
    const int tid = T.tid, wid = T.wave, lane = T.lane, wr = wid >> 2, wc = (wid & 3) ^ (wr << 1), fr = lane & 15, fq = lane >> 4;
    unsigned voffA[2], voffB[2];
#pragma unroll
    for (int i = 0; i < 2; ++i) { int R, C; stage_rc(tid * 16 + i * 8192, R, C); const int Rb = (R & ~31) + perm32(R & 31);
        voffA[i] = (unsigned)(R * K + C) * 2u; voffB[i] = (unsigned)(Rb * K + C) * 2u; }
    constexpr size_t kstep = (size_t)(BK * 2);
    constexpr size_t hstep = (size_t)HALF * K * 2;
    constexpr size_t tstep = 2 * hstep;
    const unsigned ldsw = (unsigned)wid * 1024u;
    const int aoff = lds_byte(wr * 64 + fr, fq * 8), boff = lds_byte(wc * 32 + fr, fq * 8);
#define PG8_SA(b, h) (((b) * 2 + (h)) * HTB)
#define PG8_SB(b, h) ((4 + (b) * 2 + (h)) * HTB)
#define PG8_STAGE(bufoff, gbase, voff) do { _Pragma("unroll") for (int _i = 0; _i < 2; ++_i) \
        __builtin_amdgcn_global_load_lds((const unsigned*)((const char*)(gbase) + (voff)[_i]), (LAS unsigned*)(lds + (bufoff) + ldsw + _i * 8192), 16, 0, 0); } while (0)
#define PG8_LDA(dst, b, h) do { _Pragma("unroll") for (int m = 0; m < 4; ++m) _Pragma("unroll") for (int k = 0; k < 2; ++k) dst[m][k] = *(const LAS bf16x8*)(lds + PG8_SA(b, h) + aoff + m * 2048 + k * 1024); } while (0)
#define PG8_LDB(dst, b, h) do { _Pragma("unroll") for (int n = 0; n < 2; ++n) _Pragma("unroll") for (int k = 0; k < 2; ++k) dst[n][k] = *(const LAS bf16x8*)(lds + PG8_SB(b, h) + boff + n * 2048 + k * 1024); } while (0)
#define PG8_MMA(ai, bj, At, Bt) do { __builtin_amdgcn_s_setprio(1); _Pragma("unroll") for (int m = 0; m < 4; ++m) _Pragma("unroll") for (int n = 0; n < 2; ++n) _Pragma("unroll") for (int k = 0; k < 2; ++k) \
        acc[ai][bj][m][n] = __builtin_amdgcn_mfma_f32_16x16x32_bf16(Bt[n][k], At[m][k], acc[ai][bj][m][n], 0, 0, 0); __builtin_amdgcn_s_setprio(0); } while (0)
#define PG8_WAIT_V(n) asm volatile("s_waitcnt vmcnt(" #n ")" ::: "memory")
#define PG8_WAIT_L(n) asm volatile("s_waitcnt lgkmcnt(" #n ")" ::: "memory")
#define PG8_WAIT_VR(sel) asm volatile("s_cmp_lt_i32 %0, 8\n\ts_cbranch_scc1 .Lw8_%=\n\ts_cmp_lt_i32 %0, 16\n\ts_cbranch_scc1 .Lw16_%=\n\ts_waitcnt vmcnt(24)\n\ts_branch .Lwe_%=\n.Lw16_%=:\n\ts_waitcnt vmcnt(16)\n\ts_branch .Lwe_%=\n.Lw8_%=:\n\ts_waitcnt vmcnt(8)\n.Lwe_%=:" :: "s"(sel) : "memory", "scc")
#define PG8_BAR __builtin_amdgcn_s_barrier()
#define PG8_SCHED __builtin_amdgcn_sched_barrier(0)
#define PG8_TA(u, t) (Ab[(t) / NTS] + (size_t)(u).pm * tstep + (size_t)((t) % NTS) * kstep)
#define PG8_TB(u, t) (Bb[(t) / NTS] + (size_t)(u).pn * tstep + (size_t)((t) % NTS) * kstep)
    Unit cur, nxt; int ui = 0;
    if (!S.next(0, cur)) return;
    f32x4 acc[2][2][4][2];
#pragma unroll
    for (int a = 0; a < 2; ++a)
#pragma unroll
        for (int b = 0; b < 2; ++b)
#pragma unroll
            for (int m = 0; m < 4; ++m)
#pragma unroll
                for (int n = 0; n < 2; ++n) acc[a][b][m][n] = (f32x4){0.f, 0.f, 0.f, 0.f};
    bf16x8 At[4][2], B0[2][2], B1[2][2];
    {
        const char* cA = PG8_TA(cur, 0); const char* cB = PG8_TB(cur, 0);
        PG8_STAGE(PG8_SB(0, 0), cB, voffB); PG8_STAGE(PG8_SB(0, 1), cB + hstep, voffB); PG8_STAGE(PG8_SA(0, 0), cA, voffA); PG8_STAGE(PG8_SA(0, 1), cA + hstep, voffA);
        if (wr == 1) PG8_BAR;
        PG8_WAIT_V(2); PG8_BAR;
        PG8_STAGE(PG8_SB(1, 0), cB + kstep, voffB); PG8_STAGE(PG8_SA(1, 0), cA + kstep, voffA); PG8_STAGE(PG8_SB(1, 1), cB + hstep + kstep, voffB);
        PG8_WAIT_V(6); PG8_BAR;
    }
    for (;;) {
        const bool has_next = S.next(ui + 1, nxt);
        const Unit nu = has_next ? nxt : cur;
        for (int t = 0; t < nt; t += 2) {
            if (NSEG == 2 && t == NTS) E.mid(acc, cur, wr, wc, fr, fq);
            const bool last = (t == nt - 2);
            const char* a1 = PG8_TA(cur, t + 1);
            const char* a2 = last ? PG8_TA(nu, 0) : PG8_TA(cur, t + 2); const char* b2 = last ? PG8_TB(nu, 0) : PG8_TB(cur, t + 2);
            const char* a3 = a2 + kstep; const char* b3 = b2 + kstep;
            PG8_LDB(B0, 0, 0); PG8_LDB(B1, 0, 1); PG8_SCHED; PG8_LDA(At, 0, 0); PG8_STAGE(PG8_SA(1, 1), a1 + hstep, voffA);
            PG8_WAIT_V(8); PG8_WAIT_L(0); PG8_BAR; PG8_MMA(0, 0, At, B0); PG8_MMA(0, 1, At, B1); PG8_BAR; PG8_SCHED;
            PG8_LDA(At, 0, 1); PG8_STAGE(PG8_SB(0, 0), b2, voffB); PG8_STAGE(PG8_SB(0, 1), b2 + hstep, voffB); PG8_STAGE(PG8_SA(0, 0), a2, voffA);
            PG8_WAIT_V(8); PG8_WAIT_L(0); PG8_BAR; PG8_MMA(1, 0, At, B0); PG8_MMA(1, 1, At, B1); PG8_BAR; PG8_SCHED;
            PG8_LDB(B0, 1, 0); PG8_LDB(B1, 1, 1); PG8_SCHED; PG8_LDA(At, 1, 0); PG8_STAGE(PG8_SA(0, 1), a2 + hstep, voffA);
            PG8_WAIT_V(8); PG8_WAIT_L(0); PG8_BAR; PG8_MMA(0, 0, At, B0); PG8_MMA(0, 1, At, B1); PG8_BAR; PG8_SCHED;
            PG8_LDA(At, 1, 1); PG8_STAGE(PG8_SB(1, 0), b3, voffB); PG8_STAGE(PG8_SB(1, 1), b3 + hstep, voffB); PG8_STAGE(PG8_SA(1, 0), a3, voffA);
            PG8_WAIT_V(8); PG8_WAIT_L(0); PG8_BAR; PG8_MMA(1, 0, At, B0); PG8_MMA(1, 1, At, B1); PG8_BAR; PG8_SCHED;
        }
        if (wr == 0) PG8_BAR;
        E(acc, cur, wr, wc, fr, fq);
        if (!has_next) break;
#pragma unroll
        for (int a = 0; a < 2; ++a)
#pragma unroll
            for (int b = 0; b < 2; ++b)
#pragma unroll
                for (int m = 0; m < 4; ++m)
#pragma unroll
                    for (int n = 0; n < 2; ++n) acc[a][b][m][n] = (f32x4){0.f, 0.f, 0.f, 0.f};
        cur = nxt; ++ui;
        if (wr == 1) PG8_BAR;
    }
    PG8_WAIT_V(0);
    PG8_BAR;
#undef PG8_SA
#undef PG8_SB
#undef PG8_STAGE
#undef PG8_LDA
#undef PG8_LDB
#undef PG8_MMA
#undef PG8_WAIT_V
#undef PG8_WAIT_L
#undef PG8_WAIT_VR
#undef PG8_BAR
#undef PG8_SCHED
#undef PG8_TA
#undef PG8_TB
}
}


#define XB_TMO      128
#define XB_XCNT(j)  (256  + 64 * (j))
#define XB_XSUB(j)  (1280 + 64 * (j))
#define XB_XGEN(j)  (2304 + 64 * (j))
#define XB_TOP      3328
#define XB_TOPGEN   3392
#define XCD_BAR_WORDS 3456
#define XB_SPIN_CAP (1u << 18)
DI unsigned xb_ld(unsigned* p)              { return __hip_atomic_load(p, __ATOMIC_RELAXED, __HIP_MEMORY_SCOPE_AGENT); }
DI unsigned xb_add(unsigned* p, unsigned v) { return __hip_atomic_fetch_add(p, v, __ATOMIC_RELAXED, __HIP_MEMORY_SCOPE_AGENT); }
DI unsigned xb_xcc_id() { return (unsigned)__builtin_amdgcn_s_getreg((3 << 11) | 20) & 0xFu; }
#define XB_SPIN(cond, bar) do { unsigned _sp = 0; while (cond) { __builtin_amdgcn_s_sleep(1); \
    if ((++_sp & 255u) == 0u) { if (xb_ld(&(bar)[XB_TMO])) break; if (_sp > XB_SPIN_CAP) { atomicAdd(&(bar)[XB_TMO], 1u); break; } } } } while (0)
struct XcdBarrier { unsigned* bar; unsigned x; volatile LAS unsigned* st; };
DI XcdBarrier xcd_barrier_post(unsigned* bar, volatile LAS unsigned* st) {
    XcdBarrier b; b.bar = bar; b.x = xb_xcc_id(); b.st = st;
    if (threadIdx.x == 0) (void)xb_add(&bar[XB_XCNT(b.x)], 1u);
    return b;
}
DI void xcd_barrier_complete(unsigned* bar, unsigned x, unsigned& nloc, unsigned& nx) {
    const unsigned G = gridDim.x * gridDim.y * gridDim.z;
    unsigned sum, cnt, mine, sp = 0u;
    for (;;) {
        sum = 0u; cnt = 0u; mine = 0u;
#pragma unroll
        for (unsigned j = 0; j < 16; ++j) { const unsigned c = xb_ld(&bar[XB_XCNT(j)]); sum += c; cnt += (c > 0u) ? 1u : 0u; mine = (j == x) ? c : mine; }
        if (sum == G) break;
        __builtin_amdgcn_s_sleep(1);
        if ((++sp & 255u) == 0u) { if (xb_ld(&bar[XB_TMO])) break; if (sp > XB_SPIN_CAP) { atomicAdd(&bar[XB_TMO], 1u); break; } }
    }
    nloc = mine > 0u ? mine : 1u; nx = cnt > 0u ? cnt : 1u;
}
DI void xcd_barrier(const XcdBarrier& b) {
    asm volatile("s_waitcnt vmcnt(0)" ::: "memory");
    __syncthreads();
    if (threadIdx.x == 0) {
        unsigned* bar = b.bar;
        __builtin_amdgcn_s_waitcnt(0);
        unsigned nloc = b.st[0], nx = b.st[1];
        if (nloc == 0u) { xcd_barrier_complete(bar, b.x, nloc, nx); b.st[0] = nloc; b.st[1] = nx; }
        const unsigned old = xb_add(&bar[XB_XSUB(b.x)], 1u);
        const unsigned gen = old / nloc;
        if (old + 1u == (gen + 1u) * nloc) {
            __builtin_amdgcn_fence(__ATOMIC_RELEASE, "agent");
            asm volatile("s_waitcnt vmcnt(0)" ::: "memory");
            const unsigned og = xb_add(&bar[XB_TOP], 1u);
            const unsigned tg = og / nx;
            if (og + 1u == (tg + 1u) * nx) xb_add(&bar[XB_TOPGEN], 1u);
            else XB_SPIN(xb_ld(&bar[XB_TOPGEN]) == tg, bar);
            __builtin_amdgcn_fence(__ATOMIC_ACQUIRE, "agent");
            xb_add(&bar[XB_XGEN(b.x)], 1u);
            asm volatile("s_waitcnt vmcnt(0)" ::: "memory");
        } else {
            XB_SPIN(xb_ld(&bar[XB_XGEN(b.x)]) == gen, bar);
            __builtin_amdgcn_fence(__ATOMIC_ACQUIRE, "agent");
            asm volatile("s_waitcnt vmcnt(0)" ::: "memory");
        }
    }
    __syncthreads();
}

struct Args { const float* in[16]; float* out; unsigned char* ws; int ph_lo, ph_hi; unsigned naive; int pad; };
struct Ctx {
    LAS unsigned char* lds;
    const float *x, *c, *ctx, *c_ctx, *norm_w, *ada_w, *ada_b, *w_in, *conv_w, *conv_b, *decay_logit, *gn_w, *w_a, *w_b, *w_out, *final_w;
    float* out; unsigned char* ws;
    float* MOD; f32x2* ROPE;
    bf16_t *WA, *WB, *WOUT, *WIN, *XM, *KV, *KVC, *HC, *ST, *MM, *P, *Q, *K, *V, *SZB, *KC, *VC, *UB, *R, *SGB;
    float* RET; float* S0;
};

DI int win_dest(int o) {
    if (o < 4096) { const int g = o >> 10, ch = o & 1023; return 256 * (ch >> 6) + 64 * g + (ch & 63); }
    if (o < 5120) { const int qk = (o - 4096) >> 9, oo = (o - 4096) & 511, head = oo >> 6, i = oo & 63, t = head >> 2, hh = head & 3;
        return 256 * (16 + 2 * qk + t) + (i < 32 ? 32 * hh + i : 128 + 32 * hh + (i - 32)); }
    if (o < 7168) return o;
    { const int gs = (o - 7168) >> 10, ch = (o - 7168) & 1023; return 256 * (28 + (ch >> 7)) + 128 * gs + (ch & 127); }
}
DI void p0_transpose_item(const float* W, int K, int N, bf16_t* WT, bool permute, LAS float* scr, int item, int lane) {
    const int nblk = N / 32, kb = item / nblk, nb = item % nblk, k0 = 64 * kb, n0 = 32 * nb;
    f32x4 rv[8];
#pragma unroll
    for (int i = 0; i < 8; ++i) rv[i] = *(const f32x4*)(W + (size_t)(k0 + 8 * i + (lane >> 3)) * N + n0 + 4 * (lane & 7));
#pragma unroll
    for (int i = 0; i < 8; ++i) { LAS float* d = scr + (8 * i + (lane >> 3)) * 33 + 4 * (lane & 7); d[0] = rv[i].x; d[1] = rv[i].y; d[2] = rv[i].z; d[3] = rv[i].w; }
    asm volatile("s_waitcnt lgkmcnt(0)" ::: "memory");
    const int c = lane & 7; const int d0 = permute ? win_dest(n0) : n0;
#pragma unroll
    for (int j = 0; j < 4; ++j) { const int n = (lane >> 3) + 8 * j; const LAS float* sp = scr + (8 * c) * 33 + n;
        u32x4 o; o.x = cvt_pk_bf16(sp[0 * 33], sp[1 * 33]); o.y = cvt_pk_bf16(sp[2 * 33], sp[3 * 33]); o.z = cvt_pk_bf16(sp[4 * 33], sp[5 * 33]); o.w = cvt_pk_bf16(sp[6 * 33], sp[7 * 33]);
        *(u32x4*)(WT + (size_t)(d0 + n) * K + k0 + 8 * c) = o; }
    asm volatile("s_waitcnt lgkmcnt(0)" ::: "memory");
}
DI void p0_prologue(const Ctx& F) {
    const Tid T = opaque_tid();
    if (blockIdx.x < 48) {
        LAS float* red = (LAS float*)F.lds;
        LAS float* sl = (LAS float*)(F.lds + 16384);
        for (int e = T.tid; e < 5 * 1024; e += 512) { const int v = e >> 10, k = e & 1023; sl[e] = siluf(v < 4 ? F.c[v * 1024 + k] : F.c_ctx[k]); }
        __syncthreads();
        const int n0 = 64 * blockIdx.x, k0 = 128 * T.wave, r4 = T.lane >> 4, c4 = T.lane & 15;
        f32x4 a[5];
#pragma unroll
        for (int v = 0; v < 5; ++v) a[v] = (f32x4){0.f, 0.f, 0.f, 0.f};
#pragma unroll 1
        for (int ib = 0; ib < 32; ib += 8) {
            f32x4 wv[8];
#pragma unroll
            for (int i = 0; i < 8; ++i) wv[i] = *(const f32x4*)(F.ada_w + (size_t)(k0 + 4 * (ib + i) + r4) * 3072 + n0 + 4 * c4);
#pragma unroll
            for (int i = 0; i < 8; ++i) {
#pragma unroll
                for (int v = 0; v < 5; ++v) a[v] += wv[i] * sl[v * 1024 + k0 + 4 * (ib + i) + r4];
                __builtin_amdgcn_sched_barrier(0); }
        }
#pragma unroll
        for (int v = 0; v < 5; ++v) {
#pragma unroll
            for (int e = 0; e < 4; ++e) { float t = a[v][e]; t += __shfl_xor(t, 16); t += __shfl_xor(t, 32); a[v][e] = t; }
            if (r4 == 0) { LAS float* d = red + (T.wave * 5 + v) * 64 + 4 * c4; d[0] = a[v].x; d[1] = a[v].y; d[2] = a[v].z; d[3] = a[v].w; } }
        __syncthreads();
        if (T.tid < 320) { const int v = T.tid >> 6, l = T.tid & 63; float s = F.ada_b[n0 + l];
#pragma unroll
            for (int w = 0; w < 8; ++w) s += red[(w * 5 + v) * 64 + l];
            F.MOD[v * 3072 + n0 + l] = s; }
        __syncthreads();
    }
    if (blockIdx.x == 48) {
        for (int e = T.tid; e < 1024; e += 512) { const int p = e >> 4, f = e & 15; const float inv = powf(10000.f, -(float)f / 16.f); const float ang = (float)p * inv;
            F.ROPE[e] = (f32x2){cosf(ang), sinf(ang)}; }
    }
    LAS float* scr = (LAS float*)(F.lds + T.wave * 16384);
    const int gw = blockIdx.x * 8 + T.wave, NGW = gridDim.x * 8;
    constexpr int I_IN = 16 * (NIN / 32), I_SQ = 16 * 32;
    for (int it = gw; it < I_IN + 3 * I_SQ; it += NGW) {
        int r = it;
        if (r < I_IN) { p0_transpose_item(F.w_in, 1024, NIN, F.WIN, true, scr, r, T.lane); continue; } r -= I_IN;
        if (r < I_SQ) { p0_transpose_item(F.w_a, 1024, 1024, F.WA, false, scr, r, T.lane); continue; } r -= I_SQ;
        if (r < I_SQ) { p0_transpose_item(F.w_b, 1024, 1024, F.WB, false, scr, r, T.lane); continue; } r -= I_SQ;
        p0_transpose_item(F.w_out, 1024, 1024, F.WOUT, false, scr, r, T.lane);
    }
}
template <int RB> DI void p1_row_group(const Ctx& F, const Tid& T, int m0) {
    f32x4 v[RB][2][2]; float ss[RB];
#pragma unroll
    for (int r = 0; r < RB; ++r) { const int m = m0 + r; const float* xr = m < MTOK ? F.x + (size_t)m * DM : F.ctx + (size_t)(m - MTOK) * DM;
#pragma unroll
        for (int j = 0; j < 2; ++j)
#pragma unroll
            for (int h = 0; h < 2; ++h) v[r][j][h] = ((const f32x4*)xr)[2 * (T.lane + 64 * j) + h]; }
#pragma unroll
    for (int r = 0; r < RB; ++r) { float s = 0.f;
#pragma unroll
        for (int j = 0; j < 2; ++j)
#pragma unroll
            for (int h = 0; h < 2; ++h) { const f32x4 t = v[r][j][h]; s += (t.x * t.x + t.y * t.y) + (t.z * t.z + t.w * t.w); }
        ss[r] = s; }
#pragma unroll
    for (int o = 1; o < 64; o <<= 1)
#pragma unroll
        for (int r = 0; r < RB; ++r) ss[r] += __shfl_xor(ss[r], o);
    const int mb = m0 < MTOK ? (m0 >> 12) : 4; const float* mod = F.MOD + mb * 3072;
#pragma unroll
    for (int j = 0; j < 2; ++j) { const int col = 8 * (T.lane + 64 * j);
        f32x4 w[2], sh[2], sc[2];
#pragma unroll
        for (int h = 0; h < 2; ++h) { w[h] = *(const f32x4*)(F.norm_w + col + 4 * h); sh[h] = *(const f32x4*)(mod + col + 4 * h); sc[h] = *(const f32x4*)(mod + 1024 + col + 4 * h); }
#pragma unroll
        for (int r = 0; r < RB; ++r) { const float rstd = __builtin_amdgcn_rsqf(ss[r] * (1.f / DM) + EPS);
            const f32x4 y0 = (v[r][j][0] * rstd * w[0]) * (sc[0] + 1.0f) + sh[0], y1 = (v[r][j][1] * rstd * w[1]) * (sc[1] + 1.0f) + sh[1];
            u32x4 o; o.x = cvt_pk_bf16(y0.x, y0.y); o.y = cvt_pk_bf16(y0.z, y0.w); o.z = cvt_pk_bf16(y1.x, y1.y); o.w = cvt_pk_bf16(y1.z, y1.w);
            *(u32x4*)(F.XM + (size_t)(m0 + r) * DM + col) = o; } }
}
DI void p1_rows(const Ctx& F) {
    const Tid T = opaque_tid();
    const int gw = blockIdx.x * 8 + T.wave, NGW = gridDim.x * 8;
    for (int m0 = gw * 8; m0 < MTOK; m0 += NGW * 8) p1_row_group<8>(F, T, m0);
    for (int m0 = MTOK + gw; m0 < MALL; m0 += NGW) p1_row_group<1>(F, T, m0);
}
DI size_t gate_block(int pm, int t, int wr, int wc, int ai, int m) { return (size_t)(((((pm * 8 + t) * 8 + (wr * 4 + wc)) * 2 + ai) * 4 + m)) * 512; }
DI size_t gate_index(int row, int col) { const int pm = row >> 8, rr = row & 255, cc = col & 127;
    return gate_block(pm, col >> 7, (rr >> 6) & 1, cc >> 5, rr >> 7, (rr >> 4) & 3) + (size_t)(((cc >> 3) & 3) * 16 + (rr & 15)) * 8 + (cc & 7); }
struct Sched1 {
    int G, c;
    DI bool next(int i, pg8::Unit& u) const { const int L = i * G + c; if (L >= 64 * 36) return false; pg8::tile_of(L, 64, 36, u); return true; }
};
struct SchedCtx {
    int c;
    DI bool next(int i, pg8::Unit& u) const { if (i > 0 || c >= 24) return false; u.pm = 64 + c / 6; u.pn = 18 + c % 6; return true; }
};
struct Epi1 {
    unsigned char* ws; bf16_t *R, *SGB; const f32x2* rope;
    DI int vm_ops(const pg8::Unit& u) const { return u.pn < 16 ? 8 : 16; }
    DI void mid(f32x4 (&)[2][2][4][2], const pg8::Unit&, int, int, int, int) const {}
    DI void operator()(const f32x4 (&acc)[2][2][4][2], const pg8::Unit& u, int wr, int wc, int fr, int fq) const {
        const int pn = u.pn, row0 = u.pm * 256 + wr * 64 + fr, x0 = wc * 32 + 8 * fq;
        const bool isctx = u.pm >= 64;
        if (pn < 16) {
            bf16_t* dst = (bf16_t*)(ws + (wc < 2 ? WS_HC : WS_P)) + 64 * pn + (x0 & 63);
#pragma unroll
            for (int ai = 0; ai < 2; ++ai)
#pragma unroll
                for (int m = 0; m < 4; ++m) { const size_t row = row0 + ai * 128 + m * 16;
                    f32x4 o[2];
#pragma unroll
                    for (int n = 0; n < 2; ++n) { const f32x4 a = acc[ai][0][m][n], b = acc[ai][1][m][n];
                        if (wc < 2) o[n] = a * b;
                        else { o[n].x = a.x * siluf(b.x); o[n].y = a.y * siluf(b.y); o[n].z = a.z * siluf(b.z); o[n].w = a.w * siluf(b.w); } }
                    u32x4 w; w.x = cvt_pk_bf16(o[0].x, o[0].y); w.y = cvt_pk_bf16(o[0].z, o[0].w); w.z = cvt_pk_bf16(o[1].x, o[1].y); w.w = cvt_pk_bf16(o[1].z, o[1].w);
                    *(u32x4*)(dst + row * 1024) = w; }
        } else if (pn < 20) {
            const int t = (pn - 16) & 1, isk = (pn - 16) >> 1, head = 4 * t + wc, i0 = 8 * fq;
            const float scale = isk ? 0.125f : 1.0f;
            bf16_t* base = (bf16_t*)(ws + (isk ? (isctx ? WS_KC : WS_K) : WS_Q));
#pragma unroll
            for (int ai = 0; ai < 2; ++ai)
#pragma unroll
                for (int m = 0; m < 4; ++m) { const int row = row0 + ai * 128 + m * 16; const int orow = isctx ? row - MTOK : row;
                    const int pos = row & 4095, pidx = (fq < 2) ? (pos >> 6) : (pos & 63);
                    const f32x2* rp = rope + pidx * 16 + (fq & 1) * 8;
                    float o1[8], o2[8];
#pragma unroll
                    for (int e = 0; e < 8; ++e) { f32x2 cs = rp[e]; if (isctx) cs = (f32x2){1.f, 0.f};
                        const float t1 = acc[ai][0][m][e >> 2][e & 3], t2 = acc[ai][1][m][e >> 2][e & 3];
                        o1[e] = (t1 * cs.x - t2 * cs.y) * scale; o2[e] = (t1 * cs.y + t2 * cs.x) * scale; }
                    u32x4 w1, w2; w1.x = cvt_pk_bf16(o1[0], o1[1]); w1.y = cvt_pk_bf16(o1[2], o1[3]); w1.z = cvt_pk_bf16(o1[4], o1[5]); w1.w = cvt_pk_bf16(o1[6], o1[7]);
                    w2.x = cvt_pk_bf16(o2[0], o2[1]); w2.y = cvt_pk_bf16(o2[2], o2[3]); w2.z = cvt_pk_bf16(o2[4], o2[5]); w2.w = cvt_pk_bf16(o2[6], o2[7]);
                    bf16_t* d = base + (size_t)orow * 512 + head * 64 + i0;
                    *(u32x4*)d = w1; *(u32x4*)(d + 32) = w2; }
        } else if (pn < 28) {
            const bool isz = pn >= 24;
            bf16_t* base = (bf16_t*)(ws + (isz ? WS_SZB : (isctx ? WS_VC : WS_V)));
            const int colt = 256 * (pn - (isz ? 24 : 20)) + x0;
#pragma unroll
            for (int ai = 0; ai < 2; ++ai)
#pragma unroll
                for (int m = 0; m < 4; ++m) { const int row = row0 + ai * 128 + m * 16; const int orow = isctx ? row - MTOK : row;
#pragma unroll
                    for (int bj = 0; bj < 2; ++bj) { f32x4 a = acc[ai][bj][m][0], b = acc[ai][bj][m][1];
                        u32x4 w; w.x = cvt_pk_bf16(a.x, a.y); w.y = cvt_pk_bf16(a.z, a.w); w.z = cvt_pk_bf16(b.x, b.y); w.w = cvt_pk_bf16(b.z, b.w);
                        if (isz) __builtin_nontemporal_store(w, (u32x4*)(base + (size_t)orow * 1024 + colt + bj * 128)); else *(u32x4*)(base + (size_t)orow * 1024 + colt + bj * 128) = w; } }
        } else {
            const int col = 128 * (pn - 28) + x0;
#pragma unroll
            for (int ai = 0; ai < 2; ++ai)
#pragma unroll
                for (int m = 0; m < 4; ++m) { const size_t row = row0 + ai * 128 + m * 16;
                    float rr[8], sg[8];
#pragma unroll
                    for (int e = 0; e < 8; ++e) { const float ga = acc[ai][0][m][e >> 2][e & 3], gb = acc[ai][1][m][e >> 2][e & 3];
                        const float ea = 1.f + __expf(-ga), eb = 1.f + __expf(-gb); sg[e] = __builtin_amdgcn_rcpf(eb); rr[e] = eb * __builtin_amdgcn_rcpf(ea); }
                    u32x4 w1, w2; w1.x = cvt_pk_bf16(rr[0], rr[1]); w1.y = cvt_pk_bf16(rr[2], rr[3]); w1.z = cvt_pk_bf16(rr[4], rr[5]); w1.w = cvt_pk_bf16(rr[6], rr[7]);
                    w2.x = cvt_pk_bf16(sg[0], sg[1]); w2.y = cvt_pk_bf16(sg[2], sg[3]); w2.z = cvt_pk_bf16(sg[4], sg[5]); w2.w = cvt_pk_bf16(sg[6], sg[7]);
                    const size_t gi = gate_block(u.pm, pn - 28, wr, wc, ai, m) + (size_t)(fq * 16 + fr) * 8;
                    __builtin_nontemporal_store(w1, (u32x4*)(R + gi)); __builtin_nontemporal_store(w2, (u32x4*)(SGB + gi)); }
        }
    }
};
DI void n2_inproj(const Ctx& F) {
    const Tid T = opaque_tid();
    const size_t NT = (size_t)gridDim.x * 512, gt = (size_t)blockIdx.x * 512 + T.tid;
    for (size_t idx = gt; idx < (size_t)(MALL / 4) * 1024; idx += NT) {
        const int ch = (int)(idx & 1023), t0 = (int)(idx >> 10) * 4;
        const bool doqk = ch < 512 && (ch & 63) < 32;
        float a[12][4];
#pragma unroll
        for (int o = 0; o < 12; ++o)
#pragma unroll
            for (int j = 0; j < 4; ++j) a[o][j] = 0.f;
        for (int k = 0; k < 1024; ++k) {
            const float* wr = F.w_in + (size_t)k * NIN;
            float xv[4];
#pragma unroll
            for (int j = 0; j < 4; ++j) xv[j] = bf2f(F.XM[(size_t)(t0 + j) * 1024 + k]);
            float w[12];
            w[0] = wr[ch]; w[1] = wr[1024 + ch]; w[2] = wr[2048 + ch]; w[3] = wr[3072 + ch]; w[4] = wr[5120 + ch]; w[5] = wr[6144 + ch]; w[6] = wr[7168 + ch]; w[7] = wr[8192 + ch];
            if (doqk) { w[8] = wr[4096 + ch]; w[9] = wr[4096 + ch + 32]; w[10] = wr[4608 + ch]; w[11] = wr[4608 + ch + 32]; } else { w[8] = w[9] = w[10] = w[11] = 0.f; }
#pragma unroll
            for (int o = 0; o < 12; ++o)
#pragma unroll
                for (int j = 0; j < 4; ++j) a[o][j] += xv[j] * w[o];
        }
#pragma unroll
        for (int j = 0; j < 4; ++j) { const int t = t0 + j;
            if (t < MTOK) {
                const size_t o = (size_t)t * 1024 + ch;
                F.HC[o] = f2bf(a[2][j] * a[0][j]); F.P[o] = f2bf(siluf(a[3][j]) * a[1][j]); F.V[o] = f2bf(a[4][j]); F.SZB[o] = f2bf(a[5][j]);
                const float sga = 1.f / (1.f + __expf(-a[6][j])), sgb = 1.f / (1.f + __expf(-a[7][j]));
                { const size_t gi = gate_index(t, ch); F.R[gi] = f2bf(sga / sgb); F.SGB[gi] = f2bf(sgb); }
                if (doqk) { const int i = ch & 63, pos = t & 4095; const int pidx = i < 16 ? (pos >> 6) : (pos & 63); const f32x2 cs = F.ROPE[pidx * 16 + (i & 15)];
                    const size_t q = (size_t)t * 512 + ch;
                    F.Q[q] = f2bf(a[8][j] * cs.x - a[9][j] * cs.y); F.Q[q + 32] = f2bf(a[8][j] * cs.y + a[9][j] * cs.x);
                    F.K[q] = f2bf((a[10][j] * cs.x - a[11][j] * cs.y) * 0.125f); F.K[q + 32] = f2bf((a[10][j] * cs.y + a[11][j] * cs.x) * 0.125f); }
            } else {
                const int tc = t - MTOK;
                F.VC[(size_t)tc * 1024 + ch] = f2bf(a[4][j]);
                if (doqk) { F.KC[(size_t)tc * 512 + ch] = f2bf(a[10][j] * 0.125f); F.KC[(size_t)tc * 512 + ch + 32] = f2bf(a[11][j] * 0.125f); }
            }
        }
    }
}
DI bf16x8 tr2(const LAS unsigned char* p, int delta) {
    const s16x4 lo = __builtin_bit_cast(s16x4, __builtin_amdgcn_ds_read_tr16_b64_v4i16((LAS v4i16_t*)p));
    const s16x4 hi = __builtin_bit_cast(s16x4, __builtin_amdgcn_ds_read_tr16_b64_v4i16((LAS v4i16_t*)(p + delta)));
    return __builtin_shufflevector(lo, hi, 0, 1, 2, 3, 4, 5, 6, 7);
}
DI u32x4 scale8(u32x4 w, float s) {
    u32x4 o; o.x = cvt_pk_bf16(bflo(w.x) * s, bfhi(w.x) * s); o.y = cvt_pk_bf16(bflo(w.y) * s, bfhi(w.y) * s); o.z = cvt_pk_bf16(bflo(w.z) * s, bfhi(w.z) * s); o.w = cvt_pk_bf16(bflo(w.w) * s, bfhi(w.w) * s); return o;
}
DI void p3_kv(const Ctx& F, int it0, int it1, int stride) {
    const Tid T = opaque_tid();
    LAS unsigned char* KFI = F.lds; LAS unsigned char* KBI = F.lds + 20480; LAS unsigned char* VI = F.lds + 40960;
    const int tid = T.tid, lane = T.lane, w = T.wave, g = lane >> 4, q = (lane & 15) >> 2, p = lane & 3;
    const int row = tid >> 2, seg = tid & 3;
    u32x4 pk[2], pv[4];
    auto prefetch = [&](int it) { const int bh = it >> 5, c = it & 31; const size_t tok0 = (size_t)(bh >> 3) * SEQ + c * CHK;
        const bf16_t* kp = F.K + tok0 * 512 + (bh & 7) * 64; const bf16_t* vp = F.V + tok0 * 1024 + (bh & 7) * 128;
        pk[0] = *(const u32x4*)(kp + (size_t)row * 512 + seg * 16); pk[1] = *(const u32x4*)(kp + (size_t)row * 512 + seg * 16 + 8);
#pragma unroll
        for (int i = 0; i < 4; ++i) pv[i] = *(const u32x4*)(vp + (size_t)row * 1024 + seg * 32 + 8 * i); };
    if (it0 < it1) prefetch(it0);
    for (int it = it0; it < it1; it += stride) {
        const int bh = it >> 5, c = it & 31;
        const float l2f = log2_gamma(F.decay_logit, 0, bh & 7), l2b = log2_gamma(F.decay_logit, 1, bh & 7);
        { const float df = __builtin_amdgcn_exp2f(l2f * (float)(127 - row)), db = __builtin_amdgcn_exp2f(l2b * (float)row);
            *(LAS u32x4*)(KFI + row * 160 + seg * 32) = scale8(pk[0], df); *(LAS u32x4*)(KFI + row * 160 + seg * 32 + 16) = scale8(pk[1], df);
            *(LAS u32x4*)(KBI + row * 160 + seg * 32) = scale8(pk[0], db); *(LAS u32x4*)(KBI + row * 160 + seg * 32 + 16) = scale8(pk[1], db);
#pragma unroll
            for (int i = 0; i < 4; ++i) *(LAS u32x4*)(VI + row * 288 + seg * 64 + 16 * i) = pv[i]; }
        __syncthreads();
        if (it + stride < it1) prefetch(it + stride);
        f32x4 acc[2][4];
#pragma unroll
        for (int d = 0; d < 2; ++d)
#pragma unroll
            for (int nb = 0; nb < 4; ++nb) acc[d][nb] = (f32x4){0.f, 0.f, 0.f, 0.f};
#pragma unroll
        for (int s2 = 0; s2 < 4; ++s2) {
            const bf16x8 vb = tr2(VI + (32 * s2 + 8 * g + q) * 288 + (16 * w + 4 * p) * 2, 4 * 288);
#pragma unroll
            for (int nb = 0; nb < 4; ++nb) {
                const bf16x8 kf = tr2(KFI + (32 * s2 + 8 * g + q) * 160 + (16 * nb + 4 * p) * 2, 4 * 160);
                const bf16x8 kb = tr2(KBI + (32 * s2 + 8 * g + q) * 160 + (16 * nb + 4 * p) * 2, 4 * 160);
                acc[0][nb] = __builtin_amdgcn_mfma_f32_16x16x32_bf16(kf, vb, acc[0][nb], 0, 0, 0);
                acc[1][nb] = __builtin_amdgcn_mfma_f32_16x16x32_bf16(kb, vb, acc[1][nb], 0, 0, 0);
            }
        }
        bf16_t* of = F.KV + ((size_t)(0 * 32 + bh) * 32 + c) * 8192; bf16_t* ob = F.KV + ((size_t)(1 * 32 + bh) * 32 + c) * 8192;
#pragma unroll
        for (int nb = 0; nb < 4; ++nb) { const int o = ((w * 4 + nb) * 64 + lane) * 4;
            u32x2 a, b; a.x = cvt_pk_bf16(acc[0][nb].x, acc[0][nb].y); a.y = cvt_pk_bf16(acc[0][nb].z, acc[0][nb].w); b.x = cvt_pk_bf16(acc[1][nb].x, acc[1][nb].y); b.y = cvt_pk_bf16(acc[1][nb].z, acc[1][nb].w);
            *(u32x2*)(of + o) = a; *(u32x2*)(ob + o) = b; }
        __syncthreads();
    }
}
DI void p4_ctx_state(const Ctx& F, int bh) {
    const Tid T = opaque_tid();
    LAS unsigned char* KFI = F.lds; LAS unsigned char* KBI = F.lds + 20480; LAS unsigned char* VI = F.lds + 40960;
    const int tid = T.tid, lane = T.lane, w = T.wave, g = lane >> 4, q = (lane & 15) >> 2, p = lane & 3;
    const int row = tid >> 2, seg = tid & 3;
    const float l2f = log2_gamma(F.decay_logit, 0, bh & 7), l2b = log2_gamma(F.decay_logit, 1, bh & 7);
    f32x4 acc[2][4];
#pragma unroll
    for (int d = 0; d < 2; ++d)
#pragma unroll
        for (int nb = 0; nb < 4; ++nb) acc[d][nb] = (f32x4){0.f, 0.f, 0.f, 0.f};
    for (int cc = 0; cc < 2; ++cc) {
        const size_t tok0 = (size_t)(bh >> 3) * CTXL + cc * CHK; const int m = cc * CHK + row;
        const bf16_t* kp = F.KC + tok0 * 512 + (bh & 7) * 64; const bf16_t* vp = F.VC + tok0 * 1024 + (bh & 7) * 128;
        const u32x4 k0 = *(const u32x4*)(kp + (size_t)row * 512 + seg * 16), k1 = *(const u32x4*)(kp + (size_t)row * 512 + seg * 16 + 8);
        const float df = __builtin_amdgcn_exp2f(l2f * (float)(255 - m)), db = __builtin_amdgcn_exp2f(l2b * (float)m);
        *(LAS u32x4*)(KFI + row * 160 + seg * 32) = scale8(k0, df); *(LAS u32x4*)(KFI + row * 160 + seg * 32 + 16) = scale8(k1, df);
        *(LAS u32x4*)(KBI + row * 160 + seg * 32) = scale8(k0, db); *(LAS u32x4*)(KBI + row * 160 + seg * 32 + 16) = scale8(k1, db);
#pragma unroll
        for (int i = 0; i < 4; ++i) *(LAS u32x4*)(VI + row * 288 + seg * 64 + 16 * i) = *(const u32x4*)(vp + (size_t)row * 1024 + seg * 32 + 8 * i);
        __syncthreads();
#pragma unroll
        for (int s2 = 0; s2 < 4; ++s2) {
            const bf16x8 vb = tr2(VI + (32 * s2 + 8 * g + q) * 288 + (16 * w + 4 * p) * 2, 4 * 288);
#pragma unroll
            for (int nb = 0; nb < 4; ++nb) {
                const bf16x8 kf = tr2(KFI + (32 * s2 + 8 * g + q) * 160 + (16 * nb + 4 * p) * 2, 4 * 160);
                const bf16x8 kb = tr2(KBI + (32 * s2 + 8 * g + q) * 160 + (16 * nb + 4 * p) * 2, 4 * 160);
                acc[0][nb] = __builtin_amdgcn_mfma_f32_16x16x32_bf16(kf, vb, acc[0][nb], 0, 0, 0);
                acc[1][nb] = __builtin_amdgcn_mfma_f32_16x16x32_bf16(kb, vb, acc[1][nb], 0, 0, 0);
            }
        }
        __syncthreads();
    }
    float* of = F.S0 + (size_t)(0 * 32 + bh) * 8192; float* ob = F.S0 + (size_t)(1 * 32 + bh) * 8192;
#pragma unroll
    for (int nb = 0; nb < 4; ++nb) { const int o = ((w * 4 + nb) * 64 + lane) * 4; *(f32x4*)(of + o) = acc[0][nb]; *(f32x4*)(ob + o) = acc[1][nb]; }
}
DI void p3_ua(const Ctx& F, int blk, int nblk) {
    const Tid T = opaque_tid();
    const size_t NT = (size_t)nblk * 512, gt = (size_t)blk * 512 + T.tid;
    for (size_t idx = gt; idx < (size_t)MTOK * 128; idx += NT) {
        const int t = (int)(idx >> 7), c8 = (int)(idx & 127) * 8, pos = t & 4095;
        const bf16_t* hp = F.HC + (size_t)t * 1024 + c8;
        const u32x4 z = (u32x4){0u, 0u, 0u, 0u};
        const u32x4 h0 = pos > 0 ? *(const u32x4*)(hp - 1024) : z, h1 = *(const u32x4*)hp, h2 = pos < SEQ - 1 ? *(const u32x4*)(hp + 1024) : z;
        const u32x4 pv = *(const u32x4*)(F.P + (size_t)t * 1024 + c8);
        float o[8];
#pragma unroll
        for (int e = 0; e < 8; ++e) { const unsigned a = h0[e >> 1], b = h1[e >> 1], c = h2[e >> 1], pp = pv[e >> 1];
            const float x0 = (e & 1) ? bfhi(a) : bflo(a), x1 = (e & 1) ? bfhi(b) : bflo(b), x2 = (e & 1) ? bfhi(c) : bflo(c), pf = (e & 1) ? bfhi(pp) : bflo(pp);
            const float cv = F.conv_w[c8 + e] * x0 + F.conv_w[1024 + c8 + e] * x1 + F.conv_w[2048 + c8 + e] * x2 + F.conv_b[c8 + e];
            o[e] = pf * cv; }
        u32x4 w; w.x = cvt_pk_bf16(o[0], o[1]); w.y = cvt_pk_bf16(o[2], o[3]); w.z = cvt_pk_bf16(o[4], o[5]); w.w = cvt_pk_bf16(o[6], o[7]);
        *(u32x4*)(F.P + (size_t)t * 1024 + c8) = w;
    }
}
DI void p4_scan(const Ctx& F, int blk, int nblk) {
    const Tid T = opaque_tid();
    const size_t NT = (size_t)nblk * 512, gt = (size_t)blk * 512 + T.tid;
    for (size_t idx = gt; idx < (size_t)2 * 32 * 2048; idx += NT) {
        const int e4 = (int)(idx & 2047), bh = (int)(idx >> 11) & 31, dir = (int)(idx >> 16);
        const float g = exp2f(log2_gamma(F.decay_logit, dir, bh & 7) * 128.f);
        const u32x2* kv = (const u32x2*)(F.KV + ((size_t)(dir * 32 + bh) * 32) * 8192) + e4;
        u32x2* st = (u32x2*)(F.ST + ((size_t)(dir * 32 + bh) * 32) * 8192) + e4;
        float s0 = 0.f, s1 = 0.f, s2 = 0.f, s3 = 0.f;
        u32x2 v[32];
#pragma unroll
        for (int i = 0; i < 32; ++i) v[i] = kv[(size_t)(dir == 0 ? i : 31 - i) * 2048];
#pragma unroll
        for (int i = 0; i < 32; ++i) { const int c = dir == 0 ? i : 31 - i;
            u32x2 o; o.x = cvt_pk_bf16(s0, s1); o.y = cvt_pk_bf16(s2, s3); st[(size_t)c * 2048] = o;
            s0 = g * s0 + bflo(v[i].x); s1 = g * s1 + bfhi(v[i].x); s2 = g * s2 + bflo(v[i].y); s3 = g * s3 + bfhi(v[i].y); }
    }
}
DI void n4_recurrence(const Ctx& F) {
    const Tid T = opaque_tid();
    const int gw = blockIdx.x * 8 + T.wave, NGW = gridDim.x * 8, d = T.lane;
    for (int task = gw; task < 32 * 128; task += NGW) {
        const int bh = task >> 7, v = task & 127, b = bh >> 3, h = bh & 7;
        const float gf = exp2f(log2_gamma(F.decay_logit, 0, h)), gb = exp2f(log2_gamma(F.decay_logit, 1, h));
        float s = 0.f;
        for (int m = 0; m < CTXL; ++m) { const size_t t = (size_t)b * CTXL + m; s = gf * s + bf2f(F.KC[t * 512 + h * 64 + d]) * bf2f(F.VC[t * 1024 + h * 128 + v]); }
        const float sF = s; s = 0.f;
        for (int m = CTXL - 1; m >= 0; --m) { const size_t t = (size_t)b * CTXL + m; s = gb * s + bf2f(F.KC[t * 512 + h * 64 + d]) * bf2f(F.VC[t * 1024 + h * 128 + v]); }
        const float sB = s;
        s = sF;
        for (int n = 0; n < SEQ; ++n) { const size_t t = (size_t)b * SEQ + n; s = gf * s + bf2f(F.K[t * 512 + h * 64 + d]) * bf2f(F.V[t * 1024 + h * 128 + v]);
            const float o = wave_sum(bf2f(F.Q[t * 512 + h * 64 + d]) * s); if (d == 0) F.RET[t * 1024 + h * 128 + v] = o; }
        s = sB;
        for (int n = SEQ - 1; n >= 0; --n) { const size_t t = (size_t)b * SEQ + n; s = gb * s + bf2f(F.K[t * 512 + h * 64 + d]) * bf2f(F.V[t * 1024 + h * 128 + v]);
            const float o = wave_sum(bf2f(F.Q[t * 512 + h * 64 + d]) * s); if (d == 0) F.RET[t * 1024 + h * 128 + v] += o; }
    }
}
DI void n5_groupnorm(const Ctx& F) {
    const Tid T = opaque_tid();
    const int gw = blockIdx.x * 8 + T.wave, NGW = gridDim.x * 8;
    for (int task = gw; task < MTOK * NH; task += NGW) {
        const int t = task >> 3, h = task & 7; const size_t o = (size_t)t * 1024 + h * 128 + 2 * T.lane;
        const float a = F.RET[o], b = F.RET[o + 1];
        const float mu = wave_sum(a + b) * (1.f / 128.f); const float da = a - mu, db = b - mu;
        const float var = wave_sum(da * da + db * db) * (1.f / 128.f); const float rstd = 1.0f / sqrtf(var + EPS);
        const float ra = da * rstd * F.gn_w[h * 128 + 2 * T.lane], rb = db * rstd * F.gn_w[h * 128 + 2 * T.lane + 1];
        *(unsigned*)(F.UB + o) = cvt_pk_bf16(siluf(bf2f(F.SZB[o])) * ra, siluf(bf2f(F.SZB[o + 1])) * rb);
    }
}
DI void p5_ret(const Ctx& F) {
    const Tid T = opaque_tid();
    LAS unsigned char* KI = F.lds; LAS unsigned char* VI = F.lds + 20480; LAS unsigned char* SF = F.lds + 57344; LAS unsigned char* SB = F.lds + 75776;
    LAS unsigned char* S0F = F.lds + 94208; LAS unsigned char* S0B = F.lds + 110592;
    const int tid = T.tid, lane = T.lane, w = T.wave, g = lane >> 4, q = (lane & 15) >> 2, p = lane & 3, l15 = lane & 15;
    const int row = tid >> 2, seg = tid & 3, il = 16 * w + l15;
    for (int base = blockIdx.x * 4; base < 1024; base += gridDim.x * 4) {
        const int bh = base >> 5, h = bh & 7;
        const float l2f = log2_gamma(F.decay_logit, 0, h), l2b = log2_gamma(F.decay_logit, 1, h);
        { const float* s0f = F.S0 + (size_t)(0 * 32 + bh) * 8192 + row * 64 + seg * 16; const float* s0b = F.S0 + (size_t)(1 * 32 + bh) * 8192 + row * 64 + seg * 16;
#pragma unroll
            for (int i = 0; i < 2; ++i) { const f32x4 a0 = *(const f32x4*)(s0f + 8 * i), a1 = *(const f32x4*)(s0f + 8 * i + 4), b0 = *(const f32x4*)(s0b + 8 * i), b1 = *(const f32x4*)(s0b + 8 * i + 4);
                u32x4 x, y; x.x = cvt_pk_bf16(a0.x, a0.y); x.y = cvt_pk_bf16(a0.z, a0.w); x.z = cvt_pk_bf16(a1.x, a1.y); x.w = cvt_pk_bf16(a1.z, a1.w);
                y.x = cvt_pk_bf16(b0.x, b0.y); y.y = cvt_pk_bf16(b0.z, b0.w); y.z = cvt_pk_bf16(b1.x, b1.y); y.w = cvt_pk_bf16(b1.z, b1.w);
                *(LAS u32x4*)(S0F + row * 128 + seg * 32 + 16 * i) = x; *(LAS u32x4*)(S0B + row * 128 + seg * 32 + 16 * i) = y; } }
        u32x4 pk[2], pv[4], pf0[2], pb0[2]; bf16x8 pq[2];
        auto prefetch = [&](int it) { const int c = it & 31; const size_t tok0 = (size_t)(bh >> 3) * SEQ + c * CHK;
            const bf16_t* kp = F.K + tok0 * 512 + h * 64; const bf16_t* vp = F.V + tok0 * 1024 + h * 128; const bf16_t* qp = F.Q + tok0 * 512 + h * 64;
            const bf16_t* stf = F.ST + ((size_t)(0 * 32 + bh) * 32 + c) * 8192; const bf16_t* stb = F.ST + ((size_t)(1 * 32 + bh) * 32 + c) * 8192;
#pragma unroll
            for (int i = 0; i < 2; ++i) { pk[i] = *(const u32x4*)(kp + (size_t)row * 512 + seg * 16 + 8 * i); pf0[i] = *(const u32x4*)(stf + row * 64 + seg * 16 + 8 * i); pb0[i] = *(const u32x4*)(stb + row * 64 + seg * 16 + 8 * i);
                pq[i] = *(const bf16x8*)(qp + (size_t)il * 512 + 32 * i + 8 * g); }
#pragma unroll
            for (int i = 0; i < 4; ++i) pv[i] = *(const u32x4*)(vp + (size_t)row * 1024 + seg * 32 + 8 * i); };
        prefetch(base);
        for (int k = 0; k < 4; ++k) {
            const int it = base + k, c = it & 31; const size_t tok0 = (size_t)(bh >> 3) * SEQ + c * CHK;
            { const float cf = __builtin_amdgcn_exp2f(l2f * 128.f * (float)c), cb = __builtin_amdgcn_exp2f(l2b * 128.f * (float)(31 - c));
#pragma unroll
                for (int i = 0; i < 2; ++i) { *(LAS u32x4*)(KI + row * 160 + seg * 32 + 16 * i) = pk[i];
                    const u32x4 x = *(const LAS u32x4*)(S0F + row * 128 + seg * 32 + 16 * i), y = *(const LAS u32x4*)(S0B + row * 128 + seg * 32 + 16 * i);
                    u32x4 of, ob;
#pragma unroll
                    for (int e = 0; e < 4; ++e) { of[e] = cvt_pk_bf16(bflo(pf0[i][e]) + cf * bflo(x[e]), bfhi(pf0[i][e]) + cf * bfhi(x[e])); ob[e] = cvt_pk_bf16(bflo(pb0[i][e]) + cb * bflo(y[e]), bfhi(pb0[i][e]) + cb * bfhi(y[e])); }
#pragma unroll
                    for (int jj = 0; jj < 2; ++jj) { const int vv = 16 * (tid >> 6) + 4 * (tid & 3) + 2 * i + jj, dd = 16 * ((tid >> 4) & 3) + 4 * ((tid & 15) >> 2);
                        *(LAS u32x2*)(SF + vv * 144 + dd * 2) = (u32x2){of[2 * jj], of[2 * jj + 1]}; *(LAS u32x2*)(SB + vv * 144 + dd * 2) = (u32x2){ob[2 * jj], ob[2 * jj + 1]}; } }
#pragma unroll
                for (int i = 0; i < 4; ++i) *(LAS u32x4*)(VI + row * 288 + seg * 64 + 16 * i) = pv[i]; }
            bf16x8 qf[2]; qf[0] = pq[0]; qf[1] = pq[1];
            __syncthreads();
            if (k < 3) prefetch(it + 1);
            f32x4 accS[8];
#pragma unroll
            for (int jb = 0; jb < 8; ++jb) { accS[jb] = (f32x4){0.f, 0.f, 0.f, 0.f};
#pragma unroll
                for (int ks = 0; ks < 2; ++ks) { const bf16x8 kf = *(const LAS bf16x8*)(KI + (16 * jb + l15) * 160 + (32 * ks + 8 * g) * 2);
                    accS[jb] = __builtin_amdgcn_mfma_f32_16x16x32_bf16(kf, qf[ks], accS[jb], 0, 0, 0); } }
            bf16x8 pf[4];
#pragma unroll
            for (int s2 = 0; s2 < 4; ++s2) { float pe[8];
#pragma unroll
                for (int e = 0; e < 8; ++e) { const int jb = 2 * s2 + (e >> 2), r = e & 3, j = 16 * jb + 4 * g + r, df = il - j;
                    float mk = __builtin_amdgcn_exp2f((df >= 0 ? l2f : -l2b) * (float)df); if (df == 0) mk = 2.f;
                    pe[e] = accS[jb][r] * mk; }
                u32x4 pw; pw.x = cvt_pk_bf16(pe[0], pe[1]); pw.y = cvt_pk_bf16(pe[2], pe[3]); pw.z = cvt_pk_bf16(pe[4], pe[5]); pw.w = cvt_pk_bf16(pe[6], pe[7]);
                pf[s2] = __builtin_bit_cast(bf16x8, pw); }
            const float decf = __builtin_amdgcn_exp2f(l2f * (float)(il + 1)), decb = __builtin_amdgcn_exp2f(l2b * (float)(128 - il));
            f32x4 accO[8];
#pragma unroll
            for (int vb = 0; vb < 8; ++vb) { f32x4 o = (f32x4){0.f, 0.f, 0.f, 0.f};
#pragma unroll
                for (int s2 = 0; s2 < 4; ++s2) { const bf16x8 vf = tr2(VI + (32 * s2 + 4 * g + q) * 288 + (16 * vb + 4 * p) * 2, 16 * 288);
                    o = __builtin_amdgcn_mfma_f32_16x16x32_bf16(vf, pf[s2], o, 0, 0, 0); }
                f32x4 tf = (f32x4){0.f, 0.f, 0.f, 0.f}, tb = (f32x4){0.f, 0.f, 0.f, 0.f};
#pragma unroll
                for (int ks = 0; ks < 2; ++ks) { const bf16x8 sf = *(const LAS bf16x8*)(SF + (16 * vb + l15) * 144 + (32 * ks + 8 * g) * 2);
                    const bf16x8 sb = *(const LAS bf16x8*)(SB + (16 * vb + l15) * 144 + (32 * ks + 8 * g) * 2);
                    tf = __builtin_amdgcn_mfma_f32_16x16x32_bf16(sf, qf[ks], tf, 0, 0, 0); tb = __builtin_amdgcn_mfma_f32_16x16x32_bf16(sb, qf[ks], tb, 0, 0, 0); }
                accO[vb] = o + tf * decf + tb * decb; __builtin_amdgcn_sched_barrier(0); }
            float sm = 0.f;
#pragma unroll
            for (int vb = 0; vb < 8; ++vb) sm += (accO[vb].x + accO[vb].y) + (accO[vb].z + accO[vb].w);
            sm += __shfl_xor(sm, 16); sm += __shfl_xor(sm, 32);
            const float mu = sm * (1.f / 128.f); float sq = 0.f;
#pragma unroll
            for (int vb = 0; vb < 8; ++vb) { accO[vb] = accO[vb] - mu; sq += (accO[vb].x * accO[vb].x + accO[vb].y * accO[vb].y) + (accO[vb].z * accO[vb].z + accO[vb].w * accO[vb].w); }
            sq += __shfl_xor(sq, 16); sq += __shfl_xor(sq, 32);
            const float rstd = 1.0f / sqrtf(sq * (1.f / 128.f) + EPS);
            __syncthreads();
#pragma unroll
            for (int vb = 0; vb < 8; ++vb) { const f32x4 gw = *(const f32x4*)(F.gn_w + h * 128 + 16 * vb + 4 * g); const f32x4 o = accO[vb] * rstd * gw;
                u32x2 ow; ow.x = cvt_pk_bf16(o.x, o.y); ow.y = cvt_pk_bf16(o.z, o.w);
                *(LAS u32x2*)(VI + il * 288 + (16 * vb + 4 * g) * 2) = ow; }
            __syncthreads();
            { const size_t go = (tok0 + row) * 1024 + h * 128 + seg * 32;
#pragma unroll
                for (int i = 0; i < 4; ++i) { const u32x4 o = *(const LAS u32x4*)(VI + row * 288 + seg * 64 + 16 * i); const u32x4 z = *(const u32x4*)(F.SZB + go + 8 * i);
                    u32x4 r;
#pragma unroll
                    for (int e = 0; e < 4; ++e) r[e] = cvt_pk_bf16(bflo(o[e]) * siluf(bflo(z[e])), bfhi(o[e]) * siluf(bfhi(z[e])));
                    *(u32x4*)(F.UB + go + 8 * i) = r; } }
            __syncthreads();
        }
    }
}
struct SchedSq { int G, c; DI bool next(int i, pg8::Unit& u) const { const int L = i * G + c; if (L >= 256) return false; pg8::tile_of(L, 64, 4, u); return true; } };
struct EpiAB {
    const bf16_t* R; const bf16_t* SGB; bf16_t* MM;
    DI int vm_ops(const pg8::Unit&) const { return 0; }
    DI void mid(f32x4 (&acc)[2][2][4][2], const pg8::Unit& u, int wr, int wc, int fr, int fq) const { apply<false>(acc, u, wr, wc, fr, fq); }
    DI void operator()(const f32x4 (&acc)[2][2][4][2], const pg8::Unit& u, int wr, int wc, int fr, int fq) const { apply<true>(const_cast<f32x4 (&)[2][2][4][2]>(acc), u, wr, wc, fr, fq); }
    template <bool FIN> DI void apply(f32x4 (&acc)[2][2][4][2], const pg8::Unit& u, int wr, int wc, int fr, int fq) const {
        const bf16_t* src = FIN ? SGB : R;
        const size_t base = (size_t)(u.pm * 256 + wr * 64 + fr) * 1024 + u.pn * 256 + wc * 32 + 8 * fq;
#pragma unroll
        for (int am = 0; am < 4; ++am) { const int ai = am >> 1;
            u32x4 gv[4][2];
#pragma unroll
            for (int m = 2 * (am & 1); m < 2 * (am & 1) + 2; ++m)
#pragma unroll
                for (int bj = 0; bj < 2; ++bj) gv[m][bj] = *(const u32x4*)(src + gate_block(u.pm, 2 * u.pn + bj, wr, wc, ai, m) + (size_t)(fq * 16 + fr) * 8);
#pragma unroll
            for (int m = 2 * (am & 1); m < 2 * (am & 1) + 2; ++m)
#pragma unroll
                for (int bj = 0; bj < 2; ++bj) { const u32x4 gq = gv[m][bj];
                    f32x4 a = acc[ai][bj][m][0], b = acc[ai][bj][m][1];
                    a.x *= bflo(gq.x); a.y *= bfhi(gq.x); a.z *= bflo(gq.y); a.w *= bfhi(gq.y); b.x *= bflo(gq.z); b.y *= bfhi(gq.z); b.z *= bflo(gq.w); b.w *= bfhi(gq.w);
                    if (FIN) { u32x4 w; w.x = cvt_pk_bf16(a.x, a.y); w.y = cvt_pk_bf16(a.z, a.w); w.z = cvt_pk_bf16(b.x, b.y); w.w = cvt_pk_bf16(b.z, b.w);
                        *(u32x4*)(MM + base + (size_t)(ai * 128 + m * 16) * 1024 + bj * 128) = w; }
                    else { acc[ai][bj][m][0] = a; acc[ai][bj][m][1] = b; } }
            asm volatile("" ::: "memory");
        }
    }
};
struct EpiOut {
    const float* x; const float* MOD; float* out;
    DI int vm_ops(const pg8::Unit&) const { return 0; }
    DI void mid(f32x4 (&)[2][2][4][2], const pg8::Unit&, int, int, int, int) const {}
    DI void operator()(const f32x4 (&acc)[2][2][4][2], const pg8::Unit& u, int wr, int wc, int fr, int fq) const {
        const int col0 = u.pn * 256 + wc * 32 + 8 * fq; const float* gp = MOD + (u.pm >> 4) * 3072 + 2048 + col0;
        f32x4 gx[2][2];
#pragma unroll
        for (int bj = 0; bj < 2; ++bj)
#pragma unroll
            for (int n = 0; n < 2; ++n) gx[bj][n] = *(const f32x4*)(gp + bj * 128 + 4 * n);
#pragma unroll
        for (int ai = 0; ai < 2; ++ai)
#pragma unroll
            for (int m = 0; m < 4; ++m) { const size_t off = (size_t)(u.pm * 256 + ai * 128 + wr * 64 + m * 16 + fr) * 1024 + col0;
#pragma unroll
                for (int bj = 0; bj < 2; ++bj)
#pragma unroll
                    for (int n = 0; n < 2; ++n) { const f32x4 xv = *(const f32x4*)(x + off + bj * 128 + 4 * n); *(f32x4*)(out + off + bj * 128 + 4 * n) = xv + gx[bj][n] * acc[ai][bj][m][n]; }
                if (m & 1) asm volatile("" ::: "memory"); }
    }
};
struct EpiOutNorm {
    const float* x; const float* MOD; float* out; const float* fw; float* slots; unsigned* cnt; LAS float* tab;
    DI int vm_ops(const pg8::Unit&) const { return 0; }
    DI void mid(f32x4 (&)[2][2][4][2], const pg8::Unit&, int, int, int, int) const {}
    DI void operator()(const f32x4 (&acc_)[2][2][4][2], const pg8::Unit& u, int wr, int wc, int fr, int fq) const {
        f32x4 (&acc)[2][2][4][2] = const_cast<f32x4 (&)[2][2][4][2]>(acc_);
        const int col0 = u.pn * 256 + wc * 32 + 8 * fq; const float* gp = MOD + (u.pm >> 4) * 3072 + 2048 + col0;
        f32x4 gx[2][2];
#pragma unroll
        for (int bj = 0; bj < 2; ++bj)
#pragma unroll
            for (int n = 0; n < 2; ++n) gx[bj][n] = *(const f32x4*)(gp + bj * 128 + 4 * n);
#pragma unroll
        for (int ai = 0; ai < 2; ++ai)
#pragma unroll
            for (int m = 0; m < 4; ++m) { const int row = u.pm * 256 + ai * 128 + wr * 64 + m * 16 + fr; const size_t off = (size_t)row * 1024 + col0; float ss = 0.f;
#pragma unroll
                for (int bj = 0; bj < 2; ++bj)
#pragma unroll
                    for (int n = 0; n < 2; ++n) { const f32x4 xv = *(const f32x4*)(x + off + bj * 128 + 4 * n); const f32x4 v = xv + gx[bj][n] * acc[ai][bj][m][n]; acc[ai][bj][m][n] = v;
                        ss += (v.x * v.x + v.y * v.y) + (v.z * v.z + v.w * v.w); }
                ss += __shfl_xor(ss, 16); ss += __shfl_xor(ss, 32);
                if (fq == 0) __hip_atomic_store(slots + (size_t)row * 16 + u.pn * 4 + wc, ss, __ATOMIC_RELAXED, __HIP_MEMORY_SCOPE_AGENT);
                if (m & 1) asm volatile("" ::: "memory"); }
        asm volatile("s_waitcnt vmcnt(0)" ::: "memory");
        __syncthreads();
        if (threadIdx.x == 0) {
            unsigned* c = cnt + 64 * u.pm;
            __hip_atomic_fetch_add(c, 1u, __ATOMIC_RELAXED, __HIP_MEMORY_SCOPE_AGENT);
            unsigned sp = 0;
            while (__hip_atomic_load(c, __ATOMIC_RELAXED, __HIP_MEMORY_SCOPE_AGENT) < 4u) { __builtin_amdgcn_s_sleep(1); if (++sp > (1u << 22)) break; }
            __builtin_amdgcn_fence(__ATOMIC_ACQUIRE, "agent");
            asm volatile("s_waitcnt vmcnt(0)" ::: "memory");
        }
        __syncthreads();
        { const int t = threadIdx.x, row = t >> 1, half = t & 1; const float* sp = slots + (size_t)(u.pm * 256 + row) * 16 + half * 8; float s = 0.f;
#pragma unroll
            for (int j = 0; j < 8; ++j) s += __hip_atomic_load(sp + j, __ATOMIC_RELAXED, __HIP_MEMORY_SCOPE_AGENT);
            s += __shfl_xor(s, 1);
            if (half == 0) tab[row] = 1.0f / sqrtf(s * (1.f / 1024.f) + EPS); }
        __syncthreads();
        f32x4 fv[2][2];
#pragma unroll
        for (int bj = 0; bj < 2; ++bj)
#pragma unroll
            for (int n = 0; n < 2; ++n) fv[bj][n] = *(const f32x4*)(fw + col0 + bj * 128 + 4 * n);
#pragma unroll
        for (int ai = 0; ai < 2; ++ai)
#pragma unroll
            for (int m = 0; m < 4; ++m) { const int rl = ai * 128 + wr * 64 + m * 16 + fr; const float r = tab[rl]; const size_t off = (size_t)(u.pm * 256 + rl) * 1024 + col0;
#pragma unroll
                for (int bj = 0; bj < 2; ++bj)
#pragma unroll
                    for (int n = 0; n < 2; ++n) *(f32x4*)(out + off + bj * 128 + 4 * n) = acc[ai][bj][m][n] * r * fv[bj][n]; }
    }
};
DI void n6_ab(const Ctx& F) {
    const Tid T = opaque_tid();
    const size_t NT = (size_t)gridDim.x * 512, gt = (size_t)blockIdx.x * 512 + T.tid;
    for (size_t idx = gt; idx < (size_t)(MTOK / 4) * 1024; idx += NT) {
        const int n = (int)(idx & 1023), t0 = (int)(idx >> 10) * 4; float ya[4] = {0.f, 0.f, 0.f, 0.f}, yb[4] = {0.f, 0.f, 0.f, 0.f};
        for (int k = 0; k < 1024; ++k) { const float wa = F.w_a[(size_t)k * 1024 + n], wb = F.w_b[(size_t)k * 1024 + n];
#pragma unroll
            for (int j = 0; j < 4; ++j) { ya[j] += bf2f(F.P[(size_t)(t0 + j) * 1024 + k]) * wa; yb[j] += bf2f(F.UB[(size_t)(t0 + j) * 1024 + k]) * wb; } }
#pragma unroll
        for (int j = 0; j < 4; ++j) { const size_t o = (size_t)(t0 + j) * 1024 + n; const size_t gi = gate_index(t0 + j, n); const float sgb = bf2f(F.SGB[gi]), sga = bf2f(F.R[gi]) * sgb; F.MM[o] = f2bf(sga * ya[j] + sgb * yb[j]); }
    }
}
DI void n7_out(const Ctx& F) {
    const Tid T = opaque_tid();
    const size_t NT = (size_t)gridDim.x * 512, gt = (size_t)blockIdx.x * 512 + T.tid;
    for (size_t idx = gt; idx < (size_t)(MTOK / 4) * 1024; idx += NT) {
        const int n = (int)(idx & 1023), t0 = (int)(idx >> 10) * 4; float y[4] = {0.f, 0.f, 0.f, 0.f};
        for (int k = 0; k < 1024; ++k) { const float w = F.w_out[(size_t)k * 1024 + n];
#pragma unroll
            for (int j = 0; j < 4; ++j) y[j] += bf2f(F.MM[(size_t)(t0 + j) * 1024 + k]) * w; }
#pragma unroll
        for (int j = 0; j < 4; ++j) { const size_t o = (size_t)(t0 + j) * 1024 + n; F.out[o] = F.x[o] + F.MOD[((t0 + j) >> 12) * 3072 + 2048 + n] * y[j]; }
    }
}
DI void p8_final(const Ctx& F) {
    const Tid T = opaque_tid();
    const int gw = blockIdx.x * 8 + T.wave, NGW = gridDim.x * 8;
    for (int m = gw; m < MTOK; m += NGW) {
        f32x4* xr = (f32x4*)(F.out + (size_t)m * DM);
        f32x4 v[4]; float ss = 0.f;
#pragma unroll
        for (int j = 0; j < 4; ++j) { v[j] = xr[T.lane + 64 * j]; ss += (v[j].x * v[j].x + v[j].y * v[j].y) + (v[j].z * v[j].z + v[j].w * v[j].w); }
        const float rstd = 1.0f / sqrtf(wave_sum(ss) * (1.f / DM) + EPS);
#pragma unroll
        for (int j = 0; j < 4; ++j) { const f32x4 w = *(const f32x4*)(F.final_w + 4 * (T.lane + 64 * j)); xr[T.lane + 64 * j] = v[j] * rstd * w; }
    }
}

constexpr int NPH = 9;
__global__ void __launch_bounds__(512, 2) fwd_kernel(Args args) {
    extern __shared__ __attribute__((aligned(16))) unsigned char lds_raw[];
    Ctx F;
    F.lds = (LAS unsigned char*)lds_raw;
    if (threadIdx.x < 16) ((LAS unsigned*)(F.lds + LDS_MISC))[threadIdx.x] = 0u;
#if !MK_LAUNCH_PER_PHASE
    {
        unsigned* flag = (unsigned*)(args.ws + WS_FLAG); unsigned* done = flag + 64;
        if (blockIdx.x == 0) {
            for (unsigned i = threadIdx.x; i < WS_BAR_BYTES / 16; i += 512) ((u32x4*)(args.ws + WS_BAR))[i] = (u32x4){0u, 0u, 0u, 0u};
            if (threadIdx.x == 0) __hip_atomic_store(done, 0u, __ATOMIC_RELAXED, __HIP_MEMORY_SCOPE_AGENT);
            asm volatile("s_waitcnt vmcnt(0)" ::: "memory");
            __syncthreads();
            if (threadIdx.x == 0) { __builtin_amdgcn_fence(__ATOMIC_RELEASE, "agent"); asm volatile("s_waitcnt vmcnt(0)" ::: "memory");
                __hip_atomic_store(flag, CTL_MAGIC, __ATOMIC_RELAXED, __HIP_MEMORY_SCOPE_AGENT); }
        } else if (threadIdx.x == 0) {
            unsigned sp = 0;
            while (__hip_atomic_load(flag, __ATOMIC_RELAXED, __HIP_MEMORY_SCOPE_AGENT) != CTL_MAGIC) { __builtin_amdgcn_s_sleep(1); if (++sp > (1u << 22)) break; }
            __builtin_amdgcn_fence(__ATOMIC_ACQUIRE, "agent"); asm volatile("s_waitcnt vmcnt(0)" ::: "memory");
        }
    }
#endif
    __syncthreads();
    const XcdBarrier bar = xcd_barrier_post((unsigned*)(args.ws + WS_BAR), (volatile LAS unsigned*)(F.lds + LDS_MISC));
    F.x = args.in[0]; F.c = args.in[1]; F.ctx = args.in[2]; F.c_ctx = args.in[3]; F.norm_w = args.in[4]; F.ada_w = args.in[5]; F.ada_b = args.in[6]; F.w_in = args.in[7];
    F.conv_w = args.in[8]; F.conv_b = args.in[9]; F.decay_logit = args.in[10]; F.gn_w = args.in[11]; F.w_a = args.in[12]; F.w_b = args.in[13]; F.w_out = args.in[14]; F.final_w = args.in[15];
    F.out = args.out; unsigned char* ws = args.ws; F.ws = ws;
    F.MOD = (float*)(ws + WS_MOD); F.ROPE = (f32x2*)(ws + WS_ROPE);
    F.WA = (bf16_t*)(ws + WS_WA); F.WB = (bf16_t*)(ws + WS_WB); F.WOUT = (bf16_t*)(ws + WS_WOUT); F.WIN = (bf16_t*)(ws + WS_WIN); F.XM = (bf16_t*)(ws + WS_XM);
    F.KV = (bf16_t*)(ws + WS_KV); F.KVC = (bf16_t*)(ws + WS_KVC); F.HC = (bf16_t*)(ws + WS_HC); F.ST = (bf16_t*)(ws + WS_ST); F.MM = (bf16_t*)(ws + WS_MM);
    F.P = (bf16_t*)(ws + WS_P); F.Q = (bf16_t*)(ws + WS_Q); F.K = (bf16_t*)(ws + WS_K); F.V = (bf16_t*)(ws + WS_V); F.SZB = (bf16_t*)(ws + WS_SZB);
    F.KC = (bf16_t*)(ws + WS_KC); F.VC = (bf16_t*)(ws + WS_VC); F.UB = (bf16_t*)(ws + WS_UB);
    F.R = (bf16_t*)args.out; F.SGB = (bf16_t*)args.out + (size_t)MTOK * DM;
    F.RET = (float*)(ws + WS_RET); F.S0 = (float*)(ws + WS_KVC);
    const int lo = args.ph_lo, hi = args.ph_hi; const unsigned naive = args.naive;
#define IN(k) (lo <= (k) && (k) < hi && ((MK_PHASES >> (k)) & 1))
#define NAIVE(k) (((naive & MK_NAIVE_AVAIL) >> (k)) & 1u)
#define SEAM(k) do { if (IN(k) && IN((k) + 1)) xcd_barrier(bar); } while (0)
#define REP(k) for (int rep_ = 0; rep_ < 1 + (int)((MK_REP_MASK >> (k)) & 1u); ++rep_)
    if (IN(0)) REP(0) { p0_prologue(F); } SEAM(0);
    if (IN(1)) REP(1) { p1_rows(F); } SEAM(1);
    if (IN(2)) REP(2) {
        if (NAIVE(2)) n2_inproj(F);
        else { const char* const Ab[2] = {(const char*)F.XM, (const char*)F.XM}; const char* const Bb[2] = {(const char*)F.WIN, (const char*)F.WIN};
            Sched1 S{(int)gridDim.x, (int)blockIdx.x}; Epi1 E{F.ws, F.R, F.SGB, F.ROPE};
            pg8::gemm_phase<1, Epi1, Sched1>(F.lds, Ab, Bb, S, E); }
    } SEAM(2);
    if (IN(3)) {
        if (!NAIVE(3)) {
            const char* const Ab[2] = {(const char*)F.XM, (const char*)F.XM}; const char* const Bb[2] = {(const char*)F.WIN, (const char*)F.WIN};
            SchedCtx S{(int)blockIdx.x}; Epi1 E{F.ws, F.R, F.SGB, F.ROPE};
            pg8::gemm_phase<1, Epi1, SchedCtx>(F.lds, Ab, Bb, S, E);
            if (blockIdx.x >= 24) { REP(3) p3_kv(F, blockIdx.x - 24, 1024, gridDim.x - 24); p3_ua(F, blockIdx.x - 24, gridDim.x - 24); }
        } else p3_ua(F, blockIdx.x, gridDim.x);
    } SEAM(3);
    if (IN(4)) REP(4) { if (NAIVE(4)) n4_recurrence(F); else { if (blockIdx.x >= gridDim.x - 32) p4_ctx_state(F, blockIdx.x - (gridDim.x - 32)); else p4_scan(F, blockIdx.x, gridDim.x - 32); } } SEAM(4);
    if (IN(5)) REP(5) { if (NAIVE(5)) n5_groupnorm(F); else p5_ret(F); } SEAM(5);
    if (IN(6)) REP(6) {
        if (NAIVE(6)) n6_ab(F);
        else { const char* const Ab[2] = {(const char*)F.P, (const char*)F.UB}; const char* const Bb[2] = {(const char*)F.WA, (const char*)F.WB};
            SchedSq S{(int)gridDim.x, (int)blockIdx.x}; EpiAB E{F.R, F.SGB, F.MM};
            pg8::gemm_phase<2, EpiAB, SchedSq>(F.lds, Ab, Bb, S, E); }
    } SEAM(6);
    if (IN(7)) {
        const char* const Ab[2] = {(const char*)F.MM, (const char*)F.MM}; const char* const Bb[2] = {(const char*)F.WOUT, (const char*)F.WOUT};
        SchedSq S{(int)gridDim.x, (int)blockIdx.x};
        if (NAIVE(7)) n7_out(F);
        else if (gridDim.x == 256) {
            EpiOutNorm E{F.x, F.MOD, F.out, F.final_w, (float*)(F.ws + WS_SLOTS), (unsigned*)(F.ws + WS_PCNT), (LAS float*)(F.lds + LDS_TAB)};
            pg8::gemm_phase<1, EpiOutNorm, SchedSq>(F.lds, Ab, Bb, S, E); }
        else { EpiOut E{F.x, F.MOD, F.out}; pg8::gemm_phase<1, EpiOut, SchedSq>(F.lds, Ab, Bb, S, E); }
    }
    if (NAIVE(7) || gridDim.x != 256) { SEAM(7); if (IN(8)) { p8_final(F); } }
#if !MK_LAUNCH_PER_PHASE
    __syncthreads();
    if (threadIdx.x == 0) { unsigned* flag = (unsigned*)(args.ws + WS_FLAG); unsigned* done = flag + 64;
        if (__hip_atomic_fetch_add(done, 1u, __ATOMIC_RELAXED, __HIP_MEMORY_SCOPE_AGENT) == gridDim.x - 1) __hip_atomic_store(flag, 0u, __ATOMIC_RELAXED, __HIP_MEMORY_SCOPE_AGENT); }
#endif
#undef IN
#undef NAIVE
#undef SEAM
}

extern "C" void kernel_launch(void* const* d_in, const int* in_sizes, int n_in, void* d_out, int out_size, void* d_ws, size_t ws_size, hipStream_t stream) {
    static int grid = 0;
    if (grid == 0) {
        if (n_in != 16 || out_size != MTOK * DM || ws_size < WS_END) { fprintf(stderr, "kernel_launch: unexpected shapes (n_in %d out %d ws %zu)\n", n_in, out_size, ws_size); grid = -1; return; }
        int dev = 0, cus = 0, per_cu = 0;
        hipGetDevice(&dev); hipDeviceGetAttribute(&cus, hipDeviceAttributeMultiprocessorCount, dev);
        hipFuncSetAttribute((const void*)fwd_kernel, hipFuncAttributeMaxDynamicSharedMemorySize, LDS_BYTES);
        hipOccupancyMaxActiveBlocksPerMultiprocessor(&per_cu, (const void*)fwd_kernel, 512, LDS_BYTES);
        if (per_cu < 1) { fprintf(stderr, "kernel_launch: occupancy query says %d blocks/CU\n", per_cu); per_cu = 1; }
        grid = cus;
        (void)hipGetLastError();
    }
    if (grid < 0) return;
    Args a{};
    for (int i = 0; i < 16; ++i) a.in[i] = (const float*)d_in[i];
    a.out = (float*)d_out; a.ws = (unsigned char*)d_ws; a.naive = MK_NAIVE_MASK;
#if MK_LAUNCH_PER_PHASE
    hipMemsetAsync((unsigned char*)d_ws + WS_BAR, 0, WS_BAR_BYTES, stream);
#endif
#if MK_LAUNCH_PER_PHASE
    for (int ph = 0; ph < NPH; ++ph) { a.ph_lo = ph; a.ph_hi = ph + 1; hipLaunchKernelGGL(fwd_kernel, dim3(grid), dim3(512), LDS_BYTES, stream, a); }
#else
    a.ph_lo = 0; a.ph_hi = NPH;
    hipLaunchKernelGGL(fwd_kernel, dim3(grid), dim3(512), LDS_BYTES, stream, a);
#endif
}
```

```cpp
#include <hip/hip_runtime.h>
#include <cstdio>
#include <cstdint>

#ifndef MK_LAUNCH_PER_PHASE
#define MK_LAUNCH_PER_PHASE 0
#endif
#ifndef MK_NAIVE_MASK
#define MK_NAIVE_MASK 0x00u
#endif

#ifndef MK_REP_MASK
#define MK_REP_MASK 0u
#endif
#ifndef MK_PHASES
#define MK_PHASES 0x1ff
#endif
#ifndef MK_NAIVE_AVAIL
#define MK_NAIVE_AVAIL 0xffu
#endif
#define DI __device__ __forceinline__
#define LAS __attribute__((address_space(3)))
typedef unsigned short bf16_t;
typedef float f32x4 __attribute__((ext_vector_type(4)));
typedef float f32x2 __attribute__((ext_vector_type(2)));
typedef unsigned u32x4 __attribute__((ext_vector_type(4)));
typedef unsigned u32x2 __attribute__((ext_vector_type(2)));
typedef short bf16x8 __attribute__((ext_vector_type(8)));
typedef short s16x4 __attribute__((ext_vector_type(4)));
typedef short v4i16_t __attribute__((ext_vector_type(4)));

constexpr int NB = 4, SEQ = 4096, DM = 1024, MTOK = NB * SEQ, CTXL = 256, MCTX = NB * CTXL, MALL = MTOK + MCTX;
constexpr int NIN = 9216, NH = 8, DK = 64, DV = 128, CHK = 128, NCHK = SEQ / CHK;
constexpr float EPS = 1e-6f;
constexpr size_t MiB = 1u << 20;
constexpr size_t WS_MOD = 0;
constexpr size_t WS_ROPE = 65536;
constexpr size_t WS_WA = 2 * MiB, WS_WB = 4 * MiB, WS_WOUT = 6 * MiB, WS_WIN = 8 * MiB;
constexpr size_t WS_XM = 26 * MiB;
constexpr size_t WS_KV = 223 * MiB;
constexpr size_t WS_KVC = 40 * MiB;
constexpr size_t WS_RET = 8 * MiB;
constexpr size_t WS_HC = 60 * MiB;
constexpr size_t WS_ST = 60 * MiB;
constexpr size_t WS_MM = 60 * MiB;
constexpr size_t WS_P = 92 * MiB;
constexpr size_t WS_Q = 124 * MiB, WS_K = 140 * MiB, WS_V = 156 * MiB, WS_SZB = 188 * MiB;
constexpr size_t WS_KC = 220 * MiB, WS_VC = 221 * MiB;
constexpr size_t WS_UB = 223 * MiB;
constexpr size_t WS_END = 255 * MiB;
constexpr int LDS_BYTES = 147456;
constexpr int LDS_MISC = 139264;
constexpr size_t WS_BAR = 131072, WS_BAR_BYTES = 65536;
constexpr size_t WS_PCNT = WS_BAR + 16384, WS_SLOTS = 1 * MiB;
constexpr size_t WS_FLAG = 98304;
constexpr unsigned CTL_MAGIC = 0x600DF1A6u;
constexpr int LDS_TAB = 132096;

DI float bf2f(bf16_t v) { return __uint_as_float((unsigned)v << 16); }
DI float bflo(unsigned w) { return __uint_as_float(w << 16); }
DI float bfhi(unsigned w) { return __uint_as_float(w & 0xffff0000u); }
typedef __bf16 bf16x2_t __attribute__((ext_vector_type(2)));
DI unsigned cvt_pk_bf16(float lo, float hi) { const f32x2 f = {lo, hi}; const bf16x2_t v = __builtin_convertvector(f, bf16x2_t); return __builtin_bit_cast(unsigned, v); }
DI bf16_t f2bf(float f) { return (bf16_t)(cvt_pk_bf16(f, 0.f) & 0xffffu); }
DI float wave_sum(float v) {
#pragma unroll
    for (int o = 1; o < 64; o <<= 1) v += __shfl_xor(v, o);
    return v;
}
struct Tid { int tid, lane, wave; };
DI Tid opaque_tid() { int t = threadIdx.x; asm volatile("" : "+v"(t)); Tid r; r.tid = t; r.lane = t & 63; r.wave = __builtin_amdgcn_readfirstlane(t >> 6); return r; }
DI float siluf(float x) { return x * __builtin_amdgcn_rcpf(1.f + __expf(-x)); }
DI float log2_gamma(const float* decay_logit, int dir, int h) {
    const float x = decay_logit[dir * NH + h];
    const float ls = fminf(x, 0.f) - log1pf(expf(-fabsf(x)));
    return ls * 1.4426950408889634f;
}

namespace pg8 {
constexpr int BM = 256, BK = 64, HALF = 128, HTB = HALF * BK * 2, STAGE_BYTES = 8 * HTB, NXCD = 8, WGM = 4;
DI int lds_byte(int r, int c) { const int st = (r >> 4) * 2 + (c >> 5), rr = r & 15, cc = c & 31, ob = rr * 64 + cc * 2; return st * 1024 + (ob ^ (((ob >> 9) & 1) << 5)); }
DI void stage_rc(int b, int& R, int& C) { const int st = b / 1024, sb = b % 1024, swz = sb ^ (((sb >> 9) & 1) << 5); R = (st >> 1) * 16 + swz / 64; C = (st & 1) * 32 + (swz % 64) / 2; }
DI int perm32(int rho) { const int n = rho >> 4, i = rho & 15; return 8 * (i >> 2) + 4 * n + (i & 3); }
struct Unit { int pm, pn; };
DI void tile_of(int L, int nM, int nN, Unit& u) {
    const int nwg = nM * nN; int wgid = L;
    { const int q = nwg / NXCD, r = nwg % NXCD, xcd = wgid % NXCD, off = wgid / NXCD; wgid = (xcd < r ? xcd * (q + 1) : r * (q + 1) + (xcd - r) * q) + off; }
    const int nig = WGM * nN, gid = wgid / nig, fm = gid * WGM, gsz = (nM - fm) < WGM ? (nM - fm) : WGM;
    u.pm = fm + ((wgid % nig) % gsz); u.pn = (wgid % nig) / gsz;
}
template <int NSEG, class Epi, class Sched>
DI void gemm_phase(LAS unsigned char* lds, const char* const (&Ab)[2], const char* const (&Bb)[2], const Sched& S, const Epi& E) {
    constexpr int K = 1024, NTS = K / BK;
    constexpr int nt = NSEG * NTS;
    const Tid T = opaque_tid();
    const int tid = T.tid, wid = T.wave, lane = T.lane, wr = wid >> 2, wc = (wid & 3) ^ (wr << 1), fr = lane & 15, fq = lane >> 4;
    unsigned voffA[2], voffB[2];
#pragma unroll
    for (int i = 0; i < 2; ++i) { int R, C; stage_rc(tid * 16 + i * 8192, R, C); const int Rb = (R & ~31) + perm32(R & 31);
        voffA[i] = (unsigned)(R * K + C) * 2u; voffB[i] = (unsigned)(Rb * K + C) * 2u; }
    constexpr size_t kstep = (size_t)(BK * 2);
    constexpr size_t hstep = (size_t)HALF * K * 2;
    constexpr size_t tstep = 2 * hstep;
    const unsigned ldsw = (unsigned)wid * 1024u;
    const int aoff = lds_byte(wr * 64 + fr, fq * 8), boff = lds_byte(wc * 32 + fr, fq * 8);
#define PG8_SA(b, h) (((b) * 2 + (h)) * HTB)
#define PG8_SB(b, h) ((4 + (b) * 2 + (h)) * HTB)
#define PG8_STAGE(bufoff, gbase, voff) do { _Pragma("unroll") for (int _i = 0; _i < 2; ++_i) \
        __builtin_amdgcn_global_load_lds((const unsigned*)((const char*)(gbase) + (voff)[_i]), (LAS unsigned*)(lds + (bufoff) + ldsw + _i * 8192), 16, 0, 0); } while (0)
#define PG8_LDA(dst, b, h) do { _Pragma("unroll") for (int m = 0; m < 4; ++m) _Pragma("unroll") for (int k = 0; k < 2; ++k) dst[m][k] = *(const LAS bf16x8*)(lds + PG8_SA(b, h) + aoff + m * 2048 + k * 1024); } while (0)
#define PG8_LDB(dst, b, h) do { _Pragma("unroll") for (int n = 0; n < 2; ++n) _Pragma("unroll") for (int k = 0; k < 2; ++k) dst[n][k] = *(const LAS bf16x8*)(lds + PG8_SB(b, h) + boff + n * 2048 + k * 1024); } while (0)
#define PG8_MMA(ai, bj, At, Bt) do { __builtin_amdgcn_s_setprio(1); _Pragma("unroll") for (int m = 0; m < 4; ++m) _Pragma("unroll") for (int n = 0; n < 2; ++n) _Pragma("unroll") for (int k = 0; k < 2; ++k) \
        acc[ai][bj][m][n] = __builtin_amdgcn_mfma_f32_16x16x32_bf16(Bt[n][k], At[m][k], acc[ai][bj][m][n], 0, 0, 0); __builtin_amdgcn_s_setprio(0); } while (0)
#define PG8_WAIT_V(n) asm volatile("s_waitcnt vmcnt(" #n ")" ::: "memory")
#define PG8_WAIT_L(n) asm volatile("s_waitcnt lgkmcnt(" #n ")" ::: "memory")
#define PG8_WAIT_VR(sel) asm volatile("s_cmp_lt_i32 %0, 8\n\ts_cbranch_scc1 .Lw8_%=\n\ts_cmp_lt_i32 %0, 16\n\ts_cbranch_scc1 .Lw16_%=\n\ts_waitcnt vmcnt(24)\n\ts_branch .Lwe_%=\n.Lw16_%=:\n\ts_waitcnt vmcnt(16)\n\ts_branch .Lwe_%=\n.Lw8_%=:\n\ts_waitcnt vmcnt(8)\n.Lwe_%=:" :: "s"(sel) : "memory", "scc")
#define PG8_BAR __builtin_amdgcn_s_barrier()
#define PG8_SCHED __builtin_amdgcn_sched_barrier(0)
#define PG8_TA(u, t) (Ab[(t) / NTS] + (size_t)(u).pm * tstep + (size_t)((t) % NTS) * kstep)
#define PG8_TB(u, t) (Bb[(t) / NTS] + (size_t)(u).pn * tstep + (size_t)((t) % NTS) * kstep)
    Unit cur, nxt; int ui = 0;
    if (!S.next(0, cur)) return;
    f32x4 acc[2][2][4][2];
#pragma unroll
    for (int a = 0; a < 2; ++a)
#pragma unroll
        for (int b = 0; b < 2; ++b)
#pragma unroll
            for (int m = 0; m < 4; ++m)
#pragma unroll
                for (int n = 0; n < 2; ++n) acc[a][b][m][n] = (f32x4){0.f, 0.f, 0.f, 0.f};
    bf16x8 At[4][2], B0[2][2], B1[2][2];
    {
        const char* cA = PG8_TA(cur, 0); const char* cB = PG8_TB(cur, 0);
        PG8_STAGE(PG8_SB(0, 0), cB, voffB); PG8_STAGE(PG8_SB(0, 1), cB + hstep, voffB); PG8_STAGE(PG8_SA(0, 0), cA, voffA); PG8_STAGE(PG8_SA(0, 1), cA + hstep, voffA);
        if (wr == 1) PG8_BAR;
        PG8_WAIT_V(2); PG8_BAR;
        PG8_STAGE(PG8_SB(1, 0), cB + kstep, voffB); PG8_STAGE(PG8_SA(1, 0), cA + kstep, voffA); PG8_STAGE(PG8_SB(1, 1), cB + hstep + kstep, voffB);
        PG8_WAIT_V(6); PG8_BAR;
    }
    for (;;) {
        const bool has_next = S.next(ui + 1, nxt);
        const Unit nu = has_next ? nxt : cur;
        for (int t = 0; t < nt; t += 2) {
            if (NSEG == 2 && t == NTS) E.mid(acc, cur, wr, wc, fr, fq);
            const bool last = (t == nt - 2);
            const char* a1 = PG8_TA(cur, t + 1);
            const char* a2 = last ? PG8_TA(nu, 0) : PG8_TA(cur, t + 2); const char* b2 = last ? PG8_TB(nu, 0) : PG8_TB(cur, t + 2);
            const char* a3 = a2 + kstep; const char* b3 = b2 + kstep;
            PG8_LDB(B0, 0, 0); PG8_LDB(B1, 0, 1); PG8_SCHED; PG8_LDA(At, 0, 0); PG8_STAGE(PG8_SA(1, 1), a1 + hstep, voffA);
            PG8_WAIT_V(8); PG8_WAIT_L(0); PG8_BAR; PG8_MMA(0, 0, At, B0); PG8_MMA(0, 1, At, B1); PG8_BAR; PG8_SCHED;
            PG8_LDA(At, 0, 1); PG8_STAGE(PG8_SB(0, 0), b2, voffB); PG8_STAGE(PG8_SB(0, 1), b2 + hstep, voffB); PG8_STAGE(PG8_SA(0, 0), a2, voffA);
            PG8_WAIT_V(8); PG8_WAIT_L(0); PG8_BAR; PG8_MMA(1, 0, At, B0); PG8_MMA(1, 1, At, B1); PG8_BAR; PG8_SCHED;
            PG8_LDB(B0, 1, 0); PG8_LDB(B1, 1, 1); PG8_SCHED; PG8_LDA(At, 1, 0); PG8_STAGE(PG8_SA(0, 1), a2 + hstep, voffA);
            PG8_WAIT_V(8); PG8_WAIT_L(0); PG8_BAR; PG8_MMA(0, 0, At, B0); PG8_MMA(0, 1, At, B1); PG8_BAR; PG8_SCHED;
            PG8_LDA(At, 1, 1); PG8_STAGE(PG8_SB(1, 0), b3, voffB); PG8_STAGE(PG8_SB(1, 1), b3 + hstep, voffB); PG8_STAGE(PG8_SA(1, 0), a3, voffA);
            PG8_WAIT_V(8); PG8_WAIT_L(0); PG8_BAR; PG8_MMA(1, 0, At, B0); PG8_MMA(1, 1, At, B1); PG8_BAR; PG8_SCHED;
        }
        if (wr == 0) PG8_BAR;
        E(acc, cur, wr, wc, fr, fq);
        if (!has_next) break;
#pragma unroll
        for (int a = 0; a < 2; ++a)
#pragma unroll
            for (int b = 0; b < 2; ++b)
#pragma unroll
                for (int m = 0; m < 4; ++m)
#pragma unroll
                    for (int n = 0; n < 2; ++n) acc[a][b][m][n] = (f32x4){0.f, 0.f, 0.f, 0.f};
        cur = nxt; ++ui;
        if (wr == 1) PG8_BAR;
    }
    PG8_WAIT_V(0);
    PG8_BAR;
#undef PG8_SA
#undef PG8_SB
#undef PG8_STAGE
#undef PG8_LDA
#undef PG8_LDB
#undef PG8_MMA
#undef PG8_WAIT_V
#undef PG8_WAIT_L
#undef PG8_WAIT_VR
#undef PG8_BAR
#undef PG8_SCHED
#undef PG8_TA
#undef PG8_TB
}
}


#define XB_TMO      128
#define XB_XCNT(j)  (256  + 64 * (j))
#define XB_XSUB(j)  (1280 + 64 * (j))
#define XB_XGEN(j)  (2304 + 64 * (j))
#define XB_TOP      3328
#define XB_TOPGEN   3392
#define XCD_BAR_WORDS 3456
#define XB_SPIN_CAP (1u << 18)
DI unsigned xb_ld(unsigned* p)              { return __hip_atomic_load(p, __ATOMIC_RELAXED, __HIP_MEMORY_SCOPE_AGENT); }
DI unsigned xb_add(unsigned* p, unsigned v) { return __hip_atomic_fetch_add(p, v, __ATOMIC_RELAXED, __HIP_MEMORY_SCOPE_AGENT); }
DI unsigned xb_xcc_id() { return (unsigned)__builtin_amdgcn_s_getreg((3 << 11) | 20) & 0xFu; }
#define XB_SPIN(cond, bar) do { unsigned _sp = 0; while (cond) { __builtin_amdgcn_s_sleep(1); \
    if ((++_sp & 255u) == 0u) { if (xb_ld(&(bar)[XB_TMO])) break; if (_sp > XB_SPIN_CAP) { atomicAdd(&(bar)[XB_TMO], 1u); break; } } } } while (0)
struct XcdBarrier { unsigned* bar; unsigned x; volatile LAS unsigned* st; };
DI XcdBarrier xcd_barrier_post(unsigned* bar, volatile LAS unsigned* st) {
    XcdBarrier b; b.bar = bar; b.x = xb_xcc_id(); b.st = st;
    if (threadIdx.x == 0) (void)xb_add(&bar[XB_XCNT(b.x)], 1u);
    return b;
}
DI void xcd_barrier_complete(unsigned* bar, unsigned x, unsigned& nloc, unsigned& nx) {
    const unsigned G = gridDim.x * gridDim.y * gridDim.z;
    unsigned sum, cnt, mine, sp = 0u;
    for (;;) {
        sum = 0u; cnt = 0u; mine = 0u;
#pragma unroll
        for (unsigned j = 0; j < 16; ++j) { const unsigned c = xb_ld(&bar[XB_XCNT(j)]); sum += c; cnt += (c > 0u) ? 1u : 0u; mine = (j == x) ? c : mine; }
        if (sum == G) break;
        __builtin_amdgcn_s_sleep(1);
        if ((++sp & 255u) == 0u) { if (xb_ld(&bar[XB_TMO])) break; if (sp > XB_SPIN_CAP) { atomicAdd(&bar[XB_TMO], 1u); break; } }
    }
    nloc = mine > 0u ? mine : 1u; nx = cnt > 0u ? cnt : 1u;
}
DI void xcd_barrier(const XcdBarrier& b) {
    asm volatile("s_waitcnt vmcnt(0)" ::: "memory");
    __syncthreads();
    if (threadIdx.x == 0) {
        unsigned* bar = b.bar;
        __builtin_amdgcn_s_waitcnt(0);
        unsigned nloc = b.st[0], nx = b.st[1];
        if (nloc == 0u) { xcd_barrier_complete(bar, b.x, nloc, nx); b.st[0] = nloc; b.st[1] = nx; }
        const unsigned old = xb_add(&bar[XB_XSUB(b.x)], 1u);
        const unsigned gen = old / nloc;
        if (old + 1u == (gen + 1u) * nloc) {
            __builtin_amdgcn_fence(__ATOMIC_RELEASE, "agent");
            asm volatile("s_waitcnt vmcnt(0)" ::: "memory");
            const unsigned og = xb_add(&bar[XB_TOP], 1u);
            const unsigned tg = og / nx;
            if (og + 1u == (tg + 1u) * nx) xb_add(&bar[XB_TOPGEN], 1u);
            else XB_SPIN(xb_ld(&bar[XB_TOPGEN]) == tg, bar);
            __builtin_amdgcn_fence(__ATOMIC_ACQUIRE, "agent");
            xb_add(&bar[XB_XGEN(b.x)], 1u);
            asm volatile("s_waitcnt vmcnt(0)" ::: "memory");
        } else {
            XB_SPIN(xb_ld(&bar[XB_XGEN(b.x)]) == gen, bar);
            __builtin_amdgcn_fence(__ATOMIC_ACQUIRE, "agent");
            asm volatile("s_waitcnt vmcnt(0)" ::: "memory");
        }
    }
    __syncthreads();
}

struct Args { const float* in[16]; float* out; unsigned char* ws; int ph_lo, ph_hi; unsigned naive; int pad; };
struct Ctx {
    LAS unsigned char* lds;
    const float *x, *c, *ctx, *c_ctx, *norm_w, *ada_w, *ada_b, *w_in, *conv_w, *conv_b, *decay_logit, *gn_w, *w_a, *w_b, *w_out, *final_w;
    float* out; unsigned char* ws;
    float* MOD; f32x2* ROPE;
    bf16_t *WA, *WB, *WOUT, *WIN, *XM, *KV, *KVC, *HC, *ST, *MM, *P, *Q, *K, *V, *SZB, *KC, *VC, *UB, *R, *SGB;
    float* RET; float* S0;
};

DI int win_dest(int o) {
    if (o < 4096) { const int g = o >> 10, ch = o & 1023; return 256 * (ch >> 6) + 64 * g + (ch & 63); }
    if (o < 5120) { const int qk = (o - 4096) >> 9, oo = (o - 4096) & 511, head = oo >> 6, i = oo & 63, t = head >> 2, hh = head & 3;
        return 256 * (16 + 2 * qk + t) + (i < 32 ? 32 * hh + i : 128 + 32 * hh + (i - 32)); }
    if (o < 7168) return o;
    { const int gs = (o - 7168) >> 10, ch = (o - 7168) & 1023; return 256 * (28 + (ch >> 7)) + 128 * gs + (ch & 127); }
}
DI void p0_transpose_item(const float* W, int K, int N, bf16_t* WT, bool permute, LAS float* scr, int item, int lane) {
    const int nblk = N / 32, kb = item / nblk, nb = item % nblk, k0 = 64 * kb, n0 = 32 * nb;
    f32x4 rv[8];
#pragma unroll
    for (int i = 0; i < 8; ++i) rv[i] = *(const f32x4*)(W + (size_t)(k0 + 8 * i + (lane >> 3)) * N + n0 + 4 * (lane & 7));
#pragma unroll
    for (int i = 0; i < 8; ++i) { LAS float* d = scr + (8 * i + (lane >> 3)) * 33 + 4 * (lane & 7); d[0] = rv[i].x; d[1] = rv[i].y; d[2] = rv[i].z; d[3] = rv[i].w; }
    asm volatile("s_waitcnt lgkmcnt(0)" ::: "memory");
    const int c = lane & 7; const int d0 = permute ? win_dest(n0) : n0;
#pragma unroll
    for (int j = 0; j < 4; ++j) { const int n = (lane >> 3) + 8 * j; const LAS float* sp = scr + (8 * c) * 33 + n;
        u32x4 o; o.x = cvt_pk_bf16(sp[0 * 33], sp[1 * 33]); o.y = cvt_pk_bf16(sp[2 * 33], sp[3 * 33]); o.z = cvt_pk_bf16(sp[4 * 33], sp[5 * 33]); o.w = cvt_pk_bf16(sp[6 * 33], sp[7 * 33]);
        *(u32x4*)(WT + (size_t)(d0 + n) * K + k0 + 8 * c) = o; }
    asm volatile("s_waitcnt lgkmcnt(0)" ::: "memory");
}
DI void p0_prologue(const Ctx& F) {
    const Tid T = opaque_tid();
    if (blockIdx.x < 48) {
        LAS float* red = (LAS float*)F.lds;
        LAS float* sl = (LAS float*)(F.lds + 16384);
        for (int e = T.tid; e < 5 * 1024; e += 512) { const int v = e >> 10, k = e & 1023; sl[e] = siluf(v < 4 ? F.c[v * 1024 + k] : F.c_ctx[k]); }
        __syncthreads();
        const int n0 = 64 * blockIdx.x, k0 = 128 * T.wave, r4 = T.lane >> 4, c4 = T.lane & 15;
        f32x4 a[5];
#pragma unroll
        for (int v = 0; v < 5; ++v) a[v] = (f32x4){0.f, 0.f, 0.f, 0.f};
#pragma unroll 1
        for (int ib = 0; ib < 32; ib += 8) {
            f32x4 wv[8];
#pragma unroll
            for (int i = 0; i < 8; ++i) wv[i] = *(const f32x4*)(F.ada_w + (size_t)(k0 + 4 * (ib + i) + r4) * 3072 + n0 + 4 * c4);
#pragma unroll
            for (int i = 0; i < 8; ++i) {
#pragma unroll
                for (int v = 0; v < 5; ++v) a[v] += wv[i] * sl[v * 1024 + k0 + 4 * (ib + i) + r4];
                __builtin_amdgcn_sched_barrier(0); }
        }
#pragma unroll
        for (int v = 0; v < 5; ++v) {
#pragma unroll
            for (int e = 0; e < 4; ++e) { float t = a[v][e]; t += __shfl_xor(t, 16); t += __shfl_xor(t, 32); a[v][e] = t; }
            if (r4 == 0) { LAS float* d = red + (T.wave * 5 + v) * 64 + 4 * c4; d[0] = a[v].x; d[1] = a[v].y; d[2] = a[v].z; d[3] = a[v].w; } }
        __syncthreads();
        if (T.tid < 320) { const int v = T.tid >> 6, l = T.tid & 63; float s = F.ada_b[n0 + l];
#pragma unroll
            for (int w = 0; w < 8; ++w) s += red[(w * 5 + v) * 64 + l];
            F.MOD[v * 3072 + n0 + l] = s; }
        __syncthreads();
    }
    if (blockIdx.x == 48) {
        for (int e = T.tid; e < 1024; e += 512) { const int p = e >> 4, f = e & 15; const float inv = powf(10000.f, -(float)f / 16.f); const float ang = (float)p * inv;
            F.ROPE[e] = (f32x2){cosf(ang), sinf(ang)}; }
    }
    LAS float* scr = (LAS float*)(F.lds + T.wave * 16384);
    const int gw = blockIdx.x * 8 + T.wave, NGW = gridDim.x * 8;
    constexpr int I_IN = 16 * (NIN / 32), I_SQ = 16 * 32;
    for (int it = gw; it < I_IN + 3 * I_SQ; it += NGW) {
        int r = it;
        if (r < I_IN) { p0_transpose_item(F.w_in, 1024, NIN, F.WIN, true, scr, r, T.lane); continue; } r -= I_IN;
        if (r < I_SQ) { p0_transpose_item(F.w_a, 1024, 1024, F.WA, false, scr, r, T.lane); continue; } r -= I_SQ;
        if (r < I_SQ) { p0_transpose_item(F.w_b, 1024, 1024, F.WB, false, scr, r, T.lane); continue; } r -= I_SQ;
        p0_transpose_item(F.w_out, 1024, 1024, F.WOUT, false, scr, r, T.lane);
    }
}
template <int RB> DI void p1_row_group(const Ctx& F, const Tid& T, int m0) {
    f32x4 v[RB][2][2]; float ss[RB];
#pragma unroll
    for (int r = 0; r < RB; ++r) { const int m = m0 + r; const float* xr = m < MTOK ? F.x + (size_t)m * DM : F.ctx + (size_t)(m - MTOK) * DM;
#pragma unroll
        for (int j = 0; j < 2; ++j)
#pragma unroll
            for (int h = 0; h < 2; ++h) v[r][j][h] = ((const f32x4*)xr)[2 * (T.lane + 64 * j) + h]; }
#pragma unroll
    for (int r = 0; r < RB; ++r) { float s = 0.f;
#pragma unroll
        for (int j = 0; j < 2; ++j)
#pragma unroll
            for (int h = 0; h < 2; ++h) { const f32x4 t = v[r][j][h]; s += (t.x * t.x + t.y * t.y) + (t.z * t.z + t.w * t.w); }
        ss[r] = s; }
#pragma unroll
    for (int o = 1; o < 64; o <<= 1)
#pragma unroll
        for (int r = 0; r < RB; ++r) ss[r] += __shfl_xor(ss[r], o);
    const int mb = m0 < MTOK ? (m0 >> 12) : 4; const float* mod = F.MOD + mb * 3072;
#pragma unroll
    for (int j = 0; j < 2; ++j) { const int col = 8 * (T.lane + 64 * j);
        f32x4 w[2], sh[2], sc[2];
#pragma unroll
        for (int h = 0; h < 2; ++h) { w[h] = *(const f32x4*)(F.norm_w + col + 4 * h); sh[h] = *(const f32x4*)(mod + col + 4 * h); sc[h] = *(const f32x4*)(mod + 1024 + col + 4 * h); }
#pragma unroll
        for (int r = 0; r < RB; ++r) { const float rstd = __builtin_amdgcn_rsqf(ss[r] * (1.f / DM) + EPS);
            const f32x4 y0 = (v[r][j][0] * rstd * w[0]) * (sc[0] + 1.0f) + sh[0], y1 = (v[r][j][1] * rstd * w[1]) * (sc[1] + 1.0f) + sh[1];
            u32x4 o; o.x = cvt_pk_bf16(y0.x, y0.y); o.y = cvt_pk_bf16(y0.z, y0.w); o.z = cvt_pk_bf16(y1.x, y1.y); o.w = cvt_pk_bf16(y1.z, y1.w);
            *(u32x4*)(F.XM + (size_t)(m0 + r) * DM + col) = o; } }
}
DI void p1_rows(const Ctx& F) {
    const Tid T = opaque_tid();
    const int gw = blockIdx.x * 8 + T.wave, NGW = gridDim.x * 8;
    for (int m0 = gw * 8; m0 < MTOK; m0 += NGW * 8) p1_row_group<8>(F, T, m0);
    for (int m0 = MTOK + gw; m0 < MALL; m0 += NGW) p1_row_group<1>(F, T, m0);
}
DI size_t gate_block(int pm, int t, int wr, int wc, int ai, int m) { return (size_t)(((((pm * 8 + t) * 8 + (wr * 4 + wc)) * 2 + ai) * 4 + m)) * 512; }
DI size_t gate_index(int row, int col) { const int pm = row >> 8, rr = row & 255, cc = col & 127;
    return gate_block(pm, col >> 7, (rr >> 6) & 1, cc >> 5, rr >> 7, (rr >> 4) & 3) + (size_t)(((cc >> 3) & 3) * 16 + (rr & 15)) * 8 + (cc & 7); }
struct Sched1 {
    int G, c;
    DI bool next(int i, pg8::Unit& u) const { const int L = i * G + c; if (L >= 64 * 36) return false; pg8::tile_of(L, 64, 36, u); return true; }
};
struct SchedCtx {
    int c;
    DI bool next(int i, pg8::Unit& u) const { if (i > 0 || c >= 24) return false; u.pm = 64 + c / 6; u.pn = 18 + c % 6; return true; }
};
struct Epi1 {
    unsigned char* ws; bf16_t *R, *SGB; const f32x2* rope;
    DI int vm_ops(const pg8::Unit& u) const { return u.pn < 16 ? 8 : 16; }
    DI void mid(f32x4 (&)[2][2][4][2], const pg8::Unit&, int, int, int, int) const {}
    DI void operator()(const f32x4 (&acc)[2][2][4][2], const pg8::Unit& u, int wr, int wc, int fr, int fq) const {
        const int pn = u.pn, row0 = u.pm * 256 + wr * 64 + fr, x0 = wc * 32 + 8 * fq;
        const bool isctx = u.pm >= 64;
        if (pn < 16) {
            bf16_t* dst = (bf16_t*)(ws + (wc < 2 ? WS_HC : WS_P)) + 64 * pn + (x0 & 63);
#pragma unroll
            for (int ai = 0; ai < 2; ++ai)
#pragma unroll
                for (int m = 0; m < 4; ++m) { const size_t row = row0 + ai * 128 + m * 16;
                    f32x4 o[2];
#pragma unroll
                    for (int n = 0; n < 2; ++n) { const f32x4 a = acc[ai][0][m][n], b = acc[ai][1][m][n];
                        if (wc < 2) o[n] = a * b;
                        else { o[n].x = a.x * siluf(b.x); o[n].y = a.y * siluf(b.y); o[n].z = a.z * siluf(b.z); o[n].w = a.w * siluf(b.w); } }
                    u32x4 w; w.x = cvt_pk_bf16(o[0].x, o[0].y); w.y = cvt_pk_bf16(o[0].z, o[0].w); w.z = cvt_pk_bf16(o[1].x, o[1].y); w.w = cvt_pk_bf16(o[1].z, o[1].w);
                    *(u32x4*)(dst + row * 1024) = w; }
        } else if (pn < 20) {
            const int t = (pn - 16) & 1, isk = (pn - 16) >> 1, head = 4 * t + wc, i0 = 8 * fq;
            const float scale = isk ? 0.125f : 1.0f;
            bf16_t* base = (bf16_t*)(ws + (isk ? (isctx ? WS_KC : WS_K) : WS_Q));
#pragma unroll
            for (int ai = 0; ai < 2; ++ai)
#pragma unroll
                for (int m = 0; m < 4; ++m) { const int row = row0 + ai * 128 + m * 16; const int orow = isctx ? row - MTOK : row;
                    const int pos = row & 4095, pidx = (fq < 2) ? (pos >> 6) : (pos & 63);
                    const f32x2* rp = rope + pidx * 16 + (fq & 1) * 8;
                    float o1[8], o2[8];
#pragma unroll
                    for (int e = 0; e < 8; ++e) { f32x2 cs = rp[e]; if (isctx) cs = (f32x2){1.f, 0.f};
                        const float t1 = acc[ai][0][m][e >> 2][e & 3], t2 = acc[ai][1][m][e >> 2][e & 3];
                        o1[e] = (t1 * cs.x - t2 * cs.y) * scale; o2[e] = (t1 * cs.y + t2 * cs.x) * scale; }
                    u32x4 w1, w2; w1.x = cvt_pk_bf16(o1[0], o1[1]); w1.y = cvt_pk_bf16(o1[2], o1[3]); w1.z = cvt_pk_bf16(o1[4], o1[5]); w1.w = cvt_pk_bf16(o1[6], o1[7]);
                    w2.x = cvt_pk_bf16(o2[0], o2[1]); w2.y = cvt_pk_bf16(o2[2], o2[3]); w2.z = cvt_pk_bf16(o2[4], o2[5]); w2.w = cvt_pk_bf16(o2[6], o2[7]);
                    bf16_t* d = base + (size_t)orow * 512 + head * 64 + i0;
                    *(u32x4*)d = w1; *(u32x4*)(d + 32) = w2; }
        } else if (pn < 28) {
            const bool isz = pn >= 24;
            bf16_t* base = (bf16_t*)(ws + (isz ? WS_SZB : (isctx ? WS_VC : WS_V)));
            const int colt = 256 * (pn - (isz ? 24 : 20)) + x0;
#pragma unroll
            for (int ai = 0; ai < 2; ++ai)
#pragma unroll
                for (int m = 0; m < 4; ++m) { const int row = row0 + ai * 128 + m * 16; const int orow = isctx ? row - MTOK : row;
#pragma unroll
                    for (int bj = 0; bj < 2; ++bj) { f32x4 a = acc[ai][bj][m][0], b = acc[ai][bj][m][1];
                        u32x4 w; w.x = cvt_pk_bf16(a.x, a.y); w.y = cvt_pk_bf16(a.z, a.w); w.z = cvt_pk_bf16(b.x, b.y); w.w = cvt_pk_bf16(b.z, b.w);
                        if (isz) __builtin_nontemporal_store(w, (u32x4*)(base + (size_t)orow * 1024 + colt + bj * 128)); else *(u32x4*)(base + (size_t)orow * 1024 + colt + bj * 128) = w; } }
        } else {
            const int col = 128 * (pn - 28) + x0;
#pragma unroll
            for (int ai = 0; ai < 2; ++ai)
#pragma unroll
                for (int m = 0; m < 4; ++m) { const size_t row = row0 + ai * 128 + m * 16;
                    float rr[8], sg[8];
#pragma unroll
                    for (int e = 0; e < 8; ++e) { const float ga = acc[ai][0][m][e >> 2][e & 3], gb = acc[ai][1][m][e >> 2][e & 3];
                        const float ea = 1.f + __expf(-ga), eb = 1.f + __expf(-gb); sg[e] = __builtin_amdgcn_rcpf(eb); rr[e] = eb * __builtin_amdgcn_rcpf(ea); }
                    u32x4 w1, w2; w1.x = cvt_pk_bf16(rr[0], rr[1]); w1.y = cvt_pk_bf16(rr[2], rr[3]); w1.z = cvt_pk_bf16(rr[4], rr[5]); w1.w = cvt_pk_bf16(rr[6], rr[7]);
                    w2.x = cvt_pk_bf16(sg[0], sg[1]); w2.y = cvt_pk_bf16(sg[2], sg[3]); w2.z = cvt_pk_bf16(sg[4], sg[5]); w2.w = cvt_pk_bf16(sg[6], sg[7]);
                    const size_t gi = gate_block(u.pm, pn - 28, wr, wc, ai, m) + (size_t)(fq * 16 + fr) * 8;
                    __builtin_nontemporal_store(w1, (u32x4*)(R + gi)); __builtin_nontemporal_store(w2, (u32x4*)(SGB + gi)); }
        }
    }
};
DI void n2_inproj(const Ctx& F) {
    const Tid T = opaque_tid();
    const size_t NT = (size_t)gridDim.x * 512, gt = (size_t)blockIdx.x * 512 + T.tid;
    for (size_t idx = gt; idx < (size_t)(MALL / 4) * 1024; idx += NT) {
        const int ch = (int)(idx & 1023), t0 = (int)(idx >> 10) * 4;
        const bool doqk = ch < 512 && (ch & 63) < 32;
        float a[12][4];
#pragma unroll
        for (int o = 0; o < 12; ++o)
#pragma unroll
            for (int j = 0; j < 4; ++j) a[o][j] = 0.f;
        for (int k = 0; k < 1024; ++k) {
            const float* wr = F.w_in + (size_t)k * NIN;
            float xv[4];
#pragma unroll
            for (int j = 0; j < 4; ++j) xv[j] = bf2f(F.XM[(size_t)(t0 + j) * 1024 + k]);
            float w[12];
            w[0] = wr[ch]; w[1] = wr[1024 + ch]; w[2] = wr[2048 + ch]; w[3] = wr[3072 + ch]; w[4] = wr[5120 + ch]; w[5] = wr[6144 + ch]; w[6] = wr[7168 + ch]; w[7] = wr[8192 + ch];
            if (doqk) { w[8] = wr[4096 + ch]; w[9] = wr[4096 + ch + 32]; w[10] = wr[4608 + ch]; w[11] = wr[4608 + ch + 32]; } else { w[8] = w[9] = w[10] = w[11] = 0.f; }
#pragma unroll
            for (int o = 0; o < 12; ++o)
#pragma unroll
                for (int j = 0; j < 4; ++j) a[o][j] += xv[j] * w[o];
        }
#pragma unroll
        for (int j = 0; j < 4; ++j) { const int t = t0 + j;
            if (t < MTOK) {
                const size_t o = (size_t)t * 1024 + ch;
                F.HC[o] = f2bf(a[2][j] * a[0][j]); F.P[o] = f2bf(siluf(a[3][j]) * a[1][j]); F.V[o] = f2bf(a[4][j]); F.SZB[o] = f2bf(a[5][j]);
                const float sga = 1.f / (1.f + __expf(-a[6][j])), sgb = 1.f / (1.f + __expf(-a[7][j]));
                { const size_t gi = gate_index(t, ch); F.R[gi] = f2bf(sga / sgb); F.SGB[gi] = f2bf(sgb); }
                if (doqk) { const int i = ch & 63, pos = t & 4095; const int pidx = i < 16 ? (pos >> 6) : (pos & 63); const f32x2 cs = F.ROPE[pidx * 16 + (i & 15)];
                    const size_t q = (size_t)t * 512 + ch;
                    F.Q[q] = f2bf(a[8][j] * cs.x - a[9][j] * cs.y); F.Q[q + 32] = f2bf(a[8][j] * cs.y + a[9][j] * cs.x);
                    F.K[q] = f2bf((a[10][j] * cs.x - a[11][j] * cs.y) * 0.125f); F.K[q + 32] = f2bf((a[10][j] * cs.y + a[11][j] * cs.x) * 0.125f); }
            } else {
                const int tc = t - MTOK;
                F.VC[(size_t)tc * 1024 + ch] = f2bf(a[4][j]);
                if (doqk) { F.KC[(size_t)tc * 512 + ch] = f2bf(a[10][j] * 0.125f); F.KC[(size_t)tc * 512 + ch + 32] = f2bf(a[11][j] * 0.125f); }
            }
        }
    }
}
DI bf16x8 tr2(const LAS unsigned char* p, int delta) {
    const s16x4 lo = __builtin_bit_cast(s16x4, __builtin_amdgcn_ds_read_tr16_b64_v4i16((LAS v4i16_t*)p));
    const s16x4 hi = __builtin_bit_cast(s16x4, __builtin_amdgcn_ds_read_tr16_b64_v4i16((LAS v4i16_t*)(p + delta)));
    return __builtin_shufflevector(lo, hi, 0, 1, 2, 3, 4, 5, 6, 7);
}
DI u32x4 scale8(u32x4 w, float s) {
    u32x4 o; o.x = cvt_pk_bf16(bflo(w.x) * s, bfhi(w.x) * s); o.y = cvt_pk_bf16(bflo(w.y) * s, bfhi(w.y) * s); o.z = cvt_pk_bf16(bflo(w.z) * s, bfhi(w.z) * s); o.w = cvt_pk_bf16(bflo(w.w) * s, bfhi(w.w) * s); return o;
}
DI void p3_kv(const Ctx& F, int it0, int it1, int stride) {
    const Tid T = opaque_tid();
    LAS unsigned char* KFI = F.lds; LAS unsigned char* KBI = F.lds + 20480; LAS unsigned char* VI = F.lds + 40960;
    const int tid = T.tid, lane = T.lane, w = T.wave, g = lane >> 4, q = (lane & 15) >> 2, p = lane & 3;
    const int row = tid >> 2, seg = tid & 3;
    u32x4 pk[2], pv[4];
    auto prefetch = [&](int it) { const int bh = it >> 5, c = it & 31; const size_t tok0 = (size_t)(bh >> 3) * SEQ + c * CHK;
        const bf16_t* kp = F.K + tok0 * 512 + (bh & 7) * 64; const bf16_t* vp = F.V + tok0 * 1024 + (bh & 7) * 128;
        pk[0] = *(const u32x4*)(kp + (size_t)row * 512 + seg * 16); pk[1] = *(const u32x4*)(kp + (size_t)row * 512 + seg * 16 + 8);
#pragma unroll
        for (int i = 0; i < 4; ++i) pv[i] = *(const u32x4*)(vp + (size_t)row * 1024 + seg * 32 + 8 * i); };
    if (it0 < it1) prefetch(it0);
    for (int it = it0; it < it1; it += stride) {
        const int bh = it >> 5, c = it & 31;
        const float l2f = log2_gamma(F.decay_logit, 0, bh & 7), l2b = log2_gamma(F.decay_logit, 1, bh & 7);
        { const float df = __builtin_amdgcn_exp2f(l2f * (float)(127 - row)), db = __builtin_amdgcn_exp2f(l2b * (float)row);
            *(LAS u32x4*)(KFI + row * 160 + seg * 32) = scale8(pk[0], df); *(LAS u32x4*)(KFI + row * 160 + seg * 32 + 16) = scale8(pk[1], df);
            *(LAS u32x4*)(KBI + row * 160 + seg * 32) = scale8(pk[0], db); *(LAS u32x4*)(KBI + row * 160 + seg * 32 + 16) = scale8(pk[1], db);
#pragma unroll
            for (int i = 0; i < 4; ++i) *(LAS u32x4*)(VI + row * 288 + seg * 64 + 16 * i) = pv[i]; }
        __syncthreads();
        if (it + stride < it1) prefetch(it + stride);
        f32x4 acc[2][4];
#pragma unroll
        for (int d = 0; d < 2; ++d)
#pragma unroll
            for (int nb = 0; nb < 4; ++nb) acc[d][nb] = (f32x4){0.f, 0.f, 0.f, 0.f};
#pragma unroll
        for (int s2 = 0; s2 < 4; ++s2) {
            const bf16x8 vb = tr2(VI + (32 * s2 + 8 * g + q) * 288 + (16 * w + 4 * p) * 2, 4 * 288);
#pragma unroll
            for (int nb = 0; nb < 4; ++nb) {
                const bf16x8 kf = tr2(KFI + (32 * s2 + 8 * g + q) * 160 + (16 * nb + 4 * p) * 2, 4 * 160);
                const bf16x8 kb = tr2(KBI + (32 * s2 + 8 * g + q) * 160 + (16 * nb + 4 * p) * 2, 4 * 160);
                acc[0][nb] = __builtin_amdgcn_mfma_f32_16x16x32_bf16(kf, vb, acc[0][nb], 0, 0, 0);
                acc[1][nb] = __builtin_amdgcn_mfma_f32_16x16x32_bf16(kb, vb, acc[1][nb], 0, 0, 0);
            }
        }
        bf16_t* of = F.KV + ((size_t)(0 * 32 + bh) * 32 + c) * 8192; bf16_t* ob = F.KV + ((size_t)(1 * 32 + bh) * 32 + c) * 8192;
#pragma unroll
        for (int nb = 0; nb < 4; ++nb) { const int o = ((w * 4 + nb) * 64 + lane) * 4;
            u32x2 a, b; a.x = cvt_pk_bf16(acc[0][nb].x, acc[0][nb].y); a.y = cvt_pk_bf16(acc[0][nb].z, acc[0][nb].w); b.x = cvt_pk_bf16(acc[1][nb].x, acc[1][nb].y); b.y = cvt_pk_bf16(acc[1][nb].z, acc[1][nb].w);
            *(u32x2*)(of + o) = a; *(u32x2*)(ob + o) = b; }
        __syncthreads();
    }
}
DI void p4_ctx_state(const Ctx& F, int bh) {
    const Tid T = opaque_tid();
    LAS unsigned char* KFI = F.lds; LAS unsigned char* KBI = F.lds + 20480; LAS unsigned char* VI = F.lds + 40960;
    const int tid = T.tid, lane = T.lane, w = T.wave, g = lane >> 4, q = (lane & 15) >> 2, p = lane & 3;
    const int row = tid >> 2, seg = tid & 3;
    const float l2f = log2_gamma(F.decay_logit, 0, bh & 7), l2b = log2_gamma(F.decay_logit, 1, bh & 7);
    f32x4 acc[2][4];
#pragma unroll
    for (int d = 0; d < 2; ++d)
#pragma unroll
        for (int nb = 0; nb < 4; ++nb) acc[d][nb] = (f32x4){0.f, 0.f, 0.f, 0.f};
    for (int cc = 0; cc < 2; ++cc) {
        const size_t tok0 = (size_t)(bh >> 3) * CTXL + cc * CHK; const int m = cc * CHK + row;
        const bf16_t* kp = F.KC + tok0 * 512 + (bh & 7) * 64; const bf16_t* vp = F.VC + tok0 * 1024 + (bh & 7) * 128;
        const u32x4 k0 = *(const u32x4*)(kp + (size_t)row * 512 + seg * 16), k1 = *(const u32x4*)(kp + (size_t)row * 512 + seg * 16 + 8);
        const float df = __builtin_amdgcn_exp2f(l2f * (float)(255 - m)), db = __builtin_amdgcn_exp2f(l2b * (float)m);
        *(LAS u32x4*)(KFI + row * 160 + seg * 32) = scale8(k0, df); *(LAS u32x4*)(KFI + row * 160 + seg * 32 + 16) = scale8(k1, df);
        *(LAS u32x4*)(KBI + row * 160 + seg * 32) = scale8(k0, db); *(LAS u32x4*)(KBI + row * 160 + seg * 32 + 16) = scale8(k1, db);
#pragma unroll
        for (int i = 0; i < 4; ++i) *(LAS u32x4*)(VI + row * 288 + seg * 64 + 16 * i) = *(const u32x4*)(vp + (size_t)row * 1024 + seg * 32 + 8 * i);
        __syncthreads();
#pragma unroll
        for (int s2 = 0; s2 < 4; ++s2) {
            const bf16x8 vb = tr2(VI + (32 * s2 + 8 * g + q) * 288 + (16 * w + 4 * p) * 2, 4 * 288);
#pragma unroll
            for (int nb = 0; nb < 4; ++nb) {
                const bf16x8 kf = tr2(KFI + (32 * s2 + 8 * g + q) * 160 + (16 * nb + 4 * p) * 2, 4 * 160);
                const bf16x8 kb = tr2(KBI + (32 * s2 + 8 * g + q) * 160 + (16 * nb + 4 * p) * 2, 4 * 160);
                acc[0][nb] = __builtin_amdgcn_mfma_f32_16x16x32_bf16(kf, vb, acc[0][nb], 0, 0, 0);
                acc[1][nb] = __builtin_amdgcn_mfma_f32_16x16x32_bf16(kb, vb, acc[1][nb], 0, 0, 0);
            }
        }
        __syncthreads();
    }
    float* of = F.S0 + (size_t)(0 * 32 + bh) * 8192; float* ob = F.S0 + (size_t)(1 * 32 + bh) * 8192;
#pragma unroll
    for (int nb = 0; nb < 4; ++nb) { const int o = ((w * 4 + nb) * 64 + lane) * 4; *(f32x4*)(of + o) = acc[0][nb]; *(f32x4*)(ob + o) = acc[1][nb]; }
}
DI void p3_ua(const Ctx& F, int blk, int nblk) {
    const Tid T = opaque_tid();
    const size_t NT = (size_t)nblk * 512, gt = (size_t)blk * 512 + T.tid;
    for (size_t idx = gt; idx < (size_t)MTOK * 128; idx += NT) {
        const int t = (int)(idx >> 7), c8 = (int)(idx & 127) * 8, pos = t & 4095;
        const bf16_t* hp = F.HC + (size_t)t * 1024 + c8;
        const u32x4 z = (u32x4){0u, 0u, 0u, 0u};
        const u32x4 h0 = pos > 0 ? *(const u32x4*)(hp - 1024) : z, h1 = *(const u32x4*)hp, h2 = pos < SEQ - 1 ? *(const u32x4*)(hp + 1024) : z;
        const u32x4 pv = *(const u32x4*)(F.P + (size_t)t * 1024 + c8);
        float o[8];
#pragma unroll
        for (int e = 0; e < 8; ++e) { const unsigned a = h0[e >> 1], b = h1[e >> 1], c = h2[e >> 1], pp = pv[e >> 1];
            const float x0 = (e & 1) ? bfhi(a) : bflo(a), x1 = (e & 1) ? bfhi(b) : bflo(b), x2 = (e & 1) ? bfhi(c) : bflo(c), pf = (e & 1) ? bfhi(pp) : bflo(pp);
            const float cv = F.conv_w[c8 + e] * x0 + F.conv_w[1024 + c8 + e] * x1 + F.conv_w[2048 + c8 + e] * x2 + F.conv_b[c8 + e];
            o[e] = pf * cv; }
        u32x4 w; w.x = cvt_pk_bf16(o[0], o[1]); w.y = cvt_pk_bf16(o[2], o[3]); w.z = cvt_pk_bf16(o[4], o[5]); w.w = cvt_pk_bf16(o[6], o[7]);
        *(u32x4*)(F.P + (size_t)t * 1024 + c8) = w;
    }
}
DI void p4_scan(const Ctx& F, int blk, int nblk) {
    const Tid T = opaque_tid();
    const size_t NT = (size_t)nblk * 512, gt = (size_t)blk * 512 + T.tid;
    for (size_t idx = gt; idx < (size_t)2 * 32 * 2048; idx += NT) {
        const int e4 = (int)(idx & 2047), bh = (int)(idx >> 11) & 31, dir = (int)(idx >> 16);
        const float g = exp2f(log2_gamma(F.decay_logit, dir, bh & 7) * 128.f);
        const u32x2* kv = (const u32x2*)(F.KV + ((size_t)(dir * 32 + bh) * 32) * 8192) + e4;
        u32x2* st = (u32x2*)(F.ST + ((size_t)(dir * 32 + bh) * 32) * 8192) + e4;
        float s0 = 0.f, s1 = 0.f, s2 = 0.f, s3 = 0.f;
        u32x2 v[32];
#pragma unroll
        for (int i = 0; i < 32; ++i) v[i] = kv[(size_t)(dir == 0 ? i : 31 - i) * 2048];
#pragma unroll
        for (int i = 0; i < 32; ++i) { const int c = dir == 0 ? i : 31 - i;
            u32x2 o; o.x = cvt_pk_bf16(s0, s1); o.y = cvt_pk_bf16(s2, s3); st[(size_t)c * 2048] = o;
            s0 = g * s0 + bflo(v[i].x); s1 = g * s1 + bfhi(v[i].x); s2 = g * s2 + bflo(v[i].y); s3 = g * s3 + bfhi(v[i].y); }
    }
}
DI void n4_recurrence(const Ctx& F) {
    const Tid T = opaque_tid();
    const int gw = blockIdx.x * 8 + T.wave, NGW = gridDim.x * 8, d = T.lane;
    for (int task = gw; task < 32 * 128; task += NGW) {
        const int bh = task >> 7, v = task & 127, b = bh >> 3, h = bh & 7;
        const float gf = exp2f(log2_gamma(F.decay_logit, 0, h)), gb = exp2f(log2_gamma(F.decay_logit, 1, h));
        float s = 0.f;
        for (int m = 0; m < CTXL; ++m) { const size_t t = (size_t)b * CTXL + m; s = gf * s + bf2f(F.KC[t * 512 + h * 64 + d]) * bf2f(F.VC[t * 1024 + h * 128 + v]); }
        const float sF = s; s = 0.f;
        for (int m = CTXL - 1; m >= 0; --m) { const size_t t = (size_t)b * CTXL + m; s = gb * s + bf2f(F.KC[t * 512 + h * 64 + d]) * bf2f(F.VC[t * 1024 + h * 128 + v]); }
        const float sB = s;
        s = sF;
        for (int n = 0; n < SEQ; ++n) { const size_t t = (size_t)b * SEQ + n; s = gf * s + bf2f(F.K[t * 512 + h * 64 + d]) * bf2f(F.V[t * 1024 + h * 128 + v]);
            const float o = wave_sum(bf2f(F.Q[t * 512 + h * 64 + d]) * s); if (d == 0) F.RET[t * 1024 + h * 128 + v] = o; }
        s = sB;
        for (int n = SEQ - 1; n >= 0; --n) { const size_t t = (size_t)b * SEQ + n; s = gb * s + bf2f(F.K[t * 512 + h * 64 + d]) * bf2f(F.V[t * 1024 + h * 128 + v]);
            const float o = wave_sum(bf2f(F.Q[t * 512 + h * 64 + d]) * s); if (d == 0) F.RET[t * 1024 + h * 128 + v] += o; }
    }
}
DI void n5_groupnorm(const Ctx& F) {
    const Tid T = opaque_tid();
    const int gw = blockIdx.x * 8 + T.wave, NGW = gridDim.x * 8;
    for (int task = gw; task < MTOK * NH; task += NGW) {
        const int t = task >> 3, h = task & 7; const size_t o = (size_t)t * 1024 + h * 128 + 2 * T.lane;
        const float a = F.RET[o], b = F.RET[o + 1];
        const float mu = wave_sum(a + b) * (1.f / 128.f); const float da = a - mu, db = b - mu;
        const float var = wave_sum(da * da + db * db) * (1.f / 128.f); const float rstd = 1.0f / sqrtf(var + EPS);
        const float ra = da * rstd * F.gn_w[h * 128 + 2 * T.lane], rb = db * rstd * F.gn_w[h * 128 + 2 * T.lane + 1];
        *(unsigned*)(F.UB + o) = cvt_pk_bf16(siluf(bf2f(F.SZB[o])) * ra, siluf(bf2f(F.SZB[o + 1])) * rb);
    }
}
DI void p5_ret(const Ctx& F) {
    const Tid T = opaque_tid();
    LAS unsigned char* KI = F.lds; LAS unsigned char* VI = F.lds + 20480; LAS unsigned char* SF = F.lds + 57344; LAS unsigned char* SB = F.lds + 75776;
    LAS unsigned char* S0F = F.lds + 94208; LAS unsigned char* S0B = F.lds + 110592;
    const int tid = T.tid, lane = T.lane, w = T.wave, g = lane >> 4, q = (lane & 15) >> 2, p = lane & 3, l15 = lane & 15;
    const int row = tid >> 2, seg = tid & 3, il = 16 * w + l15;
    for (int base = blockIdx.x * 4; base < 1024; base += gridDim.x * 4) {
        const int bh = base >> 5, h = bh & 7;
        const float l2f = log2_gamma(F.decay_logit, 0, h), l2b = log2_gamma(F.decay_logit, 1, h);
        { const float* s0f = F.S0 + (size_t)(0 * 32 + bh) * 8192 + row * 64 + seg * 16; const float* s0b = F.S0 + (size_t)(1 * 32 + bh) * 8192 + row * 64 + seg * 16;
#pragma unroll
            for (int i = 0; i < 2; ++i) { const f32x4 a0 = *(const f32x4*)(s0f + 8 * i), a1 = *(const f32x4*)(s0f + 8 * i + 4), b0 = *(const f32x4*)(s0b + 8 * i), b1 = *(const f32x4*)(s0b + 8 * i + 4);
                u32x4 x, y; x.x = cvt_pk_bf16(a0.x, a0.y); x.y = cvt_pk_bf16(a0.z, a0.w); x.z = cvt_pk_bf16(a1.x, a1.y); x.w = cvt_pk_bf16(a1.z, a1.w);
                y.x = cvt_pk_bf16(b0.x, b0.y); y.y = cvt_pk_bf16(b0.z, b0.w); y.z = cvt_pk_bf16(b1.x, b1.y); y.w = cvt_pk_bf16(b1.z, b1.w);
                *(LAS u32x4*)(S0F + row * 128 + seg * 32 + 16 * i) = x; *(LAS u32x4*)(S0B + row * 128 + seg * 32 + 16 * i) = y; } }
        u32x4 pk[2], pv[4], pf0[2], pb0[2]; bf16x8 pq[2];
        auto prefetch = [&](int it) { const int c = it & 31; const size_t tok0 = (size_t)(bh >> 3) * SEQ + c * CHK;
            const bf16_t* kp = F.K + tok0 * 512 + h * 64; const bf16_t* vp = F.V + tok0 * 1024 + h * 128; const bf16_t* qp = F.Q + tok0 * 512 + h * 64;
            const bf16_t* stf = F.ST + ((size_t)(0 * 32 + bh) * 32 + c) * 8192; const bf16_t* stb = F.ST + ((size_t)(1 * 32 + bh) * 32 + c) * 8192;
#pragma unroll
            for (int i = 0; i < 2; ++i) { pk[i] = *(const u32x4*)(kp + (size_t)row * 512 + seg * 16 + 8 * i); pf0[i] = *(const u32x4*)(stf + row * 64 + seg * 16 + 8 * i); pb0[i] = *(const u32x4*)(stb + row * 64 + seg * 16 + 8 * i);
                pq[i] = *(const bf16x8*)(qp + (size_t)il * 512 + 32 * i + 8 * g); }
#pragma unroll
            for (int i = 0; i < 4; ++i) pv[i] = *(const u32x4*)(vp + (size_t)row * 1024 + seg * 32 + 8 * i); };
        prefetch(base);
        for (int k = 0; k < 4; ++k) {
            const int it = base + k, c = it & 31; const size_t tok0 = (size_t)(bh >> 3) * SEQ + c * CHK;
            { const float cf = __builtin_amdgcn_exp2f(l2f * 128.f * (float)c), cb = __builtin_amdgcn_exp2f(l2b * 128.f * (float)(31 - c));
#pragma unroll
                for (int i = 0; i < 2; ++i) { *(LAS u32x4*)(KI + row * 160 + seg * 32 + 16 * i) = pk[i];
                    const u32x4 x = *(const LAS u32x4*)(S0F + row * 128 + seg * 32 + 16 * i), y = *(const LAS u32x4*)(S0B + row * 128 + seg * 32 + 16 * i);
                    u32x4 of, ob;
#pragma unroll
                    for (int e = 0; e < 4; ++e) { of[e] = cvt_pk_bf16(bflo(pf0[i][e]) + cf * bflo(x[e]), bfhi(pf0[i][e]) + cf * bfhi(x[e])); ob[e] = cvt_pk_bf16(bflo(pb0[i][e]) + cb * bflo(y[e]), bfhi(pb0[i][e]) + cb * bfhi(y[e])); }
#pragma unroll
                    for (int jj = 0; jj < 2; ++jj) { const int vv = 16 * (tid >> 6) + 4 * (tid & 3) + 2 * i + jj, dd = 16 * ((tid >> 4) & 3) + 4 * ((tid & 15) >> 2);
                        *(LAS u32x2*)(SF + vv * 144 + dd * 2) = (u32x2){of[2 * jj], of[2 * jj + 1]}; *(LAS u32x2*)(SB + vv * 144 + dd * 2) = (u32x2){ob[2 * jj], ob[2 * jj + 1]}; } }
#pragma unroll
                for (int i = 0; i < 4; ++i) *(LAS u32x4*)(VI + row * 288 + seg * 64 + 16 * i) = pv[i]; }
            bf16x8 qf[2]; qf[0] = pq[0]; qf[1] = pq[1];
            __syncthreads();
            if (k < 3) prefetch(it + 1);
            f32x4 accS[8];
#pragma unroll
            for (int jb = 0; jb < 8; ++jb) { accS[jb] = (f32x4){0.f, 0.f, 0.f, 0.f};
#pragma unroll
                for (int ks = 0; ks < 2; ++ks) { const bf16x8 kf = *(const LAS bf16x8*)(KI + (16 * jb + l15) * 160 + (32 * ks + 8 * g) * 2);
                    accS[jb] = __builtin_amdgcn_mfma_f32_16x16x32_bf16(kf, qf[ks], accS[jb], 0, 0, 0); } }
            bf16x8 pf[4];
#pragma unroll
            for (int s2 = 0; s2 < 4; ++s2) { float pe[8];
#pragma unroll
                for (int e = 0; e < 8; ++e) { const int jb = 2 * s2 + (e >> 2), r = e & 3, j = 16 * jb + 4 * g + r, df = il - j;
                    float mk = __builtin_amdgcn_exp2f((df >= 0 ? l2f : -l2b) * (float)df); if (df == 0) mk = 2.f;
                    pe[e] = accS[jb][r] * mk; }
                u32x4 pw; pw.x = cvt_pk_bf16(pe[0], pe[1]); pw.y = cvt_pk_bf16(pe[2], pe[3]); pw.z = cvt_pk_bf16(pe[4], pe[5]); pw.w = cvt_pk_bf16(pe[6], pe[7]);
                pf[s2] = __builtin_bit_cast(bf16x8, pw); }
            const float decf = __builtin_amdgcn_exp2f(l2f * (float)(il + 1)), decb = __builtin_amdgcn_exp2f(l2b * (float)(128 - il));
            f32x4 accO[8];
#pragma unroll
            for (int vb = 0; vb < 8; ++vb) { f32x4 o = (f32x4){0.f, 0.f, 0.f, 0.f};
#pragma unroll
                for (int s2 = 0; s2 < 4; ++s2) { const bf16x8 vf = tr2(VI + (32 * s2 + 4 * g + q) * 288 + (16 * vb + 4 * p) * 2, 16 * 288);
                    o = __builtin_amdgcn_mfma_f32_16x16x32_bf16(vf, pf[s2], o, 0, 0, 0); }
                f32x4 tf = (f32x4){0.f, 0.f, 0.f, 0.f}, tb = (f32x4){0.f, 0.f, 0.f, 0.f};
#pragma unroll
                for (int ks = 0; ks < 2; ++ks) { const bf16x8 sf = *(const LAS bf16x8*)(SF + (16 * vb + l15) * 144 + (32 * ks + 8 * g) * 2);
                    const bf16x8 sb = *(const LAS bf16x8*)(SB + (16 * vb + l15) * 144 + (32 * ks + 8 * g) * 2);
                    tf = __builtin_amdgcn_mfma_f32_16x16x32_bf16(sf, qf[ks], tf, 0, 0, 0); tb = __builtin_amdgcn_mfma_f32_16x16x32_bf16(sb, qf[ks], tb, 0, 0, 0); }
                accO[vb] = o + tf * decf + tb * decb; __builtin_amdgcn_sched_barrier(0); }
            float sm = 0.f;
#pragma unroll
            for (int vb = 0; vb < 8; ++vb) sm += (accO[vb].x + accO[vb].y) + (accO[vb].z + accO[vb].w);
            sm += __shfl_xor(sm, 16); sm += __shfl_xor(sm, 32);
            const float mu = sm * (1.f / 128.f); float sq = 0.f;
#pragma unroll
            for (int vb = 0; vb < 8; ++vb) { accO[vb] = accO[vb] - mu; sq += (accO[vb].x * accO[vb].x + accO[vb].y * accO[vb].y) + (accO[vb].z * accO[vb].z + accO[vb].w * accO[vb].w); }
            sq += __shfl_xor(sq, 16); sq += __shfl_xor(sq, 32);
            const float rstd = 1.0f / sqrtf(sq * (1.f / 128.f) + EPS);
            __syncthreads();
#pragma unroll
            for (int vb = 0; vb < 8; ++vb) { const f32x4 gw = *(const f32x4*)(F.gn_w + h * 128 + 16 * vb + 4 * g); const f32x4 o = accO[vb] * rstd * gw;
                u32x2 ow; ow.x = cvt_pk_bf16(o.x, o.y); ow.y = cvt_pk_bf16(o.z, o.w);
                *(LAS u32x2*)(VI + il * 288 + (16 * vb + 4 * g) * 2) = ow; }
            __syncthreads();
            { const size_t go = (tok0 + row) * 1024 + h * 128 + seg * 32;
#pragma unroll
                for (int i = 0; i < 4; ++i) { const u32x4 o = *(const LAS u32x4*)(VI + row * 288 + seg * 64 + 16 * i); const u32x4 z = *(const u32x4*)(F.SZB + go + 8 * i);
                    u32x4 r;
#pragma unroll
                    for (int e = 0; e < 4; ++e) r[e] = cvt_pk_bf16(bflo(o[e]) * siluf(bflo(z[e])), bfhi(o[e]) * siluf(bfhi(z[e])));
                    *(u32x4*)(F.UB + go + 8 * i) = r; } }
            __syncthreads();
        }
    }
}
struct SchedSq { int G, c; DI bool next(int i, pg8::Unit& u) const { const int L = i * G + c; if (L >= 256) return false; pg8::tile_of(L, 64, 4, u); return true; } };
struct EpiAB {
    const bf16_t* R; const bf16_t* SGB; bf16_t* MM;
    DI int vm_ops(const pg8::Unit&) const { return 0; }
    DI void mid(f32x4 (&acc)[2][2][4][2], const pg8::Unit& u, int wr, int wc, int fr, int fq) const { apply<false>(acc, u, wr, wc, fr, fq); }
    DI void operator()(const f32x4 (&acc)[2][2][4][2], const pg8::Unit& u, int wr, int wc, int fr, int fq) const { apply<true>(const_cast<f32x4 (&)[2][2][4][2]>(acc), u, wr, wc, fr, fq); }
    template <bool FIN> DI void apply(f32x4 (&acc)[2][2][4][2], const pg8::Unit& u, int wr, int wc, int fr, int fq) const {
        const bf16_t* src = FIN ? SGB : R;
        const size_t base = (size_t)(u.pm * 256 + wr * 64 + fr) * 1024 + u.pn * 256 + wc * 32 + 8 * fq;
#pragma unroll
        for (int am = 0; am < 4; ++am) { const int ai = am >> 1;
            u32x4 gv[4][2];
#pragma unroll
            for (int m = 2 * (am & 1); m < 2 * (am & 1) + 2; ++m)
#pragma unroll
                for (int bj = 0; bj < 2; ++bj) gv[m][bj] = __builtin_nontemporal_load((const u32x4*)(src + gate_block(u.pm, 2 * u.pn + bj, wr, wc, ai, m) + (size_t)(fq * 16 + fr) * 8));
#pragma unroll
            for (int m = 2 * (am & 1); m < 2 * (am & 1) + 2; ++m)
#pragma unroll
                for (int bj = 0; bj < 2; ++bj) { const u32x4 gq = gv[m][bj];
                    f32x4 a = acc[ai][bj][m][0], b = acc[ai][bj][m][1];
                    a.x *= bflo(gq.x); a.y *= bfhi(gq.x); a.z *= bflo(gq.y); a.w *= bfhi(gq.y); b.x *= bflo(gq.z); b.y *= bfhi(gq.z); b.z *= bflo(gq.w); b.w *= bfhi(gq.w);
                    if (FIN) { u32x4 w; w.x = cvt_pk_bf16(a.x, a.y); w.y = cvt_pk_bf16(a.z, a.w); w.z = cvt_pk_bf16(b.x, b.y); w.w = cvt_pk_bf16(b.z, b.w);
                        *(u32x4*)(MM + base + (size_t)(ai * 128 + m * 16) * 1024 + bj * 128) = w; }
                    else { acc[ai][bj][m][0] = a; acc[ai][bj][m][1] = b; } }
            asm volatile("" ::: "memory");
        }
    }
};
struct EpiOut {
    const float* x; const float* MOD; float* out;
    DI int vm_ops(const pg8::Unit&) const { return 0; }
    DI void mid(f32x4 (&)[2][2][4][2], const pg8::Unit&, int, int, int, int) const {}
    DI void operator()(const f32x4 (&acc)[2][2][4][2], const pg8::Unit& u, int wr, int wc, int fr, int fq) const {
        const int col0 = u.pn * 256 + wc * 32 + 8 * fq; const float* gp = MOD + (u.pm >> 4) * 3072 + 2048 + col0;
        f32x4 gx[2][2];
#pragma unroll
        for (int bj = 0; bj < 2; ++bj)
#pragma unroll
            for (int n = 0; n < 2; ++n) gx[bj][n] = *(const f32x4*)(gp + bj * 128 + 4 * n);
#pragma unroll
        for (int ai = 0; ai < 2; ++ai)
#pragma unroll
            for (int m = 0; m < 4; ++m) { const size_t off = (size_t)(u.pm * 256 + ai * 128 + wr * 64 + m * 16 + fr) * 1024 + col0;
#pragma unroll
                for (int bj = 0; bj < 2; ++bj)
#pragma unroll
                    for (int n = 0; n < 2; ++n) { const f32x4 xv = *(const f32x4*)(x + off + bj * 128 + 4 * n); *(f32x4*)(out + off + bj * 128 + 4 * n) = xv + gx[bj][n] * acc[ai][bj][m][n]; }
                if (m & 1) asm volatile("" ::: "memory"); }
    }
};
struct EpiOutNorm {
    const float* x; const float* MOD; float* out; const float* fw; float* slots; unsigned* cnt; LAS float* tab;
    DI int vm_ops(const pg8::Unit&) const { return 0; }
    DI void mid(f32x4 (&)[2][2][4][2], const pg8::Unit&, int, int, int, int) const {}
    DI void operator()(const f32x4 (&acc_)[2][2][4][2], const pg8::Unit& u, int wr, int wc, int fr, int fq) const {
        f32x4 (&acc)[2][2][4][2] = const_cast<f32x4 (&)[2][2][4][2]>(acc_);
        const int col0 = u.pn * 256 + wc * 32 + 8 * fq; const float* gp = MOD + (u.pm >> 4) * 3072 + 2048 + col0;
        f32x4 gx[2][2];
#pragma unroll
        for (int bj = 0; bj < 2; ++bj)
#pragma unroll
            for (int n = 0; n < 2; ++n) gx[bj][n] = *(const f32x4*)(gp + bj * 128 + 4 * n);
#pragma unroll
        for (int ai = 0; ai < 2; ++ai)
#pragma unroll
            for (int m = 0; m < 4; ++m) { const int row = u.pm * 256 + ai * 128 + wr * 64 + m * 16 + fr; const size_t off = (size_t)row * 1024 + col0; float ss = 0.f;
#pragma unroll
                for (int bj = 0; bj < 2; ++bj)
#pragma unroll
                    for (int n = 0; n < 2; ++n) { const f32x4 xv = *(const f32x4*)(x + off + bj * 128 + 4 * n); const f32x4 v = xv + gx[bj][n] * acc[ai][bj][m][n]; acc[ai][bj][m][n] = v;
                        ss += (v.x * v.x + v.y * v.y) + (v.z * v.z + v.w * v.w); }
                ss += __shfl_xor(ss, 16); ss += __shfl_xor(ss, 32);
                if (fq == 0) __hip_atomic_store(slots + (size_t)row * 16 + u.pn * 4 + wc, ss, __ATOMIC_RELAXED, __HIP_MEMORY_SCOPE_AGENT);
                if (m & 1) asm volatile("" ::: "memory"); }
        asm volatile("s_waitcnt vmcnt(0)" ::: "memory");
        __syncthreads();
        if (threadIdx.x == 0) {
            unsigned* c = cnt + 64 * u.pm;
            __hip_atomic_fetch_add(c, 1u, __ATOMIC_RELAXED, __HIP_MEMORY_SCOPE_AGENT);
            unsigned sp = 0;
            while (__hip_atomic_load(c, __ATOMIC_RELAXED, __HIP_MEMORY_SCOPE_AGENT) < 4u) { __builtin_amdgcn_s_sleep(1); if (++sp > (1u << 22)) break; }
            __builtin_amdgcn_fence(__ATOMIC_ACQUIRE, "agent");
            asm volatile("s_waitcnt vmcnt(0)" ::: "memory");
        }
        __syncthreads();
        { const int t = threadIdx.x, row = t >> 1, half = t & 1; const float* sp = slots + (size_t)(u.pm * 256 + row) * 16 + half * 8; float s = 0.f;
#pragma unroll
            for (int j = 0; j < 8; ++j) s += __hip_atomic_load(sp + j, __ATOMIC_RELAXED, __HIP_MEMORY_SCOPE_AGENT);
            s += __shfl_xor(s, 1);
            if (half == 0) tab[row] = 1.0f / sqrtf(s * (1.f / 1024.f) + EPS); }
        __syncthreads();
        f32x4 fv[2][2];
#pragma unroll
        for (int bj = 0; bj < 2; ++bj)
#pragma unroll
            for (int n = 0; n < 2; ++n) fv[bj][n] = *(const f32x4*)(fw + col0 + bj * 128 + 4 * n);
#pragma unroll
        for (int ai = 0; ai < 2; ++ai)
#pragma unroll
            for (int m = 0; m < 4; ++m) { const int rl = ai * 128 + wr * 64 + m * 16 + fr; const float r = tab[rl]; const size_t off = (size_t)(u.pm * 256 + rl) * 1024 + col0;
#pragma unroll
                for (int bj = 0; bj < 2; ++bj)
#pragma unroll
                    for (int n = 0; n < 2; ++n) *(f32x4*)(out + off + bj * 128 + 4 * n) = acc[ai][bj][m][n] * r * fv[bj][n]; }
    }
};
DI void n6_ab(const Ctx& F) {
    const Tid T = opaque_tid();
    const size_t NT = (size_t)gridDim.x * 512, gt = (size_t)blockIdx.x * 512 + T.tid;
    for (size_t idx = gt; idx < (size_t)(MTOK / 4) * 1024; idx += NT) {
        const int n = (int)(idx & 1023), t0 = (int)(idx >> 10) * 4; float ya[4] = {0.f, 0.f, 0.f, 0.f}, yb[4] = {0.f, 0.f, 0.f, 0.f};
        for (int k = 0; k < 1024; ++k) { const float wa = F.w_a[(size_t)k * 1024 + n], wb = F.w_b[(size_t)k * 1024 + n];
#pragma unroll
            for (int j = 0; j < 4; ++j) { ya[j] += bf2f(F.P[(size_t)(t0 + j) * 1024 + k]) * wa; yb[j] += bf2f(F.UB[(size_t)(t0 + j) * 1024 + k]) * wb; } }
#pragma unroll
        for (int j = 0; j < 4; ++j) { const size_t o = (size_t)(t0 + j) * 1024 + n; const size_t gi = gate_index(t0 + j, n); const float sgb = bf2f(F.SGB[gi]), sga = bf2f(F.R[gi]) * sgb; F.MM[o] = f2bf(sga * ya[j] + sgb * yb[j]); }
    }
}
DI void n7_out(const Ctx& F) {
    const Tid T = opaque_tid();
    const size_t NT = (size_t)gridDim.x * 512, gt = (size_t)blockIdx.x * 512 + T.tid;
    for (size_t idx = gt; idx < (size_t)(MTOK / 4) * 1024; idx += NT) {
        const int n = (int)(idx & 1023), t0 = (int)(idx >> 10) * 4; float y[4] = {0.f, 0.f, 0.f, 0.f};
        for (int k = 0; k < 1024; ++k) { const float w = F.w_out[(size_t)k * 1024 + n];
#pragma unroll
            for (int j = 0; j < 4; ++j) y[j] += bf2f(F.MM[(size_t)(t0 + j) * 1024 + k]) * w; }
#pragma unroll
        for (int j = 0; j < 4; ++j) { const size_t o = (size_t)(t0 + j) * 1024 + n; F.out[o] = F.x[o] + F.MOD[((t0 + j) >> 12) * 3072 + 2048 + n] * y[j]; }
    }
}
DI void p8_final(const Ctx& F) {
    const Tid T = opaque_tid();
    const int gw = blockIdx.x * 8 + T.wave, NGW = gridDim.x * 8;
    for (int m = gw; m < MTOK; m += NGW) {
        f32x4* xr = (f32x4*)(F.out + (size_t)m * DM);
        f32x4 v[4]; float ss = 0.f;
#pragma unroll
        for (int j = 0; j < 4; ++j) { v[j] = xr[T.lane + 64 * j]; ss += (v[j].x * v[j].x + v[j].y * v[j].y) + (v[j].z * v[j].z + v[j].w * v[j].w); }
        const float rstd = 1.0f / sqrtf(wave_sum(ss) * (1.f / DM) + EPS);
#pragma unroll
        for (int j = 0; j < 4; ++j) { const f32x4 w = *(const f32x4*)(F.final_w + 4 * (T.lane + 64 * j)); xr[T.lane + 64 * j] = v[j] * rstd * w; }
    }
}

constexpr int NPH = 9;
__global__ void __launch_bounds__(512, 2) fwd_kernel(Args args) {
    extern __shared__ __attribute__((aligned(16))) unsigned char lds_raw[];
    Ctx F;
    F.lds = (LAS unsigned char*)lds_raw;
    if (threadIdx.x < 16) ((LAS unsigned*)(F.lds + LDS_MISC))[threadIdx.x] = 0u;
#if !MK_LAUNCH_PER_PHASE
    {
        unsigned* flag = (unsigned*)(args.ws + WS_FLAG); unsigned* done = flag + 64;
        if (blockIdx.x == 0) {
            for (unsigned i = threadIdx.x; i < WS_BAR_BYTES / 16; i += 512) ((u32x4*)(args.ws + WS_BAR))[i] = (u32x4){0u, 0u, 0u, 0u};
            if (threadIdx.x == 0) __hip_atomic_store(done, 0u, __ATOMIC_RELAXED, __HIP_MEMORY_SCOPE_AGENT);
            asm volatile("s_waitcnt vmcnt(0)" ::: "memory");
            __syncthreads();
            if (threadIdx.x == 0) { __builtin_amdgcn_fence(__ATOMIC_RELEASE, "agent"); asm volatile("s_waitcnt vmcnt(0)" ::: "memory");
                __hip_atomic_store(flag, CTL_MAGIC, __ATOMIC_RELAXED, __HIP_MEMORY_SCOPE_AGENT); }
        } else if (threadIdx.x == 0) {
            unsigned sp = 0;
            while (__hip_atomic_load(flag, __ATOMIC_RELAXED, __HIP_MEMORY_SCOPE_AGENT) != CTL_MAGIC) { __builtin_amdgcn_s_sleep(1); if (++sp > (1u << 22)) break; }
            __builtin_amdgcn_fence(__ATOMIC_ACQUIRE, "agent"); asm volatile("s_waitcnt vmcnt(0)" ::: "memory");
        }
    }
#endif
    __syncthreads();
    const XcdBarrier bar = xcd_barrier_post((unsigned*)(args.ws + WS_BAR), (volatile LAS unsigned*)(F.lds + LDS_MISC));
    F.x = args.in[0]; F.c = args.in[1]; F.ctx = args.in[2]; F.c_ctx = args.in[3]; F.norm_w = args.in[4]; F.ada_w = args.in[5]; F.ada_b = args.in[6]; F.w_in = args.in[7];
    F.conv_w = args.in[8]; F.conv_b = args.in[9]; F.decay_logit = args.in[10]; F.gn_w = args.in[11]; F.w_a = args.in[12]; F.w_b = args.in[13]; F.w_out = args.in[14]; F.final_w = args.in[15];
    F.out = args.out; unsigned char* ws = args.ws; F.ws = ws;
    F.MOD = (float*)(ws + WS_MOD); F.ROPE = (f32x2*)(ws + WS_ROPE);
    F.WA = (bf16_t*)(ws + WS_WA); F.WB = (bf16_t*)(ws + WS_WB); F.WOUT = (bf16_t*)(ws + WS_WOUT); F.WIN = (bf16_t*)(ws + WS_WIN); F.XM = (bf16_t*)(ws + WS_XM);
    F.KV = (bf16_t*)(ws + WS_KV); F.KVC = (bf16_t*)(ws + WS_KVC); F.HC = (bf16_t*)(ws + WS_HC); F.ST = (bf16_t*)(ws + WS_ST); F.MM = (bf16_t*)(ws + WS_MM);
    F.P = (bf16_t*)(ws + WS_P); F.Q = (bf16_t*)(ws + WS_Q); F.K = (bf16_t*)(ws + WS_K); F.V = (bf16_t*)(ws + WS_V); F.SZB = (bf16_t*)(ws + WS_SZB);
    F.KC = (bf16_t*)(ws + WS_KC); F.VC = (bf16_t*)(ws + WS_VC); F.UB = (bf16_t*)(ws + WS_UB);
    F.R = (bf16_t*)args.out; F.SGB = (bf16_t*)args.out + (size_t)MTOK * DM;
    F.RET = (float*)(ws + WS_RET); F.S0 = (float*)(ws + WS_KVC);
    const int lo = args.ph_lo, hi = args.ph_hi; const unsigned naive = args.naive;
#define IN(k) (lo <= (k) && (k) < hi && ((MK_PHASES >> (k)) & 1))
#define NAIVE(k) (((naive & MK_NAIVE_AVAIL) >> (k)) & 1u)
#define SEAM(k) do { if (IN(k) && IN((k) + 1)) xcd_barrier(bar); } while (0)
#define REP(k) for (int rep_ = 0; rep_ < 1 + (int)((MK_REP_MASK >> (k)) & 1u); ++rep_)
    if (IN(0)) REP(0) { p0_prologue(F); } SEAM(0);
    if (IN(1)) REP(1) { p1_rows(F); } SEAM(1);
    if (IN(2)) REP(2) {
        if (NAIVE(2)) n2_inproj(F);
        else { const char* const Ab[2] = {(const char*)F.XM, (const char*)F.XM}; const char* const Bb[2] = {(const char*)F.WIN, (const char*)F.WIN};
            Sched1 S{(int)gridDim.x, (int)blockIdx.x}; Epi1 E{F.ws, F.R, F.SGB, F.ROPE};
            pg8::gemm_phase<1, Epi1, Sched1>(F.lds, Ab, Bb, S, E); }
    } SEAM(2);
    if (IN(3)) {
        if (!NAIVE(3)) {
            const char* const Ab[2] = {(const char*)F.XM, (const char*)F.XM}; const char* const Bb[2] = {(const char*)F.WIN, (const char*)F.WIN};
            SchedCtx S{(int)blockIdx.x}; Epi1 E{F.ws, F.R, F.SGB, F.ROPE};
            pg8::gemm_phase<1, Epi1, SchedCtx>(F.lds, Ab, Bb, S, E);
            if (blockIdx.x >= 24) { REP(3) p3_kv(F, blockIdx.x - 24, 1024, gridDim.x - 24); p3_ua(F, blockIdx.x - 24, gridDim.x - 24); }
        } else p3_ua(F, blockIdx.x, gridDim.x);
    } SEAM(3);
    if (IN(4)) REP(4) { if (NAIVE(4)) n4_recurrence(F); else { if (blockIdx.x >= gridDim.x - 32) p4_ctx_state(F, blockIdx.x - (gridDim.x - 32)); else p4_scan(F, blockIdx.x, gridDim.x - 32); } } SEAM(4);
    if (IN(5)) REP(5) { if (NAIVE(5)) n5_groupnorm(F); else p5_ret(F); } SEAM(5);
    if (IN(6)) REP(6) {
        if (NAIVE(6)) n6_ab(F);
        else { const char* const Ab[2] = {(const char*)F.P, (const char*)F.UB}; const char* const Bb[2] = {(const char*)F.WA, (const char*)F.WB};
            SchedSq S{(int)gridDim.x, (int)blockIdx.x}; EpiAB E{F.R, F.SGB, F.MM};
            pg8::gemm_phase<2, EpiAB, SchedSq>(F.lds, Ab, Bb, S, E); }
    } SEAM(6);
    if (IN(7)) {
        const char* const Ab[2] = {(const char*)F.MM, (const char*)F.MM}; const char* const Bb[2] = {(const char*)F.WOUT, (const char*)F.WOUT};
        SchedSq S{(int)gridDim.x, (int)blockIdx.x};
        if (NAIVE(7)) n7_out(F);
        else if (gridDim.x == 256) {
            EpiOutNorm E{F.x, F.MOD, F.out, F.final_w, (float*)(F.ws + WS_SLOTS), (unsigned*)(F.ws + WS_PCNT), (LAS float*)(F.lds + LDS_TAB)};
            pg8::gemm_phase<1, EpiOutNorm, SchedSq>(F.lds, Ab, Bb, S, E); }
        else { EpiOut E{F.x, F.MOD, F.out}; pg8::gemm_phase<1, EpiOut, SchedSq>(F.lds, Ab, Bb, S, E); }
    }
    if (NAIVE(7) || gridDim.x != 256) { SEAM(7); if (IN(8)) { p8_final(F); } }
#if !MK_LAUNCH_PER_PHASE
    __syncthreads();
    if (threadIdx.x == 0) { unsigned* flag = (unsigned*)(args.ws + WS_FLAG); unsigned* done = flag + 64;
        if (__hip_atomic_fetch_add(done, 1u, __ATOMIC_RELAXED, __HIP_MEMORY_SCOPE_AGENT) == gridDim.x - 1) __hip_atomic_store(flag, 0u, __ATOMIC_RELAXED, __HIP_MEMORY_SCOPE_AGENT); }
#endif
#undef IN
#undef NAIVE
#undef SEAM
}

extern "C" void kernel_launch(void* const* d_in, const int* in_sizes, int n_in, void* d_out, int out_size, void* d_ws, size_t ws_size, hipStream_t stream) {
    static int grid = 0;
    if (grid == 0) {
        if (n_in != 16 || out_size != MTOK * DM || ws_size < WS_END) { fprintf(stderr, "kernel_launch: unexpected shapes (n_in %d out %d ws %zu)\n", n_in, out_size, ws_size); grid = -1; return; }
        int dev = 0, cus = 0, per_cu = 0;
        hipGetDevice(&dev); hipDeviceGetAttribute(&cus, hipDeviceAttributeMultiprocessorCount, dev);
        hipFuncSetAttribute((const void*)fwd_kernel, hipFuncAttributeMaxDynamicSharedMemorySize, LDS_BYTES);
        hipOccupancyMaxActiveBlocksPerMultiprocessor(&per_cu, (const void*)fwd_kernel, 512, LDS_BYTES);
        if (per_cu < 1) { fprintf(stderr, "kernel_launch: occupancy query says %d blocks/CU\n", per_cu); per_cu = 1; }
        grid = cus;
        (void)hipGetLastError();
    }
    if (grid < 0) return;
    Args a{};
    for (int i = 0; i < 16; ++i) a.in[i] = (const float*)d_in[i];
    a.out = (float*)d_out; a.ws = (unsigned char*)d_ws; a.naive = MK_NAIVE_MASK;
#if MK_LAUNCH_PER_PHASE
    hipMemsetAsync((unsigned char*)d_ws + WS_BAR, 0, WS_BAR_BYTES, stream);
#endif
#if MK_LAUNCH_PER_PHASE
    for (int ph = 0; ph < NPH; ++ph) { a.ph_lo = ph; a.ph_hi = ph + 1; hipLaunchKernelGGL(fwd_kernel, dim3(grid), dim3(512), LDS_BYTES, stream, a); }
#else
    a.ph_lo = 0; a.ph_hi = NPH;
    hipLaunchKernelGGL(fwd_kernel, dim3(grid), dim3(512), LDS_BYTES, stream, a);
#endif
}
```

```cpp
#include <hip/hip_runtime.h>
#include <cstdio>
#include <cstdint>

#ifndef MK_LAUNCH_PER_PHASE
#define MK_LAUNCH_PER_PHASE 0
#endif
#ifndef MK_NAIVE_MASK
#define MK_NAIVE_MASK 0x00u
#endif

#ifndef MK_REP_MASK
#define MK_REP_MASK 0u
#endif
#ifndef MK_PHASES
#define MK_PHASES 0x1ff
#endif
#ifndef MK_NAIVE_AVAIL
#define MK_NAIVE_AVAIL 0xffu
#endif
#define DI __device__ __forceinline__
#define LAS __attribute__((address_space(3)))
typedef unsigned short bf16_t;
typedef float f32x4 __attribute__((ext_vector_type(4)));
typedef float f32x2 __attribute__((ext_vector_type(2)));
typedef unsigned u32x4 __attribute__((ext_vector_type(4)));
typedef unsigned u32x2 __attribute__((ext_vector_type(2)));
typedef short bf16x8 __attribute__((ext_vector_type(8)));
typedef short s16x4 __attribute__((ext_vector_type(4)));
typedef short v4i16_t __attribute__((ext_vector_type(4)));

constexpr int NB = 4, SEQ = 4096, DM = 1024, MTOK = NB * SEQ, CTXL = 256, MCTX = NB * CTXL, MALL = MTOK + MCTX;
constexpr int NIN = 9216, NH = 8, DK = 64, DV = 128, CHK = 128, NCHK = SEQ / CHK;
constexpr float EPS = 1e-6f;
constexpr size_t MiB = 1u << 20;
constexpr size_t WS_MOD = 0;
constexpr size_t WS_ROPE = 65536;
constexpr size_t WS_WA = 2 * MiB, WS_WB = 4 * MiB, WS_WOUT = 6 * MiB, WS_WIN = 8 * MiB;
constexpr size_t WS_XM = 26 * MiB;
constexpr size_t WS_KV = 223 * MiB;
constexpr size_t WS_KVC = 40 * MiB;
constexpr size_t WS_RET = 8 * MiB;
constexpr size_t WS_HC = 60 * MiB;
constexpr size_t WS_ST = 60 * MiB;
constexpr size_t WS_MM = 60 * MiB;
constexpr size_t WS_P = 92 * MiB;
constexpr size_t WS_Q = 124 * MiB, WS_K = 140 * MiB, WS_V = 156 * MiB, WS_SZB = 188 * MiB;
constexpr size_t WS_KC = 220 * MiB, WS_VC = 221 * MiB;
constexpr size_t WS_UB = 223 * MiB;
constexpr size_t WS_END = 255 * MiB;
constexpr int LDS_BYTES = 147456;
constexpr int LDS_MISC = 139264;
constexpr size_t WS_BAR = 131072, WS_BAR_BYTES = 65536;
constexpr size_t WS_PCNT = WS_BAR + 16384, WS_SLOTS = 1 * MiB;
constexpr size_t WS_FLAG = 98304;
constexpr unsigned CTL_MAGIC = 0x600DF1A6u;
constexpr int LDS_TAB = 132096;

DI float bf2f(bf16_t v) { return __uint_as_float((unsigned)v << 16); }
DI float bflo(unsigned w) { return __uint_as_float(w << 16); }
DI float bfhi(unsigned w) { return __uint_as_float(w & 0xffff0000u); }
typedef __bf16 bf16x2_t __attribute__((ext_vector_type(2)));
DI unsigned cvt_pk_bf16(float lo, float hi) { const f32x2 f = {lo, hi}; const bf16x2_t v = __builtin_convertvector(f, bf16x2_t); return __builtin_bit_cast(unsigned, v); }
DI bf16_t f2bf(float f) { return (bf16_t)(cvt_pk_bf16(f, 0.f) & 0xffffu); }
DI float wave_sum(float v) {
#pragma unroll
    for (int o = 1; o < 64; o <<= 1) v += __shfl_xor(v, o);
    return v;
}
struct Tid { int tid, lane, wave; };
DI Tid opaque_tid() { int t = threadIdx.x; asm volatile("" : "+v"(t)); Tid r; r.tid = t; r.lane = t & 63; r.wave = __builtin_amdgcn_readfirstlane(t >> 6); return r; }
DI float siluf(float x) { return x * __builtin_amdgcn_rcpf(1.f + __expf(-x)); }
DI float log2_gamma(const float* decay_logit, int dir, int h) {
    const float x = decay_logit[dir * NH + h];
    const float ls = fminf(x, 0.f) - log1pf(expf(-fabsf(x)));
    return ls * 1.4426950408889634f;
}

namespace pg8 {
constexpr int BM = 256, BK = 64, HALF = 128, HTB = HALF * BK * 2, STAGE_BYTES = 8 * HTB, NXCD = 8, WGM = 4;
DI int lds_byte(int r, int c) { const int st = (r >> 4) * 2 + (c >> 5), rr = r & 15, cc = c & 31, ob = rr * 64 + cc * 2; return st * 1024 + (ob ^ (((ob >> 9) & 1) << 5)); }
DI void stage_rc(int b, int& R, int& C) { const int st = b / 1024, sb = b % 1024, swz = sb ^ (((sb >> 9) & 1) << 5); R = (st >> 1) * 16 + swz / 64; C = (st & 1) * 32 + (swz % 64) / 2; }
DI int perm32(int rho) { const int n = rho >> 4, i = rho & 15; return 8 * (i >> 2) + 4 * n + (i & 3); }
struct Unit { int pm, pn; };
DI void tile_of(int L, int nM, int nN, Unit& u) {
    const int nwg = nM * nN; int wgid = L;
    { const int q = nwg / NXCD, r = nwg % NXCD, xcd = wgid % NXCD, off = wgid / NXCD; wgid = (xcd < r ? xcd * (q + 1) : r * (q + 1) + (xcd - r) * q) + off; }
    const int nig = WGM * nN, gid = wgid / nig, fm = gid * WGM, gsz = (nM - fm) < WGM ? (nM - fm) : WGM;
    u.pm = fm + ((wgid % nig) % gsz); u.pn = (wgid % nig) / gsz;
}
template <int NSEG, class Epi, class Sched>
DI void gemm_phase(LAS unsigned char* lds, const char* const (&Ab)[2], const char* const (&Bb)[2], const Sched& S, const Epi& E) {
    constexpr int K = 1024, NTS = K / BK;
    constexpr int nt = NSEG * NTS;
    const Tid T = opaque_tid();
    const int tid = T.tid, wid = T.wave, lane = T.lane, wr = wid >> 2, wc = (wid & 3) ^ (wr << 1), fr = lane & 15, fq = lane >> 4;
    unsigned voffA[2], voffB[2];
#pragma unroll
    for (int i = 0; i < 2; ++i) { int R, C; stage_rc(tid * 16 + i * 8192, R, C); const int Rb = (R & ~31) + perm32(R & 31);
        voffA[i] = (unsigned)(R * K + C) * 2u; voffB[i] = (unsigned)(Rb * K + C) * 2u; }
    constexpr size_t kstep = (size_t)(BK * 2);
    constexpr size_t hstep = (size_t)HALF * K * 2;
    constexpr size_t tstep = 2 * hstep;
    const unsigned ldsw = (unsigned)wid * 1024u;
    const int aoff = lds_byte(wr * 64 + fr, fq * 8), boff = lds_byte(wc * 32 + fr, fq * 8);
#define PG8_SA(b, h) (((b) * 2 + (h)) * HTB)
#define PG8_SB(b, h) ((4 + (b) * 2 + (h)) * HTB)
#define PG8_STAGE(bufoff, gbase, voff) do { _Pragma("unroll") for (int _i = 0; _i < 2; ++_i) \
        __builtin_amdgcn_global_load_lds((const unsigned*)((const char*)(gbase) + (voff)[_i]), (LAS unsigned*)(lds + (bufoff) + ldsw + _i * 8192), 16, 0, 0); } while (0)
#define PG8_LDA(dst, b, h) do { _Pragma("unroll") for (int m = 0; m < 4; ++m) _Pragma("unroll") for (int k = 0; k < 2; ++k) dst[m][k] = *(const LAS bf16x8*)(lds + PG8_SA(b, h) + aoff + m * 2048 + k * 1024); } while (0)
#define PG8_LDB(dst, b, h) do { _Pragma("unroll") for (int n = 0; n < 2; ++n) _Pragma("unroll") for (int k = 0; k < 2; ++k) dst[n][k] = *(const LAS bf16x8*)(lds + PG8_SB(b, h) + boff + n * 2048 + k * 1024); } while (0)
#define PG8_MMA(ai, bj, At, Bt) do { __builtin_amdgcn_s_setprio(1); _Pragma("unroll") for (int m = 0; m < 4; ++m) _Pragma("unroll") for (int n = 0; n < 2; ++n) _Pragma("unroll") for (int k = 0; k < 2; ++k) \
        acc[ai][bj][m][n] = __builtin_amdgcn_mfma_f32_16x16x32_bf16(Bt[n][k], At[m][k], acc[ai][bj][m][n], 0, 0, 0); __builtin_amdgcn_s_setprio(0); } while (0)
#define PG8_WAIT_V(n) asm volatile("s_waitcnt vmcnt(" #n ")" ::: "memory")
#define PG8_WAIT_L(n) asm volatile("s_waitcnt lgkmcnt(" #n ")" ::: "memory")
#define PG8_WAIT_VR(sel) asm volatile("s_cmp_lt_i32 %0, 8\n\ts_cbranch_scc1 .Lw8_%=\n\ts_cmp_lt_i32 %0, 16\n\ts_cbranch_scc1 .Lw16_%=\n\ts_waitcnt vmcnt(24)\n\ts_branch .Lwe_%=\n.Lw16_%=:\n\ts_waitcnt vmcnt(16)\n\ts_branch .Lwe_%=\n.Lw8_%=:\n\ts_waitcnt vmcnt(8)\n.Lwe_%=:" :: "s"(sel) : "memory", "scc")
#define PG8_BAR __builtin_amdgcn_s_barrier()
#define PG8_SCHED __builtin_amdgcn_sched_barrier(0)
#define PG8_TA(u, t) (Ab[(t) / NTS] + (size_t)(u).pm * tstep + (size_t)((t) % NTS) * kstep)
#define PG8_TB(u, t) (Bb[(t) / NTS] + (size_t)(u).pn * tstep + (size_t)((t) % NTS) * kstep)
    Unit cur, nxt; int ui = 0;
    if (!S.next(0, cur)) return;
    f32x4 acc[2][2][4][2];
#pragma unroll
    for (int a = 0; a < 2; ++a)
#pragma unroll
        for (int b = 0; b < 2; ++b)
#pragma unroll
            for (int m = 0; m < 4; ++m)
#pragma unroll
                for (int n = 0; n < 2; ++n) acc[a][b][m][n] = (f32x4){0.f, 0.f, 0.f, 0.f};
    bf16x8 At[4][2], B0[2][2], B1[2][2];
    {
        const char* cA = PG8_TA(cur, 0); const char* cB = PG8_TB(cur, 0);
        PG8_STAGE(PG8_SB(0, 0), cB, voffB); PG8_STAGE(PG8_SB(0, 1), cB + hstep, voffB); PG8_STAGE(PG8_SA(0, 0), cA, voffA); PG8_STAGE(PG8_SA(0, 1), cA + hstep, voffA);
        if (wr == 1) PG8_BAR;
        PG8_WAIT_V(2); PG8_BAR;
        PG8_STAGE(PG8_SB(1, 0), cB + kstep, voffB); PG8_STAGE(PG8_SA(1, 0), cA + kstep, voffA); PG8_STAGE(PG8_SB(1, 1), cB + hstep + kstep, voffB);
        PG8_WAIT_V(6); PG8_BAR;
    }
    for (;;) {
        const bool has_next = S.next(ui + 1, nxt);
        const Unit nu = has_next ? nxt : cur;
        for (int t = 0; t < nt; t += 2) {
            if (NSEG == 2 && t == NTS) E.mid(acc, cur, wr, wc, fr, fq);
            const bool last = (t == nt - 2);
            const char* a1 = PG8_TA(cur, t + 1);
            const char* a2 = last ? PG8_TA(nu, 0) : PG8_TA(cur, t + 2); const char* b2 = last ? PG8_TB(nu, 0) : PG8_TB(cur, t + 2);
            const char* a3 = a2 + kstep; const char* b3 = b2 + kstep;
            PG8_LDB(B0, 0, 0); PG8_LDB(B1, 0, 1); PG8_SCHED; PG8_LDA(At, 0, 0); PG8_STAGE(PG8_SA(1, 1), a1 + hstep, voffA);
            PG8_WAIT_V(8); PG8_WAIT_L(0); PG8_BAR; PG8_MMA(0, 0, At, B0); PG8_MMA(0, 1, At, B1); PG8_BAR; PG8_SCHED;
            PG8_LDA(At, 0, 1); PG8_STAGE(PG8_SB(0, 0), b2, voffB); PG8_STAGE(PG8_SB(0, 1), b2 + hstep, voffB); PG8_STAGE(PG8_SA(0, 0), a2, voffA);
            PG8_WAIT_V(8); PG8_WAIT_L(0); PG8_BAR; PG8_MMA(1, 0, At, B0); PG8_MMA(1, 1, At, B1); PG8_BAR; PG8_SCHED;
            PG8_LDB(B0, 1, 0); PG8_LDB(B1, 1, 1); PG8_SCHED; PG8_LDA(At, 1, 0); PG8_STAGE(PG8_SA(0, 1), a2 + hstep, voffA);
            PG8_WAIT_V(8); PG8_WAIT_L(0); PG8_BAR; PG8_MMA(0, 0, At, B0); PG8_MMA(0, 1, At, B1); PG8_BAR; PG8_SCHED;
            PG8_LDA(At, 1, 1); PG8_STAGE(PG8_SB(1, 0), b3, voffB); PG8_STAGE(PG8_SB(1, 1), b3 + hstep, voffB); PG8_STAGE(PG8_SA(1, 0), a3, voffA);
            PG8_WAIT_V(8); PG8_WAIT_L(0); PG8_BAR; PG8_MMA(1, 0, At, B0); PG8_MMA(1, 1, At, B1); PG8_BAR; PG8_SCHED;
        }
        if (wr == 0) PG8_BAR;
        E(acc, cur, wr, wc, fr, fq);
        if (!has_next) break;
#pragma unroll
        for (int a = 0; a < 2; ++a)
#pragma unroll
            for (int b = 0; b < 2; ++b)
#pragma unroll
                for (int m = 0; m < 4; ++m)
#pragma unroll
                    for (int n = 0; n < 2; ++n) acc[a][b][m][n] = (f32x4){0.f, 0.f, 0.f, 0.f};
        cur = nxt; ++ui;
        if (wr == 1) PG8_BAR;
    }
    PG8_WAIT_V(0);
    PG8_BAR;
#undef PG8_SA
#undef PG8_SB
#undef PG8_STAGE
#undef PG8_LDA
#undef PG8_LDB
#undef PG8_MMA
#undef PG8_WAIT_V
#undef PG8_WAIT_L
#undef PG8_WAIT_VR
#undef PG8_BAR
#undef PG8_SCHED
#undef PG8_TA
#undef PG8_TB
}
}


#define XB_TMO      128
#define XB_XCNT(j)  (256  + 64 * (j))
#define XB_XSUB(j)  (1280 + 64 * (j))
#define XB_XGEN(j)  (2304 + 64 * (j))
#define XB_TOP      3328
#define XB_TOPGEN   3392
#define XCD_BAR_WORDS 3456
#define XB_SPIN_CAP (1u << 18)
DI unsigned xb_ld(unsigned* p)              { return __hip_atomic_load(p, __ATOMIC_RELAXED, __HIP_MEMORY_SCOPE_AGENT); }
DI unsigned xb_add(unsigned* p, unsigned v) { return __hip_atomic_fetch_add(p, v, __ATOMIC_RELAXED, __HIP_MEMORY_SCOPE_AGENT); }
DI unsigned xb_xcc_id() { return (unsigned)__builtin_amdgcn_s_getreg((3 << 11) | 20) & 0xFu; }
#define XB_SPIN(cond, bar) do { unsigned _sp = 0; while (cond) { __builtin_amdgcn_s_sleep(1); \
    if ((++_sp & 255u) == 0u) { if (xb_ld(&(bar)[XB_TMO])) break; if (_sp > XB_SPIN_CAP) { atomicAdd(&(bar)[XB_TMO], 1u); break; } } } } while (0)
struct XcdBarrier { unsigned* bar; unsigned x; volatile LAS unsigned* st; };
DI XcdBarrier xcd_barrier_post(unsigned* bar, volatile LAS unsigned* st) {
    XcdBarrier b; b.bar = bar; b.x = xb_xcc_id(); b.st = st;
    if (threadIdx.x == 0) (void)xb_add(&bar[XB_XCNT(b.x)], 1u);
    return b;
}
DI void xcd_barrier_complete(unsigned* bar, unsigned x, unsigned& nloc, unsigned& nx) {
    const unsigned G = gridDim.x * gridDim.y * gridDim.z;
    unsigned sum, cnt, mine, sp = 0u;
    for (;;) {
        sum = 0u; cnt = 0u; mine = 0u;
#pragma unroll
        for (unsigned j = 0; j < 16; ++j) { const unsigned c = xb_ld(&bar[XB_XCNT(j)]); sum += c; cnt += (c > 0u) ? 1u : 0u; mine = (j == x) ? c : mine; }
        if (sum == G) break;
        __builtin_amdgcn_s_sleep(1);
        if ((++sp & 255u) == 0u) { if (xb_ld(&bar[XB_TMO])) break; if (sp > XB_SPIN_CAP) { atomicAdd(&bar[XB_TMO], 1u); break; } }
    }
    nloc = mine > 0u ? mine : 1u; nx = cnt > 0u ? cnt : 1u;
}
DI void xcd_barrier(const XcdBarrier& b) {
    asm volatile("s_waitcnt vmcnt(0)" ::: "memory");
    __syncthreads();
    if (threadIdx.x == 0) {
        unsigned* bar = b.bar;
        __builtin_amdgcn_s_waitcnt(0);
        unsigned nloc = b.st[0], nx = b.st[1];
        if (nloc == 0u) { xcd_barrier_complete(bar, b.x, nloc, nx); b.st[0] = nloc; b.st[1] = nx; }
        const unsigned old = xb_add(&bar[XB_XSUB(b.x)], 1u);
        const unsigned gen = old / nloc;
        if (old + 1u == (gen + 1u) * nloc) {
            __builtin_amdgcn_fence(__ATOMIC_RELEASE, "agent");
            asm volatile("s_waitcnt vmcnt(0)" ::: "memory");
            const unsigned og = xb_add(&bar[XB_TOP], 1u);
            const unsigned tg = og / nx;
            if (og + 1u == (tg + 1u) * nx) xb_add(&bar[XB_TOPGEN], 1u);
            else XB_SPIN(xb_ld(&bar[XB_TOPGEN]) == tg, bar);
            __builtin_amdgcn_fence(__ATOMIC_ACQUIRE, "agent");
            xb_add(&bar[XB_XGEN(b.x)], 1u);
            asm volatile("s_waitcnt vmcnt(0)" ::: "memory");
        } else {
            XB_SPIN(xb_ld(&bar[XB_XGEN(b.x)]) == gen, bar);
            __builtin_amdgcn_fence(__ATOMIC_ACQUIRE, "agent");
            asm volatile("s_waitcnt vmcnt(0)" ::: "memory");
        }
    }
    __syncthreads();
}

struct Args { const float* in[16]; float* out; unsigned char* ws; int ph_lo, ph_hi; unsigned naive; int pad; };
struct Ctx {
    LAS unsigned char* lds;
    const float *x, *c, *ctx, *c_ctx, *norm_w, *ada_w, *ada_b, *w_in, *conv_w, *conv_b, *decay_logit, *gn_w, *w_a, *w_b, *w_out, *final_w;
    float* out; unsigned char* ws;
    float* MOD; f32x2* ROPE;
    bf16_t *WA, *WB, *WOUT, *WIN, *XM, *KV, *KVC, *HC, *ST, *MM, *P, *Q, *K, *V, *SZB, *KC, *VC, *UB, *R, *SGB;
    float* RET; float* S0;
};

DI int win_dest(int o) {
    if (o < 4096) { const int g = o >> 10, ch = o & 1023; return 256 * (ch >> 6) + 64 * g + (ch & 63); }
    if (o < 5120) { const int qk = (o - 4096) >> 9, oo = (o - 4096) & 511, head = oo >> 6, i = oo & 63, t = head >> 2, hh = head & 3;
        return 256 * (16 + 2 * qk + t) + (i < 32 ? 32 * hh + i : 128 + 32 * hh + (i - 32)); }
    if (o < 7168) return o;
    { const int gs = (o - 7168) >> 10, ch = (o - 7168) & 1023; return 256 * (28 + (ch >> 7)) + 128 * gs + (ch & 127); }
}
DI void p0_transpose_item(const float* W, int K, int N, bf16_t* WT, bool permute, LAS float* scr, int item, int lane) {
    const int nblk = N / 32, kb = item / nblk, nb = item % nblk, k0 = 64 * kb, n0 = 32 * nb;
    f32x4 rv[8];
#pragma unroll
    for (int i = 0; i < 8; ++i) rv[i] = __builtin_nontemporal_load((const f32x4*)(W + (size_t)(k0 + 8 * i + (lane >> 3)) * N + n0 + 4 * (lane & 7)));
#pragma unroll
    for (int i = 0; i < 8; ++i) { LAS float* d = scr + (8 * i + (lane >> 3)) * 33 + 4 * (lane & 7); d[0] = rv[i].x; d[1] = rv[i].y; d[2] = rv[i].z; d[3] = rv[i].w; }
    asm volatile("s_waitcnt lgkmcnt(0)" ::: "memory");
    const int c = lane & 7; const int d0 = permute ? win_dest(n0) : n0;
#pragma unroll
    for (int j = 0; j < 4; ++j) { const int n = (lane >> 3) + 8 * j; const LAS float* sp = scr + (8 * c) * 33 + n;
        u32x4 o; o.x = cvt_pk_bf16(sp[0 * 33], sp[1 * 33]); o.y = cvt_pk_bf16(sp[2 * 33], sp[3 * 33]); o.z = cvt_pk_bf16(sp[4 * 33], sp[5 * 33]); o.w = cvt_pk_bf16(sp[6 * 33], sp[7 * 33]);
        *(u32x4*)(WT + (size_t)(d0 + n) * K + k0 + 8 * c) = o; }
    asm volatile("s_waitcnt lgkmcnt(0)" ::: "memory");
}
DI void p0_prologue(const Ctx& F) {
    const Tid T = opaque_tid();
    if (blockIdx.x < 48) {
        LAS float* red = (LAS float*)F.lds;
        LAS float* sl = (LAS float*)(F.lds + 16384);
        for (int e = T.tid; e < 5 * 1024; e += 512) { const int v = e >> 10, k = e & 1023; sl[e] = siluf(v < 4 ? F.c[v * 1024 + k] : F.c_ctx[k]); }
        __syncthreads();
        const int n0 = 64 * blockIdx.x, k0 = 128 * T.wave, r4 = T.lane >> 4, c4 = T.lane & 15;
        f32x4 a[5];
#pragma unroll
        for (int v = 0; v < 5; ++v) a[v] = (f32x4){0.f, 0.f, 0.f, 0.f};
#pragma unroll 1
        for (int ib = 0; ib < 32; ib += 8) {
            f32x4 wv[8];
#pragma unroll
            for (int i = 0; i < 8; ++i) wv[i] = __builtin_nontemporal_load((const f32x4*)(F.ada_w + (size_t)(k0 + 4 * (ib + i) + r4) * 3072 + n0 + 4 * c4));
#pragma unroll
            for (int i = 0; i < 8; ++i) {
#pragma unroll
                for (int v = 0; v < 5; ++v) a[v] += wv[i] * sl[v * 1024 + k0 + 4 * (ib + i) + r4];
                __builtin_amdgcn_sched_barrier(0); }
        }
#pragma unroll
        for (int v = 0; v < 5; ++v) {
#pragma unroll
            for (int e = 0; e < 4; ++e) { float t = a[v][e]; t += __shfl_xor(t, 16); t += __shfl_xor(t, 32); a[v][e] = t; }
            if (r4 == 0) { LAS float* d = red + (T.wave * 5 + v) * 64 + 4 * c4; d[0] = a[v].x; d[1] = a[v].y; d[2] = a[v].z; d[3] = a[v].w; } }
        __syncthreads();
        if (T.tid < 320) { const int v = T.tid >> 6, l = T.tid & 63; float s = F.ada_b[n0 + l];
#pragma unroll
            for (int w = 0; w < 8; ++w) s += red[(w * 5 + v) * 64 + l];
            F.MOD[v * 3072 + n0 + l] = s; }
        __syncthreads();
    }
    if (blockIdx.x == 48) {
        for (int e = T.tid; e < 1024; e += 512) { const int p = e >> 4, f = e & 15; const float inv = powf(10000.f, -(float)f / 16.f); const float ang = (float)p * inv;
            F.ROPE[e] = (f32x2){cosf(ang), sinf(ang)}; }
    }
    LAS float* scr = (LAS float*)(F.lds + T.wave * 16384);
    const int gw = blockIdx.x * 8 + T.wave, NGW = gridDim.x * 8;
    constexpr int I_IN = 16 * (NIN / 32), I_SQ = 16 * 32;
    for (int it = gw; it < I_IN + 3 * I_SQ; it += NGW) {
        int r = it;
        if (r < I_IN) { p0_transpose_item(F.w_in, 1024, NIN, F.WIN, true, scr, r, T.lane); continue; } r -= I_IN;
        if (r < I_SQ) { p0_transpose_item(F.w_a, 1024, 1024, F.WA, false, scr, r, T.lane); continue; } r -= I_SQ;
        if (r < I_SQ) { p0_transpose_item(F.w_b, 1024, 1024, F.WB, false, scr, r, T.lane); continue; } r -= I_SQ;
        p0_transpose_item(F.w_out, 1024, 1024, F.WOUT, false, scr, r, T.lane);
    }
}
template <int RB> DI void p1_row_group(const Ctx& F, const Tid& T, int m0) {
    f32x4 v[RB][2][2]; float ss[RB];
#pragma unroll
    for (int r = 0; r < RB; ++r) { const int m = m0 + r; const float* xr = m < MTOK ? F.x + (size_t)m * DM : F.ctx + (size_t)(m - MTOK) * DM;
#pragma unroll
        for (int j = 0; j < 2; ++j)
#pragma unroll
            for (int h = 0; h < 2; ++h) v[r][j][h] = __builtin_nontemporal_load(((const f32x4*)xr) + 2 * (T.lane + 64 * j) + h); }
#pragma unroll
    for (int r = 0; r < RB; ++r) { float s = 0.f;
#pragma unroll
        for (int j = 0; j < 2; ++j)
#pragma unroll
            for (int h = 0; h < 2; ++h) { const f32x4 t = v[r][j][h]; s += (t.x * t.x + t.y * t.y) + (t.z * t.z + t.w * t.w); }
        ss[r] = s; }
#pragma unroll
    for (int o = 1; o < 64; o <<= 1)
#pragma unroll
        for (int r = 0; r < RB; ++r) ss[r] += __shfl_xor(ss[r], o);
    const int mb = m0 < MTOK ? (m0 >> 12) : 4; const float* mod = F.MOD + mb * 3072;
#pragma unroll
    for (int j = 0; j < 2; ++j) { const int col = 8 * (T.lane + 64 * j);
        f32x4 w[2], sh[2], sc[2];
#pragma unroll
        for (int h = 0; h < 2; ++h) { w[h] = *(const f32x4*)(F.norm_w + col + 4 * h); sh[h] = *(const f32x4*)(mod + col + 4 * h); sc[h] = *(const f32x4*)(mod + 1024 + col + 4 * h); }
#pragma unroll
        for (int r = 0; r < RB; ++r) { const float rstd = __builtin_amdgcn_rsqf(ss[r] * (1.f / DM) + EPS);
            const f32x4 y0 = (v[r][j][0] * rstd * w[0]) * (sc[0] + 1.0f) + sh[0], y1 = (v[r][j][1] * rstd * w[1]) * (sc[1] + 1.0f) + sh[1];
            u32x4 o; o.x = cvt_pk_bf16(y0.x, y0.y); o.y = cvt_pk_bf16(y0.z, y0.w); o.z = cvt_pk_bf16(y1.x, y1.y); o.w = cvt_pk_bf16(y1.z, y1.w);
            *(u32x4*)(F.XM + (size_t)(m0 + r) * DM + col) = o; } }
}
DI void p1_rows(const Ctx& F) {
    const Tid T = opaque_tid();
    const int gw = blockIdx.x * 8 + T.wave, NGW = gridDim.x * 8;
    for (int m0 = gw * 8; m0 < MTOK; m0 += NGW * 8) p1_row_group<8>(F, T, m0);
    for (int m0 = MTOK + gw; m0 < MALL; m0 += NGW) p1_row_group<1>(F, T, m0);
}
DI size_t gate_block(int pm, int t, int wr, int wc, int ai, int m) { return (size_t)(((((pm * 8 + t) * 8 + (wr * 4 + wc)) * 2 + ai) * 4 + m)) * 512; }
DI size_t gate_index(int row, int col) { const int pm = row >> 8, rr = row & 255, cc = col & 127;
    return gate_block(pm, col >> 7, (rr >> 6) & 1, cc >> 5, rr >> 7, (rr >> 4) & 3) + (size_t)(((cc >> 3) & 3) * 16 + (rr & 15)) * 8 + (cc & 7); }
struct Sched1 {
    int G, c;
    DI bool next(int i, pg8::Unit& u) const { const int L = i * G + c; if (L >= 64 * 36) return false; pg8::tile_of(L, 64, 36, u); return true; }
};
struct SchedCtx {
    int c;
    DI bool next(int i, pg8::Unit& u) const { if (i > 0 || c >= 24) return false; u.pm = 64 + c / 6; u.pn = 18 + c % 6; return true; }
};
struct Epi1 {
    unsigned char* ws; bf16_t *R, *SGB; const f32x2* rope;
    DI int vm_ops(const pg8::Unit& u) const { return u.pn < 16 ? 8 : 16; }
    DI void mid(f32x4 (&)[2][2][4][2], const pg8::Unit&, int, int, int, int) const {}
    DI void operator()(const f32x4 (&acc)[2][2][4][2], const pg8::Unit& u, int wr, int wc, int fr, int fq) const {
        const int pn = u.pn, row0 = u.pm * 256 + wr * 64 + fr, x0 = wc * 32 + 8 * fq;
        const bool isctx = u.pm >= 64;
        if (pn < 16) {
            bf16_t* dst = (bf16_t*)(ws + (wc < 2 ? WS_HC : WS_P)) + 64 * pn + (x0 & 63);
#pragma unroll
            for (int ai = 0; ai < 2; ++ai)
#pragma unroll
                for (int m = 0; m < 4; ++m) { const size_t row = row0 + ai * 128 + m * 16;
                    f32x4 o[2];
#pragma unroll
                    for (int n = 0; n < 2; ++n) { const f32x4 a = acc[ai][0][m][n], b = acc[ai][1][m][n];
                        if (wc < 2) o[n] = a * b;
                        else { o[n].x = a.x * siluf(b.x); o[n].y = a.y * siluf(b.y); o[n].z = a.z * siluf(b.z); o[n].w = a.w * siluf(b.w); } }
                    u32x4 w; w.x = cvt_pk_bf16(o[0].x, o[0].y); w.y = cvt_pk_bf16(o[0].z, o[0].w); w.z = cvt_pk_bf16(o[1].x, o[1].y); w.w = cvt_pk_bf16(o[1].z, o[1].w);
                    *(u32x4*)(dst + row * 1024) = w; }
        } else if (pn < 20) {
            const int t = (pn - 16) & 1, isk = (pn - 16) >> 1, head = 4 * t + wc, i0 = 8 * fq;
            const float scale = isk ? 0.125f : 1.0f;
            bf16_t* base = (bf16_t*)(ws + (isk ? (isctx ? WS_KC : WS_K) : WS_Q));
#pragma unroll
            for (int ai = 0; ai < 2; ++ai)
#pragma unroll
                for (int m = 0; m < 4; ++m) { const int row = row0 + ai * 128 + m * 16; const int orow = isctx ? row - MTOK : row;
                    const int pos = row & 4095, pidx = (fq < 2) ? (pos >> 6) : (pos & 63);
                    const f32x2* rp = rope + pidx * 16 + (fq & 1) * 8;
                    float o1[8], o2[8];
#pragma unroll
                    for (int e = 0; e < 8; ++e) { f32x2 cs = rp[e]; if (isctx) cs = (f32x2){1.f, 0.f};
                        const float t1 = acc[ai][0][m][e >> 2][e & 3], t2 = acc[ai][1][m][e >> 2][e & 3];
                        o1[e] = (t1 * cs.x - t2 * cs.y) * scale; o2[e] = (t1 * cs.y + t2 * cs.x) * scale; }
                    u32x4 w1, w2; w1.x = cvt_pk_bf16(o1[0], o1[1]); w1.y = cvt_pk_bf16(o1[2], o1[3]); w1.z = cvt_pk_bf16(o1[4], o1[5]); w1.w = cvt_pk_bf16(o1[6], o1[7]);
                    w2.x = cvt_pk_bf16(o2[0], o2[1]); w2.y = cvt_pk_bf16(o2[2], o2[3]); w2.z = cvt_pk_bf16(o2[4], o2[5]); w2.w = cvt_pk_bf16(o2[6], o2[7]);
                    bf16_t* d = base + (size_t)orow * 512 + head * 64 + i0;
                    *(u32x4*)d = w1; *(u32x4*)(d + 32) = w2; }
        } else if (pn < 28) {
            const bool isz = pn >= 24;
            bf16_t* base = (bf16_t*)(ws + (isz ? WS_SZB : (isctx ? WS_VC : WS_V)));
            const int colt = 256 * (pn - (isz ? 24 : 20)) + x0;
#pragma unroll
            for (int ai = 0; ai < 2; ++ai)
#pragma unroll
                for (int m = 0; m < 4; ++m) { const int row = row0 + ai * 128 + m * 16; const int orow = isctx ? row - MTOK : row;
#pragma unroll
                    for (int bj = 0; bj < 2; ++bj) { f32x4 a = acc[ai][bj][m][0], b = acc[ai][bj][m][1];
                        u32x4 w; w.x = cvt_pk_bf16(a.x, a.y); w.y = cvt_pk_bf16(a.z, a.w); w.z = cvt_pk_bf16(b.x, b.y); w.w = cvt_pk_bf16(b.z, b.w);
                        if (isz) __builtin_nontemporal_store(w, (u32x4*)(base + (size_t)orow * 1024 + colt + bj * 128)); else *(u32x4*)(base + (size_t)orow * 1024 + colt + bj * 128) = w; } }
        } else {
            const int col = 128 * (pn - 28) + x0;
#pragma unroll
            for (int ai = 0; ai < 2; ++ai)
#pragma unroll
                for (int m = 0; m < 4; ++m) { const size_t row = row0 + ai * 128 + m * 16;
                    float rr[8], sg[8];
#pragma unroll
                    for (int e = 0; e < 8; ++e) { const float ga = acc[ai][0][m][e >> 2][e & 3], gb = acc[ai][1][m][e >> 2][e & 3];
                        const float ea = 1.f + __expf(-ga), eb = 1.f + __expf(-gb); sg[e] = __builtin_amdgcn_rcpf(eb); rr[e] = eb * __builtin_amdgcn_rcpf(ea); }
                    u32x4 w1, w2; w1.x = cvt_pk_bf16(rr[0], rr[1]); w1.y = cvt_pk_bf16(rr[2], rr[3]); w1.z = cvt_pk_bf16(rr[4], rr[5]); w1.w = cvt_pk_bf16(rr[6], rr[7]);
                    w2.x = cvt_pk_bf16(sg[0], sg[1]); w2.y = cvt_pk_bf16(sg[2], sg[3]); w2.z = cvt_pk_bf16(sg[4], sg[5]); w2.w = cvt_pk_bf16(sg[6], sg[7]);
                    const size_t gi = gate_block(u.pm, pn - 28, wr, wc, ai, m) + (size_t)(fq * 16 + fr) * 8;
                    __builtin_nontemporal_store(w1, (u32x4*)(R + gi)); __builtin_nontemporal_store(w2, (u32x4*)(SGB + gi)); }
        }
    }
};
DI void n2_inproj(const Ctx& F) {
    const Tid T = opaque_tid();
    const size_t NT = (size_t)gridDim.x * 512, gt = (size_t)blockIdx.x * 512 + T.tid;
    for (size_t idx = gt; idx < (size_t)(MALL / 4) * 1024; idx += NT) {
        const int ch = (int)(idx & 1023), t0 = (int)(idx >> 10) * 4;
        const bool doqk = ch < 512 && (ch & 63) < 32;
        float a[12][4];
#pragma unroll
        for (int o = 0; o < 12; ++o)
#pragma unroll
            for (int j = 0; j < 4; ++j) a[o][j] = 0.f;
        for (int k = 0; k < 1024; ++k) {
            const float* wr = F.w_in + (size_t)k * NIN;
            float xv[4];
#pragma unroll
            for (int j = 0; j < 4; ++j) xv[j] = bf2f(F.XM[(size_t)(t0 + j) * 1024 + k]);
            float w[12];
            w[0] = wr[ch]; w[1] = wr[1024 + ch]; w[2] = wr[2048 + ch]; w[3] = wr[3072 + ch]; w[4] = wr[5120 + ch]; w[5] = wr[6144 + ch]; w[6] = wr[7168 + ch]; w[7] = wr[8192 + ch];
            if (doqk) { w[8] = wr[4096 + ch]; w[9] = wr[4096 + ch + 32]; w[10] = wr[4608 + ch]; w[11] = wr[4608 + ch + 32]; } else { w[8] = w[9] = w[10] = w[11] = 0.f; }
#pragma unroll
            for (int o = 0; o < 12; ++o)
#pragma unroll
                for (int j = 0; j < 4; ++j) a[o][j] += xv[j] * w[o];
        }
#pragma unroll
        for (int j = 0; j < 4; ++j) { const int t = t0 + j;
            if (t < MTOK) {
                const size_t o = (size_t)t * 1024 + ch;
                F.HC[o] = f2bf(a[2][j] * a[0][j]); F.P[o] = f2bf(siluf(a[3][j]) * a[1][j]); F.V[o] = f2bf(a[4][j]); F.SZB[o] = f2bf(a[5][j]);
                const float sga = 1.f / (1.f + __expf(-a[6][j])), sgb = 1.f / (1.f + __expf(-a[7][j]));
                { const size_t gi = gate_index(t, ch); F.R[gi] = f2bf(sga / sgb); F.SGB[gi] = f2bf(sgb); }
                if (doqk) { const int i = ch & 63, pos = t & 4095; const int pidx = i < 16 ? (pos >> 6) : (pos & 63); const f32x2 cs = F.ROPE[pidx * 16 + (i & 15)];
                    const size_t q = (size_t)t * 512 + ch;
                    F.Q[q] = f2bf(a[8][j] * cs.x - a[9][j] * cs.y); F.Q[q + 32] = f2bf(a[8][j] * cs.y + a[9][j] * cs.x);
                    F.K[q] = f2bf((a[10][j] * cs.x - a[11][j] * cs.y) * 0.125f); F.K[q + 32] = f2bf((a[10][j] * cs.y + a[11][j] * cs.x) * 0.125f); }
            } else {
                const int tc = t - MTOK;
                F.VC[(size_t)tc * 1024 + ch] = f2bf(a[4][j]);
                if (doqk) { F.KC[(size_t)tc * 512 + ch] = f2bf(a[10][j] * 0.125f); F.KC[(size_t)tc * 512 + ch + 32] = f2bf(a[11][j] * 0.125f); }
            }
        }
    }
}
DI bf16x8 tr2(const LAS unsigned char* p, int delta) {
    const s16x4 lo = __builtin_bit_cast(s16x4, __builtin_amdgcn_ds_read_tr16_b64_v4i16((LAS v4i16_t*)p));
    const s16x4 hi = __builtin_bit_cast(s16x4, __builtin_amdgcn_ds_read_tr16_b64_v4i16((LAS v4i16_t*)(p + delta)));
    return __builtin_shufflevector(lo, hi, 0, 1, 2, 3, 4, 5, 6, 7);
}
DI u32x4 scale8(u32x4 w, float s) {
    u32x4 o; o.x = cvt_pk_bf16(bflo(w.x) * s, bfhi(w.x) * s); o.y = cvt_pk_bf16(bflo(w.y) * s, bfhi(w.y) * s); o.z = cvt_pk_bf16(bflo(w.z) * s, bfhi(w.z) * s); o.w = cvt_pk_bf16(bflo(w.w) * s, bfhi(w.w) * s); return o;
}
DI void p3_kv(const Ctx& F, int it0, int it1, int stride) {
    const Tid T = opaque_tid();
    LAS unsigned char* KFI = F.lds; LAS unsigned char* KBI = F.lds + 20480; LAS unsigned char* VI = F.lds + 40960;
    const int tid = T.tid, lane = T.lane, w = T.wave, g = lane >> 4, q = (lane & 15) >> 2, p = lane & 3;
    const int row = tid >> 2, seg = tid & 3;
    u32x4 pk[2], pv[4];
    auto prefetch = [&](int it) { const int bh = it >> 5, c = it & 31; const size_t tok0 = (size_t)(bh >> 3) * SEQ + c * CHK;
        const bf16_t* kp = F.K + tok0 * 512 + (bh & 7) * 64; const bf16_t* vp = F.V + tok0 * 1024 + (bh & 7) * 128;
        pk[0] = *(const u32x4*)(kp + (size_t)row * 512 + seg * 16); pk[1] = *(const u32x4*)(kp + (size_t)row * 512 + seg * 16 + 8);
#pragma unroll
        for (int i = 0; i < 4; ++i) pv[i] = *(const u32x4*)(vp + (size_t)row * 1024 + seg * 32 + 8 * i); };
    if (it0 < it1) prefetch(it0);
    for (int it = it0; it < it1; it += stride) {
        const int bh = it >> 5, c = it & 31;
        const float l2f = log2_gamma(F.decay_logit, 0, bh & 7), l2b = log2_gamma(F.decay_logit, 1, bh & 7);
        { const float df = __builtin_amdgcn_exp2f(l2f * (float)(127 - row)), db = __builtin_amdgcn_exp2f(l2b * (float)row);
            *(LAS u32x4*)(KFI + row * 160 + seg * 32) = scale8(pk[0], df); *(LAS u32x4*)(KFI + row * 160 + seg * 32 + 16) = scale8(pk[1], df);
            *(LAS u32x4*)(KBI + row * 160 + seg * 32) = scale8(pk[0], db); *(LAS u32x4*)(KBI + row * 160 + seg * 32 + 16) = scale8(pk[1], db);
#pragma unroll
            for (int i = 0; i < 4; ++i) *(LAS u32x4*)(VI + row * 288 + seg * 64 + 16 * i) = pv[i]; }
        __syncthreads();
        if (it + stride < it1) prefetch(it + stride);
        f32x4 acc[2][4];
#pragma unroll
        for (int d = 0; d < 2; ++d)
#pragma unroll
            for (int nb = 0; nb < 4; ++nb) acc[d][nb] = (f32x4){0.f, 0.f, 0.f, 0.f};
#pragma unroll
        for (int s2 = 0; s2 < 4; ++s2) {
            const bf16x8 vb = tr2(VI + (32 * s2 + 8 * g + q) * 288 + (16 * w + 4 * p) * 2, 4 * 288);
#pragma unroll
            for (int nb = 0; nb < 4; ++nb) {
                const bf16x8 kf = tr2(KFI + (32 * s2 + 8 * g + q) * 160 + (16 * nb + 4 * p) * 2, 4 * 160);
                const bf16x8 kb = tr2(KBI + (32 * s2 + 8 * g + q) * 160 + (16 * nb + 4 * p) * 2, 4 * 160);
                acc[0][nb] = __builtin_amdgcn_mfma_f32_16x16x32_bf16(kf, vb, acc[0][nb], 0, 0, 0);
                acc[1][nb] = __builtin_amdgcn_mfma_f32_16x16x32_bf16(kb, vb, acc[1][nb], 0, 0, 0);
            }
        }
        bf16_t* of = F.KV + ((size_t)(0 * 32 + bh) * 32 + c) * 8192; bf16_t* ob = F.KV + ((size_t)(1 * 32 + bh) * 32 + c) * 8192;
#pragma unroll
        for (int nb = 0; nb < 4; ++nb) { const int o = ((w * 4 + nb) * 64 + lane) * 4;
            u32x2 a, b; a.x = cvt_pk_bf16(acc[0][nb].x, acc[0][nb].y); a.y = cvt_pk_bf16(acc[0][nb].z, acc[0][nb].w); b.x = cvt_pk_bf16(acc[1][nb].x, acc[1][nb].y); b.y = cvt_pk_bf16(acc[1][nb].z, acc[1][nb].w);
            *(u32x2*)(of + o) = a; *(u32x2*)(ob + o) = b; }
        __syncthreads();
    }
}
DI void p4_ctx_state(const Ctx& F, int bh) {
    const Tid T = opaque_tid();
    LAS unsigned char* KFI = F.lds; LAS unsigned char* KBI = F.lds + 20480; LAS unsigned char* VI = F.lds + 40960;
    const int tid = T.tid, lane = T.lane, w = T.wave, g = lane >> 4, q = (lane & 15) >> 2, p = lane & 3;
    const int row = tid >> 2, seg = tid & 3;
    const float l2f = log2_gamma(F.decay_logit, 0, bh & 7), l2b = log2_gamma(F.decay_logit, 1, bh & 7);
    f32x4 acc[2][4];
#pragma unroll
    for (int d = 0; d < 2; ++d)
#pragma unroll
        for (int nb = 0; nb < 4; ++nb) acc[d][nb] = (f32x4){0.f, 0.f, 0.f, 0.f};
    for (int cc = 0; cc < 2; ++cc) {
        const size_t tok0 = (size_t)(bh >> 3) * CTXL + cc * CHK; const int m = cc * CHK + row;
        const bf16_t* kp = F.KC + tok0 * 512 + (bh & 7) * 64; const bf16_t* vp = F.VC + tok0 * 1024 + (bh & 7) * 128;
        const u32x4 k0 = *(const u32x4*)(kp + (size_t)row * 512 + seg * 16), k1 = *(const u32x4*)(kp + (size_t)row * 512 + seg * 16 + 8);
        const float df = __builtin_amdgcn_exp2f(l2f * (float)(255 - m)), db = __builtin_amdgcn_exp2f(l2b * (float)m);
        *(LAS u32x4*)(KFI + row * 160 + seg * 32) = scale8(k0, df); *(LAS u32x4*)(KFI + row * 160 + seg * 32 + 16) = scale8(k1, df);
        *(LAS u32x4*)(KBI + row * 160 + seg * 32) = scale8(k0, db); *(LAS u32x4*)(KBI + row * 160 + seg * 32 + 16) = scale8(k1, db);
#pragma unroll
        for (int i = 0; i < 4; ++i) *(LAS u32x4*)(VI + row * 288 + seg * 64 + 16 * i) = *(const u32x4*)(vp + (size_t)row * 1024 + seg * 32 + 8 * i);
        __syncthreads();
#pragma unroll
        for (int s2 = 0; s2 < 4; ++s2) {
            const bf16x8 vb = tr2(VI + (32 * s2 + 8 * g + q) * 288 + (16 * w + 4 * p) * 2, 4 * 288);
#pragma unroll
            for (int nb = 0; nb < 4; ++nb) {
                const bf16x8 kf = tr2(KFI + (32 * s2 + 8 * g + q) * 160 + (16 * nb + 4 * p) * 2, 4 * 160);
                const bf16x8 kb = tr2(KBI + (32 * s2 + 8 * g + q) * 160 + (16 * nb + 4 * p) * 2, 4 * 160);
                acc[0][nb] = __builtin_amdgcn_mfma_f32_16x16x32_bf16(kf, vb, acc[0][nb], 0, 0, 0);
                acc[1][nb] = __builtin_amdgcn_mfma_f32_16x16x32_bf16(kb, vb, acc[1][nb], 0, 0, 0);
            }
        }
        __syncthreads();
    }
    float* of = F.S0 + (size_t)(0 * 32 + bh) * 8192; float* ob = F.S0 + (size_t)(1 * 32 + bh) * 8192;
#pragma unroll
    for (int nb = 0; nb < 4; ++nb) { const int o = ((w * 4 + nb) * 64 + lane) * 4; *(f32x4*)(of + o) = acc[0][nb]; *(f32x4*)(ob + o) = acc[1][nb]; }
}
DI void p3_ua(const Ctx& F, int blk, int nblk) {
    const Tid T = opaque_tid();
    const size_t NT = (size_t)nblk * 512, gt = (size_t)blk * 512 + T.tid;
    for (size_t idx = gt; idx < (size_t)MTOK * 128; idx += NT) {
        const int t = (int)(idx >> 7), c8 = (int)(idx & 127) * 8, pos = t & 4095;
        const bf16_t* hp = F.HC + (size_t)t * 1024 + c8;
        const u32x4 z = (u32x4){0u, 0u, 0u, 0u};
        const u32x4 h0 = pos > 0 ? *(const u32x4*)(hp - 1024) : z, h1 = *(const u32x4*)hp, h2 = pos < SEQ - 1 ? *(const u32x4*)(hp + 1024) : z;
        const u32x4 pv = *(const u32x4*)(F.P + (size_t)t * 1024 + c8);
        float o[8];
#pragma unroll
        for (int e = 0; e < 8; ++e) { const unsigned a = h0[e >> 1], b = h1[e >> 1], c = h2[e >> 1], pp = pv[e >> 1];
            const float x0 = (e & 1) ? bfhi(a) : bflo(a), x1 = (e & 1) ? bfhi(b) : bflo(b), x2 = (e & 1) ? bfhi(c) : bflo(c), pf = (e & 1) ? bfhi(pp) : bflo(pp);
            const float cv = F.conv_w[c8 + e] * x0 + F.conv_w[1024 + c8 + e] * x1 + F.conv_w[2048 + c8 + e] * x2 + F.conv_b[c8 + e];
            o[e] = pf * cv; }
        u32x4 w; w.x = cvt_pk_bf16(o[0], o[1]); w.y = cvt_pk_bf16(o[2], o[3]); w.z = cvt_pk_bf16(o[4], o[5]); w.w = cvt_pk_bf16(o[6], o[7]);
        *(u32x4*)(F.P + (size_t)t * 1024 + c8) = w;
    }
}
DI void p4_scan(const Ctx& F, int blk, int nblk) {
    const Tid T = opaque_tid();
    const size_t NT = (size_t)nblk * 512, gt = (size_t)blk * 512 + T.tid;
    for (size_t idx = gt; idx < (size_t)2 * 32 * 2048; idx += NT) {
        const int e4 = (int)(idx & 2047), bh = (int)(idx >> 11) & 31, dir = (int)(idx >> 16);
        const float g = exp2f(log2_gamma(F.decay_logit, dir, bh & 7) * 128.f);
        const u32x2* kv = (const u32x2*)(F.KV + ((size_t)(dir * 32 + bh) * 32) * 8192) + e4;
        u32x2* st = (u32x2*)(F.ST + ((size_t)(dir * 32 + bh) * 32) * 8192) + e4;
        float s0 = 0.f, s1 = 0.f, s2 = 0.f, s3 = 0.f;
        u32x2 v[32];
#pragma unroll
        for (int i = 0; i < 32; ++i) v[i] = __builtin_nontemporal_load(kv + (size_t)(dir == 0 ? i : 31 - i) * 2048);
#pragma unroll
        for (int i = 0; i < 32; ++i) { const int c = dir == 0 ? i : 31 - i;
            u32x2 o; o.x = cvt_pk_bf16(s0, s1); o.y = cvt_pk_bf16(s2, s3); st[(size_t)c * 2048] = o;
            s0 = g * s0 + bflo(v[i].x); s1 = g * s1 + bfhi(v[i].x); s2 = g * s2 + bflo(v[i].y); s3 = g * s3 + bfhi(v[i].y); }
    }
}
DI void n4_recurrence(const Ctx& F) {
    const Tid T = opaque_tid();
    const int gw = blockIdx.x * 8 + T.wave, NGW = gridDim.x * 8, d = T.lane;
    for (int task = gw; task < 32 * 128; task += NGW) {
        const int bh = task >> 7, v = task & 127, b = bh >> 3, h = bh & 7;
        const float gf = exp2f(log2_gamma(F.decay_logit, 0, h)), gb = exp2f(log2_gamma(F.decay_logit, 1, h));
        float s = 0.f;
        for (int m = 0; m < CTXL; ++m) { const size_t t = (size_t)b * CTXL + m; s = gf * s + bf2f(F.KC[t * 512 + h * 64 + d]) * bf2f(F.VC[t * 1024 + h * 128 + v]); }
        const float sF = s; s = 0.f;
        for (int m = CTXL - 1; m >= 0; --m) { const size_t t = (size_t)b * CTXL + m; s = gb * s + bf2f(F.KC[t * 512 + h * 64 + d]) * bf2f(F.VC[t * 1024 + h * 128 + v]); }
        const float sB = s;
        s = sF;
        for (int n = 0; n < SEQ; ++n) { const size_t t = (size_t)b * SEQ + n; s = gf * s + bf2f(F.K[t * 512 + h * 64 + d]) * bf2f(F.V[t * 1024 + h * 128 + v]);
            const float o = wave_sum(bf2f(F.Q[t * 512 + h * 64 + d]) * s); if (d == 0) F.RET[t * 1024 + h * 128 + v] = o; }
        s = sB;
        for (int n = SEQ - 1; n >= 0; --n) { const size_t t = (size_t)b * SEQ + n; s = gb * s + bf2f(F.K[t * 512 + h * 64 + d]) * bf2f(F.V[t * 1024 + h * 128 + v]);
            const float o = wave_sum(bf2f(F.Q[t * 512 + h * 64 + d]) * s); if (d == 0) F.RET[t * 1024 + h * 128 + v] += o; }
    }
}
DI void n5_groupnorm(const Ctx& F) {
    const Tid T = opaque_tid();
    const int gw = blockIdx.x * 8 + T.wave, NGW = gridDim.x * 8;
    for (int task = gw; task < MTOK * NH; task += NGW) {
        const int t = task >> 3, h = task & 7; const size_t o = (size_t)t * 1024 + h * 128 + 2 * T.lane;
        const float a = F.RET[o], b = F.RET[o + 1];
        const float mu = wave_sum(a + b) * (1.f / 128.f); const float da = a - mu, db = b - mu;
        const float var = wave_sum(da * da + db * db) * (1.f / 128.f); const float rstd = 1.0f / sqrtf(var + EPS);
        const float ra = da * rstd * F.gn_w[h * 128 + 2 * T.lane], rb = db * rstd * F.gn_w[h * 128 + 2 * T.lane + 1];
        *(unsigned*)(F.UB + o) = cvt_pk_bf16(siluf(bf2f(F.SZB[o])) * ra, siluf(bf2f(F.SZB[o + 1])) * rb);
    }
}
DI void p5_ret(const Ctx& F) {
    const Tid T = opaque_tid();
    LAS unsigned char* KI = F.lds; LAS unsigned char* VI = F.lds + 20480; LAS unsigned char* SF = F.lds + 57344; LAS unsigned char* SB = F.lds + 75776;
    LAS unsigned char* S0F = F.lds + 94208; LAS unsigned char* S0B = F.lds + 110592;
    const int tid = T.tid, lane = T.lane, w = T.wave, g = lane >> 4, q = (lane & 15) >> 2, p = lane & 3, l15 = lane & 15;
    const int row = tid >> 2, seg = tid & 3, il = 16 * w + l15;
    for (int base = blockIdx.x * 4; base < 1024; base += gridDim.x * 4) {
        const int bh = base >> 5, h = bh & 7;
        const float l2f = log2_gamma(F.decay_logit, 0, h), l2b = log2_gamma(F.decay_logit, 1, h);
        { const float* s0f = F.S0 + (size_t)(0 * 32 + bh) * 8192 + row * 64 + seg * 16; const float* s0b = F.S0 + (size_t)(1 * 32 + bh) * 8192 + row * 64 + seg * 16;
#pragma unroll
            for (int i = 0; i < 2; ++i) { const f32x4 a0 = *(const f32x4*)(s0f + 8 * i), a1 = *(const f32x4*)(s0f + 8 * i + 4), b0 = *(const f32x4*)(s0b + 8 * i), b1 = *(const f32x4*)(s0b + 8 * i + 4);
                u32x4 x, y; x.x = cvt_pk_bf16(a0.x, a0.y); x.y = cvt_pk_bf16(a0.z, a0.w); x.z = cvt_pk_bf16(a1.x, a1.y); x.w = cvt_pk_bf16(a1.z, a1.w);
                y.x = cvt_pk_bf16(b0.x, b0.y); y.y = cvt_pk_bf16(b0.z, b0.w); y.z = cvt_pk_bf16(b1.x, b1.y); y.w = cvt_pk_bf16(b1.z, b1.w);
                *(LAS u32x4*)(S0F + row * 128 + seg * 32 + 16 * i) = x; *(LAS u32x4*)(S0B + row * 128 + seg * 32 + 16 * i) = y; } }
        u32x4 pk[2], pv[4], pf0[2], pb0[2]; bf16x8 pq[2];
        auto prefetch = [&](int it) { const int c = it & 31; const size_t tok0 = (size_t)(bh >> 3) * SEQ + c * CHK;
            const bf16_t* kp = F.K + tok0 * 512 + h * 64; const bf16_t* vp = F.V + tok0 * 1024 + h * 128; const bf16_t* qp = F.Q + tok0 * 512 + h * 64;
            const bf16_t* stf = F.ST + ((size_t)(0 * 32 + bh) * 32 + c) * 8192; const bf16_t* stb = F.ST + ((size_t)(1 * 32 + bh) * 32 + c) * 8192;
#pragma unroll
            for (int i = 0; i < 2; ++i) { pk[i] = *(const u32x4*)(kp + (size_t)row * 512 + seg * 16 + 8 * i); pf0[i] = *(const u32x4*)(stf + row * 64 + seg * 16 + 8 * i); pb0[i] = *(const u32x4*)(stb + row * 64 + seg * 16 + 8 * i);
                pq[i] = *(const bf16x8*)(qp + (size_t)il * 512 + 32 * i + 8 * g); }
#pragma unroll
            for (int i = 0; i < 4; ++i) pv[i] = *(const u32x4*)(vp + (size_t)row * 1024 + seg * 32 + 8 * i); };
        prefetch(base);
        for (int k = 0; k < 4; ++k) {
            const int it = base + k, c = it & 31; const size_t tok0 = (size_t)(bh >> 3) * SEQ + c * CHK;
            { const float cf = __builtin_amdgcn_exp2f(l2f * 128.f * (float)c), cb = __builtin_amdgcn_exp2f(l2b * 128.f * (float)(31 - c));
#pragma unroll
                for (int i = 0; i < 2; ++i) { *(LAS u32x4*)(KI + row * 160 + seg * 32 + 16 * i) = pk[i];
                    const u32x4 x = *(const LAS u32x4*)(S0F + row * 128 + seg * 32 + 16 * i), y = *(const LAS u32x4*)(S0B + row * 128 + seg * 32 + 16 * i);
                    u32x4 of, ob;
#pragma unroll
                    for (int e = 0; e < 4; ++e) { of[e] = cvt_pk_bf16(bflo(pf0[i][e]) + cf * bflo(x[e]), bfhi(pf0[i][e]) + cf * bfhi(x[e])); ob[e] = cvt_pk_bf16(bflo(pb0[i][e]) + cb * bflo(y[e]), bfhi(pb0[i][e]) + cb * bfhi(y[e])); }
#pragma unroll
                    for (int jj = 0; jj < 2; ++jj) { const int vv = 16 * (tid >> 6) + 4 * (tid & 3) + 2 * i + jj, dd = 16 * ((tid >> 4) & 3) + 4 * ((tid & 15) >> 2);
                        *(LAS u32x2*)(SF + vv * 144 + dd * 2) = (u32x2){of[2 * jj], of[2 * jj + 1]}; *(LAS u32x2*)(SB + vv * 144 + dd * 2) = (u32x2){ob[2 * jj], ob[2 * jj + 1]}; } }
#pragma unroll
                for (int i = 0; i < 4; ++i) *(LAS u32x4*)(VI + row * 288 + seg * 64 + 16 * i) = pv[i]; }
            bf16x8 qf[2]; qf[0] = pq[0]; qf[1] = pq[1];
            __syncthreads();
            if (k < 3) prefetch(it + 1);
            f32x4 accS[8];
#pragma unroll
            for (int jb = 0; jb < 8; ++jb) { accS[jb] = (f32x4){0.f, 0.f, 0.f, 0.f};
#pragma unroll
                for (int ks = 0; ks < 2; ++ks) { const bf16x8 kf = *(const LAS bf16x8*)(KI + (16 * jb + l15) * 160 + (32 * ks + 8 * g) * 2);
                    accS[jb] = __builtin_amdgcn_mfma_f32_16x16x32_bf16(kf, qf[ks], accS[jb], 0, 0, 0); } }
            bf16x8 pf[4];
#pragma unroll
            for (int s2 = 0; s2 < 4; ++s2) { float pe[8];
#pragma unroll
                for (int e = 0; e < 8; ++e) { const int jb = 2 * s2 + (e >> 2), r = e & 3, j = 16 * jb + 4 * g + r, df = il - j;
                    float mk = __builtin_amdgcn_exp2f((df >= 0 ? l2f : -l2b) * (float)df); if (df == 0) mk = 2.f;
                    pe[e] = accS[jb][r] * mk; }
                u32x4 pw; pw.x = cvt_pk_bf16(pe[0], pe[1]); pw.y = cvt_pk_bf16(pe[2], pe[3]); pw.z = cvt_pk_bf16(pe[4], pe[5]); pw.w = cvt_pk_bf16(pe[6], pe[7]);
                pf[s2] = __builtin_bit_cast(bf16x8, pw); }
            const float decf = __builtin_amdgcn_exp2f(l2f * (float)(il + 1)), decb = __builtin_amdgcn_exp2f(l2b * (float)(128 - il));
            f32x4 accO[8];
#pragma unroll
            for (int vb = 0; vb < 8; ++vb) { f32x4 o = (f32x4){0.f, 0.f, 0.f, 0.f};
#pragma unroll
                for (int s2 = 0; s2 < 4; ++s2) { const bf16x8 vf = tr2(VI + (32 * s2 + 4 * g + q) * 288 + (16 * vb + 4 * p) * 2, 16 * 288);
                    o = __builtin_amdgcn_mfma_f32_16x16x32_bf16(vf, pf[s2], o, 0, 0, 0); }
                f32x4 tf = (f32x4){0.f, 0.f, 0.f, 0.f}, tb = (f32x4){0.f, 0.f, 0.f, 0.f};
#pragma unroll
                for (int ks = 0; ks < 2; ++ks) { const bf16x8 sf = *(const LAS bf16x8*)(SF + (16 * vb + l15) * 144 + (32 * ks + 8 * g) * 2);
                    const bf16x8 sb = *(const LAS bf16x8*)(SB + (16 * vb + l15) * 144 + (32 * ks + 8 * g) * 2);
                    tf = __builtin_amdgcn_mfma_f32_16x16x32_bf16(sf, qf[ks], tf, 0, 0, 0); tb = __builtin_amdgcn_mfma_f32_16x16x32_bf16(sb, qf[ks], tb, 0, 0, 0); }
                accO[vb] = o + tf * decf + tb * decb; __builtin_amdgcn_sched_barrier(0); }
            float sm = 0.f;
#pragma unroll
            for (int vb = 0; vb < 8; ++vb) sm += (accO[vb].x + accO[vb].y) + (accO[vb].z + accO[vb].w);
            sm += __shfl_xor(sm, 16); sm += __shfl_xor(sm, 32);
            const float mu = sm * (1.f / 128.f); float sq = 0.f;
#pragma unroll
            for (int vb = 0; vb < 8; ++vb) { accO[vb] = accO[vb] - mu; sq += (accO[vb].x * accO[vb].x + accO[vb].y * accO[vb].y) + (accO[vb].z * accO[vb].z + accO[vb].w * accO[vb].w); }
            sq += __shfl_xor(sq, 16); sq += __shfl_xor(sq, 32);
            const float rstd = 1.0f / sqrtf(sq * (1.f / 128.f) + EPS);
            __syncthreads();
#pragma unroll
            for (int vb = 0; vb < 8; ++vb) { const f32x4 gw = *(const f32x4*)(F.gn_w + h * 128 + 16 * vb + 4 * g); const f32x4 o = accO[vb] * rstd * gw;
                u32x2 ow; ow.x = cvt_pk_bf16(o.x, o.y); ow.y = cvt_pk_bf16(o.z, o.w);
                *(LAS u32x2*)(VI + il * 288 + (16 * vb + 4 * g) * 2) = ow; }
            __syncthreads();
            { const size_t go = (tok0 + row) * 1024 + h * 128 + seg * 32;
#pragma unroll
                for (int i = 0; i < 4; ++i) { const u32x4 o = *(const LAS u32x4*)(VI + row * 288 + seg * 64 + 16 * i); const u32x4 z = *(const u32x4*)(F.SZB + go + 8 * i);
                    u32x4 r;
#pragma unroll
                    for (int e = 0; e < 4; ++e) r[e] = cvt_pk_bf16(bflo(o[e]) * siluf(bflo(z[e])), bfhi(o[e]) * siluf(bfhi(z[e])));
                    *(u32x4*)(F.UB + go + 8 * i) = r; } }
            __syncthreads();
        }
    }
}
struct SchedSq { int G, c; DI bool next(int i, pg8::Unit& u) const { const int L = i * G + c; if (L >= 256) return false; pg8::tile_of(L, 64, 4, u); return true; } };
struct EpiAB {
    const bf16_t* R; const bf16_t* SGB; bf16_t* MM;
    DI int vm_ops(const pg8::Unit&) const { return 0; }
    DI void mid(f32x4 (&acc)[2][2][4][2], const pg8::Unit& u, int wr, int wc, int fr, int fq) const { apply<false>(acc, u, wr, wc, fr, fq); }
    DI void operator()(const f32x4 (&acc)[2][2][4][2], const pg8::Unit& u, int wr, int wc, int fr, int fq) const { apply<true>(const_cast<f32x4 (&)[2][2][4][2]>(acc), u, wr, wc, fr, fq); }
    template <bool FIN> DI void apply(f32x4 (&acc)[2][2][4][2], const pg8::Unit& u, int wr, int wc, int fr, int fq) const {
        const bf16_t* src = FIN ? SGB : R;
        const size_t base = (size_t)(u.pm * 256 + wr * 64 + fr) * 1024 + u.pn * 256 + wc * 32 + 8 * fq;
#pragma unroll
        for (int am = 0; am < 4; ++am) { const int ai = am >> 1;
            u32x4 gv[4][2];
#pragma unroll
            for (int m = 2 * (am & 1); m < 2 * (am & 1) + 2; ++m)
#pragma unroll
                for (int bj = 0; bj < 2; ++bj) gv[m][bj] = __builtin_nontemporal_load((const u32x4*)(src + gate_block(u.pm, 2 * u.pn + bj, wr, wc, ai, m) + (size_t)(fq * 16 + fr) * 8));
#pragma unroll
            for (int m = 2 * (am & 1); m < 2 * (am & 1) + 2; ++m)
#pragma unroll
                for (int bj = 0; bj < 2; ++bj) { const u32x4 gq = gv[m][bj];
                    f32x4 a = acc[ai][bj][m][0], b = acc[ai][bj][m][1];
                    a.x *= bflo(gq.x); a.y *= bfhi(gq.x); a.z *= bflo(gq.y); a.w *= bfhi(gq.y); b.x *= bflo(gq.z); b.y *= bfhi(gq.z); b.z *= bflo(gq.w); b.w *= bfhi(gq.w);
                    if (FIN) { u32x4 w; w.x = cvt_pk_bf16(a.x, a.y); w.y = cvt_pk_bf16(a.z, a.w); w.z = cvt_pk_bf16(b.x, b.y); w.w = cvt_pk_bf16(b.z, b.w);
                        *(u32x4*)(MM + base + (size_t)(ai * 128 + m * 16) * 1024 + bj * 128) = w; }
                    else { acc[ai][bj][m][0] = a; acc[ai][bj][m][1] = b; } }
            asm volatile("" ::: "memory");
        }
    }
};
struct EpiOut {
    const float* x; const float* MOD; float* out;
    DI int vm_ops(const pg8::Unit&) const { return 0; }
    DI void mid(f32x4 (&)[2][2][4][2], const pg8::Unit&, int, int, int, int) const {}
    DI void operator()(const f32x4 (&acc)[2][2][4][2], const pg8::Unit& u, int wr, int wc, int fr, int fq) const {
        const int col0 = u.pn * 256 + wc * 32 + 8 * fq; const float* gp = MOD + (u.pm >> 4) * 3072 + 2048 + col0;
        f32x4 gx[2][2];
#pragma unroll
        for (int bj = 0; bj < 2; ++bj)
#pragma unroll
            for (int n = 0; n < 2; ++n) gx[bj][n] = *(const f32x4*)(gp + bj * 128 + 4 * n);
#pragma unroll
        for (int ai = 0; ai < 2; ++ai)
#pragma unroll
            for (int m = 0; m < 4; ++m) { const size_t off = (size_t)(u.pm * 256 + ai * 128 + wr * 64 + m * 16 + fr) * 1024 + col0;
#pragma unroll
                for (int bj = 0; bj < 2; ++bj)
#pragma unroll
                    for (int n = 0; n < 2; ++n) { const f32x4 xv = *(const f32x4*)(x + off + bj * 128 + 4 * n); *(f32x4*)(out + off + bj * 128 + 4 * n) = xv + gx[bj][n] * acc[ai][bj][m][n]; }
                if (m & 1) asm volatile("" ::: "memory"); }
    }
};
struct EpiOutNorm {
    const float* x; const float* MOD; float* out; const float* fw; float* slots; unsigned* cnt; LAS float* tab;
    DI int vm_ops(const pg8::Unit&) const { return 0; }
    DI void mid(f32x4 (&)[2][2][4][2], const pg8::Unit&, int, int, int, int) const {}
    DI void operator()(const f32x4 (&acc_)[2][2][4][2], const pg8::Unit& u, int wr, int wc, int fr, int fq) const {
        f32x4 (&acc)[2][2][4][2] = const_cast<f32x4 (&)[2][2][4][2]>(acc_);
        const int col0 = u.pn * 256 + wc * 32 + 8 * fq; const float* gp = MOD + (u.pm >> 4) * 3072 + 2048 + col0;
        f32x4 gx[2][2];
#pragma unroll
        for (int bj = 0; bj < 2; ++bj)
#pragma unroll
            for (int n = 0; n < 2; ++n) gx[bj][n] = *(const f32x4*)(gp + bj * 128 + 4 * n);
#pragma unroll
        for (int ai = 0; ai < 2; ++ai)
#pragma unroll
            for (int m = 0; m < 4; ++m) { const int row = u.pm * 256 + ai * 128 + wr * 64 + m * 16 + fr; const size_t off = (size_t)row * 1024 + col0; float ss = 0.f;
#pragma unroll
                for (int bj = 0; bj < 2; ++bj)
#pragma unroll
                    for (int n = 0; n < 2; ++n) { const f32x4 xv = *(const f32x4*)(x + off + bj * 128 + 4 * n); const f32x4 v = xv + gx[bj][n] * acc[ai][bj][m][n]; acc[ai][bj][m][n] = v;
                        ss += (v.x * v.x + v.y * v.y) + (v.z * v.z + v.w * v.w); }
                ss += __shfl_xor(ss, 16); ss += __shfl_xor(ss, 32);
                if (fq == 0) __hip_atomic_store(slots + (size_t)row * 16 + u.pn * 4 + wc, ss, __ATOMIC_RELAXED, __HIP_MEMORY_SCOPE_AGENT);
                if (m & 1) asm volatile("" ::: "memory"); }
        asm volatile("s_waitcnt vmcnt(0)" ::: "memory");
        __syncthreads();
        if (threadIdx.x == 0) {
            unsigned* c = cnt + 64 * u.pm;
            __hip_atomic_fetch_add(c, 1u, __ATOMIC_RELAXED, __HIP_MEMORY_SCOPE_AGENT);
            unsigned sp = 0;
            while (__hip_atomic_load(c, __ATOMIC_RELAXED, __HIP_MEMORY_SCOPE_AGENT) < 4u) { __builtin_amdgcn_s_sleep(1); if (++sp > (1u << 22)) break; }
            __builtin_amdgcn_fence(__ATOMIC_ACQUIRE, "agent");
            asm volatile("s_waitcnt vmcnt(0)" ::: "memory");
        }
        __syncthreads();
        { const int t = threadIdx.x, row = t >> 1, half = t & 1; const float* sp = slots + (size_t)(u.pm * 256 + row) * 16 + half * 8; float s = 0.f;
#pragma unroll
            for (int j = 0; j < 8; ++j) s += __hip_atomic_load(sp + j, __ATOMIC_RELAXED, __HIP_MEMORY_SCOPE_AGENT);
            s += __shfl_xor(s, 1);
            if (half == 0) tab[row] = 1.0f / sqrtf(s * (1.f / 1024.f) + EPS); }
        __syncthreads();
        f32x4 fv[2][2];
#pragma unroll
        for (int bj = 0; bj < 2; ++bj)
#pragma unroll
            for (int n = 0; n < 2; ++n) fv[bj][n] = *(const f32x4*)(fw + col0 + bj * 128 + 4 * n);
#pragma unroll
        for (int ai = 0; ai < 2; ++ai)
#pragma unroll
            for (int m = 0; m < 4; ++m) { const int rl = ai * 128 + wr * 64 + m * 16 + fr; const float r = tab[rl]; const size_t off = (size_t)(u.pm * 256 + rl) * 1024 + col0;
#pragma unroll
                for (int bj = 0; bj < 2; ++bj)
#pragma unroll
                    for (int n = 0; n < 2; ++n) *(f32x4*)(out + off + bj * 128 + 4 * n) = acc[ai][bj][m][n] * r * fv[bj][n]; }
    }
};
DI void n6_ab(const Ctx& F) {
    const Tid T = opaque_tid();
    const size_t NT = (size_t)gridDim.x * 512, gt = (size_t)blockIdx.x * 512 + T.tid;
    for (size_t idx = gt; idx < (size_t)(MTOK / 4) * 1024; idx += NT) {
        const int n = (int)(idx & 1023), t0 = (int)(idx >> 10) * 4; float ya[4] = {0.f, 0.f, 0.f, 0.f}, yb[4] = {0.f, 0.f, 0.f, 0.f};
        for (int k = 0; k < 1024; ++k) { const float wa = F.w_a[(size_t)k * 1024 + n], wb = F.w_b[(size_t)k * 1024 + n];
#pragma unroll
            for (int j = 0; j < 4; ++j) { ya[j] += bf2f(F.P[(size_t)(t0 + j) * 1024 + k]) * wa; yb[j] += bf2f(F.UB[(size_t)(t0 + j) * 1024 + k]) * wb; } }
#pragma unroll
        for (int j = 0; j < 4; ++j) { const size_t o = (size_t)(t0 + j) * 1024 + n; const size_t gi = gate_index(t0 + j, n); const float sgb = bf2f(F.SGB[gi]), sga = bf2f(F.R[gi]) * sgb; F.MM[o] = f2bf(sga * ya[j] + sgb * yb[j]); }
    }
}
DI void n7_out(const Ctx& F) {
    const Tid T = opaque_tid();
    const size_t NT = (size_t)gridDim.x * 512, gt = (size_t)blockIdx.x * 512 + T.tid;
    for (size_t idx = gt; idx < (size_t)(MTOK / 4) * 1024; idx += NT) {
        const int n = (int)(idx & 1023), t0 = (int)(idx >> 10) * 4; float y[4] = {0.f, 0.f, 0.f, 0.f};
        for (int k = 0; k < 1024; ++k) { const float w = F.w_out[(size_t)k * 1024 + n];
#pragma unroll
            for (int j = 0; j < 4; ++j) y[j] += bf2f(F.MM[(size_t)(t0 + j) * 1024 + k]) * w; }
#pragma unroll
        for (int j = 0; j < 4; ++j) { const size_t o = (size_t)(t0 + j) * 1024 + n; F.out[o] = F.x[o] + F.MOD[((t0 + j) >> 12) * 3072 + 2048 + n] * y[j]; }
    }
}
DI void p8_final(const Ctx& F) {
    const Tid T = opaque_tid();
    const int gw = blockIdx.x * 8 + T.wave, NGW = gridDim.x * 8;
    for (int m = gw; m < MTOK; m += NGW) {
        f32x4* xr = (f32x4*)(F.out + (size_t)m * DM);
        f32x4 v[4]; float ss = 0.f;
#pragma unroll
        for (int j = 0; j < 4; ++j) { v[j] = xr[T.lane + 64 * j]; ss += (v[j].x * v[j].x + v[j].y * v[j].y) + (v[j].z * v[j].z + v[j].w * v[j].w); }
        const float rstd = 1.0f / sqrtf(wave_sum(ss) * (1.f / DM) + EPS);
#pragma unroll
        for (int j = 0; j < 4; ++j) { const f32x4 w = *(const f32x4*)(F.final_w + 4 * (T.lane + 64 * j)); xr[T.lane + 64 * j] = v[j] * rstd * w; }
    }
}

constexpr int NPH = 9;
__global__ void __launch_bounds__(512, 2) fwd_kernel(Args args) {
    extern __shared__ __attribute__((aligned(16))) unsigned char lds_raw[];
    Ctx F;
    F.lds = (LAS unsigned char*)lds_raw;
    if (threadIdx.x < 16) ((LAS unsigned*)(F.lds + LDS_MISC))[threadIdx.x] = 0u;
#if !MK_LAUNCH_PER_PHASE
    {
        unsigned* flag = (unsigned*)(args.ws + WS_FLAG); unsigned* done = flag + 64;
        if (blockIdx.x == 0) {
            for (unsigned i = threadIdx.x; i < WS_BAR_BYTES / 16; i += 512) ((u32x4*)(args.ws + WS_BAR))[i] = (u32x4){0u, 0u, 0u, 0u};
            if (threadIdx.x == 0) __hip_atomic_store(done, 0u, __ATOMIC_RELAXED, __HIP_MEMORY_SCOPE_AGENT);
            asm volatile("s_waitcnt vmcnt(0)" ::: "memory");
            __syncthreads();
            if (threadIdx.x == 0) { __builtin_amdgcn_fence(__ATOMIC_RELEASE, "agent"); asm volatile("s_waitcnt vmcnt(0)" ::: "memory");
                __hip_atomic_store(flag, CTL_MAGIC, __ATOMIC_RELAXED, __HIP_MEMORY_SCOPE_AGENT); }
        } else if (threadIdx.x == 0) {
            unsigned sp = 0;
            while (__hip_atomic_load(flag, __ATOMIC_RELAXED, __HIP_MEMORY_SCOPE_AGENT) != CTL_MAGIC) { __builtin_amdgcn_s_sleep(1); if (++sp > (1u << 22)) break; }
            __builtin_amdgcn_fence(__ATOMIC_ACQUIRE, "agent"); asm volatile("s_waitcnt vmcnt(0)" ::: "memory");
        }
    }
#endif
    __syncthreads();
    const XcdBarrier bar = xcd_barrier_post((unsigned*)(args.ws + WS_BAR), (volatile LAS unsigned*)(F.lds + LDS_MISC));
    F.x = args.in[0]; F.c = args.in[1]; F.ctx = args.in[2]; F.c_ctx = args.in[3]; F.norm_w = args.in[4]; F.ada_w = args.in[5]; F.ada_b = args.in[6]; F.w_in = args.in[7];
    F.conv_w = args.in[8]; F.conv_b = args.in[9]; F.decay_logit = args.in[10]; F.gn_w = args.in[11]; F.w_a = args.in[12]; F.w_b = args.in[13]; F.w_out = args.in[14]; F.final_w = args.in[15];
    F.out = args.out; unsigned char* ws = args.ws; F.ws = ws;
    F.MOD = (float*)(ws + WS_MOD); F.ROPE = (f32x2*)(ws + WS_ROPE);
    F.WA = (bf16_t*)(ws + WS_WA); F.WB = (bf16_t*)(ws + WS_WB); F.WOUT = (bf16_t*)(ws + WS_WOUT); F.WIN = (bf16_t*)(ws + WS_WIN); F.XM = (bf16_t*)(ws + WS_XM);
    F.KV = (bf16_t*)(ws + WS_KV); F.KVC = (bf16_t*)(ws + WS_KVC); F.HC = (bf16_t*)(ws + WS_HC); F.ST = (bf16_t*)(ws + WS_ST); F.MM = (bf16_t*)(ws + WS_MM);
    F.P = (bf16_t*)(ws + WS_P); F.Q = (bf16_t*)(ws + WS_Q); F.K = (bf16_t*)(ws + WS_K); F.V = (bf16_t*)(ws + WS_V); F.SZB = (bf16_t*)(ws + WS_SZB);
    F.KC = (bf16_t*)(ws + WS_KC); F.VC = (bf16_t*)(ws + WS_VC); F.UB = (bf16_t*)(ws + WS_UB);
    F.R = (bf16_t*)args.out; F.SGB = (bf16_t*)args.out + (size_t)MTOK * DM;
    F.RET = (float*)(ws + WS_RET); F.S0 = (float*)(ws + WS_KVC);
    const int lo = args.ph_lo, hi = args.ph_hi; const unsigned naive = args.naive;
#define IN(k) (lo <= (k) && (k) < hi && ((MK_PHASES >> (k)) & 1))
#define NAIVE(k) (((naive & MK_NAIVE_AVAIL) >> (k)) & 1u)
#define SEAM(k) do { if (IN(k) && IN((k) + 1)) xcd_barrier(bar); } while (0)
#define REP(k) for (int rep_ = 0; rep_ < 1 + (int)((MK_REP_MASK >> (k)) & 1u); ++rep_)
    if (IN(0)) REP(0) { p0_prologue(F); } SEAM(0);
    if (IN(1)) REP(1) { p1_rows(F); } SEAM(1);
    if (IN(2)) REP(2) {
        if (NAIVE(2)) n2_inproj(F);
        else { const char* const Ab[2] = {(const char*)F.XM, (const char*)F.XM}; const char* const Bb[2] = {(const char*)F.WIN, (const char*)F.WIN};
            Sched1 S{(int)gridDim.x, (int)blockIdx.x}; Epi1 E{F.ws, F.R, F.SGB, F.ROPE};
            pg8::gemm_phase<1, Epi1, Sched1>(F.lds, Ab, Bb, S, E); }
    } SEAM(2);
    if (IN(3)) {
        if (!NAIVE(3)) {
            const char* const Ab[2] = {(const char*)F.XM, (const char*)F.XM}; const char* const Bb[2] = {(const char*)F.WIN, (const char*)F.WIN};
            SchedCtx S{(int)blockIdx.x}; Epi1 E{F.ws, F.R, F.SGB, F.ROPE};
            pg8::gemm_phase<1, Epi1, SchedCtx>(F.lds, Ab, Bb, S, E);
            if (blockIdx.x >= 24) { REP(3) p3_kv(F, blockIdx.x - 24, 1024, gridDim.x - 24); p3_ua(F, blockIdx.x - 24, gridDim.x - 24); }
        } else p3_ua(F, blockIdx.x, gridDim.x);
    } SEAM(3);
    if (IN(4)) REP(4) { if (NAIVE(4)) n4_recurrence(F); else { if (blockIdx.x >= gridDim.x - 32) p4_ctx_state(F, blockIdx.x - (gridDim.x - 32)); else p4_scan(F, blockIdx.x, gridDim.x - 32); } } SEAM(4);
    if (IN(5)) REP(5) { if (NAIVE(5)) n5_groupnorm(F); else p5_ret(F); } SEAM(5);
    if (IN(6)) REP(6) {
        if (NAIVE(6)) n6_ab(F);
        else { const char* const Ab[2] = {(const char*)F.P, (const char*)F.UB}; const char* const Bb[2] = {(const char*)F.WA, (const char*)F.WB};
            SchedSq S{(int)gridDim.x, (int)blockIdx.x}; EpiAB E{F.R, F.SGB, F.MM};
            pg8::gemm_phase<2, EpiAB, SchedSq>(F.lds, Ab, Bb, S, E); }
    } SEAM(6);
    if (IN(7)) {
        const char* const Ab[2] = {(const char*)F.MM, (const char*)F.MM}; const char* const Bb[2] = {(const char*)F.WOUT, (const char*)F.WOUT};
        SchedSq S{(int)gridDim.x, (int)blockIdx.x};
        if (NAIVE(7)) n7_out(F);
        else if (gridDim.x == 256) {
            EpiOutNorm E{F.x, F.MOD, F.out, F.final_w, (float*)(F.ws + WS_SLOTS), (unsigned*)(F.ws + WS_PCNT), (LAS float*)(F.lds + LDS_TAB)};
            pg8::gemm_phase<1, EpiOutNorm, SchedSq>(F.lds, Ab, Bb, S, E); }
        else { EpiOut E{F.x, F.MOD, F.out}; pg8::gemm_phase<1, EpiOut, SchedSq>(F.lds, Ab, Bb, S, E); }
    }
    if (NAIVE(7) || gridDim.x != 256) { SEAM(7); if (IN(8)) { p8_final(F); } }
#if !MK_LAUNCH_PER_PHASE
    __syncthreads();
    if (threadIdx.x == 0) { unsigned* flag = (unsigned*)(args.ws + WS_FLAG); unsigned* done = flag + 64;
        if (__hip_atomic_fetch_add(done, 1u, __ATOMIC_RELAXED, __HIP_MEMORY_SCOPE_AGENT) == gridDim.x - 1) __hip_atomic_store(flag, 0u, __ATOMIC_RELAXED, __HIP_MEMORY_SCOPE_AGENT); }
#endif
#undef IN
#undef NAIVE
#undef SEAM
}

extern "C" void kernel_launch(void* const* d_in, const int* in_sizes, int n_in, void* d_out, int out_size, void* d_ws, size_t ws_size, hipStream_t stream) {
    static int grid = 0;
    if (grid == 0) {
        if (n_in != 16 || out_size != MTOK * DM || ws_size < WS_END) { fprintf(stderr, "kernel_launch: unexpected shapes (n_in %d out %d ws %zu)\n", n_in, out_size, ws_size); grid = -1; return; }
        int dev = 0, cus = 0, per_cu = 0;
        hipGetDevice(&dev); hipDeviceGetAttribute(&cus, hipDeviceAttributeMultiprocessorCount, dev);
        hipFuncSetAttribute((const void*)fwd_kernel, hipFuncAttributeMaxDynamicSharedMemorySize, LDS_BYTES);
        hipOccupancyMaxActiveBlocksPerMultiprocessor(&per_cu, (const void*)fwd_kernel, 512, LDS_BYTES);
        if (per_cu < 1) { fprintf(stderr, "kernel_launch: occupancy query says %d blocks/CU\n", per_cu); per_cu = 1; }
        grid = cus;
        (void)hipGetLastError();
    }
    if (grid < 0) return;
    Args a{};
    for (int i = 0; i < 16; ++i) a.in[i] = (const float*)d_in[i];
    a.out = (float*)d_out; a.ws = (unsigned char*)d_ws; a.naive = MK_NAIVE_MASK;
#if MK_LAUNCH_PER_PHASE
    hipMemsetAsync((unsigned char*)d_ws + WS_BAR, 0, WS_BAR_BYTES, stream);
#endif
#if MK_LAUNCH_PER_PHASE
    for (int ph = 0; ph < NPH; ++ph) { a.ph_lo = ph; a.ph_hi = ph + 1; hipLaunchKernelGGL(fwd_kernel, dim3(grid), dim3(512), LDS_BYTES, stream, a); }
#else
    a.ph_lo = 0; a.ph_hi = NPH;
    hipLaunchKernelGGL(fwd_kernel, dim3(grid), dim3(512), LDS_BYTES, stream, a);
#endif
}
```

```cpp
#include <hip/hip_runtime.h>
#include <cstdio>
#include <cstdint>

#ifndef MK_LAUNCH_PER_PHASE
#define MK_LAUNCH_PER_PHASE 0
#endif
#ifndef MK_NAIVE_MASK
#define MK_NAIVE_MASK 0x00u
#endif

#ifndef MK_REP_MASK
#define MK_REP_MASK 0u
#endif
#ifndef MK_PHASES
#define MK_PHASES 0x1ff
#endif
#ifndef MK_NAIVE_AVAIL
#define MK_NAIVE_AVAIL 0xffu
#endif
#define DI __device__ __forceinline__
#define LAS __attribute__((address_space(3)))
typedef unsigned short bf16_t;
typedef float f32x4 __attribute__((ext_vector_type(4)));
typedef float f32x2 __attribute__((ext_vector_type(2)));
typedef unsigned u32x4 __attribute__((ext_vector_type(4)));
typedef unsigned u32x2 __attribute__((ext_vector_type(2)));
typedef short bf16x8 __attribute__((ext_vector_type(8)));
typedef short s16x4 __attribute__((ext_vector_type(4)));
typedef short v4i16_t __attribute__((ext_vector_type(4)));

constexpr int NB = 4, SEQ = 4096, DM = 1024, MTOK = NB * SEQ, CTXL = 256, MCTX = NB * CTXL, MALL = MTOK + MCTX;
constexpr int NIN = 9216, NH = 8, DK = 64, DV = 128, CHK = 128, NCHK = SEQ / CHK;
constexpr float EPS = 1e-6f;
constexpr size_t MiB = 1u << 20;
constexpr size_t WS_MOD = 0;
constexpr size_t WS_ROPE = 65536;
constexpr size_t WS_WA = 2 * MiB, WS_WB = 4 * MiB, WS_WOUT = 6 * MiB, WS_WIN = 8 * MiB;
constexpr size_t WS_XM = 26 * MiB;
constexpr size_t WS_KV = 223 * MiB;
constexpr size_t WS_KVC = 40 * MiB;
constexpr size_t WS_RET = 8 * MiB;
constexpr size_t WS_HC = 60 * MiB;
constexpr size_t WS_ST = 60 * MiB;
constexpr size_t WS_MM = 60 * MiB;
constexpr size_t WS_P = 92 * MiB;
constexpr size_t WS_Q = 124 * MiB, WS_K = 140 * MiB, WS_V = 156 * MiB, WS_SZB = 188 * MiB;
constexpr size_t WS_KC = 220 * MiB, WS_VC = 221 * MiB;
constexpr size_t WS_UB = 223 * MiB;
constexpr size_t WS_END = 255 * MiB;
constexpr int LDS_BYTES = 147456;
constexpr int LDS_MISC = 139264;
constexpr size_t WS_BAR = 131072, WS_BAR_BYTES = 65536;
constexpr size_t WS_PCNT = WS_BAR + 16384, WS_SLOTS = 1 * MiB;
constexpr size_t WS_FLAG = 98304;
constexpr unsigned CTL_MAGIC = 0x600DF1A6u;
constexpr int LDS_TAB = 132096;

DI float bf2f(bf16_t v) { return __uint_as_float((unsigned)v << 16); }
DI float bflo(unsigned w) { return __uint_as_float(w << 16); }
DI float bfhi(unsigned w) { return __uint_as_float(w & 0xffff0000u); }
typedef __bf16 bf16x2_t __attribute__((ext_vector_type(2)));
DI unsigned cvt_pk_bf16(float lo, float hi) { const f32x2 f = {lo, hi}; const bf16x2_t v = __builtin_convertvector(f, bf16x2_t); return __builtin_bit_cast(unsigned, v); }
DI bf16_t f2bf(float f) { return (bf16_t)(cvt_pk_bf16(f, 0.f) & 0xffffu); }
DI float wave_sum(float v) {
#pragma unroll
    for (int o = 1; o < 64; o <<= 1) v += __shfl_xor(v, o);
    return v;
}
struct Tid { int tid, lane, wave; };
DI Tid opaque_tid() { int t = threadIdx.x; asm volatile("" : "+v"(t)); Tid r; r.tid = t; r.lane = t & 63; r.wave = __builtin_amdgcn_readfirstlane(t >> 6); return r; }
DI float siluf(float x) { return x * __builtin_amdgcn_rcpf(1.f + __expf(-x)); }
DI float log2_gamma(const float* decay_logit, int dir, int h) {
    const float x = decay_logit[dir * NH + h];
    const float ls = fminf(x, 0.f) - log1pf(expf(-fabsf(x)));
    return ls * 1.4426950408889634f;
}

namespace pg8 {
constexpr int BM = 256, BK = 64, HALF = 128, HTB = HALF * BK * 2, STAGE_BYTES = 8 * HTB, NXCD = 8, WGM = 4;
DI int lds_byte(int r, int c) { const int st = (r >> 4) * 2 + (c >> 5), rr = r & 15, cc = c & 31, ob = rr * 64 + cc * 2; return st * 1024 + (ob ^ (((ob >> 9) & 1) << 5)); }
DI void stage_rc(int b, int& R, int& C) { const int st = b / 1024, sb = b % 1024, swz = sb ^ (((sb >> 9) & 1) << 5); R = (st >> 1) * 16 + swz / 64; C = (st & 1) * 32 + (swz % 64) / 2; }
DI int perm32(int rho) { const int n = rho >> 4, i = rho & 15; return 8 * (i >> 2) + 4 * n + (i & 3); }
struct Unit { int pm, pn; };
DI void tile_of(int L, int nM, int nN, Unit& u) {
    const int nwg = nM * nN; int wgid = L;
    { const int q = nwg / NXCD, r = nwg % NXCD, xcd = wgid % NXCD, off = wgid / NXCD; wgid = (xcd < r ? xcd * (q + 1) : r * (q + 1) + (xcd - r) * q) + off; }
    const int nig = WGM * nN, gid = wgid / nig, fm = gid * WGM, gsz = (nM - fm) < WGM ? (nM - fm) : WGM;
    u.pm = fm + ((wgid % nig) % gsz); u.pn = (wgid % nig) / gsz;
}
template <int NSEG, class Epi, class Sched>
DI void gemm_phase(LAS unsigned char* lds, const char* const (&Ab)[2], const char* const (&Bb)[2], const Sched& S, const Epi& E) {
    constexpr int K = 1024, NTS = K / BK;
    constexpr int nt = NSEG * NTS;
    const Tid T = opaque_tid();
    const int tid = T.tid, wid = T.wave, lane = T.lane, wr = wid >> 2, wc = (wid & 3) ^ (wr << 1), fr = lane & 15, fq = lane >> 4;
    unsigned voffA[2], voffB[2];
#pragma unroll
    for (int i = 0; i < 2; ++i) { int R, C; stage_rc(tid * 16 + i * 8192, R, C); const int Rb = (R & ~31) + perm32(R & 31);
        voffA[i] = (unsigned)(R * K + C) * 2u; voffB[i] = (unsigned)(Rb * K + C) * 2u; }
    constexpr size_t kstep = (size_t)(BK * 2);
    constexpr size_t hstep = (size_t)HALF * K * 2;
    constexpr size_t tstep = 2 * hstep;
    const unsigned ldsw = (unsigned)wid * 1024u;
    const int aoff = lds_byte(wr * 64 + fr, fq * 8), boff = lds_byte(wc * 32 + fr, fq * 8);
#define PG8_SA(b, h) (((b) * 2 + (h)) * HTB)
#define PG8_SB(b, h) ((4 + (b) * 2 + (h)) * HTB)
#define PG8_STAGE(bufoff, gbase, voff) do { _Pragma("unroll") for (int _i = 0; _i < 2; ++_i) \
        __builtin_amdgcn_global_load_lds((const unsigned*)((const char*)(gbase) + (voff)[_i]), (LAS unsigned*)(lds + (bufoff) + ldsw + _i * 8192), 16, 0, 0); } while (0)
#define PG8_LDA(dst, b, h) do { _Pragma("unroll") for (int m = 0; m < 4; ++m) _Pragma("unroll") for (int k = 0; k < 2; ++k) dst[m][k] = *(const LAS bf16x8*)(lds + PG8_SA(b, h) + aoff + m * 2048 + k * 1024); } while (0)
#define PG8_LDB(dst, b, h) do { _Pragma("unroll") for (int n = 0; n < 2; ++n) _Pragma("unroll") for (int k = 0; k < 2; ++k) dst[n][k] = *(const LAS bf16x8*)(lds + PG8_SB(b, h) + boff + n * 2048 + k * 1024); } while (0)
#define PG8_MMA(ai, bj, At, Bt) do { __builtin_amdgcn_s_setprio(1); _Pragma("unroll") for (int m = 0; m < 4; ++m) _Pragma("unroll") for (int n = 0; n < 2; ++n) _Pragma("unroll") for (int k = 0; k < 2; ++k) \
        acc[ai][bj][m][n] = __builtin_amdgcn_mfma_f32_16x16x32_bf16(Bt[n][k], At[m][k], acc[ai][bj][m][n], 0, 0, 0); __builtin_amdgcn_s_setprio(0); } while (0)
#define PG8_WAIT_V(n) asm volatile("s_waitcnt vmcnt(" #n ")" ::: "memory")
#define PG8_WAIT_L(n) asm volatile("s_waitcnt lgkmcnt(" #n ")" ::: "memory")
#define PG8_WAIT_VR(sel) asm volatile("s_cmp_lt_i32 %0, 8\n\ts_cbranch_scc1 .Lw8_%=\n\ts_cmp_lt_i32 %0, 16\n\ts_cbranch_scc1 .Lw16_%=\n\ts_waitcnt vmcnt(24)\n\ts_branch .Lwe_%=\n.Lw16_%=:\n\ts_waitcnt vmcnt(16)\n\ts_branch .Lwe_%=\n.Lw8_%=:\n\ts_waitcnt vmcnt(8)\n.Lwe_%=:" :: "s"(sel) : "memory", "scc")
#define PG8_BAR __builtin_amdgcn_s_barrier()
#define PG8_SCHED __builtin_amdgcn_sched_barrier(0)
#define PG8_TA(u, t) (Ab[(t) / NTS] + (size_t)(u).pm * tstep + (size_t)((t) % NTS) * kstep)
#define PG8_TB(u, t) (Bb[(t) / NTS] + (size_t)(u).pn * tstep + (size_t)((t) % NTS) * kstep)
    Unit cur, nxt; int ui = 0;
    if (!S.next(0, cur)) return;
    f32x4 acc[2][2][4][2];
#pragma unroll
    for (int a = 0; a < 2; ++a)
#pragma unroll
        for (int b = 0; b < 2; ++b)
#pragma unroll
            for (int m = 0; m < 4; ++m)
#pragma unroll
                for (int n = 0; n < 2; ++n) acc[a][b][m][n] = (f32x4){0.f, 0.f, 0.f, 0.f};
    bf16x8 At[4][2], B0[2][2], B1[2][2];
    {
        const char* cA = PG8_TA(cur, 0); const char* cB = PG8_TB(cur, 0);
        PG8_STAGE(PG8_SB(0, 0), cB, voffB); PG8_STAGE(PG8_SB(0, 1), cB + hstep, voffB); PG8_STAGE(PG8_SA(0, 0), cA, voffA); PG8_STAGE(PG8_SA(0, 1), cA + hstep, voffA);
        if (wr == 1) PG8_BAR;
        PG8_WAIT_V(2); PG8_BAR;
        PG8_STAGE(PG8_SB(1, 0), cB + kstep, voffB); PG8_STAGE(PG8_SA(1, 0), cA + kstep, voffA); PG8_STAGE(PG8_SB(1, 1), cB + hstep + kstep, voffB);
        PG8_WAIT_V(6); PG8_BAR;
    }
    for (;;) {
        const bool has_next = S.next(ui + 1, nxt);
        const Unit nu = has_next ? nxt : cur;
        for (int t = 0; t < nt; t += 2) {
            if (NSEG == 2 && t == NTS) E.mid(acc, cur, wr, wc, fr, fq);
            const bool last = (t == nt - 2);
            const char* a1 = PG8_TA(cur, t + 1);
            const char* a2 = last ? PG8_TA(nu, 0) : PG8_TA(cur, t + 2); const char* b2 = last ? PG8_TB(nu, 0) : PG8_TB(cur, t + 2);
            const char* a3 = a2 + kstep; const char* b3 = b2 + kstep;
            PG8_LDB(B0, 0, 0); PG8_LDB(B1, 0, 1); PG8_SCHED; PG8_LDA(At, 0, 0); PG8_STAGE(PG8_SA(1, 1), a1 + hstep, voffA);
            PG8_WAIT_V(8); PG8_WAIT_L(0); PG8_BAR; PG8_MMA(0, 0, At, B0); PG8_MMA(0, 1, At, B1); PG8_BAR; PG8_SCHED;
            PG8_LDA(At, 0, 1); PG8_STAGE(PG8_SB(0, 0), b2, voffB); PG8_STAGE(PG8_SB(0, 1), b2 + hstep, voffB); PG8_STAGE(PG8_SA(0, 0), a2, voffA);
            PG8_WAIT_V(8); PG8_WAIT_L(0); PG8_BAR; PG8_MMA(1, 0, At, B0); PG8_MMA(1, 1, At, B1); PG8_BAR; PG8_SCHED;
            PG8_LDB(B0, 1, 0); PG8_LDB(B1, 1, 1); PG8_SCHED; PG8_LDA(At, 1, 0); PG8_STAGE(PG8_SA(0, 1), a2 + hstep, voffA);
            PG8_WAIT_V(8); PG8_WAIT_L(0); PG8_BAR; PG8_MMA(0, 0, At, B0); PG8_MMA(0, 1, At, B1); PG8_BAR; PG8_SCHED;
            PG8_LDA(At, 1, 1); PG8_STAGE(PG8_SB(1, 0), b3, voffB); PG8_STAGE(PG8_SB(1, 1), b3 + hstep, voffB); PG8_STAGE(PG8_SA(1, 0), a3, voffA);
            PG8_WAIT_V(8); PG8_WAIT_L(0); PG8_BAR; PG8_MMA(1, 0, At, B0); PG8_MMA(1, 1, At, B1); PG8_BAR; PG8_SCHED;
        }
        if (wr == 0) PG8_BAR;
        E(acc, cur, wr, wc, fr, fq);
        if (!has_next) break;
#pragma unroll
        for (int a = 0; a < 2; ++a)
#pragma unroll
            for (int b = 0; b < 2; ++b)
#pragma unroll
                for (int m = 0; m < 4; ++m)
#pragma unroll
                    for (int n = 0; n < 2; ++n) acc[a][b][m][n] = (f32x4){0.f, 0.f, 0.f, 0.f};
        cur = nxt; ++ui;
        if (wr == 1) PG8_BAR;
    }
    PG8_WAIT_V(0);
    PG8_BAR;
#undef PG8_SA
#undef PG8_SB
#undef PG8_STAGE
#undef PG8_LDA
#undef PG8_LDB
#undef PG8_MMA
#undef PG8_WAIT_V
#undef PG8_WAIT_L
#undef PG8_WAIT_VR
#undef PG8_BAR
#undef PG8_SCHED
#undef PG8_TA
#undef PG8_TB
}
}


#define XB_TMO      128
#define XB_XCNT(j)  (256  + 64 * (j))
#define XB_XSUB(j)  (1280 + 64 * (j))
#define XB_XGEN(j)  (2304 + 64 * (j))
#define XB_TOP      3328
#define XB_TOPGEN   3392
#define XCD_BAR_WORDS 3456
#define XB_SPIN_CAP (1u << 18)
DI unsigned xb_ld(unsigned* p)              { return __hip_atomic_load(p, __ATOMIC_RELAXED, __HIP_MEMORY_SCOPE_AGENT); }
DI unsigned xb_add(unsigned* p, unsigned v) { return __hip_atomic_fetch_add(p, v, __ATOMIC_RELAXED, __HIP_MEMORY_SCOPE_AGENT); }
DI unsigned xb_xcc_id() { return (unsigned)__builtin_amdgcn_s_getreg((3 << 11) | 20) & 0xFu; }
#define XB_SPIN(cond, bar) do { unsigned _sp = 0; while (cond) { __builtin_amdgcn_s_sleep(1); \
    if ((++_sp & 255u) == 0u) { if (xb_ld(&(bar)[XB_TMO])) break; if (_sp > XB_SPIN_CAP) { atomicAdd(&(bar)[XB_TMO], 1u); break; } } } } while (0)
struct XcdBarrier { unsigned* bar; unsigned x; volatile LAS unsigned* st; };
DI XcdBarrier xcd_barrier_post(unsigned* bar, volatile LAS unsigned* st) {
    XcdBarrier b; b.bar = bar; b.x = xb_xcc_id(); b.st = st;
    if (threadIdx.x == 0) (void)xb_add(&bar[XB_XCNT(b.x)], 1u);
    return b;
}
DI void xcd_barrier_complete(unsigned* bar, unsigned x, unsigned& nloc, unsigned& nx) {
    const unsigned G = gridDim.x * gridDim.y * gridDim.z;
    unsigned sum, cnt, mine, sp = 0u;
    for (;;) {
        sum = 0u; cnt = 0u; mine = 0u;
#pragma unroll
        for (unsigned j = 0; j < 16; ++j) { const unsigned c = xb_ld(&bar[XB_XCNT(j)]); sum += c; cnt += (c > 0u) ? 1u : 0u; mine = (j == x) ? c : mine; }
        if (sum == G) break;
        __builtin_amdgcn_s_sleep(1);
        if ((++sp & 255u) == 0u) { if (xb_ld(&bar[XB_TMO])) break; if (sp > XB_SPIN_CAP) { atomicAdd(&bar[XB_TMO], 1u); break; } }
    }
    nloc = mine > 0u ? mine : 1u; nx = cnt > 0u ? cnt : 1u;
}
DI void xcd_barrier(const XcdBarrier& b) {
    asm volatile("s_waitcnt vmcnt(0)" ::: "memory");
    __syncthreads();
    if (threadIdx.x == 0) {
        unsigned* bar = b.bar;
        __builtin_amdgcn_s_waitcnt(0);
        unsigned nloc = b.st[0], nx = b.st[1];
        if (nloc == 0u) { xcd_barrier_complete(bar, b.x, nloc, nx); b.st[0] = nloc; b.st[1] = nx; }
        const unsigned old = xb_add(&bar[XB_XSUB(b.x)], 1u);
        const unsigned gen = old / nloc;
        if (old + 1u == (gen + 1u) * nloc) {
            __builtin_amdgcn_fence(__ATOMIC_RELEASE, "agent");
            asm volatile("s_waitcnt vmcnt(0)" ::: "memory");
            const unsigned og = xb_add(&bar[XB_TOP], 1u);
            const unsigned tg = og / nx;
            if (og + 1u == (tg + 1u) * nx) xb_add(&bar[XB_TOPGEN], 1u);
            else XB_SPIN(xb_ld(&bar[XB_TOPGEN]) == tg, bar);
            __builtin_amdgcn_fence(__ATOMIC_ACQUIRE, "agent");
            xb_add(&bar[XB_XGEN(b.x)], 1u);
            asm volatile("s_waitcnt vmcnt(0)" ::: "memory");
        } else {
            XB_SPIN(xb_ld(&bar[XB_XGEN(b.x)]) == gen, bar);
            __builtin_amdgcn_fence(__ATOMIC_ACQUIRE, "agent");
            asm volatile("s_waitcnt vmcnt(0)" ::: "memory");
        }
    }
    __syncthreads();
}

struct Args { const float* in[16]; float* out; unsigned char* ws; int ph_lo, ph_hi; unsigned naive; int pad; };
struct Ctx {
    LAS unsigned char* lds;
    const float *x, *c, *ctx, *c_ctx, *norm_w, *ada_w, *ada_b, *w_in, *conv_w, *conv_b, *decay_logit, *gn_w, *w_a, *w_b, *w_out, *final_w;
    float* out; unsigned char* ws;
    float* MOD; f32x2* ROPE;
    bf16_t *WA, *WB, *WOUT, *WIN, *XM, *KV, *KVC, *HC, *ST, *MM, *P, *Q, *K, *V, *SZB, *KC, *VC, *UB, *R, *SGB;
    float* RET; float* S0;
};

DI int win_dest(int o) {
    if (o < 4096) { const int g = o >> 10, ch = o & 1023; return 256 * (ch >> 6) + 64 * g + (ch & 63); }
    if (o < 5120) { const int qk = (o - 4096) >> 9, oo = (o - 4096) & 511, head = oo >> 6, i = oo & 63, t = head >> 2, hh = head & 3;
        return 256 * (16 + 2 * qk + t) + (i < 32 ? 32 * hh + i : 128 + 32 * hh + (i - 32)); }
    if (o < 7168) return o;
    { const int gs = (o - 7168) >> 10, ch = (o - 7168) & 1023; return 256 * (28 + (ch >> 7)) + 128 * gs + (ch & 127); }
}
DI void p0_transpose_item(const float* W, int K, int N, bf16_t* WT, bool permute, LAS float* scr, int item, int lane) {
    const int nblk = N / 32, kb = item / nblk, nb = item % nblk, k0 = 64 * kb, n0 = 32 * nb;
    f32x4 rv[8];
#pragma unroll
    for (int i = 0; i < 8; ++i) rv[i] = __builtin_nontemporal_load((const f32x4*)(W + (size_t)(k0 + 8 * i + (lane >> 3)) * N + n0 + 4 * (lane & 7)));
#pragma unroll
    for (int i = 0; i < 8; ++i) { LAS float* d = scr + (8 * i + (lane >> 3)) * 33 + 4 * (lane & 7); d[0] = rv[i].x; d[1] = rv[i].y; d[2] = rv[i].z; d[3] = rv[i].w; }
    asm volatile("s_waitcnt lgkmcnt(0)" ::: "memory");
    const int c = lane & 7; const int d0 = permute ? win_dest(n0) : n0;
#pragma unroll
    for (int j = 0; j < 4; ++j) { const int n = (lane >> 3) + 8 * j; const LAS float* sp = scr + (8 * c) * 33 + n;
        u32x4 o; o.x = cvt_pk_bf16(sp[0 * 33], sp[1 * 33]); o.y = cvt_pk_bf16(sp[2 * 33], sp[3 * 33]); o.z = cvt_pk_bf16(sp[4 * 33], sp[5 * 33]); o.w = cvt_pk_bf16(sp[6 * 33], sp[7 * 33]);
        *(u32x4*)(WT + (size_t)(d0 + n) * K + k0 + 8 * c) = o; }
    asm volatile("s_waitcnt lgkmcnt(0)" ::: "memory");
}
DI void p0_prologue(const Ctx& F) {
    const Tid T = opaque_tid();
    if (blockIdx.x < 48) {
        LAS float* red = (LAS float*)F.lds;
        LAS float* sl = (LAS float*)(F.lds + 16384);
        for (int e = T.tid; e < 5 * 1024; e += 512) { const int v = e >> 10, k = e & 1023; sl[e] = siluf(v < 4 ? F.c[v * 1024 + k] : F.c_ctx[k]); }
        __syncthreads();
        const int n0 = 64 * blockIdx.x, k0 = 128 * T.wave, r4 = T.lane >> 4, c4 = T.lane & 15;
        f32x4 a[5];
#pragma unroll
        for (int v = 0; v < 5; ++v) a[v] = (f32x4){0.f, 0.f, 0.f, 0.f};
#pragma unroll 1
        for (int ib = 0; ib < 32; ib += 8) {
            f32x4 wv[8];
#pragma unroll
            for (int i = 0; i < 8; ++i) wv[i] = __builtin_nontemporal_load((const f32x4*)(F.ada_w + (size_t)(k0 + 4 * (ib + i) + r4) * 3072 + n0 + 4 * c4));
#pragma unroll
            for (int i = 0; i < 8; ++i) {
#pragma unroll
                for (int v = 0; v < 5; ++v) a[v] += wv[i] * sl[v * 1024 + k0 + 4 * (ib + i) + r4];
                __builtin_amdgcn_sched_barrier(0); }
        }
#pragma unroll
        for (int v = 0; v < 5; ++v) {
#pragma unroll
            for (int e = 0; e < 4; ++e) { float t = a[v][e]; t += __shfl_xor(t, 16); t += __shfl_xor(t, 32); a[v][e] = t; }
            if (r4 == 0) { LAS float* d = red + (T.wave * 5 + v) * 64 + 4 * c4; d[0] = a[v].x; d[1] = a[v].y; d[2] = a[v].z; d[3] = a[v].w; } }
        __syncthreads();
        if (T.tid < 320) { const int v = T.tid >> 6, l = T.tid & 63; float s = F.ada_b[n0 + l];
#pragma unroll
            for (int w = 0; w < 8; ++w) s += red[(w * 5 + v) * 64 + l];
            F.MOD[v * 3072 + n0 + l] = s; }
        __syncthreads();
    }
    if (blockIdx.x == 48) {
        for (int e = T.tid; e < 1024; e += 512) { const int p = e >> 4, f = e & 15; const float inv = powf(10000.f, -(float)f / 16.f); const float ang = (float)p * inv;
            F.ROPE[e] = (f32x2){cosf(ang), sinf(ang)}; }
    }
    LAS float* scr = (LAS float*)(F.lds + T.wave * 16384);
    const int gw = blockIdx.x * 8 + T.wave, NGW = gridDim.x * 8;
    constexpr int I_IN = 16 * (NIN / 32), I_SQ = 16 * 32;
    for (int it = gw; it < I_IN + 3 * I_SQ; it += NGW) {
        int r = it;
        if (r < I_IN) { p0_transpose_item(F.w_in, 1024, NIN, F.WIN, true, scr, r, T.lane); continue; } r -= I_IN;
        if (r < I_SQ) { p0_transpose_item(F.w_a, 1024, 1024, F.WA, false, scr, r, T.lane); continue; } r -= I_SQ;
        if (r < I_SQ) { p0_transpose_item(F.w_b, 1024, 1024, F.WB, false, scr, r, T.lane); continue; } r -= I_SQ;
        p0_transpose_item(F.w_out, 1024, 1024, F.WOUT, false, scr, r, T.lane);
    }
}
template <int RB> DI void p1_row_group(const Ctx& F, const Tid& T, int m0) {
    f32x4 v[RB][2][2]; float ss[RB];
#pragma unroll
    for (int r = 0; r < RB; ++r) { const int m = m0 + r; const float* xr = m < MTOK ? F.x + (size_t)m * DM : F.ctx + (size_t)(m - MTOK) * DM;
#pragma unroll
        for (int j = 0; j < 2; ++j)
#pragma unroll
            for (int h = 0; h < 2; ++h) v[r][j][h] = __builtin_nontemporal_load(((const f32x4*)xr) + 2 * (T.lane + 64 * j) + h); }
#pragma unroll
    for (int r = 0; r < RB; ++r) { float s = 0.f;
#pragma unroll
        for (int j = 0; j < 2; ++j)
#pragma unroll
            for (int h = 0; h < 2; ++h) { const f32x4 t = v[r][j][h]; s += (t.x * t.x + t.y * t.y) + (t.z * t.z + t.w * t.w); }
        ss[r] = s; }
#pragma unroll
    for (int o = 1; o < 64; o <<= 1)
#pragma unroll
        for (int r = 0; r < RB; ++r) ss[r] += __shfl_xor(ss[r], o);
    const int mb = m0 < MTOK ? (m0 >> 12) : 4; const float* mod = F.MOD + mb * 3072;
#pragma unroll
    for (int j = 0; j < 2; ++j) { const int col = 8 * (T.lane + 64 * j);
        f32x4 w[2], sh[2], sc[2];
#pragma unroll
        for (int h = 0; h < 2; ++h) { w[h] = *(const f32x4*)(F.norm_w + col + 4 * h); sh[h] = *(const f32x4*)(mod + col + 4 * h); sc[h] = *(const f32x4*)(mod + 1024 + col + 4 * h); }
#pragma unroll
        for (int r = 0; r < RB; ++r) { const float rstd = __builtin_amdgcn_rsqf(ss[r] * (1.f / DM) + EPS);
            const f32x4 y0 = (v[r][j][0] * rstd * w[0]) * (sc[0] + 1.0f) + sh[0], y1 = (v[r][j][1] * rstd * w[1]) * (sc[1] + 1.0f) + sh[1];
            u32x4 o; o.x = cvt_pk_bf16(y0.x, y0.y); o.y = cvt_pk_bf16(y0.z, y0.w); o.z = cvt_pk_bf16(y1.x, y1.y); o.w = cvt_pk_bf16(y1.z, y1.w);
            *(u32x4*)(F.XM + (size_t)(m0 + r) * DM + col) = o; } }
}
DI void p1_rows(const Ctx& F) {
    const Tid T = opaque_tid();
    const int gw = blockIdx.x * 8 + T.wave, NGW = gridDim.x * 8;
    for (int m0 = gw * 8; m0 < MTOK; m0 += NGW * 8) p1_row_group<8>(F, T, m0);
    for (int m0 = MTOK + gw; m0 < MALL; m0 += NGW) p1_row_group<1>(F, T, m0);
}
DI size_t gate_block(int pm, int t, int wr, int wc, int ai, int m) { return (size_t)(((((pm * 8 + t) * 8 + (wr * 4 + wc)) * 2 + ai) * 4 + m)) * 512; }
DI size_t gate_index(int row, int col) { const int pm = row >> 8, rr = row & 255, cc = col & 127;
    return gate_block(pm, col >> 7, (rr >> 6) & 1, cc >> 5, rr >> 7, (rr >> 4) & 3) + (size_t)(((cc >> 3) & 3) * 16 + (rr & 15)) * 8 + (cc & 7); }
struct Sched1 {
    int G, c;
    DI bool next(int i, pg8::Unit& u) const { const int L = i * G + c; if (L >= 64 * 36) return false; pg8::tile_of(L, 64, 36, u); return true; }
};
struct SchedCtx {
    int c;
    DI bool next(int i, pg8::Unit& u) const { if (i > 0 || c >= 24) return false; u.pm = 64 + c / 6; u.pn = 18 + c % 6; return true; }
};
struct Epi1 {
    unsigned char* ws; bf16_t *R, *SGB; const f32x2* rope;
    DI int vm_ops(const pg8::Unit& u) const { return u.pn < 16 ? 8 : 16; }
    DI void mid(f32x4 (&)[2][2][4][2], const pg8::Unit&, int, int, int, int) const {}
    DI void operator()(const f32x4 (&acc)[2][2][4][2], const pg8::Unit& u, int wr, int wc, int fr, int fq) const {
        const int pn = u.pn, row0 = u.pm * 256 + wr * 64 + fr, x0 = wc * 32 + 8 * fq;
        const bool isctx = u.pm >= 64;
        if (pn < 16) {
            bf16_t* dst = (bf16_t*)(ws + (wc < 2 ? WS_HC : WS_P)) + 64 * pn + (x0 & 63);
#pragma unroll
            for (int ai = 0; ai < 2; ++ai)
#pragma unroll
                for (int m = 0; m < 4; ++m) { const size_t row = row0 + ai * 128 + m * 16;
                    f32x4 o[2];
#pragma unroll
                    for (int n = 0; n < 2; ++n) { const f32x4 a = acc[ai][0][m][n], b = acc[ai][1][m][n];
                        if (wc < 2) o[n] = a * b;
                        else { o[n].x = a.x * siluf(b.x); o[n].y = a.y * siluf(b.y); o[n].z = a.z * siluf(b.z); o[n].w = a.w * siluf(b.w); } }
                    u32x4 w; w.x = cvt_pk_bf16(o[0].x, o[0].y); w.y = cvt_pk_bf16(o[0].z, o[0].w); w.z = cvt_pk_bf16(o[1].x, o[1].y); w.w = cvt_pk_bf16(o[1].z, o[1].w);
                    *(u32x4*)(dst + row * 1024) = w; }
        } else if (pn < 20) {
            const int t = (pn - 16) & 1, isk = (pn - 16) >> 1, head = 4 * t + wc, i0 = 8 * fq;
            const float scale = isk ? 0.125f : 1.0f;
            bf16_t* base = (bf16_t*)(ws + (isk ? (isctx ? WS_KC : WS_K) : WS_Q));
#pragma unroll
            for (int ai = 0; ai < 2; ++ai)
#pragma unroll
                for (int m = 0; m < 4; ++m) { const int row = row0 + ai * 128 + m * 16; const int orow = isctx ? row - MTOK : row;
                    const int pos = row & 4095, pidx = (fq < 2) ? (pos >> 6) : (pos & 63);
                    const f32x2* rp = rope + pidx * 16 + (fq & 1) * 8;
                    float o1[8], o2[8];
#pragma unroll
                    for (int e = 0; e < 8; ++e) { f32x2 cs = rp[e]; if (isctx) cs = (f32x2){1.f, 0.f};
                        const float t1 = acc[ai][0][m][e >> 2][e & 3], t2 = acc[ai][1][m][e >> 2][e & 3];
                        o1[e] = (t1 * cs.x - t2 * cs.y) * scale; o2[e] = (t1 * cs.y + t2 * cs.x) * scale; }
                    u32x4 w1, w2; w1.x = cvt_pk_bf16(o1[0], o1[1]); w1.y = cvt_pk_bf16(o1[2], o1[3]); w1.z = cvt_pk_bf16(o1[4], o1[5]); w1.w = cvt_pk_bf16(o1[6], o1[7]);
                    w2.x = cvt_pk_bf16(o2[0], o2[1]); w2.y = cvt_pk_bf16(o2[2], o2[3]); w2.z = cvt_pk_bf16(o2[4], o2[5]); w2.w = cvt_pk_bf16(o2[6], o2[7]);
                    bf16_t* d = base + (size_t)orow * 512 + head * 64 + i0;
                    *(u32x4*)d = w1; *(u32x4*)(d + 32) = w2; }
        } else if (pn < 28) {
            const bool isz = pn >= 24;
            bf16_t* base = (bf16_t*)(ws + (isz ? WS_SZB : (isctx ? WS_VC : WS_V)));
            const int colt = 256 * (pn - (isz ? 24 : 20)) + x0;
#pragma unroll
            for (int ai = 0; ai < 2; ++ai)
#pragma unroll
                for (int m = 0; m < 4; ++m) { const int row = row0 + ai * 128 + m * 16; const int orow = isctx ? row - MTOK : row;
#pragma unroll
                    for (int bj = 0; bj < 2; ++bj) { f32x4 a = acc[ai][bj][m][0], b = acc[ai][bj][m][1];
                        u32x4 w; w.x = cvt_pk_bf16(a.x, a.y); w.y = cvt_pk_bf16(a.z, a.w); w.z = cvt_pk_bf16(b.x, b.y); w.w = cvt_pk_bf16(b.z, b.w);
                        if (isz) __builtin_nontemporal_store(w, (u32x4*)(base + (size_t)orow * 1024 + colt + bj * 128)); else *(u32x4*)(base + (size_t)orow * 1024 + colt + bj * 128) = w; } }
        } else {
            const int col = 128 * (pn - 28) + x0;
#pragma unroll
            for (int ai = 0; ai < 2; ++ai)
#pragma unroll
                for (int m = 0; m < 4; ++m) { const size_t row = row0 + ai * 128 + m * 16;
                    float rr[8], sg[8];
#pragma unroll
                    for (int e = 0; e < 8; ++e) { const float ga = acc[ai][0][m][e >> 2][e & 3], gb = acc[ai][1][m][e >> 2][e & 3];
                        const float ea = 1.f + __expf(-ga), eb = 1.f + __expf(-gb); sg[e] = __builtin_amdgcn_rcpf(eb); rr[e] = eb * __builtin_amdgcn_rcpf(ea); }
                    u32x4 w1, w2; w1.x = cvt_pk_bf16(rr[0], rr[1]); w1.y = cvt_pk_bf16(rr[2], rr[3]); w1.z = cvt_pk_bf16(rr[4], rr[5]); w1.w = cvt_pk_bf16(rr[6], rr[7]);
                    w2.x = cvt_pk_bf16(sg[0], sg[1]); w2.y = cvt_pk_bf16(sg[2], sg[3]); w2.z = cvt_pk_bf16(sg[4], sg[5]); w2.w = cvt_pk_bf16(sg[6], sg[7]);
                    const size_t gi = gate_block(u.pm, pn - 28, wr, wc, ai, m) + (size_t)(fq * 16 + fr) * 8;
                    __builtin_nontemporal_store(w1, (u32x4*)(R + gi)); __builtin_nontemporal_store(w2, (u32x4*)(SGB + gi)); }
        }
    }
};
DI void n2_inproj(const Ctx& F) {
    const Tid T = opaque_tid();
    const size_t NT = (size_t)gridDim.x * 512, gt = (size_t)blockIdx.x * 512 + T.tid;
    for (size_t idx = gt; idx < (size_t)(MALL / 4) * 1024; idx += NT) {
        const int ch = (int)(idx & 1023), t0 = (int)(idx >> 10) * 4;
        const bool doqk = ch < 512 && (ch & 63) < 32;
        float a[12][4];
#pragma unroll
        for (int o = 0; o < 12; ++o)
#pragma unroll
            for (int j = 0; j < 4; ++j) a[o][j] = 0.f;
        for (int k = 0; k < 1024; ++k) {
            const float* wr = F.w_in + (size_t)k * NIN;
            float xv[4];
#pragma unroll
            for (int j = 0; j < 4; ++j) xv[j] = bf2f(F.XM[(size_t)(t0 + j) * 1024 + k]);
            float w[12];
            w[0] = wr[ch]; w[1] = wr[1024 + ch]; w[2] = wr[2048 + ch]; w[3] = wr[3072 + ch]; w[4] = wr[5120 + ch]; w[5] = wr[6144 + ch]; w[6] = wr[7168 + ch]; w[7] = wr[8192 + ch];
            if (doqk) { w[8] = wr[4096 + ch]; w[9] = wr[4096 + ch + 32]; w[10] = wr[4608 + ch]; w[11] = wr[4608 + ch + 32]; } else { w[8] = w[9] = w[10] = w[11] = 0.f; }
#pragma unroll
            for (int o = 0; o < 12; ++o)
#pragma unroll
                for (int j = 0; j < 4; ++j) a[o][j] += xv[j] * w[o];
        }
#pragma unroll
        for (int j = 0; j < 4; ++j) { const int t = t0 + j;
            if (t < MTOK) {
                const size_t o = (size_t)t * 1024 + ch;
                F.HC[o] = f2bf(a[2][j] * a[0][j]); F.P[o] = f2bf(siluf(a[3][j]) * a[1][j]); F.V[o] = f2bf(a[4][j]); F.SZB[o] = f2bf(a[5][j]);
                const float sga = 1.f / (1.f + __expf(-a[6][j])), sgb = 1.f / (1.f + __expf(-a[7][j]));
                { const size_t gi = gate_index(t, ch); F.R[gi] = f2bf(sga / sgb); F.SGB[gi] = f2bf(sgb); }
                if (doqk) { const int i = ch & 63, pos = t & 4095; const int pidx = i < 16 ? (pos >> 6) : (pos & 63); const f32x2 cs = F.ROPE[pidx * 16 + (i & 15)];
                    const size_t q = (size_t)t * 512 + ch;
                    F.Q[q] = f2bf(a[8][j] * cs.x - a[9][j] * cs.y); F.Q[q + 32] = f2bf(a[8][j] * cs.y + a[9][j] * cs.x);
                    F.K[q] = f2bf((a[10][j] * cs.x - a[11][j] * cs.y) * 0.125f); F.K[q + 32] = f2bf((a[10][j] * cs.y + a[11][j] * cs.x) * 0.125f); }
            } else {
                const int tc = t - MTOK;
                F.VC[(size_t)tc * 1024 + ch] = f2bf(a[4][j]);
                if (doqk) { F.KC[(size_t)tc * 512 + ch] = f2bf(a[10][j] * 0.125f); F.KC[(size_t)tc * 512 + ch + 32] = f2bf(a[11][j] * 0.125f); }
            }
        }
    }
}
DI bf16x8 tr2(const LAS unsigned char* p, int delta) {
    const s16x4 lo = __builtin_bit_cast(s16x4, __builtin_amdgcn_ds_read_tr16_b64_v4i16((LAS v4i16_t*)p));
    const s16x4 hi = __builtin_bit_cast(s16x4, __builtin_amdgcn_ds_read_tr16_b64_v4i16((LAS v4i16_t*)(p + delta)));
    return __builtin_shufflevector(lo, hi, 0, 1, 2, 3, 4, 5, 6, 7);
}
DI u32x4 scale8(u32x4 w, float s) {
    u32x4 o; o.x = cvt_pk_bf16(bflo(w.x) * s, bfhi(w.x) * s); o.y = cvt_pk_bf16(bflo(w.y) * s, bfhi(w.y) * s); o.z = cvt_pk_bf16(bflo(w.z) * s, bfhi(w.z) * s); o.w = cvt_pk_bf16(bflo(w.w) * s, bfhi(w.w) * s); return o;
}
DI void p3_kv(const Ctx& F, int it0, int it1, int stride) {
    const Tid T = opaque_tid();
    LAS unsigned char* KFI = F.lds; LAS unsigned char* KBI = F.lds + 20480; LAS unsigned char* VI = F.lds + 40960;
    const int tid = T.tid, lane = T.lane, w = T.wave, g = lane >> 4, q = (lane & 15) >> 2, p = lane & 3;
    const int row = tid >> 2, seg = tid & 3;
    u32x4 pk[2], pv[4];
    auto prefetch = [&](int it) { const int bh = it >> 5, c = it & 31; const size_t tok0 = (size_t)(bh >> 3) * SEQ + c * CHK;
        const bf16_t* kp = F.K + tok0 * 512 + (bh & 7) * 64; const bf16_t* vp = F.V + tok0 * 1024 + (bh & 7) * 128;
        pk[0] = *(const u32x4*)(kp + (size_t)row * 512 + seg * 16); pk[1] = *(const u32x4*)(kp + (size_t)row * 512 + seg * 16 + 8);
#pragma unroll
        for (int i = 0; i < 4; ++i) pv[i] = *(const u32x4*)(vp + (size_t)row * 1024 + seg * 32 + 8 * i); };
    if (it0 < it1) prefetch(it0);
    for (int it = it0; it < it1; it += stride) {
        const int bh = it >> 5, c = it & 31;
        const float l2f = log2_gamma(F.decay_logit, 0, bh & 7), l2b = log2_gamma(F.decay_logit, 1, bh & 7);
        { const float df = __builtin_amdgcn_exp2f(l2f * (float)(127 - row)), db = __builtin_amdgcn_exp2f(l2b * (float)row);
            *(LAS u32x4*)(KFI + row * 160 + seg * 32) = scale8(pk[0], df); *(LAS u32x4*)(KFI + row * 160 + seg * 32 + 16) = scale8(pk[1], df);
            *(LAS u32x4*)(KBI + row * 160 + seg * 32) = scale8(pk[0], db); *(LAS u32x4*)(KBI + row * 160 + seg * 32 + 16) = scale8(pk[1], db);
#pragma unroll
            for (int i = 0; i < 4; ++i) *(LAS u32x4*)(VI + row * 288 + seg * 64 + 16 * i) = pv[i]; }
        __syncthreads();
        if (it + stride < it1) prefetch(it + stride);
        f32x4 acc[2][4];
#pragma unroll
        for (int d = 0; d < 2; ++d)
#pragma unroll
            for (int nb = 0; nb < 4; ++nb) acc[d][nb] = (f32x4){0.f, 0.f, 0.f, 0.f};
#pragma unroll
        for (int s2 = 0; s2 < 4; ++s2) {
            const bf16x8 vb = tr2(VI + (32 * s2 + 8 * g + q) * 288 + (16 * w + 4 * p) * 2, 4 * 288);
#pragma unroll
            for (int nb = 0; nb < 4; ++nb) {
                const bf16x8 kf = tr2(KFI + (32 * s2 + 8 * g + q) * 160 + (16 * nb + 4 * p) * 2, 4 * 160);
                const bf16x8 kb = tr2(KBI + (32 * s2 + 8 * g + q) * 160 + (16 * nb + 4 * p) * 2, 4 * 160);
                acc[0][nb] = __builtin_amdgcn_mfma_f32_16x16x32_bf16(kf, vb, acc[0][nb], 0, 0, 0);
                acc[1][nb] = __builtin_amdgcn_mfma_f32_16x16x32_bf16(kb, vb, acc[1][nb], 0, 0, 0);
            }
        }
        bf16_t* of = F.KV + ((size_t)(0 * 32 + bh) * 32 + c) * 8192; bf16_t* ob = F.KV + ((size_t)(1 * 32 + bh) * 32 + c) * 8192;
#pragma unroll
        for (int nb = 0; nb < 4; ++nb) { const int o = ((w * 4 + nb) * 64 + lane) * 4;
            u32x2 a, b; a.x = cvt_pk_bf16(acc[0][nb].x, acc[0][nb].y); a.y = cvt_pk_bf16(acc[0][nb].z, acc[0][nb].w); b.x = cvt_pk_bf16(acc[1][nb].x, acc[1][nb].y); b.y = cvt_pk_bf16(acc[1][nb].z, acc[1][nb].w);
            *(u32x2*)(of + o) = a; *(u32x2*)(ob + o) = b; }
        __syncthreads();
    }
}
DI void p4_ctx_state(const Ctx& F, int bh) {
    const Tid T = opaque_tid();
    LAS unsigned char* KFI = F.lds; LAS unsigned char* KBI = F.lds + 20480; LAS unsigned char* VI = F.lds + 40960;
    const int tid = T.tid, lane = T.lane, w = T.wave, g = lane >> 4, q = (lane & 15) >> 2, p = lane & 3;
    const int row = tid >> 2, seg = tid & 3;
    const float l2f = log2_gamma(F.decay_logit, 0, bh & 7), l2b = log2_gamma(F.decay_logit, 1, bh & 7);
    f32x4 acc[2][4];
#pragma unroll
    for (int d = 0; d < 2; ++d)
#pragma unroll
        for (int nb = 0; nb < 4; ++nb) acc[d][nb] = (f32x4){0.f, 0.f, 0.f, 0.f};
    for (int cc = 0; cc < 2; ++cc) {
        const size_t tok0 = (size_t)(bh >> 3) * CTXL + cc * CHK; const int m = cc * CHK + row;
        const bf16_t* kp = F.KC + tok0 * 512 + (bh & 7) * 64; const bf16_t* vp = F.VC + tok0 * 1024 + (bh & 7) * 128;
        const u32x4 k0 = *(const u32x4*)(kp + (size_t)row * 512 + seg * 16), k1 = *(const u32x4*)(kp + (size_t)row * 512 + seg * 16 + 8);
        const float df = __builtin_amdgcn_exp2f(l2f * (float)(255 - m)), db = __builtin_amdgcn_exp2f(l2b * (float)m);
        *(LAS u32x4*)(KFI + row * 160 + seg * 32) = scale8(k0, df); *(LAS u32x4*)(KFI + row * 160 + seg * 32 + 16) = scale8(k1, df);
        *(LAS u32x4*)(KBI + row * 160 + seg * 32) = scale8(k0, db); *(LAS u32x4*)(KBI + row * 160 + seg * 32 + 16) = scale8(k1, db);
#pragma unroll
        for (int i = 0; i < 4; ++i) *(LAS u32x4*)(VI + row * 288 + seg * 64 + 16 * i) = *(const u32x4*)(vp + (size_t)row * 1024 + seg * 32 + 8 * i);
        __syncthreads();
#pragma unroll
        for (int s2 = 0; s2 < 4; ++s2) {
            const bf16x8 vb = tr2(VI + (32 * s2 + 8 * g + q) * 288 + (16 * w + 4 * p) * 2, 4 * 288);
#pragma unroll
            for (int nb = 0; nb < 4; ++nb) {
                const bf16x8 kf = tr2(KFI + (32 * s2 + 8 * g + q) * 160 + (16 * nb + 4 * p) * 2, 4 * 160);
                const bf16x8 kb = tr2(KBI + (32 * s2 + 8 * g + q) * 160 + (16 * nb + 4 * p) * 2, 4 * 160);
                acc[0][nb] = __builtin_amdgcn_mfma_f32_16x16x32_bf16(kf, vb, acc[0][nb], 0, 0, 0);
                acc[1][nb] = __builtin_amdgcn_mfma_f32_16x16x32_bf16(kb, vb, acc[1][nb], 0, 0, 0);
            }
        }
        __syncthreads();
    }
    float* of = F.S0 + (size_t)(0 * 32 + bh) * 8192; float* ob = F.S0 + (size_t)(1 * 32 + bh) * 8192;
#pragma unroll
    for (int nb = 0; nb < 4; ++nb) { const int o = ((w * 4 + nb) * 64 + lane) * 4; *(f32x4*)(of + o) = acc[0][nb]; *(f32x4*)(ob + o) = acc[1][nb]; }
}
DI void p3_ua(const Ctx& F, int blk, int nblk) {
    const Tid T = opaque_tid();
    const size_t NT = (size_t)nblk * 512, gt = (size_t)blk * 512 + T.tid;
    for (size_t idx = gt; idx < (size_t)MTOK * 128; idx += NT) {
        const int t = (int)(idx >> 7), c8 = (int)(idx & 127) * 8, pos = t & 4095;
        const bf16_t* hp = F.HC + (size_t)t * 1024 + c8;
        const u32x4 z = (u32x4){0u, 0u, 0u, 0u};
        const u32x4 h0 = pos > 0 ? *(const u32x4*)(hp - 1024) : z, h1 = *(const u32x4*)hp, h2 = pos < SEQ - 1 ? *(const u32x4*)(hp + 1024) : z;
        const u32x4 pv = *(const u32x4*)(F.P + (size_t)t * 1024 + c8);
        float o[8];
#pragma unroll
        for (int e = 0; e < 8; ++e) { const unsigned a = h0[e >> 1], b = h1[e >> 1], c = h2[e >> 1], pp = pv[e >> 1];
            const float x0 = (e & 1) ? bfhi(a) : bflo(a), x1 = (e & 1) ? bfhi(b) : bflo(b), x2 = (e & 1) ? bfhi(c) : bflo(c), pf = (e & 1) ? bfhi(pp) : bflo(pp);
            const float cv = F.conv_w[c8 + e] * x0 + F.conv_w[1024 + c8 + e] * x1 + F.conv_w[2048 + c8 + e] * x2 + F.conv_b[c8 + e];
            o[e] = pf * cv; }
        u32x4 w; w.x = cvt_pk_bf16(o[0], o[1]); w.y = cvt_pk_bf16(o[2], o[3]); w.z = cvt_pk_bf16(o[4], o[5]); w.w = cvt_pk_bf16(o[6], o[7]);
        *(u32x4*)(F.P + (size_t)t * 1024 + c8) = w;
    }
}
DI void p4_scan(const Ctx& F, int blk, int nblk) {
    const Tid T = opaque_tid();
    const size_t NT = (size_t)nblk * 512, gt = (size_t)blk * 512 + T.tid;
    for (size_t idx = gt; idx < (size_t)2 * 32 * 2048; idx += NT) {
        const int e4 = (int)(idx & 2047), bh = (int)(idx >> 11) & 31, dir = (int)(idx >> 16);
        const float g = exp2f(log2_gamma(F.decay_logit, dir, bh & 7) * 128.f);
        const u32x2* kv = (const u32x2*)(F.KV + ((size_t)(dir * 32 + bh) * 32) * 8192) + e4;
        u32x2* st = (u32x2*)(F.ST + ((size_t)(dir * 32 + bh) * 32) * 8192) + e4;
        float s0 = 0.f, s1 = 0.f, s2 = 0.f, s3 = 0.f;
        u32x2 v[32];
#pragma unroll
        for (int i = 0; i < 32; ++i) v[i] = __builtin_nontemporal_load(kv + (size_t)(dir == 0 ? i : 31 - i) * 2048);
#pragma unroll
        for (int i = 0; i < 32; ++i) { const int c = dir == 0 ? i : 31 - i;
            u32x2 o; o.x = cvt_pk_bf16(s0, s1); o.y = cvt_pk_bf16(s2, s3); st[(size_t)c * 2048] = o;
            s0 = g * s0 + bflo(v[i].x); s1 = g * s1 + bfhi(v[i].x); s2 = g * s2 + bflo(v[i].y); s3 = g * s3 + bfhi(v[i].y); }
    }
}
DI void n4_recurrence(const Ctx& F) {
    const Tid T = opaque_tid();
    const int gw = blockIdx.x * 8 + T.wave, NGW = gridDim.x * 8, d = T.lane;
    for (int task = gw; task < 32 * 128; task += NGW) {
        const int bh = task >> 7, v = task & 127, b = bh >> 3, h = bh & 7;
        const float gf = exp2f(log2_gamma(F.decay_logit, 0, h)), gb = exp2f(log2_gamma(F.decay_logit, 1, h));
        float s = 0.f;
        for (int m = 0; m < CTXL; ++m) { const size_t t = (size_t)b * CTXL + m; s = gf * s + bf2f(F.KC[t * 512 + h * 64 + d]) * bf2f(F.VC[t * 1024 + h * 128 + v]); }
        const float sF = s; s = 0.f;
        for (int m = CTXL - 1; m >= 0; --m) { const size_t t = (size_t)b * CTXL + m; s = gb * s + bf2f(F.KC[t * 512 + h * 64 + d]) * bf2f(F.VC[t * 1024 + h * 128 + v]); }
        const float sB = s;
        s = sF;
        for (int n = 0; n < SEQ; ++n) { const size_t t = (size_t)b * SEQ + n; s = gf * s + bf2f(F.K[t * 512 + h * 64 + d]) * bf2f(F.V[t * 1024 + h * 128 + v]);
            const float o = wave_sum(bf2f(F.Q[t * 512 + h * 64 + d]) * s); if (d == 0) F.RET[t * 1024 + h * 128 + v] = o; }
        s = sB;
        for (int n = SEQ - 1; n >= 0; --n) { const size_t t = (size_t)b * SEQ + n; s = gb * s + bf2f(F.K[t * 512 + h * 64 + d]) * bf2f(F.V[t * 1024 + h * 128 + v]);
            const float o = wave_sum(bf2f(F.Q[t * 512 + h * 64 + d]) * s); if (d == 0) F.RET[t * 1024 + h * 128 + v] += o; }
    }
}
DI void n5_groupnorm(const Ctx& F) {
    const Tid T = opaque_tid();
    const int gw = blockIdx.x * 8 + T.wave, NGW = gridDim.x * 8;
    for (int task = gw; task < MTOK * NH; task += NGW) {
        const int t = task >> 3, h = task & 7; const size_t o = (size_t)t * 1024 + h * 128 + 2 * T.lane;
        const float a = F.RET[o], b = F.RET[o + 1];
        const float mu = wave_sum(a + b) * (1.f / 128.f); const float da = a - mu, db = b - mu;
        const float var = wave_sum(da * da + db * db) * (1.f / 128.f); const float rstd = 1.0f / sqrtf(var + EPS);
        const float ra = da * rstd * F.gn_w[h * 128 + 2 * T.lane], rb = db * rstd * F.gn_w[h * 128 + 2 * T.lane + 1];
        *(unsigned*)(F.UB + o) = cvt_pk_bf16(siluf(bf2f(F.SZB[o])) * ra, siluf(bf2f(F.SZB[o + 1])) * rb);
    }
}
DI void p5_ret(const Ctx& F) {
    const Tid T = opaque_tid();
    LAS unsigned char* KI = F.lds; LAS unsigned char* VI = F.lds + 20480; LAS unsigned char* SF = F.lds + 57344; LAS unsigned char* SB = F.lds + 75776;
    LAS unsigned char* S0F = F.lds + 94208; LAS unsigned char* S0B = F.lds + 110592;
    const int tid = T.tid, lane = T.lane, w = T.wave, g = lane >> 4, q = (lane & 15) >> 2, p = lane & 3, l15 = lane & 15;
    const int row = tid >> 2, seg = tid & 3, il = 16 * w + l15;
    for (int base = blockIdx.x * 4; base < 1024; base += gridDim.x * 4) {
        const int bh = base >> 5, h = bh & 7;
        const float l2f = log2_gamma(F.decay_logit, 0, h), l2b = log2_gamma(F.decay_logit, 1, h);
        { const float* s0f = F.S0 + (size_t)(0 * 32 + bh) * 8192 + row * 64 + seg * 16; const float* s0b = F.S0 + (size_t)(1 * 32 + bh) * 8192 + row * 64 + seg * 16;
#pragma unroll
            for (int i = 0; i < 2; ++i) { const f32x4 a0 = *(const f32x4*)(s0f + 8 * i), a1 = *(const f32x4*)(s0f + 8 * i + 4), b0 = *(const f32x4*)(s0b + 8 * i), b1 = *(const f32x4*)(s0b + 8 * i + 4);
                u32x4 x, y; x.x = cvt_pk_bf16(a0.x, a0.y); x.y = cvt_pk_bf16(a0.z, a0.w); x.z = cvt_pk_bf16(a1.x, a1.y); x.w = cvt_pk_bf16(a1.z, a1.w);
                y.x = cvt_pk_bf16(b0.x, b0.y); y.y = cvt_pk_bf16(b0.z, b0.w); y.z = cvt_pk_bf16(b1.x, b1.y); y.w = cvt_pk_bf16(b1.z, b1.w);
                *(LAS u32x4*)(S0F + row * 128 + seg * 32 + 16 * i) = x; *(LAS u32x4*)(S0B + row * 128 + seg * 32 + 16 * i) = y; } }
        u32x4 pk[2], pv[4], pf0[2], pb0[2]; bf16x8 pq[2];
        auto prefetch = [&](int it) { const int c = it & 31; const size_t tok0 = (size_t)(bh >> 3) * SEQ + c * CHK;
            const bf16_t* kp = F.K + tok0 * 512 + h * 64; const bf16_t* vp = F.V + tok0 * 1024 + h * 128; const bf16_t* qp = F.Q + tok0 * 512 + h * 64;
            const bf16_t* stf = F.ST + ((size_t)(0 * 32 + bh) * 32 + c) * 8192; const bf16_t* stb = F.ST + ((size_t)(1 * 32 + bh) * 32 + c) * 8192;
#pragma unroll
            for (int i = 0; i < 2; ++i) { pk[i] = *(const u32x4*)(kp + (size_t)row * 512 + seg * 16 + 8 * i); pf0[i] = *(const u32x4*)(stf + row * 64 + seg * 16 + 8 * i); pb0[i] = *(const u32x4*)(stb + row * 64 + seg * 16 + 8 * i);
                pq[i] = *(const bf16x8*)(qp + (size_t)il * 512 + 32 * i + 8 * g); }
#pragma unroll
            for (int i = 0; i < 4; ++i) pv[i] = *(const u32x4*)(vp + (size_t)row * 1024 + seg * 32 + 8 * i); };
        prefetch(base);
        for (int k = 0; k < 4; ++k) {
            const int it = base + k, c = it & 31; const size_t tok0 = (size_t)(bh >> 3) * SEQ + c * CHK;
            { const float cf = __builtin_amdgcn_exp2f(l2f * 128.f * (float)c), cb = __builtin_amdgcn_exp2f(l2b * 128.f * (float)(31 - c));
#pragma unroll
                for (int i = 0; i < 2; ++i) { *(LAS u32x4*)(KI + row * 160 + seg * 32 + 16 * i) = pk[i];
                    const u32x4 x = *(const LAS u32x4*)(S0F + row * 128 + seg * 32 + 16 * i), y = *(const LAS u32x4*)(S0B + row * 128 + seg * 32 + 16 * i);
                    u32x4 of, ob;
#pragma unroll
                    for (int e = 0; e < 4; ++e) { of[e] = cvt_pk_bf16(bflo(pf0[i][e]) + cf * bflo(x[e]), bfhi(pf0[i][e]) + cf * bfhi(x[e])); ob[e] = cvt_pk_bf16(bflo(pb0[i][e]) + cb * bflo(y[e]), bfhi(pb0[i][e]) + cb * bfhi(y[e])); }
#pragma unroll
                    for (int jj = 0; jj < 2; ++jj) { const int vv = 16 * (tid >> 6) + 4 * (tid & 3) + 2 * i + jj, dd = 16 * ((tid >> 4) & 3) + 4 * ((tid & 15) >> 2);
                        *(LAS u32x2*)(SF + vv * 144 + dd * 2) = (u32x2){of[2 * jj], of[2 * jj + 1]}; *(LAS u32x2*)(SB + vv * 144 + dd * 2) = (u32x2){ob[2 * jj], ob[2 * jj + 1]}; } }
#pragma unroll
                for (int i = 0; i < 4; ++i) *(LAS u32x4*)(VI + row * 288 + seg * 64 + 16 * i) = pv[i]; }
            bf16x8 qf[2]; qf[0] = pq[0]; qf[1] = pq[1];
            __syncthreads();
            if (k < 3) prefetch(it + 1);
            f32x4 accS[8];
#pragma unroll
            for (int jb = 0; jb < 8; ++jb) { accS[jb] = (f32x4){0.f, 0.f, 0.f, 0.f};
#pragma unroll
                for (int ks = 0; ks < 2; ++ks) { const bf16x8 kf = *(const LAS bf16x8*)(KI + (16 * jb + l15) * 160 + (32 * ks + 8 * g) * 2);
                    accS[jb] = __builtin_amdgcn_mfma_f32_16x16x32_bf16(kf, qf[ks], accS[jb], 0, 0, 0); } }
            bf16x8 pf[4];
#pragma unroll
            for (int s2 = 0; s2 < 4; ++s2) { float pe[8];
#pragma unroll
                for (int e = 0; e < 8; ++e) { const int jb = 2 * s2 + (e >> 2), r = e & 3, j = 16 * jb + 4 * g + r, df = il - j;
                    float mk = __builtin_amdgcn_exp2f((df >= 0 ? l2f : -l2b) * (float)df); if (df == 0) mk = 2.f;
                    pe[e] = accS[jb][r] * mk; }
                u32x4 pw; pw.x = cvt_pk_bf16(pe[0], pe[1]); pw.y = cvt_pk_bf16(pe[2], pe[3]); pw.z = cvt_pk_bf16(pe[4], pe[5]); pw.w = cvt_pk_bf16(pe[6], pe[7]);
                pf[s2] = __builtin_bit_cast(bf16x8, pw); }
            const float decf = __builtin_amdgcn_exp2f(l2f * (float)(il + 1)), decb = __builtin_amdgcn_exp2f(l2b * (float)(128 - il));
            f32x4 accO[8];
#pragma unroll
            for (int vb = 0; vb < 8; ++vb) { f32x4 o = (f32x4){0.f, 0.f, 0.f, 0.f};
#pragma unroll
                for (int s2 = 0; s2 < 4; ++s2) { const bf16x8 vf = tr2(VI + (32 * s2 + 4 * g + q) * 288 + (16 * vb + 4 * p) * 2, 16 * 288);
                    o = __builtin_amdgcn_mfma_f32_16x16x32_bf16(vf, pf[s2], o, 0, 0, 0); }
                f32x4 tf = (f32x4){0.f, 0.f, 0.f, 0.f}, tb = (f32x4){0.f, 0.f, 0.f, 0.f};
#pragma unroll
                for (int ks = 0; ks < 2; ++ks) { const bf16x8 sf = *(const LAS bf16x8*)(SF + (16 * vb + l15) * 144 + (32 * ks + 8 * g) * 2);
                    const bf16x8 sb = *(const LAS bf16x8*)(SB + (16 * vb + l15) * 144 + (32 * ks + 8 * g) * 2);
                    tf = __builtin_amdgcn_mfma_f32_16x16x32_bf16(sf, qf[ks], tf, 0, 0, 0); tb = __builtin_amdgcn_mfma_f32_16x16x32_bf16(sb, qf[ks], tb, 0, 0, 0); }
                accO[vb] = o + tf * decf + tb * decb; __builtin_amdgcn_sched_barrier(0); }
            float sm = 0.f;
#pragma unroll
            for (int vb = 0; vb < 8; ++vb) sm += (accO[vb].x + accO[vb].y) + (accO[vb].z + accO[vb].w);
            sm += __shfl_xor(sm, 16); sm += __shfl_xor(sm, 32);
            const float mu = sm * (1.f / 128.f); float sq = 0.f;
#pragma unroll
            for (int vb = 0; vb < 8; ++vb) { accO[vb] = accO[vb] - mu; sq += (accO[vb].x * accO[vb].x + accO[vb].y * accO[vb].y) + (accO[vb].z * accO[vb].z + accO[vb].w * accO[vb].w); }
            sq += __shfl_xor(sq, 16); sq += __shfl_xor(sq, 32);
            const float rstd = 1.0f / sqrtf(sq * (1.f / 128.f) + EPS);
            __syncthreads();
#pragma unroll
            for (int vb = 0; vb < 8; ++vb) { const f32x4 gw = *(const f32x4*)(F.gn_w + h * 128 + 16 * vb + 4 * g); const f32x4 o = accO[vb] * rstd * gw;
                u32x2 ow; ow.x = cvt_pk_bf16(o.x, o.y); ow.y = cvt_pk_bf16(o.z, o.w);
                *(LAS u32x2*)(VI + il * 288 + (16 * vb + 4 * g) * 2) = ow; }
            __syncthreads();
            { const size_t go = (tok0 + row) * 1024 + h * 128 + seg * 32;
#pragma unroll
                for (int i = 0; i < 4; ++i) { const u32x4 o = *(const LAS u32x4*)(VI + row * 288 + seg * 64 + 16 * i); const u32x4 z = *(const u32x4*)(F.SZB + go + 8 * i);
                    u32x4 r;
#pragma unroll
                    for (int e = 0; e < 4; ++e) r[e] = cvt_pk_bf16(bflo(o[e]) * siluf(bflo(z[e])), bfhi(o[e]) * siluf(bfhi(z[e])));
                    *(u32x4*)(F.UB + go + 8 * i) = r; } }
            __syncthreads();
        }
    }
}
struct SchedSq { int G, c; DI bool next(int i, pg8::Unit& u) const { const int L = i * G + c; if (L >= 256) return false; pg8::tile_of(L, 64, 4, u); return true; } };
struct EpiAB {
    const bf16_t* R; const bf16_t* SGB; bf16_t* MM;
    DI int vm_ops(const pg8::Unit&) const { return 0; }
    DI void mid(f32x4 (&acc)[2][2][4][2], const pg8::Unit& u, int wr, int wc, int fr, int fq) const { apply<false>(acc, u, wr, wc, fr, fq); }
    DI void operator()(const f32x4 (&acc)[2][2][4][2], const pg8::Unit& u, int wr, int wc, int fr, int fq) const { apply<true>(const_cast<f32x4 (&)[2][2][4][2]>(acc), u, wr, wc, fr, fq); }
    template <bool FIN> DI void apply(f32x4 (&acc)[2][2][4][2], const pg8::Unit& u, int wr, int wc, int fr, int fq) const {
        const bf16_t* src = FIN ? SGB : R;
        const size_t base = (size_t)(u.pm * 256 + wr * 64 + fr) * 1024 + u.pn * 256 + wc * 32 + 8 * fq;
#pragma unroll
        for (int am = 0; am < 4; ++am) { const int ai = am >> 1;
            u32x4 gv[4][2];
#pragma unroll
            for (int m = 2 * (am & 1); m < 2 * (am & 1) + 2; ++m)
#pragma unroll
                for (int bj = 0; bj < 2; ++bj) gv[m][bj] = __builtin_nontemporal_load((const u32x4*)(src + gate_block(u.pm, 2 * u.pn + bj, wr, wc, ai, m) + (size_t)(fq * 16 + fr) * 8));
#pragma unroll
            for (int m = 2 * (am & 1); m < 2 * (am & 1) + 2; ++m)
#pragma unroll
                for (int bj = 0; bj < 2; ++bj) { const u32x4 gq = gv[m][bj];
                    f32x4 a = acc[ai][bj][m][0], b = acc[ai][bj][m][1];
                    a.x *= bflo(gq.x); a.y *= bfhi(gq.x); a.z *= bflo(gq.y); a.w *= bfhi(gq.y); b.x *= bflo(gq.z); b.y *= bfhi(gq.z); b.z *= bflo(gq.w); b.w *= bfhi(gq.w);
                    if (FIN) { u32x4 w; w.x = cvt_pk_bf16(a.x, a.y); w.y = cvt_pk_bf16(a.z, a.w); w.z = cvt_pk_bf16(b.x, b.y); w.w = cvt_pk_bf16(b.z, b.w);
                        *(u32x4*)(MM + base + (size_t)(ai * 128 + m * 16) * 1024 + bj * 128) = w; }
                    else { acc[ai][bj][m][0] = a; acc[ai][bj][m][1] = b; } }
            asm volatile("" ::: "memory");
        }
    }
};
struct EpiOut {
    const float* x; const float* MOD; float* out;
    DI int vm_ops(const pg8::Unit&) const { return 0; }
    DI void mid(f32x4 (&)[2][2][4][2], const pg8::Unit&, int, int, int, int) const {}
    DI void operator()(const f32x4 (&acc)[2][2][4][2], const pg8::Unit& u, int wr, int wc, int fr, int fq) const {
        const int col0 = u.pn * 256 + wc * 32 + 8 * fq; const float* gp = MOD + (u.pm >> 4) * 3072 + 2048 + col0;
        f32x4 gx[2][2];
#pragma unroll
        for (int bj = 0; bj < 2; ++bj)
#pragma unroll
            for (int n = 0; n < 2; ++n) gx[bj][n] = *(const f32x4*)(gp + bj * 128 + 4 * n);
#pragma unroll
        for (int ai = 0; ai < 2; ++ai)
#pragma unroll
            for (int m = 0; m < 4; ++m) { const size_t off = (size_t)(u.pm * 256 + ai * 128 + wr * 64 + m * 16 + fr) * 1024 + col0;
#pragma unroll
                for (int bj = 0; bj < 2; ++bj)
#pragma unroll
                    for (int n = 0; n < 2; ++n) { const f32x4 xv = *(const f32x4*)(x + off + bj * 128 + 4 * n); *(f32x4*)(out + off + bj * 128 + 4 * n) = xv + gx[bj][n] * acc[ai][bj][m][n]; }
                if (m & 1) asm volatile("" ::: "memory"); }
    }
};
struct EpiOutNorm {
    const float* x; const float* MOD; float* out; const float* fw; float* slots; unsigned* cnt; LAS float* tab;
    DI int vm_ops(const pg8::Unit&) const { return 0; }
    DI void mid(f32x4 (&)[2][2][4][2], const pg8::Unit&, int, int, int, int) const {}
    DI void operator()(const f32x4 (&acc_)[2][2][4][2], const pg8::Unit& u, int wr, int wc, int fr, int fq) const {
        f32x4 (&acc)[2][2][4][2] = const_cast<f32x4 (&)[2][2][4][2]>(acc_);
        const int col0 = u.pn * 256 + wc * 32 + 8 * fq; const float* gp = MOD + (u.pm >> 4) * 3072 + 2048 + col0;
        f32x4 gx[2][2];
#pragma unroll
        for (int bj = 0; bj < 2; ++bj)
#pragma unroll
            for (int n = 0; n < 2; ++n) gx[bj][n] = *(const f32x4*)(gp + bj * 128 + 4 * n);
#pragma unroll
        for (int ai = 0; ai < 2; ++ai)
#pragma unroll
            for (int m = 0; m < 4; ++m) { const int row = u.pm * 256 + ai * 128 + wr * 64 + m * 16 + fr; const size_t off = (size_t)row * 1024 + col0; float ss = 0.f;
#pragma unroll
                for (int bj = 0; bj < 2; ++bj)
#pragma unroll
                    for (int n = 0; n < 2; ++n) { const f32x4 xv = *(const f32x4*)(x + off + bj * 128 + 4 * n); const f32x4 v = xv + gx[bj][n] * acc[ai][bj][m][n]; acc[ai][bj][m][n] = v;
                        ss += (v.x * v.x + v.y * v.y) + (v.z * v.z + v.w * v.w); }
                ss += __shfl_xor(ss, 16); ss += __shfl_xor(ss, 32);
                if (fq == 0) __hip_atomic_store(slots + (size_t)row * 16 + u.pn * 4 + wc, ss, __ATOMIC_RELAXED, __HIP_MEMORY_SCOPE_AGENT);
                if (m & 1) asm volatile("" ::: "memory"); }
        asm volatile("s_waitcnt vmcnt(0)" ::: "memory");
        __syncthreads();
        if (threadIdx.x == 0) {
            unsigned* c = cnt + 64 * u.pm;
            __hip_atomic_fetch_add(c, 1u, __ATOMIC_RELAXED, __HIP_MEMORY_SCOPE_AGENT);
            unsigned sp = 0;
            while (__hip_atomic_load(c, __ATOMIC_RELAXED, __HIP_MEMORY_SCOPE_AGENT) < 4u) { __builtin_amdgcn_s_sleep(1); if (++sp > (1u << 22)) break; }
            __builtin_amdgcn_fence(__ATOMIC_ACQUIRE, "agent");
            asm volatile("s_waitcnt vmcnt(0)" ::: "memory");
        }
        __syncthreads();
        { const int t = threadIdx.x, row = t >> 1, half = t & 1; const float* sp = slots + (size_t)(u.pm * 256 + row) * 16 + half * 8; float s = 0.f;
#pragma unroll
            for (int j = 0; j < 8; ++j) s += __hip_atomic_load(sp + j, __ATOMIC_RELAXED, __HIP_MEMORY_SCOPE_AGENT);
            s += __shfl_xor(s, 1);
            if (half == 0) tab[row] = 1.0f / sqrtf(s * (1.f / 1024.f) + EPS); }
        __syncthreads();
        f32x4 fv[2][2];
#pragma unroll
        for (int bj = 0; bj < 2; ++bj)
#pragma unroll
            for (int n = 0; n < 2; ++n) fv[bj][n] = *(const f32x4*)(fw + col0 + bj * 128 + 4 * n);
#pragma unroll
        for (int ai = 0; ai < 2; ++ai)
#pragma unroll
            for (int m = 0; m < 4; ++m) { const int rl = ai * 128 + wr * 64 + m * 16 + fr; const float r = tab[rl]; const size_t off = (size_t)(u.pm * 256 + rl) * 1024 + col0;
#pragma unroll
                for (int bj = 0; bj < 2; ++bj)
#pragma unroll
                    for (int n = 0; n < 2; ++n) *(f32x4*)(out + off + bj * 128 + 4 * n) = acc[ai][bj][m][n] * r * fv[bj][n]; }
    }
};
DI void n6_ab(const Ctx& F) {
    const Tid T = opaque_tid();
    const size_t NT = (size_t)gridDim.x * 512, gt = (size_t)blockIdx.x * 512 + T.tid;
    for (size_t idx = gt; idx < (size_t)(MTOK / 4) * 1024; idx += NT) {
        const int n = (int)(idx & 1023), t0 = (int)(idx >> 10) * 4; float ya[4] = {0.f, 0.f, 0.f, 0.f}, yb[4] = {0.f, 0.f, 0.f, 0.f};
        for (int k = 0; k < 1024; ++k) { const float wa = F.w_a[(size_t)k * 1024 + n], wb = F.w_b[(size_t)k * 1024 + n];
#pragma unroll
            for (int j = 0; j < 4; ++j) { ya[j] += bf2f(F.P[(size_t)(t0 + j) * 1024 + k]) * wa; yb[j] += bf2f(F.UB[(size_t)(t0 + j) * 1024 + k]) * wb; } }
#pragma unroll
        for (int j = 0; j < 4; ++j) { const size_t o = (size_t)(t0 + j) * 1024 + n; const size_t gi = gate_index(t0 + j, n); const float sgb = bf2f(F.SGB[gi]), sga = bf2f(F.R[gi]) * sgb; F.MM[o] = f2bf(sga * ya[j] + sgb * yb[j]); }
    }
}
DI void n7_out(const Ctx& F) {
    const Tid T = opaque_tid();
    const size_t NT = (size_t)gridDim.x * 512, gt = (size_t)blockIdx.x * 512 + T.tid;
    for (size_t idx = gt; idx < (size_t)(MTOK / 4) * 1024; idx += NT) {
        const int n = (int)(idx & 1023), t0 = (int)(idx >> 10) * 4; float y[4] = {0.f, 0.f, 0.f, 0.f};
        for (int k = 0; k < 1024; ++k) { const float w = F.w_out[(size_t)k * 1024 + n];
#pragma unroll
            for (int j = 0; j < 4; ++j) y[j] += bf2f(F.MM[(size_t)(t0 + j) * 1024 + k]) * w; }
#pragma unroll
        for (int j = 0; j < 4; ++j) { const size_t o = (size_t)(t0 + j) * 1024 + n; F.out[o] = F.x[o] + F.MOD[((t0 + j) >> 12) * 3072 + 2048 + n] * y[j]; }
    }
}
DI void p8_final(const Ctx& F) {
    const Tid T = opaque_tid();
    const int gw = blockIdx.x * 8 + T.wave, NGW = gridDim.x * 8;
    for (int m = gw; m < MTOK; m += NGW) {
        f32x4* xr = (f32x4*)(F.out + (size_t)m * DM);
        f32x4 v[4]; float ss = 0.f;
#pragma unroll
        for (int j = 0; j < 4; ++j) { v[j] = xr[T.lane + 64 * j]; ss += (v[j].x * v[j].x + v[j].y * v[j].y) + (v[j].z * v[j].z + v[j].w * v[j].w); }
        const float rstd = 1.0f / sqrtf(wave_sum(ss) * (1.f / DM) + EPS);
#pragma unroll
        for (int j = 0; j < 4; ++j) { const f32x4 w = *(const f32x4*)(F.final_w + 4 * (T.lane + 64 * j)); xr[T.lane + 64 * j] = v[j] * rstd * w; }
    }
}

constexpr int NPH = 9;
__global__ void __launch_bounds__(512, 2) fwd_kernel(Args args) {
    extern __shared__ __attribute__((aligned(16))) unsigned char lds_raw[];
    Ctx F;
    F.lds = (LAS unsigned char*)lds_raw;
    if (threadIdx.x < 16) ((LAS unsigned*)(F.lds + LDS_MISC))[threadIdx.x] = 0u;
#if !MK_LAUNCH_PER_PHASE
    {
        unsigned* flag = (unsigned*)(args.ws + WS_FLAG); unsigned* done = flag + 64;
        if (blockIdx.x == 0) {
            for (unsigned i = threadIdx.x; i < WS_BAR_BYTES / 16; i += 512) ((u32x4*)(args.ws + WS_BAR))[i] = (u32x4){0u, 0u, 0u, 0u};
            if (threadIdx.x == 0) __hip_atomic_store(done, 0u, __ATOMIC_RELAXED, __HIP_MEMORY_SCOPE_AGENT);
            asm volatile("s_waitcnt vmcnt(0)" ::: "memory");
            __syncthreads();
            if (threadIdx.x == 0) { __builtin_amdgcn_fence(__ATOMIC_RELEASE, "agent"); asm volatile("s_waitcnt vmcnt(0)" ::: "memory");
                __hip_atomic_store(flag, CTL_MAGIC, __ATOMIC_RELAXED, __HIP_MEMORY_SCOPE_AGENT); }
        } else if (threadIdx.x == 0) {
            unsigned sp = 0;
            while (__hip_atomic_load(flag, __ATOMIC_RELAXED, __HIP_MEMORY_SCOPE_AGENT) != CTL_MAGIC) { __builtin_amdgcn_s_sleep(1); if (++sp > (1u << 22)) break; }
            __builtin_amdgcn_fence(__ATOMIC_ACQUIRE, "agent"); asm volatile("s_waitcnt vmcnt(0)" ::: "memory");
        }
    }
#endif
    __syncthreads();
    const XcdBarrier bar = xcd_barrier_post((unsigned*)(args.ws + WS_BAR), (volatile LAS unsigned*)(F.lds + LDS_MISC));
    F.x = args.in[0]; F.c = args.in[1]; F.ctx = args.in[2]; F.c_ctx = args.in[3]; F.norm_w = args.in[4]; F.ada_w = args.in[5]; F.ada_b = args.in[6]; F.w_in = args.in[7];
    F.conv_w = args.in[8]; F.conv_b = args.in[9]; F.decay_logit = args.in[10]; F.gn_w = args.in[11]; F.w_a = args.in[12]; F.w_b = args.in[13]; F.w_out = args.in[14]; F.final_w = args.in[15];
    F.out = args.out; unsigned char* ws = args.ws; F.ws = ws;
    F.MOD = (float*)(ws + WS_MOD); F.ROPE = (f32x2*)(ws + WS_ROPE);
    F.WA = (bf16_t*)(ws + WS_WA); F.WB = (bf16_t*)(ws + WS_WB); F.WOUT = (bf16_t*)(ws + WS_WOUT); F.WIN = (bf16_t*)(ws + WS_WIN); F.XM = (bf16_t*)(ws + WS_XM);
    F.KV = (bf16_t*)(ws + WS_KV); F.KVC = (bf16_t*)(ws + WS_KVC); F.HC = (bf16_t*)(ws + WS_HC); F.ST = (bf16_t*)(ws + WS_ST); F.MM = (bf16_t*)(ws + WS_MM);
    F.P = (bf16_t*)(ws + WS_P); F.Q = (bf16_t*)(ws + WS_Q); F.K = (bf16_t*)(ws + WS_K); F.V = (bf16_t*)(ws + WS_V); F.SZB = (bf16_t*)(ws + WS_SZB);
    F.KC = (bf16_t*)(ws + WS_KC); F.VC = (bf16_t*)(ws + WS_VC); F.UB = (bf16_t*)(ws + WS_UB);
    F.R = (bf16_t*)args.out; F.SGB = (bf16_t*)args.out + (size_t)MTOK * DM;
    F.RET = (float*)(ws + WS_RET); F.S0 = (float*)(ws + WS_KVC);
    const int lo = args.ph_lo, hi = args.ph_hi; const unsigned naive = args.naive;
#define IN(k) (lo <= (k) && (k) < hi && ((MK_PHASES >> (k)) & 1))
#define NAIVE(k) (((naive & MK_NAIVE_AVAIL) >> (k)) & 1u)
#define SEAM(k) do { if (IN(k) && IN((k) + 1)) xcd_barrier(bar); } while (0)
#define REP(k) for (int rep_ = 0; rep_ < 1 + (int)((MK_REP_MASK >> (k)) & 1u); ++rep_)
    if (IN(0)) REP(0) { p0_prologue(F); } SEAM(0);
    if (IN(1)) REP(1) { p1_rows(F); } SEAM(1);
    if (IN(2)) REP(2) {
        if (NAIVE(2)) n2_inproj(F);
        else { const char* const Ab[2] = {(const char*)F.XM, (const char*)F.XM}; const char* const Bb[2] = {(const char*)F.WIN, (const char*)F.WIN};
            Sched1 S{(int)gridDim.x, (int)blockIdx.x}; Epi1 E{F.ws, F.R, F.SGB, F.ROPE};
            pg8::gemm_phase<1, Epi1, Sched1>(F.lds, Ab, Bb, S, E); }
    } SEAM(2);
    if (IN(3)) {
        if (!NAIVE(3)) {
            const char* const Ab[2] = {(const char*)F.XM, (const char*)F.XM}; const char* const Bb[2] = {(const char*)F.WIN, (const char*)F.WIN};
            SchedCtx S{(int)blockIdx.x}; Epi1 E{F.ws, F.R, F.SGB, F.ROPE};
            pg8::gemm_phase<1, Epi1, SchedCtx>(F.lds, Ab, Bb, S, E);
            if (blockIdx.x >= 24) { p3_ua(F, blockIdx.x - 24, gridDim.x - 24); REP(3) p3_kv(F, blockIdx.x - 24, 1024, gridDim.x - 24); }
        } else p3_ua(F, blockIdx.x, gridDim.x);
    } SEAM(3);
    if (IN(4)) REP(4) { if (NAIVE(4)) n4_recurrence(F); else { if (blockIdx.x >= gridDim.x - 32) p4_ctx_state(F, blockIdx.x - (gridDim.x - 32)); else p4_scan(F, blockIdx.x, gridDim.x - 32); } } SEAM(4);
    if (IN(5)) REP(5) { if (NAIVE(5)) n5_groupnorm(F); else p5_ret(F); } SEAM(5);
    if (IN(6)) REP(6) {
        if (NAIVE(6)) n6_ab(F);
        else { const char* const Ab[2] = {(const char*)F.P, (const char*)F.UB}; const char* const Bb[2] = {(const char*)F.WA, (const char*)F.WB};
            SchedSq S{(int)gridDim.x, (int)blockIdx.x}; EpiAB E{F.R, F.SGB, F.MM};
            pg8::gemm_phase<2, EpiAB, SchedSq>(F.lds, Ab, Bb, S, E); }
    } SEAM(6);
    if (IN(7)) {
        const char* const Ab[2] = {(const char*)F.MM, (const char*)F.MM}; const char* const Bb[2] = {(const char*)F.WOUT, (const char*)F.WOUT};
        SchedSq S{(int)gridDim.x, (int)blockIdx.x};
        if (NAIVE(7)) n7_out(F);
        else if (gridDim.x == 256) {
            EpiOutNorm E{F.x, F.MOD, F.out, F.final_w, (float*)(F.ws + WS_SLOTS), (unsigned*)(F.ws + WS_PCNT), (LAS float*)(F.lds + LDS_TAB)};
            pg8::gemm_phase<1, EpiOutNorm, SchedSq>(F.lds, Ab, Bb, S, E); }
        else { EpiOut E{F.x, F.MOD, F.out}; pg8::gemm_phase<1, EpiOut, SchedSq>(F.lds, Ab, Bb, S, E); }
    }
    if (NAIVE(7) || gridDim.x != 256) { SEAM(7); if (IN(8)) { p8_final(F); } }
#if !MK_LAUNCH_PER_PHASE
    __syncthreads();
    if (threadIdx.x == 0) { unsigned* flag = (unsigned*)(args.ws + WS_FLAG); unsigned* done = flag + 64;
        if (__hip_atomic_fetch_add(done, 1u, __ATOMIC_RELAXED, __HIP_MEMORY_SCOPE_AGENT) == gridDim.x - 1) __hip_atomic_store(flag, 0u, __ATOMIC_RELAXED, __HIP_MEMORY_SCOPE_AGENT); }
#endif
#undef IN
#undef NAIVE
#undef SEAM
}

extern "C" void kernel_launch(void* const* d_in, const int* in_sizes, int n_in, void* d_out, int out_size, void* d_ws, size_t ws_size, hipStream_t stream) {
    static int grid = 0;
    if (grid == 0) {
        if (n_in != 16 || out_size != MTOK * DM || ws_size < WS_END) { fprintf(stderr, "kernel_launch: unexpected shapes (n_in %d out %d ws %zu)\n", n_in, out_size, ws_size); grid = -1; return; }
        int dev = 0, cus = 0, per_cu = 0;
        hipGetDevice(&dev); hipDeviceGetAttribute(&cus, hipDeviceAttributeMultiprocessorCount, dev);
        hipFuncSetAttribute((const void*)fwd_kernel, hipFuncAttributeMaxDynamicSharedMemorySize, LDS_BYTES);
        hipOccupancyMaxActiveBlocksPerMultiprocessor(&per_cu, (const void*)fwd_kernel, 512, LDS_BYTES);
        if (per_cu < 1) { fprintf(stderr, "kernel_launch: occupancy query says %d blocks/CU\n", per_cu); per_cu = 1; }
        grid = cus;
        (void)hipGetLastError();
    }
    if (grid < 0) return;
    Args a{};
    for (int i = 0; i < 16; ++i) a.in[i] = (const float*)d_in[i];
    a.out = (float*)d_out; a.ws = (unsigned char*)d_ws; a.naive = MK_NAIVE_MASK;
#if MK_LAUNCH_PER_PHASE
    hipMemsetAsync((unsigned char*)d_ws + WS_BAR, 0, WS_BAR_BYTES, stream);
#endif
#if MK_LAUNCH_PER_PHASE
    for (int ph = 0; ph < NPH; ++ph) { a.ph_lo = ph; a.ph_hi = ph + 1; hipLaunchKernelGGL(fwd_kernel, dim3(grid), dim3(512), LDS_BYTES, stream, a); }
#else
    a.ph_lo = 0; a.ph_hi = NPH;
    hipLaunchKernelGGL(fwd_kernel, dim3(grid), dim3(512), LDS_BYTES, stream, a);
#endif
}
```
